# Optimizing an MI355X kernel written in HIP

```python
import math
import numpy as np
import jax
import jax.numpy as jnp
from jax import lax

D_MODEL = 1024
BATCH = 32
SEQ = 2048
DEPTH = 2

PLE_DIM = 256
CONV_WIDTH = 4
RMS_EPS = 1e-6
DN_HEADS = 6
DN_HEAD_DIM = 128
DN_WIDTH = DN_HEADS * DN_HEAD_DIM
DN_CHUNK = 64
SSM_HEADS = 12
SSM_HEAD_DIM = 64
SSM_WIDTH = SSM_HEADS * SSM_HEAD_DIM
SSM_GROUPS = 2
SSM_STATE = 128
SSM_CHUNK = 64
SSM_XBC = SSM_WIDTH + 2 * SSM_GROUPS * SSM_STATE
ATTN_HEADS = 12
ATTN_HEAD_DIM = 64
DILATION_GROUPS = ((128, 1), (512, 4), (2048, 16))
ATTN_GROUP_HEADS = ATTN_HEADS // len(DILATION_GROUPS)
ATTN_OUT_WIDTH = ATTN_GROUP_HEADS * ATTN_HEAD_DIM
ATTN_BLOCK = 128
ALIBI_MAX_BIAS = 8.0
N_BRANCHES = 3
FFN_DIM = 2816
N_EXPERTS = 8
TOP_K = 2
EXPERT_DIM = 3584
IN_SPLIT_SIZES = (3 * DN_WIDTH, DN_WIDTH, DN_HEADS, DN_HEADS, SSM_XBC, SSM_WIDTH, SSM_HEADS, 3 * ATTN_HEADS * ATTN_HEAD_DIM, N_BRANCHES * D_MODEL)
IN_WIDTH = sum(IN_SPLIT_SIZES)

kernel_name = 'hybrid_deltanet_ssd_dilated_attn_moe'

F32 = jnp.float32


def rmsnorm(x, g):
    xf = x.astype(F32)
    y = xf * lax.rsqrt(jnp.mean(xf * xf, axis=-1, keepdims=True) + RMS_EPS)
    return (y * g.astype(F32)).astype(x.dtype)


def l2norm(x):
    xf = x.astype(F32)
    return xf * lax.rsqrt(jnp.sum(xf * xf, axis=-1, keepdims=True) + RMS_EPS)


def causal_conv(x, w):
    k_w = w.shape[0]
    s = x.shape[1]
    xp = jnp.pad(x, ((0, 0), (k_w - 1, 0), (0, 0)))
    y = xp[:, k_w - 1:k_w - 1 + s] * w[k_w - 1]
    for j in range(k_w - 1):
        y = y + xp[:, j:j + s] * w[j]
    return y


def swiglu(h, w_gate, w_up, w_down):
    return (jax.nn.silu(h @ w_gate) * (h @ w_up)) @ w_down


def chunked_gated_delta_rule(q, k, v, g, beta):
    bsz, s, h, dk = q.shape
    dv = v.shape[-1]
    c = DN_CHUNK
    n = s // c

    def to_chunks(t):
        return jnp.moveaxis(t.astype(F32).reshape(bsz, n, c, h, *t.shape[3:]), 3, 2)

    q, k, v, g, beta = [to_chunks(t) for t in (q, k, v, g, beta)]
    q = q * dk ** -0.5
    gam = jnp.cumsum(g, axis=-1)
    incl = jnp.tril(jnp.ones((c, c), bool))
    strict = jnp.tril(jnp.ones((c, c), bool), k=-1)
    diff = gam[..., :, None] - gam[..., None, :]
    decay = jnp.where(incl, jnp.exp(jnp.where(incl, diff, 0.0)), 0.0)
    kb = k * beta[..., None]
    a_mat = jnp.where(strict, jnp.einsum('bnhid,bnhjd->bnhij', kb, k) * decay, 0.0)
    lower = a_mat + jnp.eye(c, dtype=F32)
    rhs = jnp.concatenate([kb * jnp.exp(gam)[..., None], v * beta[..., None]], axis=-1)
    sol = lax.linalg.triangular_solve(lower, rhs, left_side=True, lower=True, unit_diagonal=True)
    w_c, u_c = sol[..., :dk], sol[..., dk:]
    q_dec = q * jnp.exp(gam)[..., None]
    attn_qk = jnp.einsum('bnhid,bnhjd->bnhij', q, k) * decay
    g_last = gam[..., -1]
    k_dec = k * jnp.exp(g_last[..., None] - gam)[..., None]

    def step(state, xs):
        w_i, u_i, qd_i, aqk_i, kd_i, gl_i = xs
        v_new = u_i - jnp.einsum('bhcd,bhde->bhce', w_i, state)
        o_i = jnp.einsum('bhcd,bhde->bhce', qd_i, state) + jnp.einsum('bhij,bhje->bhie', aqk_i, v_new)
        state = state * jnp.exp(gl_i)[..., None, None] + jnp.einsum('bhcd,bhce->bhde', kd_i, v_new)
        return state, o_i

    xs = tuple(jnp.moveaxis(t, 1, 0) for t in (w_c, u_c, q_dec, attn_qk, k_dec, g_last))
    _, o = lax.scan(step, jnp.zeros((bsz, h, dk, dv), F32), xs)
    o = jnp.moveaxis(jnp.moveaxis(o, 0, 1), 3, 2)
    return o.reshape(bsz, s, h, dv)


def gated_deltanet(qkv, z, a, b, conv_w, a_log, dt_bias, norm_g):
    bsz, s, _ = qkv.shape
    qkv = jax.nn.silu(causal_conv(qkv, conv_w))
    q, k, v = jnp.split(qkv, 3, axis=-1)
    q = l2norm(q.reshape(bsz, s, DN_HEADS, DN_HEAD_DIM))
    k = l2norm(k.reshape(bsz, s, DN_HEADS, DN_HEAD_DIM))
    v = v.reshape(bsz, s, DN_HEADS, DN_HEAD_DIM)
    g = -jnp.exp(a_log.astype(F32)) * jax.nn.softplus(a.astype(F32) + dt_bias.astype(F32))
    beta = jax.nn.sigmoid(b.astype(F32))
    o = chunked_gated_delta_rule(q, k, v, g, beta)
    o = rmsnorm(o, norm_g) * jax.nn.silu(z.reshape(bsz, s, DN_HEADS, DN_HEAD_DIM).astype(F32))
    return o.reshape(bsz, s, DN_WIDTH).astype(qkv.dtype)


def ssd_chunked(x, dt, a_neg, bm, cm):
    bsz, s, h, pd = x.shape
    grp, ns = bm.shape[2], bm.shape[3]
    hpg = h // grp
    c = SSM_CHUNK
    nc = s // c
    xdt = (x.astype(F32) * dt[..., None]).reshape(bsz, nc, c, grp, hpg, pd)
    a = jnp.moveaxis((dt * a_neg.astype(F32)).reshape(bsz, nc, c, grp, hpg), 2, -1)
    bc = bm.astype(F32).reshape(bsz, nc, c, grp, ns)
    cc = cm.astype(F32).reshape(bsz, nc, c, grp, ns)
    acs = jnp.cumsum(a, axis=-1)
    incl = jnp.tril(jnp.ones((c, c), bool))
    diff = acs[..., :, None] - acs[..., None, :]
    lmat = jnp.where(incl, jnp.exp(jnp.where(incl, diff, 0.0)), 0.0)
    cb = jnp.einsum('bcigs,bcjgs->bcgij', cc, bc)
    y_diag = jnp.einsum('bcgij,bcghij,bcjghp->bcighp', cb, lmat, xdt)
    decay_end = jnp.exp(acs[..., -1:] - acs)
    states = jnp.einsum('bcjgs,bcghj,bcjghp->bcghps', bc, decay_end, xdt)
    chunk_decay = jnp.exp(acs[..., -1])

    def step(state, xs):
        st_i, dec_i = xs
        return state * dec_i[..., None, None] + st_i, state

    _, prev = lax.scan(step, jnp.zeros((bsz, grp, hpg, pd, ns), F32), (jnp.moveaxis(states, 1, 0), jnp.moveaxis(chunk_decay, 1, 0)))
    prev = jnp.moveaxis(prev, 0, 1)
    y_off = jnp.einsum('bcigs,bcghps,bcghi->bcighp', cc, prev, jnp.exp(acs))
    return (y_diag + y_off).reshape(bsz, s, h, pd)


def mamba2_ssd(xbc, z, dt, conv_w, conv_b, a_log, dt_bias, d_skip, norm_g):
    bsz, s, _ = xbc.shape
    xbc = jax.nn.silu(causal_conv(xbc, conv_w) + conv_b)
    xs, bm, cm = jnp.split(xbc, [SSM_WIDTH, SSM_WIDTH + SSM_GROUPS * SSM_STATE], axis=-1)
    x = xs.reshape(bsz, s, SSM_HEADS, SSM_HEAD_DIM)
    bm = bm.reshape(bsz, s, SSM_GROUPS, SSM_STATE)
    cm = cm.reshape(bsz, s, SSM_GROUPS, SSM_STATE)
    dt = jax.nn.softplus(dt.astype(F32) + dt_bias.astype(F32))
    y = ssd_chunked(x, dt, -jnp.exp(a_log.astype(F32)), bm, cm) + d_skip.astype(F32)[:, None] * x.astype(F32)
    y = y.reshape(bsz, s, SSM_GROUPS, SSM_WIDTH // SSM_GROUPS) * jax.nn.silu(z.reshape(bsz, s, SSM_GROUPS, SSM_WIDTH // SSM_GROUPS).astype(F32))
    y = rmsnorm(y, norm_g.reshape(SSM_GROUPS, SSM_WIDTH // SSM_GROUPS))
    return y.reshape(bsz, s, SSM_WIDTH).astype(xbc.dtype)


def alibi_slopes(n_heads):
    return jnp.exp2(-ALIBI_MAX_BIAS * (jnp.arange(n_heads, dtype=F32) + 1.0) / n_heads)


def dilated_window_attention(q, k, v, slopes, window, dil):
    bsz, s, hg, e = q.shape
    sub_len = s // dil
    w_sub = window // dil
    c = ATTN_BLOCK
    nb = -(-sub_len // c)
    lp = nb * c

    def to_sub(t):
        return t.reshape(bsz, sub_len, dil, hg, e).transpose(0, 2, 3, 1, 4)

    qs, ks, vs = to_sub(q), to_sub(k), to_sub(v)
    qb = jnp.pad(qs, ((0, 0), (0, 0), (0, 0), (0, lp - sub_len), (0, 0))).reshape(bsz, dil, hg, nb, c, e)

    def band(t):
        tp = jnp.pad(t, ((0, 0), (0, 0), (0, 0), (c, lp - sub_len), (0, 0))).reshape(bsz, dil, hg, nb + 1, c, e)
        return jnp.concatenate([tp[:, :, :, :-1], tp[:, :, :, 1:]], axis=-2)

    kb, vb = band(ks), band(vs)
    scores = jnp.einsum('bdhnqe,bdhnke->bdhnqk', qb, kb).astype(F32) * e ** -0.5
    qpos = jnp.arange(c)[:, None]
    kpos = jnp.arange(2 * c)[None, :]
    delta = c + qpos - kpos
    key_idx = (jnp.arange(nb)[:, None, None] - 1) * c + kpos[None]
    valid = (delta >= 0) & (delta <= w_sub) & (key_idx >= 0)
    bias = -slopes.astype(F32)[:, None, None] * (delta * dil).astype(F32)
    scores = jnp.where(valid, scores + bias[:, None], -jnp.inf)
    m = jnp.max(scores, axis=-1, keepdims=True)
    ex = jnp.exp(scores - m)
    den = jnp.sum(ex, axis=-1, keepdims=True)
    o = jnp.einsum('bdhnqk,bdhnke->bdhnqe', (ex / den).astype(v.dtype), vb)
    lse = (m + jnp.log(den))[..., 0]
    o = o.reshape(bsz, dil, hg, lp, e)[:, :, :, :sub_len].transpose(0, 3, 1, 2, 4).reshape(bsz, s, hg, e)
    lse = lse.reshape(bsz, dil, hg, lp)[..., :sub_len].transpose(0, 3, 1, 2).reshape(bsz, s, hg)
    return o, lse


def dilated_attention(qkv):
    bsz, s, _ = qkv.shape
    qkv = qkv.reshape(bsz, s, 3, ATTN_HEADS, ATTN_HEAD_DIM)
    q, k, v = qkv[:, :, 0], qkv[:, :, 1], qkv[:, :, 2]
    slopes = alibi_slopes(ATTN_HEADS)
    outs, lses = [], []
    for gi, (window, dil) in enumerate(DILATION_GROUPS):
        hs = slice(gi * ATTN_GROUP_HEADS, (gi + 1) * ATTN_GROUP_HEADS)
        o, lse = dilated_window_attention(q[:, :, hs], k[:, :, hs], v[:, :, hs], slopes[hs], window, dil)
        outs.append(o)
        lses.append(lse)
    wts = jax.nn.softmax(jnp.stack(lses, axis=0), axis=0)
    o = jnp.sum(wts[..., None] * jnp.stack(outs, axis=0).astype(F32), axis=0)
    return o.reshape(bsz, s, ATTN_OUT_WIDTH).astype(qkv.dtype)


def hybrid_mixer(h, w_in, dn_conv, dn_a_log, dn_dt_bias, dn_norm, ssm_conv, ssm_conv_b, ssm_a_log, ssm_dt_bias, ssm_d, ssm_norm, w_br_dn, w_br_ssm, w_br_attn, w_out):
    cuts = np.cumsum(IN_SPLIT_SIZES)[:-1].tolist()
    dn_qkv, dn_z, dn_a, dn_b, ssm_xbc, ssm_z, ssm_dt, attn_qkv, gate_logits = jnp.split(h @ w_in, cuts, axis=-1)
    y_dn = gated_deltanet(dn_qkv, dn_z, dn_a, dn_b, dn_conv, dn_a_log, dn_dt_bias, dn_norm)
    y_ssm = mamba2_ssd(ssm_xbc, ssm_z, ssm_dt, ssm_conv, ssm_conv_b, ssm_a_log, ssm_dt_bias, ssm_d, ssm_norm)
    y_attn = dilated_attention(attn_qkv)
    g_dn, g_ssm, g_attn = jnp.split(jax.nn.sigmoid(gate_logits), N_BRANCHES, axis=-1)
    merged = g_dn * (y_dn @ w_br_dn) + g_ssm * (y_ssm @ w_br_ssm) + g_attn * (y_attn @ w_br_attn)
    return merged @ w_out


def moe_swiglu(h, w_router, w_gate, w_up, w_down):
    logits = (h @ w_router).astype(F32)
    top_vals, top_idx = lax.top_k(logits, TOP_K)
    top_w = jax.nn.softmax(top_vals, axis=-1)
    gates = jnp.sum(jax.nn.one_hot(top_idx, N_EXPERTS, dtype=F32) * top_w[..., None], axis=-2).astype(h.dtype)
    out = gates[..., 0:1] * swiglu(h, w_gate[0], w_up[0], w_down[0])
    for e in range(1, N_EXPERTS):
        out = out + gates[..., e:e + 1] * swiglu(h, w_gate[e], w_up[e], w_down[e])
    return out


def setup_inputs(seed: int = 0) -> dict:
    key = jax.random.key(seed)
    keys = list(jax.random.split(key, 40))
    n_dense = (DEPTH + 1) // 2
    n_moe = DEPTH // 2

    def nxt():
        return keys.pop()

    def nrm(shape, fan_in):
        return jax.random.normal(nxt(), shape, F32) * fan_in ** -0.5

    def gain(shape):
        return 1.0 + 0.1 * jax.random.normal(nxt(), shape, F32)

    def log_a(shape):
        return jnp.log(jax.random.uniform(nxt(), shape, F32, 1.0, 16.0))

    def dt_bias(shape):
        dt = jnp.exp(jax.random.uniform(nxt(), shape, F32, math.log(1e-3), math.log(1e-1)))
        return dt + jnp.log(-jnp.expm1(-dt))

    return {
        'x': jax.random.normal(nxt(), (BATCH, SEQ, D_MODEL), F32),
        'p': jax.random.normal(nxt(), (DEPTH, BATCH, SEQ, PLE_DIM), F32),
        'mix_norm': gain((DEPTH, D_MODEL)),
        'w_in': nrm((DEPTH, D_MODEL, IN_WIDTH), D_MODEL),
        'dn_conv': nrm((DEPTH, CONV_WIDTH, 3 * DN_WIDTH), CONV_WIDTH),
        'dn_a_log': log_a((DEPTH, DN_HEADS)),
        'dn_dt_bias': dt_bias((DEPTH, DN_HEADS)),
        'dn_norm': gain((DEPTH, DN_HEAD_DIM)),
        'ssm_conv': nrm((DEPTH, CONV_WIDTH, SSM_XBC), CONV_WIDTH),
        'ssm_conv_b': 0.01 * jax.random.normal(nxt(), (DEPTH, SSM_XBC), F32),
        'ssm_a_log': log_a((DEPTH, SSM_HEADS)),
        'ssm_dt_bias': dt_bias((DEPTH, SSM_HEADS)),
        'ssm_d': gain((DEPTH, SSM_HEADS)),
        'ssm_norm': gain((DEPTH, SSM_WIDTH)),
        'w_br_dn': nrm((DEPTH, DN_WIDTH, D_MODEL), DN_WIDTH),
        'w_br_ssm': nrm((DEPTH, SSM_WIDTH, D_MODEL), SSM_WIDTH),
        'w_br_attn': nrm((DEPTH, ATTN_OUT_WIDTH, D_MODEL), ATTN_OUT_WIDTH),
        'w_out': nrm((DEPTH, D_MODEL, D_MODEL), D_MODEL),
        'ffn_norm': gain((DEPTH, D_MODEL)),
        'w_ff_gate': nrm((n_dense, D_MODEL, FFN_DIM), D_MODEL),
        'w_ff_up': nrm((n_dense, D_MODEL, FFN_DIM), D_MODEL),
        'w_ff_down': nrm((n_dense, FFN_DIM, D_MODEL), FFN_DIM),
        'w_router': nrm((n_moe, D_MODEL, N_EXPERTS), D_MODEL),
        'w_moe_gate': nrm((n_moe, N_EXPERTS, D_MODEL, EXPERT_DIM), D_MODEL),
        'w_moe_up': nrm((n_moe, N_EXPERTS, D_MODEL, EXPERT_DIM), D_MODEL),
        'w_moe_down': nrm((n_moe, N_EXPERTS, EXPERT_DIM, D_MODEL), EXPERT_DIM),
        'ple_norm': gain((DEPTH, D_MODEL)),
        'w_ple': nrm((DEPTH, PLE_DIM, D_MODEL), PLE_DIM),
        'w_ple_gate': nrm((DEPTH, D_MODEL, D_MODEL), D_MODEL),
        'final_norm': gain((D_MODEL,)),
    }


def reference(x, p, mix_norm, w_in, dn_conv, dn_a_log, dn_dt_bias, dn_norm, ssm_conv, ssm_conv_b, ssm_a_log, ssm_dt_bias, ssm_d, ssm_norm, w_br_dn, w_br_ssm, w_br_attn, w_out, ffn_norm, w_ff_gate, w_ff_up, w_ff_down, w_router, w_moe_gate, w_moe_up, w_moe_down, ple_norm, w_ple, w_ple_gate, final_norm):
    for i in range(DEPTH):
        h = rmsnorm(x, mix_norm[i])
        x = x + hybrid_mixer(h, w_in[i], dn_conv[i], dn_a_log[i], dn_dt_bias[i], dn_norm[i], ssm_conv[i], ssm_conv_b[i], ssm_a_log[i], ssm_dt_bias[i], ssm_d[i], ssm_norm[i], w_br_dn[i], w_br_ssm[i], w_br_attn[i], w_out[i])
        h = rmsnorm(x, ffn_norm[i])
        j = i // 2
        if i % 2 == 0:
            x = x + swiglu(h, w_ff_gate[j], w_ff_up[j], w_ff_down[j])
        else:
            x = x + moe_swiglu(h, w_router[j], w_moe_gate[j], w_moe_up[j], w_moe_down[j])
        ple_gate = jax.nn.sigmoid(rmsnorm(x, ple_norm[i]) @ w_ple_gate[i])
        x = x + (p[i] @ w_ple[i]) * ple_gate
    return rmsnorm(x, final_norm)
```

```cpp
#include <hip/hip_runtime.h>
#include <cstdio>
#include <cstdint>

#define GAS __attribute__((address_space(1)))
#define LAS __attribute__((address_space(3)))
typedef unsigned short bf16_t;
typedef short bf16x8 __attribute__((ext_vector_type(8)));
typedef float f32x4 __attribute__((ext_vector_type(4)));
typedef float f32x2 __attribute__((ext_vector_type(2)));
typedef unsigned u32x4 __attribute__((ext_vector_type(4)));
typedef unsigned u32x2 __attribute__((ext_vector_type(2)));

#ifndef REP_PH
#define REP_PH -1
#endif
#ifndef EMU_FP8
#define EMU_FP8 0
#endif
#ifndef MIX2_PROBE
#define MIX2_PROBE 0
#endif
#ifndef DBG_ABL
#define DBG_ABL 0
#endif
#ifndef ONE_LAUNCH
#define ONE_LAUNCH 1
#endif

constexpr int D = 1024, BATCH = 32, SEQ = 2048, DEPTH = 2;
constexpr int PLE = 256;
constexpr float EPS = 1e-6f;
constexpr int FFN = 2816, NE = 8, EXD = 3584;
constexpr int C_DNZ = 2304, C_DNA = 3072, C_DNB = 3078, C_XBC = 3084, C_SSZ = 4364, C_SSDT = 5132, C_ATT = 5144, C_GATE = 7448, INW = 10520;
constexpr int NB = 8, TC = NB * SEQ, NCH = BATCH / NB;
constexpr int INP = 10752;
constexpr int MOE_SLOTS = 2 * TC + NE * 256;

constexpr size_t MiB = 1u << 20;
constexpr size_t WS_CTL = 0;
constexpr size_t WS_WIN = 1 * MiB;
constexpr size_t WS_WDN = WS_WIN + 42 * MiB;
constexpr size_t WS_WSSM = WS_WDN + 3 * MiB;
constexpr size_t WS_WATT = WS_WSSM + 3 * MiB;
constexpr size_t WS_WOUT = WS_WATT + 1 * MiB;
constexpr size_t WS_WFGU = WS_WOUT + 4 * MiB;
constexpr size_t WS_WFD = WS_WFGU + 11 * MiB;
constexpr size_t WS_WMGU = WS_WFD + 6 * MiB;
constexpr size_t WS_WMD = WS_WMGU + 112 * MiB;
constexpr size_t WS_WPG = WS_WMD + 56 * MiB;
constexpr size_t WS_WPLE = WS_WPG + 4 * MiB;
constexpr size_t WS_WR = WS_WPLE + 1 * MiB;
constexpr size_t WS_ACT0 = WS_WR + 1 * MiB;
constexpr size_t WS_XB = WS_ACT0;
constexpr size_t WS_SSQ = WS_XB + 32 * MiB;
constexpr size_t WS_PB = WS_SSQ + 1 * MiB;
constexpr size_t WS_ROUTE = WS_PB + 16 * MiB;
constexpr size_t WS_PART = WS_ROUTE + 1 * MiB;
constexpr size_t WS_PP = WS_PART;
constexpr size_t WS_MERGED = WS_PART + 64 * MiB;
constexpr size_t WS_Y = WS_MERGED + 32 * MiB;
constexpr size_t WS_YDN = WS_Y, WS_YSSM = WS_Y + 24 * MiB, WS_YATT = WS_Y + 48 * MiB, WS_OG = WS_Y + 56 * MiB, WS_LSE = WS_Y + 80 * MiB;
constexpr size_t WS_YPAIR = WS_Y;
constexpr size_t WS_PROJ = WS_Y + 81 * MiB;
constexpr size_t WS_PDN = WS_PROJ, WS_PSSM = WS_PDN + 96 * MiB, WS_SMALL = WS_PSSM + 64 * MiB, WS_QK = WS_SMALL + 2 * MiB, WS_VT = WS_QK + 48 * MiB, WS_GATES = WS_VT + 24 * MiB;
constexpr size_t WS_ACT = WS_PROJ, WS_ACTM = WS_PROJ;
constexpr int KSPL = 7, TAILMAX = 32;
constexpr size_t WS_PARTK = WS_PROJ + 256 * MiB;
static_assert((size_t)MOE_SLOTS * EXD * 2 <= 256 * MiB && WS_PARTK + (size_t)KSPL * (TAILMAX / 4) * 256 * 1024 * 4 <= WS_PROJ + 330 * MiB, "partk");
constexpr size_t WS_SCR = WS_PROJ + 330 * MiB;
constexpr size_t WS_XB2 = WS_SCR;
constexpr size_t WS_SSQ2 = WS_XB2 + 32 * MiB;
constexpr size_t WS_PART2 = WS_XB2 + 40 * MiB;
constexpr int DNS_ITEM = 73728;
constexpr size_t WS_DNS = WS_SCR + 40 * MiB;
constexpr size_t WS_DNEGL = WS_DNS + (size_t)NB * 32 * 6 * DNS_ITEM;
constexpr size_t WS_END = WS_SCR + 200 * MiB;
constexpr size_t WS_SSCD = WS_DNEGL + 8192;
static_assert(WS_SSCD + 16384 <= WS_END, "dn scratch");
constexpr size_t WS_SSPV = WS_SCR + 150 * MiB;
static_assert(WS_SSCD + 16384 <= WS_SSPV && WS_SSPV + 48 * MiB <= WS_END, "ssd prev");
constexpr size_t WS_SSST = WS_PART + 48 * MiB;
static_assert(WS_MERGED == WS_PART + 64 * MiB && (size_t)NB * 32 * 12 * 8192 * 2 <= 48 * MiB, "ssd states (bf16) sit in PART[48, 64) | MERGED, both idle during the mixers");
static_assert((size_t)MOE_SLOTS * EXD * 2 <= 330 * MiB, "moe act overlay");
static_assert((size_t)MOE_SLOTS * D * 2 <= 81 * MiB, "ypair overlay");
static_assert(WS_END <= 1024 * MiB, "workspace");
constexpr int RT_TOPE = 0, RT_TOPP = 2 * TC, RT_TOPW = 4 * TC, RT_TOPS = 6 * TC, RT_IDX = 8 * TC;
static_assert((size_t)(RT_IDX + MOE_SLOTS) * 4 <= MiB, "route");
constexpr int CW_BAR = 4096;
constexpr int CW_BAR2 = 8192;
constexpr int CW_SUB = 20480;
constexpr int CW_CNT = 16384;

constexpr int LDS_BYTES = 147456;
__device__ __forceinline__ int htid() { int t = threadIdx.x; asm volatile("" : "+v"(t)); return t; }
__device__ __forceinline__ float bf2f(bf16_t b) { return __uint_as_float(((unsigned)b) << 16); }
__device__ __forceinline__ unsigned f2bf(float f) { unsigned u = __float_as_uint(f); return (u + 0x7fffu + ((u >> 16) & 1u)) >> 16; }
typedef __bf16 bf16x2_t __attribute__((ext_vector_type(2)));
__device__ __forceinline__ unsigned pk2(float lo, float hi) { const f32x2 v = {lo, hi}; return __builtin_bit_cast(unsigned, __builtin_convertvector(v, bf16x2_t)); }
#define ST2_BF(PA, PB, A, B) do { const unsigned pw_ = pk2((A), (B)); *(PA) = (bf16_t)(pw_ & 0xffffu); *(PB) = (bf16_t)(pw_ >> 16); } while (0)
__device__ __forceinline__ float lo_bf(unsigned w) { return __uint_as_float(w << 16); }
__device__ __forceinline__ float hi_bf(unsigned w) { return __uint_as_float(w & 0xffff0000u); }
__device__ __forceinline__ float fexp(float x) { return __builtin_amdgcn_exp2f(x * 1.4426950408889634f); }
__device__ __forceinline__ float sigmoidf_(float x) { return __builtin_amdgcn_rcpf(1.f + fexp(-x)); }
__device__ __forceinline__ float siluf_(float x) { return x * sigmoidf_(x); }
__device__ __forceinline__ float softplusf_(float x) { const float e = fexp(x); return x > 20.f ? x : (x < -9.f ? e : __builtin_amdgcn_logf(1.f + e) * 0.6931471805599453f); }
__device__ __forceinline__ float q8(float v) {
    if (!EMU_FP8) return v;
    const float a = fabsf(v); float r;
    if (a < 0.015625f) r = rintf(a * 512.f) * (1.f / 512.f);
    else { unsigned u = __float_as_uint(a); u += 0x7FFFFu + ((u >> 20) & 1u); u &= ~0xFFFFFu; r = fminf(__uint_as_float(u), 448.f); }
    return copysignf(r, v);
}
__device__ __forceinline__ f32x4 q8v(f32x4 v) { return (f32x4){q8(v[0]), q8(v[1]), q8(v[2]), q8(v[3])}; }
__device__ __forceinline__ float wave_sum(float v) {
#pragma unroll
    for (int o = 1; o < 64; o <<= 1) v += __shfl_xor(v, o);
    return v;
}
__device__ __forceinline__ float wave_max(float v) {
#pragma unroll
    for (int o = 1; o < 64; o <<= 1) v = fmaxf(v, __shfl_xor(v, o));
    return v;
}
__device__ __forceinline__ float rstd_of(const float* ssq, int row) {
    const f32x4* p = (const f32x4*)(ssq + (size_t)row * 16);
    const f32x4 a = p[0], b = p[1], c = p[2], d = p[3];
    const float s = (((a.x + a.y) + (a.z + a.w)) + ((b.x + b.y) + (b.z + b.w))) + (((c.x + c.y) + (c.z + c.w)) + ((d.x + d.y) + (d.z + d.w)));
    return rsqrtf(s * (1.f / 1024.f) + EPS);
}
__device__ __forceinline__ int token_of_pos(int d, int p) {
    const int b = p >> 11, q = p & 2047;
    const int t = (d == 1) ? q : (d == 4) ? (4 * (q & 511) + (q >> 9)) : (16 * (q & 127) + (q >> 7));
    return b * 2048 + t;
}

#define XB_TMO      128
#define XB_XCNT(j)  (256  + 64 * (j))
#define XB_XSUB(j)  (1280 + 64 * (j))
#define XB_XGEN(j)  (2304 + 64 * (j))
#define XB_TOP      3328
#define XB_TOPGEN   3392
#define XCD_BAR_WORDS 3456
#define XB_SPIN_CAP (1u << 22)
__device__ __forceinline__ unsigned xb_ld(unsigned* p)              { return __hip_atomic_load(p, __ATOMIC_RELAXED, __HIP_MEMORY_SCOPE_AGENT); }
__device__ __forceinline__ unsigned xb_add(unsigned* p, unsigned v) { return __hip_atomic_fetch_add(p, v, __ATOMIC_RELAXED, __HIP_MEMORY_SCOPE_AGENT); }
__device__ __forceinline__ unsigned xb_xcc_id() { return (unsigned)__builtin_amdgcn_s_getreg((3 << 11) | 20) & 0xFu; }
#define XB_SPIN(cond, bar) do { unsigned _sp = 0; while (cond) { __builtin_amdgcn_s_sleep(1); \
    if ((++_sp & 255u) == 0u) { if (xb_ld(&(bar)[XB_TMO])) break; if (_sp > XB_SPIN_CAP) { atomicAdd(&(bar)[XB_TMO], 1u); break; } } } } while (0)
struct XcdBarrier { unsigned* bar; unsigned x; volatile LAS unsigned* st; };
__device__ __forceinline__ XcdBarrier xcd_barrier_post(unsigned* bar, volatile LAS unsigned* st) {
    XcdBarrier b; b.bar = bar; b.x = xb_xcc_id(); b.st = st;
    if (threadIdx.x == 0) (void)xb_add(&bar[XB_XCNT(b.x)], 1u);
    return b;
}
__device__ __forceinline__ void xcd_barrier_complete(unsigned* bar, unsigned x, unsigned& nloc, unsigned& nx, unsigned G) {
    unsigned sum, cnt, mine, sp = 0u;
    for (;;) {
        sum = 0u; cnt = 0u; mine = 0u;
#pragma unroll
        for (unsigned j = 0; j < 16; ++j) { const unsigned c = xb_ld(&bar[XB_XCNT(j)]); sum += c; cnt += (c > 0u) ? 1u : 0u; }
        mine = xb_ld(&bar[XB_XCNT(x)]);
        if (sum == G) break;
        __builtin_amdgcn_s_sleep(1);
        if ((++sp & 255u) == 0u) { if (xb_ld(&bar[XB_TMO])) break; if (sp > XB_SPIN_CAP) { atomicAdd(&bar[XB_TMO], 1u); break; } }
    }
    nloc = mine > 0u ? mine : 1u; nx = cnt > 0u ? cnt : 1u;
}
__device__ __forceinline__ void xcd_barrier(const XcdBarrier& b, unsigned nparts = 0u) {
    asm volatile("s_waitcnt vmcnt(0)" ::: "memory");
    __syncthreads();
    if (threadIdx.x == 0) {
        unsigned* bar = b.bar;
        __builtin_amdgcn_s_waitcnt(0);
        unsigned nloc = b.st[0], nx = b.st[1];
        if (nloc == 0u) { xcd_barrier_complete(bar, b.x, nloc, nx, nparts ? nparts : gridDim.x * gridDim.y * gridDim.z); b.st[0] = nloc; b.st[1] = nx; }
        const unsigned old = xb_add(&bar[XB_XSUB(b.x)], 1u);
        const unsigned gen = old / nloc;
        if (old + 1u == (gen + 1u) * nloc) {
            __builtin_amdgcn_fence(__ATOMIC_RELEASE, "agent");
            asm volatile("s_waitcnt vmcnt(0)" ::: "memory");
            const unsigned og = xb_add(&bar[XB_TOP], 1u);
            const unsigned tg = og / nx;
            if (og + 1u == (tg + 1u) * nx) xb_add(&bar[XB_TOPGEN], 1u);
            else XB_SPIN(xb_ld(&bar[XB_TOPGEN]) == tg, bar);
            __builtin_amdgcn_fence(__ATOMIC_ACQUIRE, "agent");
            xb_add(&bar[XB_XGEN(b.x)], 1u);
            asm volatile("s_waitcnt vmcnt(0)" ::: "memory");
        } else {
            XB_SPIN(xb_ld(&bar[XB_XGEN(b.x)]) == gen, bar);
            __builtin_amdgcn_fence(__ATOMIC_ACQUIRE, "agent");
            asm volatile("s_waitcnt vmcnt(0)" ::: "memory");
        }
    }
    __syncthreads();
}

constexpr int BM = 256, BK = 64, HALF = 128, HTB = HALF * BK * 2, STAGE_BYTES = 8 * HTB, NXCD = 8, WGM = 4;
__device__ __forceinline__ int lds_byte(int r, int c) { const int st = (r >> 4) * 2 + (c >> 5), rr = r & 15, cc = c & 31, ob = rr * 64 + cc * 2; return st * 1024 + (ob ^ (((ob >> 9) & 1) << 5)); }
__device__ __forceinline__ void stage_rc(int b, int& R, int& C) { const int st = b / 1024, sb = b % 1024, swz = sb ^ (((sb >> 9) & 1) << 5); R = (st >> 1) * 16 + swz / 64; C = (st & 1) * 32 + (swz % 64) / 2; }
__device__ __forceinline__ int perm32(int rho) { const int n = rho >> 4, i = rho & 15; return 8 * (i >> 2) + 4 * n + (i & 3); }

struct Unit { int pm, pn; };
struct StaticOrder {
    int nM, nN, nwg, G, c;
    __device__ __forceinline__ void init(int nM_, int nN_, int G_, int c_) { nM = nM_; nN = nN_; nwg = nM * nN; G = G_; c = c_; }
    __device__ __forceinline__ bool next(int i, Unit& u) const {
        const long L = (long)i * G + c; if (L >= nwg) return false;
        int wgid = (int)L; { const int q = nwg / NXCD, r = nwg % NXCD, xcd = wgid % NXCD, off = wgid / NXCD; wgid = (xcd < r ? xcd * (q + 1) : r * (q + 1) + (xcd - r) * q) + off; }
        const int nig = WGM * nN, gid = wgid / nig, fm = gid * WGM, gsz = (nM - fm) < WGM ? (nM - fm) : WGM;
        u.pm = fm + ((wgid % nig) % gsz); u.pn = (wgid % nig) / gsz; return true;
    }
};
struct GU { const char* A; const char* B; int lda, ldb, nt, mapA, mapB; const int* idx; int pm, pn, sub, aux; };
__device__ __forceinline__ unsigned row_off(int map, int RR, int ld, const int* idx) {
    int row;
    if (map == 0) row = RR;
    else if (map == 4) row = 4 * RR;
    else if (map == 16) row = 16 * (RR & 127) + (RR >> 7);
    else row = idx[RR];
    return (unsigned)row * (unsigned)ld;
}
template <class Prog>
__device__ __forceinline__ void gemm_phase(LAS unsigned char* lds, const Prog& P) {
    const int tid = htid(), wid = __builtin_amdgcn_readfirstlane(tid >> 6), lane = tid & 63, wr = wid >> 2, wc = wid & 3, fr = lane & 15, fq = lane >> 4;
    GU cur, nxt; int ui = 0;
    if (!P.unit(0, cur)) return;
    unsigned vA[4], vB[4];
#define G_SETV(u) do { int tz_ = threadIdx.x; asm volatile("" : "+v"(tz_)); int R0, C0, R1, C1; stage_rc(tz_ * 16, R0, C0); stage_rc(tz_ * 16 + 8192, R1, C1); \
        const int Rb0 = (R0 & ~31) + perm32(R0 & 31), Rb1 = (R1 & ~31) + perm32(R1 & 31); \
        vA[0] = row_off((u).mapA, R0, (u).lda, (u).idx) + C0 * 2; vA[1] = row_off((u).mapA, R1, (u).lda, (u).idx) + C1 * 2; \
        vA[2] = row_off((u).mapA, R0 + 128, (u).lda, (u).idx) + C0 * 2; vA[3] = row_off((u).mapA, R1 + 128, (u).lda, (u).idx) + C1 * 2; \
        vB[0] = row_off((u).mapB, Rb0, (u).ldb, nullptr) + C0 * 2; vB[1] = row_off((u).mapB, Rb1, (u).ldb, nullptr) + C1 * 2; \
        vB[2] = row_off((u).mapB, Rb0 + 128, (u).ldb, nullptr) + C0 * 2; vB[3] = row_off((u).mapB, Rb1 + 128, (u).ldb, nullptr) + C1 * 2; } while (0)
    G_SETV(cur);
    const unsigned ldsw = (unsigned)wid * 1024u;
    const int aoff = lds_byte(wr * 64 + fr, fq * 8), boff = lds_byte(wc * 32 + fr, fq * 8);
#define G_SA(b, h) (((b) * 2 + (h)) * HTB)
#define G_SB(b, h) ((4 + (b) * 2 + (h)) * HTB)
#define G_STAGE(bufoff, gbase, v, h) do { \
        __builtin_amdgcn_global_load_lds((const unsigned*)((gbase) + (v)[2 * (h)]), (LAS unsigned*)(lds + (bufoff) + ldsw), 16, 0, 0); \
        __builtin_amdgcn_global_load_lds((const unsigned*)((gbase) + (v)[2 * (h) + 1]), (LAS unsigned*)(lds + (bufoff) + ldsw + 8192), 16, 0, 0); } while (0)
#define G_LDA(dst, b, h) do { _Pragma("unroll") for (int m = 0; m < 4; ++m) _Pragma("unroll") for (int k = 0; k < 2; ++k) dst[m][k] = *(const LAS bf16x8*)(lds + G_SA(b, h) + aoff + m * 2048 + k * 1024); } while (0)
#define G_LDB(dst, b, h) do { _Pragma("unroll") for (int n = 0; n < 2; ++n) _Pragma("unroll") for (int k = 0; k < 2; ++k) dst[n][k] = *(const LAS bf16x8*)(lds + G_SB(b, h) + boff + n * 2048 + k * 1024); } while (0)
#define G_MMA(ai, bj, At, Bt) do { __builtin_amdgcn_s_setprio(1); _Pragma("unroll") for (int m = 0; m < 4; ++m) _Pragma("unroll") for (int n = 0; n < 2; ++n) _Pragma("unroll") for (int k = 0; k < 2; ++k) \
        acc[ai][bj][m][n] = __builtin_amdgcn_mfma_f32_16x16x32_bf16(Bt[n][k], At[m][k], acc[ai][bj][m][n], 0, 0, 0); __builtin_amdgcn_s_setprio(0); } while (0)
#define G_WAIT_V(n) asm volatile("s_waitcnt vmcnt(" #n ")" ::: "memory")
#define G_WAIT_L(n) asm volatile("s_waitcnt lgkmcnt(" #n ")" ::: "memory")
#define G_BAR __builtin_amdgcn_s_barrier()
#define G_SCHED __builtin_amdgcn_sched_barrier(0)
    f32x4 acc[2][2][4][2];
#pragma unroll
    for (int a = 0; a < 2; ++a)
#pragma unroll
        for (int b = 0; b < 2; ++b)
#pragma unroll
            for (int m = 0; m < 4; ++m)
#pragma unroll
                for (int n = 0; n < 2; ++n) acc[a][b][m][n] = (f32x4){0.f, 0.f, 0.f, 0.f};
    bf16x8 At[4][2], B0[2][2], B1[2][2];
    const char* cA = cur.A; const char* cB = cur.B;
    const size_t kstep = (size_t)(BK * 2);
    G_STAGE(G_SB(0, 0), cB, vB, 0); G_STAGE(G_SA(0, 0), cA, vA, 0); G_STAGE(G_SB(0, 1), cB, vB, 1); G_STAGE(G_SA(0, 1), cA, vA, 1);
    if (wr == 1) G_BAR;
    G_WAIT_V(4); G_BAR;
    G_STAGE(G_SB(1, 0), cB + kstep, vB, 0); G_STAGE(G_SA(1, 0), cA + kstep, vA, 0); G_STAGE(G_SB(1, 1), cB + kstep, vB, 1);
    G_WAIT_V(6); G_BAR;
    for (;;) {
        const bool has_next = P.unit(ui + 1, nxt);
        const char* nA = has_next ? nxt.A : cA; const char* nB = has_next ? nxt.B : cB;
        const int nt = cur.nt;
        for (int t = 0; t < nt; t += 2) {
            const bool last = (t == nt - 2);
            const char* a1 = cA + (size_t)(t + 1) * kstep;
            const char* a2 = last ? nA : cA + (size_t)(t + 2) * kstep; const char* b2 = last ? nB : cB + (size_t)(t + 2) * kstep;
            const char* a3 = a2 + kstep; const char* b3 = b2 + kstep;
            G_STAGE(G_SA(1, 1), a1, vA, 1);
            if (last && has_next) { G_SETV(nxt); }
            G_LDB(B0, 0, 0); G_SCHED; G_LDA(At, 0, 0);
            G_WAIT_L(8); G_BAR; G_WAIT_L(0); G_MMA(0, 0, At, B0); G_BAR; G_SCHED;
            G_LDB(B1, 0, 1); G_STAGE(G_SB(0, 0), b2, vB, 0);
            G_BAR; G_WAIT_L(0); G_MMA(0, 1, At, B1); G_BAR;
            G_LDA(At, 0, 1); G_STAGE(G_SA(0, 0), a2, vA, 0);
            G_BAR; G_WAIT_L(0); G_MMA(1, 0, At, B0); G_BAR; G_SCHED;
            G_STAGE(G_SB(0, 1), b2, vB, 1);
            G_WAIT_V(6); G_BAR; G_MMA(1, 1, At, B1); G_BAR;
            G_LDB(B0, 1, 0); G_SCHED; G_LDA(At, 1, 0); G_STAGE(G_SA(0, 1), a2, vA, 1);
            G_WAIT_L(8); G_BAR; G_WAIT_L(0); G_MMA(0, 0, At, B0); G_BAR; G_SCHED;
            G_LDB(B1, 1, 1); G_STAGE(G_SB(1, 0), b3, vB, 0);
            G_BAR; G_WAIT_L(0); G_MMA(0, 1, At, B1); G_BAR;
            G_LDA(At, 1, 1); G_STAGE(G_SA(1, 0), a3, vA, 0);
            G_BAR; G_WAIT_L(0); G_MMA(1, 0, At, B0); G_BAR; G_SCHED;
            G_STAGE(G_SB(1, 1), b3, vB, 1);
            G_WAIT_V(6); G_BAR; G_MMA(1, 1, At, B1); G_BAR;
        }
        { int tz_ = threadIdx.x; asm volatile("" : "+v"(tz_)); const int ln_ = tz_ & 63; P.epi(acc, cur, wr, wc, ln_ & 15, ln_ >> 4); }
        if (!has_next) break;
        if (!P.keep(cur))
#pragma unroll
        for (int a = 0; a < 2; ++a)
#pragma unroll
            for (int b = 0; b < 2; ++b)
#pragma unroll
                for (int m = 0; m < 4; ++m)
#pragma unroll
                    for (int n = 0; n < 2; ++n) acc[a][b][m][n] = (f32x4){0.f, 0.f, 0.f, 0.f};
        cur = nxt; cA = nA; cB = nB; ++ui;
    }
    G_WAIT_V(0);
    if (wr == 0) G_BAR;
    G_BAR;
#undef G_SETV
#undef G_SA
#undef G_SB
#undef G_STAGE
#undef G_LDA
#undef G_LDB
#undef G_MMA
#undef G_WAIT_V
#undef G_WAIT_L
#undef G_BAR
#undef G_SCHED
}

__device__ __forceinline__ void st_bf8(bf16_t* p, const f32x4 a, const f32x4 b) {
    u32x4 w; w.x = pk2(a[0], a[1]); w.y = pk2(a[2], a[3]); w.z = pk2(b[0], b[1]); w.w = pk2(b[2], b[3]);
    *(u32x4*)p = w;
}
__device__ __forceinline__ void ld_bf8(const bf16_t* p, f32x4& a, f32x4& b) {
    const u32x4 w = *(const u32x4*)p;
    a = (f32x4){lo_bf(w.x), hi_bf(w.x), lo_bf(w.y), hi_bf(w.y)}; b = (f32x4){lo_bf(w.z), hi_bf(w.z), lo_bf(w.w), hi_bf(w.w)};
}
__device__ __forceinline__ float sq8(const f32x4 a, const f32x4 b) { return ((a[0] * a[0] + a[1] * a[1]) + (a[2] * a[2] + a[3] * a[3])) + ((b[0] * b[0] + b[1] * b[1]) + (b[2] * b[2] + b[3] * b[3])); }

#define EPI_ROWS(ai, m) _Pragma("unroll") for (int ai = 0; ai < 2; ++ai) _Pragma("unroll") for (int m = 0; m < 4; ++m)
#define EPI_FENCE asm volatile("" ::: "memory")
#define EPI_SC(ai, m) __shfl((ai) ? r1_ : r0_, (m) * 16 + fr)

struct ProgIn {
    __device__ __forceinline__ bool keep(const GU&) const { return false; }
    StaticOrder S; const bf16_t* xb; const bf16_t* Wt; const float* ssq; unsigned char* wsb;
    const bf16_t* pb; const bf16_t* wple;
    __device__ __forceinline__ bool unit(int i, GU& u) const {
        Unit t;
        if (!S.next(i, t)) {
            const int rem = S.nwg % S.G, nfull = S.nwg / S.G, idle = rem == 0 ? S.G : S.G - rem, per = (256 + idle - 1) / idle;
            const int rk = rem == 0 ? S.c : S.c - rem, k = i - nfull;
            if (rk < 0 || k < 0 || k >= per) return false;
            const int pu = rk * per + k; if (pu >= 256) return false;
            u.pm = pu >> 2; u.pn = 64 + (pu & 3); u.sub = 0; u.aux = 0; u.nt = 4; u.idx = nullptr; u.lda = 512; u.ldb = 512; u.mapA = 0; u.mapB = 0;
            u.A = (const char*)pb + (size_t)(pu >> 2) * 256 * 512; u.B = (const char*)wple + (size_t)(pu & 3) * 256 * 512; return true;
        }
        u.pm = t.pm; u.pn = t.pn; u.sub = 0; u.aux = 0; u.nt = 16; u.idx = nullptr; u.lda = 2048; u.ldb = 2048;
        const char* w = (const char*)Wt + (size_t)t.pn * 256 * 2048;
        int g = 0; bool isvt = false;
        if (t.pn >= 20 && t.pn < 29) { g = (t.pn - 20) % 3; isvt = t.pn >= 26; }
        const int d = g == 0 ? 1 : (g == 1 ? 4 : 16);
        const int b = t.pm >> 3, tb = t.pm & 7;
        const int base = b * 2048 + (d == 1 ? 256 * tb : d == 4 ? 1024 * (tb & 1) + (tb >> 1) : 2 * tb);
        const char* x = (const char*)xb + (size_t)base * 2048;
        const int mapx = d == 1 ? 0 : d;
        if (!isvt) { u.A = x; u.mapA = mapx; u.B = w; u.mapB = 0; }
        else { u.A = w; u.mapA = 0; u.B = x; u.mapB = mapx; }
        return true;
    }
    __device__ __forceinline__ void epi(f32x4 (&acc)[2][2][4][2], const GU& u, int wr, int wc, int fr, int fq) const {
        const int pn = u.pn, pm = u.pm, rl0 = wr * 64 + fr, cl0 = wc * 32 + 8 * fq;
        if (pn >= 64) {
            EPI_ROWS(ai, m) { bf16_t* o = (bf16_t*)(wsb + WS_PP) + (size_t)(pm * 256 + ai * 128 + m * 16 + rl0) * 1024 + (pn - 64) * 256 + cl0;
#pragma unroll
                for (int bj = 0; bj < 2; ++bj) st_bf8(o + bj * 128, acc[ai][bj][m][0], acc[ai][bj][m][1]); }
            return;
        }
        if (pn >= 26 && pn < 29) {
            const int g = pn - 26, d = g == 0 ? 1 : (g == 1 ? 4 : 16), ln = fq * 16 + fr;
            const float rc = rstd_of(ssq, token_of_pos(d, pm * 256 + (ln >> 5) * 128 + wc * 32 + (ln & 31)));
            f32x4 s[2][2];
#pragma unroll
            for (int bj = 0; bj < 2; ++bj)
#pragma unroll
                for (int j = 0; j < 8; ++j) s[bj][j >> 2][j & 3] = __shfl(rc, bj * 32 + 8 * fq + j);
            EPI_ROWS(ai, m) { const int ch = ai * 128 + m * 16 + rl0; bf16_t* o = (bf16_t*)(wsb + WS_VT) + (size_t)(g * 256 + ch) * TC + pm * 256 + cl0;
#pragma unroll
                for (int bj = 0; bj < 2; ++bj) st_bf8(o + bj * 128, acc[ai][bj][m][0] * s[bj][0], acc[ai][bj][m][1] * s[bj][1]); }
            return;
        }
        int d = 1; if (pn >= 20 && pn < 26) { const int g = (pn - 20) % 3; d = g == 0 ? 1 : (g == 1 ? 4 : 16); }
        const float r0_ = rstd_of(ssq, token_of_pos(d, pm * 256 + fq * 16 + rl0)), r1_ = rstd_of(ssq, token_of_pos(d, pm * 256 + 128 + fq * 16 + rl0));
        if (pn < 20) {
            bf16_t* base = pn < 12 ? (bf16_t*)(wsb + WS_PDN) + pn * 256 : (bf16_t*)(wsb + WS_PSSM) + (pn - 12) * 256; const int ld = pn < 12 ? 3072 : 2048;
            EPI_ROWS(ai, m) { const int row = pm * 256 + ai * 128 + m * 16 + rl0; const float s = EPI_SC(ai, m); bf16_t* o = base + (size_t)row * ld + cl0;
#pragma unroll
                for (int bj = 0; bj < 2; ++bj) st_bf8(o + bj * 128, acc[ai][bj][m][0] * s, acc[ai][bj][m][1] * s); }
        } else if (pn < 26) {
            const int which = (pn - 20) / 3, g = (pn - 20) % 3; const float qs = which == 0 ? 0.125f : 1.f;
            bf16_t* base = (bf16_t*)(wsb + WS_QK) + (size_t)(which * 3 + g) * TC * 256;
            EPI_ROWS(ai, m) { const int p = pm * 256 + ai * 128 + m * 16 + rl0; const float s = EPI_SC(ai, m) * qs; bf16_t* o = base + (size_t)p * 256 + cl0;
#pragma unroll
                for (int bj = 0; bj < 2; ++bj) st_bf8(o + bj * 128, acc[ai][bj][m][0] * s, acc[ai][bj][m][1] * s); }
        } else if (pn < 41) {
            bf16_t* base = (bf16_t*)(wsb + WS_GATES) + (pn - 29) * 256;
            EPI_ROWS(ai, m) { const int row = pm * 256 + ai * 128 + m * 16 + rl0; const float s = EPI_SC(ai, m); bf16_t* o = base + (size_t)row * 3072 + cl0;
#pragma unroll
                for (int bj = 0; bj < 2; ++bj) { f32x4 a = acc[ai][bj][m][0] * s, b = acc[ai][bj][m][1] * s;
#pragma unroll
                    for (int j = 0; j < 4; ++j) { a[j] = sigmoidf_(a[j]); b[j] = sigmoidf_(b[j]); }
                    st_bf8(o + bj * 128, a, b); } }
        } else {
            EPI_ROWS(ai, m) { const int row = pm * 256 + ai * 128 + m * 16 + rl0; const float s = EPI_SC(ai, m);
                if (wc == 0) { float* o = (float*)(wsb + WS_SMALL) + (size_t)row * 32 + 8 * fq; *(f32x4*)o = acc[ai][0][m][0] * s; *(f32x4*)(o + 4) = acc[ai][0][m][1] * s; } }
        }
    }
};

struct ProgMerge {
    StaticOrder S; const bf16_t *wdn, *wssm, *watt; unsigned char* wsb;
    __device__ __forceinline__ bool keep(const GU& u) const { return u.sub < 2; }
    __device__ __forceinline__ bool unit(int i, GU& u) const {
        Unit t; if (!S.next(i / 3, t)) return false;
        const int sub = i % 3;
        u.pm = t.pm; u.pn = t.pn; u.sub = sub; u.aux = 0; u.idx = nullptr; u.mapA = 0; u.mapB = 0;
        if (sub < 2) { u.lda = 1536; u.ldb = 1536; u.nt = 12; u.A = (const char*)(wsb + (sub == 0 ? WS_YDN : WS_YSSM)) + (size_t)t.pm * 256 * 1536; u.B = (const char*)(sub == 0 ? wdn : wssm) + (size_t)t.pn * 256 * 1536; }
        else { u.lda = 512; u.ldb = 512; u.nt = 4; u.A = (const char*)(wsb + WS_YATT) + (size_t)t.pm * 256 * 512; u.B = (const char*)watt + (size_t)t.pn * 256 * 512; }
        return true;
    }
    __device__ __forceinline__ void epi(f32x4 (&acc)[2][2][4][2], const GU& u, int wr, int wc, int fr, int fq) const {
        const int rl0 = wr * 64 + fr, cl0 = wc * 32 + 8 * fq, sub = u.sub;
        const bf16_t* gp0 = (const bf16_t*)(wsb + WS_GATES) + (size_t)(u.pm * 256 + rl0) * 3072 + u.pn * 256 + cl0 + sub * 1024;
#pragma unroll
        for (int ai = 0; ai < 2; ++ai) {
            u32x4 gw[4][2], hw[4][2];
            if (sub < 2) {
#pragma unroll
                for (int m = 0; m < 4; ++m)
#pragma unroll
                    for (int bj = 0; bj < 2; ++bj) { const bf16_t* gp = gp0 + (size_t)(ai * 128 + m * 16) * 3072 + bj * 128; gw[m][bj] = *(const u32x4*)gp; hw[m][bj] = *(const u32x4*)(gp + 1024); }
            } else {
#pragma unroll
                for (int m = 0; m < 4; ++m)
#pragma unroll
                    for (int bj = 0; bj < 2; ++bj) { const bf16_t* gp = gp0 + (size_t)(ai * 128 + m * 16) * 3072 + bj * 128; gw[m][bj] = *(const u32x4*)gp; hw[m][bj] = gw[m][bj]; }
            }
#pragma unroll
            for (int m = 0; m < 4; ++m)
#pragma unroll
                for (int bj = 0; bj < 2; ++bj) { const int row = u.pm * 256 + ai * 128 + m * 16 + rl0, col = u.pn * 256 + bj * 128 + cl0;
                    f32x4 g0 = (f32x4){lo_bf(gw[m][bj].x), hi_bf(gw[m][bj].x), lo_bf(gw[m][bj].y), hi_bf(gw[m][bj].y)}, g1 = (f32x4){lo_bf(gw[m][bj].z), hi_bf(gw[m][bj].z), lo_bf(gw[m][bj].w), hi_bf(gw[m][bj].w)};
                    if ((DBG_ABL >> sub) & 1) { acc[ai][bj][m][0] = (f32x4){0.f, 0.f, 0.f, 0.f}; acc[ai][bj][m][1] = acc[ai][bj][m][0]; }
#pragma unroll
                    for (int j = 0; j < 4; ++j) { g0[j] = fmaxf(g0[j], 1e-8f); g1[j] = fmaxf(g1[j], 1e-8f); }
                    if (sub < 2) { const f32x4 h0 = (f32x4){lo_bf(hw[m][bj].x), hi_bf(hw[m][bj].x), lo_bf(hw[m][bj].y), hi_bf(hw[m][bj].y)}, h1 = (f32x4){lo_bf(hw[m][bj].z), hi_bf(hw[m][bj].z), lo_bf(hw[m][bj].w), hi_bf(hw[m][bj].w)};
#pragma unroll
                        for (int j = 0; j < 4; ++j) { acc[ai][bj][m][0][j] *= g0[j] * __builtin_amdgcn_rcpf(fmaxf(h0[j], 1e-8f)); acc[ai][bj][m][1][j] *= g1[j] * __builtin_amdgcn_rcpf(fmaxf(h1[j], 1e-8f)); } }
                    else st_bf8((bf16_t*)(wsb + WS_MERGED) + (size_t)row * 1024 + col, acc[ai][bj][m][0] * g0, acc[ai][bj][m][1] * g1); }
            EPI_FENCE;
        }
    }
};

struct ProgResid {
    __device__ __forceinline__ bool keep(const GU&) const { return false; }
    StaticOrder S; const bf16_t* A; int lda, nt; const bf16_t* Wt; int ldb; const float* xin; float* xout; bf16_t* xb; float* ssq; float sc; int qx;
    __device__ __forceinline__ bool unit(int i, GU& u) const {
        Unit t; if (!S.next(i, t)) return false;
        u.pm = t.pm; u.pn = t.pn; u.sub = 0; u.aux = 0; u.idx = nullptr; u.mapA = 0; u.mapB = 0; u.lda = lda; u.ldb = ldb; u.nt = nt;
        u.A = (const char*)A + (size_t)t.pm * 256 * lda; u.B = (const char*)Wt + (size_t)t.pn * 256 * ldb; return true;
    }
    __device__ __forceinline__ void epi(f32x4 (&acc)[2][2][4][2], const GU& u, int wr, int wc, int fr, int fq) const {
        const int rl0 = wr * 64 + fr, cl0 = wc * 32 + 8 * fq;
#pragma unroll
        for (int ai = 0; ai < 2; ++ai) {
            f32x4 xv[4][2][2];
#pragma unroll
            for (int m = 0; m < 4; ++m)
#pragma unroll
                for (int bj = 0; bj < 2; ++bj) { const size_t o = (size_t)(u.pm * 256 + ai * 128 + m * 16 + rl0) * 1024 + u.pn * 256 + bj * 128 + cl0; xv[m][bj][0] = *(const f32x4*)(xin + o); xv[m][bj][1] = *(const f32x4*)(xin + o + 4); }
#pragma unroll
            for (int m = 0; m < 4; ++m) { const int row = u.pm * 256 + ai * 128 + m * 16 + rl0; float ss = 0.f;
#pragma unroll
                for (int bj = 0; bj < 2; ++bj) { const size_t o = (size_t)row * 1024 + u.pn * 256 + bj * 128 + cl0;
                    const f32x4 v0 = acc[ai][bj][m][0] * sc + xv[m][bj][0], v1 = acc[ai][bj][m][1] * sc + xv[m][bj][1];
                    *(f32x4*)(xout + o) = v0; *(f32x4*)(xout + o + 4) = v1; if (qx) st_bf8(xb + o, q8v(v0), q8v(v1)); else st_bf8(xb + o, v0, v1); ss += sq8(v0, v1); }
                ss += __shfl_xor(ss, 16); ss += __shfl_xor(ss, 32);
                if (fq == 0) ssq[(size_t)row * 16 + u.pn * 4 + wc] = ss; }
            EPI_FENCE;
        }
    }
};

struct ProgFfnGu {
    __device__ __forceinline__ bool keep(const GU&) const { return false; }
    StaticOrder S; const bf16_t* xb; const bf16_t* Wt; const float* ssq; bf16_t* act;
    __device__ __forceinline__ bool unit(int i, GU& u) const {
        Unit t; if (!S.next(i, t)) return false;
        u.pm = t.pm; u.pn = t.pn; u.sub = 0; u.aux = 0; u.idx = nullptr; u.mapA = 0; u.mapB = 0; u.lda = 2048; u.ldb = 2048; u.nt = 16;
        u.A = (const char*)xb + (size_t)t.pm * 256 * 2048; u.B = (const char*)Wt + (size_t)t.pn * 256 * 2048; return true;
    }
    __device__ __forceinline__ void epi(f32x4 (&acc)[2][2][4][2], const GU& u, int wr, int wc, int fr, int fq) const {
        const int rl0 = wr * 64 + fr, cl0 = wc * 32 + 8 * fq;
        const float r0_ = rstd_of(ssq, u.pm * 256 + fq * 16 + rl0), r1_ = rstd_of(ssq, u.pm * 256 + 128 + fq * 16 + rl0);
        EPI_ROWS(ai, m) { const int row = u.pm * 256 + ai * 128 + m * 16 + rl0; const float s = EPI_SC(ai, m);
            f32x4 o[2];
#pragma unroll
            for (int n = 0; n < 2; ++n)
#pragma unroll
                for (int j = 0; j < 4; ++j) { const float g = acc[ai][0][m][n][j] * s, up = acc[ai][1][m][n][j] * s; o[n][j] = q8(siluf_(g) * up); }
            st_bf8(act + (size_t)row * FFN + u.pn * 128 + cl0, o[0], o[1]); }
    }
};

struct ProgPle {
    __device__ __forceinline__ bool keep(const GU&) const { return false; }
    StaticOrder S; const bf16_t *xb, *wpg, *pp; const float* ssq; float* x; bf16_t* xbout; float* ssqout;
    __device__ __forceinline__ bool unit(int i, GU& u) const {
        Unit t; if (!S.next(i, t)) return false;
        u.pm = t.pm; u.pn = t.pn; u.sub = 0; u.aux = 0; u.idx = nullptr; u.mapA = 0; u.mapB = 0; u.lda = 2048; u.ldb = 2048; u.nt = 16;
        u.A = (const char*)xb + (size_t)t.pm * 256 * 2048; u.B = (const char*)wpg + (size_t)t.pn * 256 * 2048; return true;
    }
    __device__ __forceinline__ void epi(f32x4 (&acc)[2][2][4][2], const GU& u, int wr, int wc, int fr, int fq) const {
        const int rl0 = wr * 64 + fr, cl0 = wc * 32 + 8 * fq; const float ps = (DBG_ABL & 32) ? 0.f : 1.f;
        const float r0_ = rstd_of(ssq, u.pm * 256 + fq * 16 + rl0), r1_ = rstd_of(ssq, u.pm * 256 + 128 + fq * 16 + rl0);
#pragma unroll
        for (int ai = 0; ai < 2; ++ai)
#pragma unroll
            for (int mh = 0; mh < 2; ++mh) {
                f32x4 xv[2][2][2]; u32x4 gw[2][2];
#pragma unroll
                for (int m2 = 0; m2 < 2; ++m2)
#pragma unroll
                    for (int bj = 0; bj < 2; ++bj) { const size_t o = (size_t)(u.pm * 256 + ai * 128 + (2 * mh + m2) * 16 + rl0) * 1024 + u.pn * 256 + bj * 128 + cl0;
                        xv[m2][bj][0] = *(const f32x4*)(x + o); xv[m2][bj][1] = *(const f32x4*)(x + o + 4); gw[m2][bj] = *(const u32x4*)(pp + o); }
#pragma unroll
                for (int m2 = 0; m2 < 2; ++m2) { const int m = 2 * mh + m2, row = u.pm * 256 + ai * 128 + m * 16 + rl0; const float sc = EPI_SC(ai, m); float ss = 0.f;
#pragma unroll
                    for (int bj = 0; bj < 2; ++bj) { const size_t o = (size_t)row * 1024 + u.pn * 256 + bj * 128 + cl0; const u32x4 w = gw[m2][bj];
                        const f32x4 p0 = (f32x4){lo_bf(w.x), hi_bf(w.x), lo_bf(w.y), hi_bf(w.y)}, p1 = (f32x4){lo_bf(w.z), hi_bf(w.z), lo_bf(w.w), hi_bf(w.w)};
                        f32x4 g0 = acc[ai][bj][m][0] * sc, g1 = acc[ai][bj][m][1] * sc;
#pragma unroll
                        for (int j = 0; j < 4; ++j) { g0[j] = sigmoidf_(g0[j]); g1[j] = sigmoidf_(g1[j]); }
                        const f32x4 v0 = xv[m2][bj][0] + p0 * ps * g0, v1 = xv[m2][bj][1] + p1 * ps * g1;
                        *(f32x4*)(x + o) = v0; *(f32x4*)(x + o + 4) = v1; st_bf8(xbout + o, v0, v1); ss += sq8(v0, v1); }
                    ss += __shfl_xor(ss, 16); ss += __shfl_xor(ss, 32);
                    if (fq == 0) ssqout[(size_t)row * 16 + u.pn * 4 + wc] = ss; }
                EPI_FENCE;
            }
    }
};

struct MoeOrder {
    int tl[NE]; int nN, total, G, c;
    __device__ __forceinline__ void init(const unsigned* cnt, int nN_, int G_, int c_) {
        nN = nN_; G = G_; c = c_; int tt = 0;
#pragma unroll
        for (int e = 0; e < NE; ++e) { tl[e] = (int)((__builtin_amdgcn_readfirstlane(cnt[e]) + 255u) >> 8); tt += tl[e]; }
        total = tt * nN;
    }
    __device__ __forceinline__ bool next(int i, int& e, int& pml, int& pn, int& slot0) const {
        const long L = (long)i * G + c; if (L >= total) return false;
        int wgid = (int)L; { const int q = total / NXCD, r = total % NXCD, xcd = wgid % NXCD, off = wgid / NXCD; wgid = (xcd < r ? xcd * (q + 1) : r * (q + 1) + (xcd - r) * q) + off; }
        int ee = 0, ubase = 0, tbase = 0, nMe = tl[0], uacc = 0, tacc = 0;
#pragma unroll
        for (int k = 0; k < NE; ++k) { if (wgid >= uacc) { ee = k; ubase = uacc; tbase = tacc; nMe = tl[k]; } uacc += tl[k] * nN; tacc += tl[k]; }
        const int li = wgid - ubase, nig = WGM * nN, gid = li / nig, fm = gid * WGM, gsz = (nMe - fm) < WGM ? (nMe - fm) : WGM;
        pml = fm + ((li % nig) % gsz); pn = (li % nig) / gsz; e = ee; slot0 = (tbase + pml) * 256; return true;
    }
};
struct ProgMoeGu {
    __device__ __forceinline__ bool keep(const GU&) const { return false; }
    MoeOrder S; const bf16_t* xb; const bf16_t* Wt; const float* ssq; const int* idx; bf16_t* act;
    __device__ __forceinline__ bool unit(int i, GU& u) const {
        int e, pml, pn, slot0; if (!S.next(i, e, pml, pn, slot0)) return false;
        u.pm = slot0; u.pn = pn; u.sub = 0; u.aux = e; u.idx = idx + slot0; u.mapA = 99; u.mapB = 0; u.lda = 2048; u.ldb = 2048; u.nt = 16;
        u.A = (const char*)xb; u.B = (const char*)Wt + ((size_t)e * 7168 + (size_t)pn * 256) * 2048; return true;
    }
    __device__ __forceinline__ void epi(f32x4 (&acc)[2][2][4][2], const GU& u, int wr, int wc, int fr, int fq) const {
        const int rl0 = wr * 64 + fr, cl0 = wc * 32 + 8 * fq;
        const float r0_ = rstd_of(ssq, idx[u.pm + fq * 16 + rl0]), r1_ = rstd_of(ssq, idx[u.pm + 128 + fq * 16 + rl0]);
        EPI_ROWS(ai, m) { const int slot = u.pm + ai * 128 + m * 16 + rl0; const float s = EPI_SC(ai, m);
            f32x4 o[2];
#pragma unroll
            for (int n = 0; n < 2; ++n)
#pragma unroll
                for (int j = 0; j < 4; ++j) { const float g = acc[ai][0][m][n][j] * s, up = acc[ai][1][m][n][j] * s; o[n][j] = q8(siluf_(g) * up); }
            st_bf8(act + (size_t)slot * EXD + u.pn * 128 + cl0, o[0], o[1]); }
    }
};
struct MoeDownPlan { int ntiles, main, tail; };
__device__ __forceinline__ MoeDownPlan moe_down_plan(const unsigned* cnt, int G) {
    MoeDownPlan pl; int nt = 0;
#pragma unroll
    for (int e = 0; e < NE; ++e) nt += (int)((__builtin_amdgcn_readfirstlane(cnt[e]) + 255u) >> 8);
    const int U = 4 * nt; int tail = U % G; if (U < G || tail > TAILMAX) tail = 0;
    pl.ntiles = nt; pl.tail = tail; pl.main = U - tail; return pl;
}
struct ProgMoeDown {
    __device__ __forceinline__ bool keep(const GU&) const { return false; }
    int tl[NE]; MoeDownPlan pl; int G, c; const bf16_t* act; const bf16_t* Wt; bf16_t* ypair; float* partk;
    __device__ __forceinline__ void init(const unsigned* cnt, int G_, int c_) { G = G_; c = c_; pl = moe_down_plan(cnt, G_);
#pragma unroll
        for (int e = 0; e < NE; ++e) tl[e] = (int)((__builtin_amdgcn_readfirstlane(cnt[e]) + 255u) >> 8); }
    __device__ __forceinline__ bool unit(int i, GU& u) const {
        const long L = (long)i * G + c; int w, kp = -1;
        if (L < pl.main) { w = (int)L; const int q = pl.main / NXCD, r = pl.main % NXCD, xcd = w % NXCD, off = w / NXCD; w = (xcd < r ? xcd * (q + 1) : r * (q + 1) + (xcd - r) * q) + off; }
        else { const long s2 = L - pl.main; if (s2 >= (long)pl.tail * KSPL) return false; w = pl.main + (int)(s2 / KSPL); kp = (int)(s2 % KSPL); }
        const int tile = w >> 2, pn = w & 3; int e = 0, tacc = 0;
#pragma unroll
        for (int k = 0; k < NE; ++k) { if (tile >= tacc) e = k; tacc += tl[k]; }
        const int slot0 = tile * 256;
        u.pm = slot0; u.pn = pn; u.aux = e; u.idx = nullptr; u.mapA = 0; u.mapB = 0; u.lda = 7168; u.ldb = 7168;
        u.A = (const char*)act + (size_t)slot0 * 7168; u.B = (const char*)Wt + ((size_t)e * 1024 + (size_t)pn * 256) * 7168;
        if (kp < 0) { u.sub = 0; u.nt = 56; } else { u.sub = 1 + kp; u.nt = 8; u.A += kp * 1024; u.B += kp * 1024; }
        return true;
    }
    __device__ __forceinline__ void epi(f32x4 (&acc)[2][2][4][2], const GU& u, int wr, int wc, int fr, int fq) const {
        const int rl0 = wr * 64 + fr, cl0 = wc * 32 + 8 * fq;
        if (u.sub == 0) {
            EPI_ROWS(ai, m) { const int slot = u.pm + ai * 128 + m * 16 + rl0;
#pragma unroll
                for (int bj = 0; bj < 2; ++bj) st_bf8(ypair + (size_t)slot * 1024 + u.pn * 256 + bj * 128 + cl0, acc[ai][bj][m][0], acc[ai][bj][m][1]); }
        } else {
            float* pk = partk + ((size_t)(u.sub - 1) * (TAILMAX / 4) * 256 + (u.pm - (pl.main >> 2) * 256)) * 1024 + u.pn * 256 + cl0;
            EPI_ROWS(ai, m) { float* o = pk + (size_t)(ai * 128 + m * 16 + rl0) * 1024;
#pragma unroll
                for (int bj = 0; bj < 2; ++bj) { *(f32x4*)(o + bj * 128) = acc[ai][bj][m][0]; *(f32x4*)(o + bj * 128 + 4) = acc[ai][bj][m][1]; } }
        }
    }
};

struct Params { const float* in[30]; float* out; unsigned char* ws; int s_lo, s_hi; };
enum { I_X = 0, I_P, I_MIXN, I_WIN, I_DNCONV, I_DNALOG, I_DNDTB, I_DNNORM, I_SSCONV, I_SSCONVB, I_SSALOG, I_SSDTB, I_SSD, I_SSNORM, I_WBRDN, I_WBRSSM, I_WBRATT, I_WOUT, I_FFNN,
       I_WFG, I_WFU, I_WFD, I_WROUTER, I_WMG, I_WMU, I_WMD, I_PLEN, I_WPLE, I_WPLEG, I_FINALN };

template <class Map>
__device__ __forceinline__ void tr_job(const Map& map, int K, int N, bf16_t* WT, const float* gain, LAS float* scr, int lane, int gw, int NGW, float qs = 0.f) {
    const int nblk = N / 32, nitems = (K / 64) * nblk;
    for (int item = gw; item < nitems; item += NGW) {
        const int kb = item / nblk, nb = item % nblk, k0 = 64 * kb, n0 = 32 * nb;
        int ld = 0; const float* src = map(n0 + (lane & 31), ld);
#pragma unroll
        for (int i = 0; i < 32; ++i) { const int kk = 2 * i + (lane >> 5); float v = 0.f; if (src) { v = src[(size_t)(k0 + kk) * ld]; if (gain) v *= gain[k0 + kk]; if (qs > 0.f) v = q8(v * qs) / qs; } scr[kk * 33 + (lane & 31)] = v; }
        asm volatile("s_waitcnt lgkmcnt(0)" ::: "memory");
        const int c = lane & 7;
#pragma unroll
        for (int j = 0; j < 4; ++j) { const int n = (lane >> 3) + 8 * j; const LAS float* s = scr + (8 * c) * 33 + n;
            u32x4 o; o.x = pk2(s[0 * 33], s[1 * 33]); o.y = pk2(s[2 * 33], s[3 * 33]); o.z = pk2(s[4 * 33], s[5 * 33]); o.w = pk2(s[6 * 33], s[7 * 33]);
            *(u32x4*)(WT + (size_t)(n0 + n) * K + k0 + 8 * c) = o; }
        asm volatile("s_waitcnt lgkmcnt(0)" ::: "memory");
    }
}
struct MapPlain { const float* W; int ld; __device__ __forceinline__ const float* operator()(int n, int& l) const { l = ld; return W + n; } };
struct MapIn { const float* W; __device__ __forceinline__ const float* operator()(int n, int& l) const { l = INW; const int tile = n >> 8, r = n & 255; int col;
        if (tile < 9) col = n; else if (tile < 12) col = C_DNZ + (n - 2304); else if (tile < 17) col = C_XBC + (n - 3072); else if (tile < 20) col = C_SSZ + (n - 4352);
        else if (tile < 29) col = C_ATT + (n - 5120); else if (tile < 41) col = C_GATE + (n - 7424);
        else { if (r < 6) col = C_DNA + r; else if (r < 12) col = C_DNB + (r - 6); else if (r < 24) col = C_SSDT + (r - 12); else return nullptr; }
        return W + col; } };
struct MapGu { const float* Wg; const float* Wu; int ld; __device__ __forceinline__ const float* operator()(int n, int& l) const { l = ld; const int tile = n >> 8, r = n & 255; return r < 128 ? Wg + tile * 128 + r : Wu + tile * 128 + (r - 128); } };

__device__ __forceinline__ void phase_convert(const Params& p, LAS unsigned char* lds) {
    const int tid_ = htid(), lane = tid_ & 63, wave = tid_ >> 6, G = gridDim.x;
    const int gw = blockIdx.x * 8 + wave, NGW = G * 8;
    LAS float* scr = (LAS float*)(lds + wave * 16384);
    unsigned char* ws = p.ws;
    for (int l = 0; l < DEPTH; ++l) {
        tr_job(MapIn{p.in[I_WIN] + (size_t)l * D * INW}, D, INP, (bf16_t*)(ws + WS_WIN) + (size_t)l * INP * D, p.in[I_MIXN] + l * D, scr, lane, gw, NGW);
        tr_job(MapPlain{p.in[I_WBRDN] + (size_t)l * 768 * D, D}, 768, D, (bf16_t*)(ws + WS_WDN) + (size_t)l * D * 768, nullptr, scr, lane, gw, NGW);
        tr_job(MapPlain{p.in[I_WBRSSM] + (size_t)l * 768 * D, D}, 768, D, (bf16_t*)(ws + WS_WSSM) + (size_t)l * D * 768, nullptr, scr, lane, gw, NGW);
        tr_job(MapPlain{p.in[I_WBRATT] + (size_t)l * 256 * D, D}, 256, D, (bf16_t*)(ws + WS_WATT) + (size_t)l * D * 256, nullptr, scr, lane, gw, NGW);
        tr_job(MapPlain{p.in[I_WOUT] + (size_t)l * D * D, D}, D, D, (bf16_t*)(ws + WS_WOUT) + (size_t)l * D * D, nullptr, scr, lane, gw, NGW);
        tr_job(MapPlain{p.in[I_WPLEG] + (size_t)l * D * D, D}, D, D, (bf16_t*)(ws + WS_WPG) + (size_t)l * D * D, p.in[I_PLEN] + l * D, scr, lane, gw, NGW);
        tr_job(MapPlain{p.in[I_WPLE] + (size_t)l * PLE * D, D}, PLE, D, (bf16_t*)(ws + WS_WPLE) + (size_t)l * D * PLE, nullptr, scr, lane, gw, NGW);
    }
    tr_job(MapGu{p.in[I_WFG], p.in[I_WFU], FFN}, D, 2 * FFN, (bf16_t*)(ws + WS_WFGU), p.in[I_FFNN], scr, lane, gw, NGW, 16.f);
    tr_job(MapPlain{p.in[I_WFD], D}, FFN, D, (bf16_t*)(ws + WS_WFD), nullptr, scr, lane, gw, NGW, 16.f);
    for (int e = 0; e < NE; ++e) {
        tr_job(MapGu{p.in[I_WMG] + (size_t)e * D * EXD, p.in[I_WMU] + (size_t)e * D * EXD, EXD}, D, 2 * EXD, (bf16_t*)(ws + WS_WMGU) + (size_t)e * 2 * EXD * D, p.in[I_FFNN] + D, scr, lane, gw, NGW, 16.f);
        tr_job(MapPlain{p.in[I_WMD] + (size_t)e * EXD * D, D}, EXD, D, (bf16_t*)(ws + WS_WMD) + (size_t)e * D * EXD, nullptr, scr, lane, gw, NGW, 16.f);
    }
    float* wr = (float*)(ws + WS_WR);
    for (int i = blockIdx.x * 512 + tid_; i < D * NE; i += G * 512) wr[i] = p.in[I_WROUTER][i] * p.in[I_FFNN][D + (i >> 3)];
}

__device__ __forceinline__ void phase_chunk_in(const Params& p, int chunk) {
    const int tid_ = htid(), lane = tid_ & 63, gw = blockIdx.x * 8 + (tid_ >> 6), NGW = gridDim.x * 8;
    const float* x = p.in[I_X] + (size_t)chunk * TC * D;
    bf16_t* xb = (bf16_t*)(p.ws + WS_XB); float* ssq = (float*)(p.ws + WS_SSQ);
    for (int r = gw; r < TC; r += NGW) {
        const f32x4* xr = (const f32x4*)(x + (size_t)r * D) + lane; float s = 0.f;
        u32x2* o = (u32x2*)(xb + (size_t)r * D) + lane;
#pragma unroll
        for (int j = 0; j < 4; ++j) { const f32x4 v = xr[64 * j]; s += (v.x * v.x + v.y * v.y) + (v.z * v.z + v.w * v.w); u32x2 w; w.x = pk2(v.x, v.y); w.y = pk2(v.z, v.w); o[64 * j] = w; }
        s = wave_sum(s);
        if (lane < 16) ssq[(size_t)r * 16 + lane] = lane == 0 ? s : 0.f;
    }
    bf16_t* pb = (bf16_t*)(p.ws + WS_PB);
    for (int r = gw; r < 2 * TC; r += NGW) {
        const int l = r / TC, rr = r % TC;
        const f32x4 v = *((const f32x4*)(p.in[I_P] + ((size_t)l * BATCH * SEQ + (size_t)chunk * TC + rr) * PLE) + lane);
        u32x2 w; w.x = pk2(v.x, v.y); w.y = pk2(v.z, v.w); *((u32x2*)(pb + ((size_t)l * TC + rr) * PLE) + lane) = w;
    }
}
__device__ __forceinline__ void phase_final(const Params& p, int chunk) {
    const int tid_ = htid(), lane = tid_ & 63, gw = blockIdx.x * 8 + (tid_ >> 6), NGW = gridDim.x * 8;
    float* x = p.out + (size_t)chunk * TC * D; const float* g = p.in[I_FINALN];
    for (int r = gw; r < TC; r += NGW) {
        f32x4* xr = (f32x4*)(x + (size_t)r * D) + lane; f32x4 v[4]; float s = 0.f;
#pragma unroll
        for (int j = 0; j < 4; ++j) { v[j] = xr[64 * j]; s += (v[j].x * v[j].x + v[j].y * v[j].y) + (v[j].z * v[j].z + v[j].w * v[j].w); }
        const float rs = rsqrtf(wave_sum(s) * (1.f / D) + EPS);
#pragma unroll
        for (int j = 0; j < 4; ++j) xr[64 * j] = v[j] * rs * ((const f32x4*)g)[lane + 64 * j];
    }
}
__device__ __forceinline__ void phase_router(const Params& p, int chunk) {
    const int tid_ = htid(), lane = tid_ & 63, gw = blockIdx.x * 8 + (tid_ >> 6), NGW = gridDim.x * 8;
    const float* x = p.out + (size_t)chunk * TC * D; const float* wr = (const float*)(p.ws + WS_WR);
    int* rt = (int*)(p.ws + WS_ROUTE); unsigned* cnt = (unsigned*)(p.ws + WS_CTL) + CW_CNT + chunk * 64;
    for (int r = gw; r < TC; r += NGW) {
        const f32x4* xr = (const f32x4*)(x + (size_t)r * D) + lane; float s = 0.f; float lg[NE];
#pragma unroll
        for (int e = 0; e < NE; ++e) lg[e] = 0.f;
#pragma unroll
        for (int j = 0; j < 4; ++j) { const f32x4 v = xr[64 * j]; s += (v.x * v.x + v.y * v.y) + (v.z * v.z + v.w * v.w);
#pragma unroll
            for (int q = 0; q < 4; ++q) { const int k = 4 * (lane + 64 * j) + q; const f32x4 w0 = *(const f32x4*)(wr + k * 8), w1 = *(const f32x4*)(wr + k * 8 + 4);
                lg[0] += v[q] * w0.x; lg[1] += v[q] * w0.y; lg[2] += v[q] * w0.z; lg[3] += v[q] * w0.w; lg[4] += v[q] * w1.x; lg[5] += v[q] * w1.y; lg[6] += v[q] * w1.z; lg[7] += v[q] * w1.w; } }
        const float rs = rsqrtf(wave_sum(s) * (1.f / D) + EPS);
#pragma unroll
        for (int e = 0; e < NE; ++e) lg[e] = wave_sum(lg[e]) * rs;
        int i0 = 0; float l0 = lg[0];
#pragma unroll
        for (int e = 1; e < NE; ++e) if (lg[e] > l0) { l0 = lg[e]; i0 = e; }
        int i1 = -1; float l1 = -3.0e38f;
#pragma unroll
        for (int e = 0; e < NE; ++e) if (e != i0 && lg[e] > l1) { l1 = lg[e]; i1 = e; }
        if (lane == 0) {
            const float w0 = 1.f / (1.f + expf(l1 - l0));
            const unsigned p0 = atomicAdd(cnt + i0, 1u), p1 = atomicAdd(cnt + i1, 1u);
            rt[RT_TOPE + 2 * r] = i0; rt[RT_TOPE + 2 * r + 1] = i1; rt[RT_TOPP + 2 * r] = (int)p0; rt[RT_TOPP + 2 * r + 1] = (int)p1;
            ((float*)rt)[RT_TOPW + 2 * r] = w0; ((float*)rt)[RT_TOPW + 2 * r + 1] = 1.f - w0;
        }
    }
}
__device__ __forceinline__ void phase_slots(const Params& p, int chunk) {
    int* rt = (int*)(p.ws + WS_ROUTE); const unsigned* cnt = (const unsigned*)(p.ws + WS_CTL) + CW_CNT + chunk * 64;
    int c[NE], off[NE + 1]; off[0] = 0;
#pragma unroll
    for (int e = 0; e < NE; ++e) { c[e] = (int)cnt[e]; off[e + 1] = off[e] + ((c[e] + 255) & ~255); }
    const int gt = blockIdx.x * 512 + htid(), NT = gridDim.x * 512;
    for (int i = gt; i < 2 * TC; i += NT) {
        const int e = rt[RT_TOPE + i], pos = rt[RT_TOPP + i]; int o = 0;
#pragma unroll
        for (int k = 0; k < NE; ++k) o = (e == k) ? off[k] : o;
        const int slot = o + pos; rt[RT_TOPS + i] = slot; rt[RT_IDX + slot] = i >> 1;
    }
    for (int s = gt; s < off[NE]; s += NT) {
        bool pad = false;
#pragma unroll
        for (int k = 0; k < NE; ++k) pad = pad || (s >= off[k] + c[k] && s < off[k + 1]);
        if (pad) rt[RT_IDX + s] = 0;
    }
}
__device__ __forceinline__ f32x4 moe_y4(const bf16_t* yp, const float* partk, int slot, int tail0, int col) {
    if (slot < tail0) { const u32x2 a = *(const u32x2*)(yp + (size_t)slot * D + col); return (f32x4){lo_bf(a.x), hi_bf(a.x), lo_bf(a.y), hi_bf(a.y)}; }
    f32x4 v = (f32x4){0.f, 0.f, 0.f, 0.f};
#pragma unroll
    for (int k = 0; k < KSPL; ++k) v += *(const f32x4*)(partk + ((size_t)k * (TAILMAX / 4) * 256 + (slot - tail0)) * 1024 + col);
    return v;
}
__device__ __forceinline__ void phase_combine(const Params& p, int chunk) {
    const int tid_ = htid(), lane = tid_ & 63, gw = blockIdx.x * 8 + (tid_ >> 6), NGW = gridDim.x * 8;
    float* x = p.out + (size_t)chunk * TC * D; const int* rt = (const int*)(p.ws + WS_ROUTE);
    const bf16_t* yp = (const bf16_t*)(p.ws + WS_YPAIR); const float* partk = (const float*)(p.ws + WS_PARTK); bf16_t* xb = (bf16_t*)(p.ws + WS_XB); float* ssq = (float*)(p.ws + WS_SSQ);
    const MoeDownPlan pl = moe_down_plan((const unsigned*)(p.ws + WS_CTL) + CW_CNT + chunk * 64, gridDim.x);
    const int tail0 = pl.tail > 0 ? (pl.main >> 2) * 256 : 0x7fffffff;
    for (int r = gw; r < TC; r += NGW) {
        const int s0 = rt[RT_TOPS + 2 * r], s1 = rt[RT_TOPS + 2 * r + 1]; const float w0 = (DBG_ABL & 16) ? 0.f : ((const float*)rt)[RT_TOPW + 2 * r], w1 = (DBG_ABL & 16) ? 0.f : ((const float*)rt)[RT_TOPW + 2 * r + 1];
        f32x4* xr = (f32x4*)(x + (size_t)r * D) + lane; u32x2* o = (u32x2*)(xb + (size_t)r * D) + lane; float s = 0.f;
#pragma unroll
        for (int j = 0; j < 4; ++j) { f32x4 v = xr[64 * j]; const int col = 4 * (lane + 64 * j);
            v += w0 * moe_y4(yp, partk, s0, tail0, col) + w1 * moe_y4(yp, partk, s1, tail0, col);
            xr[64 * j] = v; s += (v.x * v.x + v.y * v.y) + (v.z * v.z + v.w * v.w); u32x2 w; w.x = pk2(v.x, v.y); w.y = pk2(v.z, v.w); o[64 * j] = w; }
        s = wave_sum(s);
        if (lane < 16) ssq[(size_t)r * 16 + lane] = lane == 0 ? s : 0.f;
    }
}

#define LDS_BARRIER() do { asm volatile("s_waitcnt lgkmcnt(0)" ::: "memory"); __builtin_amdgcn_s_barrier(); asm volatile("" ::: "memory"); } while (0)
__device__ __forceinline__ f32x4 mfma16(const bf16x8 a, const bf16x8 b, const f32x4 c) { return __builtin_amdgcn_mfma_f32_16x16x32_bf16(a, b, c, 0, 0, 0); }
__device__ __forceinline__ void dn_prep(const Params& p, LAS unsigned char* lds, int layer, int b, int n, int h) {
    const int tid = htid(), lane = tid & 63, wave = tid >> 6;
    LAS unsigned char* QS = lds; LAS unsigned char* KS = lds + 17408; LAS unsigned char* VS = lds + 34816;
    LAS float* AM = (LAS float*)(lds + 52224);
    LAS float* SC = (LAS float*)(lds + 69632);
    const int t0 = n * 64;
    const bf16_t* proj = (const bf16_t*)(p.ws + WS_PDN) + (size_t)b * SEQ * 3072;
    unsigned char* item = p.ws + WS_DNS + (size_t)((b * 32 + n) * 6 + h) * DNS_ITEM;
    if (tid < 480) {
        const int cg = tid % 48, seg = tid / 48, part = cg >> 4, c8 = (cg & 15) * 8, col = part * 768 + h * 128 + c8;
        const float* cw = p.in[I_DNCONV] + (size_t)layer * 4 * 2304 + col;
        f32x4 w[4][2];
#pragma unroll
        for (int j = 0; j < 4; ++j) { w[j][0] = *(const f32x4*)(cw + j * 2304); w[j][1] = *(const f32x4*)(cw + j * 2304 + 4); }
        const int ts = seg * 7;
        f32x4 x[10][2];
#pragma unroll
        for (int i = 0; i < 10; ++i) { const int t = t0 + ts - 3 + i; x[i][0] = (f32x4){0.f, 0.f, 0.f, 0.f}; x[i][1] = x[i][0];
            if (t >= 0 && ts - 3 + i < 64) ld_bf8(proj + (size_t)t * 3072 + col, x[i][0], x[i][1]); }
        LAS unsigned char* dst = part == 0 ? QS : (part == 1 ? KS : VS);
#pragma unroll
        for (int i = 0; i < 7; ++i) { const int tk = ts + i;
            if (tk < 64) { f32x4 a0 = w[3][0] * x[i + 3][0] + w[2][0] * x[i + 2][0] + w[1][0] * x[i + 1][0] + w[0][0] * x[i][0];
                f32x4 a1 = w[3][1] * x[i + 3][1] + w[2][1] * x[i + 2][1] + w[1][1] * x[i + 1][1] + w[0][1] * x[i][1];
#pragma unroll
                for (int c = 0; c < 4; ++c) { a0[c] = siluf_(a0[c]); a1[c] = siluf_(a1[c]); }
                u32x4 pw; pw.x = pk2(a0[0], a0[1]); pw.y = pk2(a0[2], a0[3]); pw.z = pk2(a1[0], a1[1]); pw.w = pk2(a1[2], a1[3]);
                *(LAS u32x4*)(dst + tk * 272 + c8 * 2) = pw;
 } }
    } else {
        const float Aexp = expf(p.in[I_DNALOG][layer * 6 + h]), dtb = p.in[I_DNDTB][layer * 6 + h];
        const float* small = (const float*)(p.ws + WS_SMALL) + (size_t)b * SEQ * 32;
#pragma unroll
        for (int q = 0; q < 2; ++q) { const int tk = (tid - 480) * 2 + q; const float a = small[(size_t)(t0 + tk) * 32 + h], bb = small[(size_t)(t0 + tk) * 32 + 6 + h];
            SC[128 + tk] = sigmoidf_(bb); SC[192 + tk] = -Aexp * softplusf_(a + dtb); }
    }
    LDS_BARRIER();
    {
        const int row = tid >> 3, sg = tid & 7; const u32x4 q0 = *(const LAS u32x4*)(QS + row * 272 + sg * 32), q1 = *(const LAS u32x4*)(QS + row * 272 + sg * 32 + 16), k0 = *(const LAS u32x4*)(KS + row * 272 + sg * 32), k1 = *(const LAS u32x4*)(KS + row * 272 + sg * 32 + 16);
        float sq = sq8((f32x4){lo_bf(q0.x), hi_bf(q0.x), lo_bf(q0.y), hi_bf(q0.y)}, (f32x4){lo_bf(q0.z), hi_bf(q0.z), lo_bf(q0.w), hi_bf(q0.w)}) + sq8((f32x4){lo_bf(q1.x), hi_bf(q1.x), lo_bf(q1.y), hi_bf(q1.y)}, (f32x4){lo_bf(q1.z), hi_bf(q1.z), lo_bf(q1.w), hi_bf(q1.w)});
        float sk = sq8((f32x4){lo_bf(k0.x), hi_bf(k0.x), lo_bf(k0.y), hi_bf(k0.y)}, (f32x4){lo_bf(k0.z), hi_bf(k0.z), lo_bf(k0.w), hi_bf(k0.w)}) + sq8((f32x4){lo_bf(k1.x), hi_bf(k1.x), lo_bf(k1.y), hi_bf(k1.y)}, (f32x4){lo_bf(k1.z), hi_bf(k1.z), lo_bf(k1.w), hi_bf(k1.w)});
        sq += __shfl_xor(sq, 1); sq += __shfl_xor(sq, 2); sq += __shfl_xor(sq, 4); sk += __shfl_xor(sk, 1); sk += __shfl_xor(sk, 2); sk += __shfl_xor(sk, 4);
        if (sg == 0) { SC[row] = sq; SC[64 + row] = sk; } }
    LDS_BARRIER();
    if (wave == 0) {
        float g = SC[192 + lane];
#pragma unroll
        for (int o = 1; o < 64; o <<= 1) { const float t = __shfl_up(g, o); if (lane >= o) g += t; }
        SC[192 + lane] = g; SC[256 + lane] = expf(g); SC[320 + lane] = rsqrtf(SC[lane] + EPS); SC[384 + lane] = rsqrtf(SC[64 + lane] + EPS);
    }
    LDS_BARRIER();
    {
        const int r = lane & 15, kg = lane >> 4;
        bf16x8 fa[4][4], fb[4][4];
#pragma unroll
        for (int q = 0; q < 4; ++q) { const int t = wave * 4 + q, which = t >> 4, mt = (t >> 2) & 3, nt = t & 3;
            const LAS unsigned char* A = (which == 0 ? KS : QS) + (16 * mt + r) * 272 + kg * 16; const LAS unsigned char* Bt = KS + (16 * nt + r) * 272 + kg * 16;
#pragma unroll
            for (int ks = 0; ks < 4; ++ks) { fa[q][ks] = *(const LAS bf16x8*)(A + ks * 64); fb[q][ks] = *(const LAS bf16x8*)(Bt + ks * 64); } }
#pragma unroll
        for (int q = 0; q < 4; ++q) { const int t = wave * 4 + q, which = t >> 4, mt = (t >> 2) & 3, nt = t & 3;
            f32x4 acc = (f32x4){0.f, 0.f, 0.f, 0.f};
#pragma unroll
            for (int ks = 0; ks < 4; ++ks) acc = mfma16(fa[q][ks], fb[q][ks], acc);
            const int j = 16 * nt + r; const float gj = SC[192 + j], rkj = SC[384 + j];
            float ov[4];
#pragma unroll
            for (int rr = 0; rr < 4; ++rr) { const int i = 16 * mt + 4 * kg + rr; const float e = fexp(fminf(SC[192 + i] - gj, 0.f));
                if (which == 0) AM[i * 68 + j] = (i > j) ? SC[128 + i] * SC[384 + i] * rkj * acc[rr] * e : 0.f;
                ov[rr] = (i >= j) ? SC[320 + i] * rkj * 0.08838834764831845f * acc[rr] * e : 0.f; }
            if (which != 0) { bf16_t* ao = (bf16_t*)(item + 32768) + (16 * mt + 4 * kg) * 64 + j; ST2_BF(ao, ao + 64, ov[0], ov[1]); ST2_BF(ao + 128, ao + 192, ov[2], ov[3]); }
        }
    }
    LDS_BARRIER();
    if (tid < 256) {
        float x[64];
        if (tid < 128) {
#pragma unroll
            for (int i = 0; i < 64; ++i) x[i] = bf2f(*(const LAS bf16_t*)(KS + i * 272 + tid * 2)) * SC[384 + i] * SC[128 + i] * SC[256 + i];
        } else {
#pragma unroll
            for (int i = 0; i < 64; ++i) x[i] = bf2f(*(const LAS bf16_t*)(VS + i * 272 + (tid - 128) * 2)) * SC[128 + i];
        }
        f32x4 rw[2][16];
        rw[1][0] = *(const LAS f32x4*)(AM + 1 * 68);
#pragma unroll
        for (int i = 1; i < 64; ++i) {
            if (i + 1 < 64) {
#pragma unroll
                for (int k4 = 0; k4 < (i + 4) / 4; ++k4) rw[(i + 1) & 1][k4] = *(const LAS f32x4*)(AM + (i + 1) * 68 + 4 * k4);
            }
            float a4[4] = {x[i], 0.f, 0.f, 0.f};
#pragma unroll
            for (int k4 = 0; k4 < (i + 3) / 4; ++k4) { const f32x4 am = rw[i & 1][k4];
#pragma unroll
                for (int c = 0; c < 4; ++c) if (4 * k4 + c < i) a4[c] -= am[c] * x[4 * k4 + c]; }
            x[i] = (a4[0] + a4[1]) + (a4[2] + a4[3]); }
        if (tid < 128) { bf16_t* W = (bf16_t*)item;
#pragma unroll
            for (int i = 0; i < 64; i += 2) ST2_BF(W + i * 128 + tid, W + (i + 1) * 128 + tid, x[i], x[i + 1]);
        } else { u32x4* UT = (u32x4*)(item + 57344 + (size_t)(tid - 128) * 128);
#pragma unroll
            for (int c = 0; c < 8; ++c) { u32x4 w; w.x = pk2(x[8 * c], x[8 * c + 1]); w.y = pk2(x[8 * c + 2], x[8 * c + 3]); w.z = pk2(x[8 * c + 4], x[8 * c + 5]); w.w = pk2(x[8 * c + 6], x[8 * c + 7]); UT[c] = w; } }
    } else {
        const int u = tid - 256; const float glast = SC[192 + 63];
#pragma unroll
        for (int i = 0; i < 4; ++i) { const int q = u + 256 * i, c = q >> 4, d8 = (q & 15) * 8; f32x4 a0, a1;
            const u32x4 w = *(const LAS u32x4*)(QS + c * 272 + d8 * 2); const float sc = SC[320 + c] * 0.08838834764831845f * SC[256 + c];
            a0 = (f32x4){lo_bf(w.x), hi_bf(w.x), lo_bf(w.y), hi_bf(w.y)} * sc; a1 = (f32x4){lo_bf(w.z), hi_bf(w.z), lo_bf(w.w), hi_bf(w.w)} * sc;
            st_bf8((bf16_t*)(item + 16384) + c * 128 + d8, a0, a1); }
#pragma unroll
        for (int i = 0; i < 4; ++i) { const int q = u + 256 * i, d = q >> 3, c8 = (q & 7) * 8; float v[8];
#pragma unroll
            for (int c = 0; c < 8; ++c) v[c] = bf2f(*(const LAS bf16_t*)(KS + (c8 + c) * 272 + d * 2)) * SC[384 + c8 + c] * fexp(glast - SC[192 + c8 + c]);
            st_bf8((bf16_t*)(item + 40960) + d * 64 + c8, (f32x4){v[0], v[1], v[2], v[3]}, (f32x4){v[4], v[5], v[6], v[7]}); }
        if (u == 0) ((float*)(p.ws + WS_DNEGL))[(b * 32 + n) * 6 + h] = SC[256 + 63];
    }
    {
        const float* ng = p.in[I_DNNORM] + layer * 128; bf16_t* ydn = (bf16_t*)(p.ws + WS_YDN) + ((size_t)b * SEQ + t0) * 768 + h * 128;
#pragma unroll
        for (int i = 0; i < 2; ++i) { const int q = tid + 512 * i, c = q >> 4, e8 = (q & 15) * 8; f32x4 z0, z1; ld_bf8(proj + (size_t)(t0 + c) * 3072 + 2304 + h * 128 + e8, z0, z1);
            const f32x4 g0 = *(const f32x4*)(ng + e8), g1 = *(const f32x4*)(ng + e8 + 4);
#pragma unroll
            for (int j = 0; j < 4; ++j) { z0[j] = g0[j] * siluf_(z0[j]); z1[j] = g1[j] * siluf_(z1[j]); }
            st_bf8(ydn + (size_t)c * 768 + e8, z0, z1); }
    }
    LDS_BARRIER();
}
__device__ __forceinline__ float row16_sum(float v) {
    v += __builtin_bit_cast(float, __builtin_amdgcn_update_dpp(0, __builtin_bit_cast(int, v), 0xB1, 0xf, 0xf, false));
    v += __builtin_bit_cast(float, __builtin_amdgcn_update_dpp(0, __builtin_bit_cast(int, v), 0x4E, 0xf, 0xf, false));
    v += __builtin_bit_cast(float, __builtin_amdgcn_update_dpp(0, __builtin_bit_cast(int, v), 0x141, 0xf, 0xf, false));
    v += __builtin_bit_cast(float, __builtin_amdgcn_update_dpp(0, __builtin_bit_cast(int, v), 0x140, 0xf, 0xf, false));
    return v;
}
__device__ __forceinline__ void dn_scan(const Params& p, LAS unsigned char* lds, int layer, int b, int h) {
    const int tid = htid(), lane = tid & 63, wave = __builtin_amdgcn_readfirstlane(tid >> 6), r = lane & 15, kg = lane >> 4;
    LAS unsigned char* W = lds; LAS unsigned char* QD = lds + 17408; LAS unsigned char* ATT = lds + 34816; LAS unsigned char* KDT = lds + 44032; LAS unsigned char* UT = lds + 62464;
    LAS unsigned char* ST = lds + 80896; LAS unsigned char* VNT = lds + 115712; LAS float* PS = (LAS float*)(lds + 134144); LAS float* RS = (LAS float*)(lds + 136192) + wave * 64;
    const unsigned char* items = p.ws + WS_DNS + (size_t)(b * 32 * 6 + h) * DNS_ITEM;
    bf16_t* ydn = (bf16_t*)(p.ws + WS_YDN) + (size_t)b * SEQ * 768 + h * 128 + 16 * wave + r;
    float egl_all = lane < 32 ? ((const float*)(p.ws + WS_DNEGL))[b * 32 * 6 + h + 6 * lane] : 0.f;
    asm volatile("" : "+v"(egl_all));
    f32x4 S[8], o[4];
#pragma unroll
    for (int dt = 0; dt < 8; ++dt) S[dt] = (f32x4){0.f, 0.f, 0.f, 0.f};
#pragma unroll
    for (int mt = 0; mt < 4; ++mt) o[mt] = (f32x4){0.f, 0.f, 0.f, 0.f};
    for (int i = lane; i < 16 * 272 / 16; i += 64) *(LAS u32x4*)(ST + wave * 16 * 272 + i * 16) = (u32x4){0u, 0u, 0u, 0u};
    u32x4 R[9];
#pragma unroll
    for (int i = 0; i < 9; ++i) R[i] = *(const u32x4*)(items + (size_t)(tid + 512 * i) * 16);
    unsigned short zc[16];
#pragma unroll
    for (int i = 0; i < 16; ++i) zc[i] = 0u;
    LDS_BARRIER();
    for (int n = 0; n <= 32; ++n) {
        if (n < 32) {
#pragma unroll
            for (int i = 0; i < 9; ++i) { const int q = tid + 512 * i; LAS unsigned char* dst;
                if (i < 2) dst = W + (q >> 4) * 272 + (q & 15) * 16; else if (i < 4) dst = QD + ((q - 1024) >> 4) * 272 + (q & 15) * 16;
                else if (i < 5) dst = ATT + ((q - 2048) >> 3) * 144 + (q & 7) * 16; else if (i < 7) dst = KDT + ((q - 2560) >> 3) * 144 + (q & 7) * 16;
                else dst = UT + ((q - 3584) >> 3) * 144 + (q & 7) * 16;
                *(LAS u32x4*)dst = R[i]; }
        }
        if (n > 0) {
            float tot = 0.f;
#pragma unroll
            for (int w = 0; w < 8; ++w) tot += PS[w * 64 + lane];
            RS[lane] = rsqrtf(tot * (1.f / 128.f) + EPS);
#pragma unroll
            for (int mt = 0; mt < 4; ++mt) { const f32x4 rs = *(const LAS f32x4*)(RS + 16 * mt + 4 * kg);
#pragma unroll
                for (int rr = 0; rr < 4; rr += 2) { bf16_t* yo_ = ydn + (size_t)((n - 1) * 64 + 16 * mt + 4 * kg + rr) * 768;
                    ST2_BF(yo_, yo_ + 768, o[mt][rr] * rs[rr] * __uint_as_float(((unsigned)zc[4 * mt + rr]) << 16), o[mt][rr + 1] * rs[rr + 1] * __uint_as_float(((unsigned)zc[4 * mt + rr + 1]) << 16)); } }
        }
        if (n == 32) break;
        if (n + 1 < 32) {
#pragma unroll
            for (int i = 0; i < 9; ++i) R[i] = *(const u32x4*)(items + (size_t)(n + 1) * 6 * DNS_ITEM + (size_t)(tid + 512 * i) * 16);
        }
#pragma unroll
        for (int mt = 0; mt < 4; ++mt)
#pragma unroll
            for (int rr = 0; rr < 4; ++rr) zc[4 * mt + rr] = ydn[(size_t)(n * 64 + 16 * mt + 4 * kg + rr) * 768];
        const float egl = __builtin_bit_cast(float, __builtin_amdgcn_readlane(__builtin_bit_cast(int, egl_all), n));
        LDS_BARRIER();
        bf16x8 sf[4];
#pragma unroll
        for (int ks = 0; ks < 4; ++ks) sf[ks] = *(const LAS bf16x8*)(ST + (16 * wave + r) * 272 + ks * 64 + kg * 16);
        {   bf16x8 af[4][4]; u32x2 uw[4];
#pragma unroll
            for (int mt = 0; mt < 4; ++mt) {
#pragma unroll
                for (int ks = 0; ks < 4; ++ks) af[mt][ks] = *(const LAS bf16x8*)(W + (16 * mt + r) * 272 + ks * 64 + kg * 16);
                uw[mt] = *(const LAS u32x2*)(UT + (16 * wave + r) * 144 + (16 * mt + 4 * kg) * 2); }
#pragma unroll
            for (int mt = 0; mt < 4; ++mt) { f32x4 ws = (f32x4){0.f, 0.f, 0.f, 0.f};
#pragma unroll
                for (int ks = 0; ks < 4; ++ks) ws = mfma16(af[mt][ks], sf[ks], ws);
                const f32x4 vn = (f32x4){lo_bf(uw[mt].x), hi_bf(uw[mt].x), lo_bf(uw[mt].y), hi_bf(uw[mt].y)} - ws;
                u32x2 vw; vw.x = pk2(vn[0], vn[1]); vw.y = pk2(vn[2], vn[3]);
                *(LAS u32x2*)(VNT + (16 * wave + r) * 144 + (16 * mt + 4 * kg) * 2) = vw; } }
        bf16x8 vf[2];
        {
            bf16x8 qf[4][4], tf[4][2];
#pragma unroll
            for (int mt = 0; mt < 4; ++mt) {
#pragma unroll
                for (int ks = 0; ks < 4; ++ks) qf[mt][ks] = *(const LAS bf16x8*)(QD + (16 * mt + r) * 272 + ks * 64 + kg * 16);
#pragma unroll
                for (int kc = 0; kc < 2; ++kc) tf[mt][kc] = *(const LAS bf16x8*)(ATT + (16 * mt + r) * 144 + kc * 64 + kg * 16); }
#pragma unroll
            for (int kc = 0; kc < 2; ++kc) vf[kc] = *(const LAS bf16x8*)(VNT + (16 * wave + r) * 144 + kc * 64 + kg * 16);
#pragma unroll
            for (int mt = 0; mt < 4; ++mt) { f32x4 a = (f32x4){0.f, 0.f, 0.f, 0.f};
#pragma unroll
                for (int ks = 0; ks < 4; ++ks) a = mfma16(qf[mt][ks], sf[ks], a);
#pragma unroll
                for (int kc = 0; kc < 2; ++kc) a = mfma16(tf[mt][kc], vf[kc], a);
                o[mt] = a; } }
        {
            bf16x8 kf[8][2];
#pragma unroll
            for (int dt = 0; dt < 8; ++dt)
#pragma unroll
                for (int kc = 0; kc < 2; ++kc) kf[dt][kc] = *(const LAS bf16x8*)(KDT + (16 * dt + r) * 144 + kc * 64 + kg * 16);
#pragma unroll
            for (int dt = 0; dt < 8; ++dt) { f32x4 a = S[dt] * egl;
#pragma unroll
                for (int kc = 0; kc < 2; ++kc) a = mfma16(kf[dt][kc], vf[kc], a);
                S[dt] = a; u32x2 sw; sw.x = pk2(a[0], a[1]); sw.y = pk2(a[2], a[3]);
                *(LAS u32x2*)(ST + (16 * wave + r) * 272 + (16 * dt + 4 * kg) * 2) = sw; } }
#pragma unroll
        for (int mt = 0; mt < 4; ++mt) { f32x4 q;
#pragma unroll
            for (int rr = 0; rr < 4; ++rr) q[rr] = row16_sum(o[mt][rr] * o[mt][rr]);
            if (r == 0) *(LAS f32x4*)(PS + wave * 64 + 16 * mt + 4 * kg) = q; }
        LDS_BARRIER();
    }
    LDS_BARRIER();
}
template <int MODE>
__device__ __forceinline__ void ssd_load(const Params& p, LAS unsigned char* lds, int layer, int b, int c, int grp) {
    const int tid = htid(), lane = tid & 63, wave = tid >> 6, t0 = c * 64;
    LAS float* DT = (LAS float*)(lds + 117760); LAS float* ACS = DT + 384;
    LAS unsigned char* XT = lds + 34816;
    if (wave < 6) { const int hh = grp * 6 + wave; const float* small = (const float*)(p.ws + WS_SMALL) + ((size_t)b * SEQ + t0 + lane) * 32;
        const float dt = softplusf_(small[12 + hh] + p.in[I_SSDTB][layer * 12 + hh]); float a = -expf(p.in[I_SSALOG][layer * 12 + hh]) * dt;
#pragma unroll
        for (int o = 1; o < 64; o <<= 1) { const float t = __shfl_up(a, o); if (lane >= o) a += t; }
        DT[wave * 64 + lane] = dt; ACS[wave * 64 + lane] = a; }
    LDS_BARRIER();
    const int cg = tid % 80, seg = tid / 80, ch8 = cg * 8;
    if (tid < 480 && (MODE == 1 || ch8 < 512)) {
        const int col = ch8 < 384 ? grp * 384 + ch8 : (ch8 < 512 ? 768 + grp * 128 + (ch8 - 384) : 1024 + grp * 128 + (ch8 - 512));
        const float* cw = p.in[I_SSCONV] + (size_t)layer * 4 * 1280 + col; const float* cb = p.in[I_SSCONVB] + layer * 1280 + col;
        f32x4 w[4][2], bias[2];
#pragma unroll
        for (int j = 0; j < 4; ++j) { w[j][0] = *(const f32x4*)(cw + j * 1280); w[j][1] = *(const f32x4*)(cw + j * 1280 + 4); }
        bias[0] = *(const f32x4*)cb; bias[1] = *(const f32x4*)(cb + 4);
        const bf16_t* proj = (const bf16_t*)(p.ws + WS_PSSM) + (size_t)b * SEQ * 2048 + col;
        const int ts = seg * 11, hi = ch8 >> 6;
        f32x4 xm[3][2];
#pragma unroll
        for (int i = 0; i < 3; ++i) { const int t = t0 + ts - 3 + i; xm[i][0] = (f32x4){0.f, 0.f, 0.f, 0.f}; xm[i][1] = xm[i][0]; if (t >= 0) ld_bf8(proj + (size_t)t * 2048, xm[i][0], xm[i][1]); }
#pragma unroll
        for (int i = 0; i < 11; ++i) { const int tk = ts + i;
            if (tk < 64) { f32x4 c0, c1; ld_bf8(proj + (size_t)(t0 + tk) * 2048, c0, c1);
                f32x4 a0 = bias[0] + w[3][0] * c0 + w[2][0] * xm[2][0] + w[1][0] * xm[1][0] + w[0][0] * xm[0][0];
                f32x4 a1 = bias[1] + w[3][1] * c1 + w[2][1] * xm[2][1] + w[1][1] * xm[1][1] + w[0][1] * xm[0][1];
                xm[0][0] = xm[1][0]; xm[0][1] = xm[1][1]; xm[1][0] = xm[2][0]; xm[1][1] = xm[2][1]; xm[2][0] = c0; xm[2][1] = c1;
#pragma unroll
                for (int q = 0; q < 4; ++q) { a0[q] = siluf_(a0[q]); a1[q] = siluf_(a1[q]); }
                if (ch8 < 384) { const float sc = MODE == 0 ? DT[hi * 64 + tk] * fexp(ACS[hi * 64 + 63] - ACS[hi * 64 + tk]) : DT[hi * 64 + tk];
#pragma unroll
                    for (int q = 0; q < 4; ++q) { const unsigned pw = pk2(a0[q] * sc, a1[q] * sc);
                        *(LAS bf16_t*)(XT + (ch8 + q) * 144 + tk * 2) = (bf16_t)(pw & 0xffffu); *(LAS bf16_t*)(XT + (ch8 + 4 + q) * 144 + tk * 2) = (bf16_t)(pw >> 16); } }
                else if (MODE == 0) {
#pragma unroll
                    for (int q = 0; q < 4; ++q) { const unsigned pw = pk2(a0[q], a1[q]);
                        *(LAS bf16_t*)(lds + (ch8 - 384 + q) * 144 + tk * 2) = (bf16_t)(pw & 0xffffu); *(LAS bf16_t*)(lds + (ch8 - 384 + 4 + q) * 144 + tk * 2) = (bf16_t)(pw >> 16); } }
                else { u32x4 pw; pw.x = pk2(a0[0], a0[1]); pw.y = pk2(a0[2], a0[3]); pw.z = pk2(a1[0], a1[1]); pw.w = pk2(a1[2], a1[3]);
                    *(LAS u32x4*)(lds + (ch8 < 512 ? 17408 + tk * 272 + (ch8 - 384) * 2 : tk * 272 + (ch8 - 512) * 2)) = pw; } } }
    }
    LDS_BARRIER();
}
__device__ __forceinline__ void ssd_states(const Params& p, LAS unsigned char* lds, int layer, int b, int c, int grp) {
    ssd_load<0>(p, lds, layer, b, c, grp);
    const int tid = htid(), lane = tid & 63, wave = tid >> 6, r = lane & 15, kg = lane >> 4;
    const LAS unsigned char* XT = lds + 34816; const LAS unsigned char* BT = lds; const LAS float* ACS = (const LAS float*)(lds + 117760) + 384;
    bf16_t* st = (bf16_t*)(p.ws + WS_SSST) + ((size_t)(b * 32 + c) * 12 + grp * 6) * 8192;
    for (int t4 = 0; t4 < 24; t4 += 4) {
        bf16x8 af[4][2], bfr[4][2];
#pragma unroll
        for (int q = 0; q < 4; ++q) { const int t = wave + 8 * (t4 + q), hi = t >> 5, mt = (t >> 3) & 3, nt = t & 7;
#pragma unroll
            for (int ks = 0; ks < 2; ++ks) { af[q][ks] = *(const LAS bf16x8*)(XT + (hi * 64 + 16 * mt + r) * 144 + ks * 64 + kg * 16); bfr[q][ks] = *(const LAS bf16x8*)(BT + (16 * nt + r) * 144 + ks * 64 + kg * 16); } }
#pragma unroll
        for (int q = 0; q < 4; ++q) { const int t = wave + 8 * (t4 + q), hi = t >> 5, mt = (t >> 3) & 3, nt = t & 7;
            f32x4 acc = (f32x4){0.f, 0.f, 0.f, 0.f};
#pragma unroll
            for (int ks = 0; ks < 2; ++ks) acc = mfma16(af[q][ks], bfr[q][ks], acc);
#pragma unroll
            for (int rr = 0; rr < 4; rr += 2) { bf16_t* so_ = st + (size_t)hi * 8192 + (16 * mt + 4 * kg + rr) * 128 + 16 * nt + r; ST2_BF(so_, so_ + 128, acc[rr], acc[rr + 1]); } }
    }
    if (tid < 6) ((float*)(p.ws + WS_SSCD))[(b * 32 + c) * 12 + grp * 6 + tid] = expf(ACS[tid * 64 + 63]);
    LDS_BARRIER();
}
__device__ __forceinline__ void ssd_scan(const Params& p, int first_blk, int nblk) {
    const int gt = ((int)blockIdx.x - first_blk) * 512 + htid(), NT = nblk * 512;
    const u32x2* st = (const u32x2*)(p.ws + WS_SSST); const float* cd = (const float*)(p.ws + WS_SSCD); u32x2* pv = (u32x2*)(p.ws + WS_SSPV);
    for (int v = gt; v < NB * 12 * 2048; v += NT) { const int b = v / (12 * 2048), h = (v / 2048) % 12, e = v % 2048;
        f32x4 run = (f32x4){0.f, 0.f, 0.f, 0.f};
        for (int c0 = 0; c0 < 32; c0 += 8) { u32x2 t[8];
#pragma unroll
            for (int i = 0; i < 8; ++i) t[i] = st[((size_t)(b * 32 + c0 + i) * 12 + h) * 2048 + e];
#pragma unroll
            for (int i = 0; i < 8; ++i) { u32x2 w; w.x = pk2(run[0], run[1]); w.y = pk2(run[2], run[3]); pv[((size_t)(b * 32 + c0 + i) * 12 + h) * 2048 + e] = w;
                run = run * cd[(b * 32 + c0 + i) * 12 + h] + (f32x4){lo_bf(t[i].x), hi_bf(t[i].x), lo_bf(t[i].y), hi_bf(t[i].y)}; } }
    }
}
__device__ __forceinline__ void ssd_out(const Params& p, LAS unsigned char* lds, int layer, int b, int c, int grp) {
    ssd_load<1>(p, lds, layer, b, c, grp);
    const int tid = htid(), lane = tid & 63, wave = tid >> 6, r = lane & 15, kg = lane >> 4, t0 = c * 64;
    const LAS unsigned char* CM = lds; const LAS unsigned char* BM = lds + 17408; const LAS unsigned char* XT = lds + 34816; LAS unsigned char* MH = lds + 90112;
    const LAS float* DT = (const LAS float*)(lds + 117760); const LAS float* ACS = DT + 384; LAS float* YG = (LAS float*)lds;
    const bf16_t* prev = (const bf16_t*)(p.ws + WS_SSPV) + ((size_t)(b * 32 + c) * 12 + grp * 6) * 8192;
    f32x4 cb[2];
    {   bf16x8 ca[2][4], cbf[2][4];
#pragma unroll
        for (int q = 0; q < 2; ++q) { const int t = wave * 2 + q, mt = t >> 2, nt = t & 3;
#pragma unroll
            for (int ks = 0; ks < 4; ++ks) { ca[q][ks] = *(const LAS bf16x8*)(CM + (16 * mt + r) * 272 + ks * 64 + kg * 16); cbf[q][ks] = *(const LAS bf16x8*)(BM + (16 * nt + r) * 272 + ks * 64 + kg * 16); } }
#pragma unroll
        for (int q = 0; q < 2; ++q) { f32x4 acc = (f32x4){0.f, 0.f, 0.f, 0.f};
#pragma unroll
            for (int ks = 0; ks < 4; ++ks) acc = mfma16(ca[q][ks], cbf[q][ks], acc);
            cb[q] = acc; } }
    f32x4 y[2][6];
#pragma unroll
    for (int half = 0; half < 2; ++half) {
#pragma unroll
        for (int q = 0; q < 2; ++q) { const int t = wave * 2 + q, mt = t >> 2, nt = t & 3, j = 16 * nt + r;
#pragma unroll
            for (int hl = 0; hl < 3; ++hl) { const int hi = 3 * half + hl; const float aj = ACS[hi * 64 + j];
#pragma unroll
                for (int rr = 0; rr < 4; ++rr) { const int i = 16 * mt + 4 * kg + rr; *(LAS bf16_t*)(MH + hl * 9216 + i * 144 + j * 2) = (bf16_t)f2bf((i >= j) ? cb[q][rr] * fexp(fminf(ACS[hi * 64 + i] - aj, 0.f)) : 0.f); } } }
        bf16x8 pf[6][4];
#pragma unroll
        for (int k = 0; k < 6; ++k) { const int t = wave + 8 * k, hl = t >> 4, nt = t & 3, hi = 3 * half + hl; const bf16_t* pr = prev + (size_t)hi * 8192 + (16 * nt + r) * 128 + kg * 8;
#pragma unroll
            for (int ks = 0; ks < 4; ++ks) pf[k][ks] = *(const bf16x8*)(pr + ks * 32); }
        LDS_BARRIER();
#pragma unroll
        for (int k = 0; k < 6; ++k) { const int t = wave + 8 * k, hl = t >> 4, mt = (t >> 2) & 3, nt = t & 3, hi = 3 * half + hl, hh = grp * 6 + hi;
            f32x4 acc = (f32x4){0.f, 0.f, 0.f, 0.f}, off = acc;
            bf16x8 mf[2], xf[2], cf[4];
#pragma unroll
            for (int ks = 0; ks < 2; ++ks) { mf[ks] = *(const LAS bf16x8*)(MH + hl * 9216 + (16 * mt + r) * 144 + ks * 64 + kg * 16); xf[ks] = *(const LAS bf16x8*)(XT + (hi * 64 + 16 * nt + r) * 144 + ks * 64 + kg * 16); }
#pragma unroll
            for (int ks = 0; ks < 4; ++ks) cf[ks] = *(const LAS bf16x8*)(CM + (16 * mt + r) * 272 + ks * 64 + kg * 16);
#pragma unroll
            for (int ks = 0; ks < 2; ++ks) acc = mfma16(mf[ks], xf[ks], acc);
#pragma unroll
            for (int ks = 0; ks < 4; ++ks) off = mfma16(cf[ks], pf[k][ks], off);
            const u32x2 xw = *(const LAS u32x2*)(XT + (hi * 64 + 16 * nt + r) * 144 + (16 * mt + 4 * kg) * 2); const float xs[4] = {lo_bf(xw.x), hi_bf(xw.x), lo_bf(xw.y), hi_bf(xw.y)};
            const float dsk = p.in[I_SSD][layer * 12 + hh];
#pragma unroll
            for (int rr = 0; rr < 4; ++rr) { const int i = 16 * mt + 4 * kg + rr; acc[rr] += fexp(ACS[hi * 64 + i]) * off[rr] + dsk * xs[rr] * __builtin_amdgcn_rcpf(fmaxf(DT[hi * 64 + i], 1e-30f)); }
            y[half][k] = acc; }
        LDS_BARRIER();
    }
    const bf16_t* zp = (const bf16_t*)(p.ws + WS_PSSM) + ((size_t)b * SEQ + t0) * 2048 + 1280 + grp * 384;
#pragma unroll
    for (int half = 0; half < 2; ++half)
#pragma unroll
        for (int k = 0; k < 6; ++k) { const int t = wave + 8 * k, hl = t >> 4, mt = (t >> 2) & 3, nt = t & 3, hi = 3 * half + hl, ch = hi * 64 + 16 * nt + r;
#pragma unroll
            for (int rr = 0; rr < 4; ++rr) { const int i = 16 * mt + 4 * kg + rr; const float z = bf2f(zp[(size_t)i * 2048 + ch]); YG[i * 388 + ch] = y[half][k][rr] * siluf_(z); } }
    LDS_BARRIER();
    const float* sn = p.in[I_SSNORM] + layer * 768 + grp * 384; bf16_t* yo = (bf16_t*)(p.ws + WS_YSSM) + ((size_t)b * SEQ + t0) * 768 + grp * 384;
#pragma unroll
    for (int i8 = 0; i8 < 8; ++i8) { const int i = 8 * wave + i8; float v[6], ss = 0.f;
#pragma unroll
        for (int k = 0; k < 6; ++k) { v[k] = YG[i * 388 + lane + 64 * k]; ss += v[k] * v[k]; }
        const float rs = rsqrtf(wave_sum(ss) * (1.f / 384.f) + EPS);
#pragma unroll
        for (int k = 0; k < 6; k += 2) ST2_BF(yo + (size_t)i * 768 + lane + 64 * k, yo + (size_t)i * 768 + lane + 64 * (k + 1), v[k] * rs * sn[lane + 64 * k], v[k + 1] * rs * sn[lane + 64 * (k + 1)]); }
    LDS_BARRIER();
}

typedef float f32x16 __attribute__((ext_vector_type(16)));
__device__ __forceinline__ void attn_tile(const Params& p, int b, int g, int j, int r, int qt, int lane) {
    const int d = g == 0 ? 1 : (g == 1 ? 4 : 16), L = SEQ / d, n = lane & 31, hw = lane >> 5;
    const int P0 = b * SEQ + r * L;
    const bf16_t* Q = (const bf16_t*)(p.ws + WS_QK) + (size_t)(0 * 3 + g) * TC * 256 + j * 64;
    const bf16_t* K = (const bf16_t*)(p.ws + WS_QK) + (size_t)(1 * 3 + g) * TC * 256 + j * 64;
    const bf16_t* V = (const bf16_t*)(p.ws + WS_VT) + (size_t)(g * 256 + j * 64) * TC;
    const float sl2 = exp2f(-8.f * (float)(4 * g + j + 1) / 12.f) * (float)d * 1.4426950408889634f;
    bf16x8 qf[4];
    { const bf16_t* qrow = Q + (size_t)(P0 + 32 * qt + n) * 256 + 8 * hw;
#pragma unroll
      for (int s = 0; s < 4; ++s) qf[s] = *(const bf16x8*)(qrow + 16 * s); }
    f32x16 o0, o1;
#pragma unroll
    for (int i = 0; i < 16; ++i) { o0[i] = 0.f; o1[i] = 0.f; }
    float mrun = -1e30f, lrun = 0.f;
    const int pim = (n & 0x13) | (((n >> 2) & 1) << 3) | (((n >> 3) & 1) << 2);
    const int qi = 32 * qt + n;
    const int kb0 = qt > 4 ? qt - 4 : 0;
    bf16x8 kf[4], vf[2][2];
    { const bf16_t* krow = K + (size_t)(P0 + 32 * kb0 + pim) * 256 + 8 * hw;
#pragma unroll
      for (int s = 0; s < 4; ++s) kf[s] = *(const bf16x8*)(krow + 16 * s);
#pragma unroll
      for (int sp = 0; sp < 2; ++sp)
#pragma unroll
          for (int dh = 0; dh < 2; ++dh) vf[sp][dh] = *(const bf16x8*)(V + (size_t)(32 * dh + n) * TC + P0 + 32 * kb0 + 16 * sp + 8 * hw); }
    for (int kb = kb0; kb <= qt; ++kb) {
        f32x16 st;
#pragma unroll
        for (int i = 0; i < 16; ++i) st[i] = 0.f;
#pragma unroll
        for (int s = 0; s < 4; ++s) st = __builtin_amdgcn_mfma_f32_32x32x16_bf16(kf[s], qf[s], st, 0, 0, 0);
        bf16x8 vc[2][2];
#pragma unroll
        for (int sp = 0; sp < 2; ++sp)
#pragma unroll
            for (int dh = 0; dh < 2; ++dh) vc[sp][dh] = vf[sp][dh];
        if (kb < qt) {
            const bf16_t* krow = K + (size_t)(P0 + 32 * (kb + 1) + pim) * 256 + 8 * hw;
#pragma unroll
            for (int s = 0; s < 4; ++s) kf[s] = *(const bf16x8*)(krow + 16 * s);
#pragma unroll
            for (int sp = 0; sp < 2; ++sp)
#pragma unroll
                for (int dh = 0; dh < 2; ++dh) vf[sp][dh] = *(const bf16x8*)(V + (size_t)(32 * dh + n) * TC + P0 + 32 * (kb + 1) + 16 * sp + 8 * hw);
        }
        float mx = -1e30f;
#pragma unroll
        for (int jj = 0; jj < 16; ++jj) { const int kidx = 32 * kb + 16 * (jj >> 3) + 8 * hw + 4 * ((jj >> 2) & 1) + (jj & 3); const int dl = qi - kidx;
            const float sc = (dl >= 0 && dl <= 128) ? st[jj] * 1.4426950408889634f - sl2 * (float)dl : -1e30f; st[jj] = sc; mx = fmaxf(mx, sc); }
        mx = fmaxf(mx, __shfl_xor(mx, 32));
        const float mnew = fmaxf(mrun, mx), alpha = __builtin_amdgcn_exp2f(mrun - mnew);
        float rs = 0.f;
#pragma unroll
        for (int jj = 0; jj < 16; ++jj) { const float pj = __builtin_amdgcn_exp2f(st[jj] - mnew); st[jj] = pj; rs += pj; }
        rs += __shfl_xor(rs, 32);
        lrun = lrun * alpha + rs; mrun = mnew;
#pragma unroll
        for (int i = 0; i < 16; ++i) { o0[i] *= alpha; o1[i] *= alpha; }
#pragma unroll
        for (int sp = 0; sp < 2; ++sp) {
            u32x4 pw; pw.x = pk2(st[8 * sp + 0], st[8 * sp + 1]); pw.y = pk2(st[8 * sp + 2], st[8 * sp + 3]); pw.z = pk2(st[8 * sp + 4], st[8 * sp + 5]); pw.w = pk2(st[8 * sp + 6], st[8 * sp + 7]);
            const bf16x8 pf = __builtin_bit_cast(bf16x8, pw);
            o0 = __builtin_amdgcn_mfma_f32_32x32x16_bf16(vc[sp][0], pf, o0, 0, 0, 0);
            o1 = __builtin_amdgcn_mfma_f32_32x32x16_bf16(vc[sp][1], pf, o1, 0, 0, 0);
        }
    }
    const float inv = 1.f / lrun;
    const int tok = b * SEQ + qi * d + r;
    bf16_t* og = (bf16_t*)(p.ws + WS_OG) + ((size_t)g * TC + tok) * 256 + j * 64 + 4 * hw;
#pragma unroll
    for (int q4 = 0; q4 < 4; ++q4) {
        u32x2 w0, w1; w0.x = pk2(o0[4 * q4] * inv, o0[4 * q4 + 1] * inv); w0.y = pk2(o0[4 * q4 + 2] * inv, o0[4 * q4 + 3] * inv);
        w1.x = pk2(o1[4 * q4] * inv, o1[4 * q4 + 1] * inv); w1.y = pk2(o1[4 * q4 + 2] * inv, o1[4 * q4 + 3] * inv);
        *(u32x2*)(og + 8 * q4) = w0; *(u32x2*)(og + 32 + 8 * q4) = w1;
    }
    if (hw == 0) ((float*)(p.ws + WS_LSE))[((size_t)g * TC + tok) * 4 + j] = (mrun + log2f(lrun)) * 0.6931471805599453f;
}
__device__ __forceinline__ void phase_attn_combine(const Params& p, int skip) {
    const int tid_ = htid(), lane = tid_ & 63, gw = ((int)blockIdx.x - skip) * 8 + (tid_ >> 6), NGW = ((int)gridDim.x - skip) * 8;
    const bf16_t* og = (const bf16_t*)(p.ws + WS_OG); const float* lse = (const float*)(p.ws + WS_LSE); bf16_t* ya = (bf16_t*)(p.ws + WS_YATT);
    for (int t = gw; t < TC; t += NGW) {
        const int j = lane >> 4;
        const float l0 = lse[((size_t)0 * TC + t) * 4 + j], l1 = lse[((size_t)1 * TC + t) * 4 + j], l2 = lse[((size_t)2 * TC + t) * 4 + j];
        const float M = fmaxf(l0, fmaxf(l1, l2)); float w0 = expf(l0 - M), w1 = expf(l1 - M), w2 = expf(l2 - M); const float iw = 1.f / (w0 + w1 + w2); w0 *= iw; w1 *= iw; w2 *= iw;
        const u32x2 a = *((const u32x2*)(og + ((size_t)0 * TC + t) * 256) + lane), bb = *((const u32x2*)(og + ((size_t)1 * TC + t) * 256) + lane), c = *((const u32x2*)(og + ((size_t)2 * TC + t) * 256) + lane);
        u32x2 o; o.x = pk2(w0 * lo_bf(a.x) + w1 * lo_bf(bb.x) + w2 * lo_bf(c.x), w0 * hi_bf(a.x) + w1 * hi_bf(bb.x) + w2 * hi_bf(c.x));
        o.y = pk2(w0 * lo_bf(a.y) + w1 * lo_bf(bb.y) + w2 * lo_bf(c.y), w0 * hi_bf(a.y) + w1 * hi_bf(bb.y) + w2 * hi_bf(c.y));
        *((u32x2*)(ya + (size_t)t * 256) + lane) = o;
    }
}
__device__ __forceinline__ void sub_barrier(unsigned* cnt, unsigned target) {
    asm volatile("s_waitcnt vmcnt(0)" ::: "memory");
    __syncthreads();
    if (threadIdx.x == 0) {
        __builtin_amdgcn_fence(__ATOMIC_RELEASE, "agent"); asm volatile("s_waitcnt vmcnt(0)" ::: "memory");
        (void)xb_add(cnt, 1u);
        unsigned sp = 0; while (xb_ld(cnt) < target) { __builtin_amdgcn_s_sleep(2); if (++sp > (1u << 24)) break; }
        __builtin_amdgcn_fence(__ATOMIC_ACQUIRE, "agent"); asm volatile("s_waitcnt vmcnt(0)" ::: "memory");
    }
    __syncthreads();
}
__device__ __forceinline__ void phase_mixers(const Params& p, LAS unsigned char* lds, int layer) {
    const int G = gridDim.x, NDP = NB * 32 * 6, NSS = NB * 32 * 2;
    for (int item = blockIdx.x; item < NDP + NSS; item += G) {
        if (item < NDP) dn_prep(p, lds, layer, item / 192, (item / 6) % 32, item % 6);
        else { const int it = item - NDP; ssd_states(p, lds, layer, it / 64, (it >> 1) & 31, it & 1); }
    }
}
__device__ __forceinline__ void phase_mixers2(const Params& p, LAS unsigned char* lds, int layer, int rep, unsigned* subcnt, bool use_bar2) {
    const int tid_ = htid(), lane = tid_ & 63, wave = tid_ >> 6, G = gridDim.x, nscan = NB * 6;
    const int ded = G > 2 * nscan ? nscan : 0;
    if ((int)blockIdx.x < ded) { if (!(MIX2_PROBE == 2 && rep > 0)) dn_scan(p, lds, layer, blockIdx.x / 6, blockIdx.x % 6); return; }
    if (MIX2_PROBE == 1 && rep > 0) return;
    if (ded == 0) for (int it = blockIdx.x; it < nscan; it += G) dn_scan(p, lds, layer, it / 6, it % 6);
    const int nb = G - ded, rb = (int)blockIdx.x - ded;
    for (int item = rb; item < NB * 3 * 4 * 64 / 8; item += nb) { const int w = item * 8 + wave;
        const int st = w & 63, jj = (w >> 6) & 3, gg = (w >> 8) % 3, bb = w / 768;
        const int dd = gg == 0 ? 1 : (gg == 1 ? 4 : 16), tiles = SEQ / dd / 32;
        attn_tile(p, bb, gg, jj, st / tiles, st % tiles, lane); }
    ssd_scan(p, ded, nb);
    if (use_bar2) { XcdBarrier bar2; bar2.bar = (unsigned*)(p.ws + WS_CTL) + CW_BAR2; bar2.x = xb_xcc_id(); bar2.st = (volatile LAS unsigned*)(lds + LDS_BYTES - 256) + 12; xcd_barrier(bar2, (unsigned)nb); } else sub_barrier(subcnt, (unsigned)(nb * (rep + 1)));
    for (int it = rb; it < NB * 32 * 2; it += nb) ssd_out(p, lds, layer, it / 64, (it >> 1) & 31, it & 1);
    phase_attn_combine(p, ded);
}

constexpr int NSTEPS = 1 + NCH * (1 + 8 + 11 + 1);
__global__ void __launch_bounds__(512, 2) hybrid_fwd(Params p) {
    extern __shared__ __attribute__((aligned(16))) unsigned char lds_raw[];
    LAS unsigned char* lds = (LAS unsigned char*)lds_raw;
    volatile LAS unsigned* MISC = (volatile LAS unsigned*)(lds + LDS_BYTES - 256);
    if (threadIdx.x < 64) MISC[threadIdx.x] = 0u;
    __syncthreads();
    const int G = gridDim.x, cid = blockIdx.x;
    unsigned char* ws = p.ws;
    XcdBarrier bar; bar.bar = (unsigned*)(ws + WS_CTL) + CW_BAR; bar.x = 0; bar.st = MISC + 8;
    if (p.s_hi - p.s_lo > 1) bar = xcd_barrier_post((unsigned*)(ws + WS_CTL) + CW_BAR, MISC + 8);
    const bool use_bar2 = (p.s_hi - p.s_lo == NSTEPS) && ((int)gridDim.x > 2 * NB * 6);
    if (use_bar2 && (int)blockIdx.x >= NB * 6 && threadIdx.x == 0) (void)xb_add((unsigned*)(ws + WS_CTL) + CW_BAR2 + XB_XCNT(xb_xcc_id()), 1u);
    const int lo = p.s_lo, hi = p.s_hi;
    int step = 0;
#define IN_STEP (step >= lo && step < hi)
#define END_STEP do { if (step >= lo && step + 1 < hi) xcd_barrier(bar); ++step; } while (0)
    bf16_t* xb = (bf16_t*)(ws + WS_XB); float* ssq = (float*)(ws + WS_SSQ);
    if (IN_STEP) for (int rep_ = 0; rep_ < (REP_PH == 0 ? 3 : 1); ++rep_, (rep_ < (REP_PH == 0 ? 3 : 1) ? xcd_barrier(bar) : (void)0)) phase_convert(p, lds);
    END_STEP;
    for (int chunk = 0; chunk < NCH; ++chunk) {
        float* xo = p.out + (size_t)chunk * TC * D;
        if (IN_STEP) phase_chunk_in(p, chunk);
        END_STEP;
        for (int layer = 0; layer < DEPTH; ++layer) {
            if (IN_STEP) for (int rep_ = 0; rep_ < (REP_PH == 2 ? 3 : 1); ++rep_, (rep_ < (REP_PH == 2 ? 3 : 1) ? xcd_barrier(bar) : (void)0)) {
                ProgIn P; P.S.init(TC / 256, INP / 256, G, cid); P.xb = layer == 0 ? xb : (const bf16_t*)(ws + WS_XB2); P.Wt = (const bf16_t*)(ws + WS_WIN) + (size_t)layer * INP * D; P.ssq = layer == 0 ? ssq : (const float*)(ws + WS_SSQ2);
                P.wsb = ws; P.pb = (const bf16_t*)(ws + WS_PB) + (size_t)layer * TC * PLE; P.wple = (const bf16_t*)(ws + WS_WPLE) + (size_t)layer * D * PLE;
                gemm_phase(lds, P);
            }
            END_STEP;
            if (IN_STEP) for (int rep_ = 0; rep_ < (REP_PH == 3 ? 3 : 1); ++rep_, (rep_ < (REP_PH == 3 ? 3 : 1) ? xcd_barrier(bar) : (void)0)) phase_mixers(p, lds, layer);
            END_STEP;
            if (IN_STEP) for (int rep_ = 0; rep_ < (REP_PH == 4 ? 3 : 1); ++rep_, (rep_ < (REP_PH == 4 ? 3 : 1) ? xcd_barrier(bar) : (void)0)) phase_mixers2(p, lds, layer, rep_, (unsigned*)(ws + WS_CTL) + CW_SUB + (chunk * 2 + layer) * 64, use_bar2);
            END_STEP;
            if (IN_STEP) for (int rep_ = 0; rep_ < (REP_PH == 6 ? 3 : 1); ++rep_, (rep_ < (REP_PH == 6 ? 3 : 1) ? xcd_barrier(bar) : (void)0)) {
                ProgMerge P; P.S.init(TC / 256, 4, G, cid); P.wsb = ws;
                P.wdn = (const bf16_t*)(ws + WS_WDN) + (size_t)layer * D * 768; P.wssm = (const bf16_t*)(ws + WS_WSSM) + (size_t)layer * D * 768; P.watt = (const bf16_t*)(ws + WS_WATT) + (size_t)layer * D * 256;
                gemm_phase(lds, P);
            }
            END_STEP;
            if (IN_STEP) {
                ProgResid P; P.S.init(TC / 256, 4, G, cid); P.A = (const bf16_t*)(ws + WS_MERGED); P.lda = 2048; P.nt = 16; P.Wt = (const bf16_t*)(ws + WS_WOUT) + (size_t)layer * D * D; P.ldb = 2048;
                P.xin = layer == 0 ? p.in[I_X] + (size_t)chunk * TC * D : xo; P.xout = xo; P.xb = xb; P.ssq = ssq; P.sc = 1.f; P.qx = 1;
                gemm_phase(lds, P);
            }
            END_STEP;
            if (layer == 0) {
                if (IN_STEP) for (int rep_ = 0; rep_ < (REP_PH == 8 ? 3 : 1); ++rep_, (rep_ < (REP_PH == 8 ? 3 : 1) ? xcd_barrier(bar) : (void)0)) {
                    ProgFfnGu P; P.S.init(TC / 256, 2 * FFN / 256, G, cid); P.xb = xb; P.Wt = (const bf16_t*)(ws + WS_WFGU); P.ssq = ssq; P.act = (bf16_t*)(ws + WS_ACT);
                    gemm_phase(lds, P);
                }
                END_STEP;
                if (IN_STEP) {
                    ProgResid P; P.S.init(TC / 256, 4, G, cid); P.A = (const bf16_t*)(ws + WS_ACT); P.lda = 2 * FFN; P.nt = FFN / 64; P.Wt = (const bf16_t*)(ws + WS_WFD); P.ldb = 2 * FFN;
                    P.xin = xo; P.xout = xo; P.xb = xb; P.ssq = ssq; P.sc = (DBG_ABL & 8) ? 0.f : 1.f; P.qx = 0;
                    gemm_phase(lds, P);
                }
                END_STEP;
            } else {
                if (IN_STEP) phase_router(p, chunk);
                END_STEP;
                if (IN_STEP) phase_slots(p, chunk);
                END_STEP;
                if (IN_STEP) for (int rep_ = 0; rep_ < (REP_PH == 12 ? 3 : 1); ++rep_, (rep_ < (REP_PH == 12 ? 3 : 1) ? xcd_barrier(bar) : (void)0)) {
                    ProgMoeGu P; P.S.init((const unsigned*)(ws + WS_CTL) + CW_CNT + chunk * 64, 2 * EXD / 256, G, cid); P.xb = xb; P.Wt = (const bf16_t*)(ws + WS_WMGU); P.ssq = ssq;
                    P.idx = (const int*)(ws + WS_ROUTE) + RT_IDX; P.act = (bf16_t*)(ws + WS_ACTM);
                    gemm_phase(lds, P);
                }
                END_STEP;
                if (IN_STEP) for (int rep_ = 0; rep_ < (REP_PH == 13 ? 3 : 1); ++rep_, (rep_ < (REP_PH == 13 ? 3 : 1) ? xcd_barrier(bar) : (void)0)) {
                    ProgMoeDown P; P.init((const unsigned*)(ws + WS_CTL) + CW_CNT + chunk * 64, G, cid); P.act = (const bf16_t*)(ws + WS_ACTM); P.Wt = (const bf16_t*)(ws + WS_WMD); P.ypair = (bf16_t*)(ws + WS_YPAIR); P.partk = (float*)(ws + WS_PARTK);
                    gemm_phase(lds, P);
                }
                END_STEP;
                if (IN_STEP) phase_combine(p, chunk);
                END_STEP;
            }
            if (IN_STEP) {
                ProgPle P; P.S.init(TC / 256, 4, G, cid); P.xb = xb; P.wpg = (const bf16_t*)(ws + WS_WPG) + (size_t)layer * D * D; P.pp = (const bf16_t*)(ws + WS_PP); P.ssq = ssq;
                P.x = xo; P.xbout = (bf16_t*)(ws + WS_XB2); P.ssqout = (float*)(ws + WS_SSQ2);
                gemm_phase(lds, P);
            }
            END_STEP;
        }
        if (IN_STEP) phase_final(p, chunk);
        END_STEP;
    }
#undef IN_STEP
#undef END_STEP
}

#if defined(DBG_REP_STEP)
__global__ void dbg_csum(const unsigned* buf, size_t n, unsigned long long* out) {
    unsigned long long a = 0;
    for (size_t i = (size_t)blockIdx.x * 256 + threadIdx.x; i < n; i += (size_t)gridDim.x * 256) a += (unsigned long long)buf[i] * (unsigned long long)((i % 1021) + 1);
    atomicAdd(out, a);
}
__global__ void dbg_verdict(float* out, const unsigned long long* cs, int R) {
    bool bad = false; for (int r = 1; r < R; ++r) bad = bad || (cs[r] != cs[0]);
    const float v = bad ? __builtin_nanf("") : 0.f; const size_t n = (size_t)BATCH * SEQ * D;
    for (size_t i = (size_t)blockIdx.x * 256 + threadIdx.x; i < n; i += (size_t)gridDim.x * 256) out[i] = v;
}
#endif
#if defined(DBG_STOP)
#ifndef DBG_DUMP
#define DBG_DUMP 0
#define DBG_DUMP_OFF 0
#endif
__global__ void dbg_fill(float* out, const unsigned short* buf, int dump) {
    const size_t n = (size_t)BATCH * SEQ * D, c0 = (size_t)TC * D;
    for (size_t i = (size_t)blockIdx.x * 256 + threadIdx.x; i < n; i += (size_t)gridDim.x * 256) {
        if (i >= c0) out[i] = 0.f; else if (dump) out[i] = __uint_as_float(((unsigned)buf[i]) << 16);
    }
}
#endif
extern "C" void kernel_launch(void* const* d_in, const int* in_sizes, int n_in, void* d_out, int out_size, void* d_ws, size_t ws_size, hipStream_t stream) {
    static int grid = 0;
    if (grid == 0) {
        if (n_in != 30 || out_size != BATCH * SEQ * D || ws_size < WS_END) { fprintf(stderr, "kernel_launch: unexpected shapes (n_in %d, out %d, ws %zu < %zu)\n", n_in, out_size, ws_size, (size_t)WS_END); grid = -1; return; }
        int dev = 0, cus = 0;
        if (hipGetDevice(&dev) != hipSuccess || hipDeviceGetAttribute(&cus, hipDeviceAttributeMultiprocessorCount, dev) != hipSuccess) { grid = -1; return; }
        if (hipFuncSetAttribute((const void*)hybrid_fwd, hipFuncAttributeMaxDynamicSharedMemorySize, LDS_BYTES) != hipSuccess) { fprintf(stderr, "kernel_launch: hipFuncSetAttribute failed\n"); grid = -1; return; }
        int per_cu = 0;
        if (hipOccupancyMaxActiveBlocksPerMultiprocessor(&per_cu, (const void*)hybrid_fwd, 512, LDS_BYTES) != hipSuccess || per_cu < 1) { fprintf(stderr, "kernel_launch: occupancy query says %d\n", per_cu); }
        (void)hipGetLastError();
        grid = cus;
    }
    if (grid < 0) return;
    (void)hipMemsetAsync((char*)d_ws + WS_CTL, 0, MiB, stream);
    Params p{};
    for (int i = 0; i < 30; ++i) p.in[i] = (const float*)d_in[i];
    p.out = (float*)d_out; p.ws = (unsigned char*)d_ws;
#if defined(DBG_REP_STEP)
    for (int s = 0; s < DBG_REP_STEP; ++s) { p.s_lo = s; p.s_hi = s + 1; hipLaunchKernelGGL(hybrid_fwd, dim3(grid), dim3(512), LDS_BYTES, stream, p); }
    unsigned long long* cs = (unsigned long long*)((char*)d_ws + WS_CTL + 512 * 1024);
    for (int r = 0; r < DBG_REP_N; ++r) { p.s_lo = DBG_REP_STEP; p.s_hi = DBG_REP_STEP + 1; hipLaunchKernelGGL(hybrid_fwd, dim3(grid), dim3(512), LDS_BYTES, stream, p);
        hipLaunchKernelGGL(dbg_csum, dim3(1024), dim3(256), 0, stream, (const unsigned*)((const char*)d_ws + DBG_REP_OFF), (size_t)(DBG_REP_BYTES) / 4, cs + r); }
    hipLaunchKernelGGL(dbg_verdict, dim3(2048), dim3(256), 0, stream, (float*)d_out, cs, (int)DBG_REP_N);
#elif defined(DBG_STOP)
    for (int s = 0; s < DBG_STOP; ++s) { p.s_lo = s; p.s_hi = s + 1; hipLaunchKernelGGL(hybrid_fwd, dim3(grid), dim3(512), LDS_BYTES, stream, p); }
    hipLaunchKernelGGL(dbg_fill, dim3(2048), dim3(256), 0, stream, (float*)d_out, (const unsigned short*)((const char*)d_ws + DBG_DUMP_OFF), (int)DBG_DUMP);
#elif ONE_LAUNCH
    p.s_lo = 0; p.s_hi = NSTEPS;
    hipLaunchKernelGGL(hybrid_fwd, dim3(grid), dim3(512), LDS_BYTES, stream, p);
#else
    for (int s = 0; s < NSTEPS; ++s) { p.s_lo = s; p.s_hi = s + 1; hipLaunchKernelGGL(hybrid_fwd, dim3(grid), dim3(512), LDS_BYTES, stream, p); }
#endif
}
```

```cpp
#include <hip/hip_runtime.h>
#include <cstdio>
#include <cstdint>

#define GAS __attribute__((address_space(1)))
#define LAS __attribute__((address_space(3)))
typedef unsigned short bf16_t;
typedef short bf16x8 __attribute__((ext_vector_type(8)));
typedef float f32x4 __attribute__((ext_vector_type(4)));
typedef float f32x2 __attribute__((ext_vector_type(2)));
typedef unsigned u32x4 __attribute__((ext_vector_type(4)));
typedef unsigned u32x2 __attribute__((ext_vector_type(2)));

#ifndef REP_PH
#define REP_PH -1
#endif
#ifndef EMU_FP8
#define EMU_FP8 0
#endif
#ifndef TPROBE_MASK
#define TPROBE_MASK 0u
#endif
#ifndef MIX2_PROBE
#define MIX2_PROBE 0
#endif
#ifndef DBG_ABL
#define DBG_ABL 0
#endif
#ifndef ONE_LAUNCH
#define ONE_LAUNCH 1
#endif

constexpr int D = 1024, BATCH = 32, SEQ = 2048, DEPTH = 2;
constexpr int PLE = 256;
constexpr float EPS = 1e-6f;
constexpr int FFN = 2816, NE = 8, EXD = 3584;
constexpr int C_DNZ = 2304, C_DNA = 3072, C_DNB = 3078, C_XBC = 3084, C_SSZ = 4364, C_SSDT = 5132, C_ATT = 5144, C_GATE = 7448, INW = 10520;
constexpr int NB = 8, TC = NB * SEQ, NCH = BATCH / NB;
constexpr int INP = 10752;
constexpr int MOE_SLOTS = 2 * TC + NE * 256;

constexpr size_t MiB = 1u << 20;
constexpr size_t WS_CTL = 0;
constexpr size_t WS_WIN = 1 * MiB;
constexpr size_t WS_WDN = WS_WIN + 42 * MiB;
constexpr size_t WS_WSSM = WS_WDN + 3 * MiB;
constexpr size_t WS_WATT = WS_WSSM + 3 * MiB;
constexpr size_t WS_WOUT = WS_WATT + 1 * MiB;
constexpr size_t WS_WFGU = WS_WOUT + 4 * MiB;
constexpr size_t WS_WFD = WS_WFGU + 11 * MiB;
constexpr size_t WS_WMGU = WS_WFD + 6 * MiB;
constexpr size_t WS_WMD = WS_WMGU + 112 * MiB;
constexpr size_t WS_WPG = WS_WMD + 56 * MiB;
constexpr size_t WS_WPLE = WS_WPG + 4 * MiB;
constexpr size_t WS_WR = WS_WPLE + 1 * MiB;
constexpr size_t WS_ACT0 = WS_WR + 1 * MiB;
constexpr size_t WS_XB = WS_ACT0;
constexpr size_t WS_SSQ = WS_XB + 32 * MiB;
constexpr size_t WS_PB = WS_SSQ + 1 * MiB;
constexpr size_t WS_ROUTE = WS_PB + 16 * MiB;
constexpr size_t WS_PART = WS_ROUTE + 1 * MiB;
constexpr size_t WS_PP = WS_PART;
constexpr size_t WS_MERGED = WS_PART + 64 * MiB;
constexpr size_t WS_Y = WS_MERGED + 32 * MiB;
constexpr size_t WS_YDN = WS_Y, WS_YSSM = WS_Y + 24 * MiB, WS_YATT = WS_Y + 48 * MiB, WS_OG = WS_Y + 56 * MiB, WS_LSE = WS_Y + 80 * MiB;
constexpr size_t WS_YPAIR = WS_Y;
constexpr size_t WS_PROJ = WS_Y + 81 * MiB;
constexpr size_t WS_PDN = WS_PROJ, WS_PSSM = WS_PDN + 96 * MiB, WS_SMALL = WS_PSSM + 64 * MiB, WS_QK = WS_SMALL + 2 * MiB, WS_VT = WS_QK + 48 * MiB, WS_GATES = WS_VT + 24 * MiB;
constexpr size_t WS_ACT = WS_PROJ, WS_ACTM = WS_PROJ;
constexpr int KSPL = 7, TAILMAX = 32;
constexpr size_t WS_PARTK = WS_PROJ + 256 * MiB;
static_assert((size_t)MOE_SLOTS * EXD * 2 <= 256 * MiB && WS_PARTK + (size_t)KSPL * (TAILMAX / 4) * 256 * 1024 * 4 <= WS_PROJ + 330 * MiB, "partk");
constexpr size_t WS_SCR = WS_PROJ + 330 * MiB;
constexpr size_t WS_XB2 = WS_SCR;
constexpr size_t WS_SSQ2 = WS_XB2 + 32 * MiB;
constexpr size_t WS_PART2 = WS_XB2 + 40 * MiB;
constexpr int DNS_ITEM = 73728;
constexpr size_t WS_DNS = WS_SCR + 40 * MiB;
constexpr size_t WS_DNEGL = WS_DNS + (size_t)NB * 32 * 6 * DNS_ITEM;
constexpr size_t WS_END = WS_SCR + 200 * MiB;
constexpr size_t WS_SSCD = WS_DNEGL + 8192;
static_assert(WS_SSCD + 16384 <= WS_END, "dn scratch");
constexpr size_t WS_SSPV = WS_SCR + 150 * MiB;
static_assert(WS_SSCD + 16384 <= WS_SSPV && WS_SSPV + 48 * MiB <= WS_END, "ssd prev");
constexpr size_t WS_SSST = WS_PART + 48 * MiB;
static_assert(WS_MERGED == WS_PART + 64 * MiB && (size_t)NB * 32 * 12 * 8192 * 2 <= 48 * MiB, "ssd states (bf16) sit in PART[48, 64) | MERGED, both idle during the mixers");
static_assert((size_t)MOE_SLOTS * EXD * 2 <= 330 * MiB, "moe act overlay");
static_assert((size_t)MOE_SLOTS * D * 2 <= 81 * MiB, "ypair overlay");
static_assert(WS_END <= 1024 * MiB, "workspace");
constexpr int RT_TOPE = 0, RT_TOPP = 2 * TC, RT_TOPW = 4 * TC, RT_TOPS = 6 * TC, RT_IDX = 8 * TC;
static_assert((size_t)(RT_IDX + MOE_SLOTS) * 4 <= MiB, "route");
constexpr int CW_BAR = 4096;
constexpr int CW_BAR2 = 8192;
constexpr int CW_SUB = 20480;
constexpr int CW_CNT = 16384;

constexpr int LDS_BYTES = 147456;
__device__ __forceinline__ int htid() { int t = threadIdx.x; asm volatile("" : "+v"(t)); return t; }
__device__ __forceinline__ float bf2f(bf16_t b) { return __uint_as_float(((unsigned)b) << 16); }
__device__ __forceinline__ unsigned f2bf(float f) { unsigned u = __float_as_uint(f); return (u + 0x7fffu + ((u >> 16) & 1u)) >> 16; }
typedef __bf16 bf16x2_t __attribute__((ext_vector_type(2)));
__device__ __forceinline__ unsigned pk2(float lo, float hi) { const f32x2 v = {lo, hi}; return __builtin_bit_cast(unsigned, __builtin_convertvector(v, bf16x2_t)); }
#define ST2_BF(PA, PB, A, B) do { const unsigned pw_ = pk2((A), (B)); *(PA) = (bf16_t)(pw_ & 0xffffu); *(PB) = (bf16_t)(pw_ >> 16); } while (0)
__device__ __forceinline__ float lo_bf(unsigned w) { return __uint_as_float(w << 16); }
__device__ __forceinline__ float hi_bf(unsigned w) { return __uint_as_float(w & 0xffff0000u); }
__device__ __forceinline__ float fexp(float x) { return __builtin_amdgcn_exp2f(x * 1.4426950408889634f); }
__device__ __forceinline__ float sigmoidf_(float x) { return __builtin_amdgcn_rcpf(1.f + fexp(-x)); }
__device__ __forceinline__ float siluf_(float x) { return x * sigmoidf_(x); }
__device__ __forceinline__ float softplusf_(float x) { const float e = fexp(x); return x > 20.f ? x : (x < -9.f ? e : __builtin_amdgcn_logf(1.f + e) * 0.6931471805599453f); }
__device__ __forceinline__ float q8(float v) {
    if (!EMU_FP8) return v;
    const float a = fabsf(v); float r;
    if (a < 0.015625f) r = rintf(a * 512.f) * (1.f / 512.f);
    else { unsigned u = __float_as_uint(a); u += 0x7FFFFu + ((u >> 20) & 1u); u &= ~0xFFFFFu; r = fminf(__uint_as_float(u), 448.f); }
    return copysignf(r, v);
}
__device__ __forceinline__ f32x4 q8v(f32x4 v) { return (f32x4){q8(v[0]), q8(v[1]), q8(v[2]), q8(v[3])}; }
__device__ __forceinline__ float wave_sum(float v) {
#pragma unroll
    for (int o = 1; o < 64; o <<= 1) v += __shfl_xor(v, o);
    return v;
}
__device__ __forceinline__ float wave_max(float v) {
#pragma unroll
    for (int o = 1; o < 64; o <<= 1) v = fmaxf(v, __shfl_xor(v, o));
    return v;
}
__device__ __forceinline__ float rstd_of(const float* ssq, int row) {
    const f32x4* p = (const f32x4*)(ssq + (size_t)row * 16);
    const f32x4 a = p[0], b = p[1], c = p[2], d = p[3];
    const float s = (((a.x + a.y) + (a.z + a.w)) + ((b.x + b.y) + (b.z + b.w))) + (((c.x + c.y) + (c.z + c.w)) + ((d.x + d.y) + (d.z + d.w)));
    return rsqrtf(s * (1.f / 1024.f) + EPS);
}
__device__ __forceinline__ int token_of_pos(int d, int p) {
    const int b = p >> 11, q = p & 2047;
    const int t = (d == 1) ? q : (d == 4) ? (4 * (q & 511) + (q >> 9)) : (16 * (q & 127) + (q >> 7));
    return b * 2048 + t;
}

#define XB_TMO      128
#define XB_XCNT(j)  (256  + 64 * (j))
#define XB_XSUB(j)  (1280 + 64 * (j))
#define XB_XGEN(j)  (2304 + 64 * (j))
#define XB_TOP      3328
#define XB_TOPGEN   3392
#define XCD_BAR_WORDS 3456
#define XB_SPIN_CAP (1u << 22)
__device__ __forceinline__ unsigned xb_ld(unsigned* p)              { return __hip_atomic_load(p, __ATOMIC_RELAXED, __HIP_MEMORY_SCOPE_AGENT); }
__device__ __forceinline__ unsigned xb_add(unsigned* p, unsigned v) { return __hip_atomic_fetch_add(p, v, __ATOMIC_RELAXED, __HIP_MEMORY_SCOPE_AGENT); }
__device__ __forceinline__ unsigned xb_xcc_id() { return (unsigned)__builtin_amdgcn_s_getreg((3 << 11) | 20) & 0xFu; }
#define XB_SPIN(cond, bar) do { unsigned _sp = 0; while (cond) { __builtin_amdgcn_s_sleep(1); \
    if ((++_sp & 255u) == 0u) { if (xb_ld(&(bar)[XB_TMO])) break; if (_sp > XB_SPIN_CAP) { atomicAdd(&(bar)[XB_TMO], 1u); break; } } } } while (0)
struct XcdBarrier { unsigned* bar; unsigned x; volatile LAS unsigned* st; };
__device__ __forceinline__ XcdBarrier xcd_barrier_post(unsigned* bar, volatile LAS unsigned* st) {
    XcdBarrier b; b.bar = bar; b.x = xb_xcc_id(); b.st = st;
    if (threadIdx.x == 0) (void)xb_add(&bar[XB_XCNT(b.x)], 1u);
    return b;
}
__device__ __forceinline__ void xcd_barrier_complete(unsigned* bar, unsigned x, unsigned& nloc, unsigned& nx, unsigned G) {
    unsigned sum, cnt, mine, sp = 0u;
    for (;;) {
        sum = 0u; cnt = 0u; mine = 0u;
#pragma unroll
        for (unsigned j = 0; j < 16; ++j) { const unsigned c = xb_ld(&bar[XB_XCNT(j)]); sum += c; cnt += (c > 0u) ? 1u : 0u; }
        mine = xb_ld(&bar[XB_XCNT(x)]);
        if (sum == G) break;
        __builtin_amdgcn_s_sleep(1);
        if ((++sp & 255u) == 0u) { if (xb_ld(&bar[XB_TMO])) break; if (sp > XB_SPIN_CAP) { atomicAdd(&bar[XB_TMO], 1u); break; } }
    }
    nloc = mine > 0u ? mine : 1u; nx = cnt > 0u ? cnt : 1u;
}
__device__ __forceinline__ void xcd_barrier(const XcdBarrier& b, unsigned nparts = 0u) {
    asm volatile("s_waitcnt vmcnt(0)" ::: "memory");
    __syncthreads();
    if (threadIdx.x == 0) {
        unsigned* bar = b.bar;
        __builtin_amdgcn_s_waitcnt(0);
        unsigned nloc = b.st[0], nx = b.st[1];
        if (nloc == 0u) { xcd_barrier_complete(bar, b.x, nloc, nx, nparts ? nparts : gridDim.x * gridDim.y * gridDim.z); b.st[0] = nloc; b.st[1] = nx; }
        const unsigned old = xb_add(&bar[XB_XSUB(b.x)], 1u);
        const unsigned gen = old / nloc;
        if (old + 1u == (gen + 1u) * nloc) {
            __builtin_amdgcn_fence(__ATOMIC_RELEASE, "agent");
            asm volatile("s_waitcnt vmcnt(0)" ::: "memory");
            const unsigned og = xb_add(&bar[XB_TOP], 1u);
            const unsigned tg = og / nx;
            if (og + 1u == (tg + 1u) * nx) xb_add(&bar[XB_TOPGEN], 1u);
            else XB_SPIN(xb_ld(&bar[XB_TOPGEN]) == tg, bar);
            __builtin_amdgcn_fence(__ATOMIC_ACQUIRE, "agent");
            xb_add(&bar[XB_XGEN(b.x)], 1u);
            asm volatile("s_waitcnt vmcnt(0)" ::: "memory");
        } else {
            XB_SPIN(xb_ld(&bar[XB_XGEN(b.x)]) == gen, bar);
            __builtin_amdgcn_fence(__ATOMIC_ACQUIRE, "agent");
            asm volatile("s_waitcnt vmcnt(0)" ::: "memory");
        }
    }
    __syncthreads();
}

constexpr int BM = 256, BK = 64, HALF = 128, HTB = HALF * BK * 2, STAGE_BYTES = 8 * HTB, NXCD = 8, WGM = 4;
__device__ __forceinline__ int lds_byte(int r, int c) { const int st = (r >> 4) * 2 + (c >> 5), rr = r & 15, cc = c & 31, ob = rr * 64 + cc * 2; return st * 1024 + (ob ^ (((ob >> 9) & 1) << 5)); }
__device__ __forceinline__ void stage_rc(int b, int& R, int& C) { const int st = b / 1024, sb = b % 1024, swz = sb ^ (((sb >> 9) & 1) << 5); R = (st >> 1) * 16 + swz / 64; C = (st & 1) * 32 + (swz % 64) / 2; }
__device__ __forceinline__ int perm32(int rho) { const int n = rho >> 4, i = rho & 15; return 8 * (i >> 2) + 4 * n + (i & 3); }

struct Unit { int pm, pn; };
struct StaticOrder {
    int nM, nN, nwg, G, c;
    __device__ __forceinline__ void init(int nM_, int nN_, int G_, int c_) { nM = nM_; nN = nN_; nwg = nM * nN; G = G_; c = c_; }
    __device__ __forceinline__ bool next(int i, Unit& u) const {
        const long L = (long)i * G + c; if (L >= nwg) return false;
        int wgid = (int)L; { const int q = nwg / NXCD, r = nwg % NXCD, xcd = wgid % NXCD, off = wgid / NXCD; wgid = (xcd < r ? xcd * (q + 1) : r * (q + 1) + (xcd - r) * q) + off; }
        const int nig = WGM * nN, gid = wgid / nig, fm = gid * WGM, gsz = (nM - fm) < WGM ? (nM - fm) : WGM;
        u.pm = fm + ((wgid % nig) % gsz); u.pn = (wgid % nig) / gsz; return true;
    }
};
struct GU { const char* A; const char* B; int lda, ldb, nt, mapA, mapB; const int* idx; int pm, pn, sub, aux; };
__device__ __forceinline__ unsigned row_off(int map, int RR, int ld, const int* idx) {
    int row;
    if (map == 0) row = RR;
    else if (map == 4) row = 4 * RR;
    else if (map == 16) row = 16 * (RR & 127) + (RR >> 7);
    else row = idx[RR];
    return (unsigned)row * (unsigned)ld;
}
template <class Prog>
__device__ __forceinline__ void gemm_phase(LAS unsigned char* lds, const Prog& P) {
    const int tid = htid(), wid = __builtin_amdgcn_readfirstlane(tid >> 6), lane = tid & 63, wr = wid >> 2, wc = wid & 3, fr = lane & 15, fq = lane >> 4;
    GU cur, nxt; int ui = 0;
    if (!P.unit(0, cur)) return;
    unsigned vA[4], vB[4];
#define G_SETV(u) do { int tz_ = threadIdx.x; asm volatile("" : "+v"(tz_)); int R0, C0, R1, C1; stage_rc(tz_ * 16, R0, C0); stage_rc(tz_ * 16 + 8192, R1, C1); \
        const int Rb0 = (R0 & ~31) + perm32(R0 & 31), Rb1 = (R1 & ~31) + perm32(R1 & 31); \
        vA[0] = row_off((u).mapA, R0, (u).lda, (u).idx) + C0 * 2; vA[1] = row_off((u).mapA, R1, (u).lda, (u).idx) + C1 * 2; \
        vA[2] = row_off((u).mapA, R0 + 128, (u).lda, (u).idx) + C0 * 2; vA[3] = row_off((u).mapA, R1 + 128, (u).lda, (u).idx) + C1 * 2; \
        vB[0] = row_off((u).mapB, Rb0, (u).ldb, nullptr) + C0 * 2; vB[1] = row_off((u).mapB, Rb1, (u).ldb, nullptr) + C1 * 2; \
        vB[2] = row_off((u).mapB, Rb0 + 128, (u).ldb, nullptr) + C0 * 2; vB[3] = row_off((u).mapB, Rb1 + 128, (u).ldb, nullptr) + C1 * 2; } while (0)
    G_SETV(cur);
    const unsigned ldsw = (unsigned)wid * 1024u;
    const int aoff = lds_byte(wr * 64 + fr, fq * 8), boff = lds_byte(wc * 32 + fr, fq * 8);
#define G_SA(b, h) (((b) * 2 + (h)) * HTB)
#define G_SB(b, h) ((4 + (b) * 2 + (h)) * HTB)
#define G_STAGE(bufoff, gbase, v, h) do { \
        __builtin_amdgcn_global_load_lds((const unsigned*)((gbase) + (v)[2 * (h)]), (LAS unsigned*)(lds + (bufoff) + ldsw), 16, 0, 0); \
        __builtin_amdgcn_global_load_lds((const unsigned*)((gbase) + (v)[2 * (h) + 1]), (LAS unsigned*)(lds + (bufoff) + ldsw + 8192), 16, 0, 0); } while (0)
#define G_LDA(dst, b, h) do { _Pragma("unroll") for (int m = 0; m < 4; ++m) _Pragma("unroll") for (int k = 0; k < 2; ++k) dst[m][k] = *(const LAS bf16x8*)(lds + G_SA(b, h) + aoff + m * 2048 + k * 1024); } while (0)
#define G_LDB(dst, b, h) do { _Pragma("unroll") for (int n = 0; n < 2; ++n) _Pragma("unroll") for (int k = 0; k < 2; ++k) dst[n][k] = *(const LAS bf16x8*)(lds + G_SB(b, h) + boff + n * 2048 + k * 1024); } while (0)
#define G_MMA(ai, bj, At, Bt) do { __builtin_amdgcn_s_setprio(1); _Pragma("unroll") for (int m = 0; m < 4; ++m) _Pragma("unroll") for (int n = 0; n < 2; ++n) _Pragma("unroll") for (int k = 0; k < 2; ++k) \
        acc[ai][bj][m][n] = __builtin_amdgcn_mfma_f32_16x16x32_bf16(Bt[n][k], At[m][k], acc[ai][bj][m][n], 0, 0, 0); __builtin_amdgcn_s_setprio(0); } while (0)
#define G_WAIT_V(n) asm volatile("s_waitcnt vmcnt(" #n ")" ::: "memory")
#define G_WAIT_L(n) asm volatile("s_waitcnt lgkmcnt(" #n ")" ::: "memory")
#define G_BAR __builtin_amdgcn_s_barrier()
#define G_SCHED __builtin_amdgcn_sched_barrier(0)
    f32x4 acc[2][2][4][2];
#pragma unroll
    for (int a = 0; a < 2; ++a)
#pragma unroll
        for (int b = 0; b < 2; ++b)
#pragma unroll
            for (int m = 0; m < 4; ++m)
#pragma unroll
                for (int n = 0; n < 2; ++n) acc[a][b][m][n] = (f32x4){0.f, 0.f, 0.f, 0.f};
    bf16x8 At[4][2], B0[2][2], B1[2][2];
    const char* cA = cur.A; const char* cB = cur.B;
    const size_t kstep = (size_t)(BK * 2);
    G_STAGE(G_SB(0, 0), cB, vB, 0); G_STAGE(G_SA(0, 0), cA, vA, 0); G_STAGE(G_SB(0, 1), cB, vB, 1); G_STAGE(G_SA(0, 1), cA, vA, 1);
    if (wr == 1) G_BAR;
    G_WAIT_V(4); G_BAR;
    G_STAGE(G_SB(1, 0), cB + kstep, vB, 0); G_STAGE(G_SA(1, 0), cA + kstep, vA, 0); G_STAGE(G_SB(1, 1), cB + kstep, vB, 1);
    G_WAIT_V(6); G_BAR;
    for (;;) {
        const bool has_next = P.unit(ui + 1, nxt);
        const char* nA = has_next ? nxt.A : cA; const char* nB = has_next ? nxt.B : cB;
        const int nt = cur.nt;
        for (int t = 0; t < nt; t += 2) {
            const bool last = (t == nt - 2);
            const char* a1 = cA + (size_t)(t + 1) * kstep;
            const char* a2 = last ? nA : cA + (size_t)(t + 2) * kstep; const char* b2 = last ? nB : cB + (size_t)(t + 2) * kstep;
            const char* a3 = a2 + kstep; const char* b3 = b2 + kstep;
            G_STAGE(G_SA(1, 1), a1, vA, 1);
            if (last && has_next) { G_SETV(nxt); }
            G_LDB(B0, 0, 0); G_SCHED; G_LDA(At, 0, 0);
            G_WAIT_L(8); G_BAR; G_WAIT_L(0); G_MMA(0, 0, At, B0); G_BAR; G_SCHED;
            G_LDB(B1, 0, 1); G_STAGE(G_SB(0, 0), b2, vB, 0);
            G_BAR; G_WAIT_L(0); G_MMA(0, 1, At, B1); G_BAR;
            G_LDA(At, 0, 1); G_STAGE(G_SA(0, 0), a2, vA, 0);
            G_BAR; G_WAIT_L(0); G_MMA(1, 0, At, B0); G_BAR; G_SCHED;
            G_STAGE(G_SB(0, 1), b2, vB, 1);
            G_WAIT_V(6); G_BAR; G_MMA(1, 1, At, B1); G_BAR;
            G_LDB(B0, 1, 0); G_SCHED; G_LDA(At, 1, 0); G_STAGE(G_SA(0, 1), a2, vA, 1);
            G_WAIT_L(8); G_BAR; G_WAIT_L(0); G_MMA(0, 0, At, B0); G_BAR; G_SCHED;
            G_LDB(B1, 1, 1); G_STAGE(G_SB(1, 0), b3, vB, 0);
            G_BAR; G_WAIT_L(0); G_MMA(0, 1, At, B1); G_BAR;
            G_LDA(At, 1, 1); G_STAGE(G_SA(1, 0), a3, vA, 0);
            G_BAR; G_WAIT_L(0); G_MMA(1, 0, At, B0); G_BAR; G_SCHED;
            G_STAGE(G_SB(1, 1), b3, vB, 1);
            G_WAIT_V(6); G_BAR; G_MMA(1, 1, At, B1); G_BAR;
        }
        { int tz_ = threadIdx.x; asm volatile("" : "+v"(tz_)); const int ln_ = tz_ & 63; P.epi(acc, cur, wr, wc, ln_ & 15, ln_ >> 4); }
        if (!has_next) break;
        if (!P.keep(cur))
#pragma unroll
        for (int a = 0; a < 2; ++a)
#pragma unroll
            for (int b = 0; b < 2; ++b)
#pragma unroll
                for (int m = 0; m < 4; ++m)
#pragma unroll
                    for (int n = 0; n < 2; ++n) acc[a][b][m][n] = (f32x4){0.f, 0.f, 0.f, 0.f};
        cur = nxt; cA = nA; cB = nB; ++ui;
    }
    G_WAIT_V(0);
    if (wr == 0) G_BAR;
    G_BAR;
#undef G_SETV
#undef G_SA
#undef G_SB
#undef G_STAGE
#undef G_LDA
#undef G_LDB
#undef G_MMA
#undef G_WAIT_V
#undef G_WAIT_L
#undef G_BAR
#undef G_SCHED
}

__device__ __forceinline__ void st_bf8(bf16_t* p, const f32x4 a, const f32x4 b) {
    u32x4 w; w.x = pk2(a[0], a[1]); w.y = pk2(a[2], a[3]); w.z = pk2(b[0], b[1]); w.w = pk2(b[2], b[3]);
    *(u32x4*)p = w;
}
__device__ __forceinline__ void ld_bf8(const bf16_t* p, f32x4& a, f32x4& b) {
    const u32x4 w = *(const u32x4*)p;
    a = (f32x4){lo_bf(w.x), hi_bf(w.x), lo_bf(w.y), hi_bf(w.y)}; b = (f32x4){lo_bf(w.z), hi_bf(w.z), lo_bf(w.w), hi_bf(w.w)};
}
__device__ __forceinline__ float sq8(const f32x4 a, const f32x4 b) { return ((a[0] * a[0] + a[1] * a[1]) + (a[2] * a[2] + a[3] * a[3])) + ((b[0] * b[0] + b[1] * b[1]) + (b[2] * b[2] + b[3] * b[3])); }

#define EPI_ROWS(ai, m) _Pragma("unroll") for (int ai = 0; ai < 2; ++ai) _Pragma("unroll") for (int m = 0; m < 4; ++m)
#define EPI_FENCE asm volatile("" ::: "memory")
#define EPI_SC(ai, m) __shfl((ai) ? r1_ : r0_, (m) * 16 + fr)

struct ProgIn {
    __device__ __forceinline__ bool keep(const GU&) const { return false; }
    StaticOrder S; const bf16_t* xb; const bf16_t* Wt; const float* ssq; unsigned char* wsb;
    const bf16_t* pb; const bf16_t* wple;
    __device__ __forceinline__ bool unit(int i, GU& u) const {
        Unit t;
        if (!S.next(i, t)) {
            const int rem = S.nwg % S.G, nfull = S.nwg / S.G, idle = rem == 0 ? S.G : S.G - rem, per = (256 + idle - 1) / idle;
            const int rk = rem == 0 ? S.c : S.c - rem, k = i - nfull;
            if (rk < 0 || k < 0 || k >= per) return false;
            const int pu = rk * per + k; if (pu >= 256) return false;
            u.pm = pu >> 2; u.pn = 64 + (pu & 3); u.sub = 0; u.aux = 0; u.nt = 4; u.idx = nullptr; u.lda = 512; u.ldb = 512; u.mapA = 0; u.mapB = 0;
            u.A = (const char*)pb + (size_t)(pu >> 2) * 256 * 512; u.B = (const char*)wple + (size_t)(pu & 3) * 256 * 512; return true;
        }
        u.pm = t.pm; u.pn = t.pn; u.sub = 0; u.aux = 0; u.nt = 16; u.idx = nullptr; u.lda = 2048; u.ldb = 2048;
        const char* w = (const char*)Wt + (size_t)t.pn * 256 * 2048;
        int g = 0; bool isvt = false;
        if (t.pn >= 20 && t.pn < 29) { g = (t.pn - 20) % 3; isvt = t.pn >= 26; }
        const int d = g == 0 ? 1 : (g == 1 ? 4 : 16);
        const int b = t.pm >> 3, tb = t.pm & 7;
        const int base = b * 2048 + (d == 1 ? 256 * tb : d == 4 ? 1024 * (tb & 1) + (tb >> 1) : 2 * tb);
        const char* x = (const char*)xb + (size_t)base * 2048;
        const int mapx = d == 1 ? 0 : d;
        if (!isvt) { u.A = x; u.mapA = mapx; u.B = w; u.mapB = 0; }
        else { u.A = w; u.mapA = 0; u.B = x; u.mapB = mapx; }
        return true;
    }
    __device__ __forceinline__ void epi(f32x4 (&acc)[2][2][4][2], const GU& u, int wr, int wc, int fr, int fq) const {
        const int pn = u.pn, pm = u.pm, rl0 = wr * 64 + fr, cl0 = wc * 32 + 8 * fq;
        if (pn >= 64) {
            EPI_ROWS(ai, m) { bf16_t* o = (bf16_t*)(wsb + WS_PP) + (size_t)(pm * 256 + ai * 128 + m * 16 + rl0) * 1024 + (pn - 64) * 256 + cl0;
#pragma unroll
                for (int bj = 0; bj < 2; ++bj) st_bf8(o + bj * 128, acc[ai][bj][m][0], acc[ai][bj][m][1]); }
            return;
        }
        if (pn >= 26 && pn < 29) {
            const int g = pn - 26, d = g == 0 ? 1 : (g == 1 ? 4 : 16), ln = fq * 16 + fr;
            const float rc = rstd_of(ssq, token_of_pos(d, pm * 256 + (ln >> 5) * 128 + wc * 32 + (ln & 31)));
            f32x4 s[2][2];
#pragma unroll
            for (int bj = 0; bj < 2; ++bj)
#pragma unroll
                for (int j = 0; j < 8; ++j) s[bj][j >> 2][j & 3] = __shfl(rc, bj * 32 + 8 * fq + j);
            EPI_ROWS(ai, m) { const int ch = ai * 128 + m * 16 + rl0; bf16_t* o = (bf16_t*)(wsb + WS_VT) + (size_t)(g * 256 + ch) * TC + pm * 256 + cl0;
#pragma unroll
                for (int bj = 0; bj < 2; ++bj) st_bf8(o + bj * 128, acc[ai][bj][m][0] * s[bj][0], acc[ai][bj][m][1] * s[bj][1]); }
            return;
        }
        int d = 1; if (pn >= 20 && pn < 26) { const int g = (pn - 20) % 3; d = g == 0 ? 1 : (g == 1 ? 4 : 16); }
        const float r0_ = rstd_of(ssq, token_of_pos(d, pm * 256 + fq * 16 + rl0)), r1_ = rstd_of(ssq, token_of_pos(d, pm * 256 + 128 + fq * 16 + rl0));
        if (pn < 20) {
            bf16_t* base = pn < 12 ? (bf16_t*)(wsb + WS_PDN) + pn * 256 : (bf16_t*)(wsb + WS_PSSM) + (pn - 12) * 256; const int ld = pn < 12 ? 3072 : 2048;
            EPI_ROWS(ai, m) { const int row = pm * 256 + ai * 128 + m * 16 + rl0; const float s = EPI_SC(ai, m); bf16_t* o = base + (size_t)row * ld + cl0;
#pragma unroll
                for (int bj = 0; bj < 2; ++bj) st_bf8(o + bj * 128, acc[ai][bj][m][0] * s, acc[ai][bj][m][1] * s); }
        } else if (pn < 26) {
            const int which = (pn - 20) / 3, g = (pn - 20) % 3; const float qs = which == 0 ? 0.125f : 1.f;
            bf16_t* base = (bf16_t*)(wsb + WS_QK) + (size_t)(which * 3 + g) * TC * 256;
            EPI_ROWS(ai, m) { const int p = pm * 256 + ai * 128 + m * 16 + rl0; const float s = EPI_SC(ai, m) * qs; bf16_t* o = base + (size_t)p * 256 + cl0;
#pragma unroll
                for (int bj = 0; bj < 2; ++bj) st_bf8(o + bj * 128, acc[ai][bj][m][0] * s, acc[ai][bj][m][1] * s); }
        } else if (pn < 41) {
            bf16_t* base = (bf16_t*)(wsb + WS_GATES) + (pn - 29) * 256;
            EPI_ROWS(ai, m) { const int row = pm * 256 + ai * 128 + m * 16 + rl0; const float s = EPI_SC(ai, m); bf16_t* o = base + (size_t)row * 3072 + cl0;
#pragma unroll
                for (int bj = 0; bj < 2; ++bj) { f32x4 a = acc[ai][bj][m][0] * s, b = acc[ai][bj][m][1] * s;
#pragma unroll
                    for (int j = 0; j < 4; ++j) { a[j] = sigmoidf_(a[j]); b[j] = sigmoidf_(b[j]); }
                    st_bf8(o + bj * 128, a, b); } }
        } else {
            EPI_ROWS(ai, m) { const int row = pm * 256 + ai * 128 + m * 16 + rl0; const float s = EPI_SC(ai, m);
                if (wc == 0) { float* o = (float*)(wsb + WS_SMALL) + (size_t)row * 32 + 8 * fq; *(f32x4*)o = acc[ai][0][m][0] * s; *(f32x4*)(o + 4) = acc[ai][0][m][1] * s; } }
        }
    }
};

struct ProgMerge {
    StaticOrder S; const bf16_t *wdn, *wssm, *watt; unsigned char* wsb;
    __device__ __forceinline__ bool keep(const GU& u) const { return u.sub < 2; }
    __device__ __forceinline__ bool unit(int i, GU& u) const {
        Unit t; if (!S.next(i / 3, t)) return false;
        const int sub = i % 3;
        u.pm = t.pm; u.pn = t.pn; u.sub = sub; u.aux = 0; u.idx = nullptr; u.mapA = 0; u.mapB = 0;
        if (sub < 2) { u.lda = 1536; u.ldb = 1536; u.nt = 12; u.A = (const char*)(wsb + (sub == 0 ? WS_YDN : WS_YSSM)) + (size_t)t.pm * 256 * 1536; u.B = (const char*)(sub == 0 ? wdn : wssm) + (size_t)t.pn * 256 * 1536; }
        else { u.lda = 512; u.ldb = 512; u.nt = 4; u.A = (const char*)(wsb + WS_YATT) + (size_t)t.pm * 256 * 512; u.B = (const char*)watt + (size_t)t.pn * 256 * 512; }
        return true;
    }
    __device__ __forceinline__ void epi(f32x4 (&acc)[2][2][4][2], const GU& u, int wr, int wc, int fr, int fq) const {
        const int rl0 = wr * 64 + fr, cl0 = wc * 32 + 8 * fq, sub = u.sub;
        const bf16_t* gp0 = (const bf16_t*)(wsb + WS_GATES) + (size_t)(u.pm * 256 + rl0) * 3072 + u.pn * 256 + cl0 + sub * 1024;
#pragma unroll
        for (int ai = 0; ai < 2; ++ai) {
            u32x4 gw[4][2], hw[4][2];
            if (sub < 2) {
#pragma unroll
                for (int m = 0; m < 4; ++m)
#pragma unroll
                    for (int bj = 0; bj < 2; ++bj) { const bf16_t* gp = gp0 + (size_t)(ai * 128 + m * 16) * 3072 + bj * 128; gw[m][bj] = *(const u32x4*)gp; hw[m][bj] = *(const u32x4*)(gp + 1024); }
            } else {
#pragma unroll
                for (int m = 0; m < 4; ++m)
#pragma unroll
                    for (int bj = 0; bj < 2; ++bj) { const bf16_t* gp = gp0 + (size_t)(ai * 128 + m * 16) * 3072 + bj * 128; gw[m][bj] = *(const u32x4*)gp; hw[m][bj] = gw[m][bj]; }
            }
#pragma unroll
            for (int m = 0; m < 4; ++m)
#pragma unroll
                for (int bj = 0; bj < 2; ++bj) { const int row = u.pm * 256 + ai * 128 + m * 16 + rl0, col = u.pn * 256 + bj * 128 + cl0;
                    f32x4 g0 = (f32x4){lo_bf(gw[m][bj].x), hi_bf(gw[m][bj].x), lo_bf(gw[m][bj].y), hi_bf(gw[m][bj].y)}, g1 = (f32x4){lo_bf(gw[m][bj].z), hi_bf(gw[m][bj].z), lo_bf(gw[m][bj].w), hi_bf(gw[m][bj].w)};
                    if ((DBG_ABL >> sub) & 1) { acc[ai][bj][m][0] = (f32x4){0.f, 0.f, 0.f, 0.f}; acc[ai][bj][m][1] = acc[ai][bj][m][0]; }
#pragma unroll
                    for (int j = 0; j < 4; ++j) { g0[j] = fmaxf(g0[j], 1e-8f); g1[j] = fmaxf(g1[j], 1e-8f); }
                    if (sub < 2) { const f32x4 h0 = (f32x4){lo_bf(hw[m][bj].x), hi_bf(hw[m][bj].x), lo_bf(hw[m][bj].y), hi_bf(hw[m][bj].y)}, h1 = (f32x4){lo_bf(hw[m][bj].z), hi_bf(hw[m][bj].z), lo_bf(hw[m][bj].w), hi_bf(hw[m][bj].w)};
#pragma unroll
                        for (int j = 0; j < 4; ++j) { acc[ai][bj][m][0][j] *= g0[j] * __builtin_amdgcn_rcpf(fmaxf(h0[j], 1e-8f)); acc[ai][bj][m][1][j] *= g1[j] * __builtin_amdgcn_rcpf(fmaxf(h1[j], 1e-8f)); } }
                    else st_bf8((bf16_t*)(wsb + WS_MERGED) + (size_t)row * 1024 + col, acc[ai][bj][m][0] * g0, acc[ai][bj][m][1] * g1); }
            EPI_FENCE;
        }
    }
};

struct ProgResid {
    __device__ __forceinline__ bool keep(const GU&) const { return false; }
    StaticOrder S; const bf16_t* A; int lda, nt; const bf16_t* Wt; int ldb; const float* xin; float* xout; bf16_t* xb; float* ssq; float sc; int qx;
    __device__ __forceinline__ bool unit(int i, GU& u) const {
        Unit t; if (!S.next(i, t)) return false;
        u.pm = t.pm; u.pn = t.pn; u.sub = 0; u.aux = 0; u.idx = nullptr; u.mapA = 0; u.mapB = 0; u.lda = lda; u.ldb = ldb; u.nt = nt;
        u.A = (const char*)A + (size_t)t.pm * 256 * lda; u.B = (const char*)Wt + (size_t)t.pn * 256 * ldb; return true;
    }
    __device__ __forceinline__ void epi(f32x4 (&acc)[2][2][4][2], const GU& u, int wr, int wc, int fr, int fq) const {
        const int rl0 = wr * 64 + fr, cl0 = wc * 32 + 8 * fq;
#pragma unroll
        for (int ai = 0; ai < 2; ++ai) {
            f32x4 xv[4][2][2];
#pragma unroll
            for (int m = 0; m < 4; ++m)
#pragma unroll
                for (int bj = 0; bj < 2; ++bj) { const size_t o = (size_t)(u.pm * 256 + ai * 128 + m * 16 + rl0) * 1024 + u.pn * 256 + bj * 128 + cl0; xv[m][bj][0] = *(const f32x4*)(xin + o); xv[m][bj][1] = *(const f32x4*)(xin + o + 4); }
#pragma unroll
            for (int m = 0; m < 4; ++m) { const int row = u.pm * 256 + ai * 128 + m * 16 + rl0; float ss = 0.f;
#pragma unroll
                for (int bj = 0; bj < 2; ++bj) { const size_t o = (size_t)row * 1024 + u.pn * 256 + bj * 128 + cl0;
                    const f32x4 v0 = acc[ai][bj][m][0] * sc + xv[m][bj][0], v1 = acc[ai][bj][m][1] * sc + xv[m][bj][1];
                    *(f32x4*)(xout + o) = v0; *(f32x4*)(xout + o + 4) = v1; if (qx) st_bf8(xb + o, q8v(v0), q8v(v1)); else st_bf8(xb + o, v0, v1); ss += sq8(v0, v1); }
                ss += __shfl_xor(ss, 16); ss += __shfl_xor(ss, 32);
                if (fq == 0) ssq[(size_t)row * 16 + u.pn * 4 + wc] = ss; }
            EPI_FENCE;
        }
    }
};

struct ProgFfnGu {
    __device__ __forceinline__ bool keep(const GU&) const { return false; }
    StaticOrder S; const bf16_t* xb; const bf16_t* Wt; const float* ssq; bf16_t* act;
    __device__ __forceinline__ bool unit(int i, GU& u) const {
        Unit t; if (!S.next(i, t)) return false;
        u.pm = t.pm; u.pn = t.pn; u.sub = 0; u.aux = 0; u.idx = nullptr; u.mapA = 0; u.mapB = 0; u.lda = 2048; u.ldb = 2048; u.nt = 16;
        u.A = (const char*)xb + (size_t)t.pm * 256 * 2048; u.B = (const char*)Wt + (size_t)t.pn * 256 * 2048; return true;
    }
    __device__ __forceinline__ void epi(f32x4 (&acc)[2][2][4][2], const GU& u, int wr, int wc, int fr, int fq) const {
        const int rl0 = wr * 64 + fr, cl0 = wc * 32 + 8 * fq;
        const float r0_ = rstd_of(ssq, u.pm * 256 + fq * 16 + rl0), r1_ = rstd_of(ssq, u.pm * 256 + 128 + fq * 16 + rl0);
        EPI_ROWS(ai, m) { const int row = u.pm * 256 + ai * 128 + m * 16 + rl0; const float s = EPI_SC(ai, m);
            f32x4 o[2];
#pragma unroll
            for (int n = 0; n < 2; ++n)
#pragma unroll
                for (int j = 0; j < 4; ++j) { const float g = acc[ai][0][m][n][j] * s, up = acc[ai][1][m][n][j] * s; o[n][j] = q8(siluf_(g) * up); }
            st_bf8(act + (size_t)row * FFN + u.pn * 128 + cl0, o[0], o[1]); }
    }
};

struct ProgPle {
    __device__ __forceinline__ bool keep(const GU&) const { return false; }
    StaticOrder S; const bf16_t *xb, *wpg, *pp; const float* ssq; float* x; bf16_t* xbout; float* ssqout;
    __device__ __forceinline__ bool unit(int i, GU& u) const {
        Unit t; if (!S.next(i, t)) return false;
        u.pm = t.pm; u.pn = t.pn; u.sub = 0; u.aux = 0; u.idx = nullptr; u.mapA = 0; u.mapB = 0; u.lda = 2048; u.ldb = 2048; u.nt = 16;
        u.A = (const char*)xb + (size_t)t.pm * 256 * 2048; u.B = (const char*)wpg + (size_t)t.pn * 256 * 2048; return true;
    }
    __device__ __forceinline__ void epi(f32x4 (&acc)[2][2][4][2], const GU& u, int wr, int wc, int fr, int fq) const {
        const int rl0 = wr * 64 + fr, cl0 = wc * 32 + 8 * fq; const float ps = (DBG_ABL & 32) ? 0.f : 1.f;
        const float r0_ = rstd_of(ssq, u.pm * 256 + fq * 16 + rl0), r1_ = rstd_of(ssq, u.pm * 256 + 128 + fq * 16 + rl0);
#pragma unroll
        for (int ai = 0; ai < 2; ++ai)
#pragma unroll
            for (int mh = 0; mh < 2; ++mh) {
                f32x4 xv[2][2][2]; u32x4 gw[2][2];
#pragma unroll
                for (int m2 = 0; m2 < 2; ++m2)
#pragma unroll
                    for (int bj = 0; bj < 2; ++bj) { const size_t o = (size_t)(u.pm * 256 + ai * 128 + (2 * mh + m2) * 16 + rl0) * 1024 + u.pn * 256 + bj * 128 + cl0;
                        xv[m2][bj][0] = *(const f32x4*)(x + o); xv[m2][bj][1] = *(const f32x4*)(x + o + 4); gw[m2][bj] = *(const u32x4*)(pp + o); }
#pragma unroll
                for (int m2 = 0; m2 < 2; ++m2) { const int m = 2 * mh + m2, row = u.pm * 256 + ai * 128 + m * 16 + rl0; const float sc = EPI_SC(ai, m); float ss = 0.f;
#pragma unroll
                    for (int bj = 0; bj < 2; ++bj) { const size_t o = (size_t)row * 1024 + u.pn * 256 + bj * 128 + cl0; const u32x4 w = gw[m2][bj];
                        const f32x4 p0 = (f32x4){lo_bf(w.x), hi_bf(w.x), lo_bf(w.y), hi_bf(w.y)}, p1 = (f32x4){lo_bf(w.z), hi_bf(w.z), lo_bf(w.w), hi_bf(w.w)};
                        f32x4 g0 = acc[ai][bj][m][0] * sc, g1 = acc[ai][bj][m][1] * sc;
#pragma unroll
                        for (int j = 0; j < 4; ++j) { g0[j] = sigmoidf_(g0[j]); g1[j] = sigmoidf_(g1[j]); }
                        const f32x4 v0 = xv[m2][bj][0] + p0 * ps * g0, v1 = xv[m2][bj][1] + p1 * ps * g1;
                        *(f32x4*)(x + o) = v0; *(f32x4*)(x + o + 4) = v1; st_bf8(xbout + o, v0, v1); ss += sq8(v0, v1); }
                    ss += __shfl_xor(ss, 16); ss += __shfl_xor(ss, 32);
                    if (fq == 0) ssqout[(size_t)row * 16 + u.pn * 4 + wc] = ss; }
                EPI_FENCE;
            }
    }
};

struct MoeOrder {
    int tl[NE]; int nN, total, G, c;
    __device__ __forceinline__ void init(const unsigned* cnt, int nN_, int G_, int c_) {
        nN = nN_; G = G_; c = c_; int tt = 0;
#pragma unroll
        for (int e = 0; e < NE; ++e) { tl[e] = (int)((__builtin_amdgcn_readfirstlane(cnt[e]) + 255u) >> 8); tt += tl[e]; }
        total = tt * nN;
    }
    __device__ __forceinline__ bool next(int i, int& e, int& pml, int& pn, int& slot0) const {
        const long L = (long)i * G + c; if (L >= total) return false;
        int wgid = (int)L; { const int q = total / NXCD, r = total % NXCD, xcd = wgid % NXCD, off = wgid / NXCD; wgid = (xcd < r ? xcd * (q + 1) : r * (q + 1) + (xcd - r) * q) + off; }
        int ee = 0, ubase = 0, tbase = 0, nMe = tl[0], uacc = 0, tacc = 0;
#pragma unroll
        for (int k = 0; k < NE; ++k) { if (wgid >= uacc) { ee = k; ubase = uacc; tbase = tacc; nMe = tl[k]; } uacc += tl[k] * nN; tacc += tl[k]; }
        const int li = wgid - ubase, nig = WGM * nN, gid = li / nig, fm = gid * WGM, gsz = (nMe - fm) < WGM ? (nMe - fm) : WGM;
        pml = fm + ((li % nig) % gsz); pn = (li % nig) / gsz; e = ee; slot0 = (tbase + pml) * 256; return true;
    }
};
struct ProgMoeGu {
    __device__ __forceinline__ bool keep(const GU&) const { return false; }
    MoeOrder S; const bf16_t* xb; const bf16_t* Wt; const float* ssq; const int* idx; bf16_t* act;
    __device__ __forceinline__ bool unit(int i, GU& u) const {
        int e, pml, pn, slot0; if (!S.next(i, e, pml, pn, slot0)) return false;
        u.pm = slot0; u.pn = pn; u.sub = 0; u.aux = e; u.idx = idx + slot0; u.mapA = 99; u.mapB = 0; u.lda = 2048; u.ldb = 2048; u.nt = 16;
        u.A = (const char*)xb; u.B = (const char*)Wt + ((size_t)e * 7168 + (size_t)pn * 256) * 2048; return true;
    }
    __device__ __forceinline__ void epi(f32x4 (&acc)[2][2][4][2], const GU& u, int wr, int wc, int fr, int fq) const {
        const int rl0 = wr * 64 + fr, cl0 = wc * 32 + 8 * fq;
        const float r0_ = rstd_of(ssq, idx[u.pm + fq * 16 + rl0]), r1_ = rstd_of(ssq, idx[u.pm + 128 + fq * 16 + rl0]);
        EPI_ROWS(ai, m) { const int slot = u.pm + ai * 128 + m * 16 + rl0; const float s = EPI_SC(ai, m);
            f32x4 o[2];
#pragma unroll
            for (int n = 0; n < 2; ++n)
#pragma unroll
                for (int j = 0; j < 4; ++j) { const float g = acc[ai][0][m][n][j] * s, up = acc[ai][1][m][n][j] * s; o[n][j] = q8(siluf_(g) * up); }
            st_bf8(act + (size_t)slot * EXD + u.pn * 128 + cl0, o[0], o[1]); }
    }
};
struct MoeDownPlan { int ntiles, main, tail; };
__device__ __forceinline__ MoeDownPlan moe_down_plan(const unsigned* cnt, int G) {
    MoeDownPlan pl; int nt = 0;
#pragma unroll
    for (int e = 0; e < NE; ++e) nt += (int)((__builtin_amdgcn_readfirstlane(cnt[e]) + 255u) >> 8);
    const int U = 4 * nt; int tail = U % G; if (U < G || tail > TAILMAX) tail = 0;
    pl.ntiles = nt; pl.tail = tail; pl.main = U - tail; return pl;
}
struct ProgMoeDown {
    __device__ __forceinline__ bool keep(const GU&) const { return false; }
    int tl[NE]; MoeDownPlan pl; int G, c; const bf16_t* act; const bf16_t* Wt; bf16_t* ypair; float* partk;
    __device__ __forceinline__ void init(const unsigned* cnt, int G_, int c_) { G = G_; c = c_; pl = moe_down_plan(cnt, G_);
#pragma unroll
        for (int e = 0; e < NE; ++e) tl[e] = (int)((__builtin_amdgcn_readfirstlane(cnt[e]) + 255u) >> 8); }
    __device__ __forceinline__ bool unit(int i, GU& u) const {
        const long L = (long)i * G + c; int w, kp = -1;
        if (L < pl.main) { w = (int)L; const int q = pl.main / NXCD, r = pl.main % NXCD, xcd = w % NXCD, off = w / NXCD; w = (xcd < r ? xcd * (q + 1) : r * (q + 1) + (xcd - r) * q) + off; }
        else { const long s2 = L - pl.main; if (s2 >= (long)pl.tail * KSPL) return false; w = pl.main + (int)(s2 / KSPL); kp = (int)(s2 % KSPL); }
        const int tile = w >> 2, pn = w & 3; int e = 0, tacc = 0;
#pragma unroll
        for (int k = 0; k < NE; ++k) { if (tile >= tacc) e = k; tacc += tl[k]; }
        const int slot0 = tile * 256;
        u.pm = slot0; u.pn = pn; u.aux = e; u.idx = nullptr; u.mapA = 0; u.mapB = 0; u.lda = 7168; u.ldb = 7168;
        u.A = (const char*)act + (size_t)slot0 * 7168; u.B = (const char*)Wt + ((size_t)e * 1024 + (size_t)pn * 256) * 7168;
        if (kp < 0) { u.sub = 0; u.nt = 56; } else { u.sub = 1 + kp; u.nt = 8; u.A += kp * 1024; u.B += kp * 1024; }
        return true;
    }
    __device__ __forceinline__ void epi(f32x4 (&acc)[2][2][4][2], const GU& u, int wr, int wc, int fr, int fq) const {
        const int rl0 = wr * 64 + fr, cl0 = wc * 32 + 8 * fq;
        if (u.sub == 0) {
            EPI_ROWS(ai, m) { const int slot = u.pm + ai * 128 + m * 16 + rl0;
#pragma unroll
                for (int bj = 0; bj < 2; ++bj) st_bf8(ypair + (size_t)slot * 1024 + u.pn * 256 + bj * 128 + cl0, acc[ai][bj][m][0], acc[ai][bj][m][1]); }
        } else {
            float* pk = partk + ((size_t)(u.sub - 1) * (TAILMAX / 4) * 256 + (u.pm - (pl.main >> 2) * 256)) * 1024 + u.pn * 256 + cl0;
            EPI_ROWS(ai, m) { float* o = pk + (size_t)(ai * 128 + m * 16 + rl0) * 1024;
#pragma unroll
                for (int bj = 0; bj < 2; ++bj) { *(f32x4*)(o + bj * 128) = acc[ai][bj][m][0]; *(f32x4*)(o + bj * 128 + 4) = acc[ai][bj][m][1]; } }
        }
    }
};

struct Params { const float* in[30]; float* out; unsigned char* ws; int s_lo, s_hi; };
enum { I_X = 0, I_P, I_MIXN, I_WIN, I_DNCONV, I_DNALOG, I_DNDTB, I_DNNORM, I_SSCONV, I_SSCONVB, I_SSALOG, I_SSDTB, I_SSD, I_SSNORM, I_WBRDN, I_WBRSSM, I_WBRATT, I_WOUT, I_FFNN,
       I_WFG, I_WFU, I_WFD, I_WROUTER, I_WMG, I_WMU, I_WMD, I_PLEN, I_WPLE, I_WPLEG, I_FINALN };

template <class Map>
__device__ __forceinline__ void tr_job(const Map& map, int K, int N, bf16_t* WT, const float* gain, LAS float* scr, int lane, int gw, int NGW, float qs = 0.f) {
    const int nblk = N / 32, nitems = (K / 64) * nblk;
    for (int item = gw; item < nitems; item += NGW) {
        const int kb = item / nblk, nb = item % nblk, k0 = 64 * kb, n0 = 32 * nb;
        int ld = 0; const float* src = map(n0 + (lane & 31), ld);
#pragma unroll
        for (int i = 0; i < 32; ++i) { const int kk = 2 * i + (lane >> 5); float v = 0.f; if (src) { v = src[(size_t)(k0 + kk) * ld]; if (gain) v *= gain[k0 + kk]; if (qs > 0.f) v = q8(v * qs) / qs; } scr[kk * 33 + (lane & 31)] = v; }
        asm volatile("s_waitcnt lgkmcnt(0)" ::: "memory");
        const int c = lane & 7;
#pragma unroll
        for (int j = 0; j < 4; ++j) { const int n = (lane >> 3) + 8 * j; const LAS float* s = scr + (8 * c) * 33 + n;
            u32x4 o; o.x = pk2(s[0 * 33], s[1 * 33]); o.y = pk2(s[2 * 33], s[3 * 33]); o.z = pk2(s[4 * 33], s[5 * 33]); o.w = pk2(s[6 * 33], s[7 * 33]);
            *(u32x4*)(WT + (size_t)(n0 + n) * K + k0 + 8 * c) = o; }
        asm volatile("s_waitcnt lgkmcnt(0)" ::: "memory");
    }
}
struct MapPlain { const float* W; int ld; __device__ __forceinline__ const float* operator()(int n, int& l) const { l = ld; return W + n; } };
struct MapIn { const float* W; __device__ __forceinline__ const float* operator()(int n, int& l) const { l = INW; const int tile = n >> 8, r = n & 255; int col;
        if (tile < 9) col = n; else if (tile < 12) col = C_DNZ + (n - 2304); else if (tile < 17) col = C_XBC + (n - 3072); else if (tile < 20) col = C_SSZ + (n - 4352);
        else if (tile < 29) col = C_ATT + (n - 5120); else if (tile < 41) col = C_GATE + (n - 7424);
        else { if (r < 6) col = C_DNA + r; else if (r < 12) col = C_DNB + (r - 6); else if (r < 24) col = C_SSDT + (r - 12); else return nullptr; }
        return W + col; } };
struct MapGu { const float* Wg; const float* Wu; int ld; __device__ __forceinline__ const float* operator()(int n, int& l) const { l = ld; const int tile = n >> 8, r = n & 255; return r < 128 ? Wg + tile * 128 + r : Wu + tile * 128 + (r - 128); } };

__device__ __forceinline__ void phase_convert(const Params& p, LAS unsigned char* lds) {
    const int tid_ = htid(), lane = tid_ & 63, wave = tid_ >> 6, G = gridDim.x;
    const int gw = blockIdx.x * 8 + wave, NGW = G * 8;
    LAS float* scr = (LAS float*)(lds + wave * 16384);
    unsigned char* ws = p.ws;
    for (int l = 0; l < DEPTH; ++l) {
        tr_job(MapIn{p.in[I_WIN] + (size_t)l * D * INW}, D, INP, (bf16_t*)(ws + WS_WIN) + (size_t)l * INP * D, p.in[I_MIXN] + l * D, scr, lane, gw, NGW);
        tr_job(MapPlain{p.in[I_WBRDN] + (size_t)l * 768 * D, D}, 768, D, (bf16_t*)(ws + WS_WDN) + (size_t)l * D * 768, nullptr, scr, lane, gw, NGW);
        tr_job(MapPlain{p.in[I_WBRSSM] + (size_t)l * 768 * D, D}, 768, D, (bf16_t*)(ws + WS_WSSM) + (size_t)l * D * 768, nullptr, scr, lane, gw, NGW);
        tr_job(MapPlain{p.in[I_WBRATT] + (size_t)l * 256 * D, D}, 256, D, (bf16_t*)(ws + WS_WATT) + (size_t)l * D * 256, nullptr, scr, lane, gw, NGW);
        tr_job(MapPlain{p.in[I_WOUT] + (size_t)l * D * D, D}, D, D, (bf16_t*)(ws + WS_WOUT) + (size_t)l * D * D, nullptr, scr, lane, gw, NGW);
        tr_job(MapPlain{p.in[I_WPLEG] + (size_t)l * D * D, D}, D, D, (bf16_t*)(ws + WS_WPG) + (size_t)l * D * D, p.in[I_PLEN] + l * D, scr, lane, gw, NGW);
        tr_job(MapPlain{p.in[I_WPLE] + (size_t)l * PLE * D, D}, PLE, D, (bf16_t*)(ws + WS_WPLE) + (size_t)l * D * PLE, nullptr, scr, lane, gw, NGW);
    }
    tr_job(MapGu{p.in[I_WFG], p.in[I_WFU], FFN}, D, 2 * FFN, (bf16_t*)(ws + WS_WFGU), p.in[I_FFNN], scr, lane, gw, NGW, 16.f);
    tr_job(MapPlain{p.in[I_WFD], D}, FFN, D, (bf16_t*)(ws + WS_WFD), nullptr, scr, lane, gw, NGW, 16.f);
    for (int e = 0; e < NE; ++e) {
        tr_job(MapGu{p.in[I_WMG] + (size_t)e * D * EXD, p.in[I_WMU] + (size_t)e * D * EXD, EXD}, D, 2 * EXD, (bf16_t*)(ws + WS_WMGU) + (size_t)e * 2 * EXD * D, p.in[I_FFNN] + D, scr, lane, gw, NGW, 16.f);
        tr_job(MapPlain{p.in[I_WMD] + (size_t)e * EXD * D, D}, EXD, D, (bf16_t*)(ws + WS_WMD) + (size_t)e * D * EXD, nullptr, scr, lane, gw, NGW, 16.f);
    }
    float* wr = (float*)(ws + WS_WR);
    for (int i = blockIdx.x * 512 + tid_; i < D * NE; i += G * 512) wr[i] = p.in[I_WROUTER][i] * p.in[I_FFNN][D + (i >> 3)];
}

__device__ __forceinline__ void phase_chunk_in(const Params& p, int chunk) {
    const int tid_ = htid(), lane = tid_ & 63, gw = blockIdx.x * 8 + (tid_ >> 6), NGW = gridDim.x * 8;
    const float* x = p.in[I_X] + (size_t)chunk * TC * D;
    bf16_t* xb = (bf16_t*)(p.ws + WS_XB); float* ssq = (float*)(p.ws + WS_SSQ);
    for (int r = gw; r < TC; r += NGW) {
        const f32x4* xr = (const f32x4*)(x + (size_t)r * D) + lane; float s = 0.f;
        u32x2* o = (u32x2*)(xb + (size_t)r * D) + lane;
#pragma unroll
        for (int j = 0; j < 4; ++j) { const f32x4 v = xr[64 * j]; s += (v.x * v.x + v.y * v.y) + (v.z * v.z + v.w * v.w); u32x2 w; w.x = pk2(v.x, v.y); w.y = pk2(v.z, v.w); o[64 * j] = w; }
        s = wave_sum(s);
        if (lane < 16) ssq[(size_t)r * 16 + lane] = lane == 0 ? s : 0.f;
    }
    bf16_t* pb = (bf16_t*)(p.ws + WS_PB);
    for (int r = gw; r < 2 * TC; r += NGW) {
        const int l = r / TC, rr = r % TC;
        const f32x4 v = *((const f32x4*)(p.in[I_P] + ((size_t)l * BATCH * SEQ + (size_t)chunk * TC + rr) * PLE) + lane);
        u32x2 w; w.x = pk2(v.x, v.y); w.y = pk2(v.z, v.w); *((u32x2*)(pb + ((size_t)l * TC + rr) * PLE) + lane) = w;
    }
}
__device__ __forceinline__ void phase_final(const Params& p, int chunk) {
    const int tid_ = htid(), lane = tid_ & 63, gw = blockIdx.x * 8 + (tid_ >> 6), NGW = gridDim.x * 8;
    float* x = p.out + (size_t)chunk * TC * D; const float* g = p.in[I_FINALN];
    for (int r = gw; r < TC; r += NGW) {
        f32x4* xr = (f32x4*)(x + (size_t)r * D) + lane; f32x4 v[4]; float s = 0.f;
#pragma unroll
        for (int j = 0; j < 4; ++j) { v[j] = xr[64 * j]; s += (v[j].x * v[j].x + v[j].y * v[j].y) + (v[j].z * v[j].z + v[j].w * v[j].w); }
        const float rs = rsqrtf(wave_sum(s) * (1.f / D) + EPS);
#pragma unroll
        for (int j = 0; j < 4; ++j) xr[64 * j] = v[j] * rs * ((const f32x4*)g)[lane + 64 * j];
    }
}
__device__ __forceinline__ void phase_router(const Params& p, LAS unsigned char* lds, int chunk) {
    const int tid_ = htid(), lane = tid_ & 63, gw = blockIdx.x * 8 + (tid_ >> 6), NGW = gridDim.x * 8;
    const float* x = p.out + (size_t)chunk * TC * D; const float* wr = (const float*)(p.ws + WS_WR);
    int* rt = (int*)(p.ws + WS_ROUTE); unsigned* cnt = (unsigned*)(p.ws + WS_CTL) + CW_CNT + chunk * 64;
    LAS unsigned* lcnt = (LAS unsigned*)lds;
    f32x4 w[16][2];
#pragma unroll
    for (int j = 0; j < 4; ++j)
#pragma unroll
        for (int q = 0; q < 4; ++q) { const int k = 4 * (lane + 64 * j) + q; w[4 * j + q][0] = *(const f32x4*)(wr + k * 8); w[4 * j + q][1] = *(const f32x4*)(wr + k * 8 + 4); }
    const int nouter = (TC + 8 * NGW - 1) / (8 * NGW);
    for (int ob = 0; ob < nouter; ++ob) {
        if (tid_ < 16) lcnt[tid_] = 0u;
        __syncthreads();
        int pe[8]; unsigned pr[8];
#pragma unroll
        for (int jr = 0; jr < 8; ++jr) { const int r = gw + (ob * 8 + jr) * NGW; pe[jr] = 0; pr[jr] = 0u;
            if (r < TC) {
                const f32x4* xr = (const f32x4*)(x + (size_t)r * D) + lane; float s = 0.f; float lg[NE];
#pragma unroll
                for (int e = 0; e < NE; ++e) lg[e] = 0.f;
#pragma unroll
                for (int j = 0; j < 4; ++j) { const f32x4 v = xr[64 * j]; s += (v.x * v.x + v.y * v.y) + (v.z * v.z + v.w * v.w);
#pragma unroll
                    for (int q = 0; q < 4; ++q) { const f32x4 w0 = w[4 * j + q][0], w1 = w[4 * j + q][1];
                        lg[0] += v[q] * w0.x; lg[1] += v[q] * w0.y; lg[2] += v[q] * w0.z; lg[3] += v[q] * w0.w; lg[4] += v[q] * w1.x; lg[5] += v[q] * w1.y; lg[6] += v[q] * w1.z; lg[7] += v[q] * w1.w; } }
                const float rs = rsqrtf(wave_sum(s) * (1.f / D) + EPS);
#pragma unroll
                for (int e = 0; e < NE; ++e) lg[e] = wave_sum(lg[e]) * rs;
                int i0 = 0; float l0 = lg[0];
#pragma unroll
                for (int e = 1; e < NE; ++e) if (lg[e] > l0) { l0 = lg[e]; i0 = e; }
                int i1 = -1; float l1 = -3.0e38f;
#pragma unroll
                for (int e = 0; e < NE; ++e) if (e != i0 && lg[e] > l1) { l1 = lg[e]; i1 = e; }
                if (lane < 2) { const int e = lane == 0 ? i0 : i1; const float w0 = 1.f / (1.f + expf(l1 - l0));
                    pe[jr] = e; pr[jr] = __hip_atomic_fetch_add(lcnt + e, 1u, __ATOMIC_RELAXED, __HIP_MEMORY_SCOPE_WORKGROUP);
                    rt[RT_TOPE + 2 * r + lane] = e; ((float*)rt)[RT_TOPW + 2 * r + lane] = lane == 0 ? w0 : 1.f - w0; }
            } }
        __syncthreads();
        if (tid_ < 8) lcnt[8 + tid_] = atomicAdd(cnt + tid_, lcnt[tid_]);
        __syncthreads();
#pragma unroll
        for (int jr = 0; jr < 8; ++jr) { const int r = gw + (ob * 8 + jr) * NGW; if (r < TC && lane < 2) rt[RT_TOPP + 2 * r + lane] = (int)(lcnt[8 + pe[jr]] + pr[jr]); }
        __syncthreads();
    }
}
__device__ __forceinline__ void phase_slots(const Params& p, int chunk) {
    int* rt = (int*)(p.ws + WS_ROUTE); const unsigned* cnt = (const unsigned*)(p.ws + WS_CTL) + CW_CNT + chunk * 64;
    int c[NE], off[NE + 1]; off[0] = 0;
#pragma unroll
    for (int e = 0; e < NE; ++e) { c[e] = (int)cnt[e]; off[e + 1] = off[e] + ((c[e] + 255) & ~255); }
    const int gt = blockIdx.x * 512 + htid(), NT = gridDim.x * 512;
    for (int i = gt; i < 2 * TC; i += NT) {
        const int e = rt[RT_TOPE + i], pos = rt[RT_TOPP + i]; int o = 0;
#pragma unroll
        for (int k = 0; k < NE; ++k) o = (e == k) ? off[k] : o;
        const int slot = o + pos; rt[RT_TOPS + i] = slot; rt[RT_IDX + slot] = i >> 1;
    }
    for (int s = gt; s < off[NE]; s += NT) {
        bool pad = false;
#pragma unroll
        for (int k = 0; k < NE; ++k) pad = pad || (s >= off[k] + c[k] && s < off[k + 1]);
        if (pad) rt[RT_IDX + s] = 0;
    }
}
__device__ __forceinline__ f32x4 moe_y4(const bf16_t* yp, const float* partk, int slot, int tail0, int col) {
    if (slot < tail0) { const u32x2 a = *(const u32x2*)(yp + (size_t)slot * D + col); return (f32x4){lo_bf(a.x), hi_bf(a.x), lo_bf(a.y), hi_bf(a.y)}; }
    f32x4 v = (f32x4){0.f, 0.f, 0.f, 0.f};
#pragma unroll
    for (int k = 0; k < KSPL; ++k) v += *(const f32x4*)(partk + ((size_t)k * (TAILMAX / 4) * 256 + (slot - tail0)) * 1024 + col);
    return v;
}
__device__ __forceinline__ void phase_combine(const Params& p, int chunk) {
    const int tid_ = htid(), lane = tid_ & 63, gw = blockIdx.x * 8 + (tid_ >> 6), NGW = gridDim.x * 8;
    float* x = p.out + (size_t)chunk * TC * D; const int* rt = (const int*)(p.ws + WS_ROUTE);
    const bf16_t* yp = (const bf16_t*)(p.ws + WS_YPAIR); const float* partk = (const float*)(p.ws + WS_PARTK); bf16_t* xb = (bf16_t*)(p.ws + WS_XB); float* ssq = (float*)(p.ws + WS_SSQ);
    const MoeDownPlan pl = moe_down_plan((const unsigned*)(p.ws + WS_CTL) + CW_CNT + chunk * 64, gridDim.x);
    const int tail0 = pl.tail > 0 ? (pl.main >> 2) * 256 : 0x7fffffff;
    for (int r = gw; r < TC; r += NGW) {
        const int s0 = rt[RT_TOPS + 2 * r], s1 = rt[RT_TOPS + 2 * r + 1]; const float w0 = (DBG_ABL & 16) ? 0.f : ((const float*)rt)[RT_TOPW + 2 * r], w1 = (DBG_ABL & 16) ? 0.f : ((const float*)rt)[RT_TOPW + 2 * r + 1];
        f32x4* xr = (f32x4*)(x + (size_t)r * D) + lane; u32x2* o = (u32x2*)(xb + (size_t)r * D) + lane; float s = 0.f;
#pragma unroll
        for (int j = 0; j < 4; ++j) { f32x4 v = xr[64 * j]; const int col = 4 * (lane + 64 * j);
            v += w0 * moe_y4(yp, partk, s0, tail0, col) + w1 * moe_y4(yp, partk, s1, tail0, col);
            xr[64 * j] = v; s += (v.x * v.x + v.y * v.y) + (v.z * v.z + v.w * v.w); u32x2 w; w.x = pk2(v.x, v.y); w.y = pk2(v.z, v.w); o[64 * j] = w; }
        s = wave_sum(s);
        if (lane < 16) ssq[(size_t)r * 16 + lane] = lane == 0 ? s : 0.f;
    }
}

#define LDS_BARRIER() do { asm volatile("s_waitcnt lgkmcnt(0)" ::: "memory"); __builtin_amdgcn_s_barrier(); asm volatile("" ::: "memory"); } while (0)
__device__ __forceinline__ f32x4 mfma16(const bf16x8 a, const bf16x8 b, const f32x4 c) { return __builtin_amdgcn_mfma_f32_16x16x32_bf16(a, b, c, 0, 0, 0); }
__device__ __forceinline__ void dn_prep(const Params& p, LAS unsigned char* lds, int layer, int b, int n, int h) {
    const int tid = htid(), lane = tid & 63, wave = tid >> 6;
    LAS unsigned char* QS = lds; LAS unsigned char* KS = lds + 17408; LAS unsigned char* VS = lds + 34816;
    LAS float* AM = (LAS float*)(lds + 52224);
    LAS float* SC = (LAS float*)(lds + 69632);
    const int t0 = n * 64;
    const bf16_t* proj = (const bf16_t*)(p.ws + WS_PDN) + (size_t)b * SEQ * 3072;
    unsigned char* item = p.ws + WS_DNS + (size_t)((b * 32 + n) * 6 + h) * DNS_ITEM;
    if (tid < 480) {
        const int cg = tid % 48, seg = tid / 48, part = cg >> 4, c8 = (cg & 15) * 8, col = part * 768 + h * 128 + c8;
        const float* cw = p.in[I_DNCONV] + (size_t)layer * 4 * 2304 + col;
        f32x4 w[4][2];
#pragma unroll
        for (int j = 0; j < 4; ++j) { w[j][0] = *(const f32x4*)(cw + j * 2304); w[j][1] = *(const f32x4*)(cw + j * 2304 + 4); }
        const int ts = seg * 7;
        f32x4 x[10][2];
#pragma unroll
        for (int i = 0; i < 10; ++i) { const int t = t0 + ts - 3 + i; x[i][0] = (f32x4){0.f, 0.f, 0.f, 0.f}; x[i][1] = x[i][0];
            if (t >= 0 && ts - 3 + i < 64) ld_bf8(proj + (size_t)t * 3072 + col, x[i][0], x[i][1]); }
        LAS unsigned char* dst = part == 0 ? QS : (part == 1 ? KS : VS);
#pragma unroll
        for (int i = 0; i < 7; ++i) { const int tk = ts + i;
            if (tk < 64) { f32x4 a0 = w[3][0] * x[i + 3][0] + w[2][0] * x[i + 2][0] + w[1][0] * x[i + 1][0] + w[0][0] * x[i][0];
                f32x4 a1 = w[3][1] * x[i + 3][1] + w[2][1] * x[i + 2][1] + w[1][1] * x[i + 1][1] + w[0][1] * x[i][1];
#pragma unroll
                for (int c = 0; c < 4; ++c) { a0[c] = siluf_(a0[c]); a1[c] = siluf_(a1[c]); }
                u32x4 pw; pw.x = pk2(a0[0], a0[1]); pw.y = pk2(a0[2], a0[3]); pw.z = pk2(a1[0], a1[1]); pw.w = pk2(a1[2], a1[3]);
                *(LAS u32x4*)(dst + tk * 272 + c8 * 2) = pw;
 } }
    } else {
        const float Aexp = expf(p.in[I_DNALOG][layer * 6 + h]), dtb = p.in[I_DNDTB][layer * 6 + h];
        const float* small = (const float*)(p.ws + WS_SMALL) + (size_t)b * SEQ * 32;
#pragma unroll
        for (int q = 0; q < 2; ++q) { const int tk = (tid - 480) * 2 + q; const float a = small[(size_t)(t0 + tk) * 32 + h], bb = small[(size_t)(t0 + tk) * 32 + 6 + h];
            SC[128 + tk] = sigmoidf_(bb); SC[192 + tk] = -Aexp * softplusf_(a + dtb); }
    }
    LDS_BARRIER();
    {
        const int row = tid >> 3, sg = tid & 7; const u32x4 q0 = *(const LAS u32x4*)(QS + row * 272 + sg * 32), q1 = *(const LAS u32x4*)(QS + row * 272 + sg * 32 + 16), k0 = *(const LAS u32x4*)(KS + row * 272 + sg * 32), k1 = *(const LAS u32x4*)(KS + row * 272 + sg * 32 + 16);
        float sq = sq8((f32x4){lo_bf(q0.x), hi_bf(q0.x), lo_bf(q0.y), hi_bf(q0.y)}, (f32x4){lo_bf(q0.z), hi_bf(q0.z), lo_bf(q0.w), hi_bf(q0.w)}) + sq8((f32x4){lo_bf(q1.x), hi_bf(q1.x), lo_bf(q1.y), hi_bf(q1.y)}, (f32x4){lo_bf(q1.z), hi_bf(q1.z), lo_bf(q1.w), hi_bf(q1.w)});
        float sk = sq8((f32x4){lo_bf(k0.x), hi_bf(k0.x), lo_bf(k0.y), hi_bf(k0.y)}, (f32x4){lo_bf(k0.z), hi_bf(k0.z), lo_bf(k0.w), hi_bf(k0.w)}) + sq8((f32x4){lo_bf(k1.x), hi_bf(k1.x), lo_bf(k1.y), hi_bf(k1.y)}, (f32x4){lo_bf(k1.z), hi_bf(k1.z), lo_bf(k1.w), hi_bf(k1.w)});
        sq += __shfl_xor(sq, 1); sq += __shfl_xor(sq, 2); sq += __shfl_xor(sq, 4); sk += __shfl_xor(sk, 1); sk += __shfl_xor(sk, 2); sk += __shfl_xor(sk, 4);
        if (sg == 0) { SC[row] = sq; SC[64 + row] = sk; } }
    LDS_BARRIER();
    if (wave == 0) {
        float g = SC[192 + lane];
#pragma unroll
        for (int o = 1; o < 64; o <<= 1) { const float t = __shfl_up(g, o); if (lane >= o) g += t; }
        SC[192 + lane] = g; SC[256 + lane] = expf(g); SC[320 + lane] = rsqrtf(SC[lane] + EPS); SC[384 + lane] = rsqrtf(SC[64 + lane] + EPS);
    }
    LDS_BARRIER();
    {
        const int r = lane & 15, kg = lane >> 4;
        bf16x8 fa[4][4], fb[4][4];
#pragma unroll
        for (int q = 0; q < 4; ++q) { const int t = wave * 4 + q, which = t >> 4, mt = (t >> 2) & 3, nt = t & 3;
            const LAS unsigned char* A = (which == 0 ? KS : QS) + (16 * mt + r) * 272 + kg * 16; const LAS unsigned char* Bt = KS + (16 * nt + r) * 272 + kg * 16;
#pragma unroll
            for (int ks = 0; ks < 4; ++ks) { fa[q][ks] = *(const LAS bf16x8*)(A + ks * 64); fb[q][ks] = *(const LAS bf16x8*)(Bt + ks * 64); } }
#pragma unroll
        for (int q = 0; q < 4; ++q) { const int t = wave * 4 + q, which = t >> 4, mt = (t >> 2) & 3, nt = t & 3;
            f32x4 acc = (f32x4){0.f, 0.f, 0.f, 0.f};
#pragma unroll
            for (int ks = 0; ks < 4; ++ks) acc = mfma16(fa[q][ks], fb[q][ks], acc);
            const int j = 16 * nt + r; const float gj = SC[192 + j], rkj = SC[384 + j];
            float ov[4];
#pragma unroll
            for (int rr = 0; rr < 4; ++rr) { const int i = 16 * mt + 4 * kg + rr; const float e = fexp(fminf(SC[192 + i] - gj, 0.f));
                if (which == 0) AM[i * 68 + j] = (i > j) ? SC[128 + i] * SC[384 + i] * rkj * acc[rr] * e : 0.f;
                ov[rr] = (i >= j) ? SC[320 + i] * rkj * 0.08838834764831845f * acc[rr] * e : 0.f; }
            if (which != 0) { bf16_t* ao = (bf16_t*)(item + 32768) + (16 * mt + 4 * kg) * 64 + j; ST2_BF(ao, ao + 64, ov[0], ov[1]); ST2_BF(ao + 128, ao + 192, ov[2], ov[3]); }
        }
    }
    LDS_BARRIER();
    if (tid < 256) {
        float x[64];
        if (tid < 128) {
#pragma unroll
            for (int i = 0; i < 64; ++i) x[i] = bf2f(*(const LAS bf16_t*)(KS + i * 272 + tid * 2)) * SC[384 + i] * SC[128 + i] * SC[256 + i];
        } else {
#pragma unroll
            for (int i = 0; i < 64; ++i) x[i] = bf2f(*(const LAS bf16_t*)(VS + i * 272 + (tid - 128) * 2)) * SC[128 + i];
        }
        f32x4 rw[2][16];
        rw[1][0] = *(const LAS f32x4*)(AM + 1 * 68);
#pragma unroll
        for (int i = 1; i < 64; ++i) {
            if (i + 1 < 64) {
#pragma unroll
                for (int k4 = 0; k4 < (i + 4) / 4; ++k4) rw[(i + 1) & 1][k4] = *(const LAS f32x4*)(AM + (i + 1) * 68 + 4 * k4);
            }
            float a4[4] = {x[i], 0.f, 0.f, 0.f};
#pragma unroll
            for (int k4 = 0; k4 < (i + 3) / 4; ++k4) { const f32x4 am = rw[i & 1][k4];
#pragma unroll
                for (int c = 0; c < 4; ++c) if (4 * k4 + c < i) a4[c] -= am[c] * x[4 * k4 + c]; }
            x[i] = (a4[0] + a4[1]) + (a4[2] + a4[3]); }
        if (tid < 128) { bf16_t* W = (bf16_t*)item;
#pragma unroll
            for (int i = 0; i < 64; i += 2) ST2_BF(W + i * 128 + tid, W + (i + 1) * 128 + tid, x[i], x[i + 1]);
        } else { u32x4* UT = (u32x4*)(item + 57344 + (size_t)(tid - 128) * 128);
#pragma unroll
            for (int c = 0; c < 8; ++c) { u32x4 w; w.x = pk2(x[8 * c], x[8 * c + 1]); w.y = pk2(x[8 * c + 2], x[8 * c + 3]); w.z = pk2(x[8 * c + 4], x[8 * c + 5]); w.w = pk2(x[8 * c + 6], x[8 * c + 7]); UT[c] = w; } }
    } else {
        const int u = tid - 256; const float glast = SC[192 + 63];
#pragma unroll
        for (int i = 0; i < 4; ++i) { const int q = u + 256 * i, c = q >> 4, d8 = (q & 15) * 8; f32x4 a0, a1;
            const u32x4 w = *(const LAS u32x4*)(QS + c * 272 + d8 * 2); const float sc = SC[320 + c] * 0.08838834764831845f * SC[256 + c];
            a0 = (f32x4){lo_bf(w.x), hi_bf(w.x), lo_bf(w.y), hi_bf(w.y)} * sc; a1 = (f32x4){lo_bf(w.z), hi_bf(w.z), lo_bf(w.w), hi_bf(w.w)} * sc;
            st_bf8((bf16_t*)(item + 16384) + c * 128 + d8, a0, a1); }
#pragma unroll
        for (int i = 0; i < 4; ++i) { const int q = u + 256 * i, d = q >> 3, c8 = (q & 7) * 8; float v[8];
#pragma unroll
            for (int c = 0; c < 8; ++c) v[c] = bf2f(*(const LAS bf16_t*)(KS + (c8 + c) * 272 + d * 2)) * SC[384 + c8 + c] * fexp(glast - SC[192 + c8 + c]);
            st_bf8((bf16_t*)(item + 40960) + d * 64 + c8, (f32x4){v[0], v[1], v[2], v[3]}, (f32x4){v[4], v[5], v[6], v[7]}); }
        if (u == 0) ((float*)(p.ws + WS_DNEGL))[(b * 32 + n) * 6 + h] = SC[256 + 63];
    }
    {
        const float* ng = p.in[I_DNNORM] + layer * 128; bf16_t* ydn = (bf16_t*)(p.ws + WS_YDN) + ((size_t)b * SEQ + t0) * 768 + h * 128;
#pragma unroll
        for (int i = 0; i < 2; ++i) { const int q = tid + 512 * i, c = q >> 4, e8 = (q & 15) * 8; f32x4 z0, z1; ld_bf8(proj + (size_t)(t0 + c) * 3072 + 2304 + h * 128 + e8, z0, z1);
            const f32x4 g0 = *(const f32x4*)(ng + e8), g1 = *(const f32x4*)(ng + e8 + 4);
#pragma unroll
            for (int j = 0; j < 4; ++j) { z0[j] = g0[j] * siluf_(z0[j]); z1[j] = g1[j] * siluf_(z1[j]); }
            st_bf8(ydn + (size_t)c * 768 + e8, z0, z1); }
    }
    LDS_BARRIER();
}
__device__ __forceinline__ float row16_sum(float v) {
    v += __builtin_bit_cast(float, __builtin_amdgcn_update_dpp(0, __builtin_bit_cast(int, v), 0xB1, 0xf, 0xf, false));
    v += __builtin_bit_cast(float, __builtin_amdgcn_update_dpp(0, __builtin_bit_cast(int, v), 0x4E, 0xf, 0xf, false));
    v += __builtin_bit_cast(float, __builtin_amdgcn_update_dpp(0, __builtin_bit_cast(int, v), 0x141, 0xf, 0xf, false));
    v += __builtin_bit_cast(float, __builtin_amdgcn_update_dpp(0, __builtin_bit_cast(int, v), 0x140, 0xf, 0xf, false));
    return v;
}
__device__ __forceinline__ void dn_scan(const Params& p, LAS unsigned char* lds, int layer, int b, int h) {
    const int tid = htid(), lane = tid & 63, wave = __builtin_amdgcn_readfirstlane(tid >> 6), r = lane & 15, kg = lane >> 4;
    LAS unsigned char* W = lds; LAS unsigned char* QD = lds + 17408; LAS unsigned char* ATT = lds + 34816; LAS unsigned char* KDT = lds + 44032; LAS unsigned char* UT = lds + 62464;
    LAS unsigned char* ST = lds + 80896; LAS unsigned char* VNT = lds + 115712; LAS float* PS = (LAS float*)(lds + 134144); LAS float* RS = (LAS float*)(lds + 136192) + wave * 64;
    const unsigned char* items = p.ws + WS_DNS + (size_t)(b * 32 * 6 + h) * DNS_ITEM;
    bf16_t* ydn = (bf16_t*)(p.ws + WS_YDN) + (size_t)b * SEQ * 768 + h * 128 + 16 * wave + r;
    float egl_all = lane < 32 ? ((const float*)(p.ws + WS_DNEGL))[b * 32 * 6 + h + 6 * lane] : 0.f;
    asm volatile("" : "+v"(egl_all));
    f32x4 S[8], o[4];
#pragma unroll
    for (int dt = 0; dt < 8; ++dt) S[dt] = (f32x4){0.f, 0.f, 0.f, 0.f};
#pragma unroll
    for (int mt = 0; mt < 4; ++mt) o[mt] = (f32x4){0.f, 0.f, 0.f, 0.f};
    for (int i = lane; i < 16 * 272 / 16; i += 64) *(LAS u32x4*)(ST + wave * 16 * 272 + i * 16) = (u32x4){0u, 0u, 0u, 0u};
    u32x4 R[9];
#pragma unroll
    for (int i = 0; i < 9; ++i) R[i] = *(const u32x4*)(items + (size_t)(tid + 512 * i) * 16);
    unsigned short zc[16];
#pragma unroll
    for (int i = 0; i < 16; ++i) zc[i] = 0u;
    LDS_BARRIER();
    for (int n = 0; n <= 32; ++n) {
        if (n < 32) {
#pragma unroll
            for (int i = 0; i < 9; ++i) { const int q = tid + 512 * i; LAS unsigned char* dst;
                if (i < 2) dst = W + (q >> 4) * 272 + (q & 15) * 16; else if (i < 4) dst = QD + ((q - 1024) >> 4) * 272 + (q & 15) * 16;
                else if (i < 5) dst = ATT + ((q - 2048) >> 3) * 144 + (q & 7) * 16; else if (i < 7) dst = KDT + ((q - 2560) >> 3) * 144 + (q & 7) * 16;
                else dst = UT + ((q - 3584) >> 3) * 144 + (q & 7) * 16;
                *(LAS u32x4*)dst = R[i]; }
        }
        if (n > 0) {
            float tot = 0.f;
#pragma unroll
            for (int w = 0; w < 8; ++w) tot += PS[w * 64 + lane];
            RS[lane] = rsqrtf(tot * (1.f / 128.f) + EPS);
#pragma unroll
            for (int mt = 0; mt < 4; ++mt) { const f32x4 rs = *(const LAS f32x4*)(RS + 16 * mt + 4 * kg);
#pragma unroll
                for (int rr = 0; rr < 4; rr += 2) { bf16_t* yo_ = ydn + (size_t)((n - 1) * 64 + 16 * mt + 4 * kg + rr) * 768;
                    ST2_BF(yo_, yo_ + 768, o[mt][rr] * rs[rr] * __uint_as_float(((unsigned)zc[4 * mt + rr]) << 16), o[mt][rr + 1] * rs[rr + 1] * __uint_as_float(((unsigned)zc[4 * mt + rr + 1]) << 16)); } }
        }
        if (n == 32) break;
        if (n + 1 < 32) {
#pragma unroll
            for (int i = 0; i < 9; ++i) R[i] = *(const u32x4*)(items + (size_t)(n + 1) * 6 * DNS_ITEM + (size_t)(tid + 512 * i) * 16);
        }
#pragma unroll
        for (int mt = 0; mt < 4; ++mt)
#pragma unroll
            for (int rr = 0; rr < 4; ++rr) zc[4 * mt + rr] = ydn[(size_t)(n * 64 + 16 * mt + 4 * kg + rr) * 768];
        const float egl = __builtin_bit_cast(float, __builtin_amdgcn_readlane(__builtin_bit_cast(int, egl_all), n));
        LDS_BARRIER();
        bf16x8 sf[4];
#pragma unroll
        for (int ks = 0; ks < 4; ++ks) sf[ks] = *(const LAS bf16x8*)(ST + (16 * wave + r) * 272 + ks * 64 + kg * 16);
        {   bf16x8 af[4][4]; u32x2 uw[4];
#pragma unroll
            for (int mt = 0; mt < 4; ++mt) {
#pragma unroll
                for (int ks = 0; ks < 4; ++ks) af[mt][ks] = *(const LAS bf16x8*)(W + (16 * mt + r) * 272 + ks * 64 + kg * 16);
                uw[mt] = *(const LAS u32x2*)(UT + (16 * wave + r) * 144 + (16 * mt + 4 * kg) * 2); }
#pragma unroll
            for (int mt = 0; mt < 4; ++mt) { f32x4 ws = (f32x4){0.f, 0.f, 0.f, 0.f};
#pragma unroll
                for (int ks = 0; ks < 4; ++ks) ws = mfma16(af[mt][ks], sf[ks], ws);
                const f32x4 vn = (f32x4){lo_bf(uw[mt].x), hi_bf(uw[mt].x), lo_bf(uw[mt].y), hi_bf(uw[mt].y)} - ws;
                u32x2 vw; vw.x = pk2(vn[0], vn[1]); vw.y = pk2(vn[2], vn[3]);
                *(LAS u32x2*)(VNT + (16 * wave + r) * 144 + (16 * mt + 4 * kg) * 2) = vw; } }
        bf16x8 vf[2];
        {
            bf16x8 qf[4][4], tf[4][2];
#pragma unroll
            for (int mt = 0; mt < 4; ++mt) {
#pragma unroll
                for (int ks = 0; ks < 4; ++ks) qf[mt][ks] = *(const LAS bf16x8*)(QD + (16 * mt + r) * 272 + ks * 64 + kg * 16);
#pragma unroll
                for (int kc = 0; kc < 2; ++kc) tf[mt][kc] = *(const LAS bf16x8*)(ATT + (16 * mt + r) * 144 + kc * 64 + kg * 16); }
#pragma unroll
            for (int kc = 0; kc < 2; ++kc) vf[kc] = *(const LAS bf16x8*)(VNT + (16 * wave + r) * 144 + kc * 64 + kg * 16);
#pragma unroll
            for (int mt = 0; mt < 4; ++mt) { f32x4 a = (f32x4){0.f, 0.f, 0.f, 0.f};
#pragma unroll
                for (int ks = 0; ks < 4; ++ks) a = mfma16(qf[mt][ks], sf[ks], a);
#pragma unroll
                for (int kc = 0; kc < 2; ++kc) a = mfma16(tf[mt][kc], vf[kc], a);
                o[mt] = a; } }
        {
            bf16x8 kf[8][2];
#pragma unroll
            for (int dt = 0; dt < 8; ++dt)
#pragma unroll
                for (int kc = 0; kc < 2; ++kc) kf[dt][kc] = *(const LAS bf16x8*)(KDT + (16 * dt + r) * 144 + kc * 64 + kg * 16);
#pragma unroll
            for (int dt = 0; dt < 8; ++dt) { f32x4 a = S[dt] * egl;
#pragma unroll
                for (int kc = 0; kc < 2; ++kc) a = mfma16(kf[dt][kc], vf[kc], a);
                S[dt] = a; u32x2 sw; sw.x = pk2(a[0], a[1]); sw.y = pk2(a[2], a[3]);
                *(LAS u32x2*)(ST + (16 * wave + r) * 272 + (16 * dt + 4 * kg) * 2) = sw; } }
#pragma unroll
        for (int mt = 0; mt < 4; ++mt) { f32x4 q;
#pragma unroll
            for (int rr = 0; rr < 4; ++rr) q[rr] = row16_sum(o[mt][rr] * o[mt][rr]);
            if (r == 0) *(LAS f32x4*)(PS + wave * 64 + 16 * mt + 4 * kg) = q; }
        LDS_BARRIER();
    }
    LDS_BARRIER();
}
template <int MODE>
__device__ __forceinline__ void ssd_load(const Params& p, LAS unsigned char* lds, int layer, int b, int c, int grp) {
    const int tid = htid(), lane = tid & 63, wave = tid >> 6, t0 = c * 64;
    LAS float* DT = (LAS float*)(lds + 117760); LAS float* ACS = DT + 384;
    LAS unsigned char* XT = lds + 34816;
    if (wave < 6) { const int hh = grp * 6 + wave; const float* small = (const float*)(p.ws + WS_SMALL) + ((size_t)b * SEQ + t0 + lane) * 32;
        const float dt = softplusf_(small[12 + hh] + p.in[I_SSDTB][layer * 12 + hh]); float a = -expf(p.in[I_SSALOG][layer * 12 + hh]) * dt;
#pragma unroll
        for (int o = 1; o < 64; o <<= 1) { const float t = __shfl_up(a, o); if (lane >= o) a += t; }
        DT[wave * 64 + lane] = dt; ACS[wave * 64 + lane] = a; }
    LDS_BARRIER();
    const int cg = tid % 80, seg = tid / 80, ch8 = cg * 8;
    if (tid < 480 && (MODE == 1 || ch8 < 512)) {
        const int col = ch8 < 384 ? grp * 384 + ch8 : (ch8 < 512 ? 768 + grp * 128 + (ch8 - 384) : 1024 + grp * 128 + (ch8 - 512));
        const float* cw = p.in[I_SSCONV] + (size_t)layer * 4 * 1280 + col; const float* cb = p.in[I_SSCONVB] + layer * 1280 + col;
        f32x4 w[4][2], bias[2];
#pragma unroll
        for (int j = 0; j < 4; ++j) { w[j][0] = *(const f32x4*)(cw + j * 1280); w[j][1] = *(const f32x4*)(cw + j * 1280 + 4); }
        bias[0] = *(const f32x4*)cb; bias[1] = *(const f32x4*)(cb + 4);
        const bf16_t* proj = (const bf16_t*)(p.ws + WS_PSSM) + (size_t)b * SEQ * 2048 + col;
        const int ts = seg * 11, hi = ch8 >> 6;
        f32x4 xm[3][2];
#pragma unroll
        for (int i = 0; i < 3; ++i) { const int t = t0 + ts - 3 + i; xm[i][0] = (f32x4){0.f, 0.f, 0.f, 0.f}; xm[i][1] = xm[i][0]; if (t >= 0) ld_bf8(proj + (size_t)t * 2048, xm[i][0], xm[i][1]); }
#pragma unroll
        for (int i = 0; i < 11; ++i) { const int tk = ts + i;
            if (tk < 64) { f32x4 c0, c1; ld_bf8(proj + (size_t)(t0 + tk) * 2048, c0, c1);
                f32x4 a0 = bias[0] + w[3][0] * c0 + w[2][0] * xm[2][0] + w[1][0] * xm[1][0] + w[0][0] * xm[0][0];
                f32x4 a1 = bias[1] + w[3][1] * c1 + w[2][1] * xm[2][1] + w[1][1] * xm[1][1] + w[0][1] * xm[0][1];
                xm[0][0] = xm[1][0]; xm[0][1] = xm[1][1]; xm[1][0] = xm[2][0]; xm[1][1] = xm[2][1]; xm[2][0] = c0; xm[2][1] = c1;
#pragma unroll
                for (int q = 0; q < 4; ++q) { a0[q] = siluf_(a0[q]); a1[q] = siluf_(a1[q]); }
                if (ch8 < 384) { const float sc = MODE == 0 ? DT[hi * 64 + tk] * fexp(ACS[hi * 64 + 63] - ACS[hi * 64 + tk]) : DT[hi * 64 + tk];
#pragma unroll
                    for (int q = 0; q < 4; ++q) { const unsigned pw = pk2(a0[q] * sc, a1[q] * sc);
                        *(LAS bf16_t*)(XT + (ch8 + q) * 144 + tk * 2) = (bf16_t)(pw & 0xffffu); *(LAS bf16_t*)(XT + (ch8 + 4 + q) * 144 + tk * 2) = (bf16_t)(pw >> 16); } }
                else if (MODE == 0) {
#pragma unroll
                    for (int q = 0; q < 4; ++q) { const unsigned pw = pk2(a0[q], a1[q]);
                        *(LAS bf16_t*)(lds + (ch8 - 384 + q) * 144 + tk * 2) = (bf16_t)(pw & 0xffffu); *(LAS bf16_t*)(lds + (ch8 - 384 + 4 + q) * 144 + tk * 2) = (bf16_t)(pw >> 16); } }
                else { u32x4 pw; pw.x = pk2(a0[0], a0[1]); pw.y = pk2(a0[2], a0[3]); pw.z = pk2(a1[0], a1[1]); pw.w = pk2(a1[2], a1[3]);
                    *(LAS u32x4*)(lds + (ch8 < 512 ? 17408 + tk * 272 + (ch8 - 384) * 2 : tk * 272 + (ch8 - 512) * 2)) = pw; } } }
    }
    LDS_BARRIER();
}
__device__ __forceinline__ void ssd_states(const Params& p, LAS unsigned char* lds, int layer, int b, int c, int grp) {
    ssd_load<0>(p, lds, layer, b, c, grp);
    const int tid = htid(), lane = tid & 63, wave = tid >> 6, r = lane & 15, kg = lane >> 4;
    const LAS unsigned char* XT = lds + 34816; const LAS unsigned char* BT = lds; const LAS float* ACS = (const LAS float*)(lds + 117760) + 384;
    bf16_t* st = (bf16_t*)(p.ws + WS_SSST) + ((size_t)(b * 32 + c) * 12 + grp * 6) * 8192;
    for (int t4 = 0; t4 < 24; t4 += 4) {
        bf16x8 af[4][2], bfr[4][2];
#pragma unroll
        for (int q = 0; q < 4; ++q) { const int t = wave + 8 * (t4 + q), hi = t >> 5, mt = (t >> 3) & 3, nt = t & 7;
#pragma unroll
            for (int ks = 0; ks < 2; ++ks) { af[q][ks] = *(const LAS bf16x8*)(XT + (hi * 64 + 16 * mt + r) * 144 + ks * 64 + kg * 16); bfr[q][ks] = *(const LAS bf16x8*)(BT + (16 * nt + r) * 144 + ks * 64 + kg * 16); } }
#pragma unroll
        for (int q = 0; q < 4; ++q) { const int t = wave + 8 * (t4 + q), hi = t >> 5, mt = (t >> 3) & 3, nt = t & 7;
            f32x4 acc = (f32x4){0.f, 0.f, 0.f, 0.f};
#pragma unroll
            for (int ks = 0; ks < 2; ++ks) acc = mfma16(af[q][ks], bfr[q][ks], acc);
#pragma unroll
            for (int rr = 0; rr < 4; rr += 2) { bf16_t* so_ = st + (size_t)hi * 8192 + (16 * mt + 4 * kg + rr) * 128 + 16 * nt + r; ST2_BF(so_, so_ + 128, acc[rr], acc[rr + 1]); } }
    }
    if (tid < 6) ((float*)(p.ws + WS_SSCD))[(b * 32 + c) * 12 + grp * 6 + tid] = expf(ACS[tid * 64 + 63]);
    LDS_BARRIER();
}
__device__ __forceinline__ void ssd_scan(const Params& p, int first_blk, int nblk) {
    const int gt = ((int)blockIdx.x - first_blk) * 512 + htid(), NT = nblk * 512;
    const u32x2* st = (const u32x2*)(p.ws + WS_SSST); const float* cd = (const float*)(p.ws + WS_SSCD); u32x2* pv = (u32x2*)(p.ws + WS_SSPV);
    for (int v = gt; v < NB * 12 * 2048; v += NT) { const int b = v / (12 * 2048), h = (v / 2048) % 12, e = v % 2048;
        f32x4 run = (f32x4){0.f, 0.f, 0.f, 0.f};
        for (int c0 = 0; c0 < 32; c0 += 8) { u32x2 t[8];
#pragma unroll
            for (int i = 0; i < 8; ++i) t[i] = st[((size_t)(b * 32 + c0 + i) * 12 + h) * 2048 + e];
#pragma unroll
            for (int i = 0; i < 8; ++i) { u32x2 w; w.x = pk2(run[0], run[1]); w.y = pk2(run[2], run[3]); pv[((size_t)(b * 32 + c0 + i) * 12 + h) * 2048 + e] = w;
                run = run * cd[(b * 32 + c0 + i) * 12 + h] + (f32x4){lo_bf(t[i].x), hi_bf(t[i].x), lo_bf(t[i].y), hi_bf(t[i].y)}; } }
    }
}
__device__ __forceinline__ void ssd_out(const Params& p, LAS unsigned char* lds, int layer, int b, int c, int grp) {
    ssd_load<1>(p, lds, layer, b, c, grp);
    const int tid = htid(), lane = tid & 63, wave = tid >> 6, r = lane & 15, kg = lane >> 4, t0 = c * 64;
    const LAS unsigned char* CM = lds; const LAS unsigned char* BM = lds + 17408; const LAS unsigned char* XT = lds + 34816; LAS unsigned char* MH = lds + 90112;
    const LAS float* DT = (const LAS float*)(lds + 117760); const LAS float* ACS = DT + 384; LAS float* YG = (LAS float*)lds;
    const bf16_t* prev = (const bf16_t*)(p.ws + WS_SSPV) + ((size_t)(b * 32 + c) * 12 + grp * 6) * 8192;
    f32x4 cb[2];
    {   bf16x8 ca[2][4], cbf[2][4];
#pragma unroll
        for (int q = 0; q < 2; ++q) { const int t = wave * 2 + q, mt = t >> 2, nt = t & 3;
#pragma unroll
            for (int ks = 0; ks < 4; ++ks) { ca[q][ks] = *(const LAS bf16x8*)(CM + (16 * mt + r) * 272 + ks * 64 + kg * 16); cbf[q][ks] = *(const LAS bf16x8*)(BM + (16 * nt + r) * 272 + ks * 64 + kg * 16); } }
#pragma unroll
        for (int q = 0; q < 2; ++q) { f32x4 acc = (f32x4){0.f, 0.f, 0.f, 0.f};
#pragma unroll
            for (int ks = 0; ks < 4; ++ks) acc = mfma16(ca[q][ks], cbf[q][ks], acc);
            cb[q] = acc; } }
    f32x4 y[2][6];
#pragma unroll
    for (int half = 0; half < 2; ++half) {
#pragma unroll
        for (int q = 0; q < 2; ++q) { const int t = wave * 2 + q, mt = t >> 2, nt = t & 3, j = 16 * nt + r;
#pragma unroll
            for (int hl = 0; hl < 3; ++hl) { const int hi = 3 * half + hl; const float aj = ACS[hi * 64 + j];
#pragma unroll
                for (int rr = 0; rr < 4; ++rr) { const int i = 16 * mt + 4 * kg + rr; *(LAS bf16_t*)(MH + hl * 9216 + i * 144 + j * 2) = (bf16_t)f2bf((i >= j) ? cb[q][rr] * fexp(fminf(ACS[hi * 64 + i] - aj, 0.f)) : 0.f); } } }
        bf16x8 pf[6][4];
#pragma unroll
        for (int k = 0; k < 6; ++k) { const int t = wave + 8 * k, hl = t >> 4, nt = t & 3, hi = 3 * half + hl; const bf16_t* pr = prev + (size_t)hi * 8192 + (16 * nt + r) * 128 + kg * 8;
#pragma unroll
            for (int ks = 0; ks < 4; ++ks) pf[k][ks] = *(const bf16x8*)(pr + ks * 32); }
        LDS_BARRIER();
#pragma unroll
        for (int k = 0; k < 6; ++k) { const int t = wave + 8 * k, hl = t >> 4, mt = (t >> 2) & 3, nt = t & 3, hi = 3 * half + hl, hh = grp * 6 + hi;
            f32x4 acc = (f32x4){0.f, 0.f, 0.f, 0.f}, off = acc;
            bf16x8 mf[2], xf[2], cf[4];
#pragma unroll
            for (int ks = 0; ks < 2; ++ks) { mf[ks] = *(const LAS bf16x8*)(MH + hl * 9216 + (16 * mt + r) * 144 + ks * 64 + kg * 16); xf[ks] = *(const LAS bf16x8*)(XT + (hi * 64 + 16 * nt + r) * 144 + ks * 64 + kg * 16); }
#pragma unroll
            for (int ks = 0; ks < 4; ++ks) cf[ks] = *(const LAS bf16x8*)(CM + (16 * mt + r) * 272 + ks * 64 + kg * 16);
#pragma unroll
            for (int ks = 0; ks < 2; ++ks) acc = mfma16(mf[ks], xf[ks], acc);
#pragma unroll
            for (int ks = 0; ks < 4; ++ks) off = mfma16(cf[ks], pf[k][ks], off);
            const u32x2 xw = *(const LAS u32x2*)(XT + (hi * 64 + 16 * nt + r) * 144 + (16 * mt + 4 * kg) * 2); const float xs[4] = {lo_bf(xw.x), hi_bf(xw.x), lo_bf(xw.y), hi_bf(xw.y)};
            const float dsk = p.in[I_SSD][layer * 12 + hh];
#pragma unroll
            for (int rr = 0; rr < 4; ++rr) { const int i = 16 * mt + 4 * kg + rr; acc[rr] += fexp(ACS[hi * 64 + i]) * off[rr] + dsk * xs[rr] * __builtin_amdgcn_rcpf(fmaxf(DT[hi * 64 + i], 1e-30f)); }
            y[half][k] = acc; }
        LDS_BARRIER();
    }
    const bf16_t* zp = (const bf16_t*)(p.ws + WS_PSSM) + ((size_t)b * SEQ + t0) * 2048 + 1280 + grp * 384;
#pragma unroll
    for (int half = 0; half < 2; ++half)
#pragma unroll
        for (int k = 0; k < 6; ++k) { const int t = wave + 8 * k, hl = t >> 4, mt = (t >> 2) & 3, nt = t & 3, hi = 3 * half + hl, ch = hi * 64 + 16 * nt + r;
#pragma unroll
            for (int rr = 0; rr < 4; ++rr) { const int i = 16 * mt + 4 * kg + rr; const float z = bf2f(zp[(size_t)i * 2048 + ch]); YG[i * 388 + ch] = y[half][k][rr] * siluf_(z); } }
    LDS_BARRIER();
    const float* sn = p.in[I_SSNORM] + layer * 768 + grp * 384; bf16_t* yo = (bf16_t*)(p.ws + WS_YSSM) + ((size_t)b * SEQ + t0) * 768 + grp * 384;
#pragma unroll
    for (int i8 = 0; i8 < 8; ++i8) { const int i = 8 * wave + i8; float v[6], ss = 0.f;
#pragma unroll
        for (int k = 0; k < 6; ++k) { v[k] = YG[i * 388 + lane + 64 * k]; ss += v[k] * v[k]; }
        const float rs = rsqrtf(wave_sum(ss) * (1.f / 384.f) + EPS);
#pragma unroll
        for (int k = 0; k < 6; k += 2) ST2_BF(yo + (size_t)i * 768 + lane + 64 * k, yo + (size_t)i * 768 + lane + 64 * (k + 1), v[k] * rs * sn[lane + 64 * k], v[k + 1] * rs * sn[lane + 64 * (k + 1)]); }
    LDS_BARRIER();
}

typedef float f32x16 __attribute__((ext_vector_type(16)));
__device__ __forceinline__ void attn_tile(const Params& p, int b, int g, int j, int r, int qt, int lane) {
    const int d = g == 0 ? 1 : (g == 1 ? 4 : 16), L = SEQ / d, n = lane & 31, hw = lane >> 5;
    const int P0 = b * SEQ + r * L;
    const bf16_t* Q = (const bf16_t*)(p.ws + WS_QK) + (size_t)(0 * 3 + g) * TC * 256 + j * 64;
    const bf16_t* K = (const bf16_t*)(p.ws + WS_QK) + (size_t)(1 * 3 + g) * TC * 256 + j * 64;
    const bf16_t* V = (const bf16_t*)(p.ws + WS_VT) + (size_t)(g * 256 + j * 64) * TC;
    const float sl2 = exp2f(-8.f * (float)(4 * g + j + 1) / 12.f) * (float)d * 1.4426950408889634f;
    bf16x8 qf[4];
    { const bf16_t* qrow = Q + (size_t)(P0 + 32 * qt + n) * 256 + 8 * hw;
#pragma unroll
      for (int s = 0; s < 4; ++s) qf[s] = *(const bf16x8*)(qrow + 16 * s); }
    f32x16 o0, o1;
#pragma unroll
    for (int i = 0; i < 16; ++i) { o0[i] = 0.f; o1[i] = 0.f; }
    float mrun = -1e30f, lrun = 0.f;
    const int pim = (n & 0x13) | (((n >> 2) & 1) << 3) | (((n >> 3) & 1) << 2);
    const int qi = 32 * qt + n;
    const int kb0 = qt > 4 ? qt - 4 : 0;
    bf16x8 kf[4], vf[2][2];
    { const bf16_t* krow = K + (size_t)(P0 + 32 * kb0 + pim) * 256 + 8 * hw;
#pragma unroll
      for (int s = 0; s < 4; ++s) kf[s] = *(const bf16x8*)(krow + 16 * s);
#pragma unroll
      for (int sp = 0; sp < 2; ++sp)
#pragma unroll
          for (int dh = 0; dh < 2; ++dh) vf[sp][dh] = *(const bf16x8*)(V + (size_t)(32 * dh + n) * TC + P0 + 32 * kb0 + 16 * sp + 8 * hw); }
    for (int kb = kb0; kb <= qt; ++kb) {
        f32x16 st;
#pragma unroll
        for (int i = 0; i < 16; ++i) st[i] = 0.f;
#pragma unroll
        for (int s = 0; s < 4; ++s) st = __builtin_amdgcn_mfma_f32_32x32x16_bf16(kf[s], qf[s], st, 0, 0, 0);
        bf16x8 vc[2][2];
#pragma unroll
        for (int sp = 0; sp < 2; ++sp)
#pragma unroll
            for (int dh = 0; dh < 2; ++dh) vc[sp][dh] = vf[sp][dh];
        if (kb < qt) {
            const bf16_t* krow = K + (size_t)(P0 + 32 * (kb + 1) + pim) * 256 + 8 * hw;
#pragma unroll
            for (int s = 0; s < 4; ++s) kf[s] = *(const bf16x8*)(krow + 16 * s);
#pragma unroll
            for (int sp = 0; sp < 2; ++sp)
#pragma unroll
                for (int dh = 0; dh < 2; ++dh) vf[sp][dh] = *(const bf16x8*)(V + (size_t)(32 * dh + n) * TC + P0 + 32 * (kb + 1) + 16 * sp + 8 * hw);
        }
        float mx = -1e30f;
#pragma unroll
        for (int jj = 0; jj < 16; ++jj) { const int kidx = 32 * kb + 16 * (jj >> 3) + 8 * hw + 4 * ((jj >> 2) & 1) + (jj & 3); const int dl = qi - kidx;
            const float sc = (dl >= 0 && dl <= 128) ? st[jj] * 1.4426950408889634f - sl2 * (float)dl : -1e30f; st[jj] = sc; mx = fmaxf(mx, sc); }
        mx = fmaxf(mx, __shfl_xor(mx, 32));
        const float mnew = fmaxf(mrun, mx), alpha = __builtin_amdgcn_exp2f(mrun - mnew);
        float rs = 0.f;
#pragma unroll
        for (int jj = 0; jj < 16; ++jj) { const float pj = __builtin_amdgcn_exp2f(st[jj] - mnew); st[jj] = pj; rs += pj; }
        rs += __shfl_xor(rs, 32);
        lrun = lrun * alpha + rs; mrun = mnew;
#pragma unroll
        for (int i = 0; i < 16; ++i) { o0[i] *= alpha; o1[i] *= alpha; }
#pragma unroll
        for (int sp = 0; sp < 2; ++sp) {
            u32x4 pw; pw.x = pk2(st[8 * sp + 0], st[8 * sp + 1]); pw.y = pk2(st[8 * sp + 2], st[8 * sp + 3]); pw.z = pk2(st[8 * sp + 4], st[8 * sp + 5]); pw.w = pk2(st[8 * sp + 6], st[8 * sp + 7]);
            const bf16x8 pf = __builtin_bit_cast(bf16x8, pw);
            o0 = __builtin_amdgcn_mfma_f32_32x32x16_bf16(vc[sp][0], pf, o0, 0, 0, 0);
            o1 = __builtin_amdgcn_mfma_f32_32x32x16_bf16(vc[sp][1], pf, o1, 0, 0, 0);
        }
    }
    const float inv = 1.f / lrun;
    const int tok = b * SEQ + qi * d + r;
    bf16_t* og = (bf16_t*)(p.ws + WS_OG) + ((size_t)g * TC + tok) * 256 + j * 64 + 4 * hw;
#pragma unroll
    for (int q4 = 0; q4 < 4; ++q4) {
        u32x2 w0, w1; w0.x = pk2(o0[4 * q4] * inv, o0[4 * q4 + 1] * inv); w0.y = pk2(o0[4 * q4 + 2] * inv, o0[4 * q4 + 3] * inv);
        w1.x = pk2(o1[4 * q4] * inv, o1[4 * q4 + 1] * inv); w1.y = pk2(o1[4 * q4 + 2] * inv, o1[4 * q4 + 3] * inv);
        *(u32x2*)(og + 8 * q4) = w0; *(u32x2*)(og + 32 + 8 * q4) = w1;
    }
    if (hw == 0) ((float*)(p.ws + WS_LSE))[((size_t)g * TC + tok) * 4 + j] = (mrun + log2f(lrun)) * 0.6931471805599453f;
}
__device__ __forceinline__ void phase_attn_combine(const Params& p, int skip) {
    const int tid_ = htid(), lane = tid_ & 63, gw = ((int)blockIdx.x - skip) * 8 + (tid_ >> 6), NGW = ((int)gridDim.x - skip) * 8;
    const bf16_t* og = (const bf16_t*)(p.ws + WS_OG); const float* lse = (const float*)(p.ws + WS_LSE); bf16_t* ya = (bf16_t*)(p.ws + WS_YATT);
    for (int t = gw; t < TC; t += NGW) {
        const int j = lane >> 4;
        const float l0 = lse[((size_t)0 * TC + t) * 4 + j], l1 = lse[((size_t)1 * TC + t) * 4 + j], l2 = lse[((size_t)2 * TC + t) * 4 + j];
        const float M = fmaxf(l0, fmaxf(l1, l2)); float w0 = expf(l0 - M), w1 = expf(l1 - M), w2 = expf(l2 - M); const float iw = 1.f / (w0 + w1 + w2); w0 *= iw; w1 *= iw; w2 *= iw;
        const u32x2 a = *((const u32x2*)(og + ((size_t)0 * TC + t) * 256) + lane), bb = *((const u32x2*)(og + ((size_t)1 * TC + t) * 256) + lane), c = *((const u32x2*)(og + ((size_t)2 * TC + t) * 256) + lane);
        u32x2 o; o.x = pk2(w0 * lo_bf(a.x) + w1 * lo_bf(bb.x) + w2 * lo_bf(c.x), w0 * hi_bf(a.x) + w1 * hi_bf(bb.x) + w2 * hi_bf(c.x));
        o.y = pk2(w0 * lo_bf(a.y) + w1 * lo_bf(bb.y) + w2 * lo_bf(c.y), w0 * hi_bf(a.y) + w1 * hi_bf(bb.y) + w2 * hi_bf(c.y));
        *((u32x2*)(ya + (size_t)t * 256) + lane) = o;
    }
}
__device__ __forceinline__ void sub_barrier(unsigned* cnt, unsigned target) {
    asm volatile("s_waitcnt vmcnt(0)" ::: "memory");
    __syncthreads();
    if (threadIdx.x == 0) {
        __builtin_amdgcn_fence(__ATOMIC_RELEASE, "agent"); asm volatile("s_waitcnt vmcnt(0)" ::: "memory");
        (void)xb_add(cnt, 1u);
        unsigned sp = 0; while (xb_ld(cnt) < target) { __builtin_amdgcn_s_sleep(2); if (++sp > (1u << 24)) break; }
        __builtin_amdgcn_fence(__ATOMIC_ACQUIRE, "agent"); asm volatile("s_waitcnt vmcnt(0)" ::: "memory");
    }
    __syncthreads();
}
__device__ __forceinline__ void phase_mixers(const Params& p, LAS unsigned char* lds, int layer) {
    const int G = gridDim.x, NDP = NB * 32 * 6, NSS = NB * 32 * 2;
    for (int item = blockIdx.x; item < NDP + NSS; item += G) {
        if (item < NDP) dn_prep(p, lds, layer, item / 192, (item / 6) % 32, item % 6);
        else { const int it = item - NDP; ssd_states(p, lds, layer, it / 64, (it >> 1) & 31, it & 1); }
    }
}
__device__ __forceinline__ void phase_mixers2(const Params& p, LAS unsigned char* lds, int layer, int rep, unsigned* subcnt, bool use_bar2) {
    const int tid_ = htid(), lane = tid_ & 63, wave = tid_ >> 6, G = gridDim.x, nscan = NB * 6;
    const int ded = G > 2 * nscan ? nscan : 0;
    if ((int)blockIdx.x < ded) { if (!(MIX2_PROBE == 2 && rep > 0)) dn_scan(p, lds, layer, blockIdx.x / 6, blockIdx.x % 6); return; }
    if (MIX2_PROBE == 1 && rep > 0) return;
    if (ded == 0) for (int it = blockIdx.x; it < nscan; it += G) dn_scan(p, lds, layer, it / 6, it % 6);
    const int nb = G - ded, rb = (int)blockIdx.x - ded;
    for (int item = rb; item < NB * 3 * 4 * 64 / 8; item += nb) { const int w = item * 8 + wave;
        const int st = w & 63, jj = (w >> 6) & 3, gg = (w >> 8) % 3, bb = w / 768;
        const int dd = gg == 0 ? 1 : (gg == 1 ? 4 : 16), tiles = SEQ / dd / 32;
        attn_tile(p, bb, gg, jj, st / tiles, st % tiles, lane); }
    ssd_scan(p, ded, nb);
    if (use_bar2) { XcdBarrier bar2; bar2.bar = (unsigned*)(p.ws + WS_CTL) + CW_BAR2; bar2.x = xb_xcc_id(); bar2.st = (volatile LAS unsigned*)(lds + LDS_BYTES - 256) + 12; xcd_barrier(bar2, (unsigned)nb); } else sub_barrier(subcnt, (unsigned)(nb * (rep + 1)));
    for (int it = rb; it < NB * 32 * 2; it += nb) ssd_out(p, lds, layer, it / 64, (it >> 1) & 31, it & 1);
    phase_attn_combine(p, ded);
}

constexpr int NSTEPS = 1 + NCH * (1 + 8 + 11 + 1);
__global__ void __launch_bounds__(512, 2) hybrid_fwd(Params p) {
    extern __shared__ __attribute__((aligned(16))) unsigned char lds_raw[];
    LAS unsigned char* lds = (LAS unsigned char*)lds_raw;
    volatile LAS unsigned* MISC = (volatile LAS unsigned*)(lds + LDS_BYTES - 256);
    if (threadIdx.x < 64) MISC[threadIdx.x] = 0u;
    __syncthreads();
    const int G = gridDim.x, cid = blockIdx.x;
    unsigned char* ws = p.ws;
    XcdBarrier bar; bar.bar = (unsigned*)(ws + WS_CTL) + CW_BAR; bar.x = 0; bar.st = MISC + 8;
    if (p.s_hi - p.s_lo > 1) bar = xcd_barrier_post((unsigned*)(ws + WS_CTL) + CW_BAR, MISC + 8);
    const bool use_bar2 = (p.s_hi - p.s_lo == NSTEPS) && ((int)gridDim.x > 2 * NB * 6);
    if (use_bar2 && (int)blockIdx.x >= NB * 6 && threadIdx.x == 0) (void)xb_add((unsigned*)(ws + WS_CTL) + CW_BAR2 + XB_XCNT(xb_xcc_id()), 1u);
    const int lo = p.s_lo, hi = p.s_hi;
    int step = 0;
    unsigned long long tsum_ = 0ull, tprev_ = TPROBE_MASK != 0u ? __builtin_amdgcn_s_memrealtime() : 0ull;
#define IN_STEP (step >= lo && step < hi)
#define END_STEP do { if (step >= lo && step + 1 < hi) xcd_barrier(bar); \
        if (TPROBE_MASK != 0u) { const unsigned long long tn_ = __builtin_amdgcn_s_memrealtime(); if (step >= 1 && ((TPROBE_MASK >> ((step - 1) % 21)) & 1u)) tsum_ += tn_ - tprev_; tprev_ = tn_; } \
        ++step; } while (0)
    bf16_t* xb = (bf16_t*)(ws + WS_XB); float* ssq = (float*)(ws + WS_SSQ);
    if (IN_STEP) for (int rep_ = 0; rep_ < (REP_PH == 0 ? 3 : 1); ++rep_, (rep_ < (REP_PH == 0 ? 3 : 1) ? xcd_barrier(bar) : (void)0)) phase_convert(p, lds);
    END_STEP;
    for (int chunk = 0; chunk < NCH; ++chunk) {
        float* xo = p.out + (size_t)chunk * TC * D;
        if (IN_STEP) phase_chunk_in(p, chunk);
        END_STEP;
        for (int layer = 0; layer < DEPTH; ++layer) {
            if (IN_STEP) for (int rep_ = 0; rep_ < (REP_PH == 2 ? 3 : 1); ++rep_, (rep_ < (REP_PH == 2 ? 3 : 1) ? xcd_barrier(bar) : (void)0)) {
                ProgIn P; P.S.init(TC / 256, INP / 256, G, cid); P.xb = layer == 0 ? xb : (const bf16_t*)(ws + WS_XB2); P.Wt = (const bf16_t*)(ws + WS_WIN) + (size_t)layer * INP * D; P.ssq = layer == 0 ? ssq : (const float*)(ws + WS_SSQ2);
                P.wsb = ws; P.pb = (const bf16_t*)(ws + WS_PB) + (size_t)layer * TC * PLE; P.wple = (const bf16_t*)(ws + WS_WPLE) + (size_t)layer * D * PLE;
                gemm_phase(lds, P);
            }
            END_STEP;
            if (IN_STEP) for (int rep_ = 0; rep_ < (REP_PH == 3 ? 3 : 1); ++rep_, (rep_ < (REP_PH == 3 ? 3 : 1) ? xcd_barrier(bar) : (void)0)) phase_mixers(p, lds, layer);
            END_STEP;
            if (IN_STEP) for (int rep_ = 0; rep_ < (REP_PH == 4 ? 3 : 1); ++rep_, (rep_ < (REP_PH == 4 ? 3 : 1) ? xcd_barrier(bar) : (void)0)) phase_mixers2(p, lds, layer, rep_, (unsigned*)(ws + WS_CTL) + CW_SUB + (chunk * 2 + layer) * 64, use_bar2);
            END_STEP;
            if (IN_STEP) for (int rep_ = 0; rep_ < (REP_PH == 6 ? 3 : 1); ++rep_, (rep_ < (REP_PH == 6 ? 3 : 1) ? xcd_barrier(bar) : (void)0)) {
                ProgMerge P; P.S.init(TC / 256, 4, G, cid); P.wsb = ws;
                P.wdn = (const bf16_t*)(ws + WS_WDN) + (size_t)layer * D * 768; P.wssm = (const bf16_t*)(ws + WS_WSSM) + (size_t)layer * D * 768; P.watt = (const bf16_t*)(ws + WS_WATT) + (size_t)layer * D * 256;
                gemm_phase(lds, P);
            }
            END_STEP;
            if (IN_STEP) {
                ProgResid P; P.S.init(TC / 256, 4, G, cid); P.A = (const bf16_t*)(ws + WS_MERGED); P.lda = 2048; P.nt = 16; P.Wt = (const bf16_t*)(ws + WS_WOUT) + (size_t)layer * D * D; P.ldb = 2048;
                P.xin = layer == 0 ? p.in[I_X] + (size_t)chunk * TC * D : xo; P.xout = xo; P.xb = xb; P.ssq = ssq; P.sc = 1.f; P.qx = 1;
                gemm_phase(lds, P);
            }
            END_STEP;
            if (layer == 0) {
                if (IN_STEP) for (int rep_ = 0; rep_ < (REP_PH == 8 ? 3 : 1); ++rep_, (rep_ < (REP_PH == 8 ? 3 : 1) ? xcd_barrier(bar) : (void)0)) {
                    ProgFfnGu P; P.S.init(TC / 256, 2 * FFN / 256, G, cid); P.xb = xb; P.Wt = (const bf16_t*)(ws + WS_WFGU); P.ssq = ssq; P.act = (bf16_t*)(ws + WS_ACT);
                    gemm_phase(lds, P);
                }
                END_STEP;
                if (IN_STEP) {
                    ProgResid P; P.S.init(TC / 256, 4, G, cid); P.A = (const bf16_t*)(ws + WS_ACT); P.lda = 2 * FFN; P.nt = FFN / 64; P.Wt = (const bf16_t*)(ws + WS_WFD); P.ldb = 2 * FFN;
                    P.xin = xo; P.xout = xo; P.xb = xb; P.ssq = ssq; P.sc = (DBG_ABL & 8) ? 0.f : 1.f; P.qx = 0;
                    gemm_phase(lds, P);
                }
                END_STEP;
            } else {
                if (IN_STEP) phase_router(p, lds, chunk);
                END_STEP;
                if (IN_STEP) phase_slots(p, chunk);
                END_STEP;
                if (IN_STEP) for (int rep_ = 0; rep_ < (REP_PH == 12 ? 3 : 1); ++rep_, (rep_ < (REP_PH == 12 ? 3 : 1) ? xcd_barrier(bar) : (void)0)) {
                    ProgMoeGu P; P.S.init((const unsigned*)(ws + WS_CTL) + CW_CNT + chunk * 64, 2 * EXD / 256, G, cid); P.xb = xb; P.Wt = (const bf16_t*)(ws + WS_WMGU); P.ssq = ssq;
                    P.idx = (const int*)(ws + WS_ROUTE) + RT_IDX; P.act = (bf16_t*)(ws + WS_ACTM);
                    gemm_phase(lds, P);
                }
                END_STEP;
                if (IN_STEP) for (int rep_ = 0; rep_ < (REP_PH == 13 ? 3 : 1); ++rep_, (rep_ < (REP_PH == 13 ? 3 : 1) ? xcd_barrier(bar) : (void)0)) {
                    ProgMoeDown P; P.init((const unsigned*)(ws + WS_CTL) + CW_CNT + chunk * 64, G, cid); P.act = (const bf16_t*)(ws + WS_ACTM); P.Wt = (const bf16_t*)(ws + WS_WMD); P.ypair = (bf16_t*)(ws + WS_YPAIR); P.partk = (float*)(ws + WS_PARTK);
                    gemm_phase(lds, P);
                }
                END_STEP;
                if (IN_STEP) phase_combine(p, chunk);
                END_STEP;
            }
            if (IN_STEP) {
                ProgPle P; P.S.init(TC / 256, 4, G, cid); P.xb = xb; P.wpg = (const bf16_t*)(ws + WS_WPG) + (size_t)layer * D * D; P.pp = (const bf16_t*)(ws + WS_PP); P.ssq = ssq;
                P.x = xo; P.xbout = (bf16_t*)(ws + WS_XB2); P.ssqout = (float*)(ws + WS_SSQ2);
                gemm_phase(lds, P);
            }
            END_STEP;
        }
        if (IN_STEP) phase_final(p, chunk);
        END_STEP;
    }
    if (TPROBE_MASK != 0u && blockIdx.x == 0) { const unsigned long long t0_ = __builtin_amdgcn_s_memrealtime(); while (__builtin_amdgcn_s_memrealtime() - t0_ < 4ull * tsum_) __builtin_amdgcn_s_sleep(16); }
#undef IN_STEP
#undef END_STEP
}

#if defined(DBG_REP_STEP)
__global__ void dbg_csum(const unsigned* buf, size_t n, unsigned long long* out) {
    unsigned long long a = 0;
    for (size_t i = (size_t)blockIdx.x * 256 + threadIdx.x; i < n; i += (size_t)gridDim.x * 256) a += (unsigned long long)buf[i] * (unsigned long long)((i % 1021) + 1);
    atomicAdd(out, a);
}
__global__ void dbg_verdict(float* out, const unsigned long long* cs, int R) {
    bool bad = false; for (int r = 1; r < R; ++r) bad = bad || (cs[r] != cs[0]);
    const float v = bad ? __builtin_nanf("") : 0.f; const size_t n = (size_t)BATCH * SEQ * D;
    for (size_t i = (size_t)blockIdx.x * 256 + threadIdx.x; i < n; i += (size_t)gridDim.x * 256) out[i] = v;
}
#endif
#if defined(DBG_STOP)
#ifndef DBG_DUMP
#define DBG_DUMP 0
#define DBG_DUMP_OFF 0
#endif
__global__ void dbg_fill(float* out, const unsigned short* buf, int dump) {
    const size_t n = (size_t)BATCH * SEQ * D, c0 = (size_t)TC * D;
    for (size_t i = (size_t)blockIdx.x * 256 + threadIdx.x; i < n; i += (size_t)gridDim.x * 256) {
        if (i >= c0) out[i] = 0.f; else if (dump) out[i] = __uint_as_float(((unsigned)buf[i]) << 16);
    }
}
#endif
extern "C" void kernel_launch(void* const* d_in, const int* in_sizes, int n_in, void* d_out, int out_size, void* d_ws, size_t ws_size, hipStream_t stream) {
    static int grid = 0;
    if (grid == 0) {
        if (n_in != 30 || out_size != BATCH * SEQ * D || ws_size < WS_END) { fprintf(stderr, "kernel_launch: unexpected shapes (n_in %d, out %d, ws %zu < %zu)\n", n_in, out_size, ws_size, (size_t)WS_END); grid = -1; return; }
        int dev = 0, cus = 0;
        if (hipGetDevice(&dev) != hipSuccess || hipDeviceGetAttribute(&cus, hipDeviceAttributeMultiprocessorCount, dev) != hipSuccess) { grid = -1; return; }
        if (hipFuncSetAttribute((const void*)hybrid_fwd, hipFuncAttributeMaxDynamicSharedMemorySize, LDS_BYTES) != hipSuccess) { fprintf(stderr, "kernel_launch: hipFuncSetAttribute failed\n"); grid = -1; return; }
        int per_cu = 0;
        if (hipOccupancyMaxActiveBlocksPerMultiprocessor(&per_cu, (const void*)hybrid_fwd, 512, LDS_BYTES) != hipSuccess || per_cu < 1) { fprintf(stderr, "kernel_launch: occupancy query says %d\n", per_cu); }
        (void)hipGetLastError();
        grid = cus;
    }
    if (grid < 0) return;
    (void)hipMemsetAsync((char*)d_ws + WS_CTL, 0, MiB, stream);
    Params p{};
    for (int i = 0; i < 30; ++i) p.in[i] = (const float*)d_in[i];
    p.out = (float*)d_out; p.ws = (unsigned char*)d_ws;
#if defined(DBG_REP_STEP)
    for (int s = 0; s < DBG_REP_STEP; ++s) { p.s_lo = s; p.s_hi = s + 1; hipLaunchKernelGGL(hybrid_fwd, dim3(grid), dim3(512), LDS_BYTES, stream, p); }
    unsigned long long* cs = (unsigned long long*)((char*)d_ws + WS_CTL + 512 * 1024);
    for (int r = 0; r < DBG_REP_N; ++r) { p.s_lo = DBG_REP_STEP; p.s_hi = DBG_REP_STEP + 1; hipLaunchKernelGGL(hybrid_fwd, dim3(grid), dim3(512), LDS_BYTES, stream, p);
        hipLaunchKernelGGL(dbg_csum, dim3(1024), dim3(256), 0, stream, (const unsigned*)((const char*)d_ws + DBG_REP_OFF), (size_t)(DBG_REP_BYTES) / 4, cs + r); }
    hipLaunchKernelGGL(dbg_verdict, dim3(2048), dim3(256), 0, stream, (float*)d_out, cs, (int)DBG_REP_N);
#elif defined(DBG_STOP)
    for (int s = 0; s < DBG_STOP; ++s) { p.s_lo = s; p.s_hi = s + 1; hipLaunchKernelGGL(hybrid_fwd, dim3(grid), dim3(512), LDS_BYTES, stream, p); }
    hipLaunchKernelGGL(dbg_fill, dim3(2048), dim3(256), 0, stream, (float*)d_out, (const unsigned short*)((const char*)d_ws + DBG_DUMP_OFF), (int)DBG_DUMP);
#elif ONE_LAUNCH
    p.s_lo = 0; p.s_hi = NSTEPS;
    hipLaunchKernelGGL(hybrid_fwd, dim3(grid), dim3(512), LDS_BYTES, stream, p);
#else
    for (int s = 0; s < NSTEPS; ++s) { p.s_lo = s; p.s_hi = s + 1; hipLaunchKernelGGL(hybrid_fwd, dim3(grid), dim3(512), LDS_BYTES, stream, p); }
#endif
}
```

```cpp
#include <hip/hip_runtime.h>
#include <cstdio>
#include <cstdint>

#define GAS __attribute__((address_space(1)))
#define LAS __attribute__((address_space(3)))
typedef unsigned short bf16_t;
typedef short bf16x8 __attribute__((ext_vector_type(8)));
typedef float f32x4 __attribute__((ext_vector_type(4)));
typedef float f32x2 __attribute__((ext_vector_type(2)));
typedef unsigned u32x4 __attribute__((ext_vector_type(4)));
typedef unsigned u32x2 __attribute__((ext_vector_type(2)));

#ifndef REP_PH
#define REP_PH -1
#endif
#ifndef EMU_FP8
#define EMU_FP8 0
#endif
#ifndef TPROBE_MASK
#define TPROBE_MASK 0u
#endif
#define TPROBE_ON (TPROBE_MASK != 0u)
#ifndef MIX2_PROBE
#define MIX2_PROBE 0
#endif
#ifndef DBG_ABL
#define DBG_ABL 0
#endif
#ifndef ONE_LAUNCH
#define ONE_LAUNCH 1
#endif

constexpr int D = 1024, BATCH = 32, SEQ = 2048, DEPTH = 2;
constexpr int PLE = 256;
constexpr float EPS = 1e-6f;
constexpr int FFN = 2816, NE = 8, EXD = 3584;
constexpr int C_DNZ = 2304, C_DNA = 3072, C_DNB = 3078, C_XBC = 3084, C_SSZ = 4364, C_SSDT = 5132, C_ATT = 5144, C_GATE = 7448, INW = 10520;
constexpr int NB = 8, TC = NB * SEQ, NCH = BATCH / NB;
constexpr int INP = 10752;
constexpr int MOE_SLOTS = 2 * TC + NE * 256;

constexpr size_t MiB = 1u << 20;
constexpr size_t WS_CTL = 0;
constexpr size_t WS_WIN = 1 * MiB;
constexpr size_t WS_WDN = WS_WIN + 42 * MiB;
constexpr size_t WS_WSSM = WS_WDN + 3 * MiB;
constexpr size_t WS_WATT = WS_WSSM + 3 * MiB;
constexpr size_t WS_WOUT = WS_WATT + 1 * MiB;
constexpr size_t WS_WFGU = WS_WOUT + 4 * MiB;
constexpr size_t WS_WFD = WS_WFGU + 11 * MiB;
constexpr size_t WS_WMGU = WS_WFD + 6 * MiB;
constexpr size_t WS_WMD = WS_WMGU + 112 * MiB;
constexpr size_t WS_WPG = WS_WMD + 56 * MiB;
constexpr size_t WS_WPLE = WS_WPG + 4 * MiB;
constexpr size_t WS_WR = WS_WPLE + 1 * MiB;
constexpr size_t WS_ACT0 = WS_WR + 1 * MiB;
constexpr size_t WS_XB = WS_ACT0;
constexpr size_t WS_SSQ = WS_XB + 32 * MiB;
constexpr size_t WS_PB = WS_SSQ + 1 * MiB;
constexpr size_t WS_ROUTE = WS_PB + 16 * MiB;
constexpr size_t WS_PART = WS_ROUTE + 1 * MiB;
constexpr size_t WS_PP = WS_PART;
constexpr size_t WS_MERGED = WS_PART + 64 * MiB;
constexpr size_t WS_Y = WS_MERGED + 32 * MiB;
constexpr size_t WS_YDN = WS_Y, WS_YSSM = WS_Y + 24 * MiB, WS_YATT = WS_Y + 48 * MiB, WS_OG = WS_Y + 56 * MiB, WS_LSE = WS_Y + 80 * MiB;
constexpr size_t WS_YPAIR = WS_Y;
constexpr size_t WS_PROJ = WS_Y + 81 * MiB;
constexpr size_t WS_PDN = WS_PROJ, WS_PSSM = WS_PDN + 96 * MiB, WS_SMALL = WS_PSSM + 64 * MiB, WS_QK = WS_SMALL + 2 * MiB, WS_VT = WS_QK + 48 * MiB, WS_GATES = WS_VT + 24 * MiB;
constexpr size_t WS_ACT = WS_PROJ, WS_ACTM = WS_PROJ;
constexpr int KSPL = 7, TAILMAX = 32;
constexpr size_t WS_PARTK = WS_PROJ + 256 * MiB;
static_assert((size_t)MOE_SLOTS * EXD * 2 <= 256 * MiB && WS_PARTK + (size_t)KSPL * (TAILMAX / 4) * 256 * 1024 * 4 <= WS_PROJ + 330 * MiB, "partk");
constexpr size_t WS_SCR = WS_PROJ + 330 * MiB;
constexpr size_t WS_XB2 = WS_SCR;
constexpr size_t WS_SSQ2 = WS_XB2 + 32 * MiB;
constexpr size_t WS_PART2 = WS_XB2 + 40 * MiB;
constexpr int DNS_ITEM = 73728;
constexpr size_t WS_DNS = WS_SCR + 40 * MiB;
constexpr size_t WS_DNEGL = WS_DNS + (size_t)NB * 32 * 6 * DNS_ITEM;
constexpr size_t WS_END = WS_SCR + 200 * MiB;
constexpr size_t WS_SSCD = WS_DNEGL + 8192;
static_assert(WS_SSCD + 16384 <= WS_END, "dn scratch");
constexpr size_t WS_SSPV = WS_SCR + 150 * MiB;
static_assert(WS_SSCD + 16384 <= WS_SSPV && WS_SSPV + 48 * MiB <= WS_END, "ssd prev");
constexpr size_t WS_SSST = WS_PART + 48 * MiB;
static_assert(WS_MERGED == WS_PART + 64 * MiB && (size_t)NB * 32 * 12 * 8192 * 2 <= 48 * MiB, "ssd states (bf16) sit in PART[48, 64) | MERGED, both idle during the mixers");
static_assert((size_t)MOE_SLOTS * EXD * 2 <= 330 * MiB, "moe act overlay");
static_assert((size_t)MOE_SLOTS * D * 2 <= 81 * MiB, "ypair overlay");
static_assert(WS_END <= 1024 * MiB, "workspace");
constexpr int RT_TOPE = 0, RT_TOPP = 2 * TC, RT_TOPW = 4 * TC, RT_TOPS = 6 * TC, RT_IDX = 8 * TC;
static_assert((size_t)(RT_IDX + MOE_SLOTS) * 4 <= MiB, "route");
constexpr int CW_BAR = 4096;
constexpr int CW_BAR2 = 8192;
constexpr int CW_SUB = 20480;
constexpr int CW_CNT = 16384;

constexpr int LDS_BYTES = 147456;
__device__ __forceinline__ int htid() { int t = threadIdx.x; asm volatile("" : "+v"(t)); return t; }
__device__ __forceinline__ float bf2f(bf16_t b) { return __uint_as_float(((unsigned)b) << 16); }
__device__ __forceinline__ unsigned f2bf(float f) { unsigned u = __float_as_uint(f); return (u + 0x7fffu + ((u >> 16) & 1u)) >> 16; }
typedef __bf16 bf16x2_t __attribute__((ext_vector_type(2)));
__device__ __forceinline__ unsigned pk2(float lo, float hi) { const f32x2 v = {lo, hi}; return __builtin_bit_cast(unsigned, __builtin_convertvector(v, bf16x2_t)); }
#define ST2_BF(PA, PB, A, B) do { const unsigned pw_ = pk2((A), (B)); *(PA) = (bf16_t)(pw_ & 0xffffu); *(PB) = (bf16_t)(pw_ >> 16); } while (0)
__device__ __forceinline__ float lo_bf(unsigned w) { return __uint_as_float(w << 16); }
__device__ __forceinline__ float hi_bf(unsigned w) { return __uint_as_float(w & 0xffff0000u); }
__device__ __forceinline__ float fexp(float x) { return __builtin_amdgcn_exp2f(x * 1.4426950408889634f); }
__device__ __forceinline__ float sigmoidf_(float x) { return __builtin_amdgcn_rcpf(1.f + fexp(-x)); }
__device__ __forceinline__ float siluf_(float x) { return x * sigmoidf_(x); }
__device__ __forceinline__ float softplusf_(float x) { const float e = fexp(x); return x > 20.f ? x : (x < -9.f ? e : __builtin_amdgcn_logf(1.f + e) * 0.6931471805599453f); }
__device__ __forceinline__ float q8(float v) {
    if (!EMU_FP8) return v;
    const float a = fabsf(v); float r;
    if (a < 0.015625f) r = rintf(a * 512.f) * (1.f / 512.f);
    else { unsigned u = __float_as_uint(a); u += 0x7FFFFu + ((u >> 20) & 1u); u &= ~0xFFFFFu; r = fminf(__uint_as_float(u), 448.f); }
    return copysignf(r, v);
}
__device__ __forceinline__ f32x4 q8v(f32x4 v) { return (f32x4){q8(v[0]), q8(v[1]), q8(v[2]), q8(v[3])}; }
__device__ __forceinline__ float wave_sum(float v) {
#pragma unroll
    for (int o = 1; o < 64; o <<= 1) v += __shfl_xor(v, o);
    return v;
}
__device__ __forceinline__ float wave_max(float v) {
#pragma unroll
    for (int o = 1; o < 64; o <<= 1) v = fmaxf(v, __shfl_xor(v, o));
    return v;
}
__device__ __forceinline__ float rstd_of(const float* ssq, int row) {
    const f32x4* p = (const f32x4*)(ssq + (size_t)row * 16);
    const f32x4 a = p[0], b = p[1], c = p[2], d = p[3];
    const float s = (((a.x + a.y) + (a.z + a.w)) + ((b.x + b.y) + (b.z + b.w))) + (((c.x + c.y) + (c.z + c.w)) + ((d.x + d.y) + (d.z + d.w)));
    return rsqrtf(s * (1.f / 1024.f) + EPS);
}
__device__ __forceinline__ int token_of_pos(int d, int p) {
    const int b = p >> 11, q = p & 2047;
    const int t = (d == 1) ? q : (d == 4) ? (4 * (q & 511) + (q >> 9)) : (16 * (q & 127) + (q >> 7));
    return b * 2048 + t;
}

#define XB_TMO      128
#define XB_XCNT(j)  (256  + 64 * (j))
#define XB_XSUB(j)  (1280 + 64 * (j))
#define XB_XGEN(j)  (2304 + 64 * (j))
#define XB_TOP      3328
#define XB_TOPGEN   3392
#define XCD_BAR_WORDS 3456
#define XB_SPIN_CAP (1u << 22)
__device__ __forceinline__ unsigned xb_ld(unsigned* p)              { return __hip_atomic_load(p, __ATOMIC_RELAXED, __HIP_MEMORY_SCOPE_AGENT); }
__device__ __forceinline__ unsigned xb_add(unsigned* p, unsigned v) { return __hip_atomic_fetch_add(p, v, __ATOMIC_RELAXED, __HIP_MEMORY_SCOPE_AGENT); }
__device__ __forceinline__ unsigned xb_xcc_id() { return (unsigned)__builtin_amdgcn_s_getreg((3 << 11) | 20) & 0xFu; }
#define XB_SPIN(cond, bar) do { unsigned _sp = 0; while (cond) { __builtin_amdgcn_s_sleep(1); \
    if ((++_sp & 255u) == 0u) { if (xb_ld(&(bar)[XB_TMO])) break; if (_sp > XB_SPIN_CAP) { atomicAdd(&(bar)[XB_TMO], 1u); break; } } } } while (0)
struct XcdBarrier { unsigned* bar; unsigned x; volatile LAS unsigned* st; };
__device__ __forceinline__ XcdBarrier xcd_barrier_post(unsigned* bar, volatile LAS unsigned* st) {
    XcdBarrier b; b.bar = bar; b.x = xb_xcc_id(); b.st = st;
    if (threadIdx.x == 0) (void)xb_add(&bar[XB_XCNT(b.x)], 1u);
    return b;
}
__device__ __forceinline__ void xcd_barrier_complete(unsigned* bar, unsigned x, unsigned& nloc, unsigned& nx, unsigned G) {
    unsigned sum, cnt, mine, sp = 0u;
    for (;;) {
        sum = 0u; cnt = 0u; mine = 0u;
#pragma unroll 1
        for (unsigned j = 0; j < 16; ++j) { const unsigned c = xb_ld(&bar[XB_XCNT(j)]); sum += c; cnt += (c > 0u) ? 1u : 0u; }
        mine = xb_ld(&bar[XB_XCNT(x)]);
        if (sum == G) break;
        __builtin_amdgcn_s_sleep(1);
        if ((++sp & 255u) == 0u) { if (xb_ld(&bar[XB_TMO])) break; if (sp > XB_SPIN_CAP) { atomicAdd(&bar[XB_TMO], 1u); break; } }
    }
    nloc = mine > 0u ? mine : 1u; nx = cnt > 0u ? cnt : 1u;
}
__device__ __forceinline__ void xcd_barrier(const XcdBarrier& b, unsigned nparts = 0u) {
    asm volatile("s_waitcnt vmcnt(0)" ::: "memory");
    __syncthreads();
    if (threadIdx.x == 0) {
        unsigned* bar = b.bar;
        __builtin_amdgcn_s_waitcnt(0);
        unsigned nloc = b.st[0], nx = b.st[1];
        if (nloc == 0u) { xcd_barrier_complete(bar, b.x, nloc, nx, nparts ? nparts : gridDim.x * gridDim.y * gridDim.z); b.st[0] = nloc; b.st[1] = nx; }
        const unsigned old = xb_add(&bar[XB_XSUB(b.x)], 1u);
        const unsigned gen = old / nloc;
        if (old + 1u == (gen + 1u) * nloc) {
            __builtin_amdgcn_fence(__ATOMIC_RELEASE, "agent");
            asm volatile("s_waitcnt vmcnt(0)" ::: "memory");
            const unsigned og = xb_add(&bar[XB_TOP], 1u);
            const unsigned tg = og / nx;
            if (og + 1u == (tg + 1u) * nx) xb_add(&bar[XB_TOPGEN], 1u);
            else XB_SPIN(xb_ld(&bar[XB_TOPGEN]) == tg, bar);
            __builtin_amdgcn_fence(__ATOMIC_ACQUIRE, "agent");
            xb_add(&bar[XB_XGEN(b.x)], 1u);
            asm volatile("s_waitcnt vmcnt(0)" ::: "memory");
        } else {
            XB_SPIN(xb_ld(&bar[XB_XGEN(b.x)]) == gen, bar);
            __builtin_amdgcn_fence(__ATOMIC_ACQUIRE, "agent");
            asm volatile("s_waitcnt vmcnt(0)" ::: "memory");
        }
    }
    __syncthreads();
}

constexpr int BM = 256, BK = 64, HALF = 128, HTB = HALF * BK * 2, STAGE_BYTES = 8 * HTB, NXCD = 8, WGM = 4;
__device__ __forceinline__ int lds_byte(int r, int c) { const int st = (r >> 4) * 2 + (c >> 5), rr = r & 15, cc = c & 31, ob = rr * 64 + cc * 2; return st * 1024 + (ob ^ (((ob >> 9) & 1) << 5)); }
__device__ __forceinline__ void stage_rc(int b, int& R, int& C) { const int st = b / 1024, sb = b % 1024, swz = sb ^ (((sb >> 9) & 1) << 5); R = (st >> 1) * 16 + swz / 64; C = (st & 1) * 32 + (swz % 64) / 2; }
__device__ __forceinline__ int perm32(int rho) { const int n = rho >> 4, i = rho & 15; return 8 * (i >> 2) + 4 * n + (i & 3); }

struct Unit { int pm, pn; };
struct StaticOrder {
    int nM, nN, nwg, G, c;
    __device__ __forceinline__ void init(int nM_, int nN_, int G_, int c_) { nM = nM_; nN = nN_; nwg = nM * nN; G = G_; c = c_; }
    __device__ __forceinline__ bool next(int i, Unit& u) const {
        const long L = (long)i * G + c; if (L >= nwg) return false;
        int wgid = (int)L; { const int q = nwg / NXCD, r = nwg % NXCD, xcd = wgid % NXCD, off = wgid / NXCD; wgid = (xcd < r ? xcd * (q + 1) : r * (q + 1) + (xcd - r) * q) + off; }
        const int nig = WGM * nN, gid = wgid / nig, fm = gid * WGM, gsz = (nM - fm) < WGM ? (nM - fm) : WGM;
        u.pm = fm + ((wgid % nig) % gsz); u.pn = (wgid % nig) / gsz; return true;
    }
};
struct GU { const char* A; const char* B; int lda, ldb, nt, mapA, mapB; const int* idx; int pm, pn, sub, aux; };
__device__ __forceinline__ unsigned row_off(int map, int RR, int ld, const int* idx) {
    int row;
    if (map == 0) row = RR;
    else if (map == 4) row = 4 * RR;
    else if (map == 16) row = 16 * (RR & 127) + (RR >> 7);
    else row = idx[RR];
    return (unsigned)row * (unsigned)ld;
}
template <class Prog>
__device__ __forceinline__ void gemm_phase(LAS unsigned char* lds, const Prog& P) {
    const int tid = htid(), wid = __builtin_amdgcn_readfirstlane(tid >> 6), lane = tid & 63, wr = wid >> 2, wc = wid & 3, fr = lane & 15, fq = lane >> 4;
    GU cur, nxt; int ui = 0;
    if (!P.unit(0, cur)) return;
    unsigned vA[4], vB[4];
#define G_SETV(u) do { int tz_ = threadIdx.x; asm volatile("" : "+v"(tz_)); int R0, C0, R1, C1; stage_rc(tz_ * 16, R0, C0); stage_rc(tz_ * 16 + 8192, R1, C1); \
        const int Rb0 = (R0 & ~31) + perm32(R0 & 31), Rb1 = (R1 & ~31) + perm32(R1 & 31); \
        vA[0] = row_off((u).mapA, R0, (u).lda, (u).idx) + C0 * 2; vA[1] = row_off((u).mapA, R1, (u).lda, (u).idx) + C1 * 2; \
        vA[2] = row_off((u).mapA, R0 + 128, (u).lda, (u).idx) + C0 * 2; vA[3] = row_off((u).mapA, R1 + 128, (u).lda, (u).idx) + C1 * 2; \
        vB[0] = row_off((u).mapB, Rb0, (u).ldb, nullptr) + C0 * 2; vB[1] = row_off((u).mapB, Rb1, (u).ldb, nullptr) + C1 * 2; \
        vB[2] = row_off((u).mapB, Rb0 + 128, (u).ldb, nullptr) + C0 * 2; vB[3] = row_off((u).mapB, Rb1 + 128, (u).ldb, nullptr) + C1 * 2; } while (0)
    G_SETV(cur);
    const unsigned ldsw = (unsigned)wid * 1024u;
    const int aoff = lds_byte(wr * 64 + fr, fq * 8), boff = lds_byte(wc * 32 + fr, fq * 8);
#define G_SA(b, h) (((b) * 2 + (h)) * HTB)
#define G_SB(b, h) ((4 + (b) * 2 + (h)) * HTB)
#define G_STAGE(bufoff, gbase, v, h) do { \
        __builtin_amdgcn_global_load_lds((const unsigned*)((gbase) + (v)[2 * (h)]), (LAS unsigned*)(lds + (bufoff) + ldsw), 16, 0, 0); \
        __builtin_amdgcn_global_load_lds((const unsigned*)((gbase) + (v)[2 * (h) + 1]), (LAS unsigned*)(lds + (bufoff) + ldsw + 8192), 16, 0, 0); } while (0)
#define G_LDA(dst, b, h) do { _Pragma("unroll") for (int m = 0; m < 4; ++m) _Pragma("unroll") for (int k = 0; k < 2; ++k) dst[m][k] = *(const LAS bf16x8*)(lds + G_SA(b, h) + aoff + m * 2048 + k * 1024); } while (0)
#define G_LDB(dst, b, h) do { _Pragma("unroll") for (int n = 0; n < 2; ++n) _Pragma("unroll") for (int k = 0; k < 2; ++k) dst[n][k] = *(const LAS bf16x8*)(lds + G_SB(b, h) + boff + n * 2048 + k * 1024); } while (0)
#define G_MMA(ai, bj, At, Bt) do { __builtin_amdgcn_s_setprio(1); _Pragma("unroll") for (int m = 0; m < 4; ++m) _Pragma("unroll") for (int n = 0; n < 2; ++n) _Pragma("unroll") for (int k = 0; k < 2; ++k) \
        acc[ai][bj][m][n] = __builtin_amdgcn_mfma_f32_16x16x32_bf16(Bt[n][k], At[m][k], acc[ai][bj][m][n], 0, 0, 0); __builtin_amdgcn_s_setprio(0); } while (0)
#define G_WAIT_V(n) asm volatile("s_waitcnt vmcnt(" #n ")" ::: "memory")
#define G_WAIT_L(n) asm volatile("s_waitcnt lgkmcnt(" #n ")" ::: "memory")
#define G_BAR __builtin_amdgcn_s_barrier()
#define G_SCHED __builtin_amdgcn_sched_barrier(0)
    f32x4 acc[2][2][4][2];
#pragma unroll
    for (int a = 0; a < 2; ++a)
#pragma unroll
        for (int b = 0; b < 2; ++b)
#pragma unroll
            for (int m = 0; m < 4; ++m)
#pragma unroll
                for (int n = 0; n < 2; ++n) acc[a][b][m][n] = (f32x4){0.f, 0.f, 0.f, 0.f};
    bf16x8 At[4][2], B0[2][2], B1[2][2];
    const char* cA = cur.A; const char* cB = cur.B;
    const size_t kstep = (size_t)(BK * 2);
    G_STAGE(G_SB(0, 0), cB, vB, 0); G_STAGE(G_SA(0, 0), cA, vA, 0); G_STAGE(G_SB(0, 1), cB, vB, 1); G_STAGE(G_SA(0, 1), cA, vA, 1);
    if (wr == 1) G_BAR;
    G_WAIT_V(4); G_BAR;
    G_STAGE(G_SB(1, 0), cB + kstep, vB, 0); G_STAGE(G_SA(1, 0), cA + kstep, vA, 0); G_STAGE(G_SB(1, 1), cB + kstep, vB, 1);
    G_WAIT_V(6); G_BAR;
    for (;;) {
        const bool has_next = P.unit(ui + 1, nxt);
        const char* nA = has_next ? nxt.A : cA; const char* nB = has_next ? nxt.B : cB;
        const int nt = cur.nt;
        for (int t = 0; t < nt; t += 2) {
            const bool last = (t == nt - 2);
            const char* a1 = cA + (size_t)(t + 1) * kstep;
            const char* a2 = last ? nA : cA + (size_t)(t + 2) * kstep; const char* b2 = last ? nB : cB + (size_t)(t + 2) * kstep;
            const char* a3 = a2 + kstep; const char* b3 = b2 + kstep;
            G_STAGE(G_SA(1, 1), a1, vA, 1);
            if (last && has_next) { G_SETV(nxt); }
            G_LDB(B0, 0, 0); G_SCHED; G_LDA(At, 0, 0);
            G_WAIT_L(8); G_BAR; G_WAIT_L(0); G_MMA(0, 0, At, B0); G_BAR; G_SCHED;
            G_LDB(B1, 0, 1); G_STAGE(G_SB(0, 0), b2, vB, 0);
            G_BAR; G_WAIT_L(0); G_MMA(0, 1, At, B1); G_BAR;
            G_LDA(At, 0, 1); G_STAGE(G_SA(0, 0), a2, vA, 0);
            G_BAR; G_WAIT_L(0); G_MMA(1, 0, At, B0); G_BAR; G_SCHED;
            G_STAGE(G_SB(0, 1), b2, vB, 1);
            G_WAIT_V(6); G_BAR; G_MMA(1, 1, At, B1); G_BAR;
            G_LDB(B0, 1, 0); G_SCHED; G_LDA(At, 1, 0); G_STAGE(G_SA(0, 1), a2, vA, 1);
            G_WAIT_L(8); G_BAR; G_WAIT_L(0); G_MMA(0, 0, At, B0); G_BAR; G_SCHED;
            G_LDB(B1, 1, 1); G_STAGE(G_SB(1, 0), b3, vB, 0);
            G_BAR; G_WAIT_L(0); G_MMA(0, 1, At, B1); G_BAR;
            G_LDA(At, 1, 1); G_STAGE(G_SA(1, 0), a3, vA, 0);
            G_BAR; G_WAIT_L(0); G_MMA(1, 0, At, B0); G_BAR; G_SCHED;
            G_STAGE(G_SB(1, 1), b3, vB, 1);
            G_WAIT_V(6); G_BAR; G_MMA(1, 1, At, B1); G_BAR;
        }
        { int tz_ = threadIdx.x; asm volatile("" : "+v"(tz_)); const int ln_ = tz_ & 63; P.epi(acc, cur, wr, wc, ln_ & 15, ln_ >> 4); }
        if (!has_next) break;
        if (!P.keep(cur))
#pragma unroll
        for (int a = 0; a < 2; ++a)
#pragma unroll
            for (int b = 0; b < 2; ++b)
#pragma unroll
                for (int m = 0; m < 4; ++m)
#pragma unroll
                    for (int n = 0; n < 2; ++n) acc[a][b][m][n] = (f32x4){0.f, 0.f, 0.f, 0.f};
        cur = nxt; cA = nA; cB = nB; ++ui;
    }
    G_WAIT_V(0);
    if (wr == 0) G_BAR;
    G_BAR;
#undef G_SETV
#undef G_SA
#undef G_SB
#undef G_STAGE
#undef G_LDA
#undef G_LDB
#undef G_MMA
#undef G_WAIT_V
#undef G_WAIT_L
#undef G_BAR
#undef G_SCHED
}

__device__ __forceinline__ void st_bf8(bf16_t* p, const f32x4 a, const f32x4 b) {
    u32x4 w; w.x = pk2(a[0], a[1]); w.y = pk2(a[2], a[3]); w.z = pk2(b[0], b[1]); w.w = pk2(b[2], b[3]);
    *(u32x4*)p = w;
}
__device__ __forceinline__ void ld_bf8(const bf16_t* p, f32x4& a, f32x4& b) {
    const u32x4 w = *(const u32x4*)p;
    a = (f32x4){lo_bf(w.x), hi_bf(w.x), lo_bf(w.y), hi_bf(w.y)}; b = (f32x4){lo_bf(w.z), hi_bf(w.z), lo_bf(w.w), hi_bf(w.w)};
}
__device__ __forceinline__ float sq8(const f32x4 a, const f32x4 b) { return ((a[0] * a[0] + a[1] * a[1]) + (a[2] * a[2] + a[3] * a[3])) + ((b[0] * b[0] + b[1] * b[1]) + (b[2] * b[2] + b[3] * b[3])); }

#define EPI_ROWS(ai, m) _Pragma("unroll") for (int ai = 0; ai < 2; ++ai) _Pragma("unroll") for (int m = 0; m < 4; ++m)
#define EPI_FENCE asm volatile("" ::: "memory")
#define EPI_SC(ai, m) __shfl((ai) ? r1_ : r0_, (m) * 16 + fr)

struct ProgIn {
    __device__ __forceinline__ bool keep(const GU&) const { return false; }
    StaticOrder S; const bf16_t* xb; const bf16_t* Wt; const float* ssq; unsigned char* wsb;
    const bf16_t* pb; const bf16_t* wple;
    __device__ __forceinline__ bool unit(int i, GU& u) const {
        Unit t;
        if (!S.next(i, t)) {
            const int rem = S.nwg % S.G, nfull = S.nwg / S.G, idle = rem == 0 ? S.G : S.G - rem, per = (256 + idle - 1) / idle;
            const int rk = rem == 0 ? S.c : S.c - rem, k = i - nfull;
            if (rk < 0 || k < 0 || k >= per) return false;
            const int pu = rk * per + k; if (pu >= 256) return false;
            u.pm = pu >> 2; u.pn = 64 + (pu & 3); u.sub = 0; u.aux = 0; u.nt = 4; u.idx = nullptr; u.lda = 512; u.ldb = 512; u.mapA = 0; u.mapB = 0;
            u.A = (const char*)pb + (size_t)(pu >> 2) * 256 * 512; u.B = (const char*)wple + (size_t)(pu & 3) * 256 * 512; return true;
        }
        u.pm = t.pm; u.pn = t.pn; u.sub = 0; u.aux = 0; u.nt = 16; u.idx = nullptr; u.lda = 2048; u.ldb = 2048;
        const char* w = (const char*)Wt + (size_t)t.pn * 256 * 2048;
        int g = 0; bool isvt = false;
        if (t.pn >= 20 && t.pn < 29) { g = (t.pn - 20) % 3; isvt = t.pn >= 26; }
        const int d = g == 0 ? 1 : (g == 1 ? 4 : 16);
        const int b = t.pm >> 3, tb = t.pm & 7;
        const int base = b * 2048 + (d == 1 ? 256 * tb : d == 4 ? 1024 * (tb & 1) + (tb >> 1) : 2 * tb);
        const char* x = (const char*)xb + (size_t)base * 2048;
        const int mapx = d == 1 ? 0 : d;
        if (!isvt) { u.A = x; u.mapA = mapx; u.B = w; u.mapB = 0; }
        else { u.A = w; u.mapA = 0; u.B = x; u.mapB = mapx; }
        return true;
    }
    __device__ __forceinline__ void epi(f32x4 (&acc)[2][2][4][2], const GU& u, int wr, int wc, int fr, int fq) const {
        const int pn = u.pn, pm = u.pm, rl0 = wr * 64 + fr, cl0 = wc * 32 + 8 * fq;
        if (pn >= 64) {
            EPI_ROWS(ai, m) { bf16_t* o = (bf16_t*)(wsb + WS_PP) + (size_t)(pm * 256 + ai * 128 + m * 16 + rl0) * 1024 + (pn - 64) * 256 + cl0;
#pragma unroll
                for (int bj = 0; bj < 2; ++bj) st_bf8(o + bj * 128, acc[ai][bj][m][0], acc[ai][bj][m][1]); }
            return;
        }
        if (pn >= 26 && pn < 29) {
            const int g = pn - 26, d = g == 0 ? 1 : (g == 1 ? 4 : 16), ln = fq * 16 + fr;
            const float rc = rstd_of(ssq, token_of_pos(d, pm * 256 + (ln >> 5) * 128 + wc * 32 + (ln & 31)));
            f32x4 s[2][2];
#pragma unroll
            for (int bj = 0; bj < 2; ++bj)
#pragma unroll
                for (int j = 0; j < 8; ++j) s[bj][j >> 2][j & 3] = __shfl(rc, bj * 32 + 8 * fq + j);
            EPI_ROWS(ai, m) { const int ch = ai * 128 + m * 16 + rl0; bf16_t* o = (bf16_t*)(wsb + WS_VT) + (size_t)(g * 256 + ch) * TC + pm * 256 + cl0;
#pragma unroll
                for (int bj = 0; bj < 2; ++bj) st_bf8(o + bj * 128, acc[ai][bj][m][0] * s[bj][0], acc[ai][bj][m][1] * s[bj][1]); }
            return;
        }
        int d = 1; if (pn >= 20 && pn < 26) { const int g = (pn - 20) % 3; d = g == 0 ? 1 : (g == 1 ? 4 : 16); }
        const float r0_ = rstd_of(ssq, token_of_pos(d, pm * 256 + fq * 16 + rl0)), r1_ = rstd_of(ssq, token_of_pos(d, pm * 256 + 128 + fq * 16 + rl0));
        if (pn < 20) {
            bf16_t* base = pn < 12 ? (bf16_t*)(wsb + WS_PDN) + pn * 256 : (bf16_t*)(wsb + WS_PSSM) + (pn - 12) * 256; const int ld = pn < 12 ? 3072 : 2048;
            EPI_ROWS(ai, m) { const int row = pm * 256 + ai * 128 + m * 16 + rl0; const float s = EPI_SC(ai, m); bf16_t* o = base + (size_t)row * ld + cl0;
#pragma unroll
                for (int bj = 0; bj < 2; ++bj) st_bf8(o + bj * 128, acc[ai][bj][m][0] * s, acc[ai][bj][m][1] * s); }
        } else if (pn < 26) {
            const int which = (pn - 20) / 3, g = (pn - 20) % 3; const float qs = which == 0 ? 0.125f : 1.f;
            bf16_t* base = (bf16_t*)(wsb + WS_QK) + (size_t)(which * 3 + g) * TC * 256;
            EPI_ROWS(ai, m) { const int p = pm * 256 + ai * 128 + m * 16 + rl0; const float s = EPI_SC(ai, m) * qs; bf16_t* o = base + (size_t)p * 256 + cl0;
#pragma unroll
                for (int bj = 0; bj < 2; ++bj) st_bf8(o + bj * 128, acc[ai][bj][m][0] * s, acc[ai][bj][m][1] * s); }
        } else if (pn < 41) {
            bf16_t* base = (bf16_t*)(wsb + WS_GATES) + (pn - 29) * 256;
            EPI_ROWS(ai, m) { const int row = pm * 256 + ai * 128 + m * 16 + rl0; const float s = EPI_SC(ai, m); bf16_t* o = base + (size_t)row * 3072 + cl0;
#pragma unroll
                for (int bj = 0; bj < 2; ++bj) { f32x4 a = acc[ai][bj][m][0] * s, b = acc[ai][bj][m][1] * s;
#pragma unroll
                    for (int j = 0; j < 4; ++j) { a[j] = sigmoidf_(a[j]); b[j] = sigmoidf_(b[j]); }
                    st_bf8(o + bj * 128, a, b); } }
        } else {
            EPI_ROWS(ai, m) { const int row = pm * 256 + ai * 128 + m * 16 + rl0; const float s = EPI_SC(ai, m);
                if (wc == 0) { float* o = (float*)(wsb + WS_SMALL) + (size_t)row * 32 + 8 * fq; *(f32x4*)o = acc[ai][0][m][0] * s; *(f32x4*)(o + 4) = acc[ai][0][m][1] * s; } }
        }
    }
};

struct ProgMerge {
    StaticOrder S; const bf16_t *wdn, *wssm, *watt; unsigned char* wsb;
    __device__ __forceinline__ bool keep(const GU& u) const { return u.sub < 2; }
    __device__ __forceinline__ bool unit(int i, GU& u) const {
        Unit t; if (!S.next(i / 3, t)) return false;
        const int sub = i % 3;
        u.pm = t.pm; u.pn = t.pn; u.sub = sub; u.aux = 0; u.idx = nullptr; u.mapA = 0; u.mapB = 0;
        if (sub < 2) { u.lda = 1536; u.ldb = 1536; u.nt = 12; u.A = (const char*)(wsb + (sub == 0 ? WS_YDN : WS_YSSM)) + (size_t)t.pm * 256 * 1536; u.B = (const char*)(sub == 0 ? wdn : wssm) + (size_t)t.pn * 256 * 1536; }
        else { u.lda = 512; u.ldb = 512; u.nt = 4; u.A = (const char*)(wsb + WS_YATT) + (size_t)t.pm * 256 * 512; u.B = (const char*)watt + (size_t)t.pn * 256 * 512; }
        return true;
    }
    __device__ __forceinline__ void epi(f32x4 (&acc)[2][2][4][2], const GU& u, int wr, int wc, int fr, int fq) const {
        const int rl0 = wr * 64 + fr, cl0 = wc * 32 + 8 * fq, sub = u.sub;
        const bf16_t* gp0 = (const bf16_t*)(wsb + WS_GATES) + (size_t)(u.pm * 256 + rl0) * 3072 + u.pn * 256 + cl0 + sub * 1024;
#pragma unroll
        for (int ai = 0; ai < 2; ++ai) {
            u32x4 gw[4][2], hw[4][2];
            if (sub < 2) {
#pragma unroll
                for (int m = 0; m < 4; ++m)
#pragma unroll
                    for (int bj = 0; bj < 2; ++bj) { const bf16_t* gp = gp0 + (size_t)(ai * 128 + m * 16) * 3072 + bj * 128; gw[m][bj] = *(const u32x4*)gp; hw[m][bj] = *(const u32x4*)(gp + 1024); }
            } else {
#pragma unroll
                for (int m = 0; m < 4; ++m)
#pragma unroll
                    for (int bj = 0; bj < 2; ++bj) { const bf16_t* gp = gp0 + (size_t)(ai * 128 + m * 16) * 3072 + bj * 128; gw[m][bj] = *(const u32x4*)gp; hw[m][bj] = gw[m][bj]; }
            }
#pragma unroll
            for (int m = 0; m < 4; ++m)
#pragma unroll
                for (int bj = 0; bj < 2; ++bj) { const int row = u.pm * 256 + ai * 128 + m * 16 + rl0, col = u.pn * 256 + bj * 128 + cl0;
                    f32x4 g0 = (f32x4){lo_bf(gw[m][bj].x), hi_bf(gw[m][bj].x), lo_bf(gw[m][bj].y), hi_bf(gw[m][bj].y)}, g1 = (f32x4){lo_bf(gw[m][bj].z), hi_bf(gw[m][bj].z), lo_bf(gw[m][bj].w), hi_bf(gw[m][bj].w)};
                    if ((DBG_ABL >> sub) & 1) { acc[ai][bj][m][0] = (f32x4){0.f, 0.f, 0.f, 0.f}; acc[ai][bj][m][1] = acc[ai][bj][m][0]; }
#pragma unroll
                    for (int j = 0; j < 4; ++j) { g0[j] = fmaxf(g0[j], 1e-8f); g1[j] = fmaxf(g1[j], 1e-8f); }
                    if (sub < 2) { const f32x4 h0 = (f32x4){lo_bf(hw[m][bj].x), hi_bf(hw[m][bj].x), lo_bf(hw[m][bj].y), hi_bf(hw[m][bj].y)}, h1 = (f32x4){lo_bf(hw[m][bj].z), hi_bf(hw[m][bj].z), lo_bf(hw[m][bj].w), hi_bf(hw[m][bj].w)};
#pragma unroll
                        for (int j = 0; j < 4; ++j) { acc[ai][bj][m][0][j] *= g0[j] * __builtin_amdgcn_rcpf(fmaxf(h0[j], 1e-8f)); acc[ai][bj][m][1][j] *= g1[j] * __builtin_amdgcn_rcpf(fmaxf(h1[j], 1e-8f)); } }
                    else st_bf8((bf16_t*)(wsb + WS_MERGED) + (size_t)row * 1024 + col, acc[ai][bj][m][0] * g0, acc[ai][bj][m][1] * g1); }
            EPI_FENCE;
        }
    }
};

struct ProgResid {
    __device__ __forceinline__ bool keep(const GU&) const { return false; }
    StaticOrder S; const bf16_t* A; int lda, nt; const bf16_t* Wt; int ldb; const float* xin; float* xout; bf16_t* xb; float* ssq; float sc; int qx;
    __device__ __forceinline__ bool unit(int i, GU& u) const {
        Unit t; if (!S.next(i, t)) return false;
        u.pm = t.pm; u.pn = t.pn; u.sub = 0; u.aux = 0; u.idx = nullptr; u.mapA = 0; u.mapB = 0; u.lda = lda; u.ldb = ldb; u.nt = nt;
        u.A = (const char*)A + (size_t)t.pm * 256 * lda; u.B = (const char*)Wt + (size_t)t.pn * 256 * ldb; return true;
    }
    __device__ __forceinline__ void epi(f32x4 (&acc)[2][2][4][2], const GU& u, int wr, int wc, int fr, int fq) const {
        const int rl0 = wr * 64 + fr, cl0 = wc * 32 + 8 * fq;
#pragma unroll
        for (int ai = 0; ai < 2; ++ai) {
            f32x4 xv[4][2][2];
#pragma unroll
            for (int m = 0; m < 4; ++m)
#pragma unroll
                for (int bj = 0; bj < 2; ++bj) { const size_t o = (size_t)(u.pm * 256 + ai * 128 + m * 16 + rl0) * 1024 + u.pn * 256 + bj * 128 + cl0; xv[m][bj][0] = *(const f32x4*)(xin + o); xv[m][bj][1] = *(const f32x4*)(xin + o + 4); }
#pragma unroll
            for (int m = 0; m < 4; ++m) { const int row = u.pm * 256 + ai * 128 + m * 16 + rl0; float ss = 0.f;
#pragma unroll
                for (int bj = 0; bj < 2; ++bj) { const size_t o = (size_t)row * 1024 + u.pn * 256 + bj * 128 + cl0;
                    const f32x4 v0 = acc[ai][bj][m][0] * sc + xv[m][bj][0], v1 = acc[ai][bj][m][1] * sc + xv[m][bj][1];
                    *(f32x4*)(xout + o) = v0; *(f32x4*)(xout + o + 4) = v1; if (qx) st_bf8(xb + o, q8v(v0), q8v(v1)); else st_bf8(xb + o, v0, v1); ss += sq8(v0, v1); }
                ss += __shfl_xor(ss, 16); ss += __shfl_xor(ss, 32);
                if (fq == 0) ssq[(size_t)row * 16 + u.pn * 4 + wc] = ss; }
            EPI_FENCE;
        }
    }
};

struct ProgFfnGu {
    __device__ __forceinline__ bool keep(const GU&) const { return false; }
    StaticOrder S; const bf16_t* xb; const bf16_t* Wt; const float* ssq; bf16_t* act;
    __device__ __forceinline__ bool unit(int i, GU& u) const {
        Unit t; if (!S.next(i, t)) return false;
        u.pm = t.pm; u.pn = t.pn; u.sub = 0; u.aux = 0; u.idx = nullptr; u.mapA = 0; u.mapB = 0; u.lda = 2048; u.ldb = 2048; u.nt = 16;
        u.A = (const char*)xb + (size_t)t.pm * 256 * 2048; u.B = (const char*)Wt + (size_t)t.pn * 256 * 2048; return true;
    }
    __device__ __forceinline__ void epi(f32x4 (&acc)[2][2][4][2], const GU& u, int wr, int wc, int fr, int fq) const {
        const int rl0 = wr * 64 + fr, cl0 = wc * 32 + 8 * fq;
        const float r0_ = rstd_of(ssq, u.pm * 256 + fq * 16 + rl0), r1_ = rstd_of(ssq, u.pm * 256 + 128 + fq * 16 + rl0);
        EPI_ROWS(ai, m) { const int row = u.pm * 256 + ai * 128 + m * 16 + rl0; const float s = EPI_SC(ai, m);
            f32x4 o[2];
#pragma unroll
            for (int n = 0; n < 2; ++n)
#pragma unroll
                for (int j = 0; j < 4; ++j) { const float g = acc[ai][0][m][n][j] * s, up = acc[ai][1][m][n][j] * s; o[n][j] = q8(siluf_(g) * up); }
            st_bf8(act + (size_t)row * FFN + u.pn * 128 + cl0, o[0], o[1]); }
    }
};

struct ProgPle {
    __device__ __forceinline__ bool keep(const GU&) const { return false; }
    StaticOrder S; const bf16_t *xb, *wpg, *pp; const float* ssq; float* x; bf16_t* xbout; float* ssqout;
    __device__ __forceinline__ bool unit(int i, GU& u) const {
        Unit t; if (!S.next(i, t)) return false;
        u.pm = t.pm; u.pn = t.pn; u.sub = 0; u.aux = 0; u.idx = nullptr; u.mapA = 0; u.mapB = 0; u.lda = 2048; u.ldb = 2048; u.nt = 16;
        u.A = (const char*)xb + (size_t)t.pm * 256 * 2048; u.B = (const char*)wpg + (size_t)t.pn * 256 * 2048; return true;
    }
    __device__ __forceinline__ void epi(f32x4 (&acc)[2][2][4][2], const GU& u, int wr, int wc, int fr, int fq) const {
        const int rl0 = wr * 64 + fr, cl0 = wc * 32 + 8 * fq; const float ps = (DBG_ABL & 32) ? 0.f : 1.f;
        const float r0_ = rstd_of(ssq, u.pm * 256 + fq * 16 + rl0), r1_ = rstd_of(ssq, u.pm * 256 + 128 + fq * 16 + rl0);
#pragma unroll
        for (int ai = 0; ai < 2; ++ai)
#pragma unroll
            for (int mh = 0; mh < 2; ++mh) {
                f32x4 xv[2][2][2]; u32x4 gw[2][2];
#pragma unroll
                for (int m2 = 0; m2 < 2; ++m2)
#pragma unroll
                    for (int bj = 0; bj < 2; ++bj) { const size_t o = (size_t)(u.pm * 256 + ai * 128 + (2 * mh + m2) * 16 + rl0) * 1024 + u.pn * 256 + bj * 128 + cl0;
                        xv[m2][bj][0] = *(const f32x4*)(x + o); xv[m2][bj][1] = *(const f32x4*)(x + o + 4); gw[m2][bj] = *(const u32x4*)(pp + o); }
#pragma unroll
                for (int m2 = 0; m2 < 2; ++m2) { const int m = 2 * mh + m2, row = u.pm * 256 + ai * 128 + m * 16 + rl0; const float sc = EPI_SC(ai, m); float ss = 0.f;
#pragma unroll
                    for (int bj = 0; bj < 2; ++bj) { const size_t o = (size_t)row * 1024 + u.pn * 256 + bj * 128 + cl0; const u32x4 w = gw[m2][bj];
                        const f32x4 p0 = (f32x4){lo_bf(w.x), hi_bf(w.x), lo_bf(w.y), hi_bf(w.y)}, p1 = (f32x4){lo_bf(w.z), hi_bf(w.z), lo_bf(w.w), hi_bf(w.w)};
                        f32x4 g0 = acc[ai][bj][m][0] * sc, g1 = acc[ai][bj][m][1] * sc;
#pragma unroll
                        for (int j = 0; j < 4; ++j) { g0[j] = sigmoidf_(g0[j]); g1[j] = sigmoidf_(g1[j]); }
                        const f32x4 v0 = xv[m2][bj][0] + p0 * ps * g0, v1 = xv[m2][bj][1] + p1 * ps * g1;
                        *(f32x4*)(x + o) = v0; *(f32x4*)(x + o + 4) = v1; st_bf8(xbout + o, v0, v1); ss += sq8(v0, v1); }
                    ss += __shfl_xor(ss, 16); ss += __shfl_xor(ss, 32);
                    if (fq == 0) ssqout[(size_t)row * 16 + u.pn * 4 + wc] = ss; }
                EPI_FENCE;
            }
    }
};

struct MoeOrder {
    int tl[NE]; int nN, total, G, c;
    __device__ __forceinline__ void init(const unsigned* cnt, int nN_, int G_, int c_) {
        nN = nN_; G = G_; c = c_; int tt = 0;
#pragma unroll
        for (int e = 0; e < NE; ++e) { tl[e] = (int)((__builtin_amdgcn_readfirstlane(cnt[e]) + 255u) >> 8); tt += tl[e]; }
        total = tt * nN;
    }
    __device__ __forceinline__ bool next(int i, int& e, int& pml, int& pn, int& slot0) const {
        const long L = (long)i * G + c; if (L >= total) return false;
        int wgid = (int)L; { const int q = total / NXCD, r = total % NXCD, xcd = wgid % NXCD, off = wgid / NXCD; wgid = (xcd < r ? xcd * (q + 1) : r * (q + 1) + (xcd - r) * q) + off; }
        int ee = 0, ubase = 0, tbase = 0, nMe = tl[0], uacc = 0, tacc = 0;
#pragma unroll
        for (int k = 0; k < NE; ++k) { if (wgid >= uacc) { ee = k; ubase = uacc; tbase = tacc; nMe = tl[k]; } uacc += tl[k] * nN; tacc += tl[k]; }
        const int li = wgid - ubase, nig = WGM * nN, gid = li / nig, fm = gid * WGM, gsz = (nMe - fm) < WGM ? (nMe - fm) : WGM;
        pml = fm + ((li % nig) % gsz); pn = (li % nig) / gsz; e = ee; slot0 = (tbase + pml) * 256; return true;
    }
};
struct ProgMoeGu {
    __device__ __forceinline__ bool keep(const GU&) const { return false; }
    MoeOrder S; const bf16_t* xb; const bf16_t* Wt; const float* ssq; const int* idx; bf16_t* act;
    __device__ __forceinline__ bool unit(int i, GU& u) const {
        int e, pml, pn, slot0; if (!S.next(i, e, pml, pn, slot0)) return false;
        u.pm = slot0; u.pn = pn; u.sub = 0; u.aux = e; u.idx = idx + slot0; u.mapA = 99; u.mapB = 0; u.lda = 2048; u.ldb = 2048; u.nt = 16;
        u.A = (const char*)xb; u.B = (const char*)Wt + ((size_t)e * 7168 + (size_t)pn * 256) * 2048; return true;
    }
    __device__ __forceinline__ void epi(f32x4 (&acc)[2][2][4][2], const GU& u, int wr, int wc, int fr, int fq) const {
        const int rl0 = wr * 64 + fr, cl0 = wc * 32 + 8 * fq;
        const float r0_ = rstd_of(ssq, idx[u.pm + fq * 16 + rl0]), r1_ = rstd_of(ssq, idx[u.pm + 128 + fq * 16 + rl0]);
        EPI_ROWS(ai, m) { const int slot = u.pm + ai * 128 + m * 16 + rl0; const float s = EPI_SC(ai, m);
            f32x4 o[2];
#pragma unroll
            for (int n = 0; n < 2; ++n)
#pragma unroll
                for (int j = 0; j < 4; ++j) { const float g = acc[ai][0][m][n][j] * s, up = acc[ai][1][m][n][j] * s; o[n][j] = q8(siluf_(g) * up); }
            st_bf8(act + (size_t)slot * EXD + u.pn * 128 + cl0, o[0], o[1]); }
    }
};
struct MoeDownPlan { int ntiles, main, tail; };
__device__ __forceinline__ MoeDownPlan moe_down_plan(const unsigned* cnt, int G) {
    MoeDownPlan pl; int nt = 0;
#pragma unroll
    for (int e = 0; e < NE; ++e) nt += (int)((__builtin_amdgcn_readfirstlane(cnt[e]) + 255u) >> 8);
    const int U = 4 * nt; int tail = U % G; if (U < G || tail > TAILMAX) tail = 0;
    pl.ntiles = nt; pl.tail = tail; pl.main = U - tail; return pl;
}
struct ProgMoeDown {
    __device__ __forceinline__ bool keep(const GU&) const { return false; }
    int tl[NE]; MoeDownPlan pl; int G, c; const bf16_t* act; const bf16_t* Wt; bf16_t* ypair; float* partk;
    __device__ __forceinline__ void init(const unsigned* cnt, int G_, int c_) { G = G_; c = c_; pl = moe_down_plan(cnt, G_);
#pragma unroll
        for (int e = 0; e < NE; ++e) tl[e] = (int)((__builtin_amdgcn_readfirstlane(cnt[e]) + 255u) >> 8); }
    __device__ __forceinline__ bool unit(int i, GU& u) const {
        const long L = (long)i * G + c; int w, kp = -1;
        if (L < pl.main) { w = (int)L; const int q = pl.main / NXCD, r = pl.main % NXCD, xcd = w % NXCD, off = w / NXCD; w = (xcd < r ? xcd * (q + 1) : r * (q + 1) + (xcd - r) * q) + off; }
        else { const long s2 = L - pl.main; if (s2 >= (long)pl.tail * KSPL) return false; w = pl.main + (int)(s2 / KSPL); kp = (int)(s2 % KSPL); }
        const int tile = w >> 2, pn = w & 3; int e = 0, tacc = 0;
#pragma unroll
        for (int k = 0; k < NE; ++k) { if (tile >= tacc) e = k; tacc += tl[k]; }
        const int slot0 = tile * 256;
        u.pm = slot0; u.pn = pn; u.aux = e; u.idx = nullptr; u.mapA = 0; u.mapB = 0; u.lda = 7168; u.ldb = 7168;
        u.A = (const char*)act + (size_t)slot0 * 7168; u.B = (const char*)Wt + ((size_t)e * 1024 + (size_t)pn * 256) * 7168;
        if (kp < 0) { u.sub = 0; u.nt = 56; } else { u.sub = 1 + kp; u.nt = 8; u.A += kp * 1024; u.B += kp * 1024; }
        return true;
    }
    __device__ __forceinline__ void epi(f32x4 (&acc)[2][2][4][2], const GU& u, int wr, int wc, int fr, int fq) const {
        const int rl0 = wr * 64 + fr, cl0 = wc * 32 + 8 * fq;
        if (u.sub == 0) {
            EPI_ROWS(ai, m) { const int slot = u.pm + ai * 128 + m * 16 + rl0;
#pragma unroll
                for (int bj = 0; bj < 2; ++bj) st_bf8(ypair + (size_t)slot * 1024 + u.pn * 256 + bj * 128 + cl0, acc[ai][bj][m][0], acc[ai][bj][m][1]); }
        } else {
            float* pk = partk + ((size_t)(u.sub - 1) * (TAILMAX / 4) * 256 + (u.pm - (pl.main >> 2) * 256)) * 1024 + u.pn * 256 + cl0;
            EPI_ROWS(ai, m) { float* o = pk + (size_t)(ai * 128 + m * 16 + rl0) * 1024;
#pragma unroll
                for (int bj = 0; bj < 2; ++bj) { *(f32x4*)(o + bj * 128) = acc[ai][bj][m][0]; *(f32x4*)(o + bj * 128 + 4) = acc[ai][bj][m][1]; } }
        }
    }
};

struct Params { const float* in[30]; float* out; unsigned char* ws; int s_lo, s_hi; unsigned tmask; int pad; };
enum { I_X = 0, I_P, I_MIXN, I_WIN, I_DNCONV, I_DNALOG, I_DNDTB, I_DNNORM, I_SSCONV, I_SSCONVB, I_SSALOG, I_SSDTB, I_SSD, I_SSNORM, I_WBRDN, I_WBRSSM, I_WBRATT, I_WOUT, I_FFNN,
       I_WFG, I_WFU, I_WFD, I_WROUTER, I_WMG, I_WMU, I_WMD, I_PLEN, I_WPLE, I_WPLEG, I_FINALN };

template <class Map>
__device__ __forceinline__ void tr_job(const Map& map, int K, int N, bf16_t* WT, const float* gain, LAS float* scr, int lane, int gw, int NGW, float qs = 0.f) {
    const int nblk = N / 32, nitems = (K / 64) * nblk;
    for (int item = gw; item < nitems; item += NGW) {
        const int kb = item / nblk, nb = item % nblk, k0 = 64 * kb, n0 = 32 * nb;
        int ld = 0; const float* src = map(n0 + (lane & 31), ld);
#pragma unroll
        for (int i = 0; i < 32; ++i) { const int kk = 2 * i + (lane >> 5); float v = 0.f; if (src) { v = src[(size_t)(k0 + kk) * ld]; if (gain) v *= gain[k0 + kk]; if (qs > 0.f) v = q8(v * qs) / qs; } scr[kk * 33 + (lane & 31)] = v; }
        asm volatile("s_waitcnt lgkmcnt(0)" ::: "memory");
        const int c = lane & 7;
#pragma unroll
        for (int j = 0; j < 4; ++j) { const int n = (lane >> 3) + 8 * j; const LAS float* s = scr + (8 * c) * 33 + n;
            u32x4 o; o.x = pk2(s[0 * 33], s[1 * 33]); o.y = pk2(s[2 * 33], s[3 * 33]); o.z = pk2(s[4 * 33], s[5 * 33]); o.w = pk2(s[6 * 33], s[7 * 33]);
            *(u32x4*)(WT + (size_t)(n0 + n) * K + k0 + 8 * c) = o; }
        asm volatile("s_waitcnt lgkmcnt(0)" ::: "memory");
    }
}
struct MapPlain { const float* W; int ld; __device__ __forceinline__ const float* operator()(int n, int& l) const { l = ld; return W + n; } };
struct MapIn { const float* W; __device__ __forceinline__ const float* operator()(int n, int& l) const { l = INW; const int tile = n >> 8, r = n & 255; int col;
        if (tile < 9) col = n; else if (tile < 12) col = C_DNZ + (n - 2304); else if (tile < 17) col = C_XBC + (n - 3072); else if (tile < 20) col = C_SSZ + (n - 4352);
        else if (tile < 29) col = C_ATT + (n - 5120); else if (tile < 41) col = C_GATE + (n - 7424);
        else { if (r < 6) col = C_DNA + r; else if (r < 12) col = C_DNB + (r - 6); else if (r < 24) col = C_SSDT + (r - 12); else return nullptr; }
        return W + col; } };
struct MapGu { const float* Wg; const float* Wu; int ld; __device__ __forceinline__ const float* operator()(int n, int& l) const { l = ld; const int tile = n >> 8, r = n & 255; return r < 128 ? Wg + tile * 128 + r : Wu + tile * 128 + (r - 128); } };

__device__ __forceinline__ void phase_convert(const Params& p, LAS unsigned char* lds) {
    const int tid_ = htid(), lane = tid_ & 63, wave = tid_ >> 6, G = gridDim.x;
    const int gw = blockIdx.x * 8 + wave, NGW = G * 8;
    LAS float* scr = (LAS float*)(lds + wave * 16384);
    unsigned char* ws = p.ws;
    for (int l = 0; l < DEPTH; ++l) {
        tr_job(MapIn{p.in[I_WIN] + (size_t)l * D * INW}, D, INP, (bf16_t*)(ws + WS_WIN) + (size_t)l * INP * D, p.in[I_MIXN] + l * D, scr, lane, gw, NGW);
        tr_job(MapPlain{p.in[I_WBRDN] + (size_t)l * 768 * D, D}, 768, D, (bf16_t*)(ws + WS_WDN) + (size_t)l * D * 768, nullptr, scr, lane, gw, NGW);
        tr_job(MapPlain{p.in[I_WBRSSM] + (size_t)l * 768 * D, D}, 768, D, (bf16_t*)(ws + WS_WSSM) + (size_t)l * D * 768, nullptr, scr, lane, gw, NGW);
        tr_job(MapPlain{p.in[I_WBRATT] + (size_t)l * 256 * D, D}, 256, D, (bf16_t*)(ws + WS_WATT) + (size_t)l * D * 256, nullptr, scr, lane, gw, NGW);
        tr_job(MapPlain{p.in[I_WOUT] + (size_t)l * D * D, D}, D, D, (bf16_t*)(ws + WS_WOUT) + (size_t)l * D * D, nullptr, scr, lane, gw, NGW);
        tr_job(MapPlain{p.in[I_WPLEG] + (size_t)l * D * D, D}, D, D, (bf16_t*)(ws + WS_WPG) + (size_t)l * D * D, p.in[I_PLEN] + l * D, scr, lane, gw, NGW);
        tr_job(MapPlain{p.in[I_WPLE] + (size_t)l * PLE * D, D}, PLE, D, (bf16_t*)(ws + WS_WPLE) + (size_t)l * D * PLE, nullptr, scr, lane, gw, NGW);
    }
    tr_job(MapGu{p.in[I_WFG], p.in[I_WFU], FFN}, D, 2 * FFN, (bf16_t*)(ws + WS_WFGU), p.in[I_FFNN], scr, lane, gw, NGW, 16.f);
    tr_job(MapPlain{p.in[I_WFD], D}, FFN, D, (bf16_t*)(ws + WS_WFD), nullptr, scr, lane, gw, NGW, 16.f);
    for (int e = 0; e < NE; ++e) {
        tr_job(MapGu{p.in[I_WMG] + (size_t)e * D * EXD, p.in[I_WMU] + (size_t)e * D * EXD, EXD}, D, 2 * EXD, (bf16_t*)(ws + WS_WMGU) + (size_t)e * 2 * EXD * D, p.in[I_FFNN] + D, scr, lane, gw, NGW, 16.f);
        tr_job(MapPlain{p.in[I_WMD] + (size_t)e * EXD * D, D}, EXD, D, (bf16_t*)(ws + WS_WMD) + (size_t)e * D * EXD, nullptr, scr, lane, gw, NGW, 16.f);
    }
    float* wr = (float*)(ws + WS_WR);
    for (int i = blockIdx.x * 512 + tid_; i < D * NE; i += G * 512) wr[i] = p.in[I_WROUTER][i] * p.in[I_FFNN][D + (i >> 3)];
}

__device__ __forceinline__ void phase_chunk_in(const Params& p, int chunk) {
    const int tid_ = htid(), lane = tid_ & 63, gw = blockIdx.x * 8 + (tid_ >> 6), NGW = gridDim.x * 8;
    const float* x = p.in[I_X] + (size_t)chunk * TC * D;
    bf16_t* xb = (bf16_t*)(p.ws + WS_XB); float* ssq = (float*)(p.ws + WS_SSQ);
    for (int r0 = gw; r0 < TC; r0 += 2 * NGW) {
        f32x4 v[2][4];
#pragma unroll
        for (int u = 0; u < 2; ++u) { const int r = r0 + u * NGW < TC ? r0 + u * NGW : r0; const f32x4* xr = (const f32x4*)(x + (size_t)r * D) + lane;
#pragma unroll
            for (int j = 0; j < 4; ++j) v[u][j] = xr[64 * j]; }
#pragma unroll
        for (int u = 0; u < 2; ++u) { const int r = r0 + u * NGW; if (r >= TC) break; float s = 0.f; u32x2* o = (u32x2*)(xb + (size_t)r * D) + lane;
#pragma unroll
            for (int j = 0; j < 4; ++j) { const f32x4 t = v[u][j]; s += (t.x * t.x + t.y * t.y) + (t.z * t.z + t.w * t.w); u32x2 w; w.x = pk2(t.x, t.y); w.y = pk2(t.z, t.w); o[64 * j] = w; }
            s = wave_sum(s);
            if (lane < 16) ssq[(size_t)r * 16 + lane] = lane == 0 ? s : 0.f; }
    }
    bf16_t* pb = (bf16_t*)(p.ws + WS_PB);
    for (int r0 = gw; r0 < 2 * TC; r0 += 4 * NGW) {
        f32x4 v[4];
#pragma unroll
        for (int u = 0; u < 4; ++u) { const int r = r0 + u * NGW < 2 * TC ? r0 + u * NGW : r0; const int l = r / TC, rr = r % TC;
            v[u] = *((const f32x4*)(p.in[I_P] + ((size_t)l * BATCH * SEQ + (size_t)chunk * TC + rr) * PLE) + lane); }
#pragma unroll
        for (int u = 0; u < 4; ++u) { const int r = r0 + u * NGW; if (r >= 2 * TC) break; const int l = r / TC, rr = r % TC;
            u32x2 w; w.x = pk2(v[u].x, v[u].y); w.y = pk2(v[u].z, v[u].w); *((u32x2*)(pb + ((size_t)l * TC + rr) * PLE) + lane) = w; }
    }
}
__device__ __forceinline__ void phase_final(const Params& p, int chunk) {
    const int tid_ = htid(), lane = tid_ & 63, gw = blockIdx.x * 8 + (tid_ >> 6), NGW = gridDim.x * 8;
    float* x = p.out + (size_t)chunk * TC * D; const float* g = p.in[I_FINALN];
    for (int r = gw; r < TC; r += NGW) {
        f32x4* xr = (f32x4*)(x + (size_t)r * D) + lane; f32x4 v[4]; float s = 0.f;
#pragma unroll
        for (int j = 0; j < 4; ++j) { v[j] = xr[64 * j]; s += (v[j].x * v[j].x + v[j].y * v[j].y) + (v[j].z * v[j].z + v[j].w * v[j].w); }
        const float rs = rsqrtf(wave_sum(s) * (1.f / D) + EPS);
#pragma unroll
        for (int j = 0; j < 4; ++j) xr[64 * j] = v[j] * rs * ((const f32x4*)g)[lane + 64 * j];
    }
}
__device__ __forceinline__ void phase_router(const Params& p, LAS unsigned char* lds, int chunk) {
    const int tid_ = htid(), lane = tid_ & 63, gw = blockIdx.x * 8 + (tid_ >> 6), NGW = gridDim.x * 8;
    const float* x = p.out + (size_t)chunk * TC * D; const float* wr = (const float*)(p.ws + WS_WR);
    int* rt = (int*)(p.ws + WS_ROUTE); unsigned* cnt = (unsigned*)(p.ws + WS_CTL) + CW_CNT + chunk * 64;
    LAS unsigned* lcnt = (LAS unsigned*)lds;
    f32x4 w[16][2];
#pragma unroll
    for (int j = 0; j < 4; ++j)
#pragma unroll
        for (int q = 0; q < 4; ++q) { const int k = 4 * (lane + 64 * j) + q; w[4 * j + q][0] = *(const f32x4*)(wr + k * 8); w[4 * j + q][1] = *(const f32x4*)(wr + k * 8 + 4); }
    const int nouter = (TC + 8 * NGW - 1) / (8 * NGW);
    for (int ob = 0; ob < nouter; ++ob) {
        if (tid_ < 16) lcnt[tid_] = 0u;
        __syncthreads();
        int pe[8]; unsigned pr[8];
#pragma unroll
        for (int jr = 0; jr < 8; ++jr) { const int r = gw + (ob * 8 + jr) * NGW; pe[jr] = 0; pr[jr] = 0u;
            if (r < TC) {
                const f32x4* xr = (const f32x4*)(x + (size_t)r * D) + lane; float s = 0.f; float lg[NE];
#pragma unroll
                for (int e = 0; e < NE; ++e) lg[e] = 0.f;
#pragma unroll
                for (int j = 0; j < 4; ++j) { const f32x4 v = xr[64 * j]; s += (v.x * v.x + v.y * v.y) + (v.z * v.z + v.w * v.w);
#pragma unroll
                    for (int q = 0; q < 4; ++q) { const f32x4 w0 = w[4 * j + q][0], w1 = w[4 * j + q][1];
                        lg[0] += v[q] * w0.x; lg[1] += v[q] * w0.y; lg[2] += v[q] * w0.z; lg[3] += v[q] * w0.w; lg[4] += v[q] * w1.x; lg[5] += v[q] * w1.y; lg[6] += v[q] * w1.z; lg[7] += v[q] * w1.w; } }
                const float rs = rsqrtf(wave_sum(s) * (1.f / D) + EPS);
#pragma unroll
                for (int e = 0; e < NE; ++e) lg[e] = wave_sum(lg[e]) * rs;
                int i0 = 0; float l0 = lg[0];
#pragma unroll
                for (int e = 1; e < NE; ++e) if (lg[e] > l0) { l0 = lg[e]; i0 = e; }
                int i1 = -1; float l1 = -3.0e38f;
#pragma unroll
                for (int e = 0; e < NE; ++e) if (e != i0 && lg[e] > l1) { l1 = lg[e]; i1 = e; }
                if (lane < 2) { const int e = lane == 0 ? i0 : i1; const float w0 = 1.f / (1.f + expf(l1 - l0));
                    pe[jr] = e; pr[jr] = __hip_atomic_fetch_add(lcnt + e, 1u, __ATOMIC_RELAXED, __HIP_MEMORY_SCOPE_WORKGROUP);
                    rt[RT_TOPE + 2 * r + lane] = e; ((float*)rt)[RT_TOPW + 2 * r + lane] = lane == 0 ? w0 : 1.f - w0; }
            } }
        __syncthreads();
        if (tid_ < 8) lcnt[8 + tid_] = atomicAdd(cnt + tid_, lcnt[tid_]);
        __syncthreads();
#pragma unroll
        for (int jr = 0; jr < 8; ++jr) { const int r = gw + (ob * 8 + jr) * NGW; if (r < TC && lane < 2) rt[RT_TOPP + 2 * r + lane] = (int)(lcnt[8 + pe[jr]] + pr[jr]); }
        __syncthreads();
    }
}
__device__ __forceinline__ void phase_slots(const Params& p, int chunk) {
    int* rt = (int*)(p.ws + WS_ROUTE); const unsigned* cnt = (const unsigned*)(p.ws + WS_CTL) + CW_CNT + chunk * 64;
    int c[NE], off[NE + 1]; off[0] = 0;
#pragma unroll
    for (int e = 0; e < NE; ++e) { c[e] = (int)cnt[e]; off[e + 1] = off[e] + ((c[e] + 255) & ~255); }
    const int gt = blockIdx.x * 512 + htid(), NT = gridDim.x * 512;
    for (int i = gt; i < 2 * TC; i += NT) {
        const int e = rt[RT_TOPE + i], pos = rt[RT_TOPP + i]; int o = 0;
#pragma unroll
        for (int k = 0; k < NE; ++k) o = (e == k) ? off[k] : o;
        const int slot = o + pos; rt[RT_TOPS + i] = slot; rt[RT_IDX + slot] = i >> 1;
    }
    for (int s = gt; s < off[NE]; s += NT) {
        bool pad = false;
#pragma unroll
        for (int k = 0; k < NE; ++k) pad = pad || (s >= off[k] + c[k] && s < off[k + 1]);
        if (pad) rt[RT_IDX + s] = 0;
    }
}
__device__ __forceinline__ f32x4 moe_y4(const bf16_t* yp, const float* partk, int slot, int tail0, int col) {
    if (slot < tail0) { const u32x2 a = *(const u32x2*)(yp + (size_t)slot * D + col); return (f32x4){lo_bf(a.x), hi_bf(a.x), lo_bf(a.y), hi_bf(a.y)}; }
    f32x4 v = (f32x4){0.f, 0.f, 0.f, 0.f};
#pragma unroll
    for (int k = 0; k < KSPL; ++k) v += *(const f32x4*)(partk + ((size_t)k * (TAILMAX / 4) * 256 + (slot - tail0)) * 1024 + col);
    return v;
}
__device__ __forceinline__ void phase_combine(const Params& p, int chunk) {
    const int tid_ = htid(), lane = tid_ & 63, gw = blockIdx.x * 8 + (tid_ >> 6), NGW = gridDim.x * 8;
    float* x = p.out + (size_t)chunk * TC * D; const int* rt = (const int*)(p.ws + WS_ROUTE);
    const bf16_t* yp = (const bf16_t*)(p.ws + WS_YPAIR); const float* partk = (const float*)(p.ws + WS_PARTK); bf16_t* xb = (bf16_t*)(p.ws + WS_XB); float* ssq = (float*)(p.ws + WS_SSQ);
    const MoeDownPlan pl = moe_down_plan((const unsigned*)(p.ws + WS_CTL) + CW_CNT + chunk * 64, gridDim.x);
    const int tail0 = pl.tail > 0 ? (pl.main >> 2) * 256 : 0x7fffffff;
    for (int r0 = gw; r0 < TC; r0 += 4 * NGW) {
        int sl[4][2]; float wt[4][2];
#pragma unroll
        for (int u = 0; u < 4; ++u) { const int r = r0 + u * NGW < TC ? r0 + u * NGW : r0; sl[u][0] = rt[RT_TOPS + 2 * r]; sl[u][1] = rt[RT_TOPS + 2 * r + 1];
            wt[u][0] = (DBG_ABL & 16) ? 0.f : ((const float*)rt)[RT_TOPW + 2 * r]; wt[u][1] = (DBG_ABL & 16) ? 0.f : ((const float*)rt)[RT_TOPW + 2 * r + 1]; }
#pragma unroll
        for (int u = 0; u < 4; ++u) { const int r = r0 + u * NGW; if (r >= TC) break;
            f32x4* xr = (f32x4*)(x + (size_t)r * D) + lane; u32x2* o = (u32x2*)(xb + (size_t)r * D) + lane; float s = 0.f;
            f32x4 v[4], y0[4], y1[4];
            if (sl[u][0] < tail0 && sl[u][1] < tail0) {
                const u32x2* a0 = (const u32x2*)(yp + (size_t)sl[u][0] * D) + lane; const u32x2* a1 = (const u32x2*)(yp + (size_t)sl[u][1] * D) + lane; u32x2 q0[4], q1[4];
#pragma unroll
                for (int j = 0; j < 4; ++j) { v[j] = xr[64 * j]; q0[j] = a0[64 * j]; q1[j] = a1[64 * j]; }
#pragma unroll
                for (int j = 0; j < 4; ++j) { y0[j] = (f32x4){lo_bf(q0[j].x), hi_bf(q0[j].x), lo_bf(q0[j].y), hi_bf(q0[j].y)}; y1[j] = (f32x4){lo_bf(q1[j].x), hi_bf(q1[j].x), lo_bf(q1[j].y), hi_bf(q1[j].y)}; }
            } else {
#pragma unroll
                for (int j = 0; j < 4; ++j) { const int col = 4 * (lane + 64 * j); v[j] = xr[64 * j]; y0[j] = moe_y4(yp, partk, sl[u][0], tail0, col); y1[j] = moe_y4(yp, partk, sl[u][1], tail0, col); }
            }
#pragma unroll
            for (int j = 0; j < 4; ++j) { const f32x4 t = v[j] + wt[u][0] * y0[j] + wt[u][1] * y1[j];
                xr[64 * j] = t; s += (t.x * t.x + t.y * t.y) + (t.z * t.z + t.w * t.w); u32x2 w; w.x = pk2(t.x, t.y); w.y = pk2(t.z, t.w); o[64 * j] = w; }
            s = wave_sum(s);
            if (lane < 16) ssq[(size_t)r * 16 + lane] = lane == 0 ? s : 0.f; }
    }
}

#define LDS_BARRIER() do { asm volatile("s_waitcnt lgkmcnt(0)" ::: "memory"); __builtin_amdgcn_s_barrier(); asm volatile("" ::: "memory"); } while (0)
__device__ __forceinline__ f32x4 mfma16(const bf16x8 a, const bf16x8 b, const f32x4 c) { return __builtin_amdgcn_mfma_f32_16x16x32_bf16(a, b, c, 0, 0, 0); }
__device__ __forceinline__ void dn_prep(const Params& p, LAS unsigned char* lds, int layer, int b, int n, int h) {
    const int tid = htid(), lane = tid & 63, wave = tid >> 6;
    LAS unsigned char* QS = lds; LAS unsigned char* KS = lds + 17408; LAS unsigned char* VS = lds + 34816;
    LAS float* AM = (LAS float*)(lds + 52224);
    LAS float* SC = (LAS float*)(lds + 69632);
    const int t0 = n * 64;
    const bf16_t* proj = (const bf16_t*)(p.ws + WS_PDN) + (size_t)b * SEQ * 3072;
    unsigned char* item = p.ws + WS_DNS + (size_t)((b * 32 + n) * 6 + h) * DNS_ITEM;
    if (tid < 480) {
        const int cg = tid % 48, seg = tid / 48, part = cg >> 4, c8 = (cg & 15) * 8, col = part * 768 + h * 128 + c8;
        const float* cw = p.in[I_DNCONV] + (size_t)layer * 4 * 2304 + col;
        f32x4 w[4][2];
#pragma unroll
        for (int j = 0; j < 4; ++j) { w[j][0] = *(const f32x4*)(cw + j * 2304); w[j][1] = *(const f32x4*)(cw + j * 2304 + 4); }
        const int ts = seg * 7;
        f32x4 x[10][2];
#pragma unroll
        for (int i = 0; i < 10; ++i) { const int t = t0 + ts - 3 + i; x[i][0] = (f32x4){0.f, 0.f, 0.f, 0.f}; x[i][1] = x[i][0];
            if (t >= 0 && ts - 3 + i < 64) ld_bf8(proj + (size_t)t * 3072 + col, x[i][0], x[i][1]); }
        LAS unsigned char* dst = part == 0 ? QS : (part == 1 ? KS : VS);
#pragma unroll
        for (int i = 0; i < 7; ++i) { const int tk = ts + i;
            if (tk < 64) { f32x4 a0 = w[3][0] * x[i + 3][0] + w[2][0] * x[i + 2][0] + w[1][0] * x[i + 1][0] + w[0][0] * x[i][0];
                f32x4 a1 = w[3][1] * x[i + 3][1] + w[2][1] * x[i + 2][1] + w[1][1] * x[i + 1][1] + w[0][1] * x[i][1];
#pragma unroll
                for (int c = 0; c < 4; ++c) { a0[c] = siluf_(a0[c]); a1[c] = siluf_(a1[c]); }
                u32x4 pw; pw.x = pk2(a0[0], a0[1]); pw.y = pk2(a0[2], a0[3]); pw.z = pk2(a1[0], a1[1]); pw.w = pk2(a1[2], a1[3]);
                *(LAS u32x4*)(dst + tk * 272 + c8 * 2) = pw;
 } }
    } else {
        const float Aexp = expf(p.in[I_DNALOG][layer * 6 + h]), dtb = p.in[I_DNDTB][layer * 6 + h];
        const float* small = (const float*)(p.ws + WS_SMALL) + (size_t)b * SEQ * 32;
#pragma unroll
        for (int q = 0; q < 2; ++q) { const int tk = (tid - 480) * 2 + q; const float a = small[(size_t)(t0 + tk) * 32 + h], bb = small[(size_t)(t0 + tk) * 32 + 6 + h];
            SC[128 + tk] = sigmoidf_(bb); SC[192 + tk] = -Aexp * softplusf_(a + dtb); }
    }
    LDS_BARRIER();
    {
        const int row = tid >> 3, sg = tid & 7; const u32x4 q0 = *(const LAS u32x4*)(QS + row * 272 + sg * 32), q1 = *(const LAS u32x4*)(QS + row * 272 + sg * 32 + 16), k0 = *(const LAS u32x4*)(KS + row * 272 + sg * 32), k1 = *(const LAS u32x4*)(KS + row * 272 + sg * 32 + 16);
        float sq = sq8((f32x4){lo_bf(q0.x), hi_bf(q0.x), lo_bf(q0.y), hi_bf(q0.y)}, (f32x4){lo_bf(q0.z), hi_bf(q0.z), lo_bf(q0.w), hi_bf(q0.w)}) + sq8((f32x4){lo_bf(q1.x), hi_bf(q1.x), lo_bf(q1.y), hi_bf(q1.y)}, (f32x4){lo_bf(q1.z), hi_bf(q1.z), lo_bf(q1.w), hi_bf(q1.w)});
        float sk = sq8((f32x4){lo_bf(k0.x), hi_bf(k0.x), lo_bf(k0.y), hi_bf(k0.y)}, (f32x4){lo_bf(k0.z), hi_bf(k0.z), lo_bf(k0.w), hi_bf(k0.w)}) + sq8((f32x4){lo_bf(k1.x), hi_bf(k1.x), lo_bf(k1.y), hi_bf(k1.y)}, (f32x4){lo_bf(k1.z), hi_bf(k1.z), lo_bf(k1.w), hi_bf(k1.w)});
        sq += __shfl_xor(sq, 1); sq += __shfl_xor(sq, 2); sq += __shfl_xor(sq, 4); sk += __shfl_xor(sk, 1); sk += __shfl_xor(sk, 2); sk += __shfl_xor(sk, 4);
        if (sg == 0) { SC[row] = sq; SC[64 + row] = sk; } }
    LDS_BARRIER();
    if (wave == 0) {
        float g = SC[192 + lane];
#pragma unroll
        for (int o = 1; o < 64; o <<= 1) { const float t = __shfl_up(g, o); if (lane >= o) g += t; }
        SC[192 + lane] = g; SC[256 + lane] = expf(g); SC[320 + lane] = rsqrtf(SC[lane] + EPS); SC[384 + lane] = rsqrtf(SC[64 + lane] + EPS);
    }
    LDS_BARRIER();
    {
        const int r = lane & 15, kg = lane >> 4;
        bf16x8 fa[4][4], fb[4][4];
#pragma unroll
        for (int q = 0; q < 4; ++q) { const int t = wave * 4 + q, which = t >> 4, mt = (t >> 2) & 3, nt = t & 3;
            const LAS unsigned char* A = (which == 0 ? KS : QS) + (16 * mt + r) * 272 + kg * 16; const LAS unsigned char* Bt = KS + (16 * nt + r) * 272 + kg * 16;
#pragma unroll
            for (int ks = 0; ks < 4; ++ks) { fa[q][ks] = *(const LAS bf16x8*)(A + ks * 64); fb[q][ks] = *(const LAS bf16x8*)(Bt + ks * 64); } }
#pragma unroll
        for (int q = 0; q < 4; ++q) { const int t = wave * 4 + q, which = t >> 4, mt = (t >> 2) & 3, nt = t & 3;
            f32x4 acc = (f32x4){0.f, 0.f, 0.f, 0.f};
#pragma unroll
            for (int ks = 0; ks < 4; ++ks) acc = mfma16(fa[q][ks], fb[q][ks], acc);
            const int j = 16 * nt + r; const float gj = SC[192 + j], rkj = SC[384 + j];
            float ov[4];
#pragma unroll
            for (int rr = 0; rr < 4; ++rr) { const int i = 16 * mt + 4 * kg + rr; const float e = fexp(fminf(SC[192 + i] - gj, 0.f));
                if (which == 0) AM[i * 68 + j] = (i > j) ? SC[128 + i] * SC[384 + i] * rkj * acc[rr] * e : 0.f;
                ov[rr] = (i >= j) ? SC[320 + i] * rkj * 0.08838834764831845f * acc[rr] * e : 0.f; }
            if (which != 0) { bf16_t* ao = (bf16_t*)(item + 32768) + (16 * mt + 4 * kg) * 64 + j; ST2_BF(ao, ao + 64, ov[0], ov[1]); ST2_BF(ao + 128, ao + 192, ov[2], ov[3]); }
        }
    }
    LDS_BARRIER();
    if (tid < 256) {
        float x[64];
        if (tid < 128) {
#pragma unroll
            for (int i = 0; i < 64; ++i) x[i] = bf2f(*(const LAS bf16_t*)(KS + i * 272 + tid * 2)) * SC[384 + i] * SC[128 + i] * SC[256 + i];
        } else {
#pragma unroll
            for (int i = 0; i < 64; ++i) x[i] = bf2f(*(const LAS bf16_t*)(VS + i * 272 + (tid - 128) * 2)) * SC[128 + i];
        }
        f32x4 rw[2][16];
        rw[1][0] = *(const LAS f32x4*)(AM + 1 * 68);
#pragma unroll
        for (int i = 1; i < 64; ++i) {
            if (i + 1 < 64) {
#pragma unroll
                for (int k4 = 0; k4 < (i + 4) / 4; ++k4) rw[(i + 1) & 1][k4] = *(const LAS f32x4*)(AM + (i + 1) * 68 + 4 * k4);
            }
            float a4[4] = {x[i], 0.f, 0.f, 0.f};
#pragma unroll
            for (int k4 = 0; k4 < (i + 3) / 4; ++k4) { const f32x4 am = rw[i & 1][k4];
#pragma unroll
                for (int c = 0; c < 4; ++c) if (4 * k4 + c < i) a4[c] -= am[c] * x[4 * k4 + c]; }
            x[i] = (a4[0] + a4[1]) + (a4[2] + a4[3]); }
        if (tid < 128) { bf16_t* W = (bf16_t*)item;
#pragma unroll
            for (int i = 0; i < 64; i += 2) ST2_BF(W + i * 128 + tid, W + (i + 1) * 128 + tid, x[i], x[i + 1]);
        } else { u32x4* UT = (u32x4*)(item + 57344 + (size_t)(tid - 128) * 128);
#pragma unroll
            for (int c = 0; c < 8; ++c) { u32x4 w; w.x = pk2(x[8 * c], x[8 * c + 1]); w.y = pk2(x[8 * c + 2], x[8 * c + 3]); w.z = pk2(x[8 * c + 4], x[8 * c + 5]); w.w = pk2(x[8 * c + 6], x[8 * c + 7]); UT[c] = w; } }
    } else {
        const int u = tid - 256; const float glast = SC[192 + 63];
#pragma unroll
        for (int i = 0; i < 4; ++i) { const int q = u + 256 * i, c = q >> 4, d8 = (q & 15) * 8; f32x4 a0, a1;
            const u32x4 w = *(const LAS u32x4*)(QS + c * 272 + d8 * 2); const float sc = SC[320 + c] * 0.08838834764831845f * SC[256 + c];
            a0 = (f32x4){lo_bf(w.x), hi_bf(w.x), lo_bf(w.y), hi_bf(w.y)} * sc; a1 = (f32x4){lo_bf(w.z), hi_bf(w.z), lo_bf(w.w), hi_bf(w.w)} * sc;
            st_bf8((bf16_t*)(item + 16384) + c * 128 + d8, a0, a1); }
#pragma unroll
        for (int i = 0; i < 4; ++i) { const int q = u + 256 * i, d = q >> 3, c8 = (q & 7) * 8; float v[8];
#pragma unroll
            for (int c = 0; c < 8; ++c) v[c] = bf2f(*(const LAS bf16_t*)(KS + (c8 + c) * 272 + d * 2)) * SC[384 + c8 + c] * fexp(glast - SC[192 + c8 + c]);
            st_bf8((bf16_t*)(item + 40960) + d * 64 + c8, (f32x4){v[0], v[1], v[2], v[3]}, (f32x4){v[4], v[5], v[6], v[7]}); }
        if (u == 0) ((float*)(p.ws + WS_DNEGL))[(b * 32 + n) * 6 + h] = SC[256 + 63];
    }
    {
        const float* ng = p.in[I_DNNORM] + layer * 128; bf16_t* ydn = (bf16_t*)(p.ws + WS_YDN) + ((size_t)b * SEQ + t0) * 768 + h * 128;
#pragma unroll
        for (int i = 0; i < 2; ++i) { const int q = tid + 512 * i, c = q >> 4, e8 = (q & 15) * 8; f32x4 z0, z1; ld_bf8(proj + (size_t)(t0 + c) * 3072 + 2304 + h * 128 + e8, z0, z1);
            const f32x4 g0 = *(const f32x4*)(ng + e8), g1 = *(const f32x4*)(ng + e8 + 4);
#pragma unroll
            for (int j = 0; j < 4; ++j) { z0[j] = g0[j] * siluf_(z0[j]); z1[j] = g1[j] * siluf_(z1[j]); }
            st_bf8(ydn + (size_t)c * 768 + e8, z0, z1); }
    }
    LDS_BARRIER();
}
__device__ __forceinline__ float row16_sum(float v) {
    v += __builtin_bit_cast(float, __builtin_amdgcn_update_dpp(0, __builtin_bit_cast(int, v), 0xB1, 0xf, 0xf, false));
    v += __builtin_bit_cast(float, __builtin_amdgcn_update_dpp(0, __builtin_bit_cast(int, v), 0x4E, 0xf, 0xf, false));
    v += __builtin_bit_cast(float, __builtin_amdgcn_update_dpp(0, __builtin_bit_cast(int, v), 0x141, 0xf, 0xf, false));
    v += __builtin_bit_cast(float, __builtin_amdgcn_update_dpp(0, __builtin_bit_cast(int, v), 0x140, 0xf, 0xf, false));
    return v;
}
__device__ __forceinline__ void dn_scan(const Params& p, LAS unsigned char* lds, int layer, int b, int h) {
    const int tid = htid(), lane = tid & 63, wave = __builtin_amdgcn_readfirstlane(tid >> 6), r = lane & 15, kg = lane >> 4;
    LAS unsigned char* W = lds; LAS unsigned char* QD = lds + 17408; LAS unsigned char* ATT = lds + 34816; LAS unsigned char* KDT = lds + 44032; LAS unsigned char* UT = lds + 62464;
    LAS unsigned char* ST = lds + 80896; LAS unsigned char* VNT = lds + 115712; LAS float* PS = (LAS float*)(lds + 134144); LAS float* RS = (LAS float*)(lds + 136192) + wave * 64;
    const unsigned char* items = p.ws + WS_DNS + (size_t)(b * 32 * 6 + h) * DNS_ITEM;
    bf16_t* ydn = (bf16_t*)(p.ws + WS_YDN) + (size_t)b * SEQ * 768 + h * 128 + 16 * wave + r;
    float egl_all = lane < 32 ? ((const float*)(p.ws + WS_DNEGL))[b * 32 * 6 + h + 6 * lane] : 0.f;
    asm volatile("" : "+v"(egl_all));
    f32x4 S[8], o[4];
#pragma unroll
    for (int dt = 0; dt < 8; ++dt) S[dt] = (f32x4){0.f, 0.f, 0.f, 0.f};
#pragma unroll
    for (int mt = 0; mt < 4; ++mt) o[mt] = (f32x4){0.f, 0.f, 0.f, 0.f};
    for (int i = lane; i < 16 * 272 / 16; i += 64) *(LAS u32x4*)(ST + wave * 16 * 272 + i * 16) = (u32x4){0u, 0u, 0u, 0u};
    u32x4 R[9];
#pragma unroll
    for (int i = 0; i < 9; ++i) R[i] = *(const u32x4*)(items + (size_t)(tid + 512 * i) * 16);
    unsigned short zc[16];
#pragma unroll
    for (int i = 0; i < 16; ++i) zc[i] = 0u;
    LDS_BARRIER();
    for (int n = 0; n <= 32; ++n) {
        if (n < 32) {
#pragma unroll
            for (int i = 0; i < 9; ++i) { const int q = tid + 512 * i; LAS unsigned char* dst;
                if (i < 2) dst = W + (q >> 4) * 272 + (q & 15) * 16; else if (i < 4) dst = QD + ((q - 1024) >> 4) * 272 + (q & 15) * 16;
                else if (i < 5) dst = ATT + ((q - 2048) >> 3) * 144 + (q & 7) * 16; else if (i < 7) dst = KDT + ((q - 2560) >> 3) * 144 + (q & 7) * 16;
                else dst = UT + ((q - 3584) >> 3) * 144 + (q & 7) * 16;
                *(LAS u32x4*)dst = R[i]; }
        }
        if (n > 0) {
            float tot = 0.f;
#pragma unroll
            for (int w = 0; w < 8; ++w) tot += PS[w * 64 + lane];
            RS[lane] = rsqrtf(tot * (1.f / 128.f) + EPS);
#pragma unroll
            for (int mt = 0; mt < 4; ++mt) { const f32x4 rs = *(const LAS f32x4*)(RS + 16 * mt + 4 * kg);
#pragma unroll
                for (int rr = 0; rr < 4; rr += 2) { bf16_t* yo_ = ydn + (size_t)((n - 1) * 64 + 16 * mt + 4 * kg + rr) * 768;
                    ST2_BF(yo_, yo_ + 768, o[mt][rr] * rs[rr] * __uint_as_float(((unsigned)zc[4 * mt + rr]) << 16), o[mt][rr + 1] * rs[rr + 1] * __uint_as_float(((unsigned)zc[4 * mt + rr + 1]) << 16)); } }
        }
        if (n == 32) break;
        if (n + 1 < 32) {
#pragma unroll
            for (int i = 0; i < 9; ++i) R[i] = *(const u32x4*)(items + (size_t)(n + 1) * 6 * DNS_ITEM + (size_t)(tid + 512 * i) * 16);
        }
#pragma unroll
        for (int mt = 0; mt < 4; ++mt)
#pragma unroll
            for (int rr = 0; rr < 4; ++rr) zc[4 * mt + rr] = ydn[(size_t)(n * 64 + 16 * mt + 4 * kg + rr) * 768];
        const float egl = __builtin_bit_cast(float, __builtin_amdgcn_readlane(__builtin_bit_cast(int, egl_all), n));
        LDS_BARRIER();
        bf16x8 sf[4];
#pragma unroll
        for (int ks = 0; ks < 4; ++ks) sf[ks] = *(const LAS bf16x8*)(ST + (16 * wave + r) * 272 + ks * 64 + kg * 16);
        {   bf16x8 af[4][4]; u32x2 uw[4];
#pragma unroll
            for (int mt = 0; mt < 4; ++mt) {
#pragma unroll
                for (int ks = 0; ks < 4; ++ks) af[mt][ks] = *(const LAS bf16x8*)(W + (16 * mt + r) * 272 + ks * 64 + kg * 16);
                uw[mt] = *(const LAS u32x2*)(UT + (16 * wave + r) * 144 + (16 * mt + 4 * kg) * 2); }
#pragma unroll
            for (int mt = 0; mt < 4; ++mt) { f32x4 ws = (f32x4){0.f, 0.f, 0.f, 0.f};
#pragma unroll
                for (int ks = 0; ks < 4; ++ks) ws = mfma16(af[mt][ks], sf[ks], ws);
                const f32x4 vn = (f32x4){lo_bf(uw[mt].x), hi_bf(uw[mt].x), lo_bf(uw[mt].y), hi_bf(uw[mt].y)} - ws;
                u32x2 vw; vw.x = pk2(vn[0], vn[1]); vw.y = pk2(vn[2], vn[3]);
                *(LAS u32x2*)(VNT + (16 * wave + r) * 144 + (16 * mt + 4 * kg) * 2) = vw; } }
        bf16x8 vf[2];
        {
            bf16x8 qf[4][4], tf[4][2];
#pragma unroll
            for (int mt = 0; mt < 4; ++mt) {
#pragma unroll
                for (int ks = 0; ks < 4; ++ks) qf[mt][ks] = *(const LAS bf16x8*)(QD + (16 * mt + r) * 272 + ks * 64 + kg * 16);
#pragma unroll
                for (int kc = 0; kc < 2; ++kc) tf[mt][kc] = *(const LAS bf16x8*)(ATT + (16 * mt + r) * 144 + kc * 64 + kg * 16); }
#pragma unroll
            for (int kc = 0; kc < 2; ++kc) vf[kc] = *(const LAS bf16x8*)(VNT + (16 * wave + r) * 144 + kc * 64 + kg * 16);
#pragma unroll
            for (int mt = 0; mt < 4; ++mt) { f32x4 a = (f32x4){0.f, 0.f, 0.f, 0.f};
#pragma unroll
                for (int ks = 0; ks < 4; ++ks) a = mfma16(qf[mt][ks], sf[ks], a);
#pragma unroll
                for (int kc = 0; kc < 2; ++kc) a = mfma16(tf[mt][kc], vf[kc], a);
                o[mt] = a; } }
        {
            bf16x8 kf[8][2];
#pragma unroll
            for (int dt = 0; dt < 8; ++dt)
#pragma unroll
                for (int kc = 0; kc < 2; ++kc) kf[dt][kc] = *(const LAS bf16x8*)(KDT + (16 * dt + r) * 144 + kc * 64 + kg * 16);
#pragma unroll
            for (int dt = 0; dt < 8; ++dt) { f32x4 a = S[dt] * egl;
#pragma unroll
                for (int kc = 0; kc < 2; ++kc) a = mfma16(kf[dt][kc], vf[kc], a);
                S[dt] = a; u32x2 sw; sw.x = pk2(a[0], a[1]); sw.y = pk2(a[2], a[3]);
                *(LAS u32x2*)(ST + (16 * wave + r) * 272 + (16 * dt + 4 * kg) * 2) = sw; } }
#pragma unroll
        for (int mt = 0; mt < 4; ++mt) { f32x4 q;
#pragma unroll
            for (int rr = 0; rr < 4; ++rr) q[rr] = row16_sum(o[mt][rr] * o[mt][rr]);
            if (r == 0) *(LAS f32x4*)(PS + wave * 64 + 16 * mt + 4 * kg) = q; }
        LDS_BARRIER();
    }
    LDS_BARRIER();
}
template <int MODE>
__device__ __forceinline__ void ssd_load(const Params& p, LAS unsigned char* lds, int layer, int b, int c, int grp) {
    const int tid = htid(), lane = tid & 63, wave = tid >> 6, t0 = c * 64;
    LAS float* DT = (LAS float*)(lds + 117760); LAS float* ACS = DT + 384;
    LAS unsigned char* XT = lds + 34816;
    if (wave < 6) { const int hh = grp * 6 + wave; const float* small = (const float*)(p.ws + WS_SMALL) + ((size_t)b * SEQ + t0 + lane) * 32;
        const float dt = softplusf_(small[12 + hh] + p.in[I_SSDTB][layer * 12 + hh]); float a = -expf(p.in[I_SSALOG][layer * 12 + hh]) * dt;
#pragma unroll
        for (int o = 1; o < 64; o <<= 1) { const float t = __shfl_up(a, o); if (lane >= o) a += t; }
        DT[wave * 64 + lane] = dt; ACS[wave * 64 + lane] = a; }
    LDS_BARRIER();
    const int cg = tid % 80, seg = tid / 80, ch8 = cg * 8;
    if (tid < 480 && (MODE == 1 || ch8 < 512)) {
        const int col = ch8 < 384 ? grp * 384 + ch8 : (ch8 < 512 ? 768 + grp * 128 + (ch8 - 384) : 1024 + grp * 128 + (ch8 - 512));
        const float* cw = p.in[I_SSCONV] + (size_t)layer * 4 * 1280 + col; const float* cb = p.in[I_SSCONVB] + layer * 1280 + col;
        f32x4 w[4][2], bias[2];
#pragma unroll
        for (int j = 0; j < 4; ++j) { w[j][0] = *(const f32x4*)(cw + j * 1280); w[j][1] = *(const f32x4*)(cw + j * 1280 + 4); }
        bias[0] = *(const f32x4*)cb; bias[1] = *(const f32x4*)(cb + 4);
        const bf16_t* proj = (const bf16_t*)(p.ws + WS_PSSM) + (size_t)b * SEQ * 2048 + col;
        const int ts = seg * 11, hi = ch8 >> 6;
        f32x4 xm[3][2];
#pragma unroll
        for (int i = 0; i < 3; ++i) { const int t = t0 + ts - 3 + i; xm[i][0] = (f32x4){0.f, 0.f, 0.f, 0.f}; xm[i][1] = xm[i][0]; if (t >= 0) ld_bf8(proj + (size_t)t * 2048, xm[i][0], xm[i][1]); }
#pragma unroll
        for (int i = 0; i < 11; ++i) { const int tk = ts + i;
            if (tk < 64) { f32x4 c0, c1; ld_bf8(proj + (size_t)(t0 + tk) * 2048, c0, c1);
                f32x4 a0 = bias[0] + w[3][0] * c0 + w[2][0] * xm[2][0] + w[1][0] * xm[1][0] + w[0][0] * xm[0][0];
                f32x4 a1 = bias[1] + w[3][1] * c1 + w[2][1] * xm[2][1] + w[1][1] * xm[1][1] + w[0][1] * xm[0][1];
                xm[0][0] = xm[1][0]; xm[0][1] = xm[1][1]; xm[1][0] = xm[2][0]; xm[1][1] = xm[2][1]; xm[2][0] = c0; xm[2][1] = c1;
#pragma unroll
                for (int q = 0; q < 4; ++q) { a0[q] = siluf_(a0[q]); a1[q] = siluf_(a1[q]); }
                if (ch8 < 384) { const float sc = MODE == 0 ? DT[hi * 64 + tk] * fexp(ACS[hi * 64 + 63] - ACS[hi * 64 + tk]) : DT[hi * 64 + tk];
#pragma unroll
                    for (int q = 0; q < 4; ++q) { const unsigned pw = pk2(a0[q] * sc, a1[q] * sc);
                        *(LAS bf16_t*)(XT + (ch8 + q) * 144 + tk * 2) = (bf16_t)(pw & 0xffffu); *(LAS bf16_t*)(XT + (ch8 + 4 + q) * 144 + tk * 2) = (bf16_t)(pw >> 16); } }
                else if (MODE == 0) {
#pragma unroll
                    for (int q = 0; q < 4; ++q) { const unsigned pw = pk2(a0[q], a1[q]);
                        *(LAS bf16_t*)(lds + (ch8 - 384 + q) * 144 + tk * 2) = (bf16_t)(pw & 0xffffu); *(LAS bf16_t*)(lds + (ch8 - 384 + 4 + q) * 144 + tk * 2) = (bf16_t)(pw >> 16); } }
                else { u32x4 pw; pw.x = pk2(a0[0], a0[1]); pw.y = pk2(a0[2], a0[3]); pw.z = pk2(a1[0], a1[1]); pw.w = pk2(a1[2], a1[3]);
                    *(LAS u32x4*)(lds + (ch8 < 512 ? 17408 + tk * 272 + (ch8 - 384) * 2 : tk * 272 + (ch8 - 512) * 2)) = pw; } } }
    }
    LDS_BARRIER();
}
__device__ __forceinline__ void ssd_states(const Params& p, LAS unsigned char* lds, int layer, int b, int c, int grp) {
    ssd_load<0>(p, lds, layer, b, c, grp);
    const int tid = htid(), lane = tid & 63, wave = tid >> 6, r = lane & 15, kg = lane >> 4;
    const LAS unsigned char* XT = lds + 34816; const LAS unsigned char* BT = lds; const LAS float* ACS = (const LAS float*)(lds + 117760) + 384;
    bf16_t* st = (bf16_t*)(p.ws + WS_SSST) + ((size_t)(b * 32 + c) * 12 + grp * 6) * 8192;
    for (int t4 = 0; t4 < 24; t4 += 4) {
        bf16x8 af[4][2], bfr[4][2];
#pragma unroll
        for (int q = 0; q < 4; ++q) { const int t = wave + 8 * (t4 + q), hi = t >> 5, mt = (t >> 3) & 3, nt = t & 7;
#pragma unroll
            for (int ks = 0; ks < 2; ++ks) { af[q][ks] = *(const LAS bf16x8*)(XT + (hi * 64 + 16 * mt + r) * 144 + ks * 64 + kg * 16); bfr[q][ks] = *(const LAS bf16x8*)(BT + (16 * nt + r) * 144 + ks * 64 + kg * 16); } }
#pragma unroll
        for (int q = 0; q < 4; ++q) { const int t = wave + 8 * (t4 + q), hi = t >> 5, mt = (t >> 3) & 3, nt = t & 7;
            f32x4 acc = (f32x4){0.f, 0.f, 0.f, 0.f};
#pragma unroll
            for (int ks = 0; ks < 2; ++ks) acc = mfma16(af[q][ks], bfr[q][ks], acc);
#pragma unroll
            for (int rr = 0; rr < 4; rr += 2) { bf16_t* so_ = st + (size_t)hi * 8192 + (16 * mt + 4 * kg + rr) * 128 + 16 * nt + r; ST2_BF(so_, so_ + 128, acc[rr], acc[rr + 1]); } }
    }
    if (tid < 6) ((float*)(p.ws + WS_SSCD))[(b * 32 + c) * 12 + grp * 6 + tid] = expf(ACS[tid * 64 + 63]);
    LDS_BARRIER();
}
__device__ __forceinline__ void ssd_scan(const Params& p, int first_blk, int nblk) {
    const int gt = ((int)blockIdx.x - first_blk) * 512 + htid(), NT = nblk * 512;
    const u32x2* st = (const u32x2*)(p.ws + WS_SSST); const float* cd = (const float*)(p.ws + WS_SSCD); u32x2* pv = (u32x2*)(p.ws + WS_SSPV);
    for (int v = gt; v < NB * 12 * 2048; v += NT) { const int b = v / (12 * 2048), h = (v / 2048) % 12, e = v % 2048;
        f32x4 run = (f32x4){0.f, 0.f, 0.f, 0.f};
        for (int c0 = 0; c0 < 32; c0 += 8) { u32x2 t[8];
#pragma unroll
            for (int i = 0; i < 8; ++i) t[i] = st[((size_t)(b * 32 + c0 + i) * 12 + h) * 2048 + e];
#pragma unroll
            for (int i = 0; i < 8; ++i) { u32x2 w; w.x = pk2(run[0], run[1]); w.y = pk2(run[2], run[3]); pv[((size_t)(b * 32 + c0 + i) * 12 + h) * 2048 + e] = w;
                run = run * cd[(b * 32 + c0 + i) * 12 + h] + (f32x4){lo_bf(t[i].x), hi_bf(t[i].x), lo_bf(t[i].y), hi_bf(t[i].y)}; } }
    }
}
__device__ __forceinline__ void ssd_out(const Params& p, LAS unsigned char* lds, int layer, int b, int c, int grp) {
    ssd_load<1>(p, lds, layer, b, c, grp);
    const int tid = htid(), lane = tid & 63, wave = tid >> 6, r = lane & 15, kg = lane >> 4, t0 = c * 64;
    const LAS unsigned char* CM = lds; const LAS unsigned char* BM = lds + 17408; const LAS unsigned char* XT = lds + 34816; LAS unsigned char* MH = lds + 90112;
    const LAS float* DT = (const LAS float*)(lds + 117760); const LAS float* ACS = DT + 384; LAS float* YG = (LAS float*)lds;
    const bf16_t* prev = (const bf16_t*)(p.ws + WS_SSPV) + ((size_t)(b * 32 + c) * 12 + grp * 6) * 8192;
    f32x4 cb[2];
    {   bf16x8 ca[2][4], cbf[2][4];
#pragma unroll
        for (int q = 0; q < 2; ++q) { const int t = wave * 2 + q, mt = t >> 2, nt = t & 3;
#pragma unroll
            for (int ks = 0; ks < 4; ++ks) { ca[q][ks] = *(const LAS bf16x8*)(CM + (16 * mt + r) * 272 + ks * 64 + kg * 16); cbf[q][ks] = *(const LAS bf16x8*)(BM + (16 * nt + r) * 272 + ks * 64 + kg * 16); } }
#pragma unroll
        for (int q = 0; q < 2; ++q) { f32x4 acc = (f32x4){0.f, 0.f, 0.f, 0.f};
#pragma unroll
            for (int ks = 0; ks < 4; ++ks) acc = mfma16(ca[q][ks], cbf[q][ks], acc);
            cb[q] = acc; } }
    f32x4 y[2][6];
#pragma unroll
    for (int half = 0; half < 2; ++half) {
#pragma unroll
        for (int q = 0; q < 2; ++q) { const int t = wave * 2 + q, mt = t >> 2, nt = t & 3, j = 16 * nt + r;
#pragma unroll
            for (int hl = 0; hl < 3; ++hl) { const int hi = 3 * half + hl; const float aj = ACS[hi * 64 + j];
#pragma unroll
                for (int rr = 0; rr < 4; ++rr) { const int i = 16 * mt + 4 * kg + rr; *(LAS bf16_t*)(MH + hl * 9216 + i * 144 + j * 2) = (bf16_t)f2bf((i >= j) ? cb[q][rr] * fexp(fminf(ACS[hi * 64 + i] - aj, 0.f)) : 0.f); } } }
        bf16x8 pf[6][4];
#pragma unroll
        for (int k = 0; k < 6; ++k) { const int t = wave + 8 * k, hl = t >> 4, nt = t & 3, hi = 3 * half + hl; const bf16_t* pr = prev + (size_t)hi * 8192 + (16 * nt + r) * 128 + kg * 8;
#pragma unroll
            for (int ks = 0; ks < 4; ++ks) pf[k][ks] = *(const bf16x8*)(pr + ks * 32); }
        LDS_BARRIER();
#pragma unroll
        for (int k = 0; k < 6; ++k) { const int t = wave + 8 * k, hl = t >> 4, mt = (t >> 2) & 3, nt = t & 3, hi = 3 * half + hl, hh = grp * 6 + hi;
            f32x4 acc = (f32x4){0.f, 0.f, 0.f, 0.f}, off = acc;
            bf16x8 mf[2], xf[2], cf[4];
#pragma unroll
            for (int ks = 0; ks < 2; ++ks) { mf[ks] = *(const LAS bf16x8*)(MH + hl * 9216 + (16 * mt + r) * 144 + ks * 64 + kg * 16); xf[ks] = *(const LAS bf16x8*)(XT + (hi * 64 + 16 * nt + r) * 144 + ks * 64 + kg * 16); }
#pragma unroll
            for (int ks = 0; ks < 4; ++ks) cf[ks] = *(const LAS bf16x8*)(CM + (16 * mt + r) * 272 + ks * 64 + kg * 16);
#pragma unroll
            for (int ks = 0; ks < 2; ++ks) acc = mfma16(mf[ks], xf[ks], acc);
#pragma unroll
            for (int ks = 0; ks < 4; ++ks) off = mfma16(cf[ks], pf[k][ks], off);
            const u32x2 xw = *(const LAS u32x2*)(XT + (hi * 64 + 16 * nt + r) * 144 + (16 * mt + 4 * kg) * 2); const float xs[4] = {lo_bf(xw.x), hi_bf(xw.x), lo_bf(xw.y), hi_bf(xw.y)};
            const float dsk = p.in[I_SSD][layer * 12 + hh];
#pragma unroll
            for (int rr = 0; rr < 4; ++rr) { const int i = 16 * mt + 4 * kg + rr; acc[rr] += fexp(ACS[hi * 64 + i]) * off[rr] + dsk * xs[rr] * __builtin_amdgcn_rcpf(fmaxf(DT[hi * 64 + i], 1e-30f)); }
            y[half][k] = acc; }
        LDS_BARRIER();
    }
    const bf16_t* zp = (const bf16_t*)(p.ws + WS_PSSM) + ((size_t)b * SEQ + t0) * 2048 + 1280 + grp * 384;
#pragma unroll
    for (int half = 0; half < 2; ++half)
#pragma unroll
        for (int k = 0; k < 6; ++k) { const int t = wave + 8 * k, hl = t >> 4, mt = (t >> 2) & 3, nt = t & 3, hi = 3 * half + hl, ch = hi * 64 + 16 * nt + r;
#pragma unroll
            for (int rr = 0; rr < 4; ++rr) { const int i = 16 * mt + 4 * kg + rr; const float z = bf2f(zp[(size_t)i * 2048 + ch]); YG[i * 388 + ch] = y[half][k][rr] * siluf_(z); } }
    LDS_BARRIER();
    const float* sn = p.in[I_SSNORM] + layer * 768 + grp * 384; bf16_t* yo = (bf16_t*)(p.ws + WS_YSSM) + ((size_t)b * SEQ + t0) * 768 + grp * 384;
#pragma unroll
    for (int i8 = 0; i8 < 8; ++i8) { const int i = 8 * wave + i8; float v[6], ss = 0.f;
#pragma unroll
        for (int k = 0; k < 6; ++k) { v[k] = YG[i * 388 + lane + 64 * k]; ss += v[k] * v[k]; }
        const float rs = rsqrtf(wave_sum(ss) * (1.f / 384.f) + EPS);
#pragma unroll
        for (int k = 0; k < 6; k += 2) ST2_BF(yo + (size_t)i * 768 + lane + 64 * k, yo + (size_t)i * 768 + lane + 64 * (k + 1), v[k] * rs * sn[lane + 64 * k], v[k + 1] * rs * sn[lane + 64 * (k + 1)]); }
    LDS_BARRIER();
}

typedef float f32x16 __attribute__((ext_vector_type(16)));
__device__ __forceinline__ void attn_tile(const Params& p, int b, int g, int j, int r, int qt, int lane) {
    const int d = g == 0 ? 1 : (g == 1 ? 4 : 16), L = SEQ / d, n = lane & 31, hw = lane >> 5;
    const int P0 = b * SEQ + r * L;
    const bf16_t* Q = (const bf16_t*)(p.ws + WS_QK) + (size_t)(0 * 3 + g) * TC * 256 + j * 64;
    const bf16_t* K = (const bf16_t*)(p.ws + WS_QK) + (size_t)(1 * 3 + g) * TC * 256 + j * 64;
    const bf16_t* V = (const bf16_t*)(p.ws + WS_VT) + (size_t)(g * 256 + j * 64) * TC;
    const float sl2 = exp2f(-8.f * (float)(4 * g + j + 1) / 12.f) * (float)d * 1.4426950408889634f;
    bf16x8 qf[4];
    { const bf16_t* qrow = Q + (size_t)(P0 + 32 * qt + n) * 256 + 8 * hw;
#pragma unroll
      for (int s = 0; s < 4; ++s) qf[s] = *(const bf16x8*)(qrow + 16 * s); }
    f32x16 o0, o1;
#pragma unroll
    for (int i = 0; i < 16; ++i) { o0[i] = 0.f; o1[i] = 0.f; }
    float mrun = -1e30f, lrun = 0.f;
    const int pim = (n & 0x13) | (((n >> 2) & 1) << 3) | (((n >> 3) & 1) << 2);
    const int qi = 32 * qt + n;
    const int kb0 = qt > 4 ? qt - 4 : 0;
    bf16x8 kf[4], vf[2][2];
    { const bf16_t* krow = K + (size_t)(P0 + 32 * kb0 + pim) * 256 + 8 * hw;
#pragma unroll
      for (int s = 0; s < 4; ++s) kf[s] = *(const bf16x8*)(krow + 16 * s);
#pragma unroll
      for (int sp = 0; sp < 2; ++sp)
#pragma unroll
          for (int dh = 0; dh < 2; ++dh) vf[sp][dh] = *(const bf16x8*)(V + (size_t)(32 * dh + n) * TC + P0 + 32 * kb0 + 16 * sp + 8 * hw); }
    for (int kb = kb0; kb <= qt; ++kb) {
        f32x16 st;
#pragma unroll
        for (int i = 0; i < 16; ++i) st[i] = 0.f;
#pragma unroll
        for (int s = 0; s < 4; ++s) st = __builtin_amdgcn_mfma_f32_32x32x16_bf16(kf[s], qf[s], st, 0, 0, 0);
        bf16x8 vc[2][2];
#pragma unroll
        for (int sp = 0; sp < 2; ++sp)
#pragma unroll
            for (int dh = 0; dh < 2; ++dh) vc[sp][dh] = vf[sp][dh];
        if (kb < qt) {
            const bf16_t* krow = K + (size_t)(P0 + 32 * (kb + 1) + pim) * 256 + 8 * hw;
#pragma unroll
            for (int s = 0; s < 4; ++s) kf[s] = *(const bf16x8*)(krow + 16 * s);
#pragma unroll
            for (int sp = 0; sp < 2; ++sp)
#pragma unroll
                for (int dh = 0; dh < 2; ++dh) vf[sp][dh] = *(const bf16x8*)(V + (size_t)(32 * dh + n) * TC + P0 + 32 * (kb + 1) + 16 * sp + 8 * hw);
        }
        float mx = -1e30f;
#pragma unroll
        for (int jj = 0; jj < 16; ++jj) { const int kidx = 32 * kb + 16 * (jj >> 3) + 8 * hw + 4 * ((jj >> 2) & 1) + (jj & 3); const int dl = qi - kidx;
            const float sc = (dl >= 0 && dl <= 128) ? st[jj] * 1.4426950408889634f - sl2 * (float)dl : -1e30f; st[jj] = sc; mx = fmaxf(mx, sc); }
        mx = fmaxf(mx, __shfl_xor(mx, 32));
        const float mnew = fmaxf(mrun, mx), alpha = __builtin_amdgcn_exp2f(mrun - mnew);
        float rs = 0.f;
#pragma unroll
        for (int jj = 0; jj < 16; ++jj) { const float pj = __builtin_amdgcn_exp2f(st[jj] - mnew); st[jj] = pj; rs += pj; }
        rs += __shfl_xor(rs, 32);
        lrun = lrun * alpha + rs; mrun = mnew;
#pragma unroll
        for (int i = 0; i < 16; ++i) { o0[i] *= alpha; o1[i] *= alpha; }
#pragma unroll
        for (int sp = 0; sp < 2; ++sp) {
            u32x4 pw; pw.x = pk2(st[8 * sp + 0], st[8 * sp + 1]); pw.y = pk2(st[8 * sp + 2], st[8 * sp + 3]); pw.z = pk2(st[8 * sp + 4], st[8 * sp + 5]); pw.w = pk2(st[8 * sp + 6], st[8 * sp + 7]);
            const bf16x8 pf = __builtin_bit_cast(bf16x8, pw);
            o0 = __builtin_amdgcn_mfma_f32_32x32x16_bf16(vc[sp][0], pf, o0, 0, 0, 0);
            o1 = __builtin_amdgcn_mfma_f32_32x32x16_bf16(vc[sp][1], pf, o1, 0, 0, 0);
        }
    }
    const float inv = 1.f / lrun;
    const int tok = b * SEQ + qi * d + r;
    bf16_t* og = (bf16_t*)(p.ws + WS_OG) + ((size_t)g * TC + tok) * 256 + j * 64 + 4 * hw;
#pragma unroll
    for (int q4 = 0; q4 < 4; ++q4) {
        u32x2 w0, w1; w0.x = pk2(o0[4 * q4] * inv, o0[4 * q4 + 1] * inv); w0.y = pk2(o0[4 * q4 + 2] * inv, o0[4 * q4 + 3] * inv);
        w1.x = pk2(o1[4 * q4] * inv, o1[4 * q4 + 1] * inv); w1.y = pk2(o1[4 * q4 + 2] * inv, o1[4 * q4 + 3] * inv);
        *(u32x2*)(og + 8 * q4) = w0; *(u32x2*)(og + 32 + 8 * q4) = w1;
    }
    if (hw == 0) ((float*)(p.ws + WS_LSE))[((size_t)g * TC + tok) * 4 + j] = (mrun + log2f(lrun)) * 0.6931471805599453f;
}
__device__ __forceinline__ void phase_attn_combine(const Params& p, int skip) {
    const int tid_ = htid(), lane = tid_ & 63, gw = ((int)blockIdx.x - skip) * 8 + (tid_ >> 6), NGW = ((int)gridDim.x - skip) * 8;
    const bf16_t* og = (const bf16_t*)(p.ws + WS_OG); const float* lse = (const float*)(p.ws + WS_LSE); bf16_t* ya = (bf16_t*)(p.ws + WS_YATT);
    for (int t = gw; t < TC; t += NGW) {
        const int j = lane >> 4;
        const float l0 = lse[((size_t)0 * TC + t) * 4 + j], l1 = lse[((size_t)1 * TC + t) * 4 + j], l2 = lse[((size_t)2 * TC + t) * 4 + j];
        const float M = fmaxf(l0, fmaxf(l1, l2)); float w0 = expf(l0 - M), w1 = expf(l1 - M), w2 = expf(l2 - M); const float iw = 1.f / (w0 + w1 + w2); w0 *= iw; w1 *= iw; w2 *= iw;
        const u32x2 a = *((const u32x2*)(og + ((size_t)0 * TC + t) * 256) + lane), bb = *((const u32x2*)(og + ((size_t)1 * TC + t) * 256) + lane), c = *((const u32x2*)(og + ((size_t)2 * TC + t) * 256) + lane);
        u32x2 o; o.x = pk2(w0 * lo_bf(a.x) + w1 * lo_bf(bb.x) + w2 * lo_bf(c.x), w0 * hi_bf(a.x) + w1 * hi_bf(bb.x) + w2 * hi_bf(c.x));
        o.y = pk2(w0 * lo_bf(a.y) + w1 * lo_bf(bb.y) + w2 * lo_bf(c.y), w0 * hi_bf(a.y) + w1 * hi_bf(bb.y) + w2 * hi_bf(c.y));
        *((u32x2*)(ya + (size_t)t * 256) + lane) = o;
    }
}
__device__ __forceinline__ void sub_barrier(unsigned* cnt, unsigned target) {
    asm volatile("s_waitcnt vmcnt(0)" ::: "memory");
    __syncthreads();
    if (threadIdx.x == 0) {
        __builtin_amdgcn_fence(__ATOMIC_RELEASE, "agent"); asm volatile("s_waitcnt vmcnt(0)" ::: "memory");
        (void)xb_add(cnt, 1u);
        unsigned sp = 0; while (xb_ld(cnt) < target) { __builtin_amdgcn_s_sleep(2); if (++sp > (1u << 24)) break; }
        __builtin_amdgcn_fence(__ATOMIC_ACQUIRE, "agent"); asm volatile("s_waitcnt vmcnt(0)" ::: "memory");
    }
    __syncthreads();
}
__device__ __forceinline__ void phase_mixers(const Params& p, LAS unsigned char* lds, int layer) {
    const int G = gridDim.x, NDP = NB * 32 * 6, NSS = NB * 32 * 2;
    for (int item = blockIdx.x; item < NDP + NSS; item += G) {
        if (item < NDP) dn_prep(p, lds, layer, item / 192, (item / 6) % 32, item % 6);
        else { const int it = item - NDP; ssd_states(p, lds, layer, it / 64, (it >> 1) & 31, it & 1); }
    }
}
__device__ __forceinline__ void phase_mixers2(const Params& p, LAS unsigned char* lds, int layer, int rep, unsigned* subcnt, bool use_bar2) {
    const int tid_ = htid(), lane = tid_ & 63, wave = tid_ >> 6, G = gridDim.x, nscan = NB * 6;
    const int ded = G > 2 * nscan ? nscan : 0;
    if ((int)blockIdx.x < ded) { if (!(MIX2_PROBE == 2 && rep > 0)) dn_scan(p, lds, layer, blockIdx.x / 6, blockIdx.x % 6); return; }
    if (MIX2_PROBE == 1 && rep > 0) return;
    if (ded == 0) for (int it = blockIdx.x; it < nscan; it += G) dn_scan(p, lds, layer, it / 6, it % 6);
    const int nb = G - ded, rb = (int)blockIdx.x - ded;
    for (int item = rb; item < NB * 3 * 4 * 64 / 8; item += nb) { const int w = item * 8 + wave;
        const int st = w & 63, jj = (w >> 6) & 3, gg = (w >> 8) % 3, bb = w / 768;
        const int dd = gg == 0 ? 1 : (gg == 1 ? 4 : 16), tiles = SEQ / dd / 32;
        attn_tile(p, bb, gg, jj, st / tiles, st % tiles, lane); }
    ssd_scan(p, ded, nb);
    if (use_bar2) { XcdBarrier bar2; bar2.bar = (unsigned*)(p.ws + WS_CTL) + CW_BAR2; bar2.x = xb_xcc_id(); bar2.st = (volatile LAS unsigned*)(lds + LDS_BYTES - 256) + 12; xcd_barrier(bar2, (unsigned)nb); } else sub_barrier(subcnt, (unsigned)(nb * (rep + 1)));
    for (int it = rb; it < NB * 32 * 2; it += nb) ssd_out(p, lds, layer, it / 64, (it >> 1) & 31, it & 1);
    phase_attn_combine(p, ded);
}

constexpr int NSTEPS = 1 + NCH * (1 + 8 + 11 + 1);
__global__ void __launch_bounds__(512, 2) hybrid_fwd(Params p) {
    extern __shared__ __attribute__((aligned(16))) unsigned char lds_raw[];
    LAS unsigned char* lds = (LAS unsigned char*)lds_raw;
    volatile LAS unsigned* MISC = (volatile LAS unsigned*)(lds + LDS_BYTES - 256);
    if (threadIdx.x < 64) MISC[threadIdx.x] = 0u;
    __syncthreads();
    const int G = gridDim.x, cid = blockIdx.x;
    unsigned char* ws = p.ws;
    XcdBarrier bar; bar.bar = (unsigned*)(ws + WS_CTL) + CW_BAR; bar.x = 0; bar.st = MISC + 8;
    if (p.s_hi - p.s_lo > 1) bar = xcd_barrier_post((unsigned*)(ws + WS_CTL) + CW_BAR, MISC + 8);
    const bool use_bar2 = (p.s_hi - p.s_lo == NSTEPS) && ((int)gridDim.x > 2 * NB * 6);
    if (use_bar2 && (int)blockIdx.x >= NB * 6 && threadIdx.x == 0) (void)xb_add((unsigned*)(ws + WS_CTL) + CW_BAR2 + XB_XCNT(xb_xcc_id()), 1u);
    const int lo = p.s_lo, hi = p.s_hi;
    int step = 0;
    if (TPROBE_MASK != 0u && threadIdx.x == 0) { volatile LAS unsigned long long* tp_ = (volatile LAS unsigned long long*)(lds + LDS_BYTES - 256 + 128); tp_[0] = 0ull; tp_[1] = __builtin_amdgcn_s_memrealtime(); tp_[2] = 21ull; }
#define IN_STEP (step >= lo && step < hi)
#define END_STEP do { if (step >= lo && step + 1 < hi) xcd_barrier(bar); \
        if (TPROBE_ON && threadIdx.x == 0) { volatile LAS unsigned long long* tp_ = (volatile LAS unsigned long long*)(lds + LDS_BYTES - 256 + 128); const unsigned long long tn_ = __builtin_amdgcn_s_memrealtime(); \
            const unsigned pos_ = (unsigned)tp_[2]; if (pos_ < 22u && ((p.tmask >> pos_) & 1u)) tp_[0] += tn_ - tp_[1]; tp_[1] = tn_; tp_[2] = pos_ >= 20u ? 0ull : (unsigned long long)(pos_ + 1u); } \
        ++step; } while (0)
    bf16_t* xb = (bf16_t*)(ws + WS_XB); float* ssq = (float*)(ws + WS_SSQ);
    if (IN_STEP) for (int rep_ = 0; rep_ < (REP_PH == 0 ? 3 : 1); ++rep_, (rep_ < (REP_PH == 0 ? 3 : 1) ? xcd_barrier(bar) : (void)0)) phase_convert(p, lds);
    END_STEP;
    for (int chunk = 0; chunk < NCH; ++chunk) {
        float* xo = p.out + (size_t)chunk * TC * D;
        if (IN_STEP) phase_chunk_in(p, chunk);
        END_STEP;
        for (int layer = 0; layer < DEPTH; ++layer) {
            if (IN_STEP) for (int rep_ = 0; rep_ < (REP_PH == 2 ? 3 : 1); ++rep_, (rep_ < (REP_PH == 2 ? 3 : 1) ? xcd_barrier(bar) : (void)0)) {
                ProgIn P; P.S.init(TC / 256, INP / 256, G, cid); P.xb = layer == 0 ? xb : (const bf16_t*)(ws + WS_XB2); P.Wt = (const bf16_t*)(ws + WS_WIN) + (size_t)layer * INP * D; P.ssq = layer == 0 ? ssq : (const float*)(ws + WS_SSQ2);
                P.wsb = ws; P.pb = (const bf16_t*)(ws + WS_PB) + (size_t)layer * TC * PLE; P.wple = (const bf16_t*)(ws + WS_WPLE) + (size_t)layer * D * PLE;
                gemm_phase(lds, P);
            }
            END_STEP;
            if (IN_STEP) for (int rep_ = 0; rep_ < (REP_PH == 3 ? 3 : 1); ++rep_, (rep_ < (REP_PH == 3 ? 3 : 1) ? xcd_barrier(bar) : (void)0)) phase_mixers(p, lds, layer);
            END_STEP;
            if (IN_STEP) for (int rep_ = 0; rep_ < (REP_PH == 4 ? 3 : 1); ++rep_, (rep_ < (REP_PH == 4 ? 3 : 1) ? xcd_barrier(bar) : (void)0)) phase_mixers2(p, lds, layer, rep_, (unsigned*)(ws + WS_CTL) + CW_SUB + (chunk * 2 + layer) * 64, use_bar2);
            END_STEP;
            if (IN_STEP) for (int rep_ = 0; rep_ < (REP_PH == 6 ? 3 : 1); ++rep_, (rep_ < (REP_PH == 6 ? 3 : 1) ? xcd_barrier(bar) : (void)0)) {
                ProgMerge P; P.S.init(TC / 256, 4, G, cid); P.wsb = ws;
                P.wdn = (const bf16_t*)(ws + WS_WDN) + (size_t)layer * D * 768; P.wssm = (const bf16_t*)(ws + WS_WSSM) + (size_t)layer * D * 768; P.watt = (const bf16_t*)(ws + WS_WATT) + (size_t)layer * D * 256;
                gemm_phase(lds, P);
            }
            END_STEP;
            if (IN_STEP) {
                ProgResid P; P.S.init(TC / 256, 4, G, cid); P.A = (const bf16_t*)(ws + WS_MERGED); P.lda = 2048; P.nt = 16; P.Wt = (const bf16_t*)(ws + WS_WOUT) + (size_t)layer * D * D; P.ldb = 2048;
                P.xin = layer == 0 ? p.in[I_X] + (size_t)chunk * TC * D : xo; P.xout = xo; P.xb = xb; P.ssq = ssq; P.sc = 1.f; P.qx = 1;
                gemm_phase(lds, P);
            }
            END_STEP;
            if (layer == 0) {
                if (IN_STEP) for (int rep_ = 0; rep_ < (REP_PH == 8 ? 3 : 1); ++rep_, (rep_ < (REP_PH == 8 ? 3 : 1) ? xcd_barrier(bar) : (void)0)) {
                    ProgFfnGu P; P.S.init(TC / 256, 2 * FFN / 256, G, cid); P.xb = xb; P.Wt = (const bf16_t*)(ws + WS_WFGU); P.ssq = ssq; P.act = (bf16_t*)(ws + WS_ACT);
                    gemm_phase(lds, P);
                }
                END_STEP;
                if (IN_STEP) {
                    ProgResid P; P.S.init(TC / 256, 4, G, cid); P.A = (const bf16_t*)(ws + WS_ACT); P.lda = 2 * FFN; P.nt = FFN / 64; P.Wt = (const bf16_t*)(ws + WS_WFD); P.ldb = 2 * FFN;
                    P.xin = xo; P.xout = xo; P.xb = xb; P.ssq = ssq; P.sc = (DBG_ABL & 8) ? 0.f : 1.f; P.qx = 0;
                    gemm_phase(lds, P);
                }
                END_STEP;
            } else {
                if (IN_STEP) phase_router(p, lds, chunk);
                END_STEP;
                if (IN_STEP) phase_slots(p, chunk);
                END_STEP;
                if (IN_STEP) for (int rep_ = 0; rep_ < (REP_PH == 12 ? 3 : 1); ++rep_, (rep_ < (REP_PH == 12 ? 3 : 1) ? xcd_barrier(bar) : (void)0)) {
                    ProgMoeGu P; P.S.init((const unsigned*)(ws + WS_CTL) + CW_CNT + chunk * 64, 2 * EXD / 256, G, cid); P.xb = xb; P.Wt = (const bf16_t*)(ws + WS_WMGU); P.ssq = ssq;
                    P.idx = (const int*)(ws + WS_ROUTE) + RT_IDX; P.act = (bf16_t*)(ws + WS_ACTM);
                    gemm_phase(lds, P);
                }
                END_STEP;
                if (IN_STEP) for (int rep_ = 0; rep_ < (REP_PH == 13 ? 3 : 1); ++rep_, (rep_ < (REP_PH == 13 ? 3 : 1) ? xcd_barrier(bar) : (void)0)) {
                    ProgMoeDown P; P.init((const unsigned*)(ws + WS_CTL) + CW_CNT + chunk * 64, G, cid); P.act = (const bf16_t*)(ws + WS_ACTM); P.Wt = (const bf16_t*)(ws + WS_WMD); P.ypair = (bf16_t*)(ws + WS_YPAIR); P.partk = (float*)(ws + WS_PARTK);
                    gemm_phase(lds, P);
                }
                END_STEP;
                if (IN_STEP) phase_combine(p, chunk);
                END_STEP;
            }
            if (IN_STEP) {
                ProgPle P; P.S.init(TC / 256, 4, G, cid); P.xb = xb; P.wpg = (const bf16_t*)(ws + WS_WPG) + (size_t)layer * D * D; P.pp = (const bf16_t*)(ws + WS_PP); P.ssq = ssq;
                P.x = xo; P.xbout = (bf16_t*)(ws + WS_XB2); P.ssqout = (float*)(ws + WS_SSQ2);
                gemm_phase(lds, P);
            }
            END_STEP;
        }
        if (IN_STEP) phase_final(p, chunk);
        END_STEP;
    }
    if (TPROBE_MASK != 0u && blockIdx.x == 0 && threadIdx.x == 0) { const unsigned long long tsum_ = *(volatile LAS unsigned long long*)(lds + LDS_BYTES - 256 + 128); const unsigned long long t0_ = __builtin_amdgcn_s_memrealtime(); while (__builtin_amdgcn_s_memrealtime() - t0_ < 4ull * tsum_) __builtin_amdgcn_s_sleep(16); }
#undef IN_STEP
#undef END_STEP
}

#if defined(DBG_REP_STEP)
__global__ void dbg_csum(const unsigned* buf, size_t n, unsigned long long* out) {
    unsigned long long a = 0;
    for (size_t i = (size_t)blockIdx.x * 256 + threadIdx.x; i < n; i += (size_t)gridDim.x * 256) a += (unsigned long long)buf[i] * (unsigned long long)((i % 1021) + 1);
    atomicAdd(out, a);
}
__global__ void dbg_verdict(float* out, const unsigned long long* cs, int R) {
    bool bad = false; for (int r = 1; r < R; ++r) bad = bad || (cs[r] != cs[0]);
    const float v = bad ? __builtin_nanf("") : 0.f; const size_t n = (size_t)BATCH * SEQ * D;
    for (size_t i = (size_t)blockIdx.x * 256 + threadIdx.x; i < n; i += (size_t)gridDim.x * 256) out[i] = v;
}
#endif
#if defined(DBG_STOP)
#ifndef DBG_DUMP
#define DBG_DUMP 0
#define DBG_DUMP_OFF 0
#endif
__global__ void dbg_fill(float* out, const unsigned short* buf, int dump) {
    const size_t n = (size_t)BATCH * SEQ * D, c0 = (size_t)TC * D;
    for (size_t i = (size_t)blockIdx.x * 256 + threadIdx.x; i < n; i += (size_t)gridDim.x * 256) {
        if (i >= c0) out[i] = 0.f; else if (dump) out[i] = __uint_as_float(((unsigned)buf[i]) << 16);
    }
}
#endif
extern "C" void kernel_launch(void* const* d_in, const int* in_sizes, int n_in, void* d_out, int out_size, void* d_ws, size_t ws_size, hipStream_t stream) {
    static int grid = 0;
    if (grid == 0) {
        if (n_in != 30 || out_size != BATCH * SEQ * D || ws_size < WS_END) { fprintf(stderr, "kernel_launch: unexpected shapes (n_in %d, out %d, ws %zu < %zu)\n", n_in, out_size, ws_size, (size_t)WS_END); grid = -1; return; }
        int dev = 0, cus = 0;
        if (hipGetDevice(&dev) != hipSuccess || hipDeviceGetAttribute(&cus, hipDeviceAttributeMultiprocessorCount, dev) != hipSuccess) { grid = -1; return; }
        if (hipFuncSetAttribute((const void*)hybrid_fwd, hipFuncAttributeMaxDynamicSharedMemorySize, LDS_BYTES) != hipSuccess) { fprintf(stderr, "kernel_launch: hipFuncSetAttribute failed\n"); grid = -1; return; }
        int per_cu = 0;
        if (hipOccupancyMaxActiveBlocksPerMultiprocessor(&per_cu, (const void*)hybrid_fwd, 512, LDS_BYTES) != hipSuccess || per_cu < 1) { fprintf(stderr, "kernel_launch: occupancy query says %d\n", per_cu); }
        (void)hipGetLastError();
        grid = cus;
    }
    if (grid < 0) return;
    (void)hipMemsetAsync((char*)d_ws + WS_CTL, 0, MiB, stream);
    Params p{};
    for (int i = 0; i < 30; ++i) p.in[i] = (const float*)d_in[i];
    p.out = (float*)d_out; p.ws = (unsigned char*)d_ws; p.tmask = TPROBE_MASK; p.pad = 0;
#if defined(DBG_REP_STEP)
    for (int s = 0; s < DBG_REP_STEP; ++s) { p.s_lo = s; p.s_hi = s + 1; hipLaunchKernelGGL(hybrid_fwd, dim3(grid), dim3(512), LDS_BYTES, stream, p); }
    unsigned long long* cs = (unsigned long long*)((char*)d_ws + WS_CTL + 512 * 1024);
    for (int r = 0; r < DBG_REP_N; ++r) { p.s_lo = DBG_REP_STEP; p.s_hi = DBG_REP_STEP + 1; hipLaunchKernelGGL(hybrid_fwd, dim3(grid), dim3(512), LDS_BYTES, stream, p);
        hipLaunchKernelGGL(dbg_csum, dim3(1024), dim3(256), 0, stream, (const unsigned*)((const char*)d_ws + DBG_REP_OFF), (size_t)(DBG_REP_BYTES) / 4, cs + r); }
    hipLaunchKernelGGL(dbg_verdict, dim3(2048), dim3(256), 0, stream, (float*)d_out, cs, (int)DBG_REP_N);
#elif defined(DBG_STOP)
    for (int s = 0; s < DBG_STOP; ++s) { p.s_lo = s; p.s_hi = s + 1; hipLaunchKernelGGL(hybrid_fwd, dim3(grid), dim3(512), LDS_BYTES, stream, p); }
    hipLaunchKernelGGL(dbg_fill, dim3(2048), dim3(256), 0, stream, (float*)d_out, (const unsigned short*)((const char*)d_ws + DBG_DUMP_OFF), (int)DBG_DUMP);
#elif ONE_LAUNCH
    p.s_lo = 0; p.s_hi = NSTEPS;
    hipLaunchKernelGGL(hybrid_fwd, dim3(grid), dim3(512), LDS_BYTES, stream, p);
#else
    for (int s = 0; s < NSTEPS; ++s) { p.s_lo = s; p.s_hi = s + 1; hipLaunchKernelGGL(hybrid_fwd, dim3(grid), dim3(512), LDS_BYTES, stream, p); }
#endif
}
```

```cpp
#include <hip/hip_runtime.h>
#include <cstdio>
#include <cstdint>

#define GAS __attribute__((address_space(1)))
#define LAS __attribute__((address_space(3)))
typedef unsigned short bf16_t;
typedef short bf16x8 __attribute__((ext_vector_type(8)));
typedef float f32x4 __attribute__((ext_vector_type(4)));
typedef float f32x2 __attribute__((ext_vector_type(2)));
typedef unsigned u32x4 __attribute__((ext_vector_type(4)));
typedef unsigned u32x2 __attribute__((ext_vector_type(2)));

#ifndef REP_PH
#define REP_PH -1
#endif
#ifndef EMU_FP8
#define EMU_FP8 0
#endif
#ifndef TPROBE_MASK
#define TPROBE_MASK 0u
#endif
#define TPROBE_ON (TPROBE_MASK != 0u)
#ifndef MIX2_PROBE
#define MIX2_PROBE 0
#endif
#ifndef DBG_ABL
#define DBG_ABL 0
#endif
#ifndef ONE_LAUNCH
#define ONE_LAUNCH 1
#endif

constexpr int D = 1024, BATCH = 32, SEQ = 2048, DEPTH = 2;
constexpr int PLE = 256;
constexpr float EPS = 1e-6f;
constexpr int FFN = 2816, NE = 8, EXD = 3584;
constexpr int C_DNZ = 2304, C_DNA = 3072, C_DNB = 3078, C_XBC = 3084, C_SSZ = 4364, C_SSDT = 5132, C_ATT = 5144, C_GATE = 7448, INW = 10520;
constexpr int NB = 8, TC = NB * SEQ, NCH = BATCH / NB;
constexpr int INP = 10752;
constexpr int MOE_SLOTS = 2 * TC + NE * 256;

constexpr size_t MiB = 1u << 20;
constexpr size_t WS_CTL = 0;
constexpr size_t WS_WIN = 1 * MiB;
constexpr size_t WS_WDN = WS_WIN + 42 * MiB;
constexpr size_t WS_WSSM = WS_WDN + 3 * MiB;
constexpr size_t WS_WATT = WS_WSSM + 3 * MiB;
constexpr size_t WS_WOUT = WS_WATT + 1 * MiB;
constexpr size_t WS_WFGU = WS_WOUT + 4 * MiB;
constexpr size_t WS_WFD = WS_WFGU + 11 * MiB;
constexpr size_t WS_WMGU = WS_WFD + 6 * MiB;
constexpr size_t WS_WMD = WS_WMGU + 112 * MiB;
constexpr size_t WS_WPG = WS_WMD + 56 * MiB;
constexpr size_t WS_WPLE = WS_WPG + 4 * MiB;
constexpr size_t WS_WR = WS_WPLE + 1 * MiB;
constexpr size_t WS_ACT0 = WS_WR + 1 * MiB;
constexpr size_t WS_XB = WS_ACT0;
constexpr size_t WS_SSQ = WS_XB + 32 * MiB;
constexpr size_t WS_PB = WS_SSQ + 1 * MiB;
constexpr size_t WS_ROUTE = WS_PB + 16 * MiB;
constexpr size_t WS_PART = WS_ROUTE + 1 * MiB;
constexpr size_t WS_PP = WS_PART;
constexpr size_t WS_MERGED = WS_PART + 64 * MiB;
constexpr size_t WS_Y = WS_MERGED + 32 * MiB;
constexpr size_t WS_YDN = WS_Y, WS_YSSM = WS_Y + 24 * MiB, WS_YATT = WS_Y + 48 * MiB, WS_OG = WS_Y + 56 * MiB, WS_LSE = WS_Y + 80 * MiB;
constexpr size_t WS_YPAIR = WS_Y;
constexpr size_t WS_PROJ = WS_Y + 81 * MiB;
constexpr size_t WS_PDN = WS_PROJ, WS_PSSM = WS_PDN + 96 * MiB, WS_SMALL = WS_PSSM + 64 * MiB, WS_QK = WS_SMALL + 2 * MiB, WS_VT = WS_QK + 48 * MiB, WS_GATES = WS_VT + 24 * MiB;
constexpr size_t WS_ACT = WS_PROJ, WS_ACTM = WS_PROJ;
constexpr int KSPL = 7, TAILMAX = 32;
constexpr size_t WS_PARTK = WS_PROJ + 256 * MiB;
static_assert((size_t)MOE_SLOTS * EXD * 2 <= 256 * MiB && WS_PARTK + (size_t)KSPL * (TAILMAX / 4) * 256 * 1024 * 4 <= WS_PROJ + 330 * MiB, "partk");
constexpr size_t WS_SCR = WS_PROJ + 330 * MiB;
constexpr size_t WS_XB2 = WS_SCR;
constexpr size_t WS_SSQ2 = WS_XB2 + 32 * MiB;
constexpr size_t WS_PART2 = WS_XB2 + 40 * MiB;
constexpr int DNS_ITEM = 73728;
constexpr size_t WS_DNS = WS_SCR + 40 * MiB;
constexpr size_t WS_DNEGL = WS_DNS + (size_t)NB * 32 * 6 * DNS_ITEM;
constexpr size_t WS_END = WS_SCR + 200 * MiB;
constexpr size_t WS_SSCD = WS_DNEGL + 8192;
static_assert(WS_SSCD + 16384 <= WS_END, "dn scratch");
constexpr size_t WS_SSPV = WS_SCR + 150 * MiB;
static_assert(WS_SSCD + 16384 <= WS_SSPV && WS_SSPV + 48 * MiB <= WS_END, "ssd prev");
constexpr size_t WS_SSST = WS_PART + 48 * MiB;
static_assert(WS_MERGED == WS_PART + 64 * MiB && (size_t)NB * 32 * 12 * 8192 * 2 <= 48 * MiB, "ssd states (bf16) sit in PART[48, 64) | MERGED, both idle during the mixers");
static_assert((size_t)MOE_SLOTS * EXD * 2 <= 330 * MiB, "moe act overlay");
static_assert((size_t)MOE_SLOTS * D * 2 <= 81 * MiB, "ypair overlay");
static_assert(WS_END <= 1024 * MiB, "workspace");
constexpr int RT_TOPE = 0, RT_TOPP = 2 * TC, RT_TOPW = 4 * TC, RT_TOPS = 6 * TC, RT_IDX = 8 * TC;
static_assert((size_t)(RT_IDX + MOE_SLOTS) * 4 <= MiB, "route");
constexpr int CW_BAR = 4096;
constexpr int CW_BAR2 = 8192;
constexpr int CW_SUB = 20480;
constexpr int CW_CNT = 16384;

constexpr int LDS_BYTES = 147456;
__device__ __forceinline__ int htid() { int t = threadIdx.x; asm volatile("" : "+v"(t)); return t; }
__device__ __forceinline__ float bf2f(bf16_t b) { return __uint_as_float(((unsigned)b) << 16); }
__device__ __forceinline__ unsigned f2bf(float f) { unsigned u = __float_as_uint(f); return (u + 0x7fffu + ((u >> 16) & 1u)) >> 16; }
typedef __bf16 bf16x2_t __attribute__((ext_vector_type(2)));
__device__ __forceinline__ unsigned pk2(float lo, float hi) { const f32x2 v = {lo, hi}; return __builtin_bit_cast(unsigned, __builtin_convertvector(v, bf16x2_t)); }
#define ST2_BF(PA, PB, A, B) do { const unsigned pw_ = pk2((A), (B)); *(PA) = (bf16_t)(pw_ & 0xffffu); *(PB) = (bf16_t)(pw_ >> 16); } while (0)
__device__ __forceinline__ float lo_bf(unsigned w) { return __uint_as_float(w << 16); }
__device__ __forceinline__ float hi_bf(unsigned w) { return __uint_as_float(w & 0xffff0000u); }
__device__ __forceinline__ float fexp(float x) { return __builtin_amdgcn_exp2f(x * 1.4426950408889634f); }
__device__ __forceinline__ float sigmoidf_(float x) { return __builtin_amdgcn_rcpf(1.f + fexp(-x)); }
__device__ __forceinline__ float siluf_(float x) { return x * sigmoidf_(x); }
__device__ __forceinline__ float softplusf_(float x) { const float e = fexp(x); return x > 20.f ? x : (x < -9.f ? e : __builtin_amdgcn_logf(1.f + e) * 0.6931471805599453f); }
__device__ __forceinline__ float q8(float v) {
    if (!EMU_FP8) return v;
    const float a = fabsf(v); float r;
    if (a < 0.015625f) r = rintf(a * 512.f) * (1.f / 512.f);
    else { unsigned u = __float_as_uint(a); u += 0x7FFFFu + ((u >> 20) & 1u); u &= ~0xFFFFFu; r = fminf(__uint_as_float(u), 448.f); }
    return copysignf(r, v);
}
__device__ __forceinline__ f32x4 q8v(f32x4 v) { return (f32x4){q8(v[0]), q8(v[1]), q8(v[2]), q8(v[3])}; }
__device__ __forceinline__ float wave_sum(float v) {
#pragma unroll
    for (int o = 1; o < 64; o <<= 1) v += __shfl_xor(v, o);
    return v;
}
__device__ __forceinline__ float wave_max(float v) {
#pragma unroll
    for (int o = 1; o < 64; o <<= 1) v = fmaxf(v, __shfl_xor(v, o));
    return v;
}
__device__ __forceinline__ float rstd_of(const float* ssq, int row) {
    const f32x4* p = (const f32x4*)(ssq + (size_t)row * 16);
    const f32x4 a = p[0], b = p[1], c = p[2], d = p[3];
    const float s = (((a.x + a.y) + (a.z + a.w)) + ((b.x + b.y) + (b.z + b.w))) + (((c.x + c.y) + (c.z + c.w)) + ((d.x + d.y) + (d.z + d.w)));
    return rsqrtf(s * (1.f / 1024.f) + EPS);
}
__device__ __forceinline__ int token_of_pos(int d, int p) {
    const int b = p >> 11, q = p & 2047;
    const int t = (d == 1) ? q : (d == 4) ? (4 * (q & 511) + (q >> 9)) : (16 * (q & 127) + (q >> 7));
    return b * 2048 + t;
}

#define XB_TMO      128
#define XB_XCNT(j)  (256  + 64 * (j))
#define XB_XSUB(j)  (1280 + 64 * (j))
#define XB_XGEN(j)  (2304 + 64 * (j))
#define XB_TOP      3328
#define XB_TOPGEN   3392
#define XCD_BAR_WORDS 3456
#define XB_SPIN_CAP (1u << 22)
__device__ __forceinline__ unsigned xb_ld(unsigned* p)              { return __hip_atomic_load(p, __ATOMIC_RELAXED, __HIP_MEMORY_SCOPE_AGENT); }
__device__ __forceinline__ unsigned xb_add(unsigned* p, unsigned v) { return __hip_atomic_fetch_add(p, v, __ATOMIC_RELAXED, __HIP_MEMORY_SCOPE_AGENT); }
__device__ __forceinline__ unsigned xb_xcc_id() { return (unsigned)__builtin_amdgcn_s_getreg((3 << 11) | 20) & 0xFu; }
#define XB_SPIN(cond, bar) do { unsigned _sp = 0; while (cond) { __builtin_amdgcn_s_sleep(1); \
    if ((++_sp & 255u) == 0u) { if (xb_ld(&(bar)[XB_TMO])) break; if (_sp > XB_SPIN_CAP) { atomicAdd(&(bar)[XB_TMO], 1u); break; } } } } while (0)
struct XcdBarrier { unsigned* bar; unsigned x; volatile LAS unsigned* st; };
__device__ __forceinline__ XcdBarrier xcd_barrier_post(unsigned* bar, volatile LAS unsigned* st) {
    XcdBarrier b; b.bar = bar; b.x = xb_xcc_id(); b.st = st;
    if (threadIdx.x == 0) (void)xb_add(&bar[XB_XCNT(b.x)], 1u);
    return b;
}
__device__ __forceinline__ void xcd_barrier_complete(unsigned* bar, unsigned x, unsigned& nloc, unsigned& nx, unsigned G) {
    unsigned sum, cnt, mine, sp = 0u;
    for (;;) {
        sum = 0u; cnt = 0u; mine = 0u;
#pragma unroll 1
        for (unsigned j = 0; j < 16; ++j) { const unsigned c = xb_ld(&bar[XB_XCNT(j)]); sum += c; cnt += (c > 0u) ? 1u : 0u; }
        mine = xb_ld(&bar[XB_XCNT(x)]);
        if (sum == G) break;
        __builtin_amdgcn_s_sleep(1);
        if ((++sp & 255u) == 0u) { if (xb_ld(&bar[XB_TMO])) break; if (sp > XB_SPIN_CAP) { atomicAdd(&bar[XB_TMO], 1u); break; } }
    }
    nloc = mine > 0u ? mine : 1u; nx = cnt > 0u ? cnt : 1u;
}
__device__ __forceinline__ void xcd_barrier(const XcdBarrier& b, unsigned nparts = 0u) {
    asm volatile("s_waitcnt vmcnt(0)" ::: "memory");
    __syncthreads();
    if (threadIdx.x == 0) {
        unsigned* bar = b.bar;
        __builtin_amdgcn_s_waitcnt(0);
        unsigned nloc = b.st[0], nx = b.st[1];
        if (nloc == 0u) { xcd_barrier_complete(bar, b.x, nloc, nx, nparts ? nparts : gridDim.x * gridDim.y * gridDim.z); b.st[0] = nloc; b.st[1] = nx; }
        const unsigned old = xb_add(&bar[XB_XSUB(b.x)], 1u);
        const unsigned gen = old / nloc;
        if (old + 1u == (gen + 1u) * nloc) {
            __builtin_amdgcn_fence(__ATOMIC_RELEASE, "agent");
            asm volatile("s_waitcnt vmcnt(0)" ::: "memory");
            const unsigned og = xb_add(&bar[XB_TOP], 1u);
            const unsigned tg = og / nx;
            if (og + 1u == (tg + 1u) * nx) xb_add(&bar[XB_TOPGEN], 1u);
            else XB_SPIN(xb_ld(&bar[XB_TOPGEN]) == tg, bar);
            __builtin_amdgcn_fence(__ATOMIC_ACQUIRE, "agent");
            xb_add(&bar[XB_XGEN(b.x)], 1u);
            asm volatile("s_waitcnt vmcnt(0)" ::: "memory");
        } else {
            XB_SPIN(xb_ld(&bar[XB_XGEN(b.x)]) == gen, bar);
            __builtin_amdgcn_fence(__ATOMIC_ACQUIRE, "agent");
            asm volatile("s_waitcnt vmcnt(0)" ::: "memory");
        }
    }
    __syncthreads();
}

constexpr int BM = 256, BK = 64, HALF = 128, HTB = HALF * BK * 2, STAGE_BYTES = 8 * HTB, NXCD = 8, WGM = 4;
__device__ __forceinline__ int lds_byte(int r, int c) { const int st = (r >> 4) * 2 + (c >> 5), rr = r & 15, cc = c & 31, ob = rr * 64 + cc * 2; return st * 1024 + (ob ^ (((ob >> 9) & 1) << 5)); }
__device__ __forceinline__ void stage_rc(int b, int& R, int& C) { const int st = b / 1024, sb = b % 1024, swz = sb ^ (((sb >> 9) & 1) << 5); R = (st >> 1) * 16 + swz / 64; C = (st & 1) * 32 + (swz % 64) / 2; }
__device__ __forceinline__ int perm32(int rho) { const int n = rho >> 4, i = rho & 15; return 8 * (i >> 2) + 4 * n + (i & 3); }

struct Unit { int pm, pn; };
struct StaticOrder {
    int nM, nN, nwg, G, c;
    __device__ __forceinline__ void init(int nM_, int nN_, int G_, int c_) { nM = nM_; nN = nN_; nwg = nM * nN; G = G_; c = c_; }
    __device__ __forceinline__ bool next(int i, Unit& u) const {
        const long L = (long)i * G + c; if (L >= nwg) return false;
        int wgid = (int)L; { const int q = nwg / NXCD, r = nwg % NXCD, xcd = wgid % NXCD, off = wgid / NXCD; wgid = (xcd < r ? xcd * (q + 1) : r * (q + 1) + (xcd - r) * q) + off; }
        const int nig = WGM * nN, gid = wgid / nig, fm = gid * WGM, gsz = (nM - fm) < WGM ? (nM - fm) : WGM;
        u.pm = fm + ((wgid % nig) % gsz); u.pn = (wgid % nig) / gsz; return true;
    }
};
struct GU { const char* A; const char* B; int lda, ldb, nt, mapA, mapB; const int* idx; int pm, pn, sub, aux; };
__device__ __forceinline__ unsigned row_off(int map, int RR, int ld, const int* idx) {
    int row;
    if (map == 0) row = RR;
    else if (map == 4) row = 4 * RR;
    else if (map == 16) row = 16 * (RR & 127) + (RR >> 7);
    else row = idx[RR];
    return (unsigned)row * (unsigned)ld;
}
template <class Prog>
__device__ __forceinline__ void gemm_phase(LAS unsigned char* lds, const Prog& P) {
    const int tid = htid(), wid = __builtin_amdgcn_readfirstlane(tid >> 6), lane = tid & 63, wr = wid >> 2, wc = wid & 3, fr = lane & 15, fq = lane >> 4;
    GU cur, nxt; int ui = 0;
    if (!P.unit(0, cur)) return;
    unsigned vA[4], vB[4];
#define G_SETV(u) do { int tz_ = threadIdx.x; asm volatile("" : "+v"(tz_)); int R0, C0, R1, C1; stage_rc(tz_ * 16, R0, C0); stage_rc(tz_ * 16 + 8192, R1, C1); \
        const int Rb0 = (R0 & ~31) + perm32(R0 & 31), Rb1 = (R1 & ~31) + perm32(R1 & 31); \
        vA[0] = row_off((u).mapA, R0, (u).lda, (u).idx) + C0 * 2; vA[1] = row_off((u).mapA, R1, (u).lda, (u).idx) + C1 * 2; \
        vA[2] = row_off((u).mapA, R0 + 128, (u).lda, (u).idx) + C0 * 2; vA[3] = row_off((u).mapA, R1 + 128, (u).lda, (u).idx) + C1 * 2; \
        vB[0] = row_off((u).mapB, Rb0, (u).ldb, nullptr) + C0 * 2; vB[1] = row_off((u).mapB, Rb1, (u).ldb, nullptr) + C1 * 2; \
        vB[2] = row_off((u).mapB, Rb0 + 128, (u).ldb, nullptr) + C0 * 2; vB[3] = row_off((u).mapB, Rb1 + 128, (u).ldb, nullptr) + C1 * 2; } while (0)
    G_SETV(cur);
    const unsigned ldsw = (unsigned)wid * 1024u;
    const int aoff = lds_byte(wr * 64 + fr, fq * 8), boff = lds_byte(wc * 32 + fr, fq * 8);
#define G_SA(b, h) (((b) * 2 + (h)) * HTB)
#define G_SB(b, h) ((4 + (b) * 2 + (h)) * HTB)
#define G_STAGE(bufoff, gbase, v, h) do { \
        __builtin_amdgcn_global_load_lds((const unsigned*)((gbase) + (v)[2 * (h)]), (LAS unsigned*)(lds + (bufoff) + ldsw), 16, 0, 0); \
        __builtin_amdgcn_global_load_lds((const unsigned*)((gbase) + (v)[2 * (h) + 1]), (LAS unsigned*)(lds + (bufoff) + ldsw + 8192), 16, 0, 0); } while (0)
#define G_LDA(dst, b, h) do { _Pragma("unroll") for (int m = 0; m < 4; ++m) _Pragma("unroll") for (int k = 0; k < 2; ++k) dst[m][k] = *(const LAS bf16x8*)(lds + G_SA(b, h) + aoff + m * 2048 + k * 1024); } while (0)
#define G_LDB(dst, b, h) do { _Pragma("unroll") for (int n = 0; n < 2; ++n) _Pragma("unroll") for (int k = 0; k < 2; ++k) dst[n][k] = *(const LAS bf16x8*)(lds + G_SB(b, h) + boff + n * 2048 + k * 1024); } while (0)
#define G_MMA(ai, bj, At, Bt) do { __builtin_amdgcn_s_setprio(1); _Pragma("unroll") for (int m = 0; m < 4; ++m) _Pragma("unroll") for (int n = 0; n < 2; ++n) _Pragma("unroll") for (int k = 0; k < 2; ++k) \
        acc[ai][bj][m][n] = __builtin_amdgcn_mfma_f32_16x16x32_bf16(Bt[n][k], At[m][k], acc[ai][bj][m][n], 0, 0, 0); __builtin_amdgcn_s_setprio(0); } while (0)
#define G_WAIT_V(n) asm volatile("s_waitcnt vmcnt(" #n ")" ::: "memory")
#define G_WAIT_L(n) asm volatile("s_waitcnt lgkmcnt(" #n ")" ::: "memory")
#define G_BAR __builtin_amdgcn_s_barrier()
#define G_SCHED __builtin_amdgcn_sched_barrier(0)
    f32x4 acc[2][2][4][2];
#pragma unroll
    for (int a = 0; a < 2; ++a)
#pragma unroll
        for (int b = 0; b < 2; ++b)
#pragma unroll
            for (int m = 0; m < 4; ++m)
#pragma unroll
                for (int n = 0; n < 2; ++n) acc[a][b][m][n] = (f32x4){0.f, 0.f, 0.f, 0.f};
    bf16x8 At[4][2], B0[2][2], B1[2][2];
    const char* cA = cur.A; const char* cB = cur.B;
    const size_t kstep = (size_t)(BK * 2);
    G_STAGE(G_SB(0, 0), cB, vB, 0); G_STAGE(G_SA(0, 0), cA, vA, 0); G_STAGE(G_SB(0, 1), cB, vB, 1); G_STAGE(G_SA(0, 1), cA, vA, 1);
    if (wr == 1) G_BAR;
    G_WAIT_V(4); G_BAR;
    G_STAGE(G_SB(1, 0), cB + kstep, vB, 0); G_STAGE(G_SA(1, 0), cA + kstep, vA, 0); G_STAGE(G_SB(1, 1), cB + kstep, vB, 1);
    G_WAIT_V(6); G_BAR;
    for (;;) {
        const bool has_next = P.unit(ui + 1, nxt);
        const char* nA = has_next ? nxt.A : cA; const char* nB = has_next ? nxt.B : cB;
        const int nt = cur.nt;
        for (int t = 0; t < nt; t += 2) {
            const bool last = (t == nt - 2);
            const char* a1 = cA + (size_t)(t + 1) * kstep;
            const char* a2 = last ? nA : cA + (size_t)(t + 2) * kstep; const char* b2 = last ? nB : cB + (size_t)(t + 2) * kstep;
            const char* a3 = a2 + kstep; const char* b3 = b2 + kstep;
            G_STAGE(G_SA(1, 1), a1, vA, 1);
            if (last && has_next) { G_SETV(nxt); }
            G_LDB(B0, 0, 0); G_SCHED; G_LDA(At, 0, 0);
            G_WAIT_L(8); G_BAR; G_WAIT_L(0); G_MMA(0, 0, At, B0); G_BAR; G_SCHED;
            G_LDB(B1, 0, 1); G_STAGE(G_SB(0, 0), b2, vB, 0);
            G_BAR; G_WAIT_L(0); G_MMA(0, 1, At, B1); G_BAR;
            G_LDA(At, 0, 1); G_STAGE(G_SA(0, 0), a2, vA, 0);
            G_BAR; G_WAIT_L(0); G_MMA(1, 0, At, B0); G_BAR; G_SCHED;
            G_STAGE(G_SB(0, 1), b2, vB, 1);
            G_WAIT_V(6); G_BAR; G_MMA(1, 1, At, B1); G_BAR;
            G_LDB(B0, 1, 0); G_SCHED; G_LDA(At, 1, 0); G_STAGE(G_SA(0, 1), a2, vA, 1);
            G_WAIT_L(8); G_BAR; G_WAIT_L(0); G_MMA(0, 0, At, B0); G_BAR; G_SCHED;
            G_LDB(B1, 1, 1); G_STAGE(G_SB(1, 0), b3, vB, 0);
            G_BAR; G_WAIT_L(0); G_MMA(0, 1, At, B1); G_BAR;
            G_LDA(At, 1, 1); G_STAGE(G_SA(1, 0), a3, vA, 0);
            G_BAR; G_WAIT_L(0); G_MMA(1, 0, At, B0); G_BAR; G_SCHED;
            G_STAGE(G_SB(1, 1), b3, vB, 1);
            G_WAIT_V(6); G_BAR; G_MMA(1, 1, At, B1); G_BAR;
        }
        { int tz_ = threadIdx.x; asm volatile("" : "+v"(tz_)); const int ln_ = tz_ & 63; P.epi(acc, cur, wr, wc, ln_ & 15, ln_ >> 4); }
        if (!has_next) break;
        if (!P.keep(cur))
#pragma unroll
        for (int a = 0; a < 2; ++a)
#pragma unroll
            for (int b = 0; b < 2; ++b)
#pragma unroll
                for (int m = 0; m < 4; ++m)
#pragma unroll
                    for (int n = 0; n < 2; ++n) acc[a][b][m][n] = (f32x4){0.f, 0.f, 0.f, 0.f};
        cur = nxt; cA = nA; cB = nB; ++ui;
    }
    G_WAIT_V(0);
    if (wr == 0) G_BAR;
    G_BAR;
#undef G_SETV
#undef G_SA
#undef G_SB
#undef G_STAGE
#undef G_LDA
#undef G_LDB
#undef G_MMA
#undef G_WAIT_V
#undef G_WAIT_L
#undef G_BAR
#undef G_SCHED
}

__device__ __forceinline__ void st_bf8(bf16_t* p, const f32x4 a, const f32x4 b) {
    u32x4 w; w.x = pk2(a[0], a[1]); w.y = pk2(a[2], a[3]); w.z = pk2(b[0], b[1]); w.w = pk2(b[2], b[3]);
    *(u32x4*)p = w;
}
__device__ __forceinline__ void ld_bf8(const bf16_t* p, f32x4& a, f32x4& b) {
    const u32x4 w = *(const u32x4*)p;
    a = (f32x4){lo_bf(w.x), hi_bf(w.x), lo_bf(w.y), hi_bf(w.y)}; b = (f32x4){lo_bf(w.z), hi_bf(w.z), lo_bf(w.w), hi_bf(w.w)};
}
__device__ __forceinline__ float sq8(const f32x4 a, const f32x4 b) { return ((a[0] * a[0] + a[1] * a[1]) + (a[2] * a[2] + a[3] * a[3])) + ((b[0] * b[0] + b[1] * b[1]) + (b[2] * b[2] + b[3] * b[3])); }

#define EPI_ROWS(ai, m) _Pragma("unroll") for (int ai = 0; ai < 2; ++ai) _Pragma("unroll") for (int m = 0; m < 4; ++m)
#define EPI_FENCE asm volatile("" ::: "memory")
#define EPI_SC(ai, m) __shfl((ai) ? r1_ : r0_, (m) * 16 + fr)

struct ProgIn {
    __device__ __forceinline__ bool keep(const GU&) const { return false; }
    StaticOrder S; const bf16_t* xb; const bf16_t* Wt; const float* ssq; unsigned char* wsb;
    const bf16_t* pb; const bf16_t* wple;
    __device__ __forceinline__ bool unit(int i, GU& u) const {
        Unit t;
        if (!S.next(i, t)) {
            const int rem = S.nwg % S.G, nfull = S.nwg / S.G, idle = rem == 0 ? S.G : S.G - rem, per = (256 + idle - 1) / idle;
            const int rk = rem == 0 ? S.c : S.c - rem, k = i - nfull;
            if (rk < 0 || k < 0 || k >= per) return false;
            const int pu = rk * per + k; if (pu >= 256) return false;
            u.pm = pu >> 2; u.pn = 64 + (pu & 3); u.sub = 0; u.aux = 0; u.nt = 4; u.idx = nullptr; u.lda = 512; u.ldb = 512; u.mapA = 0; u.mapB = 0;
            u.A = (const char*)pb + (size_t)(pu >> 2) * 256 * 512; u.B = (const char*)wple + (size_t)(pu & 3) * 256 * 512; return true;
        }
        u.pm = t.pm; u.pn = t.pn; u.sub = 0; u.aux = 0; u.nt = 16; u.idx = nullptr; u.lda = 2048; u.ldb = 2048;
        const char* w = (const char*)Wt + (size_t)t.pn * 256 * 2048;
        int g = 0; bool isvt = false;
        if (t.pn >= 20 && t.pn < 29) { g = (t.pn - 20) % 3; isvt = t.pn >= 26; }
        const int d = g == 0 ? 1 : (g == 1 ? 4 : 16);
        const int b = t.pm >> 3, tb = t.pm & 7;
        const int base = b * 2048 + (d == 1 ? 256 * tb : d == 4 ? 1024 * (tb & 1) + (tb >> 1) : 2 * tb);
        const char* x = (const char*)xb + (size_t)base * 2048;
        const int mapx = d == 1 ? 0 : d;
        if (!isvt) { u.A = x; u.mapA = mapx; u.B = w; u.mapB = 0; }
        else { u.A = w; u.mapA = 0; u.B = x; u.mapB = mapx; }
        return true;
    }
    __device__ __forceinline__ void epi(f32x4 (&acc)[2][2][4][2], const GU& u, int wr, int wc, int fr, int fq) const {
        const int pn = u.pn, pm = u.pm, rl0 = wr * 64 + fr, cl0 = wc * 32 + 8 * fq;
        if (pn >= 64) {
            EPI_ROWS(ai, m) { bf16_t* o = (bf16_t*)(wsb + WS_PP) + (size_t)(pm * 256 + ai * 128 + m * 16 + rl0) * 1024 + (pn - 64) * 256 + cl0;
#pragma unroll
                for (int bj = 0; bj < 2; ++bj) st_bf8(o + bj * 128, acc[ai][bj][m][0], acc[ai][bj][m][1]); }
            return;
        }
        if (pn >= 26 && pn < 29) {
            const int g = pn - 26, d = g == 0 ? 1 : (g == 1 ? 4 : 16), ln = fq * 16 + fr;
            const float rc = rstd_of(ssq, token_of_pos(d, pm * 256 + (ln >> 5) * 128 + wc * 32 + (ln & 31)));
            f32x4 s[2][2];
#pragma unroll
            for (int bj = 0; bj < 2; ++bj)
#pragma unroll
                for (int j = 0; j < 8; ++j) s[bj][j >> 2][j & 3] = __shfl(rc, bj * 32 + 8 * fq + j);
            EPI_ROWS(ai, m) { const int ch = ai * 128 + m * 16 + rl0; bf16_t* o = (bf16_t*)(wsb + WS_VT) + (size_t)(g * 256 + ch) * TC + pm * 256 + cl0;
#pragma unroll
                for (int bj = 0; bj < 2; ++bj) st_bf8(o + bj * 128, acc[ai][bj][m][0] * s[bj][0], acc[ai][bj][m][1] * s[bj][1]); }
            return;
        }
        int d = 1; if (pn >= 20 && pn < 26) { const int g = (pn - 20) % 3; d = g == 0 ? 1 : (g == 1 ? 4 : 16); }
        const float r0_ = rstd_of(ssq, token_of_pos(d, pm * 256 + fq * 16 + rl0)), r1_ = rstd_of(ssq, token_of_pos(d, pm * 256 + 128 + fq * 16 + rl0));
        if (pn < 20) {
            bf16_t* base = pn < 12 ? (bf16_t*)(wsb + WS_PDN) + pn * 256 : (bf16_t*)(wsb + WS_PSSM) + (pn - 12) * 256; const int ld = pn < 12 ? 3072 : 2048;
            EPI_ROWS(ai, m) { const int row = pm * 256 + ai * 128 + m * 16 + rl0; const float s = EPI_SC(ai, m); bf16_t* o = base + (size_t)row * ld + cl0;
#pragma unroll
                for (int bj = 0; bj < 2; ++bj) st_bf8(o + bj * 128, acc[ai][bj][m][0] * s, acc[ai][bj][m][1] * s); }
        } else if (pn < 26) {
            const int which = (pn - 20) / 3, g = (pn - 20) % 3; const float qs = which == 0 ? 0.125f : 1.f;
            bf16_t* base = (bf16_t*)(wsb + WS_QK) + (size_t)(which * 3 + g) * TC * 256;
            EPI_ROWS(ai, m) { const int p = pm * 256 + ai * 128 + m * 16 + rl0; const float s = EPI_SC(ai, m) * qs; bf16_t* o = base + (size_t)p * 256 + cl0;
#pragma unroll
                for (int bj = 0; bj < 2; ++bj) st_bf8(o + bj * 128, acc[ai][bj][m][0] * s, acc[ai][bj][m][1] * s); }
        } else if (pn < 41) {
            bf16_t* base = (bf16_t*)(wsb + WS_GATES) + (pn - 29) * 256;
            EPI_ROWS(ai, m) { const int row = pm * 256 + ai * 128 + m * 16 + rl0; const float s = EPI_SC(ai, m); bf16_t* o = base + (size_t)row * 3072 + cl0;
#pragma unroll
                for (int bj = 0; bj < 2; ++bj) { f32x4 a = acc[ai][bj][m][0] * s, b = acc[ai][bj][m][1] * s;
#pragma unroll
                    for (int j = 0; j < 4; ++j) { a[j] = sigmoidf_(a[j]); b[j] = sigmoidf_(b[j]); }
                    st_bf8(o + bj * 128, a, b); } }
        } else {
            EPI_ROWS(ai, m) { const int row = pm * 256 + ai * 128 + m * 16 + rl0; const float s = EPI_SC(ai, m);
                if (wc == 0) { float* o = (float*)(wsb + WS_SMALL) + (size_t)row * 32 + 8 * fq; *(f32x4*)o = acc[ai][0][m][0] * s; *(f32x4*)(o + 4) = acc[ai][0][m][1] * s; } }
        }
    }
};

struct ProgMerge {
    StaticOrder S; const bf16_t *wdn, *wssm, *watt; unsigned char* wsb;
    __device__ __forceinline__ bool keep(const GU& u) const { return u.sub < 2; }
    __device__ __forceinline__ bool unit(int i, GU& u) const {
        Unit t; if (!S.next(i / 3, t)) return false;
        const int sub = i % 3;
        u.pm = t.pm; u.pn = t.pn; u.sub = sub; u.aux = 0; u.idx = nullptr; u.mapA = 0; u.mapB = 0;
        if (sub < 2) { u.lda = 1536; u.ldb = 1536; u.nt = 12; u.A = (const char*)(wsb + (sub == 0 ? WS_YDN : WS_YSSM)) + (size_t)t.pm * 256 * 1536; u.B = (const char*)(sub == 0 ? wdn : wssm) + (size_t)t.pn * 256 * 1536; }
        else { u.lda = 512; u.ldb = 512; u.nt = 4; u.A = (const char*)(wsb + WS_YATT) + (size_t)t.pm * 256 * 512; u.B = (const char*)watt + (size_t)t.pn * 256 * 512; }
        return true;
    }
    __device__ __forceinline__ void epi(f32x4 (&acc)[2][2][4][2], const GU& u, int wr, int wc, int fr, int fq) const {
        const int rl0 = wr * 64 + fr, cl0 = wc * 32 + 8 * fq, sub = u.sub;
        const bf16_t* gp0 = (const bf16_t*)(wsb + WS_GATES) + (size_t)(u.pm * 256 + rl0) * 3072 + u.pn * 256 + cl0 + sub * 1024;
#pragma unroll
        for (int ai = 0; ai < 2; ++ai) {
            u32x4 gw[4][2], hw[4][2];
            if (sub < 2) {
#pragma unroll
                for (int m = 0; m < 4; ++m)
#pragma unroll
                    for (int bj = 0; bj < 2; ++bj) { const bf16_t* gp = gp0 + (size_t)(ai * 128 + m * 16) * 3072 + bj * 128; gw[m][bj] = *(const u32x4*)gp; hw[m][bj] = *(const u32x4*)(gp + 1024); }
            } else {
#pragma unroll
                for (int m = 0; m < 4; ++m)
#pragma unroll
                    for (int bj = 0; bj < 2; ++bj) { const bf16_t* gp = gp0 + (size_t)(ai * 128 + m * 16) * 3072 + bj * 128; gw[m][bj] = *(const u32x4*)gp; hw[m][bj] = gw[m][bj]; }
            }
#pragma unroll
            for (int m = 0; m < 4; ++m)
#pragma unroll
                for (int bj = 0; bj < 2; ++bj) { const int row = u.pm * 256 + ai * 128 + m * 16 + rl0, col = u.pn * 256 + bj * 128 + cl0;
                    f32x4 g0 = (f32x4){lo_bf(gw[m][bj].x), hi_bf(gw[m][bj].x), lo_bf(gw[m][bj].y), hi_bf(gw[m][bj].y)}, g1 = (f32x4){lo_bf(gw[m][bj].z), hi_bf(gw[m][bj].z), lo_bf(gw[m][bj].w), hi_bf(gw[m][bj].w)};
                    if ((DBG_ABL >> sub) & 1) { acc[ai][bj][m][0] = (f32x4){0.f, 0.f, 0.f, 0.f}; acc[ai][bj][m][1] = acc[ai][bj][m][0]; }
#pragma unroll
                    for (int j = 0; j < 4; ++j) { g0[j] = fmaxf(g0[j], 1e-8f); g1[j] = fmaxf(g1[j], 1e-8f); }
                    if (sub < 2) { const f32x4 h0 = (f32x4){lo_bf(hw[m][bj].x), hi_bf(hw[m][bj].x), lo_bf(hw[m][bj].y), hi_bf(hw[m][bj].y)}, h1 = (f32x4){lo_bf(hw[m][bj].z), hi_bf(hw[m][bj].z), lo_bf(hw[m][bj].w), hi_bf(hw[m][bj].w)};
#pragma unroll
                        for (int j = 0; j < 4; ++j) { acc[ai][bj][m][0][j] *= g0[j] * __builtin_amdgcn_rcpf(fmaxf(h0[j], 1e-8f)); acc[ai][bj][m][1][j] *= g1[j] * __builtin_amdgcn_rcpf(fmaxf(h1[j], 1e-8f)); } }
                    else st_bf8((bf16_t*)(wsb + WS_MERGED) + (size_t)row * 1024 + col, acc[ai][bj][m][0] * g0, acc[ai][bj][m][1] * g1); }
            EPI_FENCE;
        }
    }
};

struct ProgResid {
    __device__ __forceinline__ bool keep(const GU&) const { return false; }
    StaticOrder S; const bf16_t* A; int lda, nt; const bf16_t* Wt; int ldb; const float* xin_f; const bf16_t* xin_b; bf16_t* xb; float* ssq; float sc;
    __device__ __forceinline__ bool unit(int i, GU& u) const {
        Unit t; if (!S.next(i, t)) return false;
        u.pm = t.pm; u.pn = t.pn; u.sub = 0; u.aux = 0; u.idx = nullptr; u.mapA = 0; u.mapB = 0; u.lda = lda; u.ldb = ldb; u.nt = nt;
        u.A = (const char*)A + (size_t)t.pm * 256 * lda; u.B = (const char*)Wt + (size_t)t.pn * 256 * ldb; return true;
    }
    __device__ __forceinline__ void epi(f32x4 (&acc)[2][2][4][2], const GU& u, int wr, int wc, int fr, int fq) const {
        const int rl0 = wr * 64 + fr, cl0 = wc * 32 + 8 * fq;
#pragma unroll
        for (int ai = 0; ai < 2; ++ai) {
            f32x4 xv[4][2][2];
            if (xin_f) {
#pragma unroll
                for (int m = 0; m < 4; ++m)
#pragma unroll
                    for (int bj = 0; bj < 2; ++bj) { const size_t o = (size_t)(u.pm * 256 + ai * 128 + m * 16 + rl0) * 1024 + u.pn * 256 + bj * 128 + cl0; xv[m][bj][0] = *(const f32x4*)(xin_f + o); xv[m][bj][1] = *(const f32x4*)(xin_f + o + 4); }
            } else {
                u32x4 xw[4][2];
#pragma unroll
                for (int m = 0; m < 4; ++m)
#pragma unroll
                    for (int bj = 0; bj < 2; ++bj) xw[m][bj] = *(const u32x4*)(xin_b + (size_t)(u.pm * 256 + ai * 128 + m * 16 + rl0) * 1024 + u.pn * 256 + bj * 128 + cl0);
#pragma unroll
                for (int m = 0; m < 4; ++m)
#pragma unroll
                    for (int bj = 0; bj < 2; ++bj) { const u32x4 w = xw[m][bj]; xv[m][bj][0] = (f32x4){lo_bf(w.x), hi_bf(w.x), lo_bf(w.y), hi_bf(w.y)}; xv[m][bj][1] = (f32x4){lo_bf(w.z), hi_bf(w.z), lo_bf(w.w), hi_bf(w.w)}; }
            }
#pragma unroll
            for (int m = 0; m < 4; ++m) { const int row = u.pm * 256 + ai * 128 + m * 16 + rl0; float ss = 0.f;
#pragma unroll
                for (int bj = 0; bj < 2; ++bj) { const size_t o = (size_t)row * 1024 + u.pn * 256 + bj * 128 + cl0;
                    const f32x4 v0 = acc[ai][bj][m][0] * sc + xv[m][bj][0], v1 = acc[ai][bj][m][1] * sc + xv[m][bj][1];
                    st_bf8(xb + o, v0, v1); ss += sq8(v0, v1); }
                ss += __shfl_xor(ss, 16); ss += __shfl_xor(ss, 32);
                if (fq == 0) ssq[(size_t)row * 16 + u.pn * 4 + wc] = ss; }
            EPI_FENCE;
        }
    }
};

struct ProgFfnGu {
    __device__ __forceinline__ bool keep(const GU&) const { return false; }
    StaticOrder S; const bf16_t* xb; const bf16_t* Wt; const float* ssq; bf16_t* act;
    __device__ __forceinline__ bool unit(int i, GU& u) const {
        Unit t; if (!S.next(i, t)) return false;
        u.pm = t.pm; u.pn = t.pn; u.sub = 0; u.aux = 0; u.idx = nullptr; u.mapA = 0; u.mapB = 0; u.lda = 2048; u.ldb = 2048; u.nt = 16;
        u.A = (const char*)xb + (size_t)t.pm * 256 * 2048; u.B = (const char*)Wt + (size_t)t.pn * 256 * 2048; return true;
    }
    __device__ __forceinline__ void epi(f32x4 (&acc)[2][2][4][2], const GU& u, int wr, int wc, int fr, int fq) const {
        const int rl0 = wr * 64 + fr, cl0 = wc * 32 + 8 * fq;
        const float r0_ = rstd_of(ssq, u.pm * 256 + fq * 16 + rl0), r1_ = rstd_of(ssq, u.pm * 256 + 128 + fq * 16 + rl0);
        EPI_ROWS(ai, m) { const int row = u.pm * 256 + ai * 128 + m * 16 + rl0; const float s = EPI_SC(ai, m);
            f32x4 o[2];
#pragma unroll
            for (int n = 0; n < 2; ++n)
#pragma unroll
                for (int j = 0; j < 4; ++j) { const float g = acc[ai][0][m][n][j] * s, up = acc[ai][1][m][n][j] * s; o[n][j] = q8(siluf_(g) * up); }
            st_bf8(act + (size_t)row * FFN + u.pn * 128 + cl0, o[0], o[1]); }
    }
};

struct ProgPle {
    __device__ __forceinline__ bool keep(const GU&) const { return false; }
    StaticOrder S; const bf16_t *xb, *wpg, *pp; const float* ssq; bf16_t* xbout; float* ssqout;
    __device__ __forceinline__ bool unit(int i, GU& u) const {
        Unit t; if (!S.next(i, t)) return false;
        u.pm = t.pm; u.pn = t.pn; u.sub = 0; u.aux = 0; u.idx = nullptr; u.mapA = 0; u.mapB = 0; u.lda = 2048; u.ldb = 2048; u.nt = 16;
        u.A = (const char*)xb + (size_t)t.pm * 256 * 2048; u.B = (const char*)wpg + (size_t)t.pn * 256 * 2048; return true;
    }
    __device__ __forceinline__ void epi(f32x4 (&acc)[2][2][4][2], const GU& u, int wr, int wc, int fr, int fq) const {
        const int rl0 = wr * 64 + fr, cl0 = wc * 32 + 8 * fq; const float ps = (DBG_ABL & 32) ? 0.f : 1.f;
        const float r0_ = rstd_of(ssq, u.pm * 256 + fq * 16 + rl0), r1_ = rstd_of(ssq, u.pm * 256 + 128 + fq * 16 + rl0);
#pragma unroll
        for (int ai = 0; ai < 2; ++ai)
#pragma unroll
            for (int mh = 0; mh < 2; ++mh) {
                u32x4 xw[2][2], gw[2][2];
#pragma unroll
                for (int m2 = 0; m2 < 2; ++m2)
#pragma unroll
                    for (int bj = 0; bj < 2; ++bj) { const size_t o = (size_t)(u.pm * 256 + ai * 128 + (2 * mh + m2) * 16 + rl0) * 1024 + u.pn * 256 + bj * 128 + cl0;
                        xw[m2][bj] = *(const u32x4*)(xb + o); gw[m2][bj] = *(const u32x4*)(pp + o); }
#pragma unroll
                for (int m2 = 0; m2 < 2; ++m2) { const int m = 2 * mh + m2, row = u.pm * 256 + ai * 128 + m * 16 + rl0; const float sc = EPI_SC(ai, m); float ss = 0.f;
#pragma unroll
                    for (int bj = 0; bj < 2; ++bj) { const size_t o = (size_t)row * 1024 + u.pn * 256 + bj * 128 + cl0; const u32x4 w = gw[m2][bj], xq = xw[m2][bj];
                        const f32x4 p0 = (f32x4){lo_bf(w.x), hi_bf(w.x), lo_bf(w.y), hi_bf(w.y)}, p1 = (f32x4){lo_bf(w.z), hi_bf(w.z), lo_bf(w.w), hi_bf(w.w)};
                        const f32x4 x0 = (f32x4){lo_bf(xq.x), hi_bf(xq.x), lo_bf(xq.y), hi_bf(xq.y)}, x1 = (f32x4){lo_bf(xq.z), hi_bf(xq.z), lo_bf(xq.w), hi_bf(xq.w)};
                        f32x4 g0 = acc[ai][bj][m][0] * sc, g1 = acc[ai][bj][m][1] * sc;
#pragma unroll
                        for (int j = 0; j < 4; ++j) { g0[j] = sigmoidf_(g0[j]); g1[j] = sigmoidf_(g1[j]); }
                        const f32x4 v0 = x0 + p0 * ps * g0, v1 = x1 + p1 * ps * g1;
                        st_bf8(xbout + o, v0, v1); ss += sq8(v0, v1); }
                    ss += __shfl_xor(ss, 16); ss += __shfl_xor(ss, 32);
                    if (fq == 0) ssqout[(size_t)row * 16 + u.pn * 4 + wc] = ss; }
                EPI_FENCE;
            }
    }
};

struct MoeOrder {
    int tl[NE]; int nN, total, G, c;
    __device__ __forceinline__ void init(const unsigned* cnt, int nN_, int G_, int c_) {
        nN = nN_; G = G_; c = c_; int tt = 0;
#pragma unroll
        for (int e = 0; e < NE; ++e) { tl[e] = (int)((__builtin_amdgcn_readfirstlane(cnt[e]) + 255u) >> 8); tt += tl[e]; }
        total = tt * nN;
    }
    __device__ __forceinline__ bool next(int i, int& e, int& pml, int& pn, int& slot0) const {
        const long L = (long)i * G + c; if (L >= total) return false;
        int wgid = (int)L; { const int q = total / NXCD, r = total % NXCD, xcd = wgid % NXCD, off = wgid / NXCD; wgid = (xcd < r ? xcd * (q + 1) : r * (q + 1) + (xcd - r) * q) + off; }
        int ee = 0, ubase = 0, tbase = 0, nMe = tl[0], uacc = 0, tacc = 0;
#pragma unroll
        for (int k = 0; k < NE; ++k) { if (wgid >= uacc) { ee = k; ubase = uacc; tbase = tacc; nMe = tl[k]; } uacc += tl[k] * nN; tacc += tl[k]; }
        const int li = wgid - ubase, nig = WGM * nN, gid = li / nig, fm = gid * WGM, gsz = (nMe - fm) < WGM ? (nMe - fm) : WGM;
        pml = fm + ((li % nig) % gsz); pn = (li % nig) / gsz; e = ee; slot0 = (tbase + pml) * 256; return true;
    }
};
struct ProgMoeGu {
    __device__ __forceinline__ bool keep(const GU&) const { return false; }
    MoeOrder S; const bf16_t* xb; const bf16_t* Wt; const float* ssq; const int* idx; bf16_t* act;
    __device__ __forceinline__ bool unit(int i, GU& u) const {
        int e, pml, pn, slot0; if (!S.next(i, e, pml, pn, slot0)) return false;
        u.pm = slot0; u.pn = pn; u.sub = 0; u.aux = e; u.idx = idx + slot0; u.mapA = 99; u.mapB = 0; u.lda = 2048; u.ldb = 2048; u.nt = 16;
        u.A = (const char*)xb; u.B = (const char*)Wt + ((size_t)e * 7168 + (size_t)pn * 256) * 2048; return true;
    }
    __device__ __forceinline__ void epi(f32x4 (&acc)[2][2][4][2], const GU& u, int wr, int wc, int fr, int fq) const {
        const int rl0 = wr * 64 + fr, cl0 = wc * 32 + 8 * fq;
        const float r0_ = rstd_of(ssq, idx[u.pm + fq * 16 + rl0]), r1_ = rstd_of(ssq, idx[u.pm + 128 + fq * 16 + rl0]);
        EPI_ROWS(ai, m) { const int slot = u.pm + ai * 128 + m * 16 + rl0; const float s = EPI_SC(ai, m);
            f32x4 o[2];
#pragma unroll
            for (int n = 0; n < 2; ++n)
#pragma unroll
                for (int j = 0; j < 4; ++j) { const float g = acc[ai][0][m][n][j] * s, up = acc[ai][1][m][n][j] * s; o[n][j] = q8(siluf_(g) * up); }
            st_bf8(act + (size_t)slot * EXD + u.pn * 128 + cl0, o[0], o[1]); }
    }
};
struct MoeDownPlan { int ntiles, main, tail; };
__device__ __forceinline__ MoeDownPlan moe_down_plan(const unsigned* cnt, int G) {
    MoeDownPlan pl; int nt = 0;
#pragma unroll
    for (int e = 0; e < NE; ++e) nt += (int)((__builtin_amdgcn_readfirstlane(cnt[e]) + 255u) >> 8);
    const int U = 4 * nt; int tail = U % G; if (U < G || tail > TAILMAX) tail = 0;
    pl.ntiles = nt; pl.tail = tail; pl.main = U - tail; return pl;
}
struct ProgMoeDown {
    __device__ __forceinline__ bool keep(const GU&) const { return false; }
    int tl[NE]; MoeDownPlan pl; int G, c; const bf16_t* act; const bf16_t* Wt; bf16_t* ypair; float* partk;
    __device__ __forceinline__ void init(const unsigned* cnt, int G_, int c_) { G = G_; c = c_; pl = moe_down_plan(cnt, G_);
#pragma unroll
        for (int e = 0; e < NE; ++e) tl[e] = (int)((__builtin_amdgcn_readfirstlane(cnt[e]) + 255u) >> 8); }
    __device__ __forceinline__ bool unit(int i, GU& u) const {
        const long L = (long)i * G + c; int w, kp = -1;
        if (L < pl.main) { w = (int)L; const int q = pl.main / NXCD, r = pl.main % NXCD, xcd = w % NXCD, off = w / NXCD; w = (xcd < r ? xcd * (q + 1) : r * (q + 1) + (xcd - r) * q) + off; }
        else { const long s2 = L - pl.main; if (s2 >= (long)pl.tail * KSPL) return false; w = pl.main + (int)(s2 / KSPL); kp = (int)(s2 % KSPL); }
        const int tile = w >> 2, pn = w & 3; int e = 0, tacc = 0;
#pragma unroll
        for (int k = 0; k < NE; ++k) { if (tile >= tacc) e = k; tacc += tl[k]; }
        const int slot0 = tile * 256;
        u.pm = slot0; u.pn = pn; u.aux = e; u.idx = nullptr; u.mapA = 0; u.mapB = 0; u.lda = 7168; u.ldb = 7168;
        u.A = (const char*)act + (size_t)slot0 * 7168; u.B = (const char*)Wt + ((size_t)e * 1024 + (size_t)pn * 256) * 7168;
        if (kp < 0) { u.sub = 0; u.nt = 56; } else { u.sub = 1 + kp; u.nt = 8; u.A += kp * 1024; u.B += kp * 1024; }
        return true;
    }
    __device__ __forceinline__ void epi(f32x4 (&acc)[2][2][4][2], const GU& u, int wr, int wc, int fr, int fq) const {
        const int rl0 = wr * 64 + fr, cl0 = wc * 32 + 8 * fq;
        if (u.sub == 0) {
            EPI_ROWS(ai, m) { const int slot = u.pm + ai * 128 + m * 16 + rl0;
#pragma unroll
                for (int bj = 0; bj < 2; ++bj) st_bf8(ypair + (size_t)slot * 1024 + u.pn * 256 + bj * 128 + cl0, acc[ai][bj][m][0], acc[ai][bj][m][1]); }
        } else {
            float* pk = partk + ((size_t)(u.sub - 1) * (TAILMAX / 4) * 256 + (u.pm - (pl.main >> 2) * 256)) * 1024 + u.pn * 256 + cl0;
            EPI_ROWS(ai, m) { float* o = pk + (size_t)(ai * 128 + m * 16 + rl0) * 1024;
#pragma unroll
                for (int bj = 0; bj < 2; ++bj) { *(f32x4*)(o + bj * 128) = acc[ai][bj][m][0]; *(f32x4*)(o + bj * 128 + 4) = acc[ai][bj][m][1]; } }
        }
    }
};

struct Params { const float* in[30]; float* out; unsigned char* ws; int s_lo, s_hi; unsigned tmask; int pad; };
enum { I_X = 0, I_P, I_MIXN, I_WIN, I_DNCONV, I_DNALOG, I_DNDTB, I_DNNORM, I_SSCONV, I_SSCONVB, I_SSALOG, I_SSDTB, I_SSD, I_SSNORM, I_WBRDN, I_WBRSSM, I_WBRATT, I_WOUT, I_FFNN,
       I_WFG, I_WFU, I_WFD, I_WROUTER, I_WMG, I_WMU, I_WMD, I_PLEN, I_WPLE, I_WPLEG, I_FINALN };

template <class Map>
__device__ __forceinline__ void tr_job(const Map& map, int K, int N, bf16_t* WT, const float* gain, LAS float* scr, int lane, int gw, int NGW, float qs = 0.f) {
    const int nblk = N / 32, nitems = (K / 64) * nblk;
    for (int item = gw; item < nitems; item += NGW) {
        const int kb = item / nblk, nb = item % nblk, k0 = 64 * kb, n0 = 32 * nb;
        int ld = 0; const float* src = map(n0 + (lane & 31), ld);
#pragma unroll
        for (int i = 0; i < 32; ++i) { const int kk = 2 * i + (lane >> 5); float v = 0.f; if (src) { v = src[(size_t)(k0 + kk) * ld]; if (gain) v *= gain[k0 + kk]; if (qs > 0.f) v = q8(v * qs) / qs; } scr[kk * 33 + (lane & 31)] = v; }
        asm volatile("s_waitcnt lgkmcnt(0)" ::: "memory");
        const int c = lane & 7;
#pragma unroll
        for (int j = 0; j < 4; ++j) { const int n = (lane >> 3) + 8 * j; const LAS float* s = scr + (8 * c) * 33 + n;
            u32x4 o; o.x = pk2(s[0 * 33], s[1 * 33]); o.y = pk2(s[2 * 33], s[3 * 33]); o.z = pk2(s[4 * 33], s[5 * 33]); o.w = pk2(s[6 * 33], s[7 * 33]);
            *(u32x4*)(WT + (size_t)(n0 + n) * K + k0 + 8 * c) = o; }
        asm volatile("s_waitcnt lgkmcnt(0)" ::: "memory");
    }
}
struct MapPlain { const float* W; int ld; __device__ __forceinline__ const float* operator()(int n, int& l) const { l = ld; return W + n; } };
struct MapIn { const float* W; __device__ __forceinline__ const float* operator()(int n, int& l) const { l = INW; const int tile = n >> 8, r = n & 255; int col;
        if (tile < 9) col = n; else if (tile < 12) col = C_DNZ + (n - 2304); else if (tile < 17) col = C_XBC + (n - 3072); else if (tile < 20) col = C_SSZ + (n - 4352);
        else if (tile < 29) col = C_ATT + (n - 5120); else if (tile < 41) col = C_GATE + (n - 7424);
        else { if (r < 6) col = C_DNA + r; else if (r < 12) col = C_DNB + (r - 6); else if (r < 24) col = C_SSDT + (r - 12); else return nullptr; }
        return W + col; } };
struct MapGu { const float* Wg; const float* Wu; int ld; __device__ __forceinline__ const float* operator()(int n, int& l) const { l = ld; const int tile = n >> 8, r = n & 255; return r < 128 ? Wg + tile * 128 + r : Wu + tile * 128 + (r - 128); } };

__device__ __forceinline__ void phase_convert(const Params& p, LAS unsigned char* lds) {
    const int tid_ = htid(), lane = tid_ & 63, wave = tid_ >> 6, G = gridDim.x;
    const int gw = blockIdx.x * 8 + wave, NGW = G * 8;
    LAS float* scr = (LAS float*)(lds + wave * 16384);
    unsigned char* ws = p.ws;
    for (int l = 0; l < DEPTH; ++l) {
        tr_job(MapIn{p.in[I_WIN] + (size_t)l * D * INW}, D, INP, (bf16_t*)(ws + WS_WIN) + (size_t)l * INP * D, p.in[I_MIXN] + l * D, scr, lane, gw, NGW);
        tr_job(MapPlain{p.in[I_WBRDN] + (size_t)l * 768 * D, D}, 768, D, (bf16_t*)(ws + WS_WDN) + (size_t)l * D * 768, nullptr, scr, lane, gw, NGW);
        tr_job(MapPlain{p.in[I_WBRSSM] + (size_t)l * 768 * D, D}, 768, D, (bf16_t*)(ws + WS_WSSM) + (size_t)l * D * 768, nullptr, scr, lane, gw, NGW);
        tr_job(MapPlain{p.in[I_WBRATT] + (size_t)l * 256 * D, D}, 256, D, (bf16_t*)(ws + WS_WATT) + (size_t)l * D * 256, nullptr, scr, lane, gw, NGW);
        tr_job(MapPlain{p.in[I_WOUT] + (size_t)l * D * D, D}, D, D, (bf16_t*)(ws + WS_WOUT) + (size_t)l * D * D, nullptr, scr, lane, gw, NGW);
        tr_job(MapPlain{p.in[I_WPLEG] + (size_t)l * D * D, D}, D, D, (bf16_t*)(ws + WS_WPG) + (size_t)l * D * D, p.in[I_PLEN] + l * D, scr, lane, gw, NGW);
        tr_job(MapPlain{p.in[I_WPLE] + (size_t)l * PLE * D, D}, PLE, D, (bf16_t*)(ws + WS_WPLE) + (size_t)l * D * PLE, nullptr, scr, lane, gw, NGW);
    }
    tr_job(MapGu{p.in[I_WFG], p.in[I_WFU], FFN}, D, 2 * FFN, (bf16_t*)(ws + WS_WFGU), p.in[I_FFNN], scr, lane, gw, NGW, 16.f);
    tr_job(MapPlain{p.in[I_WFD], D}, FFN, D, (bf16_t*)(ws + WS_WFD), nullptr, scr, lane, gw, NGW, 16.f);
    for (int e = 0; e < NE; ++e) {
        tr_job(MapGu{p.in[I_WMG] + (size_t)e * D * EXD, p.in[I_WMU] + (size_t)e * D * EXD, EXD}, D, 2 * EXD, (bf16_t*)(ws + WS_WMGU) + (size_t)e * 2 * EXD * D, p.in[I_FFNN] + D, scr, lane, gw, NGW, 16.f);
        tr_job(MapPlain{p.in[I_WMD] + (size_t)e * EXD * D, D}, EXD, D, (bf16_t*)(ws + WS_WMD) + (size_t)e * D * EXD, nullptr, scr, lane, gw, NGW, 16.f);
    }
    float* wr = (float*)(ws + WS_WR);
    for (int i = blockIdx.x * 512 + tid_; i < D * NE; i += G * 512) wr[i] = p.in[I_WROUTER][i] * p.in[I_FFNN][D + (i >> 3)];
}

__device__ __forceinline__ void phase_chunk_in(const Params& p, int chunk) {
    const int tid_ = htid(), lane = tid_ & 63, gw = blockIdx.x * 8 + (tid_ >> 6), NGW = gridDim.x * 8;
    const float* x = p.in[I_X] + (size_t)chunk * TC * D;
    bf16_t* xb = (bf16_t*)(p.ws + WS_XB); float* ssq = (float*)(p.ws + WS_SSQ);
    for (int r0 = gw; r0 < TC; r0 += 2 * NGW) {
        f32x4 v[2][4];
#pragma unroll
        for (int u = 0; u < 2; ++u) { const int r = r0 + u * NGW < TC ? r0 + u * NGW : r0; const f32x4* xr = (const f32x4*)(x + (size_t)r * D) + lane;
#pragma unroll
            for (int j = 0; j < 4; ++j) v[u][j] = xr[64 * j]; }
#pragma unroll
        for (int u = 0; u < 2; ++u) { const int r = r0 + u * NGW; if (r >= TC) break; float s = 0.f; u32x2* o = (u32x2*)(xb + (size_t)r * D) + lane;
#pragma unroll
            for (int j = 0; j < 4; ++j) { const f32x4 t = v[u][j]; s += (t.x * t.x + t.y * t.y) + (t.z * t.z + t.w * t.w); u32x2 w; w.x = pk2(t.x, t.y); w.y = pk2(t.z, t.w); o[64 * j] = w; }
            s = wave_sum(s);
            if (lane < 16) ssq[(size_t)r * 16 + lane] = lane == 0 ? s : 0.f; }
    }
    bf16_t* pb = (bf16_t*)(p.ws + WS_PB);
    for (int r0 = gw; r0 < 2 * TC; r0 += 4 * NGW) {
        f32x4 v[4];
#pragma unroll
        for (int u = 0; u < 4; ++u) { const int r = r0 + u * NGW < 2 * TC ? r0 + u * NGW : r0; const int l = r / TC, rr = r % TC;
            v[u] = *((const f32x4*)(p.in[I_P] + ((size_t)l * BATCH * SEQ + (size_t)chunk * TC + rr) * PLE) + lane); }
#pragma unroll
        for (int u = 0; u < 4; ++u) { const int r = r0 + u * NGW; if (r >= 2 * TC) break; const int l = r / TC, rr = r % TC;
            u32x2 w; w.x = pk2(v[u].x, v[u].y); w.y = pk2(v[u].z, v[u].w); *((u32x2*)(pb + ((size_t)l * TC + rr) * PLE) + lane) = w; }
    }
}
__device__ __forceinline__ void phase_final(const Params& p, int chunk) {
    const int tid_ = htid(), lane = tid_ & 63, gw = blockIdx.x * 8 + (tid_ >> 6), NGW = gridDim.x * 8;
    float* out = p.out + (size_t)chunk * TC * D; const bf16_t* xs = (const bf16_t*)(p.ws + WS_XB2); const float* g = p.in[I_FINALN];
    for (int r0 = gw; r0 < TC; r0 += 2 * NGW) {
        u32x4 q[2][2];
#pragma unroll
        for (int u = 0; u < 2; ++u) { const int r = r0 + u * NGW < TC ? r0 + u * NGW : r0; const u32x4* xr = (const u32x4*)(xs + (size_t)r * D) + lane; q[u][0] = xr[0]; q[u][1] = xr[64]; }
#pragma unroll
        for (int u = 0; u < 2; ++u) { const int r = r0 + u * NGW; if (r >= TC) break; float s = 0.f; f32x4 v[4];
#pragma unroll
            for (int j = 0; j < 2; ++j) { const u32x4 w = q[u][j]; v[2 * j] = (f32x4){lo_bf(w.x), hi_bf(w.x), lo_bf(w.y), hi_bf(w.y)}; v[2 * j + 1] = (f32x4){lo_bf(w.z), hi_bf(w.z), lo_bf(w.w), hi_bf(w.w)};
                s += sq8(v[2 * j], v[2 * j + 1]); }
            const float rs = rsqrtf(wave_sum(s) * (1.f / D) + EPS);
#pragma unroll
            for (int j = 0; j < 2; ++j) { const int c = 8 * (lane + 64 * j); float* o = out + (size_t)r * D + c;
                *(f32x4*)o = v[2 * j] * rs * *(const f32x4*)(g + c); *(f32x4*)(o + 4) = v[2 * j + 1] * rs * *(const f32x4*)(g + c + 4); } }
    }
}
__device__ __forceinline__ void phase_router(const Params& p, LAS unsigned char* lds, int chunk) {
    const int tid_ = htid(), lane = tid_ & 63, gw = blockIdx.x * 8 + (tid_ >> 6), NGW = gridDim.x * 8;
    const bf16_t* x = (const bf16_t*)(p.ws + WS_XB); const float* wr = (const float*)(p.ws + WS_WR);
    int* rt = (int*)(p.ws + WS_ROUTE); unsigned* cnt = (unsigned*)(p.ws + WS_CTL) + CW_CNT + chunk * 64;
    LAS unsigned* lcnt = (LAS unsigned*)lds;
    f32x4 w[16][2];
#pragma unroll
    for (int j = 0; j < 2; ++j)
#pragma unroll
        for (int q = 0; q < 8; ++q) { const int k = 8 * (lane + 64 * j) + q; w[8 * j + q][0] = *(const f32x4*)(wr + k * 8); w[8 * j + q][1] = *(const f32x4*)(wr + k * 8 + 4); }
    const int nouter = (TC + 8 * NGW - 1) / (8 * NGW);
    for (int ob = 0; ob < nouter; ++ob) {
        if (tid_ < 16) lcnt[tid_] = 0u;
        __syncthreads();
        int pe[8]; unsigned pr[8];
#pragma unroll
        for (int jr = 0; jr < 8; ++jr) { const int r = gw + (ob * 8 + jr) * NGW; pe[jr] = 0; pr[jr] = 0u;
            if (r < TC) {
                const u32x4* xr = (const u32x4*)(x + (size_t)r * D) + lane; float s = 0.f; float lg[NE];
#pragma unroll
                for (int e = 0; e < NE; ++e) lg[e] = 0.f;
#pragma unroll
                for (int j = 0; j < 2; ++j) { const u32x4 xw = xr[64 * j]; const float v[8] = {lo_bf(xw.x), hi_bf(xw.x), lo_bf(xw.y), hi_bf(xw.y), lo_bf(xw.z), hi_bf(xw.z), lo_bf(xw.w), hi_bf(xw.w)};
#pragma unroll
                    for (int q = 0; q < 8; ++q) { s += v[q] * v[q]; const f32x4 w0 = w[8 * j + q][0], w1 = w[8 * j + q][1];
                        lg[0] += v[q] * w0.x; lg[1] += v[q] * w0.y; lg[2] += v[q] * w0.z; lg[3] += v[q] * w0.w; lg[4] += v[q] * w1.x; lg[5] += v[q] * w1.y; lg[6] += v[q] * w1.z; lg[7] += v[q] * w1.w; } }
                const float rs = rsqrtf(wave_sum(s) * (1.f / D) + EPS);
#pragma unroll
                for (int e = 0; e < NE; ++e) lg[e] = wave_sum(lg[e]) * rs;
                int i0 = 0; float l0 = lg[0];
#pragma unroll
                for (int e = 1; e < NE; ++e) if (lg[e] > l0) { l0 = lg[e]; i0 = e; }
                int i1 = -1; float l1 = -3.0e38f;
#pragma unroll
                for (int e = 0; e < NE; ++e) if (e != i0 && lg[e] > l1) { l1 = lg[e]; i1 = e; }
                if (lane < 2) { const int e = lane == 0 ? i0 : i1; const float w0 = 1.f / (1.f + expf(l1 - l0));
                    pe[jr] = e; pr[jr] = __hip_atomic_fetch_add(lcnt + e, 1u, __ATOMIC_RELAXED, __HIP_MEMORY_SCOPE_WORKGROUP);
                    rt[RT_TOPE + 2 * r + lane] = e; ((float*)rt)[RT_TOPW + 2 * r + lane] = lane == 0 ? w0 : 1.f - w0; }
            } }
        __syncthreads();
        if (tid_ < 8) lcnt[8 + tid_] = atomicAdd(cnt + tid_, lcnt[tid_]);
        __syncthreads();
#pragma unroll
        for (int jr = 0; jr < 8; ++jr) { const int r = gw + (ob * 8 + jr) * NGW; if (r < TC && lane < 2) rt[RT_TOPP + 2 * r + lane] = (int)(lcnt[8 + pe[jr]] + pr[jr]); }
        __syncthreads();
    }
}
__device__ __forceinline__ void phase_slots(const Params& p, int chunk) {
    int* rt = (int*)(p.ws + WS_ROUTE); const unsigned* cnt = (const unsigned*)(p.ws + WS_CTL) + CW_CNT + chunk * 64;
    int c[NE], off[NE + 1]; off[0] = 0;
#pragma unroll
    for (int e = 0; e < NE; ++e) { c[e] = (int)cnt[e]; off[e + 1] = off[e] + ((c[e] + 255) & ~255); }
    const int gt = blockIdx.x * 512 + htid(), NT = gridDim.x * 512;
    for (int i = gt; i < 2 * TC; i += NT) {
        const int e = rt[RT_TOPE + i], pos = rt[RT_TOPP + i]; int o = 0;
#pragma unroll
        for (int k = 0; k < NE; ++k) o = (e == k) ? off[k] : o;
        const int slot = o + pos; rt[RT_TOPS + i] = slot; rt[RT_IDX + slot] = i >> 1;
    }
    for (int s = gt; s < off[NE]; s += NT) {
        bool pad = false;
#pragma unroll
        for (int k = 0; k < NE; ++k) pad = pad || (s >= off[k] + c[k] && s < off[k + 1]);
        if (pad) rt[RT_IDX + s] = 0;
    }
}
__device__ __forceinline__ f32x4 moe_y4(const bf16_t* yp, const float* partk, int slot, int tail0, int col) {
    if (slot < tail0) { const u32x2 a = *(const u32x2*)(yp + (size_t)slot * D + col); return (f32x4){lo_bf(a.x), hi_bf(a.x), lo_bf(a.y), hi_bf(a.y)}; }
    f32x4 v = (f32x4){0.f, 0.f, 0.f, 0.f};
#pragma unroll
    for (int k = 0; k < KSPL; ++k) v += *(const f32x4*)(partk + ((size_t)k * (TAILMAX / 4) * 256 + (slot - tail0)) * 1024 + col);
    return v;
}
__device__ __forceinline__ void phase_combine(const Params& p, int chunk) {
    const int tid_ = htid(), lane = tid_ & 63, gw = blockIdx.x * 8 + (tid_ >> 6), NGW = gridDim.x * 8;
    const int* rt = (const int*)(p.ws + WS_ROUTE);
    const bf16_t* yp = (const bf16_t*)(p.ws + WS_YPAIR); const float* partk = (const float*)(p.ws + WS_PARTK); bf16_t* xb = (bf16_t*)(p.ws + WS_XB); float* ssq = (float*)(p.ws + WS_SSQ);
    const MoeDownPlan pl = moe_down_plan((const unsigned*)(p.ws + WS_CTL) + CW_CNT + chunk * 64, gridDim.x);
    const int tail0 = pl.tail > 0 ? (pl.main >> 2) * 256 : 0x7fffffff;
    for (int r0 = gw; r0 < TC; r0 += 4 * NGW) {
        int sl[4][2]; float wt[4][2];
#pragma unroll
        for (int u = 0; u < 4; ++u) { const int r = r0 + u * NGW < TC ? r0 + u * NGW : r0; sl[u][0] = rt[RT_TOPS + 2 * r]; sl[u][1] = rt[RT_TOPS + 2 * r + 1];
            wt[u][0] = (DBG_ABL & 16) ? 0.f : ((const float*)rt)[RT_TOPW + 2 * r]; wt[u][1] = (DBG_ABL & 16) ? 0.f : ((const float*)rt)[RT_TOPW + 2 * r + 1]; }
#pragma unroll
        for (int u = 0; u < 4; ++u) { const int r = r0 + u * NGW; if (r >= TC) break;
            u32x2* xr = (u32x2*)(xb + (size_t)r * D) + lane; float s = 0.f;
            f32x4 v[4], y0[4], y1[4]; u32x2 xq[4];
            if (sl[u][0] < tail0 && sl[u][1] < tail0) {
                const u32x2* a0 = (const u32x2*)(yp + (size_t)sl[u][0] * D) + lane; const u32x2* a1 = (const u32x2*)(yp + (size_t)sl[u][1] * D) + lane; u32x2 q0[4], q1[4];
#pragma unroll
                for (int j = 0; j < 4; ++j) { xq[j] = xr[64 * j]; q0[j] = a0[64 * j]; q1[j] = a1[64 * j]; }
#pragma unroll
                for (int j = 0; j < 4; ++j) { y0[j] = (f32x4){lo_bf(q0[j].x), hi_bf(q0[j].x), lo_bf(q0[j].y), hi_bf(q0[j].y)}; y1[j] = (f32x4){lo_bf(q1[j].x), hi_bf(q1[j].x), lo_bf(q1[j].y), hi_bf(q1[j].y)}; }
            } else {
#pragma unroll
                for (int j = 0; j < 4; ++j) { const int col = 4 * (lane + 64 * j); xq[j] = xr[64 * j]; y0[j] = moe_y4(yp, partk, sl[u][0], tail0, col); y1[j] = moe_y4(yp, partk, sl[u][1], tail0, col); }
            }
#pragma unroll
            for (int j = 0; j < 4; ++j) { v[j] = (f32x4){lo_bf(xq[j].x), hi_bf(xq[j].x), lo_bf(xq[j].y), hi_bf(xq[j].y)}; const f32x4 t = v[j] + wt[u][0] * y0[j] + wt[u][1] * y1[j];
                s += (t.x * t.x + t.y * t.y) + (t.z * t.z + t.w * t.w); u32x2 w; w.x = pk2(t.x, t.y); w.y = pk2(t.z, t.w); xr[64 * j] = w; }
            s = wave_sum(s);
            if (lane < 16) ssq[(size_t)r * 16 + lane] = lane == 0 ? s : 0.f; }
    }
}

#define LDS_BARRIER() do { asm volatile("s_waitcnt lgkmcnt(0)" ::: "memory"); __builtin_amdgcn_s_barrier(); asm volatile("" ::: "memory"); } while (0)
__device__ __forceinline__ f32x4 mfma16(const bf16x8 a, const bf16x8 b, const f32x4 c) { return __builtin_amdgcn_mfma_f32_16x16x32_bf16(a, b, c, 0, 0, 0); }
__device__ __forceinline__ void dn_prep(const Params& p, LAS unsigned char* lds, int layer, int b, int n, int h) {
    const int tid = htid(), lane = tid & 63, wave = tid >> 6;
    LAS unsigned char* QS = lds; LAS unsigned char* KS = lds + 17408; LAS unsigned char* VS = lds + 34816;
    LAS float* AM = (LAS float*)(lds + 52224);
    LAS float* SC = (LAS float*)(lds + 69632);
    const int t0 = n * 64;
    const bf16_t* proj = (const bf16_t*)(p.ws + WS_PDN) + (size_t)b * SEQ * 3072;
    unsigned char* item = p.ws + WS_DNS + (size_t)((b * 32 + n) * 6 + h) * DNS_ITEM;
    if (tid < 480) {
        const int cg = tid % 48, seg = tid / 48, part = cg >> 4, c8 = (cg & 15) * 8, col = part * 768 + h * 128 + c8;
        const float* cw = p.in[I_DNCONV] + (size_t)layer * 4 * 2304 + col;
        f32x4 w[4][2];
#pragma unroll
        for (int j = 0; j < 4; ++j) { w[j][0] = *(const f32x4*)(cw + j * 2304); w[j][1] = *(const f32x4*)(cw + j * 2304 + 4); }
        const int ts = seg * 7;
        f32x4 x[10][2];
#pragma unroll
        for (int i = 0; i < 10; ++i) { const int t = t0 + ts - 3 + i; x[i][0] = (f32x4){0.f, 0.f, 0.f, 0.f}; x[i][1] = x[i][0];
            if (t >= 0 && ts - 3 + i < 64) ld_bf8(proj + (size_t)t * 3072 + col, x[i][0], x[i][1]); }
        LAS unsigned char* dst = part == 0 ? QS : (part == 1 ? KS : VS);
#pragma unroll
        for (int i = 0; i < 7; ++i) { const int tk = ts + i;
            if (tk < 64) { f32x4 a0 = w[3][0] * x[i + 3][0] + w[2][0] * x[i + 2][0] + w[1][0] * x[i + 1][0] + w[0][0] * x[i][0];
                f32x4 a1 = w[3][1] * x[i + 3][1] + w[2][1] * x[i + 2][1] + w[1][1] * x[i + 1][1] + w[0][1] * x[i][1];
#pragma unroll
                for (int c = 0; c < 4; ++c) { a0[c] = siluf_(a0[c]); a1[c] = siluf_(a1[c]); }
                u32x4 pw; pw.x = pk2(a0[0], a0[1]); pw.y = pk2(a0[2], a0[3]); pw.z = pk2(a1[0], a1[1]); pw.w = pk2(a1[2], a1[3]);
                *(LAS u32x4*)(dst + tk * 272 + c8 * 2) = pw;
 } }
    } else {
        const float Aexp = expf(p.in[I_DNALOG][layer * 6 + h]), dtb = p.in[I_DNDTB][layer * 6 + h];
        const float* small = (const float*)(p.ws + WS_SMALL) + (size_t)b * SEQ * 32;
#pragma unroll
        for (int q = 0; q < 2; ++q) { const int tk = (tid - 480) * 2 + q; const float a = small[(size_t)(t0 + tk) * 32 + h], bb = small[(size_t)(t0 + tk) * 32 + 6 + h];
            SC[128 + tk] = sigmoidf_(bb); SC[192 + tk] = -Aexp * softplusf_(a + dtb); }
    }
    LDS_BARRIER();
    {
        const int row = tid >> 3, sg = tid & 7; const u32x4 q0 = *(const LAS u32x4*)(QS + row * 272 + sg * 32), q1 = *(const LAS u32x4*)(QS + row * 272 + sg * 32 + 16), k0 = *(const LAS u32x4*)(KS + row * 272 + sg * 32), k1 = *(const LAS u32x4*)(KS + row * 272 + sg * 32 + 16);
        float sq = sq8((f32x4){lo_bf(q0.x), hi_bf(q0.x), lo_bf(q0.y), hi_bf(q0.y)}, (f32x4){lo_bf(q0.z), hi_bf(q0.z), lo_bf(q0.w), hi_bf(q0.w)}) + sq8((f32x4){lo_bf(q1.x), hi_bf(q1.x), lo_bf(q1.y), hi_bf(q1.y)}, (f32x4){lo_bf(q1.z), hi_bf(q1.z), lo_bf(q1.w), hi_bf(q1.w)});
        float sk = sq8((f32x4){lo_bf(k0.x), hi_bf(k0.x), lo_bf(k0.y), hi_bf(k0.y)}, (f32x4){lo_bf(k0.z), hi_bf(k0.z), lo_bf(k0.w), hi_bf(k0.w)}) + sq8((f32x4){lo_bf(k1.x), hi_bf(k1.x), lo_bf(k1.y), hi_bf(k1.y)}, (f32x4){lo_bf(k1.z), hi_bf(k1.z), lo_bf(k1.w), hi_bf(k1.w)});
        sq += __shfl_xor(sq, 1); sq += __shfl_xor(sq, 2); sq += __shfl_xor(sq, 4); sk += __shfl_xor(sk, 1); sk += __shfl_xor(sk, 2); sk += __shfl_xor(sk, 4);
        if (sg == 0) { SC[row] = sq; SC[64 + row] = sk; } }
    LDS_BARRIER();
    if (wave == 0) {
        float g = SC[192 + lane];
#pragma unroll
        for (int o = 1; o < 64; o <<= 1) { const float t = __shfl_up(g, o); if (lane >= o) g += t; }
        SC[192 + lane] = g; SC[256 + lane] = expf(g); SC[320 + lane] = rsqrtf(SC[lane] + EPS); SC[384 + lane] = rsqrtf(SC[64 + lane] + EPS);
    }
    LDS_BARRIER();
    {
        const int r = lane & 15, kg = lane >> 4;
        bf16x8 fa[4][4], fb[4][4];
#pragma unroll
        for (int q = 0; q < 4; ++q) { const int t = wave * 4 + q, which = t >> 4, mt = (t >> 2) & 3, nt = t & 3;
            const LAS unsigned char* A = (which == 0 ? KS : QS) + (16 * mt + r) * 272 + kg * 16; const LAS unsigned char* Bt = KS + (16 * nt + r) * 272 + kg * 16;
#pragma unroll
            for (int ks = 0; ks < 4; ++ks) { fa[q][ks] = *(const LAS bf16x8*)(A + ks * 64); fb[q][ks] = *(const LAS bf16x8*)(Bt + ks * 64); } }
#pragma unroll
        for (int q = 0; q < 4; ++q) { const int t = wave * 4 + q, which = t >> 4, mt = (t >> 2) & 3, nt = t & 3;
            f32x4 acc = (f32x4){0.f, 0.f, 0.f, 0.f};
#pragma unroll
            for (int ks = 0; ks < 4; ++ks) acc = mfma16(fa[q][ks], fb[q][ks], acc);
            const int j = 16 * nt + r; const float gj = SC[192 + j], rkj = SC[384 + j];
            float ov[4];
#pragma unroll
            for (int rr = 0; rr < 4; ++rr) { const int i = 16 * mt + 4 * kg + rr; const float e = fexp(fminf(SC[192 + i] - gj, 0.f));
                if (which == 0) AM[i * 68 + j] = (i > j) ? SC[128 + i] * SC[384 + i] * rkj * acc[rr] * e : 0.f;
                ov[rr] = (i >= j) ? SC[320 + i] * rkj * 0.08838834764831845f * acc[rr] * e : 0.f; }
            if (which != 0) { bf16_t* ao = (bf16_t*)(item + 32768) + (16 * mt + 4 * kg) * 64 + j; ST2_BF(ao, ao + 64, ov[0], ov[1]); ST2_BF(ao + 128, ao + 192, ov[2], ov[3]); }
        }
    }
    LDS_BARRIER();
    if (tid < 256) {
        float x[64];
        if (tid < 128) {
#pragma unroll
            for (int i = 0; i < 64; ++i) x[i] = bf2f(*(const LAS bf16_t*)(KS + i * 272 + tid * 2)) * SC[384 + i] * SC[128 + i] * SC[256 + i];
        } else {
#pragma unroll
            for (int i = 0; i < 64; ++i) x[i] = bf2f(*(const LAS bf16_t*)(VS + i * 272 + (tid - 128) * 2)) * SC[128 + i];
        }
        f32x4 rw[2][16];
        rw[1][0] = *(const LAS f32x4*)(AM + 1 * 68);
#pragma unroll
        for (int i = 1; i < 64; ++i) {
            if (i + 1 < 64) {
#pragma unroll
                for (int k4 = 0; k4 < (i + 4) / 4; ++k4) rw[(i + 1) & 1][k4] = *(const LAS f32x4*)(AM + (i + 1) * 68 + 4 * k4);
            }
            float a4[4] = {x[i], 0.f, 0.f, 0.f};
#pragma unroll
            for (int k4 = 0; k4 < (i + 3) / 4; ++k4) { const f32x4 am = rw[i & 1][k4];
#pragma unroll
                for (int c = 0; c < 4; ++c) if (4 * k4 + c < i) a4[c] -= am[c] * x[4 * k4 + c]; }
            x[i] = (a4[0] + a4[1]) + (a4[2] + a4[3]); }
        if (tid < 128) { bf16_t* W = (bf16_t*)item;
#pragma unroll
            for (int i = 0; i < 64; i += 2) ST2_BF(W + i * 128 + tid, W + (i + 1) * 128 + tid, x[i], x[i + 1]);
        } else { u32x4* UT = (u32x4*)(item + 57344 + (size_t)(tid - 128) * 128);
#pragma unroll
            for (int c = 0; c < 8; ++c) { u32x4 w; w.x = pk2(x[8 * c], x[8 * c + 1]); w.y = pk2(x[8 * c + 2], x[8 * c + 3]); w.z = pk2(x[8 * c + 4], x[8 * c + 5]); w.w = pk2(x[8 * c + 6], x[8 * c + 7]); UT[c] = w; } }
    } else {
        const int u = tid - 256; const float glast = SC[192 + 63];
#pragma unroll
        for (int i = 0; i < 4; ++i) { const int q = u + 256 * i, c = q >> 4, d8 = (q & 15) * 8; f32x4 a0, a1;
            const u32x4 w = *(const LAS u32x4*)(QS + c * 272 + d8 * 2); const float sc = SC[320 + c] * 0.08838834764831845f * SC[256 + c];
            a0 = (f32x4){lo_bf(w.x), hi_bf(w.x), lo_bf(w.y), hi_bf(w.y)} * sc; a1 = (f32x4){lo_bf(w.z), hi_bf(w.z), lo_bf(w.w), hi_bf(w.w)} * sc;
            st_bf8((bf16_t*)(item + 16384) + c * 128 + d8, a0, a1); }
#pragma unroll
        for (int i = 0; i < 4; ++i) { const int q = u + 256 * i, d = q >> 3, c8 = (q & 7) * 8; float v[8];
#pragma unroll
            for (int c = 0; c < 8; ++c) v[c] = bf2f(*(const LAS bf16_t*)(KS + (c8 + c) * 272 + d * 2)) * SC[384 + c8 + c] * fexp(glast - SC[192 + c8 + c]);
            st_bf8((bf16_t*)(item + 40960) + d * 64 + c8, (f32x4){v[0], v[1], v[2], v[3]}, (f32x4){v[4], v[5], v[6], v[7]}); }
        if (u == 0) ((float*)(p.ws + WS_DNEGL))[(b * 32 + n) * 6 + h] = SC[256 + 63];
    }
    {
        const float* ng = p.in[I_DNNORM] + layer * 128; bf16_t* ydn = (bf16_t*)(p.ws + WS_YDN) + ((size_t)b * SEQ + t0) * 768 + h * 128;
#pragma unroll
        for (int i = 0; i < 2; ++i) { const int q = tid + 512 * i, c = q >> 4, e8 = (q & 15) * 8; f32x4 z0, z1; ld_bf8(proj + (size_t)(t0 + c) * 3072 + 2304 + h * 128 + e8, z0, z1);
            const f32x4 g0 = *(const f32x4*)(ng + e8), g1 = *(const f32x4*)(ng + e8 + 4);
#pragma unroll
            for (int j = 0; j < 4; ++j) { z0[j] = g0[j] * siluf_(z0[j]); z1[j] = g1[j] * siluf_(z1[j]); }
            st_bf8(ydn + (size_t)c * 768 + e8, z0, z1); }
    }
    LDS_BARRIER();
}
__device__ __forceinline__ float row16_sum(float v) {
    v += __builtin_bit_cast(float, __builtin_amdgcn_update_dpp(0, __builtin_bit_cast(int, v), 0xB1, 0xf, 0xf, false));
    v += __builtin_bit_cast(float, __builtin_amdgcn_update_dpp(0, __builtin_bit_cast(int, v), 0x4E, 0xf, 0xf, false));
    v += __builtin_bit_cast(float, __builtin_amdgcn_update_dpp(0, __builtin_bit_cast(int, v), 0x141, 0xf, 0xf, false));
    v += __builtin_bit_cast(float, __builtin_amdgcn_update_dpp(0, __builtin_bit_cast(int, v), 0x140, 0xf, 0xf, false));
    return v;
}
__device__ __forceinline__ void dn_scan(const Params& p, LAS unsigned char* lds, int layer, int b, int h) {
    const int tid = htid(), lane = tid & 63, wave = __builtin_amdgcn_readfirstlane(tid >> 6), r = lane & 15, kg = lane >> 4;
    LAS unsigned char* W = lds; LAS unsigned char* QD = lds + 17408; LAS unsigned char* ATT = lds + 34816; LAS unsigned char* KDT = lds + 44032; LAS unsigned char* UT = lds + 62464;
    LAS unsigned char* ST = lds + 80896; LAS unsigned char* VNT = lds + 115712; LAS float* PS = (LAS float*)(lds + 134144); LAS float* RS = (LAS float*)(lds + 136192) + wave * 64;
    const unsigned char* items = p.ws + WS_DNS + (size_t)(b * 32 * 6 + h) * DNS_ITEM;
    bf16_t* ydn = (bf16_t*)(p.ws + WS_YDN) + (size_t)b * SEQ * 768 + h * 128 + 16 * wave + r;
    float egl_all = lane < 32 ? ((const float*)(p.ws + WS_DNEGL))[b * 32 * 6 + h + 6 * lane] : 0.f;
    asm volatile("" : "+v"(egl_all));
    f32x4 S[8], o[4];
#pragma unroll
    for (int dt = 0; dt < 8; ++dt) S[dt] = (f32x4){0.f, 0.f, 0.f, 0.f};
#pragma unroll
    for (int mt = 0; mt < 4; ++mt) o[mt] = (f32x4){0.f, 0.f, 0.f, 0.f};
    for (int i = lane; i < 16 * 272 / 16; i += 64) *(LAS u32x4*)(ST + wave * 16 * 272 + i * 16) = (u32x4){0u, 0u, 0u, 0u};
    u32x4 R[9];
#pragma unroll
    for (int i = 0; i < 9; ++i) R[i] = *(const u32x4*)(items + (size_t)(tid + 512 * i) * 16);
    unsigned short zc[16];
#pragma unroll
    for (int i = 0; i < 16; ++i) zc[i] = 0u;
    LDS_BARRIER();
    for (int n = 0; n <= 32; ++n) {
        if (n < 32) {
#pragma unroll
            for (int i = 0; i < 9; ++i) { const int q = tid + 512 * i; LAS unsigned char* dst;
                if (i < 2) dst = W + (q >> 4) * 272 + (q & 15) * 16; else if (i < 4) dst = QD + ((q - 1024) >> 4) * 272 + (q & 15) * 16;
                else if (i < 5) dst = ATT + ((q - 2048) >> 3) * 144 + (q & 7) * 16; else if (i < 7) dst = KDT + ((q - 2560) >> 3) * 144 + (q & 7) * 16;
                else dst = UT + ((q - 3584) >> 3) * 144 + (q & 7) * 16;
                *(LAS u32x4*)dst = R[i]; }
        }
        if (n > 0) {
            float tot = 0.f;
#pragma unroll
            for (int w = 0; w < 8; ++w) tot += PS[w * 64 + lane];
            RS[lane] = rsqrtf(tot * (1.f / 128.f) + EPS);
#pragma unroll
            for (int mt = 0; mt < 4; ++mt) { const f32x4 rs = *(const LAS f32x4*)(RS + 16 * mt + 4 * kg);
#pragma unroll
                for (int rr = 0; rr < 4; rr += 2) { bf16_t* yo_ = ydn + (size_t)((n - 1) * 64 + 16 * mt + 4 * kg + rr) * 768;
                    ST2_BF(yo_, yo_ + 768, o[mt][rr] * rs[rr] * __uint_as_float(((unsigned)zc[4 * mt + rr]) << 16), o[mt][rr + 1] * rs[rr + 1] * __uint_as_float(((unsigned)zc[4 * mt + rr + 1]) << 16)); } }
        }
        if (n == 32) break;
        if (n + 1 < 32) {
#pragma unroll
            for (int i = 0; i < 9; ++i) R[i] = *(const u32x4*)(items + (size_t)(n + 1) * 6 * DNS_ITEM + (size_t)(tid + 512 * i) * 16);
        }
#pragma unroll
        for (int mt = 0; mt < 4; ++mt)
#pragma unroll
            for (int rr = 0; rr < 4; ++rr) zc[4 * mt + rr] = ydn[(size_t)(n * 64 + 16 * mt + 4 * kg + rr) * 768];
        const float egl = __builtin_bit_cast(float, __builtin_amdgcn_readlane(__builtin_bit_cast(int, egl_all), n));
        LDS_BARRIER();
        bf16x8 sf[4];
#pragma unroll
        for (int ks = 0; ks < 4; ++ks) sf[ks] = *(const LAS bf16x8*)(ST + (16 * wave + r) * 272 + ks * 64 + kg * 16);
        {   bf16x8 af[4][4]; u32x2 uw[4];
#pragma unroll
            for (int mt = 0; mt < 4; ++mt) {
#pragma unroll
                for (int ks = 0; ks < 4; ++ks) af[mt][ks] = *(const LAS bf16x8*)(W + (16 * mt + r) * 272 + ks * 64 + kg * 16);
                uw[mt] = *(const LAS u32x2*)(UT + (16 * wave + r) * 144 + (16 * mt + 4 * kg) * 2); }
#pragma unroll
            for (int mt = 0; mt < 4; ++mt) { f32x4 ws = (f32x4){0.f, 0.f, 0.f, 0.f};
#pragma unroll
                for (int ks = 0; ks < 4; ++ks) ws = mfma16(af[mt][ks], sf[ks], ws);
                const f32x4 vn = (f32x4){lo_bf(uw[mt].x), hi_bf(uw[mt].x), lo_bf(uw[mt].y), hi_bf(uw[mt].y)} - ws;
                u32x2 vw; vw.x = pk2(vn[0], vn[1]); vw.y = pk2(vn[2], vn[3]);
                *(LAS u32x2*)(VNT + (16 * wave + r) * 144 + (16 * mt + 4 * kg) * 2) = vw; } }
        bf16x8 vf[2];
        {
            bf16x8 qf[4][4], tf[4][2];
#pragma unroll
            for (int mt = 0; mt < 4; ++mt) {
#pragma unroll
                for (int ks = 0; ks < 4; ++ks) qf[mt][ks] = *(const LAS bf16x8*)(QD + (16 * mt + r) * 272 + ks * 64 + kg * 16);
#pragma unroll
                for (int kc = 0; kc < 2; ++kc) tf[mt][kc] = *(const LAS bf16x8*)(ATT + (16 * mt + r) * 144 + kc * 64 + kg * 16); }
#pragma unroll
            for (int kc = 0; kc < 2; ++kc) vf[kc] = *(const LAS bf16x8*)(VNT + (16 * wave + r) * 144 + kc * 64 + kg * 16);
#pragma unroll
            for (int mt = 0; mt < 4; ++mt) { f32x4 a = (f32x4){0.f, 0.f, 0.f, 0.f};
#pragma unroll
                for (int ks = 0; ks < 4; ++ks) a = mfma16(qf[mt][ks], sf[ks], a);
#pragma unroll
                for (int kc = 0; kc < 2; ++kc) a = mfma16(tf[mt][kc], vf[kc], a);
                o[mt] = a; } }
        {
            bf16x8 kf[8][2];
#pragma unroll
            for (int dt = 0; dt < 8; ++dt)
#pragma unroll
                for (int kc = 0; kc < 2; ++kc) kf[dt][kc] = *(const LAS bf16x8*)(KDT + (16 * dt + r) * 144 + kc * 64 + kg * 16);
#pragma unroll
            for (int dt = 0; dt < 8; ++dt) { f32x4 a = S[dt] * egl;
#pragma unroll
                for (int kc = 0; kc < 2; ++kc) a = mfma16(kf[dt][kc], vf[kc], a);
                S[dt] = a; u32x2 sw; sw.x = pk2(a[0], a[1]); sw.y = pk2(a[2], a[3]);
                *(LAS u32x2*)(ST + (16 * wave + r) * 272 + (16 * dt + 4 * kg) * 2) = sw; } }
#pragma unroll
        for (int mt = 0; mt < 4; ++mt) { f32x4 q;
#pragma unroll
            for (int rr = 0; rr < 4; ++rr) q[rr] = row16_sum(o[mt][rr] * o[mt][rr]);
            if (r == 0) *(LAS f32x4*)(PS + wave * 64 + 16 * mt + 4 * kg) = q; }
        LDS_BARRIER();
    }
    LDS_BARRIER();
}
template <int MODE>
__device__ __forceinline__ void ssd_load(const Params& p, LAS unsigned char* lds, int layer, int b, int c, int grp) {
    const int tid = htid(), lane = tid & 63, wave = tid >> 6, t0 = c * 64;
    LAS float* DT = (LAS float*)(lds + 117760); LAS float* ACS = DT + 384;
    LAS unsigned char* XT = lds + 34816;
    if (wave < 6) { const int hh = grp * 6 + wave; const float* small = (const float*)(p.ws + WS_SMALL) + ((size_t)b * SEQ + t0 + lane) * 32;
        const float dt = softplusf_(small[12 + hh] + p.in[I_SSDTB][layer * 12 + hh]); float a = -expf(p.in[I_SSALOG][layer * 12 + hh]) * dt;
#pragma unroll
        for (int o = 1; o < 64; o <<= 1) { const float t = __shfl_up(a, o); if (lane >= o) a += t; }
        DT[wave * 64 + lane] = dt; ACS[wave * 64 + lane] = a; }
    LDS_BARRIER();
    const int cg = tid % 80, seg = tid / 80, ch8 = cg * 8;
    if (tid < 480 && (MODE == 1 || ch8 < 512)) {
        const int col = ch8 < 384 ? grp * 384 + ch8 : (ch8 < 512 ? 768 + grp * 128 + (ch8 - 384) : 1024 + grp * 128 + (ch8 - 512));
        const float* cw = p.in[I_SSCONV] + (size_t)layer * 4 * 1280 + col; const float* cb = p.in[I_SSCONVB] + layer * 1280 + col;
        f32x4 w[4][2], bias[2];
#pragma unroll
        for (int j = 0; j < 4; ++j) { w[j][0] = *(const f32x4*)(cw + j * 1280); w[j][1] = *(const f32x4*)(cw + j * 1280 + 4); }
        bias[0] = *(const f32x4*)cb; bias[1] = *(const f32x4*)(cb + 4);
        const bf16_t* proj = (const bf16_t*)(p.ws + WS_PSSM) + (size_t)b * SEQ * 2048 + col;
        const int ts = seg * 11, hi = ch8 >> 6;
        f32x4 xm[3][2];
#pragma unroll
        for (int i = 0; i < 3; ++i) { const int t = t0 + ts - 3 + i; xm[i][0] = (f32x4){0.f, 0.f, 0.f, 0.f}; xm[i][1] = xm[i][0]; if (t >= 0) ld_bf8(proj + (size_t)t * 2048, xm[i][0], xm[i][1]); }
#pragma unroll
        for (int i = 0; i < 11; ++i) { const int tk = ts + i;
            if (tk < 64) { f32x4 c0, c1; ld_bf8(proj + (size_t)(t0 + tk) * 2048, c0, c1);
                f32x4 a0 = bias[0] + w[3][0] * c0 + w[2][0] * xm[2][0] + w[1][0] * xm[1][0] + w[0][0] * xm[0][0];
                f32x4 a1 = bias[1] + w[3][1] * c1 + w[2][1] * xm[2][1] + w[1][1] * xm[1][1] + w[0][1] * xm[0][1];
                xm[0][0] = xm[1][0]; xm[0][1] = xm[1][1]; xm[1][0] = xm[2][0]; xm[1][1] = xm[2][1]; xm[2][0] = c0; xm[2][1] = c1;
#pragma unroll
                for (int q = 0; q < 4; ++q) { a0[q] = siluf_(a0[q]); a1[q] = siluf_(a1[q]); }
                if (ch8 < 384) { const float sc = MODE == 0 ? DT[hi * 64 + tk] * fexp(ACS[hi * 64 + 63] - ACS[hi * 64 + tk]) : DT[hi * 64 + tk];
#pragma unroll
                    for (int q = 0; q < 4; ++q) { const unsigned pw = pk2(a0[q] * sc, a1[q] * sc);
                        *(LAS bf16_t*)(XT + (ch8 + q) * 144 + tk * 2) = (bf16_t)(pw & 0xffffu); *(LAS bf16_t*)(XT + (ch8 + 4 + q) * 144 + tk * 2) = (bf16_t)(pw >> 16); } }
                else if (MODE == 0) {
#pragma unroll
                    for (int q = 0; q < 4; ++q) { const unsigned pw = pk2(a0[q], a1[q]);
                        *(LAS bf16_t*)(lds + (ch8 - 384 + q) * 144 + tk * 2) = (bf16_t)(pw & 0xffffu); *(LAS bf16_t*)(lds + (ch8 - 384 + 4 + q) * 144 + tk * 2) = (bf16_t)(pw >> 16); } }
                else { u32x4 pw; pw.x = pk2(a0[0], a0[1]); pw.y = pk2(a0[2], a0[3]); pw.z = pk2(a1[0], a1[1]); pw.w = pk2(a1[2], a1[3]);
                    *(LAS u32x4*)(lds + (ch8 < 512 ? 17408 + tk * 272 + (ch8 - 384) * 2 : tk * 272 + (ch8 - 512) * 2)) = pw; } } }
    }
    LDS_BARRIER();
}
__device__ __forceinline__ void ssd_states(const Params& p, LAS unsigned char* lds, int layer, int b, int c, int grp) {
    ssd_load<0>(p, lds, layer, b, c, grp);
    const int tid = htid(), lane = tid & 63, wave = tid >> 6, r = lane & 15, kg = lane >> 4;
    const LAS unsigned char* XT = lds + 34816; const LAS unsigned char* BT = lds; const LAS float* ACS = (const LAS float*)(lds + 117760) + 384;
    bf16_t* st = (bf16_t*)(p.ws + WS_SSST) + ((size_t)(b * 32 + c) * 12 + grp * 6) * 8192;
    for (int t4 = 0; t4 < 24; t4 += 4) {
        bf16x8 af[4][2], bfr[4][2];
#pragma unroll
        for (int q = 0; q < 4; ++q) { const int t = wave + 8 * (t4 + q), hi = t >> 5, mt = (t >> 3) & 3, nt = t & 7;
#pragma unroll
            for (int ks = 0; ks < 2; ++ks) { af[q][ks] = *(const LAS bf16x8*)(XT + (hi * 64 + 16 * mt + r) * 144 + ks * 64 + kg * 16); bfr[q][ks] = *(const LAS bf16x8*)(BT + (16 * nt + r) * 144 + ks * 64 + kg * 16); } }
#pragma unroll
        for (int q = 0; q < 4; ++q) { const int t = wave + 8 * (t4 + q), hi = t >> 5, mt = (t >> 3) & 3, nt = t & 7;
            f32x4 acc = (f32x4){0.f, 0.f, 0.f, 0.f};
#pragma unroll
            for (int ks = 0; ks < 2; ++ks) acc = mfma16(af[q][ks], bfr[q][ks], acc);
#pragma unroll
            for (int rr = 0; rr < 4; rr += 2) { bf16_t* so_ = st + (size_t)hi * 8192 + (16 * mt + 4 * kg + rr) * 128 + 16 * nt + r; ST2_BF(so_, so_ + 128, acc[rr], acc[rr + 1]); } }
    }
    if (tid < 6) ((float*)(p.ws + WS_SSCD))[(b * 32 + c) * 12 + grp * 6 + tid] = expf(ACS[tid * 64 + 63]);
    LDS_BARRIER();
}
__device__ __forceinline__ void ssd_scan(const Params& p, int first_blk, int nblk) {
    const int gt = ((int)blockIdx.x - first_blk) * 512 + htid(), NT = nblk * 512;
    const u32x2* st = (const u32x2*)(p.ws + WS_SSST); const float* cd = (const float*)(p.ws + WS_SSCD); u32x2* pv = (u32x2*)(p.ws + WS_SSPV);
    for (int v = gt; v < NB * 12 * 2048; v += NT) { const int b = v / (12 * 2048), h = (v / 2048) % 12, e = v % 2048;
        f32x4 run = (f32x4){0.f, 0.f, 0.f, 0.f};
        for (int c0 = 0; c0 < 32; c0 += 8) { u32x2 t[8];
#pragma unroll
            for (int i = 0; i < 8; ++i) t[i] = st[((size_t)(b * 32 + c0 + i) * 12 + h) * 2048 + e];
#pragma unroll
            for (int i = 0; i < 8; ++i) { u32x2 w; w.x = pk2(run[0], run[1]); w.y = pk2(run[2], run[3]); pv[((size_t)(b * 32 + c0 + i) * 12 + h) * 2048 + e] = w;
                run = run * cd[(b * 32 + c0 + i) * 12 + h] + (f32x4){lo_bf(t[i].x), hi_bf(t[i].x), lo_bf(t[i].y), hi_bf(t[i].y)}; } }
    }
}
__device__ __forceinline__ void ssd_out(const Params& p, LAS unsigned char* lds, int layer, int b, int c, int grp) {
    ssd_load<1>(p, lds, layer, b, c, grp);
    const int tid = htid(), lane = tid & 63, wave = tid >> 6, r = lane & 15, kg = lane >> 4, t0 = c * 64;
    const LAS unsigned char* CM = lds; const LAS unsigned char* BM = lds + 17408; const LAS unsigned char* XT = lds + 34816; LAS unsigned char* MH = lds + 90112;
    const LAS float* DT = (const LAS float*)(lds + 117760); const LAS float* ACS = DT + 384; LAS float* YG = (LAS float*)lds;
    const bf16_t* prev = (const bf16_t*)(p.ws + WS_SSPV) + ((size_t)(b * 32 + c) * 12 + grp * 6) * 8192;
    f32x4 cb[2];
    {   bf16x8 ca[2][4], cbf[2][4];
#pragma unroll
        for (int q = 0; q < 2; ++q) { const int t = wave * 2 + q, mt = t >> 2, nt = t & 3;
#pragma unroll
            for (int ks = 0; ks < 4; ++ks) { ca[q][ks] = *(const LAS bf16x8*)(CM + (16 * mt + r) * 272 + ks * 64 + kg * 16); cbf[q][ks] = *(const LAS bf16x8*)(BM + (16 * nt + r) * 272 + ks * 64 + kg * 16); } }
#pragma unroll
        for (int q = 0; q < 2; ++q) { f32x4 acc = (f32x4){0.f, 0.f, 0.f, 0.f};
#pragma unroll
            for (int ks = 0; ks < 4; ++ks) acc = mfma16(ca[q][ks], cbf[q][ks], acc);
            cb[q] = acc; } }
    f32x4 y[2][6];
#pragma unroll
    for (int half = 0; half < 2; ++half) {
#pragma unroll
        for (int q = 0; q < 2; ++q) { const int t = wave * 2 + q, mt = t >> 2, nt = t & 3, j = 16 * nt + r;
#pragma unroll
            for (int hl = 0; hl < 3; ++hl) { const int hi = 3 * half + hl; const float aj = ACS[hi * 64 + j];
#pragma unroll
                for (int rr = 0; rr < 4; ++rr) { const int i = 16 * mt + 4 * kg + rr; *(LAS bf16_t*)(MH + hl * 9216 + i * 144 + j * 2) = (bf16_t)f2bf((i >= j) ? cb[q][rr] * fexp(fminf(ACS[hi * 64 + i] - aj, 0.f)) : 0.f); } } }
        bf16x8 pf[6][4];
#pragma unroll
        for (int k = 0; k < 6; ++k) { const int t = wave + 8 * k, hl = t >> 4, nt = t & 3, hi = 3 * half + hl; const bf16_t* pr = prev + (size_t)hi * 8192 + (16 * nt + r) * 128 + kg * 8;
#pragma unroll
            for (int ks = 0; ks < 4; ++ks) pf[k][ks] = *(const bf16x8*)(pr + ks * 32); }
        LDS_BARRIER();
#pragma unroll
        for (int k = 0; k < 6; ++k) { const int t = wave + 8 * k, hl = t >> 4, mt = (t >> 2) & 3, nt = t & 3, hi = 3 * half + hl, hh = grp * 6 + hi;
            f32x4 acc = (f32x4){0.f, 0.f, 0.f, 0.f}, off = acc;
            bf16x8 mf[2], xf[2], cf[4];
#pragma unroll
            for (int ks = 0; ks < 2; ++ks) { mf[ks] = *(const LAS bf16x8*)(MH + hl * 9216 + (16 * mt + r) * 144 + ks * 64 + kg * 16); xf[ks] = *(const LAS bf16x8*)(XT + (hi * 64 + 16 * nt + r) * 144 + ks * 64 + kg * 16); }
#pragma unroll
            for (int ks = 0; ks < 4; ++ks) cf[ks] = *(const LAS bf16x8*)(CM + (16 * mt + r) * 272 + ks * 64 + kg * 16);
#pragma unroll
            for (int ks = 0; ks < 2; ++ks) acc = mfma16(mf[ks], xf[ks], acc);
#pragma unroll
            for (int ks = 0; ks < 4; ++ks) off = mfma16(cf[ks], pf[k][ks], off);
            const u32x2 xw = *(const LAS u32x2*)(XT + (hi * 64 + 16 * nt + r) * 144 + (16 * mt + 4 * kg) * 2); const float xs[4] = {lo_bf(xw.x), hi_bf(xw.x), lo_bf(xw.y), hi_bf(xw.y)};
            const float dsk = p.in[I_SSD][layer * 12 + hh];
#pragma unroll
            for (int rr = 0; rr < 4; ++rr) { const int i = 16 * mt + 4 * kg + rr; acc[rr] += fexp(ACS[hi * 64 + i]) * off[rr] + dsk * xs[rr] * __builtin_amdgcn_rcpf(fmaxf(DT[hi * 64 + i], 1e-30f)); }
            y[half][k] = acc; }
        LDS_BARRIER();
    }
    const bf16_t* zp = (const bf16_t*)(p.ws + WS_PSSM) + ((size_t)b * SEQ + t0) * 2048 + 1280 + grp * 384;
#pragma unroll
    for (int half = 0; half < 2; ++half)
#pragma unroll
        for (int k = 0; k < 6; ++k) { const int t = wave + 8 * k, hl = t >> 4, mt = (t >> 2) & 3, nt = t & 3, hi = 3 * half + hl, ch = hi * 64 + 16 * nt + r;
#pragma unroll
            for (int rr = 0; rr < 4; ++rr) { const int i = 16 * mt + 4 * kg + rr; const float z = bf2f(zp[(size_t)i * 2048 + ch]); YG[i * 388 + ch] = y[half][k][rr] * siluf_(z); } }
    LDS_BARRIER();
    const float* sn = p.in[I_SSNORM] + layer * 768 + grp * 384; bf16_t* yo = (bf16_t*)(p.ws + WS_YSSM) + ((size_t)b * SEQ + t0) * 768 + grp * 384;
#pragma unroll
    for (int i8 = 0; i8 < 8; ++i8) { const int i = 8 * wave + i8; float v[6], ss = 0.f;
#pragma unroll
        for (int k = 0; k < 6; ++k) { v[k] = YG[i * 388 + lane + 64 * k]; ss += v[k] * v[k]; }
        const float rs = rsqrtf(wave_sum(ss) * (1.f / 384.f) + EPS);
#pragma unroll
        for (int k = 0; k < 6; k += 2) ST2_BF(yo + (size_t)i * 768 + lane + 64 * k, yo + (size_t)i * 768 + lane + 64 * (k + 1), v[k] * rs * sn[lane + 64 * k], v[k + 1] * rs * sn[lane + 64 * (k + 1)]); }
    LDS_BARRIER();
}

typedef float f32x16 __attribute__((ext_vector_type(16)));
__device__ __forceinline__ void attn_tile(const Params& p, int b, int g, int j, int r, int qt, int lane) {
    const int d = g == 0 ? 1 : (g == 1 ? 4 : 16), L = SEQ / d, n = lane & 31, hw = lane >> 5;
    const int P0 = b * SEQ + r * L;
    const bf16_t* Q = (const bf16_t*)(p.ws + WS_QK) + (size_t)(0 * 3 + g) * TC * 256 + j * 64;
    const bf16_t* K = (const bf16_t*)(p.ws + WS_QK) + (size_t)(1 * 3 + g) * TC * 256 + j * 64;
    const bf16_t* V = (const bf16_t*)(p.ws + WS_VT) + (size_t)(g * 256 + j * 64) * TC;
    const float sl2 = exp2f(-8.f * (float)(4 * g + j + 1) / 12.f) * (float)d * 1.4426950408889634f;
    bf16x8 qf[4];
    { const bf16_t* qrow = Q + (size_t)(P0 + 32 * qt + n) * 256 + 8 * hw;
#pragma unroll
      for (int s = 0; s < 4; ++s) qf[s] = *(const bf16x8*)(qrow + 16 * s); }
    f32x16 o0, o1;
#pragma unroll
    for (int i = 0; i < 16; ++i) { o0[i] = 0.f; o1[i] = 0.f; }
    float mrun = -1e30f, lrun = 0.f;
    const int pim = (n & 0x13) | (((n >> 2) & 1) << 3) | (((n >> 3) & 1) << 2);
    const int qi = 32 * qt + n;
    const int kb0 = qt > 4 ? qt - 4 : 0;
    bf16x8 kf[4], vf[2][2];
    { const bf16_t* krow = K + (size_t)(P0 + 32 * kb0 + pim) * 256 + 8 * hw;
#pragma unroll
      for (int s = 0; s < 4; ++s) kf[s] = *(const bf16x8*)(krow + 16 * s);
#pragma unroll
      for (int sp = 0; sp < 2; ++sp)
#pragma unroll
          for (int dh = 0; dh < 2; ++dh) vf[sp][dh] = *(const bf16x8*)(V + (size_t)(32 * dh + n) * TC + P0 + 32 * kb0 + 16 * sp + 8 * hw); }
    for (int kb = kb0; kb <= qt; ++kb) {
        f32x16 st;
#pragma unroll
        for (int i = 0; i < 16; ++i) st[i] = 0.f;
#pragma unroll
        for (int s = 0; s < 4; ++s) st = __builtin_amdgcn_mfma_f32_32x32x16_bf16(kf[s], qf[s], st, 0, 0, 0);
        bf16x8 vc[2][2];
#pragma unroll
        for (int sp = 0; sp < 2; ++sp)
#pragma unroll
            for (int dh = 0; dh < 2; ++dh) vc[sp][dh] = vf[sp][dh];
        if (kb < qt) {
            const bf16_t* krow = K + (size_t)(P0 + 32 * (kb + 1) + pim) * 256 + 8 * hw;
#pragma unroll
            for (int s = 0; s < 4; ++s) kf[s] = *(const bf16x8*)(krow + 16 * s);
#pragma unroll
            for (int sp = 0; sp < 2; ++sp)
#pragma unroll
                for (int dh = 0; dh < 2; ++dh) vf[sp][dh] = *(const bf16x8*)(V + (size_t)(32 * dh + n) * TC + P0 + 32 * (kb + 1) + 16 * sp + 8 * hw);
        }
        float mx = -1e30f;
#pragma unroll
        for (int jj = 0; jj < 16; ++jj) { const int kidx = 32 * kb + 16 * (jj >> 3) + 8 * hw + 4 * ((jj >> 2) & 1) + (jj & 3); const int dl = qi - kidx;
            const float sc = (dl >= 0 && dl <= 128) ? st[jj] * 1.4426950408889634f - sl2 * (float)dl : -1e30f; st[jj] = sc; mx = fmaxf(mx, sc); }
        mx = fmaxf(mx, __shfl_xor(mx, 32));
        const float mnew = fmaxf(mrun, mx), alpha = __builtin_amdgcn_exp2f(mrun - mnew);
        float rs = 0.f;
#pragma unroll
        for (int jj = 0; jj < 16; ++jj) { const float pj = __builtin_amdgcn_exp2f(st[jj] - mnew); st[jj] = pj; rs += pj; }
        rs += __shfl_xor(rs, 32);
        lrun = lrun * alpha + rs; mrun = mnew;
#pragma unroll
        for (int i = 0; i < 16; ++i) { o0[i] *= alpha; o1[i] *= alpha; }
#pragma unroll
        for (int sp = 0; sp < 2; ++sp) {
            u32x4 pw; pw.x = pk2(st[8 * sp + 0], st[8 * sp + 1]); pw.y = pk2(st[8 * sp + 2], st[8 * sp + 3]); pw.z = pk2(st[8 * sp + 4], st[8 * sp + 5]); pw.w = pk2(st[8 * sp + 6], st[8 * sp + 7]);
            const bf16x8 pf = __builtin_bit_cast(bf16x8, pw);
            o0 = __builtin_amdgcn_mfma_f32_32x32x16_bf16(vc[sp][0], pf, o0, 0, 0, 0);
            o1 = __builtin_amdgcn_mfma_f32_32x32x16_bf16(vc[sp][1], pf, o1, 0, 0, 0);
        }
    }
    const float inv = 1.f / lrun;
    const int tok = b * SEQ + qi * d + r;
    bf16_t* og = (bf16_t*)(p.ws + WS_OG) + ((size_t)g * TC + tok) * 256 + j * 64 + 4 * hw;
#pragma unroll
    for (int q4 = 0; q4 < 4; ++q4) {
        u32x2 w0, w1; w0.x = pk2(o0[4 * q4] * inv, o0[4 * q4 + 1] * inv); w0.y = pk2(o0[4 * q4 + 2] * inv, o0[4 * q4 + 3] * inv);
        w1.x = pk2(o1[4 * q4] * inv, o1[4 * q4 + 1] * inv); w1.y = pk2(o1[4 * q4 + 2] * inv, o1[4 * q4 + 3] * inv);
        *(u32x2*)(og + 8 * q4) = w0; *(u32x2*)(og + 32 + 8 * q4) = w1;
    }
    if (hw == 0) ((float*)(p.ws + WS_LSE))[((size_t)g * TC + tok) * 4 + j] = (mrun + log2f(lrun)) * 0.6931471805599453f;
}
__device__ __forceinline__ void phase_attn_combine(const Params& p, int skip) {
    const int tid_ = htid(), lane = tid_ & 63, gw = ((int)blockIdx.x - skip) * 8 + (tid_ >> 6), NGW = ((int)gridDim.x - skip) * 8;
    const bf16_t* og = (const bf16_t*)(p.ws + WS_OG); const float* lse = (const float*)(p.ws + WS_LSE); bf16_t* ya = (bf16_t*)(p.ws + WS_YATT);
    for (int t = gw; t < TC; t += NGW) {
        const int j = lane >> 4;
        const float l0 = lse[((size_t)0 * TC + t) * 4 + j], l1 = lse[((size_t)1 * TC + t) * 4 + j], l2 = lse[((size_t)2 * TC + t) * 4 + j];
        const float M = fmaxf(l0, fmaxf(l1, l2)); float w0 = expf(l0 - M), w1 = expf(l1 - M), w2 = expf(l2 - M); const float iw = 1.f / (w0 + w1 + w2); w0 *= iw; w1 *= iw; w2 *= iw;
        const u32x2 a = *((const u32x2*)(og + ((size_t)0 * TC + t) * 256) + lane), bb = *((const u32x2*)(og + ((size_t)1 * TC + t) * 256) + lane), c = *((const u32x2*)(og + ((size_t)2 * TC + t) * 256) + lane);
        u32x2 o; o.x = pk2(w0 * lo_bf(a.x) + w1 * lo_bf(bb.x) + w2 * lo_bf(c.x), w0 * hi_bf(a.x) + w1 * hi_bf(bb.x) + w2 * hi_bf(c.x));
        o.y = pk2(w0 * lo_bf(a.y) + w1 * lo_bf(bb.y) + w2 * lo_bf(c.y), w0 * hi_bf(a.y) + w1 * hi_bf(bb.y) + w2 * hi_bf(c.y));
        *((u32x2*)(ya + (size_t)t * 256) + lane) = o;
    }
}
__device__ __forceinline__ void sub_barrier(unsigned* cnt, unsigned target) {
    asm volatile("s_waitcnt vmcnt(0)" ::: "memory");
    __syncthreads();
    if (threadIdx.x == 0) {
        __builtin_amdgcn_fence(__ATOMIC_RELEASE, "agent"); asm volatile("s_waitcnt vmcnt(0)" ::: "memory");
        (void)xb_add(cnt, 1u);
        unsigned sp = 0; while (xb_ld(cnt) < target) { __builtin_amdgcn_s_sleep(2); if (++sp > (1u << 24)) break; }
        __builtin_amdgcn_fence(__ATOMIC_ACQUIRE, "agent"); asm volatile("s_waitcnt vmcnt(0)" ::: "memory");
    }
    __syncthreads();
}
__device__ __forceinline__ void phase_mixers(const Params& p, LAS unsigned char* lds, int layer) {
    const int G = gridDim.x, NDP = NB * 32 * 6, NSS = NB * 32 * 2;
    for (int item = blockIdx.x; item < NDP + NSS; item += G) {
        if (item < NDP) dn_prep(p, lds, layer, item / 192, (item / 6) % 32, item % 6);
        else { const int it = item - NDP; ssd_states(p, lds, layer, it / 64, (it >> 1) & 31, it & 1); }
    }
}
__device__ __forceinline__ void phase_mixers2(const Params& p, LAS unsigned char* lds, int layer, int rep, unsigned* subcnt, bool use_bar2) {
    const int tid_ = htid(), lane = tid_ & 63, wave = tid_ >> 6, G = gridDim.x, nscan = NB * 6;
    const int ded = G > 2 * nscan ? nscan : 0;
    if ((int)blockIdx.x < ded) { if (!(MIX2_PROBE == 2 && rep > 0)) dn_scan(p, lds, layer, blockIdx.x / 6, blockIdx.x % 6); return; }
    if (MIX2_PROBE == 1 && rep > 0) return;
    if (ded == 0) for (int it = blockIdx.x; it < nscan; it += G) dn_scan(p, lds, layer, it / 6, it % 6);
    const int nb = G - ded, rb = (int)blockIdx.x - ded;
    for (int item = rb; item < NB * 3 * 4 * 64 / 8; item += nb) { const int w = item * 8 + wave;
        const int st = w & 63, jj = (w >> 6) & 3, gg = (w >> 8) % 3, bb = w / 768;
        const int dd = gg == 0 ? 1 : (gg == 1 ? 4 : 16), tiles = SEQ / dd / 32;
        attn_tile(p, bb, gg, jj, st / tiles, st % tiles, lane); }
    ssd_scan(p, ded, nb);
    if (use_bar2) { XcdBarrier bar2; bar2.bar = (unsigned*)(p.ws + WS_CTL) + CW_BAR2; bar2.x = xb_xcc_id(); bar2.st = (volatile LAS unsigned*)(lds + LDS_BYTES - 256) + 12; xcd_barrier(bar2, (unsigned)nb); } else sub_barrier(subcnt, (unsigned)(nb * (rep + 1)));
    for (int it = rb; it < NB * 32 * 2; it += nb) ssd_out(p, lds, layer, it / 64, (it >> 1) & 31, it & 1);
    phase_attn_combine(p, ded);
}

constexpr int NSTEPS = 1 + NCH * (1 + 8 + 11 + 1);
__global__ void __launch_bounds__(512, 2) hybrid_fwd(Params p) {
    extern __shared__ __attribute__((aligned(16))) unsigned char lds_raw[];
    LAS unsigned char* lds = (LAS unsigned char*)lds_raw;
    volatile LAS unsigned* MISC = (volatile LAS unsigned*)(lds + LDS_BYTES - 256);
    if (threadIdx.x < 64) MISC[threadIdx.x] = 0u;
    __syncthreads();
    const int G = gridDim.x, cid = blockIdx.x;
    unsigned char* ws = p.ws;
    XcdBarrier bar; bar.bar = (unsigned*)(ws + WS_CTL) + CW_BAR; bar.x = 0; bar.st = MISC + 8;
    if (p.s_hi - p.s_lo > 1) bar = xcd_barrier_post((unsigned*)(ws + WS_CTL) + CW_BAR, MISC + 8);
    const bool use_bar2 = (p.s_hi - p.s_lo == NSTEPS) && ((int)gridDim.x > 2 * NB * 6);
    if (use_bar2 && (int)blockIdx.x >= NB * 6 && threadIdx.x == 0) (void)xb_add((unsigned*)(ws + WS_CTL) + CW_BAR2 + XB_XCNT(xb_xcc_id()), 1u);
    const int lo = p.s_lo, hi = p.s_hi;
    int step = 0;
    if (TPROBE_MASK != 0u && threadIdx.x == 0) { volatile LAS unsigned long long* tp_ = (volatile LAS unsigned long long*)(lds + LDS_BYTES - 256 + 128); tp_[0] = 0ull; tp_[1] = __builtin_amdgcn_s_memrealtime(); tp_[2] = 21ull; }
#define IN_STEP (step >= lo && step < hi)
#define END_STEP do { if (step >= lo && step + 1 < hi) xcd_barrier(bar); \
        if (TPROBE_ON && threadIdx.x == 0) { volatile LAS unsigned long long* tp_ = (volatile LAS unsigned long long*)(lds + LDS_BYTES - 256 + 128); const unsigned long long tn_ = __builtin_amdgcn_s_memrealtime(); \
            const unsigned pos_ = (unsigned)tp_[2]; if (pos_ < 22u && ((p.tmask >> pos_) & 1u)) tp_[0] += tn_ - tp_[1]; tp_[1] = tn_; tp_[2] = pos_ >= 20u ? 0ull : (unsigned long long)(pos_ + 1u); } \
        ++step; } while (0)
    bf16_t* xb = (bf16_t*)(ws + WS_XB); float* ssq = (float*)(ws + WS_SSQ);
    if (IN_STEP) for (int rep_ = 0; rep_ < (REP_PH == 0 ? 3 : 1); ++rep_, (rep_ < (REP_PH == 0 ? 3 : 1) ? xcd_barrier(bar) : (void)0)) phase_convert(p, lds);
    END_STEP;
    for (int chunk = 0; chunk < NCH; ++chunk) {
        float* xo = p.out + (size_t)chunk * TC * D;
        if (IN_STEP) phase_chunk_in(p, chunk);
        END_STEP;
        for (int layer = 0; layer < DEPTH; ++layer) {
            if (IN_STEP) for (int rep_ = 0; rep_ < (REP_PH == 2 ? 3 : 1); ++rep_, (rep_ < (REP_PH == 2 ? 3 : 1) ? xcd_barrier(bar) : (void)0)) {
                ProgIn P; P.S.init(TC / 256, INP / 256, G, cid); P.xb = layer == 0 ? xb : (const bf16_t*)(ws + WS_XB2); P.Wt = (const bf16_t*)(ws + WS_WIN) + (size_t)layer * INP * D; P.ssq = layer == 0 ? ssq : (const float*)(ws + WS_SSQ2);
                P.wsb = ws; P.pb = (const bf16_t*)(ws + WS_PB) + (size_t)layer * TC * PLE; P.wple = (const bf16_t*)(ws + WS_WPLE) + (size_t)layer * D * PLE;
                gemm_phase(lds, P);
            }
            END_STEP;
            if (IN_STEP) for (int rep_ = 0; rep_ < (REP_PH == 3 ? 3 : 1); ++rep_, (rep_ < (REP_PH == 3 ? 3 : 1) ? xcd_barrier(bar) : (void)0)) phase_mixers(p, lds, layer);
            END_STEP;
            if (IN_STEP) for (int rep_ = 0; rep_ < (REP_PH == 4 ? 3 : 1); ++rep_, (rep_ < (REP_PH == 4 ? 3 : 1) ? xcd_barrier(bar) : (void)0)) phase_mixers2(p, lds, layer, rep_, (unsigned*)(ws + WS_CTL) + CW_SUB + (chunk * 2 + layer) * 64, use_bar2);
            END_STEP;
            if (IN_STEP) for (int rep_ = 0; rep_ < (REP_PH == 6 ? 3 : 1); ++rep_, (rep_ < (REP_PH == 6 ? 3 : 1) ? xcd_barrier(bar) : (void)0)) {
                ProgMerge P; P.S.init(TC / 256, 4, G, cid); P.wsb = ws;
                P.wdn = (const bf16_t*)(ws + WS_WDN) + (size_t)layer * D * 768; P.wssm = (const bf16_t*)(ws + WS_WSSM) + (size_t)layer * D * 768; P.watt = (const bf16_t*)(ws + WS_WATT) + (size_t)layer * D * 256;
                gemm_phase(lds, P);
            }
            END_STEP;
            if (IN_STEP) {
                ProgResid P; P.S.init(TC / 256, 4, G, cid); P.A = (const bf16_t*)(ws + WS_MERGED); P.lda = 2048; P.nt = 16; P.Wt = (const bf16_t*)(ws + WS_WOUT) + (size_t)layer * D * D; P.ldb = 2048;
                P.xin_f = layer == 0 ? p.in[I_X] + (size_t)chunk * TC * D : nullptr; P.xin_b = (const bf16_t*)(ws + WS_XB2); P.xb = xb; P.ssq = ssq; P.sc = 1.f;
                gemm_phase(lds, P);
            }
            END_STEP;
            if (layer == 0) {
                if (IN_STEP) for (int rep_ = 0; rep_ < (REP_PH == 8 ? 3 : 1); ++rep_, (rep_ < (REP_PH == 8 ? 3 : 1) ? xcd_barrier(bar) : (void)0)) {
                    ProgFfnGu P; P.S.init(TC / 256, 2 * FFN / 256, G, cid); P.xb = xb; P.Wt = (const bf16_t*)(ws + WS_WFGU); P.ssq = ssq; P.act = (bf16_t*)(ws + WS_ACT);
                    gemm_phase(lds, P);
                }
                END_STEP;
                if (IN_STEP) {
                    ProgResid P; P.S.init(TC / 256, 4, G, cid); P.A = (const bf16_t*)(ws + WS_ACT); P.lda = 2 * FFN; P.nt = FFN / 64; P.Wt = (const bf16_t*)(ws + WS_WFD); P.ldb = 2 * FFN;
                    P.xin_f = nullptr; P.xin_b = xb; P.xb = xb; P.ssq = ssq; P.sc = (DBG_ABL & 8) ? 0.f : 1.f;
                    gemm_phase(lds, P);
                }
                END_STEP;
            } else {
                if (IN_STEP) phase_router(p, lds, chunk);
                END_STEP;
                if (IN_STEP) phase_slots(p, chunk);
                END_STEP;
                if (IN_STEP) for (int rep_ = 0; rep_ < (REP_PH == 12 ? 3 : 1); ++rep_, (rep_ < (REP_PH == 12 ? 3 : 1) ? xcd_barrier(bar) : (void)0)) {
                    ProgMoeGu P; P.S.init((const unsigned*)(ws + WS_CTL) + CW_CNT + chunk * 64, 2 * EXD / 256, G, cid); P.xb = xb; P.Wt = (const bf16_t*)(ws + WS_WMGU); P.ssq = ssq;
                    P.idx = (const int*)(ws + WS_ROUTE) + RT_IDX; P.act = (bf16_t*)(ws + WS_ACTM);
                    gemm_phase(lds, P);
                }
                END_STEP;
                if (IN_STEP) for (int rep_ = 0; rep_ < (REP_PH == 13 ? 3 : 1); ++rep_, (rep_ < (REP_PH == 13 ? 3 : 1) ? xcd_barrier(bar) : (void)0)) {
                    ProgMoeDown P; P.init((const unsigned*)(ws + WS_CTL) + CW_CNT + chunk * 64, G, cid); P.act = (const bf16_t*)(ws + WS_ACTM); P.Wt = (const bf16_t*)(ws + WS_WMD); P.ypair = (bf16_t*)(ws + WS_YPAIR); P.partk = (float*)(ws + WS_PARTK);
                    gemm_phase(lds, P);
                }
                END_STEP;
                if (IN_STEP) phase_combine(p, chunk);
                END_STEP;
            }
            if (IN_STEP) {
                ProgPle P; P.S.init(TC / 256, 4, G, cid); P.xb = xb; P.wpg = (const bf16_t*)(ws + WS_WPG) + (size_t)layer * D * D; P.pp = (const bf16_t*)(ws + WS_PP); P.ssq = ssq;
                P.xbout = (bf16_t*)(ws + WS_XB2); P.ssqout = (float*)(ws + WS_SSQ2);
                gemm_phase(lds, P);
            }
            END_STEP;
        }
        if (IN_STEP) phase_final(p, chunk);
        END_STEP;
    }
    if (TPROBE_MASK != 0u && blockIdx.x == 0 && threadIdx.x == 0) { const unsigned long long tsum_ = *(volatile LAS unsigned long long*)(lds + LDS_BYTES - 256 + 128); const unsigned long long t0_ = __builtin_amdgcn_s_memrealtime(); while (__builtin_amdgcn_s_memrealtime() - t0_ < 4ull * tsum_) __builtin_amdgcn_s_sleep(16); }
#undef IN_STEP
#undef END_STEP
}

#if defined(DBG_REP_STEP)
__global__ void dbg_csum(const unsigned* buf, size_t n, unsigned long long* out) {
    unsigned long long a = 0;
    for (size_t i = (size_t)blockIdx.x * 256 + threadIdx.x; i < n; i += (size_t)gridDim.x * 256) a += (unsigned long long)buf[i] * (unsigned long long)((i % 1021) + 1);
    atomicAdd(out, a);
}
__global__ void dbg_verdict(float* out, const unsigned long long* cs, int R) {
    bool bad = false; for (int r = 1; r < R; ++r) bad = bad || (cs[r] != cs[0]);
    const float v = bad ? __builtin_nanf("") : 0.f; const size_t n = (size_t)BATCH * SEQ * D;
    for (size_t i = (size_t)blockIdx.x * 256 + threadIdx.x; i < n; i += (size_t)gridDim.x * 256) out[i] = v;
}
#endif
#if defined(DBG_STOP)
#ifndef DBG_DUMP
#define DBG_DUMP 0
#define DBG_DUMP_OFF 0
#endif
__global__ void dbg_fill(float* out, const unsigned short* buf, int dump) {
    const size_t n = (size_t)BATCH * SEQ * D, c0 = (size_t)TC * D;
    for (size_t i = (size_t)blockIdx.x * 256 + threadIdx.x; i < n; i += (size_t)gridDim.x * 256) {
        if (i >= c0) out[i] = 0.f; else if (dump) out[i] = __uint_as_float(((unsigned)buf[i]) << 16);
    }
}
#endif
extern "C" void kernel_launch(void* const* d_in, const int* in_sizes, int n_in, void* d_out, int out_size, void* d_ws, size_t ws_size, hipStream_t stream) {
    static int grid = 0;
    if (grid == 0) {
        if (n_in != 30 || out_size != BATCH * SEQ * D || ws_size < WS_END) { fprintf(stderr, "kernel_launch: unexpected shapes (n_in %d, out %d, ws %zu < %zu)\n", n_in, out_size, ws_size, (size_t)WS_END); grid = -1; return; }
        int dev = 0, cus = 0;
        if (hipGetDevice(&dev) != hipSuccess || hipDeviceGetAttribute(&cus, hipDeviceAttributeMultiprocessorCount, dev) != hipSuccess) { grid = -1; return; }
        if (hipFuncSetAttribute((const void*)hybrid_fwd, hipFuncAttributeMaxDynamicSharedMemorySize, LDS_BYTES) != hipSuccess) { fprintf(stderr, "kernel_launch: hipFuncSetAttribute failed\n"); grid = -1; return; }
        int per_cu = 0;
        if (hipOccupancyMaxActiveBlocksPerMultiprocessor(&per_cu, (const void*)hybrid_fwd, 512, LDS_BYTES) != hipSuccess || per_cu < 1) { fprintf(stderr, "kernel_launch: occupancy query says %d\n", per_cu); }
        (void)hipGetLastError();
        grid = cus;
    }
    if (grid < 0) return;
    (void)hipMemsetAsync((char*)d_ws + WS_CTL, 0, MiB, stream);
    Params p{};
    for (int i = 0; i < 30; ++i) p.in[i] = (const float*)d_in[i];
    p.out = (float*)d_out; p.ws = (unsigned char*)d_ws; p.tmask = TPROBE_MASK; p.pad = 0;
#if defined(DBG_REP_STEP)
    for (int s = 0; s < DBG_REP_STEP; ++s) { p.s_lo = s; p.s_hi = s + 1; hipLaunchKernelGGL(hybrid_fwd, dim3(grid), dim3(512), LDS_BYTES, stream, p); }
    unsigned long long* cs = (unsigned long long*)((char*)d_ws + WS_CTL + 512 * 1024);
    for (int r = 0; r < DBG_REP_N; ++r) { p.s_lo = DBG_REP_STEP; p.s_hi = DBG_REP_STEP + 1; hipLaunchKernelGGL(hybrid_fwd, dim3(grid), dim3(512), LDS_BYTES, stream, p);
        hipLaunchKernelGGL(dbg_csum, dim3(1024), dim3(256), 0, stream, (const unsigned*)((const char*)d_ws + DBG_REP_OFF), (size_t)(DBG_REP_BYTES) / 4, cs + r); }
    hipLaunchKernelGGL(dbg_verdict, dim3(2048), dim3(256), 0, stream, (float*)d_out, cs, (int)DBG_REP_N);
#elif defined(DBG_STOP)
    for (int s = 0; s < DBG_STOP; ++s) { p.s_lo = s; p.s_hi = s + 1; hipLaunchKernelGGL(hybrid_fwd, dim3(grid), dim3(512), LDS_BYTES, stream, p); }
    hipLaunchKernelGGL(dbg_fill, dim3(2048), dim3(256), 0, stream, (float*)d_out, (const unsigned short*)((const char*)d_ws + DBG_DUMP_OFF), (int)DBG_DUMP);
#elif ONE_LAUNCH
    p.s_lo = 0; p.s_hi = NSTEPS;
    hipLaunchKernelGGL(hybrid_fwd, dim3(grid), dim3(512), LDS_BYTES, stream, p);
#else
    for (int s = 0; s < NSTEPS; ++s) { p.s_lo = s; p.s_hi = s + 1; hipLaunchKernelGGL(hybrid_fwd, dim3(grid), dim3(512), LDS_BYTES, stream, p); }
#endif
}
```

```cpp
#include <hip/hip_runtime.h>
#include <cstdio>
#include <cstdint>

#define GAS __attribute__((address_space(1)))
#define LAS __attribute__((address_space(3)))
typedef unsigned short bf16_t;
typedef short bf16x8 __attribute__((ext_vector_type(8)));
typedef float f32x4 __attribute__((ext_vector_type(4)));
typedef float f32x2 __attribute__((ext_vector_type(2)));
typedef unsigned u32x4 __attribute__((ext_vector_type(4)));
typedef unsigned u32x2 __attribute__((ext_vector_type(2)));

#ifndef REP_PH
#define REP_PH -1
#endif
#ifndef EMU_FP8
#define EMU_FP8 0
#endif
#ifndef TPROBE_MASK
#define TPROBE_MASK 0u
#endif
#define TPROBE_ON (TPROBE_MASK != 0u)
#ifndef TPROBE_PAD
#define TPROBE_PAD 0
#endif
#define TSUB(b) do { if (TPROBE_ON && threadIdx.x == 0 && (int)blockIdx.x == (p.pad & 0xffff)) { volatile LAS unsigned long long* ts_ = (volatile LAS unsigned long long*)(lds + LDS_BYTES - 256 + 128); \
        const unsigned long long tn_ = __builtin_amdgcn_s_memrealtime(); if ((p.pad >> (16 + (b))) & 1) ts_[0] += tn_ - ts_[3]; ts_[3] = tn_; } } while (0)
#ifndef MIX2_PROBE
#define MIX2_PROBE 0
#endif
#ifndef DBG_ABL
#define DBG_ABL 0
#endif
#ifndef ONE_LAUNCH
#define ONE_LAUNCH 1
#endif

constexpr int D = 1024, BATCH = 32, SEQ = 2048, DEPTH = 2;
constexpr int PLE = 256;
constexpr float EPS = 1e-6f;
constexpr int FFN = 2816, NE = 8, EXD = 3584;
constexpr int C_DNZ = 2304, C_DNA = 3072, C_DNB = 3078, C_XBC = 3084, C_SSZ = 4364, C_SSDT = 5132, C_ATT = 5144, C_GATE = 7448, INW = 10520;
constexpr int NB = 8, TC = NB * SEQ, NCH = BATCH / NB;
constexpr int INP = 10752;
constexpr int MOE_SLOTS = 2 * TC + NE * 256;

constexpr size_t MiB = 1u << 20;
constexpr size_t WS_CTL = 0;
constexpr size_t WS_WIN = 1 * MiB;
constexpr size_t WS_WDN = WS_WIN + 42 * MiB;
constexpr size_t WS_WSSM = WS_WDN + 3 * MiB;
constexpr size_t WS_WATT = WS_WSSM + 3 * MiB;
constexpr size_t WS_WOUT = WS_WATT + 1 * MiB;
constexpr size_t WS_WFGU = WS_WOUT + 4 * MiB;
constexpr size_t WS_WFD = WS_WFGU + 11 * MiB;
constexpr size_t WS_WMGU = WS_WFD + 6 * MiB;
constexpr size_t WS_WMD = WS_WMGU + 112 * MiB;
constexpr size_t WS_WPG = WS_WMD + 56 * MiB;
constexpr size_t WS_WPLE = WS_WPG + 4 * MiB;
constexpr size_t WS_WR = WS_WPLE + 1 * MiB;
constexpr size_t WS_ACT0 = WS_WR + 1 * MiB;
constexpr size_t WS_XB = WS_ACT0;
constexpr size_t WS_SSQ = WS_XB + 32 * MiB;
constexpr size_t WS_PB = WS_SSQ + 1 * MiB;
constexpr size_t WS_ROUTE = WS_PB + 16 * MiB;
constexpr size_t WS_PART = WS_ROUTE + 1 * MiB;
constexpr size_t WS_PP = WS_PART;
constexpr size_t WS_MERGED = WS_PART + 64 * MiB;
constexpr size_t WS_Y = WS_MERGED + 32 * MiB;
constexpr size_t WS_YDN = WS_Y, WS_YSSM = WS_Y + 24 * MiB, WS_YATT = WS_Y + 48 * MiB, WS_OG = WS_Y + 56 * MiB, WS_LSE = WS_Y + 80 * MiB;
constexpr size_t WS_YPAIR = WS_Y;
constexpr size_t WS_PROJ = WS_Y + 81 * MiB;
constexpr size_t WS_PDN = WS_PROJ, WS_PSSM = WS_PDN + 96 * MiB, WS_SMALL = WS_PSSM + 64 * MiB, WS_QK = WS_SMALL + 2 * MiB, WS_VT = WS_QK + 48 * MiB, WS_GATES = WS_VT + 24 * MiB;
constexpr size_t WS_ACT = WS_PROJ, WS_ACTM = WS_PROJ;
constexpr int KSPL = 7, TAILMAX = 32;
constexpr size_t WS_PARTK = WS_PROJ + 256 * MiB;
static_assert((size_t)MOE_SLOTS * EXD * 2 <= 256 * MiB && WS_PARTK + (size_t)KSPL * (TAILMAX / 4) * 256 * 1024 * 4 <= WS_PROJ + 330 * MiB, "partk");
constexpr size_t WS_SCR = WS_PROJ + 330 * MiB;
constexpr size_t WS_XB2 = WS_SCR;
constexpr size_t WS_SSQ2 = WS_XB2 + 32 * MiB;
constexpr size_t WS_PART2 = WS_XB2 + 40 * MiB;
constexpr int DNS_ITEM = 73728;
constexpr size_t WS_DNS = WS_SCR + 40 * MiB;
constexpr size_t WS_DNEGL = WS_DNS + (size_t)NB * 32 * 6 * DNS_ITEM;
constexpr size_t WS_END = WS_SCR + 200 * MiB;
constexpr size_t WS_SSCD = WS_DNEGL + 8192;
static_assert(WS_SSCD + 16384 <= WS_END, "dn scratch");
constexpr size_t WS_SSPV = WS_SCR + 150 * MiB;
static_assert(WS_SSCD + 16384 <= WS_SSPV && WS_SSPV + 48 * MiB <= WS_END, "ssd prev");
constexpr size_t WS_SSST = WS_PART + 48 * MiB;
static_assert(WS_MERGED == WS_PART + 64 * MiB && (size_t)NB * 32 * 12 * 8192 * 2 <= 48 * MiB, "ssd states (bf16) sit in PART[48, 64) | MERGED, both idle during the mixers");
static_assert((size_t)MOE_SLOTS * EXD * 2 <= 330 * MiB, "moe act overlay");
static_assert((size_t)MOE_SLOTS * D * 2 <= 81 * MiB, "ypair overlay");
static_assert(WS_END <= 1024 * MiB, "workspace");
constexpr int RT_TOPE = 0, RT_TOPP = 2 * TC, RT_TOPW = 4 * TC, RT_TOPS = 6 * TC, RT_IDX = 8 * TC;
static_assert((size_t)(RT_IDX + MOE_SLOTS) * 4 <= MiB, "route");
constexpr int CW_BAR = 4096;
constexpr int CW_BAR2 = 8192;
constexpr int CW_SUB = 20480;
constexpr int CW_CNT = 16384;

constexpr int LDS_BYTES = 147456;
__device__ __forceinline__ int htid() { int t = threadIdx.x; asm volatile("" : "+v"(t)); return t; }
__device__ __forceinline__ float bf2f(bf16_t b) { return __uint_as_float(((unsigned)b) << 16); }
__device__ __forceinline__ unsigned f2bf(float f) { unsigned u = __float_as_uint(f); return (u + 0x7fffu + ((u >> 16) & 1u)) >> 16; }
typedef __bf16 bf16x2_t __attribute__((ext_vector_type(2)));
__device__ __forceinline__ unsigned pk2(float lo, float hi) { const f32x2 v = {lo, hi}; return __builtin_bit_cast(unsigned, __builtin_convertvector(v, bf16x2_t)); }
#define ST2_BF(PA, PB, A, B) do { const unsigned pw_ = pk2((A), (B)); *(PA) = (bf16_t)(pw_ & 0xffffu); *(PB) = (bf16_t)(pw_ >> 16); } while (0)
__device__ __forceinline__ float lo_bf(unsigned w) { return __uint_as_float(w << 16); }
__device__ __forceinline__ float hi_bf(unsigned w) { return __uint_as_float(w & 0xffff0000u); }
__device__ __forceinline__ float fexp(float x) { return __builtin_amdgcn_exp2f(x * 1.4426950408889634f); }
__device__ __forceinline__ float sigmoidf_(float x) { return __builtin_amdgcn_rcpf(1.f + fexp(-x)); }
__device__ __forceinline__ float siluf_(float x) { return x * sigmoidf_(x); }
__device__ __forceinline__ float softplusf_(float x) { const float e = fexp(x); return x > 20.f ? x : (x < -9.f ? e : __builtin_amdgcn_logf(1.f + e) * 0.6931471805599453f); }
__device__ __forceinline__ float q8(float v) {
    if (!EMU_FP8) return v;
    const float a = fabsf(v); float r;
    if (a < 0.015625f) r = rintf(a * 512.f) * (1.f / 512.f);
    else { unsigned u = __float_as_uint(a); u += 0x7FFFFu + ((u >> 20) & 1u); u &= ~0xFFFFFu; r = fminf(__uint_as_float(u), 448.f); }
    return copysignf(r, v);
}
__device__ __forceinline__ f32x4 q8v(f32x4 v) { return (f32x4){q8(v[0]), q8(v[1]), q8(v[2]), q8(v[3])}; }
__device__ __forceinline__ float wave_sum(float v) {
#pragma unroll
    for (int o = 1; o < 64; o <<= 1) v += __shfl_xor(v, o);
    return v;
}
__device__ __forceinline__ float wave_max(float v) {
#pragma unroll
    for (int o = 1; o < 64; o <<= 1) v = fmaxf(v, __shfl_xor(v, o));
    return v;
}
__device__ __forceinline__ float rstd_of(const float* ssq, int row) {
    const f32x4* p = (const f32x4*)(ssq + (size_t)row * 16);
    const f32x4 a = p[0], b = p[1], c = p[2], d = p[3];
    const float s = (((a.x + a.y) + (a.z + a.w)) + ((b.x + b.y) + (b.z + b.w))) + (((c.x + c.y) + (c.z + c.w)) + ((d.x + d.y) + (d.z + d.w)));
    return rsqrtf(s * (1.f / 1024.f) + EPS);
}
__device__ __forceinline__ int token_of_pos(int d, int p) {
    const int b = p >> 11, q = p & 2047;
    const int t = (d == 1) ? q : (d == 4) ? (4 * (q & 511) + (q >> 9)) : (16 * (q & 127) + (q >> 7));
    return b * 2048 + t;
}

#define XB_TMO      128
#define XB_XCNT(j)  (256  + 64 * (j))
#define XB_XSUB(j)  (1280 + 64 * (j))
#define XB_XGEN(j)  (2304 + 64 * (j))
#define XB_TOP      3328
#define XB_TOPGEN   3392
#define XCD_BAR_WORDS 3456
#define XB_SPIN_CAP (1u << 22)
__device__ __forceinline__ unsigned xb_ld(unsigned* p)              { return __hip_atomic_load(p, __ATOMIC_RELAXED, __HIP_MEMORY_SCOPE_AGENT); }
__device__ __forceinline__ unsigned xb_add(unsigned* p, unsigned v) { return __hip_atomic_fetch_add(p, v, __ATOMIC_RELAXED, __HIP_MEMORY_SCOPE_AGENT); }
__device__ __forceinline__ unsigned xb_xcc_id() { return (unsigned)__builtin_amdgcn_s_getreg((3 << 11) | 20) & 0xFu; }
#define XB_SPIN(cond, bar) do { unsigned _sp = 0; while (cond) { __builtin_amdgcn_s_sleep(1); \
    if ((++_sp & 255u) == 0u) { if (xb_ld(&(bar)[XB_TMO])) break; if (_sp > XB_SPIN_CAP) { atomicAdd(&(bar)[XB_TMO], 1u); break; } } } } while (0)
struct XcdBarrier { unsigned* bar; unsigned x; volatile LAS unsigned* st; };
__device__ __forceinline__ XcdBarrier xcd_barrier_post(unsigned* bar, volatile LAS unsigned* st) {
    XcdBarrier b; b.bar = bar; b.x = xb_xcc_id(); b.st = st;
    if (threadIdx.x == 0) (void)xb_add(&bar[XB_XCNT(b.x)], 1u);
    return b;
}
__device__ __forceinline__ void xcd_barrier_complete(unsigned* bar, unsigned x, unsigned& nloc, unsigned& nx, unsigned G) {
    unsigned sum, cnt, mine, sp = 0u;
    for (;;) {
        sum = 0u; cnt = 0u; mine = 0u;
#pragma unroll 1
        for (unsigned j = 0; j < 16; ++j) { const unsigned c = xb_ld(&bar[XB_XCNT(j)]); sum += c; cnt += (c > 0u) ? 1u : 0u; }
        mine = xb_ld(&bar[XB_XCNT(x)]);
        if (sum == G) break;
        __builtin_amdgcn_s_sleep(1);
        if ((++sp & 255u) == 0u) { if (xb_ld(&bar[XB_TMO])) break; if (sp > XB_SPIN_CAP) { atomicAdd(&bar[XB_TMO], 1u); break; } }
    }
    nloc = mine > 0u ? mine : 1u; nx = cnt > 0u ? cnt : 1u;
}
__device__ __forceinline__ void xcd_barrier(const XcdBarrier& b, unsigned nparts = 0u) {
    asm volatile("s_waitcnt vmcnt(0)" ::: "memory");
    __syncthreads();
    if (threadIdx.x == 0) {
        unsigned* bar = b.bar;
        __builtin_amdgcn_s_waitcnt(0);
        unsigned nloc = b.st[0], nx = b.st[1];
        if (nloc == 0u) { xcd_barrier_complete(bar, b.x, nloc, nx, nparts ? nparts : gridDim.x * gridDim.y * gridDim.z); b.st[0] = nloc; b.st[1] = nx; }
        const unsigned old = xb_add(&bar[XB_XSUB(b.x)], 1u);
        const unsigned gen = old / nloc;
        if (old + 1u == (gen + 1u) * nloc) {
            __builtin_amdgcn_fence(__ATOMIC_RELEASE, "agent");
            asm volatile("s_waitcnt vmcnt(0)" ::: "memory");
            const unsigned og = xb_add(&bar[XB_TOP], 1u);
            const unsigned tg = og / nx;
            if (og + 1u == (tg + 1u) * nx) xb_add(&bar[XB_TOPGEN], 1u);
            else XB_SPIN(xb_ld(&bar[XB_TOPGEN]) == tg, bar);
            __builtin_amdgcn_fence(__ATOMIC_ACQUIRE, "agent");
            xb_add(&bar[XB_XGEN(b.x)], 1u);
            asm volatile("s_waitcnt vmcnt(0)" ::: "memory");
        } else {
            XB_SPIN(xb_ld(&bar[XB_XGEN(b.x)]) == gen, bar);
            __builtin_amdgcn_fence(__ATOMIC_ACQUIRE, "agent");
            asm volatile("s_waitcnt vmcnt(0)" ::: "memory");
        }
    }
    __syncthreads();
}

constexpr int BM = 256, BK = 64, HALF = 128, HTB = HALF * BK * 2, STAGE_BYTES = 8 * HTB, NXCD = 8, WGM = 4;
__device__ __forceinline__ int lds_byte(int r, int c) { const int st = (r >> 4) * 2 + (c >> 5), rr = r & 15, cc = c & 31, ob = rr * 64 + cc * 2; return st * 1024 + (ob ^ (((ob >> 9) & 1) << 5)); }
__device__ __forceinline__ void stage_rc(int b, int& R, int& C) { const int st = b / 1024, sb = b % 1024, swz = sb ^ (((sb >> 9) & 1) << 5); R = (st >> 1) * 16 + swz / 64; C = (st & 1) * 32 + (swz % 64) / 2; }
__device__ __forceinline__ int perm32(int rho) { const int n = rho >> 4, i = rho & 15; return 8 * (i >> 2) + 4 * n + (i & 3); }

struct Unit { int pm, pn; };
struct StaticOrder {
    int nM, nN, nwg, G, c;
    __device__ __forceinline__ void init(int nM_, int nN_, int G_, int c_) { nM = nM_; nN = nN_; nwg = nM * nN; G = G_; c = c_; }
    __device__ __forceinline__ bool next(int i, Unit& u) const {
        const long L = (long)i * G + c; if (L >= nwg) return false;
        int wgid = (int)L; { const int q = nwg / NXCD, r = nwg % NXCD, xcd = wgid % NXCD, off = wgid / NXCD; wgid = (xcd < r ? xcd * (q + 1) : r * (q + 1) + (xcd - r) * q) + off; }
        const int nig = WGM * nN, gid = wgid / nig, fm = gid * WGM, gsz = (nM - fm) < WGM ? (nM - fm) : WGM;
        u.pm = fm + ((wgid % nig) % gsz); u.pn = (wgid % nig) / gsz; return true;
    }
};
struct GU { const char* A; const char* B; int lda, ldb, nt, mapA, mapB; const int* idx; int pm, pn, sub, aux; };
__device__ __forceinline__ unsigned row_off(int map, int RR, int ld, const int* idx) {
    int row;
    if (map == 0) row = RR;
    else if (map == 4) row = 4 * RR;
    else if (map == 16) row = 16 * (RR & 127) + (RR >> 7);
    else row = idx[RR];
    return (unsigned)row * (unsigned)ld;
}
template <class Prog>
__device__ __forceinline__ void gemm_phase(LAS unsigned char* lds, const Prog& P) {
    const int tid = htid(), wid = __builtin_amdgcn_readfirstlane(tid >> 6), lane = tid & 63, wr = wid >> 2, wc = wid & 3, fr = lane & 15, fq = lane >> 4;
    GU cur, nxt; int ui = 0;
    if (!P.unit(0, cur)) return;
    unsigned vA[4], vB[4];
#define G_SETV(u) do { int tz_ = threadIdx.x; asm volatile("" : "+v"(tz_)); int R0, C0, R1, C1; stage_rc(tz_ * 16, R0, C0); stage_rc(tz_ * 16 + 8192, R1, C1); \
        const int Rb0 = (R0 & ~31) + perm32(R0 & 31), Rb1 = (R1 & ~31) + perm32(R1 & 31); \
        vA[0] = row_off((u).mapA, R0, (u).lda, (u).idx) + C0 * 2; vA[1] = row_off((u).mapA, R1, (u).lda, (u).idx) + C1 * 2; \
        vA[2] = row_off((u).mapA, R0 + 128, (u).lda, (u).idx) + C0 * 2; vA[3] = row_off((u).mapA, R1 + 128, (u).lda, (u).idx) + C1 * 2; \
        vB[0] = row_off((u).mapB, Rb0, (u).ldb, nullptr) + C0 * 2; vB[1] = row_off((u).mapB, Rb1, (u).ldb, nullptr) + C1 * 2; \
        vB[2] = row_off((u).mapB, Rb0 + 128, (u).ldb, nullptr) + C0 * 2; vB[3] = row_off((u).mapB, Rb1 + 128, (u).ldb, nullptr) + C1 * 2; } while (0)
    G_SETV(cur);
    const unsigned ldsw = (unsigned)wid * 1024u;
    const int aoff = lds_byte(wr * 64 + fr, fq * 8), boff = lds_byte(wc * 32 + fr, fq * 8);
#define G_SA(b, h) (((b) * 2 + (h)) * HTB)
#define G_SB(b, h) ((4 + (b) * 2 + (h)) * HTB)
#define G_STAGE(bufoff, gbase, v, h) do { \
        __builtin_amdgcn_global_load_lds((const unsigned*)((gbase) + (v)[2 * (h)]), (LAS unsigned*)(lds + (bufoff) + ldsw), 16, 0, 0); \
        __builtin_amdgcn_global_load_lds((const unsigned*)((gbase) + (v)[2 * (h) + 1]), (LAS unsigned*)(lds + (bufoff) + ldsw + 8192), 16, 0, 0); } while (0)
#define G_LDA(dst, b, h) do { _Pragma("unroll") for (int m = 0; m < 4; ++m) _Pragma("unroll") for (int k = 0; k < 2; ++k) dst[m][k] = *(const LAS bf16x8*)(lds + G_SA(b, h) + aoff + m * 2048 + k * 1024); } while (0)
#define G_LDB(dst, b, h) do { _Pragma("unroll") for (int n = 0; n < 2; ++n) _Pragma("unroll") for (int k = 0; k < 2; ++k) dst[n][k] = *(const LAS bf16x8*)(lds + G_SB(b, h) + boff + n * 2048 + k * 1024); } while (0)
#define G_MMA(ai, bj, At, Bt) do { __builtin_amdgcn_s_setprio(1); _Pragma("unroll") for (int m = 0; m < 4; ++m) _Pragma("unroll") for (int n = 0; n < 2; ++n) _Pragma("unroll") for (int k = 0; k < 2; ++k) \
        acc[ai][bj][m][n] = __builtin_amdgcn_mfma_f32_16x16x32_bf16(Bt[n][k], At[m][k], acc[ai][bj][m][n], 0, 0, 0); __builtin_amdgcn_s_setprio(0); } while (0)
#define G_WAIT_V(n) asm volatile("s_waitcnt vmcnt(" #n ")" ::: "memory")
#define G_WAIT_L(n) asm volatile("s_waitcnt lgkmcnt(" #n ")" ::: "memory")
#define G_BAR __builtin_amdgcn_s_barrier()
#define G_SCHED __builtin_amdgcn_sched_barrier(0)
    f32x4 acc[2][2][4][2];
#pragma unroll
    for (int a = 0; a < 2; ++a)
#pragma unroll
        for (int b = 0; b < 2; ++b)
#pragma unroll
            for (int m = 0; m < 4; ++m)
#pragma unroll
                for (int n = 0; n < 2; ++n) acc[a][b][m][n] = (f32x4){0.f, 0.f, 0.f, 0.f};
    bf16x8 At[4][2], B0[2][2], B1[2][2];
    const char* cA = cur.A; const char* cB = cur.B;
    const size_t kstep = (size_t)(BK * 2);
    G_STAGE(G_SB(0, 0), cB, vB, 0); G_STAGE(G_SA(0, 0), cA, vA, 0); G_STAGE(G_SB(0, 1), cB, vB, 1); G_STAGE(G_SA(0, 1), cA, vA, 1);
    if (wr == 1) G_BAR;
    G_WAIT_V(4); G_BAR;
    G_STAGE(G_SB(1, 0), cB + kstep, vB, 0); G_STAGE(G_SA(1, 0), cA + kstep, vA, 0); G_STAGE(G_SB(1, 1), cB + kstep, vB, 1);
    G_WAIT_V(6); G_BAR;
    for (;;) {
        const bool has_next = P.unit(ui + 1, nxt);
        const char* nA = has_next ? nxt.A : cA; const char* nB = has_next ? nxt.B : cB;
        const int nt = cur.nt;
        for (int t = 0; t < nt; t += 2) {
            const bool last = (t == nt - 2);
            const char* a1 = cA + (size_t)(t + 1) * kstep;
            const char* a2 = last ? nA : cA + (size_t)(t + 2) * kstep; const char* b2 = last ? nB : cB + (size_t)(t + 2) * kstep;
            const char* a3 = a2 + kstep; const char* b3 = b2 + kstep;
            G_STAGE(G_SA(1, 1), a1, vA, 1);
            if (last && has_next) { G_SETV(nxt); }
            G_LDB(B0, 0, 0); G_SCHED; G_LDA(At, 0, 0);
            G_WAIT_L(8); G_BAR; G_WAIT_L(0); G_MMA(0, 0, At, B0); G_BAR; G_SCHED;
            G_LDB(B1, 0, 1); G_STAGE(G_SB(0, 0), b2, vB, 0);
            G_BAR; G_WAIT_L(0); G_MMA(0, 1, At, B1); G_BAR;
            G_LDA(At, 0, 1); G_STAGE(G_SA(0, 0), a2, vA, 0);
            G_BAR; G_WAIT_L(0); G_MMA(1, 0, At, B0); G_BAR; G_SCHED;
            G_STAGE(G_SB(0, 1), b2, vB, 1);
            G_WAIT_V(6); G_BAR; G_MMA(1, 1, At, B1); G_BAR;
            G_LDB(B0, 1, 0); G_SCHED; G_LDA(At, 1, 0); G_STAGE(G_SA(0, 1), a2, vA, 1);
            G_WAIT_L(8); G_BAR; G_WAIT_L(0); G_MMA(0, 0, At, B0); G_BAR; G_SCHED;
            G_LDB(B1, 1, 1); G_STAGE(G_SB(1, 0), b3, vB, 0);
            G_BAR; G_WAIT_L(0); G_MMA(0, 1, At, B1); G_BAR;
            G_LDA(At, 1, 1); G_STAGE(G_SA(1, 0), a3, vA, 0);
            G_BAR; G_WAIT_L(0); G_MMA(1, 0, At, B0); G_BAR; G_SCHED;
            G_STAGE(G_SB(1, 1), b3, vB, 1);
            G_WAIT_V(6); G_BAR; G_MMA(1, 1, At, B1); G_BAR;
        }
        { int tz_ = threadIdx.x; asm volatile("" : "+v"(tz_)); const int ln_ = tz_ & 63; P.epi(acc, cur, wr, wc, ln_ & 15, ln_ >> 4); }
        if (!has_next) break;
        if (!P.keep(cur))
#pragma unroll
        for (int a = 0; a < 2; ++a)
#pragma unroll
            for (int b = 0; b < 2; ++b)
#pragma unroll
                for (int m = 0; m < 4; ++m)
#pragma unroll
                    for (int n = 0; n < 2; ++n) acc[a][b][m][n] = (f32x4){0.f, 0.f, 0.f, 0.f};
        cur = nxt; cA = nA; cB = nB; ++ui;
    }
    G_WAIT_V(0);
    if (wr == 0) G_BAR;
    G_BAR;
#undef G_SETV
#undef G_SA
#undef G_SB
#undef G_STAGE
#undef G_LDA
#undef G_LDB
#undef G_MMA
#undef G_WAIT_V
#undef G_WAIT_L
#undef G_BAR
#undef G_SCHED
}

__device__ __forceinline__ void st_bf8(bf16_t* p, const f32x4 a, const f32x4 b) {
    u32x4 w; w.x = pk2(a[0], a[1]); w.y = pk2(a[2], a[3]); w.z = pk2(b[0], b[1]); w.w = pk2(b[2], b[3]);
    *(u32x4*)p = w;
}
__device__ __forceinline__ void ld_bf8(const bf16_t* p, f32x4& a, f32x4& b) {
    const u32x4 w = *(const u32x4*)p;
    a = (f32x4){lo_bf(w.x), hi_bf(w.x), lo_bf(w.y), hi_bf(w.y)}; b = (f32x4){lo_bf(w.z), hi_bf(w.z), lo_bf(w.w), hi_bf(w.w)};
}
__device__ __forceinline__ float sq8(const f32x4 a, const f32x4 b) { return ((a[0] * a[0] + a[1] * a[1]) + (a[2] * a[2] + a[3] * a[3])) + ((b[0] * b[0] + b[1] * b[1]) + (b[2] * b[2] + b[3] * b[3])); }

#define EPI_ROWS(ai, m) _Pragma("unroll") for (int ai = 0; ai < 2; ++ai) _Pragma("unroll") for (int m = 0; m < 4; ++m)
#define EPI_FENCE asm volatile("" ::: "memory")
#define EPI_SC(ai, m) __shfl((ai) ? r1_ : r0_, (m) * 16 + fr)

struct ProgIn {
    __device__ __forceinline__ bool keep(const GU&) const { return false; }
    StaticOrder S; const bf16_t* xb; const bf16_t* Wt; const float* ssq; unsigned char* wsb;
    const bf16_t* pb; const bf16_t* wple;
    __device__ __forceinline__ bool unit(int i, GU& u) const {
        Unit t;
        if (!S.next(i, t)) {
            const int rem = S.nwg % S.G, nfull = S.nwg / S.G, idle = rem == 0 ? S.G : S.G - rem, per = (256 + idle - 1) / idle;
            const int rk = rem == 0 ? S.c : S.c - rem, k = i - nfull;
            if (rk < 0 || k < 0 || k >= per) return false;
            const int pu = rk * per + k; if (pu >= 256) return false;
            u.pm = pu >> 2; u.pn = 64 + (pu & 3); u.sub = 0; u.aux = 0; u.nt = 4; u.idx = nullptr; u.lda = 512; u.ldb = 512; u.mapA = 0; u.mapB = 0;
            u.A = (const char*)pb + (size_t)(pu >> 2) * 256 * 512; u.B = (const char*)wple + (size_t)(pu & 3) * 256 * 512; return true;
        }
        u.pm = t.pm; u.pn = t.pn; u.sub = 0; u.aux = 0; u.nt = 16; u.idx = nullptr; u.lda = 2048; u.ldb = 2048;
        const char* w = (const char*)Wt + (size_t)t.pn * 256 * 2048;
        int g = 0; bool isvt = false;
        if (t.pn >= 20 && t.pn < 29) { g = (t.pn - 20) % 3; isvt = t.pn >= 26; }
        const int d = g == 0 ? 1 : (g == 1 ? 4 : 16);
        const int b = t.pm >> 3, tb = t.pm & 7;
        const int base = b * 2048 + (d == 1 ? 256 * tb : d == 4 ? 1024 * (tb & 1) + (tb >> 1) : 2 * tb);
        const char* x = (const char*)xb + (size_t)base * 2048;
        const int mapx = d == 1 ? 0 : d;
        if (!isvt) { u.A = x; u.mapA = mapx; u.B = w; u.mapB = 0; }
        else { u.A = w; u.mapA = 0; u.B = x; u.mapB = mapx; }
        return true;
    }
    __device__ __forceinline__ void epi(f32x4 (&acc)[2][2][4][2], const GU& u, int wr, int wc, int fr, int fq) const {
        const int pn = u.pn, pm = u.pm, rl0 = wr * 64 + fr, cl0 = wc * 32 + 8 * fq;
        if (pn >= 64) {
            EPI_ROWS(ai, m) { bf16_t* o = (bf16_t*)(wsb + WS_PP) + (size_t)(pm * 256 + ai * 128 + m * 16 + rl0) * 1024 + (pn - 64) * 256 + cl0;
#pragma unroll
                for (int bj = 0; bj < 2; ++bj) st_bf8(o + bj * 128, acc[ai][bj][m][0], acc[ai][bj][m][1]); }
            return;
        }
        if (pn >= 26 && pn < 29) {
            const int g = pn - 26, d = g == 0 ? 1 : (g == 1 ? 4 : 16), ln = fq * 16 + fr;
            const float rc = rstd_of(ssq, token_of_pos(d, pm * 256 + (ln >> 5) * 128 + wc * 32 + (ln & 31)));
            f32x4 s[2][2];
#pragma unroll
            for (int bj = 0; bj < 2; ++bj)
#pragma unroll
                for (int j = 0; j < 8; ++j) s[bj][j >> 2][j & 3] = __shfl(rc, bj * 32 + 8 * fq + j);
            EPI_ROWS(ai, m) { const int ch = ai * 128 + m * 16 + rl0; bf16_t* o = (bf16_t*)(wsb + WS_VT) + (size_t)(g * 256 + ch) * TC + pm * 256 + cl0;
#pragma unroll
                for (int bj = 0; bj < 2; ++bj) st_bf8(o + bj * 128, acc[ai][bj][m][0] * s[bj][0], acc[ai][bj][m][1] * s[bj][1]); }
            return;
        }
        int d = 1; if (pn >= 20 && pn < 26) { const int g = (pn - 20) % 3; d = g == 0 ? 1 : (g == 1 ? 4 : 16); }
        const float r0_ = rstd_of(ssq, token_of_pos(d, pm * 256 + fq * 16 + rl0)), r1_ = rstd_of(ssq, token_of_pos(d, pm * 256 + 128 + fq * 16 + rl0));
        if (pn < 20) {
            bf16_t* base = pn < 12 ? (bf16_t*)(wsb + WS_PDN) + pn * 256 : (bf16_t*)(wsb + WS_PSSM) + (pn - 12) * 256; const int ld = pn < 12 ? 3072 : 2048;
            EPI_ROWS(ai, m) { const int row = pm * 256 + ai * 128 + m * 16 + rl0; const float s = EPI_SC(ai, m); bf16_t* o = base + (size_t)row * ld + cl0;
#pragma unroll
                for (int bj = 0; bj < 2; ++bj) st_bf8(o + bj * 128, acc[ai][bj][m][0] * s, acc[ai][bj][m][1] * s); }
        } else if (pn < 26) {
            const int which = (pn - 20) / 3, g = (pn - 20) % 3; const float qs = which == 0 ? 0.125f : 1.f;
            bf16_t* base = (bf16_t*)(wsb + WS_QK) + (size_t)(which * 3 + g) * TC * 256;
            EPI_ROWS(ai, m) { const int p = pm * 256 + ai * 128 + m * 16 + rl0; const float s = EPI_SC(ai, m) * qs; bf16_t* o = base + (size_t)p * 256 + cl0;
#pragma unroll
                for (int bj = 0; bj < 2; ++bj) st_bf8(o + bj * 128, acc[ai][bj][m][0] * s, acc[ai][bj][m][1] * s); }
        } else if (pn < 41) {
            bf16_t* base = (bf16_t*)(wsb + WS_GATES) + (pn - 29) * 256;
            EPI_ROWS(ai, m) { const int row = pm * 256 + ai * 128 + m * 16 + rl0; const float s = EPI_SC(ai, m); bf16_t* o = base + (size_t)row * 3072 + cl0;
#pragma unroll
                for (int bj = 0; bj < 2; ++bj) { f32x4 a = acc[ai][bj][m][0] * s, b = acc[ai][bj][m][1] * s;
#pragma unroll
                    for (int j = 0; j < 4; ++j) { a[j] = sigmoidf_(a[j]); b[j] = sigmoidf_(b[j]); }
                    st_bf8(o + bj * 128, a, b); } }
        } else {
            EPI_ROWS(ai, m) { const int row = pm * 256 + ai * 128 + m * 16 + rl0; const float s = EPI_SC(ai, m);
                if (wc == 0) { float* o = (float*)(wsb + WS_SMALL) + (size_t)row * 32 + 8 * fq; *(f32x4*)o = acc[ai][0][m][0] * s; *(f32x4*)(o + 4) = acc[ai][0][m][1] * s; } }
        }
    }
};

struct ProgMerge {
    StaticOrder S; const bf16_t *wdn, *wssm, *watt; unsigned char* wsb;
    __device__ __forceinline__ bool keep(const GU& u) const { return u.sub < 2; }
    __device__ __forceinline__ bool unit(int i, GU& u) const {
        Unit t; if (!S.next(i / 3, t)) return false;
        const int sub = i % 3;
        u.pm = t.pm; u.pn = t.pn; u.sub = sub; u.aux = 0; u.idx = nullptr; u.mapA = 0; u.mapB = 0;
        if (sub < 2) { u.lda = 1536; u.ldb = 1536; u.nt = 12; u.A = (const char*)(wsb + (sub == 0 ? WS_YDN : WS_YSSM)) + (size_t)t.pm * 256 * 1536; u.B = (const char*)(sub == 0 ? wdn : wssm) + (size_t)t.pn * 256 * 1536; }
        else { u.lda = 512; u.ldb = 512; u.nt = 4; u.A = (const char*)(wsb + WS_YATT) + (size_t)t.pm * 256 * 512; u.B = (const char*)watt + (size_t)t.pn * 256 * 512; }
        return true;
    }
    __device__ __forceinline__ void epi(f32x4 (&acc)[2][2][4][2], const GU& u, int wr, int wc, int fr, int fq) const {
        const int rl0 = wr * 64 + fr, cl0 = wc * 32 + 8 * fq, sub = u.sub;
        const bf16_t* gp0 = (const bf16_t*)(wsb + WS_GATES) + (size_t)(u.pm * 256 + rl0) * 3072 + u.pn * 256 + cl0 + sub * 1024;
#pragma unroll
        for (int ai = 0; ai < 2; ++ai) {
            u32x4 gw[4][2], hw[4][2];
            if (sub < 2) {
#pragma unroll
                for (int m = 0; m < 4; ++m)
#pragma unroll
                    for (int bj = 0; bj < 2; ++bj) { const bf16_t* gp = gp0 + (size_t)(ai * 128 + m * 16) * 3072 + bj * 128; gw[m][bj] = *(const u32x4*)gp; hw[m][bj] = *(const u32x4*)(gp + 1024); }
            } else {
#pragma unroll
                for (int m = 0; m < 4; ++m)
#pragma unroll
                    for (int bj = 0; bj < 2; ++bj) { const bf16_t* gp = gp0 + (size_t)(ai * 128 + m * 16) * 3072 + bj * 128; gw[m][bj] = *(const u32x4*)gp; hw[m][bj] = gw[m][bj]; }
            }
#pragma unroll
            for (int m = 0; m < 4; ++m)
#pragma unroll
                for (int bj = 0; bj < 2; ++bj) { const int row = u.pm * 256 + ai * 128 + m * 16 + rl0, col = u.pn * 256 + bj * 128 + cl0;
                    f32x4 g0 = (f32x4){lo_bf(gw[m][bj].x), hi_bf(gw[m][bj].x), lo_bf(gw[m][bj].y), hi_bf(gw[m][bj].y)}, g1 = (f32x4){lo_bf(gw[m][bj].z), hi_bf(gw[m][bj].z), lo_bf(gw[m][bj].w), hi_bf(gw[m][bj].w)};
                    if ((DBG_ABL >> sub) & 1) { acc[ai][bj][m][0] = (f32x4){0.f, 0.f, 0.f, 0.f}; acc[ai][bj][m][1] = acc[ai][bj][m][0]; }
#pragma unroll
                    for (int j = 0; j < 4; ++j) { g0[j] = fmaxf(g0[j], 1e-8f); g1[j] = fmaxf(g1[j], 1e-8f); }
                    if (sub < 2) { const f32x4 h0 = (f32x4){lo_bf(hw[m][bj].x), hi_bf(hw[m][bj].x), lo_bf(hw[m][bj].y), hi_bf(hw[m][bj].y)}, h1 = (f32x4){lo_bf(hw[m][bj].z), hi_bf(hw[m][bj].z), lo_bf(hw[m][bj].w), hi_bf(hw[m][bj].w)};
#pragma unroll
                        for (int j = 0; j < 4; ++j) { acc[ai][bj][m][0][j] *= g0[j] * __builtin_amdgcn_rcpf(fmaxf(h0[j], 1e-8f)); acc[ai][bj][m][1][j] *= g1[j] * __builtin_amdgcn_rcpf(fmaxf(h1[j], 1e-8f)); } }
                    else st_bf8((bf16_t*)(wsb + WS_MERGED) + (size_t)row * 1024 + col, acc[ai][bj][m][0] * g0, acc[ai][bj][m][1] * g1); }
            EPI_FENCE;
        }
    }
};

struct ProgResid {
    __device__ __forceinline__ bool keep(const GU&) const { return false; }
    StaticOrder S; const bf16_t* A; int lda, nt; const bf16_t* Wt; int ldb; const float* xin_f; const bf16_t* xin_b; bf16_t* xb; float* ssq; float sc;
    __device__ __forceinline__ bool unit(int i, GU& u) const {
        Unit t; if (!S.next(i, t)) return false;
        u.pm = t.pm; u.pn = t.pn; u.sub = 0; u.aux = 0; u.idx = nullptr; u.mapA = 0; u.mapB = 0; u.lda = lda; u.ldb = ldb; u.nt = nt;
        u.A = (const char*)A + (size_t)t.pm * 256 * lda; u.B = (const char*)Wt + (size_t)t.pn * 256 * ldb; return true;
    }
    __device__ __forceinline__ void epi(f32x4 (&acc)[2][2][4][2], const GU& u, int wr, int wc, int fr, int fq) const {
        const int rl0 = wr * 64 + fr, cl0 = wc * 32 + 8 * fq;
#pragma unroll
        for (int ai = 0; ai < 2; ++ai) {
            f32x4 xv[4][2][2];
            if (xin_f) {
#pragma unroll
                for (int m = 0; m < 4; ++m)
#pragma unroll
                    for (int bj = 0; bj < 2; ++bj) { const size_t o = (size_t)(u.pm * 256 + ai * 128 + m * 16 + rl0) * 1024 + u.pn * 256 + bj * 128 + cl0; xv[m][bj][0] = *(const f32x4*)(xin_f + o); xv[m][bj][1] = *(const f32x4*)(xin_f + o + 4); }
            } else {
                u32x4 xw[4][2];
#pragma unroll
                for (int m = 0; m < 4; ++m)
#pragma unroll
                    for (int bj = 0; bj < 2; ++bj) xw[m][bj] = *(const u32x4*)(xin_b + (size_t)(u.pm * 256 + ai * 128 + m * 16 + rl0) * 1024 + u.pn * 256 + bj * 128 + cl0);
#pragma unroll
                for (int m = 0; m < 4; ++m)
#pragma unroll
                    for (int bj = 0; bj < 2; ++bj) { const u32x4 w = xw[m][bj]; xv[m][bj][0] = (f32x4){lo_bf(w.x), hi_bf(w.x), lo_bf(w.y), hi_bf(w.y)}; xv[m][bj][1] = (f32x4){lo_bf(w.z), hi_bf(w.z), lo_bf(w.w), hi_bf(w.w)}; }
            }
#pragma unroll
            for (int m = 0; m < 4; ++m) { const int row = u.pm * 256 + ai * 128 + m * 16 + rl0; float ss = 0.f;
#pragma unroll
                for (int bj = 0; bj < 2; ++bj) { const size_t o = (size_t)row * 1024 + u.pn * 256 + bj * 128 + cl0;
                    const f32x4 v0 = acc[ai][bj][m][0] * sc + xv[m][bj][0], v1 = acc[ai][bj][m][1] * sc + xv[m][bj][1];
                    st_bf8(xb + o, v0, v1); ss += sq8(v0, v1); }
                ss += __shfl_xor(ss, 16); ss += __shfl_xor(ss, 32);
                if (fq == 0) ssq[(size_t)row * 16 + u.pn * 4 + wc] = ss; }
            EPI_FENCE;
        }
    }
};

struct ProgFfnGu {
    __device__ __forceinline__ bool keep(const GU&) const { return false; }
    StaticOrder S; const bf16_t* xb; const bf16_t* Wt; const float* ssq; bf16_t* act;
    __device__ __forceinline__ bool unit(int i, GU& u) const {
        Unit t; if (!S.next(i, t)) return false;
        u.pm = t.pm; u.pn = t.pn; u.sub = 0; u.aux = 0; u.idx = nullptr; u.mapA = 0; u.mapB = 0; u.lda = 2048; u.ldb = 2048; u.nt = 16;
        u.A = (const char*)xb + (size_t)t.pm * 256 * 2048; u.B = (const char*)Wt + (size_t)t.pn * 256 * 2048; return true;
    }
    __device__ __forceinline__ void epi(f32x4 (&acc)[2][2][4][2], const GU& u, int wr, int wc, int fr, int fq) const {
        const int rl0 = wr * 64 + fr, cl0 = wc * 32 + 8 * fq;
        const float r0_ = rstd_of(ssq, u.pm * 256 + fq * 16 + rl0), r1_ = rstd_of(ssq, u.pm * 256 + 128 + fq * 16 + rl0);
        EPI_ROWS(ai, m) { const int row = u.pm * 256 + ai * 128 + m * 16 + rl0; const float s = EPI_SC(ai, m);
            f32x4 o[2];
#pragma unroll
            for (int n = 0; n < 2; ++n)
#pragma unroll
                for (int j = 0; j < 4; ++j) { const float g = acc[ai][0][m][n][j] * s, up = acc[ai][1][m][n][j] * s; o[n][j] = q8(siluf_(g) * up); }
            st_bf8(act + (size_t)row * FFN + u.pn * 128 + cl0, o[0], o[1]); }
    }
};

struct ProgPle {
    __device__ __forceinline__ bool keep(const GU&) const { return false; }
    StaticOrder S; const bf16_t *xb, *wpg, *pp; const float* ssq; bf16_t* xbout; float* ssqout;
    __device__ __forceinline__ bool unit(int i, GU& u) const {
        Unit t; if (!S.next(i, t)) return false;
        u.pm = t.pm; u.pn = t.pn; u.sub = 0; u.aux = 0; u.idx = nullptr; u.mapA = 0; u.mapB = 0; u.lda = 2048; u.ldb = 2048; u.nt = 16;
        u.A = (const char*)xb + (size_t)t.pm * 256 * 2048; u.B = (const char*)wpg + (size_t)t.pn * 256 * 2048; return true;
    }
    __device__ __forceinline__ void epi(f32x4 (&acc)[2][2][4][2], const GU& u, int wr, int wc, int fr, int fq) const {
        const int rl0 = wr * 64 + fr, cl0 = wc * 32 + 8 * fq; const float ps = (DBG_ABL & 32) ? 0.f : 1.f;
        const float r0_ = rstd_of(ssq, u.pm * 256 + fq * 16 + rl0), r1_ = rstd_of(ssq, u.pm * 256 + 128 + fq * 16 + rl0);
#pragma unroll
        for (int ai = 0; ai < 2; ++ai)
#pragma unroll
            for (int mh = 0; mh < 2; ++mh) {
                u32x4 xw[2][2], gw[2][2];
#pragma unroll
                for (int m2 = 0; m2 < 2; ++m2)
#pragma unroll
                    for (int bj = 0; bj < 2; ++bj) { const size_t o = (size_t)(u.pm * 256 + ai * 128 + (2 * mh + m2) * 16 + rl0) * 1024 + u.pn * 256 + bj * 128 + cl0;
                        xw[m2][bj] = *(const u32x4*)(xb + o); gw[m2][bj] = *(const u32x4*)(pp + o); }
#pragma unroll
                for (int m2 = 0; m2 < 2; ++m2) { const int m = 2 * mh + m2, row = u.pm * 256 + ai * 128 + m * 16 + rl0; const float sc = EPI_SC(ai, m); float ss = 0.f;
#pragma unroll
                    for (int bj = 0; bj < 2; ++bj) { const size_t o = (size_t)row * 1024 + u.pn * 256 + bj * 128 + cl0; const u32x4 w = gw[m2][bj], xq = xw[m2][bj];
                        const f32x4 p0 = (f32x4){lo_bf(w.x), hi_bf(w.x), lo_bf(w.y), hi_bf(w.y)}, p1 = (f32x4){lo_bf(w.z), hi_bf(w.z), lo_bf(w.w), hi_bf(w.w)};
                        const f32x4 x0 = (f32x4){lo_bf(xq.x), hi_bf(xq.x), lo_bf(xq.y), hi_bf(xq.y)}, x1 = (f32x4){lo_bf(xq.z), hi_bf(xq.z), lo_bf(xq.w), hi_bf(xq.w)};
                        f32x4 g0 = acc[ai][bj][m][0] * sc, g1 = acc[ai][bj][m][1] * sc;
#pragma unroll
                        for (int j = 0; j < 4; ++j) { g0[j] = sigmoidf_(g0[j]); g1[j] = sigmoidf_(g1[j]); }
                        const f32x4 v0 = x0 + p0 * ps * g0, v1 = x1 + p1 * ps * g1;
                        st_bf8(xbout + o, v0, v1); ss += sq8(v0, v1); }
                    ss += __shfl_xor(ss, 16); ss += __shfl_xor(ss, 32);
                    if (fq == 0) ssqout[(size_t)row * 16 + u.pn * 4 + wc] = ss; }
                EPI_FENCE;
            }
    }
};

struct MoeOrder {
    int tl[NE]; int nN, total, G, c;
    __device__ __forceinline__ void init(const unsigned* cnt, int nN_, int G_, int c_) {
        nN = nN_; G = G_; c = c_; int tt = 0;
#pragma unroll
        for (int e = 0; e < NE; ++e) { tl[e] = (int)((__builtin_amdgcn_readfirstlane(cnt[e]) + 255u) >> 8); tt += tl[e]; }
        total = tt * nN;
    }
    __device__ __forceinline__ bool next(int i, int& e, int& pml, int& pn, int& slot0) const {
        const long L = (long)i * G + c; if (L >= total) return false;
        int wgid = (int)L; { const int q = total / NXCD, r = total % NXCD, xcd = wgid % NXCD, off = wgid / NXCD; wgid = (xcd < r ? xcd * (q + 1) : r * (q + 1) + (xcd - r) * q) + off; }
        int ee = 0, ubase = 0, tbase = 0, nMe = tl[0], uacc = 0, tacc = 0;
#pragma unroll
        for (int k = 0; k < NE; ++k) { if (wgid >= uacc) { ee = k; ubase = uacc; tbase = tacc; nMe = tl[k]; } uacc += tl[k] * nN; tacc += tl[k]; }
        const int li = wgid - ubase, nig = WGM * nN, gid = li / nig, fm = gid * WGM, gsz = (nMe - fm) < WGM ? (nMe - fm) : WGM;
        pml = fm + ((li % nig) % gsz); pn = (li % nig) / gsz; e = ee; slot0 = (tbase + pml) * 256; return true;
    }
};
struct ProgMoeGu {
    __device__ __forceinline__ bool keep(const GU&) const { return false; }
    MoeOrder S; const bf16_t* xb; const bf16_t* Wt; const float* ssq; const int* idx; bf16_t* act;
    __device__ __forceinline__ bool unit(int i, GU& u) const {
        int e, pml, pn, slot0; if (!S.next(i, e, pml, pn, slot0)) return false;
        u.pm = slot0; u.pn = pn; u.sub = 0; u.aux = e; u.idx = idx + slot0; u.mapA = 99; u.mapB = 0; u.lda = 2048; u.ldb = 2048; u.nt = 16;
        u.A = (const char*)xb; u.B = (const char*)Wt + ((size_t)e * 7168 + (size_t)pn * 256) * 2048; return true;
    }
    __device__ __forceinline__ void epi(f32x4 (&acc)[2][2][4][2], const GU& u, int wr, int wc, int fr, int fq) const {
        const int rl0 = wr * 64 + fr, cl0 = wc * 32 + 8 * fq;
        const float r0_ = rstd_of(ssq, idx[u.pm + fq * 16 + rl0]), r1_ = rstd_of(ssq, idx[u.pm + 128 + fq * 16 + rl0]);
        EPI_ROWS(ai, m) { const int slot = u.pm + ai * 128 + m * 16 + rl0; const float s = EPI_SC(ai, m);
            f32x4 o[2];
#pragma unroll
            for (int n = 0; n < 2; ++n)
#pragma unroll
                for (int j = 0; j < 4; ++j) { const float g = acc[ai][0][m][n][j] * s, up = acc[ai][1][m][n][j] * s; o[n][j] = q8(siluf_(g) * up); }
            st_bf8(act + (size_t)slot * EXD + u.pn * 128 + cl0, o[0], o[1]); }
    }
};
struct MoeDownPlan { int ntiles, main, tail; };
__device__ __forceinline__ MoeDownPlan moe_down_plan(const unsigned* cnt, int G) {
    MoeDownPlan pl; int nt = 0;
#pragma unroll
    for (int e = 0; e < NE; ++e) nt += (int)((__builtin_amdgcn_readfirstlane(cnt[e]) + 255u) >> 8);
    const int U = 4 * nt; int tail = U % G; if (U < G || tail > TAILMAX) tail = 0;
    pl.ntiles = nt; pl.tail = tail; pl.main = U - tail; return pl;
}
struct ProgMoeDown {
    __device__ __forceinline__ bool keep(const GU&) const { return false; }
    int tl[NE]; MoeDownPlan pl; int G, c; const bf16_t* act; const bf16_t* Wt; bf16_t* ypair; float* partk;
    __device__ __forceinline__ void init(const unsigned* cnt, int G_, int c_) { G = G_; c = c_; pl = moe_down_plan(cnt, G_);
#pragma unroll
        for (int e = 0; e < NE; ++e) tl[e] = (int)((__builtin_amdgcn_readfirstlane(cnt[e]) + 255u) >> 8); }
    __device__ __forceinline__ bool unit(int i, GU& u) const {
        const long L = (long)i * G + c; int w, kp = -1;
        if (L < pl.main) { w = (int)L; const int q = pl.main / NXCD, r = pl.main % NXCD, xcd = w % NXCD, off = w / NXCD; w = (xcd < r ? xcd * (q + 1) : r * (q + 1) + (xcd - r) * q) + off; }
        else { const long s2 = L - pl.main; if (s2 >= (long)pl.tail * KSPL) return false; w = pl.main + (int)(s2 / KSPL); kp = (int)(s2 % KSPL); }
        const int tile = w >> 2, pn = w & 3; int e = 0, tacc = 0;
#pragma unroll
        for (int k = 0; k < NE; ++k) { if (tile >= tacc) e = k; tacc += tl[k]; }
        const int slot0 = tile * 256;
        u.pm = slot0; u.pn = pn; u.aux = e; u.idx = nullptr; u.mapA = 0; u.mapB = 0; u.lda = 7168; u.ldb = 7168;
        u.A = (const char*)act + (size_t)slot0 * 7168; u.B = (const char*)Wt + ((size_t)e * 1024 + (size_t)pn * 256) * 7168;
        if (kp < 0) { u.sub = 0; u.nt = 56; } else { u.sub = 1 + kp; u.nt = 8; u.A += kp * 1024; u.B += kp * 1024; }
        return true;
    }
    __device__ __forceinline__ void epi(f32x4 (&acc)[2][2][4][2], const GU& u, int wr, int wc, int fr, int fq) const {
        const int rl0 = wr * 64 + fr, cl0 = wc * 32 + 8 * fq;
        if (u.sub == 0) {
            EPI_ROWS(ai, m) { const int slot = u.pm + ai * 128 + m * 16 + rl0;
#pragma unroll
                for (int bj = 0; bj < 2; ++bj) st_bf8(ypair + (size_t)slot * 1024 + u.pn * 256 + bj * 128 + cl0, acc[ai][bj][m][0], acc[ai][bj][m][1]); }
        } else {
            float* pk = partk + ((size_t)(u.sub - 1) * (TAILMAX / 4) * 256 + (u.pm - (pl.main >> 2) * 256)) * 1024 + u.pn * 256 + cl0;
            EPI_ROWS(ai, m) { float* o = pk + (size_t)(ai * 128 + m * 16 + rl0) * 1024;
#pragma unroll
                for (int bj = 0; bj < 2; ++bj) { *(f32x4*)(o + bj * 128) = acc[ai][bj][m][0]; *(f32x4*)(o + bj * 128 + 4) = acc[ai][bj][m][1]; } }
        }
    }
};

struct Params { const float* in[30]; float* out; unsigned char* ws; int s_lo, s_hi; unsigned tmask; int pad; };
enum { I_X = 0, I_P, I_MIXN, I_WIN, I_DNCONV, I_DNALOG, I_DNDTB, I_DNNORM, I_SSCONV, I_SSCONVB, I_SSALOG, I_SSDTB, I_SSD, I_SSNORM, I_WBRDN, I_WBRSSM, I_WBRATT, I_WOUT, I_FFNN,
       I_WFG, I_WFU, I_WFD, I_WROUTER, I_WMG, I_WMU, I_WMD, I_PLEN, I_WPLE, I_WPLEG, I_FINALN };

template <class Map>
__device__ __forceinline__ void tr_job(const Map& map, int K, int N, bf16_t* WT, const float* gain, LAS float* scr, int lane, int gw, int NGW, float qs = 0.f) {
    const int nblk = N / 32, nitems = (K / 64) * nblk;
    for (int item = gw; item < nitems; item += NGW) {
        const int kb = item / nblk, nb = item % nblk, k0 = 64 * kb, n0 = 32 * nb;
        int ld = 0; const float* src = map(n0 + (lane & 31), ld);
#pragma unroll
        for (int i = 0; i < 32; ++i) { const int kk = 2 * i + (lane >> 5); float v = 0.f; if (src) { v = src[(size_t)(k0 + kk) * ld]; if (gain) v *= gain[k0 + kk]; if (EMU_FP8 && qs > 0.f) v = q8(v * qs) / qs; } scr[kk * 33 + (lane & 31)] = v; }
        asm volatile("s_waitcnt lgkmcnt(0)" ::: "memory");
        const int c = lane & 7;
#pragma unroll
        for (int j = 0; j < 4; ++j) { const int n = (lane >> 3) + 8 * j; const LAS float* s = scr + (8 * c) * 33 + n;
            u32x4 o; o.x = pk2(s[0 * 33], s[1 * 33]); o.y = pk2(s[2 * 33], s[3 * 33]); o.z = pk2(s[4 * 33], s[5 * 33]); o.w = pk2(s[6 * 33], s[7 * 33]);
            *(u32x4*)(WT + (size_t)(n0 + n) * K + k0 + 8 * c) = o; }
        asm volatile("s_waitcnt lgkmcnt(0)" ::: "memory");
    }
}
struct MapPlain { const float* W; int ld; __device__ __forceinline__ const float* operator()(int n, int& l) const { l = ld; return W + n; } };
struct MapIn { const float* W; __device__ __forceinline__ const float* operator()(int n, int& l) const { l = INW; const int tile = n >> 8, r = n & 255; int col;
        if (tile < 9) col = n; else if (tile < 12) col = C_DNZ + (n - 2304); else if (tile < 17) col = C_XBC + (n - 3072); else if (tile < 20) col = C_SSZ + (n - 4352);
        else if (tile < 29) col = C_ATT + (n - 5120); else if (tile < 41) col = C_GATE + (n - 7424);
        else { if (r < 6) col = C_DNA + r; else if (r < 12) col = C_DNB + (r - 6); else if (r < 24) col = C_SSDT + (r - 12); else return nullptr; }
        return W + col; } };
struct MapGu { const float* Wg; const float* Wu; int ld; __device__ __forceinline__ const float* operator()(int n, int& l) const { l = ld; const int tile = n >> 8, r = n & 255; return r < 128 ? Wg + tile * 128 + r : Wu + tile * 128 + (r - 128); } };

__device__ __forceinline__ void phase_convert(const Params& p, LAS unsigned char* lds) {
    const int tid_ = htid(), lane = tid_ & 63, wave = tid_ >> 6, G = gridDim.x;
    const int gw = blockIdx.x * 8 + wave, NGW = G * 8;
    LAS float* scr = (LAS float*)(lds + wave * 16384);
    unsigned char* ws = p.ws;
    for (int l = 0; l < DEPTH; ++l) {
        tr_job(MapIn{p.in[I_WIN] + (size_t)l * D * INW}, D, INP, (bf16_t*)(ws + WS_WIN) + (size_t)l * INP * D, p.in[I_MIXN] + l * D, scr, lane, gw, NGW);
        tr_job(MapPlain{p.in[I_WBRDN] + (size_t)l * 768 * D, D}, 768, D, (bf16_t*)(ws + WS_WDN) + (size_t)l * D * 768, nullptr, scr, lane, gw, NGW);
        tr_job(MapPlain{p.in[I_WBRSSM] + (size_t)l * 768 * D, D}, 768, D, (bf16_t*)(ws + WS_WSSM) + (size_t)l * D * 768, nullptr, scr, lane, gw, NGW);
        tr_job(MapPlain{p.in[I_WBRATT] + (size_t)l * 256 * D, D}, 256, D, (bf16_t*)(ws + WS_WATT) + (size_t)l * D * 256, nullptr, scr, lane, gw, NGW);
        tr_job(MapPlain{p.in[I_WOUT] + (size_t)l * D * D, D}, D, D, (bf16_t*)(ws + WS_WOUT) + (size_t)l * D * D, nullptr, scr, lane, gw, NGW);
        tr_job(MapPlain{p.in[I_WPLEG] + (size_t)l * D * D, D}, D, D, (bf16_t*)(ws + WS_WPG) + (size_t)l * D * D, p.in[I_PLEN] + l * D, scr, lane, gw, NGW);
        tr_job(MapPlain{p.in[I_WPLE] + (size_t)l * PLE * D, D}, PLE, D, (bf16_t*)(ws + WS_WPLE) + (size_t)l * D * PLE, nullptr, scr, lane, gw, NGW);
    }
    tr_job(MapGu{p.in[I_WFG], p.in[I_WFU], FFN}, D, 2 * FFN, (bf16_t*)(ws + WS_WFGU), p.in[I_FFNN], scr, lane, gw, NGW, 16.f);
    tr_job(MapPlain{p.in[I_WFD], D}, FFN, D, (bf16_t*)(ws + WS_WFD), nullptr, scr, lane, gw, NGW, 16.f);
    for (int e = 0; e < NE; ++e) {
        tr_job(MapGu{p.in[I_WMG] + (size_t)e * D * EXD, p.in[I_WMU] + (size_t)e * D * EXD, EXD}, D, 2 * EXD, (bf16_t*)(ws + WS_WMGU) + (size_t)e * 2 * EXD * D, p.in[I_FFNN] + D, scr, lane, gw, NGW, 16.f);
        tr_job(MapPlain{p.in[I_WMD] + (size_t)e * EXD * D, D}, EXD, D, (bf16_t*)(ws + WS_WMD) + (size_t)e * D * EXD, nullptr, scr, lane, gw, NGW, 16.f);
    }
    float* wr = (float*)(ws + WS_WR);
    for (int i = blockIdx.x * 512 + tid_; i < D * NE; i += G * 512) wr[i] = p.in[I_WROUTER][i] * p.in[I_FFNN][D + (i >> 3)];
}

__device__ __forceinline__ void phase_chunk_in(const Params& p, int chunk) {
    const int tid_ = htid(), lane = tid_ & 63, gw = blockIdx.x * 8 + (tid_ >> 6), NGW = gridDim.x * 8;
    const float* x = p.in[I_X] + (size_t)chunk * TC * D;
    bf16_t* xb = (bf16_t*)(p.ws + WS_XB); float* ssq = (float*)(p.ws + WS_SSQ);
    for (int r0 = gw; r0 < TC; r0 += 2 * NGW) {
        f32x4 v[2][4];
#pragma unroll
        for (int u = 0; u < 2; ++u) { const int r = r0 + u * NGW < TC ? r0 + u * NGW : r0; const f32x4* xr = (const f32x4*)(x + (size_t)r * D) + lane;
#pragma unroll
            for (int j = 0; j < 4; ++j) v[u][j] = xr[64 * j]; }
#pragma unroll
        for (int u = 0; u < 2; ++u) { const int r = r0 + u * NGW; if (r >= TC) break; float s = 0.f; u32x2* o = (u32x2*)(xb + (size_t)r * D) + lane;
#pragma unroll
            for (int j = 0; j < 4; ++j) { const f32x4 t = v[u][j]; s += (t.x * t.x + t.y * t.y) + (t.z * t.z + t.w * t.w); u32x2 w; w.x = pk2(t.x, t.y); w.y = pk2(t.z, t.w); o[64 * j] = w; }
            s = wave_sum(s);
            if (lane < 16) ssq[(size_t)r * 16 + lane] = lane == 0 ? s : 0.f; }
    }
    bf16_t* pb = (bf16_t*)(p.ws + WS_PB);
    for (int r0 = gw; r0 < 2 * TC; r0 += 4 * NGW) {
        f32x4 v[4];
#pragma unroll
        for (int u = 0; u < 4; ++u) { const int r = r0 + u * NGW < 2 * TC ? r0 + u * NGW : r0; const int l = r / TC, rr = r % TC;
            v[u] = *((const f32x4*)(p.in[I_P] + ((size_t)l * BATCH * SEQ + (size_t)chunk * TC + rr) * PLE) + lane); }
#pragma unroll
        for (int u = 0; u < 4; ++u) { const int r = r0 + u * NGW; if (r >= 2 * TC) break; const int l = r / TC, rr = r % TC;
            u32x2 w; w.x = pk2(v[u].x, v[u].y); w.y = pk2(v[u].z, v[u].w); *((u32x2*)(pb + ((size_t)l * TC + rr) * PLE) + lane) = w; }
    }
}
__device__ __forceinline__ void phase_final(const Params& p, int chunk) {
    const int tid_ = htid(), lane = tid_ & 63, gw = blockIdx.x * 8 + (tid_ >> 6), NGW = gridDim.x * 8;
    float* out = p.out + (size_t)chunk * TC * D; const bf16_t* xs = (const bf16_t*)(p.ws + WS_XB2); const float* g = p.in[I_FINALN];
    for (int r0 = gw; r0 < TC; r0 += 2 * NGW) {
        u32x4 q[2][2];
#pragma unroll
        for (int u = 0; u < 2; ++u) { const int r = r0 + u * NGW < TC ? r0 + u * NGW : r0; const u32x4* xr = (const u32x4*)(xs + (size_t)r * D) + lane; q[u][0] = xr[0]; q[u][1] = xr[64]; }
#pragma unroll
        for (int u = 0; u < 2; ++u) { const int r = r0 + u * NGW; if (r >= TC) break; float s = 0.f; f32x4 v[4];
#pragma unroll
            for (int j = 0; j < 2; ++j) { const u32x4 w = q[u][j]; v[2 * j] = (f32x4){lo_bf(w.x), hi_bf(w.x), lo_bf(w.y), hi_bf(w.y)}; v[2 * j + 1] = (f32x4){lo_bf(w.z), hi_bf(w.z), lo_bf(w.w), hi_bf(w.w)};
                s += sq8(v[2 * j], v[2 * j + 1]); }
            const float rs = rsqrtf(wave_sum(s) * (1.f / D) + EPS);
#pragma unroll
            for (int j = 0; j < 2; ++j) { const int c = 8 * (lane + 64 * j); float* o = out + (size_t)r * D + c;
                *(f32x4*)o = v[2 * j] * rs * *(const f32x4*)(g + c); *(f32x4*)(o + 4) = v[2 * j + 1] * rs * *(const f32x4*)(g + c + 4); } }
    }
}
__device__ __forceinline__ void phase_router(const Params& p, LAS unsigned char* lds, int chunk) {
    const int tid_ = htid(), lane = tid_ & 63, gw = blockIdx.x * 8 + (tid_ >> 6), NGW = gridDim.x * 8;
    const bf16_t* x = (const bf16_t*)(p.ws + WS_XB); const float* wr = (const float*)(p.ws + WS_WR);
    int* rt = (int*)(p.ws + WS_ROUTE); unsigned* cnt = (unsigned*)(p.ws + WS_CTL) + CW_CNT + chunk * 64;
    LAS unsigned* lcnt = (LAS unsigned*)lds;
    f32x4 w[16][2];
#pragma unroll
    for (int j = 0; j < 2; ++j)
#pragma unroll
        for (int q = 0; q < 8; ++q) { const int k = 8 * (lane + 64 * j) + q; w[8 * j + q][0] = *(const f32x4*)(wr + k * 8); w[8 * j + q][1] = *(const f32x4*)(wr + k * 8 + 4); }
    const int nouter = (TC + 8 * NGW - 1) / (8 * NGW);
    for (int ob = 0; ob < nouter; ++ob) {
        if (tid_ < 16) lcnt[tid_] = 0u;
        __syncthreads();
        int pe[8]; unsigned pr[8];
#pragma unroll
        for (int jr = 0; jr < 8; ++jr) { const int r = gw + (ob * 8 + jr) * NGW; pe[jr] = 0; pr[jr] = 0u;
            if (r < TC) {
                const u32x4* xr = (const u32x4*)(x + (size_t)r * D) + lane; float s = 0.f; float lg[NE];
#pragma unroll
                for (int e = 0; e < NE; ++e) lg[e] = 0.f;
#pragma unroll
                for (int j = 0; j < 2; ++j) { const u32x4 xw = xr[64 * j]; const float v[8] = {lo_bf(xw.x), hi_bf(xw.x), lo_bf(xw.y), hi_bf(xw.y), lo_bf(xw.z), hi_bf(xw.z), lo_bf(xw.w), hi_bf(xw.w)};
#pragma unroll
                    for (int q = 0; q < 8; ++q) { s += v[q] * v[q]; const f32x4 w0 = w[8 * j + q][0], w1 = w[8 * j + q][1];
                        lg[0] += v[q] * w0.x; lg[1] += v[q] * w0.y; lg[2] += v[q] * w0.z; lg[3] += v[q] * w0.w; lg[4] += v[q] * w1.x; lg[5] += v[q] * w1.y; lg[6] += v[q] * w1.z; lg[7] += v[q] * w1.w; } }
                const float rs = rsqrtf(wave_sum(s) * (1.f / D) + EPS);
#pragma unroll
                for (int e = 0; e < NE; ++e) lg[e] = wave_sum(lg[e]) * rs;
                int i0 = 0; float l0 = lg[0];
#pragma unroll
                for (int e = 1; e < NE; ++e) if (lg[e] > l0) { l0 = lg[e]; i0 = e; }
                int i1 = -1; float l1 = -3.0e38f;
#pragma unroll
                for (int e = 0; e < NE; ++e) if (e != i0 && lg[e] > l1) { l1 = lg[e]; i1 = e; }
                if (lane < 2) { const int e = lane == 0 ? i0 : i1; const float w0 = 1.f / (1.f + expf(l1 - l0));
                    pe[jr] = e; pr[jr] = __hip_atomic_fetch_add(lcnt + e, 1u, __ATOMIC_RELAXED, __HIP_MEMORY_SCOPE_WORKGROUP);
                    rt[RT_TOPE + 2 * r + lane] = e; ((float*)rt)[RT_TOPW + 2 * r + lane] = lane == 0 ? w0 : 1.f - w0; }
            } }
        __syncthreads();
        if (tid_ < 8) lcnt[8 + tid_] = atomicAdd(cnt + tid_, lcnt[tid_]);
        __syncthreads();
#pragma unroll
        for (int jr = 0; jr < 8; ++jr) { const int r = gw + (ob * 8 + jr) * NGW; if (r < TC && lane < 2) rt[RT_TOPP + 2 * r + lane] = (int)(lcnt[8 + pe[jr]] + pr[jr]); }
        __syncthreads();
    }
}
__device__ __forceinline__ void phase_slots(const Params& p, int chunk) {
    int* rt = (int*)(p.ws + WS_ROUTE); const unsigned* cnt = (const unsigned*)(p.ws + WS_CTL) + CW_CNT + chunk * 64;
    int c[NE], off[NE + 1]; off[0] = 0;
#pragma unroll
    for (int e = 0; e < NE; ++e) { c[e] = (int)cnt[e]; off[e + 1] = off[e] + ((c[e] + 255) & ~255); }
    const int gt = blockIdx.x * 512 + htid(), NT = gridDim.x * 512;
    for (int i = gt; i < 2 * TC; i += NT) {
        const int e = rt[RT_TOPE + i], pos = rt[RT_TOPP + i]; int o = 0;
#pragma unroll
        for (int k = 0; k < NE; ++k) o = (e == k) ? off[k] : o;
        const int slot = o + pos; rt[RT_TOPS + i] = slot; rt[RT_IDX + slot] = i >> 1;
    }
    for (int s = gt; s < off[NE]; s += NT) {
        bool pad = false;
#pragma unroll
        for (int k = 0; k < NE; ++k) pad = pad || (s >= off[k] + c[k] && s < off[k + 1]);
        if (pad) rt[RT_IDX + s] = 0;
    }
}
__device__ __forceinline__ f32x4 moe_y4(const bf16_t* yp, const float* partk, int slot, int tail0, int col) {
    if (slot < tail0) { const u32x2 a = *(const u32x2*)(yp + (size_t)slot * D + col); return (f32x4){lo_bf(a.x), hi_bf(a.x), lo_bf(a.y), hi_bf(a.y)}; }
    f32x4 v = (f32x4){0.f, 0.f, 0.f, 0.f};
#pragma unroll
    for (int k = 0; k < KSPL; ++k) v += *(const f32x4*)(partk + ((size_t)k * (TAILMAX / 4) * 256 + (slot - tail0)) * 1024 + col);
    return v;
}
__device__ __forceinline__ void phase_combine(const Params& p, int chunk) {
    const int tid_ = htid(), lane = tid_ & 63, gw = blockIdx.x * 8 + (tid_ >> 6), NGW = gridDim.x * 8;
    const int* rt = (const int*)(p.ws + WS_ROUTE);
    const bf16_t* yp = (const bf16_t*)(p.ws + WS_YPAIR); const float* partk = (const float*)(p.ws + WS_PARTK); bf16_t* xb = (bf16_t*)(p.ws + WS_XB); float* ssq = (float*)(p.ws + WS_SSQ);
    const MoeDownPlan pl = moe_down_plan((const unsigned*)(p.ws + WS_CTL) + CW_CNT + chunk * 64, gridDim.x);
    const int tail0 = pl.tail > 0 ? (pl.main >> 2) * 256 : 0x7fffffff;
    for (int r0 = gw; r0 < TC; r0 += 4 * NGW) {
        int sl[4][2]; float wt[4][2];
#pragma unroll
        for (int u = 0; u < 4; ++u) { const int r = r0 + u * NGW < TC ? r0 + u * NGW : r0; sl[u][0] = rt[RT_TOPS + 2 * r]; sl[u][1] = rt[RT_TOPS + 2 * r + 1];
            wt[u][0] = (DBG_ABL & 16) ? 0.f : ((const float*)rt)[RT_TOPW + 2 * r]; wt[u][1] = (DBG_ABL & 16) ? 0.f : ((const float*)rt)[RT_TOPW + 2 * r + 1]; }
#pragma unroll
        for (int u = 0; u < 4; ++u) { const int r = r0 + u * NGW; if (r >= TC) break;
            u32x2* xr = (u32x2*)(xb + (size_t)r * D) + lane; float s = 0.f;
            f32x4 v[4], y0[4], y1[4]; u32x2 xq[4];
            if (sl[u][0] < tail0 && sl[u][1] < tail0) {
                const u32x2* a0 = (const u32x2*)(yp + (size_t)sl[u][0] * D) + lane; const u32x2* a1 = (const u32x2*)(yp + (size_t)sl[u][1] * D) + lane; u32x2 q0[4], q1[4];
#pragma unroll
                for (int j = 0; j < 4; ++j) { xq[j] = xr[64 * j]; q0[j] = a0[64 * j]; q1[j] = a1[64 * j]; }
#pragma unroll
                for (int j = 0; j < 4; ++j) { y0[j] = (f32x4){lo_bf(q0[j].x), hi_bf(q0[j].x), lo_bf(q0[j].y), hi_bf(q0[j].y)}; y1[j] = (f32x4){lo_bf(q1[j].x), hi_bf(q1[j].x), lo_bf(q1[j].y), hi_bf(q1[j].y)}; }
            } else {
#pragma unroll
                for (int j = 0; j < 4; ++j) { const int col = 4 * (lane + 64 * j); xq[j] = xr[64 * j]; y0[j] = moe_y4(yp, partk, sl[u][0], tail0, col); y1[j] = moe_y4(yp, partk, sl[u][1], tail0, col); }
            }
#pragma unroll
            for (int j = 0; j < 4; ++j) { v[j] = (f32x4){lo_bf(xq[j].x), hi_bf(xq[j].x), lo_bf(xq[j].y), hi_bf(xq[j].y)}; const f32x4 t = v[j] + wt[u][0] * y0[j] + wt[u][1] * y1[j];
                s += (t.x * t.x + t.y * t.y) + (t.z * t.z + t.w * t.w); u32x2 w; w.x = pk2(t.x, t.y); w.y = pk2(t.z, t.w); xr[64 * j] = w; }
            s = wave_sum(s);
            if (lane < 16) ssq[(size_t)r * 16 + lane] = lane == 0 ? s : 0.f; }
    }
}

#define LDS_BARRIER() do { asm volatile("s_waitcnt lgkmcnt(0)" ::: "memory"); __builtin_amdgcn_s_barrier(); asm volatile("" ::: "memory"); } while (0)
__device__ __forceinline__ f32x4 mfma16(const bf16x8 a, const bf16x8 b, const f32x4 c) { return __builtin_amdgcn_mfma_f32_16x16x32_bf16(a, b, c, 0, 0, 0); }
__device__ __forceinline__ void dn_prep(const Params& p, LAS unsigned char* lds, int layer, int b, int n, int h) {
    const int tid = htid(), lane = tid & 63, wave = tid >> 6;
    LAS unsigned char* QS = lds; LAS unsigned char* KS = lds + 17408; LAS unsigned char* VS = lds + 34816;
    LAS float* AM = (LAS float*)(lds + 52224);
    LAS float* SC = (LAS float*)(lds + 69632);
    const int t0 = n * 64;
    const bf16_t* proj = (const bf16_t*)(p.ws + WS_PDN) + (size_t)b * SEQ * 3072;
    unsigned char* item = p.ws + WS_DNS + (size_t)((b * 32 + n) * 6 + h) * DNS_ITEM;
    if (tid < 480) {
        const int cg = tid % 48, seg = tid / 48, part = cg >> 4, c8 = (cg & 15) * 8, col = part * 768 + h * 128 + c8;
        const float* cw = p.in[I_DNCONV] + (size_t)layer * 4 * 2304 + col;
        f32x4 w[4][2];
#pragma unroll
        for (int j = 0; j < 4; ++j) { w[j][0] = *(const f32x4*)(cw + j * 2304); w[j][1] = *(const f32x4*)(cw + j * 2304 + 4); }
        const int ts = seg * 7;
        f32x4 x[10][2];
#pragma unroll
        for (int i = 0; i < 10; ++i) { const int t = t0 + ts - 3 + i; x[i][0] = (f32x4){0.f, 0.f, 0.f, 0.f}; x[i][1] = x[i][0];
            if (t >= 0 && ts - 3 + i < 64) ld_bf8(proj + (size_t)t * 3072 + col, x[i][0], x[i][1]); }
        LAS unsigned char* dst = part == 0 ? QS : (part == 1 ? KS : VS);
#pragma unroll
        for (int i = 0; i < 7; ++i) { const int tk = ts + i;
            if (tk < 64) { f32x4 a0 = w[3][0] * x[i + 3][0] + w[2][0] * x[i + 2][0] + w[1][0] * x[i + 1][0] + w[0][0] * x[i][0];
                f32x4 a1 = w[3][1] * x[i + 3][1] + w[2][1] * x[i + 2][1] + w[1][1] * x[i + 1][1] + w[0][1] * x[i][1];
#pragma unroll
                for (int c = 0; c < 4; ++c) { a0[c] = siluf_(a0[c]); a1[c] = siluf_(a1[c]); }
                u32x4 pw; pw.x = pk2(a0[0], a0[1]); pw.y = pk2(a0[2], a0[3]); pw.z = pk2(a1[0], a1[1]); pw.w = pk2(a1[2], a1[3]);
                *(LAS u32x4*)(dst + tk * 272 + c8 * 2) = pw;
 } }
    } else {
        const float Aexp = expf(p.in[I_DNALOG][layer * 6 + h]), dtb = p.in[I_DNDTB][layer * 6 + h];
        const float* small = (const float*)(p.ws + WS_SMALL) + (size_t)b * SEQ * 32;
#pragma unroll
        for (int q = 0; q < 2; ++q) { const int tk = (tid - 480) * 2 + q; const float a = small[(size_t)(t0 + tk) * 32 + h], bb = small[(size_t)(t0 + tk) * 32 + 6 + h];
            SC[128 + tk] = sigmoidf_(bb); SC[192 + tk] = -Aexp * softplusf_(a + dtb); }
    }
    LDS_BARRIER();
    TSUB(8);
    {
        const int row = tid >> 3, sg = tid & 7; const u32x4 q0 = *(const LAS u32x4*)(QS + row * 272 + sg * 32), q1 = *(const LAS u32x4*)(QS + row * 272 + sg * 32 + 16), k0 = *(const LAS u32x4*)(KS + row * 272 + sg * 32), k1 = *(const LAS u32x4*)(KS + row * 272 + sg * 32 + 16);
        float sq = sq8((f32x4){lo_bf(q0.x), hi_bf(q0.x), lo_bf(q0.y), hi_bf(q0.y)}, (f32x4){lo_bf(q0.z), hi_bf(q0.z), lo_bf(q0.w), hi_bf(q0.w)}) + sq8((f32x4){lo_bf(q1.x), hi_bf(q1.x), lo_bf(q1.y), hi_bf(q1.y)}, (f32x4){lo_bf(q1.z), hi_bf(q1.z), lo_bf(q1.w), hi_bf(q1.w)});
        float sk = sq8((f32x4){lo_bf(k0.x), hi_bf(k0.x), lo_bf(k0.y), hi_bf(k0.y)}, (f32x4){lo_bf(k0.z), hi_bf(k0.z), lo_bf(k0.w), hi_bf(k0.w)}) + sq8((f32x4){lo_bf(k1.x), hi_bf(k1.x), lo_bf(k1.y), hi_bf(k1.y)}, (f32x4){lo_bf(k1.z), hi_bf(k1.z), lo_bf(k1.w), hi_bf(k1.w)});
        sq += __shfl_xor(sq, 1); sq += __shfl_xor(sq, 2); sq += __shfl_xor(sq, 4); sk += __shfl_xor(sk, 1); sk += __shfl_xor(sk, 2); sk += __shfl_xor(sk, 4);
        if (sg == 0) { SC[row] = sq; SC[64 + row] = sk; } }
    LDS_BARRIER();
    TSUB(9);
    if (wave == 0) {
        float g = SC[192 + lane];
#pragma unroll
        for (int o = 1; o < 64; o <<= 1) { const float t = __shfl_up(g, o); if (lane >= o) g += t; }
        SC[192 + lane] = g; SC[256 + lane] = expf(g); SC[320 + lane] = rsqrtf(SC[lane] + EPS); SC[384 + lane] = rsqrtf(SC[64 + lane] + EPS);
    }
    LDS_BARRIER();
    TSUB(10);
    {
        const int r = lane & 15, kg = lane >> 4;
        bf16x8 fa[4][4], fb[4][4];
#pragma unroll
        for (int q = 0; q < 4; ++q) { const int t = wave * 4 + q, which = t >> 4, mt = (t >> 2) & 3, nt = t & 3;
            const LAS unsigned char* A = (which == 0 ? KS : QS) + (16 * mt + r) * 272 + kg * 16; const LAS unsigned char* Bt = KS + (16 * nt + r) * 272 + kg * 16;
#pragma unroll
            for (int ks = 0; ks < 4; ++ks) { fa[q][ks] = *(const LAS bf16x8*)(A + ks * 64); fb[q][ks] = *(const LAS bf16x8*)(Bt + ks * 64); } }
#pragma unroll
        for (int q = 0; q < 4; ++q) { const int t = wave * 4 + q, which = t >> 4, mt = (t >> 2) & 3, nt = t & 3;
            f32x4 acc = (f32x4){0.f, 0.f, 0.f, 0.f};
#pragma unroll
            for (int ks = 0; ks < 4; ++ks) acc = mfma16(fa[q][ks], fb[q][ks], acc);
            const int j = 16 * nt + r; const float gj = SC[192 + j], rkj = SC[384 + j];
            float ov[4];
#pragma unroll
            for (int rr = 0; rr < 4; ++rr) { const int i = 16 * mt + 4 * kg + rr; const float e = fexp(fminf(SC[192 + i] - gj, 0.f));
                if (which == 0) AM[i * 68 + j] = (i > j) ? SC[128 + i] * SC[384 + i] * rkj * acc[rr] * e : 0.f;
                ov[rr] = (i >= j) ? SC[320 + i] * rkj * 0.08838834764831845f * acc[rr] * e : 0.f; }
            if (which != 0) { bf16_t* ao = (bf16_t*)(item + 32768) + (16 * mt + 4 * kg) * 64 + j; ST2_BF(ao, ao + 64, ov[0], ov[1]); ST2_BF(ao + 128, ao + 192, ov[2], ov[3]); }
        }
    }
    LDS_BARRIER();
    TSUB(11);
    if (tid < 256) {
        float x[64];
        if (tid < 128) {
#pragma unroll
            for (int i = 0; i < 64; ++i) x[i] = bf2f(*(const LAS bf16_t*)(KS + i * 272 + tid * 2)) * SC[384 + i] * SC[128 + i] * SC[256 + i];
        } else {
#pragma unroll
            for (int i = 0; i < 64; ++i) x[i] = bf2f(*(const LAS bf16_t*)(VS + i * 272 + (tid - 128) * 2)) * SC[128 + i];
        }
        f32x4 rw[2][16];
        rw[1][0] = *(const LAS f32x4*)(AM + 1 * 68);
#pragma unroll
        for (int i = 1; i < 64; ++i) {
            if (i + 1 < 64) {
#pragma unroll
                for (int k4 = 0; k4 < (i + 4) / 4; ++k4) rw[(i + 1) & 1][k4] = *(const LAS f32x4*)(AM + (i + 1) * 68 + 4 * k4);
            }
            float a4[4] = {x[i], 0.f, 0.f, 0.f};
#pragma unroll
            for (int k4 = 0; k4 < (i + 3) / 4; ++k4) { const f32x4 am = rw[i & 1][k4];
#pragma unroll
                for (int c = 0; c < 4; ++c) if (4 * k4 + c < i) a4[c] -= am[c] * x[4 * k4 + c]; }
            x[i] = (a4[0] + a4[1]) + (a4[2] + a4[3]); }
        if (tid < 128) { bf16_t* W = (bf16_t*)item;
#pragma unroll
            for (int i = 0; i < 64; i += 2) ST2_BF(W + i * 128 + tid, W + (i + 1) * 128 + tid, x[i], x[i + 1]);
        } else { u32x4* UT = (u32x4*)(item + 57344 + (size_t)(tid - 128) * 128);
#pragma unroll
            for (int c = 0; c < 8; ++c) { u32x4 w; w.x = pk2(x[8 * c], x[8 * c + 1]); w.y = pk2(x[8 * c + 2], x[8 * c + 3]); w.z = pk2(x[8 * c + 4], x[8 * c + 5]); w.w = pk2(x[8 * c + 6], x[8 * c + 7]); UT[c] = w; } }
    } else {
        const int u = tid - 256; const float glast = SC[192 + 63];
#pragma unroll
        for (int i = 0; i < 4; ++i) { const int q = u + 256 * i, c = q >> 4, d8 = (q & 15) * 8; f32x4 a0, a1;
            const u32x4 w = *(const LAS u32x4*)(QS + c * 272 + d8 * 2); const float sc = SC[320 + c] * 0.08838834764831845f * SC[256 + c];
            a0 = (f32x4){lo_bf(w.x), hi_bf(w.x), lo_bf(w.y), hi_bf(w.y)} * sc; a1 = (f32x4){lo_bf(w.z), hi_bf(w.z), lo_bf(w.w), hi_bf(w.w)} * sc;
            st_bf8((bf16_t*)(item + 16384) + c * 128 + d8, a0, a1); }
#pragma unroll
        for (int i = 0; i < 4; ++i) { const int q = u + 256 * i, d = q >> 3, c8 = (q & 7) * 8; float v[8];
#pragma unroll
            for (int c = 0; c < 8; ++c) v[c] = bf2f(*(const LAS bf16_t*)(KS + (c8 + c) * 272 + d * 2)) * SC[384 + c8 + c] * fexp(glast - SC[192 + c8 + c]);
            st_bf8((bf16_t*)(item + 40960) + d * 64 + c8, (f32x4){v[0], v[1], v[2], v[3]}, (f32x4){v[4], v[5], v[6], v[7]}); }
        if (u == 0) ((float*)(p.ws + WS_DNEGL))[(b * 32 + n) * 6 + h] = SC[256 + 63];
    }
    TSUB(12);
    {
        const float* ng = p.in[I_DNNORM] + layer * 128; bf16_t* ydn = (bf16_t*)(p.ws + WS_YDN) + ((size_t)b * SEQ + t0) * 768 + h * 128;
#pragma unroll
        for (int i = 0; i < 2; ++i) { const int q = tid + 512 * i, c = q >> 4, e8 = (q & 15) * 8; f32x4 z0, z1; ld_bf8(proj + (size_t)(t0 + c) * 3072 + 2304 + h * 128 + e8, z0, z1);
            const f32x4 g0 = *(const f32x4*)(ng + e8), g1 = *(const f32x4*)(ng + e8 + 4);
#pragma unroll
            for (int j = 0; j < 4; ++j) { z0[j] = g0[j] * siluf_(z0[j]); z1[j] = g1[j] * siluf_(z1[j]); }
            st_bf8(ydn + (size_t)c * 768 + e8, z0, z1); }
    }
    LDS_BARRIER();
    TSUB(13);
}
__device__ __forceinline__ float row16_sum(float v) {
    v += __builtin_bit_cast(float, __builtin_amdgcn_update_dpp(0, __builtin_bit_cast(int, v), 0xB1, 0xf, 0xf, false));
    v += __builtin_bit_cast(float, __builtin_amdgcn_update_dpp(0, __builtin_bit_cast(int, v), 0x4E, 0xf, 0xf, false));
    v += __builtin_bit_cast(float, __builtin_amdgcn_update_dpp(0, __builtin_bit_cast(int, v), 0x141, 0xf, 0xf, false));
    v += __builtin_bit_cast(float, __builtin_amdgcn_update_dpp(0, __builtin_bit_cast(int, v), 0x140, 0xf, 0xf, false));
    return v;
}
__device__ __forceinline__ void dn_scan(const Params& p, LAS unsigned char* lds, int layer, int b, int h) {
    const int tid = htid(), lane = tid & 63, wave = __builtin_amdgcn_readfirstlane(tid >> 6), r = lane & 15, kg = lane >> 4;
    LAS unsigned char* W = lds; LAS unsigned char* QD = lds + 17408; LAS unsigned char* ATT = lds + 34816; LAS unsigned char* KDT = lds + 44032; LAS unsigned char* UT = lds + 62464;
    LAS unsigned char* ST = lds + 80896; LAS unsigned char* VNT = lds + 115712; LAS float* PS = (LAS float*)(lds + 134144); LAS float* RS = (LAS float*)(lds + 136192) + wave * 64;
    const unsigned char* items = p.ws + WS_DNS + (size_t)(b * 32 * 6 + h) * DNS_ITEM;
    bf16_t* ydn = (bf16_t*)(p.ws + WS_YDN) + (size_t)b * SEQ * 768 + h * 128 + 16 * wave + r;
    float egl_all = lane < 32 ? ((const float*)(p.ws + WS_DNEGL))[b * 32 * 6 + h + 6 * lane] : 0.f;
    asm volatile("" : "+v"(egl_all));
    f32x4 S[8], o[4];
#pragma unroll
    for (int dt = 0; dt < 8; ++dt) S[dt] = (f32x4){0.f, 0.f, 0.f, 0.f};
#pragma unroll
    for (int mt = 0; mt < 4; ++mt) o[mt] = (f32x4){0.f, 0.f, 0.f, 0.f};
    for (int i = lane; i < 16 * 272 / 16; i += 64) *(LAS u32x4*)(ST + wave * 16 * 272 + i * 16) = (u32x4){0u, 0u, 0u, 0u};
    u32x4 R[9];
#pragma unroll
    for (int i = 0; i < 9; ++i) R[i] = *(const u32x4*)(items + (size_t)(tid + 512 * i) * 16);
    unsigned short zc[16];
#pragma unroll
    for (int i = 0; i < 16; ++i) zc[i] = 0u;
    LDS_BARRIER();
    for (int n = 0; n <= 32; ++n) {
        if (n < 32) {
#pragma unroll
            for (int i = 0; i < 9; ++i) { const int q = tid + 512 * i; LAS unsigned char* dst;
                if (i < 2) dst = W + (q >> 4) * 272 + (q & 15) * 16; else if (i < 4) dst = QD + ((q - 1024) >> 4) * 272 + (q & 15) * 16;
                else if (i < 5) dst = ATT + ((q - 2048) >> 3) * 144 + (q & 7) * 16; else if (i < 7) dst = KDT + ((q - 2560) >> 3) * 144 + (q & 7) * 16;
                else dst = UT + ((q - 3584) >> 3) * 144 + (q & 7) * 16;
                *(LAS u32x4*)dst = R[i]; }
        }
        if (n > 0) {
            float tot = 0.f;
#pragma unroll
            for (int w = 0; w < 8; ++w) tot += PS[w * 64 + lane];
            RS[lane] = rsqrtf(tot * (1.f / 128.f) + EPS);
#pragma unroll
            for (int mt = 0; mt < 4; ++mt) { const f32x4 rs = *(const LAS f32x4*)(RS + 16 * mt + 4 * kg);
#pragma unroll
                for (int rr = 0; rr < 4; rr += 2) { bf16_t* yo_ = ydn + (size_t)((n - 1) * 64 + 16 * mt + 4 * kg + rr) * 768;
                    ST2_BF(yo_, yo_ + 768, o[mt][rr] * rs[rr] * __uint_as_float(((unsigned)zc[4 * mt + rr]) << 16), o[mt][rr + 1] * rs[rr + 1] * __uint_as_float(((unsigned)zc[4 * mt + rr + 1]) << 16)); } }
        }
        if (n == 32) break;
        if (n + 1 < 32) {
#pragma unroll
            for (int i = 0; i < 9; ++i) R[i] = *(const u32x4*)(items + (size_t)(n + 1) * 6 * DNS_ITEM + (size_t)(tid + 512 * i) * 16);
        }
#pragma unroll
        for (int mt = 0; mt < 4; ++mt)
#pragma unroll
            for (int rr = 0; rr < 4; ++rr) zc[4 * mt + rr] = ydn[(size_t)(n * 64 + 16 * mt + 4 * kg + rr) * 768];
        const float egl = __builtin_bit_cast(float, __builtin_amdgcn_readlane(__builtin_bit_cast(int, egl_all), n));
        LDS_BARRIER();
        bf16x8 sf[4];
#pragma unroll
        for (int ks = 0; ks < 4; ++ks) sf[ks] = *(const LAS bf16x8*)(ST + (16 * wave + r) * 272 + ks * 64 + kg * 16);
        {   bf16x8 af[4][4]; u32x2 uw[4];
#pragma unroll
            for (int mt = 0; mt < 4; ++mt) {
#pragma unroll
                for (int ks = 0; ks < 4; ++ks) af[mt][ks] = *(const LAS bf16x8*)(W + (16 * mt + r) * 272 + ks * 64 + kg * 16);
                uw[mt] = *(const LAS u32x2*)(UT + (16 * wave + r) * 144 + (16 * mt + 4 * kg) * 2); }
#pragma unroll
            for (int mt = 0; mt < 4; ++mt) { f32x4 ws = (f32x4){0.f, 0.f, 0.f, 0.f};
#pragma unroll
                for (int ks = 0; ks < 4; ++ks) ws = mfma16(af[mt][ks], sf[ks], ws);
                const f32x4 vn = (f32x4){lo_bf(uw[mt].x), hi_bf(uw[mt].x), lo_bf(uw[mt].y), hi_bf(uw[mt].y)} - ws;
                u32x2 vw; vw.x = pk2(vn[0], vn[1]); vw.y = pk2(vn[2], vn[3]);
                *(LAS u32x2*)(VNT + (16 * wave + r) * 144 + (16 * mt + 4 * kg) * 2) = vw; } }
        bf16x8 vf[2];
        {
            bf16x8 qf[4][4], tf[4][2];
#pragma unroll
            for (int mt = 0; mt < 4; ++mt) {
#pragma unroll
                for (int ks = 0; ks < 4; ++ks) qf[mt][ks] = *(const LAS bf16x8*)(QD + (16 * mt + r) * 272 + ks * 64 + kg * 16);
#pragma unroll
                for (int kc = 0; kc < 2; ++kc) tf[mt][kc] = *(const LAS bf16x8*)(ATT + (16 * mt + r) * 144 + kc * 64 + kg * 16); }
#pragma unroll
            for (int kc = 0; kc < 2; ++kc) vf[kc] = *(const LAS bf16x8*)(VNT + (16 * wave + r) * 144 + kc * 64 + kg * 16);
#pragma unroll
            for (int mt = 0; mt < 4; ++mt) { f32x4 a = (f32x4){0.f, 0.f, 0.f, 0.f};
#pragma unroll
                for (int ks = 0; ks < 4; ++ks) a = mfma16(qf[mt][ks], sf[ks], a);
#pragma unroll
                for (int kc = 0; kc < 2; ++kc) a = mfma16(tf[mt][kc], vf[kc], a);
                o[mt] = a; } }
        {
            bf16x8 kf[8][2];
#pragma unroll
            for (int dt = 0; dt < 8; ++dt)
#pragma unroll
                for (int kc = 0; kc < 2; ++kc) kf[dt][kc] = *(const LAS bf16x8*)(KDT + (16 * dt + r) * 144 + kc * 64 + kg * 16);
#pragma unroll
            for (int dt = 0; dt < 8; ++dt) { f32x4 a = S[dt] * egl;
#pragma unroll
                for (int kc = 0; kc < 2; ++kc) a = mfma16(kf[dt][kc], vf[kc], a);
                S[dt] = a; u32x2 sw; sw.x = pk2(a[0], a[1]); sw.y = pk2(a[2], a[3]);
                *(LAS u32x2*)(ST + (16 * wave + r) * 272 + (16 * dt + 4 * kg) * 2) = sw; } }
#pragma unroll
        for (int mt = 0; mt < 4; ++mt) { f32x4 q;
#pragma unroll
            for (int rr = 0; rr < 4; ++rr) q[rr] = row16_sum(o[mt][rr] * o[mt][rr]);
            if (r == 0) *(LAS f32x4*)(PS + wave * 64 + 16 * mt + 4 * kg) = q; }
        LDS_BARRIER();
    }
    LDS_BARRIER();
}
template <int MODE>
__device__ __forceinline__ void ssd_load(const Params& p, LAS unsigned char* lds, int layer, int b, int c, int grp) {
    const int tid = htid(), lane = tid & 63, wave = tid >> 6, t0 = c * 64;
    LAS float* DT = (LAS float*)(lds + 117760); LAS float* ACS = DT + 384;
    LAS unsigned char* XT = lds + 34816;
    if (wave < 6) { const int hh = grp * 6 + wave; const float* small = (const float*)(p.ws + WS_SMALL) + ((size_t)b * SEQ + t0 + lane) * 32;
        const float dt = softplusf_(small[12 + hh] + p.in[I_SSDTB][layer * 12 + hh]); float a = -expf(p.in[I_SSALOG][layer * 12 + hh]) * dt;
#pragma unroll
        for (int o = 1; o < 64; o <<= 1) { const float t = __shfl_up(a, o); if (lane >= o) a += t; }
        DT[wave * 64 + lane] = dt; ACS[wave * 64 + lane] = a; }
    LDS_BARRIER();
    const int cg = tid % 80, seg = tid / 80, ch8 = cg * 8;
    if (tid < 480 && (MODE == 1 || ch8 < 512)) {
        const int col = ch8 < 384 ? grp * 384 + ch8 : (ch8 < 512 ? 768 + grp * 128 + (ch8 - 384) : 1024 + grp * 128 + (ch8 - 512));
        const float* cw = p.in[I_SSCONV] + (size_t)layer * 4 * 1280 + col; const float* cb = p.in[I_SSCONVB] + layer * 1280 + col;
        f32x4 w[4][2], bias[2];
#pragma unroll
        for (int j = 0; j < 4; ++j) { w[j][0] = *(const f32x4*)(cw + j * 1280); w[j][1] = *(const f32x4*)(cw + j * 1280 + 4); }
        bias[0] = *(const f32x4*)cb; bias[1] = *(const f32x4*)(cb + 4);
        const bf16_t* proj = (const bf16_t*)(p.ws + WS_PSSM) + (size_t)b * SEQ * 2048 + col;
        const int ts = seg * 11, hi = ch8 >> 6;
        f32x4 xm[3][2];
#pragma unroll
        for (int i = 0; i < 3; ++i) { const int t = t0 + ts - 3 + i; xm[i][0] = (f32x4){0.f, 0.f, 0.f, 0.f}; xm[i][1] = xm[i][0]; if (t >= 0) ld_bf8(proj + (size_t)t * 2048, xm[i][0], xm[i][1]); }
#pragma unroll
        for (int i = 0; i < 11; ++i) { const int tk = ts + i;
            if (tk < 64) { f32x4 c0, c1; ld_bf8(proj + (size_t)(t0 + tk) * 2048, c0, c1);
                f32x4 a0 = bias[0] + w[3][0] * c0 + w[2][0] * xm[2][0] + w[1][0] * xm[1][0] + w[0][0] * xm[0][0];
                f32x4 a1 = bias[1] + w[3][1] * c1 + w[2][1] * xm[2][1] + w[1][1] * xm[1][1] + w[0][1] * xm[0][1];
                xm[0][0] = xm[1][0]; xm[0][1] = xm[1][1]; xm[1][0] = xm[2][0]; xm[1][1] = xm[2][1]; xm[2][0] = c0; xm[2][1] = c1;
#pragma unroll
                for (int q = 0; q < 4; ++q) { a0[q] = siluf_(a0[q]); a1[q] = siluf_(a1[q]); }
                if (ch8 < 384) { const float sc = MODE == 0 ? DT[hi * 64 + tk] * fexp(ACS[hi * 64 + 63] - ACS[hi * 64 + tk]) : DT[hi * 64 + tk];
#pragma unroll
                    for (int q = 0; q < 4; ++q) { const unsigned pw = pk2(a0[q] * sc, a1[q] * sc);
                        *(LAS bf16_t*)(XT + (ch8 + q) * 144 + tk * 2) = (bf16_t)(pw & 0xffffu); *(LAS bf16_t*)(XT + (ch8 + 4 + q) * 144 + tk * 2) = (bf16_t)(pw >> 16); } }
                else if (MODE == 0) {
#pragma unroll
                    for (int q = 0; q < 4; ++q) { const unsigned pw = pk2(a0[q], a1[q]);
                        *(LAS bf16_t*)(lds + (ch8 - 384 + q) * 144 + tk * 2) = (bf16_t)(pw & 0xffffu); *(LAS bf16_t*)(lds + (ch8 - 384 + 4 + q) * 144 + tk * 2) = (bf16_t)(pw >> 16); } }
                else { u32x4 pw; pw.x = pk2(a0[0], a0[1]); pw.y = pk2(a0[2], a0[3]); pw.z = pk2(a1[0], a1[1]); pw.w = pk2(a1[2], a1[3]);
                    *(LAS u32x4*)(lds + (ch8 < 512 ? 17408 + tk * 272 + (ch8 - 384) * 2 : tk * 272 + (ch8 - 512) * 2)) = pw; } } }
    }
    LDS_BARRIER();
}
__device__ __forceinline__ void ssd_states(const Params& p, LAS unsigned char* lds, int layer, int b, int c, int grp) {
    ssd_load<0>(p, lds, layer, b, c, grp);
    const int tid = htid(), lane = tid & 63, wave = tid >> 6, r = lane & 15, kg = lane >> 4;
    const LAS unsigned char* XT = lds + 34816; const LAS unsigned char* BT = lds; const LAS float* ACS = (const LAS float*)(lds + 117760) + 384;
    bf16_t* st = (bf16_t*)(p.ws + WS_SSST) + ((size_t)(b * 32 + c) * 12 + grp * 6) * 8192;
    for (int t4 = 0; t4 < 24; t4 += 4) {
        bf16x8 af[4][2], bfr[4][2];
#pragma unroll
        for (int q = 0; q < 4; ++q) { const int t = wave + 8 * (t4 + q), hi = t >> 5, mt = (t >> 3) & 3, nt = t & 7;
#pragma unroll
            for (int ks = 0; ks < 2; ++ks) { af[q][ks] = *(const LAS bf16x8*)(XT + (hi * 64 + 16 * mt + r) * 144 + ks * 64 + kg * 16); bfr[q][ks] = *(const LAS bf16x8*)(BT + (16 * nt + r) * 144 + ks * 64 + kg * 16); } }
#pragma unroll
        for (int q = 0; q < 4; ++q) { const int t = wave + 8 * (t4 + q), hi = t >> 5, mt = (t >> 3) & 3, nt = t & 7;
            f32x4 acc = (f32x4){0.f, 0.f, 0.f, 0.f};
#pragma unroll
            for (int ks = 0; ks < 2; ++ks) acc = mfma16(af[q][ks], bfr[q][ks], acc);
#pragma unroll
            for (int rr = 0; rr < 4; rr += 2) { bf16_t* so_ = st + (size_t)hi * 8192 + (16 * mt + 4 * kg + rr) * 128 + 16 * nt + r; ST2_BF(so_, so_ + 128, acc[rr], acc[rr + 1]); } }
    }
    if (tid < 6) ((float*)(p.ws + WS_SSCD))[(b * 32 + c) * 12 + grp * 6 + tid] = expf(ACS[tid * 64 + 63]);
    LDS_BARRIER();
}
__device__ __forceinline__ void ssd_scan(const Params& p, int first_blk, int nblk) {
    const int gt = ((int)blockIdx.x - first_blk) * 512 + htid(), NT = nblk * 512;
    const u32x2* st = (const u32x2*)(p.ws + WS_SSST); const float* cd = (const float*)(p.ws + WS_SSCD); u32x2* pv = (u32x2*)(p.ws + WS_SSPV);
    for (int v = gt; v < NB * 12 * 2048; v += NT) { const int b = v / (12 * 2048), h = (v / 2048) % 12, e = v % 2048;
        f32x4 run = (f32x4){0.f, 0.f, 0.f, 0.f};
        for (int c0 = 0; c0 < 32; c0 += 8) { u32x2 t[8];
#pragma unroll
            for (int i = 0; i < 8; ++i) t[i] = st[((size_t)(b * 32 + c0 + i) * 12 + h) * 2048 + e];
#pragma unroll
            for (int i = 0; i < 8; ++i) { u32x2 w; w.x = pk2(run[0], run[1]); w.y = pk2(run[2], run[3]); pv[((size_t)(b * 32 + c0 + i) * 12 + h) * 2048 + e] = w;
                run = run * cd[(b * 32 + c0 + i) * 12 + h] + (f32x4){lo_bf(t[i].x), hi_bf(t[i].x), lo_bf(t[i].y), hi_bf(t[i].y)}; } }
    }
}
__device__ __forceinline__ void ssd_out(const Params& p, LAS unsigned char* lds, int layer, int b, int c, int grp) {
    ssd_load<1>(p, lds, layer, b, c, grp);
    const int tid = htid(), lane = tid & 63, wave = tid >> 6, r = lane & 15, kg = lane >> 4, t0 = c * 64;
    const LAS unsigned char* CM = lds; const LAS unsigned char* BM = lds + 17408; const LAS unsigned char* XT = lds + 34816; LAS unsigned char* MH = lds + 90112;
    const LAS float* DT = (const LAS float*)(lds + 117760); const LAS float* ACS = DT + 384; LAS float* YG = (LAS float*)lds;
    const bf16_t* prev = (const bf16_t*)(p.ws + WS_SSPV) + ((size_t)(b * 32 + c) * 12 + grp * 6) * 8192;
    f32x4 cb[2];
    {   bf16x8 ca[2][4], cbf[2][4];
#pragma unroll
        for (int q = 0; q < 2; ++q) { const int t = wave * 2 + q, mt = t >> 2, nt = t & 3;
#pragma unroll
            for (int ks = 0; ks < 4; ++ks) { ca[q][ks] = *(const LAS bf16x8*)(CM + (16 * mt + r) * 272 + ks * 64 + kg * 16); cbf[q][ks] = *(const LAS bf16x8*)(BM + (16 * nt + r) * 272 + ks * 64 + kg * 16); } }
#pragma unroll
        for (int q = 0; q < 2; ++q) { f32x4 acc = (f32x4){0.f, 0.f, 0.f, 0.f};
#pragma unroll
            for (int ks = 0; ks < 4; ++ks) acc = mfma16(ca[q][ks], cbf[q][ks], acc);
            cb[q] = acc; } }
    f32x4 y[2][6];
#pragma unroll
    for (int half = 0; half < 2; ++half) {
#pragma unroll
        for (int q = 0; q < 2; ++q) { const int t = wave * 2 + q, mt = t >> 2, nt = t & 3, j = 16 * nt + r;
#pragma unroll
            for (int hl = 0; hl < 3; ++hl) { const int hi = 3 * half + hl; const float aj = ACS[hi * 64 + j];
#pragma unroll
                for (int rr = 0; rr < 4; ++rr) { const int i = 16 * mt + 4 * kg + rr; *(LAS bf16_t*)(MH + hl * 9216 + i * 144 + j * 2) = (bf16_t)f2bf((i >= j) ? cb[q][rr] * fexp(fminf(ACS[hi * 64 + i] - aj, 0.f)) : 0.f); } } }
        bf16x8 pf[6][4];
#pragma unroll
        for (int k = 0; k < 6; ++k) { const int t = wave + 8 * k, hl = t >> 4, nt = t & 3, hi = 3 * half + hl; const bf16_t* pr = prev + (size_t)hi * 8192 + (16 * nt + r) * 128 + kg * 8;
#pragma unroll
            for (int ks = 0; ks < 4; ++ks) pf[k][ks] = *(const bf16x8*)(pr + ks * 32); }
        LDS_BARRIER();
#pragma unroll
        for (int k = 0; k < 6; ++k) { const int t = wave + 8 * k, hl = t >> 4, mt = (t >> 2) & 3, nt = t & 3, hi = 3 * half + hl, hh = grp * 6 + hi;
            f32x4 acc = (f32x4){0.f, 0.f, 0.f, 0.f}, off = acc;
            bf16x8 mf[2], xf[2], cf[4];
#pragma unroll
            for (int ks = 0; ks < 2; ++ks) { mf[ks] = *(const LAS bf16x8*)(MH + hl * 9216 + (16 * mt + r) * 144 + ks * 64 + kg * 16); xf[ks] = *(const LAS bf16x8*)(XT + (hi * 64 + 16 * nt + r) * 144 + ks * 64 + kg * 16); }
#pragma unroll
            for (int ks = 0; ks < 4; ++ks) cf[ks] = *(const LAS bf16x8*)(CM + (16 * mt + r) * 272 + ks * 64 + kg * 16);
#pragma unroll
            for (int ks = 0; ks < 2; ++ks) acc = mfma16(mf[ks], xf[ks], acc);
#pragma unroll
            for (int ks = 0; ks < 4; ++ks) off = mfma16(cf[ks], pf[k][ks], off);
            const u32x2 xw = *(const LAS u32x2*)(XT + (hi * 64 + 16 * nt + r) * 144 + (16 * mt + 4 * kg) * 2); const float xs[4] = {lo_bf(xw.x), hi_bf(xw.x), lo_bf(xw.y), hi_bf(xw.y)};
            const float dsk = p.in[I_SSD][layer * 12 + hh];
#pragma unroll
            for (int rr = 0; rr < 4; ++rr) { const int i = 16 * mt + 4 * kg + rr; acc[rr] += fexp(ACS[hi * 64 + i]) * off[rr] + dsk * xs[rr] * __builtin_amdgcn_rcpf(fmaxf(DT[hi * 64 + i], 1e-30f)); }
            y[half][k] = acc; }
        LDS_BARRIER();
    }
    const bf16_t* zp = (const bf16_t*)(p.ws + WS_PSSM) + ((size_t)b * SEQ + t0) * 2048 + 1280 + grp * 384;
#pragma unroll
    for (int half = 0; half < 2; ++half)
#pragma unroll
        for (int k = 0; k < 6; ++k) { const int t = wave + 8 * k, hl = t >> 4, mt = (t >> 2) & 3, nt = t & 3, hi = 3 * half + hl, ch = hi * 64 + 16 * nt + r;
#pragma unroll
            for (int rr = 0; rr < 4; ++rr) { const int i = 16 * mt + 4 * kg + rr; const float z = bf2f(zp[(size_t)i * 2048 + ch]); YG[i * 388 + ch] = y[half][k][rr] * siluf_(z); } }
    LDS_BARRIER();
    const float* sn = p.in[I_SSNORM] + layer * 768 + grp * 384; bf16_t* yo = (bf16_t*)(p.ws + WS_YSSM) + ((size_t)b * SEQ + t0) * 768 + grp * 384;
#pragma unroll
    for (int i8 = 0; i8 < 8; ++i8) { const int i = 8 * wave + i8; float v[6], ss = 0.f;
#pragma unroll
        for (int k = 0; k < 6; ++k) { v[k] = YG[i * 388 + lane + 64 * k]; ss += v[k] * v[k]; }
        const float rs = rsqrtf(wave_sum(ss) * (1.f / 384.f) + EPS);
#pragma unroll
        for (int k = 0; k < 6; k += 2) ST2_BF(yo + (size_t)i * 768 + lane + 64 * k, yo + (size_t)i * 768 + lane + 64 * (k + 1), v[k] * rs * sn[lane + 64 * k], v[k + 1] * rs * sn[lane + 64 * (k + 1)]); }
    LDS_BARRIER();
}

typedef float f32x16 __attribute__((ext_vector_type(16)));
__device__ __forceinline__ void attn_tile(const Params& p, int b, int g, int j, int r, int qt, int lane) {
    const int d = g == 0 ? 1 : (g == 1 ? 4 : 16), L = SEQ / d, n = lane & 31, hw = lane >> 5;
    const int P0 = b * SEQ + r * L;
    const bf16_t* Q = (const bf16_t*)(p.ws + WS_QK) + (size_t)(0 * 3 + g) * TC * 256 + j * 64;
    const bf16_t* K = (const bf16_t*)(p.ws + WS_QK) + (size_t)(1 * 3 + g) * TC * 256 + j * 64;
    const bf16_t* V = (const bf16_t*)(p.ws + WS_VT) + (size_t)(g * 256 + j * 64) * TC;
    const float sl2 = exp2f(-8.f * (float)(4 * g + j + 1) / 12.f) * (float)d * 1.4426950408889634f;
    bf16x8 qf[4];
    { const bf16_t* qrow = Q + (size_t)(P0 + 32 * qt + n) * 256 + 8 * hw;
#pragma unroll
      for (int s = 0; s < 4; ++s) qf[s] = *(const bf16x8*)(qrow + 16 * s); }
    f32x16 o0, o1;
#pragma unroll
    for (int i = 0; i < 16; ++i) { o0[i] = 0.f; o1[i] = 0.f; }
    float mrun = -1e30f, lrun = 0.f;
    const int pim = (n & 0x13) | (((n >> 2) & 1) << 3) | (((n >> 3) & 1) << 2);
    const int qi = 32 * qt + n;
    const int kb0 = qt > 4 ? qt - 4 : 0;
    bf16x8 kf[4], vf[2][2];
    { const bf16_t* krow = K + (size_t)(P0 + 32 * kb0 + pim) * 256 + 8 * hw;
#pragma unroll
      for (int s = 0; s < 4; ++s) kf[s] = *(const bf16x8*)(krow + 16 * s);
#pragma unroll
      for (int sp = 0; sp < 2; ++sp)
#pragma unroll
          for (int dh = 0; dh < 2; ++dh) vf[sp][dh] = *(const bf16x8*)(V + (size_t)(32 * dh + n) * TC + P0 + 32 * kb0 + 16 * sp + 8 * hw); }
    for (int kb = kb0; kb <= qt; ++kb) {
        f32x16 st;
#pragma unroll
        for (int i = 0; i < 16; ++i) st[i] = 0.f;
#pragma unroll
        for (int s = 0; s < 4; ++s) st = __builtin_amdgcn_mfma_f32_32x32x16_bf16(kf[s], qf[s], st, 0, 0, 0);
        bf16x8 vc[2][2];
#pragma unroll
        for (int sp = 0; sp < 2; ++sp)
#pragma unroll
            for (int dh = 0; dh < 2; ++dh) vc[sp][dh] = vf[sp][dh];
        if (kb < qt) {
            const bf16_t* krow = K + (size_t)(P0 + 32 * (kb + 1) + pim) * 256 + 8 * hw;
#pragma unroll
            for (int s = 0; s < 4; ++s) kf[s] = *(const bf16x8*)(krow + 16 * s);
#pragma unroll
            for (int sp = 0; sp < 2; ++sp)
#pragma unroll
                for (int dh = 0; dh < 2; ++dh) vf[sp][dh] = *(const bf16x8*)(V + (size_t)(32 * dh + n) * TC + P0 + 32 * (kb + 1) + 16 * sp + 8 * hw);
        }
        float mx = -1e30f;
#pragma unroll
        for (int jj = 0; jj < 16; ++jj) { const int kidx = 32 * kb + 16 * (jj >> 3) + 8 * hw + 4 * ((jj >> 2) & 1) + (jj & 3); const int dl = qi - kidx;
            const float sc = (dl >= 0 && dl <= 128) ? st[jj] * 1.4426950408889634f - sl2 * (float)dl : -1e30f; st[jj] = sc; mx = fmaxf(mx, sc); }
        mx = fmaxf(mx, __shfl_xor(mx, 32));
        const float mnew = fmaxf(mrun, mx), alpha = __builtin_amdgcn_exp2f(mrun - mnew);
        float rs = 0.f;
#pragma unroll
        for (int jj = 0; jj < 16; ++jj) { const float pj = __builtin_amdgcn_exp2f(st[jj] - mnew); st[jj] = pj; rs += pj; }
        rs += __shfl_xor(rs, 32);
        lrun = lrun * alpha + rs; mrun = mnew;
#pragma unroll
        for (int i = 0; i < 16; ++i) { o0[i] *= alpha; o1[i] *= alpha; }
#pragma unroll
        for (int sp = 0; sp < 2; ++sp) {
            u32x4 pw; pw.x = pk2(st[8 * sp + 0], st[8 * sp + 1]); pw.y = pk2(st[8 * sp + 2], st[8 * sp + 3]); pw.z = pk2(st[8 * sp + 4], st[8 * sp + 5]); pw.w = pk2(st[8 * sp + 6], st[8 * sp + 7]);
            const bf16x8 pf = __builtin_bit_cast(bf16x8, pw);
            o0 = __builtin_amdgcn_mfma_f32_32x32x16_bf16(vc[sp][0], pf, o0, 0, 0, 0);
            o1 = __builtin_amdgcn_mfma_f32_32x32x16_bf16(vc[sp][1], pf, o1, 0, 0, 0);
        }
    }
    const float inv = 1.f / lrun;
    const int tok = b * SEQ + qi * d + r;
    bf16_t* og = (bf16_t*)(p.ws + WS_OG) + ((size_t)g * TC + tok) * 256 + j * 64 + 4 * hw;
#pragma unroll
    for (int q4 = 0; q4 < 4; ++q4) {
        u32x2 w0, w1; w0.x = pk2(o0[4 * q4] * inv, o0[4 * q4 + 1] * inv); w0.y = pk2(o0[4 * q4 + 2] * inv, o0[4 * q4 + 3] * inv);
        w1.x = pk2(o1[4 * q4] * inv, o1[4 * q4 + 1] * inv); w1.y = pk2(o1[4 * q4 + 2] * inv, o1[4 * q4 + 3] * inv);
        *(u32x2*)(og + 8 * q4) = w0; *(u32x2*)(og + 32 + 8 * q4) = w1;
    }
    if (hw == 0) ((float*)(p.ws + WS_LSE))[((size_t)g * TC + tok) * 4 + j] = (mrun + log2f(lrun)) * 0.6931471805599453f;
}
__device__ __forceinline__ void phase_attn_combine(const Params& p, int skip) {
    const int tid_ = htid(), lane = tid_ & 63, gw = ((int)blockIdx.x - skip) * 8 + (tid_ >> 6), NGW = ((int)gridDim.x - skip) * 8;
    const bf16_t* og = (const bf16_t*)(p.ws + WS_OG); const float* lse = (const float*)(p.ws + WS_LSE); bf16_t* ya = (bf16_t*)(p.ws + WS_YATT);
    for (int t = gw; t < TC; t += NGW) {
        const int j = lane >> 4;
        const float l0 = lse[((size_t)0 * TC + t) * 4 + j], l1 = lse[((size_t)1 * TC + t) * 4 + j], l2 = lse[((size_t)2 * TC + t) * 4 + j];
        const float M = fmaxf(l0, fmaxf(l1, l2)); float w0 = expf(l0 - M), w1 = expf(l1 - M), w2 = expf(l2 - M); const float iw = 1.f / (w0 + w1 + w2); w0 *= iw; w1 *= iw; w2 *= iw;
        const u32x2 a = *((const u32x2*)(og + ((size_t)0 * TC + t) * 256) + lane), bb = *((const u32x2*)(og + ((size_t)1 * TC + t) * 256) + lane), c = *((const u32x2*)(og + ((size_t)2 * TC + t) * 256) + lane);
        u32x2 o; o.x = pk2(w0 * lo_bf(a.x) + w1 * lo_bf(bb.x) + w2 * lo_bf(c.x), w0 * hi_bf(a.x) + w1 * hi_bf(bb.x) + w2 * hi_bf(c.x));
        o.y = pk2(w0 * lo_bf(a.y) + w1 * lo_bf(bb.y) + w2 * lo_bf(c.y), w0 * hi_bf(a.y) + w1 * hi_bf(bb.y) + w2 * hi_bf(c.y));
        *((u32x2*)(ya + (size_t)t * 256) + lane) = o;
    }
}
__device__ __forceinline__ void sub_barrier(unsigned* cnt, unsigned target) {
    asm volatile("s_waitcnt vmcnt(0)" ::: "memory");
    __syncthreads();
    if (threadIdx.x == 0) {
        __builtin_amdgcn_fence(__ATOMIC_RELEASE, "agent"); asm volatile("s_waitcnt vmcnt(0)" ::: "memory");
        (void)xb_add(cnt, 1u);
        unsigned sp = 0; while (xb_ld(cnt) < target) { __builtin_amdgcn_s_sleep(2); if (++sp > (1u << 24)) break; }
        __builtin_amdgcn_fence(__ATOMIC_ACQUIRE, "agent"); asm volatile("s_waitcnt vmcnt(0)" ::: "memory");
    }
    __syncthreads();
}
__device__ __forceinline__ void phase_mixers(const Params& p, LAS unsigned char* lds, int layer) {
    const int G = gridDim.x, NDP = NB * 32 * 6, NSS = NB * 32 * 2;
    TSUB(15);
    for (int item = blockIdx.x; item < NDP + NSS; item += G) {
        if (item < NDP) { dn_prep(p, lds, layer, item / 192, (item / 6) % 32, item % 6); TSUB(6); }
        else { const int it = item - NDP; ssd_states(p, lds, layer, it / 64, (it >> 1) & 31, it & 1); TSUB(7); }
    }
}
__device__ __forceinline__ void phase_mixers2(const Params& p, LAS unsigned char* lds, int layer, int rep, unsigned* subcnt, bool use_bar2) {
    const int tid_ = htid(), lane = tid_ & 63, wave = tid_ >> 6, G = gridDim.x, nscan = NB * 6;
    const int ded = G > 2 * nscan ? nscan : 0;
    TSUB(15);
    if ((int)blockIdx.x < ded) { if (!(MIX2_PROBE == 2 && rep > 0)) dn_scan(p, lds, layer, blockIdx.x / 6, blockIdx.x % 6); TSUB(0); return; }
    if (MIX2_PROBE == 1 && rep > 0) return;
    if (ded == 0) for (int it = blockIdx.x; it < nscan; it += G) dn_scan(p, lds, layer, it / 6, it % 6);
    const int nb = G - ded, rb = (int)blockIdx.x - ded;
    for (int item = rb; item < NB * 3 * 4 * 64 / 8; item += nb) { const int w = item * 8 + wave;
        const int st = w & 63, jj = (w >> 6) & 3, gg = (w >> 8) % 3, bb = w / 768;
        const int dd = gg == 0 ? 1 : (gg == 1 ? 4 : 16), tiles = SEQ / dd / 32;
        attn_tile(p, bb, gg, jj, st / tiles, st % tiles, lane); }
    TSUB(1);
    ssd_scan(p, ded, nb);
    TSUB(2);
    if (use_bar2) { XcdBarrier bar2; bar2.bar = (unsigned*)(p.ws + WS_CTL) + CW_BAR2; bar2.x = xb_xcc_id(); bar2.st = (volatile LAS unsigned*)(lds + LDS_BYTES - 256) + 12; xcd_barrier(bar2, (unsigned)nb); } else sub_barrier(subcnt, (unsigned)(nb * (rep + 1)));
    TSUB(3);
    for (int it = rb; it < NB * 32 * 2; it += nb) ssd_out(p, lds, layer, it / 64, (it >> 1) & 31, it & 1);
    TSUB(4);
    phase_attn_combine(p, ded);
    TSUB(5);
}

constexpr int NSTEPS = 1 + NCH * (8 + 11 + 1);
__global__ void __launch_bounds__(512, 2) hybrid_fwd(Params p) {
    extern __shared__ __attribute__((aligned(16))) unsigned char lds_raw[];
    LAS unsigned char* lds = (LAS unsigned char*)lds_raw;
    volatile LAS unsigned* MISC = (volatile LAS unsigned*)(lds + LDS_BYTES - 256);
    if (threadIdx.x < 64) MISC[threadIdx.x] = 0u;
    __syncthreads();
    const int G = gridDim.x, cid = blockIdx.x;
    unsigned char* ws = p.ws;
    XcdBarrier bar; bar.bar = (unsigned*)(ws + WS_CTL) + CW_BAR; bar.x = 0; bar.st = MISC + 8;
    if (p.s_hi - p.s_lo > 1) bar = xcd_barrier_post((unsigned*)(ws + WS_CTL) + CW_BAR, MISC + 8);
    const bool use_bar2 = (p.s_hi - p.s_lo == NSTEPS) && ((int)gridDim.x > 2 * NB * 6);
    if (use_bar2 && (int)blockIdx.x >= NB * 6 && threadIdx.x == 0) (void)xb_add((unsigned*)(ws + WS_CTL) + CW_BAR2 + XB_XCNT(xb_xcc_id()), 1u);
    const int lo = p.s_lo, hi = p.s_hi;
    int step = 0;
    if (TPROBE_MASK != 0u && threadIdx.x == 0) { volatile LAS unsigned long long* tp_ = (volatile LAS unsigned long long*)(lds + LDS_BYTES - 256 + 128); tp_[0] = 0ull; tp_[1] = __builtin_amdgcn_s_memrealtime(); tp_[2] = 21ull; }
#define IN_STEP (step >= lo && step < hi)
#define END_STEP do { if (step >= lo && step + 1 < hi) xcd_barrier(bar); \
        if (TPROBE_ON && threadIdx.x == 0) { volatile LAS unsigned long long* tp_ = (volatile LAS unsigned long long*)(lds + LDS_BYTES - 256 + 128); const unsigned long long tn_ = __builtin_amdgcn_s_memrealtime(); \
            const unsigned pos_ = (unsigned)tp_[2]; if (pos_ < 22u && ((p.tmask >> pos_) & 1u)) tp_[0] += tn_ - tp_[1]; tp_[1] = tn_; tp_[2] = pos_ >= 20u ? 1ull : (unsigned long long)(pos_ + 1u); } \
        ++step; } while (0)
    bf16_t* xb = (bf16_t*)(ws + WS_XB); float* ssq = (float*)(ws + WS_SSQ);
    if (IN_STEP) for (int rep_ = 0; rep_ < (REP_PH == 0 ? 3 : 1); ++rep_, (rep_ < (REP_PH == 0 ? 3 : 1) ? xcd_barrier(bar) : (void)0)) { phase_convert(p, lds); phase_chunk_in(p, 0); }
    END_STEP;
    for (int chunk = 0; chunk < NCH; ++chunk) {
        float* xo = p.out + (size_t)chunk * TC * D;
        for (int layer = 0; layer < DEPTH; ++layer) {
            if (IN_STEP) for (int rep_ = 0; rep_ < (REP_PH == 2 ? 3 : 1); ++rep_, (rep_ < (REP_PH == 2 ? 3 : 1) ? xcd_barrier(bar) : (void)0)) {
                ProgIn P; P.S.init(TC / 256, INP / 256, G, cid); P.xb = layer == 0 ? xb : (const bf16_t*)(ws + WS_XB2); P.Wt = (const bf16_t*)(ws + WS_WIN) + (size_t)layer * INP * D; P.ssq = layer == 0 ? ssq : (const float*)(ws + WS_SSQ2);
                P.wsb = ws; P.pb = (const bf16_t*)(ws + WS_PB) + (size_t)layer * TC * PLE; P.wple = (const bf16_t*)(ws + WS_WPLE) + (size_t)layer * D * PLE;
                gemm_phase(lds, P);
            }
            END_STEP;
            if (IN_STEP) for (int rep_ = 0; rep_ < (REP_PH == 3 ? 3 : 1); ++rep_, (rep_ < (REP_PH == 3 ? 3 : 1) ? xcd_barrier(bar) : (void)0)) phase_mixers(p, lds, layer);
            END_STEP;
            if (IN_STEP) for (int rep_ = 0; rep_ < (REP_PH == 4 ? 3 : 1); ++rep_, (rep_ < (REP_PH == 4 ? 3 : 1) ? xcd_barrier(bar) : (void)0)) phase_mixers2(p, lds, layer, rep_, (unsigned*)(ws + WS_CTL) + CW_SUB + (chunk * 2 + layer) * 64, use_bar2);
            END_STEP;
            if (IN_STEP) for (int rep_ = 0; rep_ < (REP_PH == 6 ? 3 : 1); ++rep_, (rep_ < (REP_PH == 6 ? 3 : 1) ? xcd_barrier(bar) : (void)0)) {
                ProgMerge P; P.S.init(TC / 256, 4, G, cid); P.wsb = ws;
                P.wdn = (const bf16_t*)(ws + WS_WDN) + (size_t)layer * D * 768; P.wssm = (const bf16_t*)(ws + WS_WSSM) + (size_t)layer * D * 768; P.watt = (const bf16_t*)(ws + WS_WATT) + (size_t)layer * D * 256;
                gemm_phase(lds, P);
            }
            END_STEP;
            if (IN_STEP) {
                ProgResid P; P.S.init(TC / 256, 4, G, cid); P.A = (const bf16_t*)(ws + WS_MERGED); P.lda = 2048; P.nt = 16; P.Wt = (const bf16_t*)(ws + WS_WOUT) + (size_t)layer * D * D; P.ldb = 2048;
                P.xin_f = layer == 0 ? p.in[I_X] + (size_t)chunk * TC * D : nullptr; P.xin_b = (const bf16_t*)(ws + WS_XB2); P.xb = xb; P.ssq = ssq; P.sc = 1.f;
                gemm_phase(lds, P);
            }
            END_STEP;
            if (layer == 0) {
                if (IN_STEP) for (int rep_ = 0; rep_ < (REP_PH == 8 ? 3 : 1); ++rep_, (rep_ < (REP_PH == 8 ? 3 : 1) ? xcd_barrier(bar) : (void)0)) {
                    ProgFfnGu P; P.S.init(TC / 256, 2 * FFN / 256, G, cid); P.xb = xb; P.Wt = (const bf16_t*)(ws + WS_WFGU); P.ssq = ssq; P.act = (bf16_t*)(ws + WS_ACT);
                    gemm_phase(lds, P);
                }
                END_STEP;
                if (IN_STEP) {
                    ProgResid P; P.S.init(TC / 256, 4, G, cid); P.A = (const bf16_t*)(ws + WS_ACT); P.lda = 2 * FFN; P.nt = FFN / 64; P.Wt = (const bf16_t*)(ws + WS_WFD); P.ldb = 2 * FFN;
                    P.xin_f = nullptr; P.xin_b = xb; P.xb = xb; P.ssq = ssq; P.sc = (DBG_ABL & 8) ? 0.f : 1.f;
                    gemm_phase(lds, P);
                }
                END_STEP;
            } else {
                if (IN_STEP) phase_router(p, lds, chunk);
                END_STEP;
                if (IN_STEP) phase_slots(p, chunk);
                END_STEP;
                if (IN_STEP) for (int rep_ = 0; rep_ < (REP_PH == 12 ? 3 : 1); ++rep_, (rep_ < (REP_PH == 12 ? 3 : 1) ? xcd_barrier(bar) : (void)0)) {
                    ProgMoeGu P; P.S.init((const unsigned*)(ws + WS_CTL) + CW_CNT + chunk * 64, 2 * EXD / 256, G, cid); P.xb = xb; P.Wt = (const bf16_t*)(ws + WS_WMGU); P.ssq = ssq;
                    P.idx = (const int*)(ws + WS_ROUTE) + RT_IDX; P.act = (bf16_t*)(ws + WS_ACTM);
                    gemm_phase(lds, P);
                }
                END_STEP;
                if (IN_STEP) for (int rep_ = 0; rep_ < (REP_PH == 13 ? 3 : 1); ++rep_, (rep_ < (REP_PH == 13 ? 3 : 1) ? xcd_barrier(bar) : (void)0)) {
                    ProgMoeDown P; P.init((const unsigned*)(ws + WS_CTL) + CW_CNT + chunk * 64, G, cid); P.act = (const bf16_t*)(ws + WS_ACTM); P.Wt = (const bf16_t*)(ws + WS_WMD); P.ypair = (bf16_t*)(ws + WS_YPAIR); P.partk = (float*)(ws + WS_PARTK);
                    gemm_phase(lds, P);
                }
                END_STEP;
                if (IN_STEP) phase_combine(p, chunk);
                END_STEP;
            }
            if (IN_STEP) {
                ProgPle P; P.S.init(TC / 256, 4, G, cid); P.xb = xb; P.wpg = (const bf16_t*)(ws + WS_WPG) + (size_t)layer * D * D; P.pp = (const bf16_t*)(ws + WS_PP); P.ssq = ssq;
                P.xbout = (bf16_t*)(ws + WS_XB2); P.ssqout = (float*)(ws + WS_SSQ2);
                gemm_phase(lds, P);
            }
            END_STEP;
        }
        if (IN_STEP) { phase_final(p, chunk); if (chunk + 1 < NCH) phase_chunk_in(p, chunk + 1); }
        END_STEP;
    }
    if (TPROBE_MASK != 0u && (int)blockIdx.x == (p.pad & 0xffff) && threadIdx.x == 0) { const unsigned long long tsum_ = *(volatile LAS unsigned long long*)(lds + LDS_BYTES - 256 + 128); const unsigned long long t0_ = __builtin_amdgcn_s_memrealtime(); while (__builtin_amdgcn_s_memrealtime() - t0_ < 4ull * tsum_) __builtin_amdgcn_s_sleep(16); }
#undef IN_STEP
#undef END_STEP
}

#if defined(DBG_REP_STEP)
__global__ void dbg_csum(const unsigned* buf, size_t n, unsigned long long* out) {
    unsigned long long a = 0;
    for (size_t i = (size_t)blockIdx.x * 256 + threadIdx.x; i < n; i += (size_t)gridDim.x * 256) a += (unsigned long long)buf[i] * (unsigned long long)((i % 1021) + 1);
    atomicAdd(out, a);
}
__global__ void dbg_verdict(float* out, const unsigned long long* cs, int R) {
    bool bad = false; for (int r = 1; r < R; ++r) bad = bad || (cs[r] != cs[0]);
    const float v = bad ? __builtin_nanf("") : 0.f; const size_t n = (size_t)BATCH * SEQ * D;
    for (size_t i = (size_t)blockIdx.x * 256 + threadIdx.x; i < n; i += (size_t)gridDim.x * 256) out[i] = v;
}
#endif
#if defined(DBG_STOP)
#ifndef DBG_DUMP
#define DBG_DUMP 0
#define DBG_DUMP_OFF 0
#endif
__global__ void dbg_fill(float* out, const unsigned short* buf, int dump) {
    const size_t n = (size_t)BATCH * SEQ * D, c0 = (size_t)TC * D;
    for (size_t i = (size_t)blockIdx.x * 256 + threadIdx.x; i < n; i += (size_t)gridDim.x * 256) {
        if (i >= c0) out[i] = 0.f; else if (dump) out[i] = __uint_as_float(((unsigned)buf[i]) << 16);
    }
}
#endif
extern "C" void kernel_launch(void* const* d_in, const int* in_sizes, int n_in, void* d_out, int out_size, void* d_ws, size_t ws_size, hipStream_t stream) {
    static int grid = 0;
    if (grid == 0) {
        if (n_in != 30 || out_size != BATCH * SEQ * D || ws_size < WS_END) { fprintf(stderr, "kernel_launch: unexpected shapes (n_in %d, out %d, ws %zu < %zu)\n", n_in, out_size, ws_size, (size_t)WS_END); grid = -1; return; }
        int dev = 0, cus = 0;
        if (hipGetDevice(&dev) != hipSuccess || hipDeviceGetAttribute(&cus, hipDeviceAttributeMultiprocessorCount, dev) != hipSuccess) { grid = -1; return; }
        if (hipFuncSetAttribute((const void*)hybrid_fwd, hipFuncAttributeMaxDynamicSharedMemorySize, LDS_BYTES) != hipSuccess) { fprintf(stderr, "kernel_launch: hipFuncSetAttribute failed\n"); grid = -1; return; }
        int per_cu = 0;
        if (hipOccupancyMaxActiveBlocksPerMultiprocessor(&per_cu, (const void*)hybrid_fwd, 512, LDS_BYTES) != hipSuccess || per_cu < 1) { fprintf(stderr, "kernel_launch: occupancy query says %d\n", per_cu); }
        (void)hipGetLastError();
        grid = cus;
    }
    if (grid < 0) return;
    (void)hipMemsetAsync((char*)d_ws + WS_CTL, 0, MiB, stream);
    Params p{};
    for (int i = 0; i < 30; ++i) p.in[i] = (const float*)d_in[i];
    p.out = (float*)d_out; p.ws = (unsigned char*)d_ws; p.tmask = TPROBE_MASK; p.pad = TPROBE_PAD;
#if defined(DBG_REP_STEP)
    for (int s = 0; s < DBG_REP_STEP; ++s) { p.s_lo = s; p.s_hi = s + 1; hipLaunchKernelGGL(hybrid_fwd, dim3(grid), dim3(512), LDS_BYTES, stream, p); }
    unsigned long long* cs = (unsigned long long*)((char*)d_ws + WS_CTL + 512 * 1024);
    for (int r = 0; r < DBG_REP_N; ++r) { p.s_lo = DBG_REP_STEP; p.s_hi = DBG_REP_STEP + 1; hipLaunchKernelGGL(hybrid_fwd, dim3(grid), dim3(512), LDS_BYTES, stream, p);
        hipLaunchKernelGGL(dbg_csum, dim3(1024), dim3(256), 0, stream, (const unsigned*)((const char*)d_ws + DBG_REP_OFF), (size_t)(DBG_REP_BYTES) / 4, cs + r); }
    hipLaunchKernelGGL(dbg_verdict, dim3(2048), dim3(256), 0, stream, (float*)d_out, cs, (int)DBG_REP_N);
#elif defined(DBG_STOP)
    for (int s = 0; s < DBG_STOP; ++s) { p.s_lo = s; p.s_hi = s + 1; hipLaunchKernelGGL(hybrid_fwd, dim3(grid), dim3(512), LDS_BYTES, stream, p); }
    hipLaunchKernelGGL(dbg_fill, dim3(2048), dim3(256), 0, stream, (float*)d_out, (const unsigned short*)((const char*)d_ws + DBG_DUMP_OFF), (int)DBG_DUMP);
#elif ONE_LAUNCH
    p.s_lo = 0; p.s_hi = NSTEPS;
    hipLaunchKernelGGL(hybrid_fwd, dim3(grid), dim3(512), LDS_BYTES, stream, p);
#else
    for (int s = 0; s < NSTEPS; ++s) { p.s_lo = s; p.s_hi = s + 1; hipLaunchKernelGGL(hybrid_fwd, dim3(grid), dim3(512), LDS_BYTES, stream, p); }
#endif
}
```

```cpp
#include <hip/hip_runtime.h>
#include <cstdio>
#include <cstdint>

#define GAS __attribute__((address_space(1)))
#define LAS __attribute__((address_space(3)))
typedef unsigned short bf16_t;
typedef short bf16x8 __attribute__((ext_vector_type(8)));
typedef float f32x4 __attribute__((ext_vector_type(4)));
typedef float f32x2 __attribute__((ext_vector_type(2)));
typedef unsigned u32x4 __attribute__((ext_vector_type(4)));
typedef unsigned u32x2 __attribute__((ext_vector_type(2)));

#ifndef REP_PH
#define REP_PH -1
#endif
#ifndef EMU_FP8
#define EMU_FP8 0
#endif
#ifndef TPROBE_MASK
#define TPROBE_MASK 0u
#endif
#define TPROBE_ON (TPROBE_MASK != 0u)
#ifndef TPROBE_PAD
#define TPROBE_PAD 0
#endif
#define TSUB(b) do { if (TPROBE_ON && threadIdx.x == 0 && (int)blockIdx.x == (p.pad & 0xffff)) { volatile LAS unsigned long long* ts_ = (volatile LAS unsigned long long*)(lds + LDS_BYTES - 256 + 128); \
        const unsigned long long tn_ = __builtin_amdgcn_s_memrealtime(); if ((p.pad >> (16 + (b))) & 1) ts_[0] += tn_ - ts_[3]; ts_[3] = tn_; } } while (0)
#ifndef MIX2_PROBE
#define MIX2_PROBE 0
#endif
#ifndef DBG_ABL
#define DBG_ABL 0
#endif
#ifndef ONE_LAUNCH
#define ONE_LAUNCH 1
#endif

constexpr int D = 1024, BATCH = 32, SEQ = 2048, DEPTH = 2;
constexpr int PLE = 256;
constexpr float EPS = 1e-6f;
constexpr int FFN = 2816, NE = 8, EXD = 3584;
constexpr int C_DNZ = 2304, C_DNA = 3072, C_DNB = 3078, C_XBC = 3084, C_SSZ = 4364, C_SSDT = 5132, C_ATT = 5144, C_GATE = 7448, INW = 10520;
constexpr int NB = 8, TC = NB * SEQ, NCH = BATCH / NB;
constexpr int INP = 10752;
constexpr int MOE_SLOTS = 2 * TC + NE * 256;

constexpr size_t MiB = 1u << 20;
constexpr size_t WS_CTL = 0;
constexpr size_t WS_WIN = 1 * MiB;
constexpr size_t WS_WDN = WS_WIN + 42 * MiB;
constexpr size_t WS_WSSM = WS_WDN + 3 * MiB;
constexpr size_t WS_WATT = WS_WSSM + 3 * MiB;
constexpr size_t WS_WOUT = WS_WATT + 1 * MiB;
constexpr size_t WS_WFGU = WS_WOUT + 4 * MiB;
constexpr size_t WS_WFD = WS_WFGU + 11 * MiB;
constexpr size_t WS_WMGU = WS_WFD + 6 * MiB;
constexpr size_t WS_WMD = WS_WMGU + 112 * MiB;
constexpr size_t WS_WPG = WS_WMD + 56 * MiB;
constexpr size_t WS_WPLE = WS_WPG + 4 * MiB;
constexpr size_t WS_WR = WS_WPLE + 1 * MiB;
constexpr size_t WS_ACT0 = WS_WR + 1 * MiB;
constexpr size_t WS_XB = WS_ACT0;
constexpr size_t WS_SSQ = WS_XB + 32 * MiB;
constexpr size_t WS_PB = WS_SSQ + 1 * MiB;
constexpr size_t WS_ROUTE = WS_PB + 16 * MiB;
constexpr size_t WS_PART = WS_ROUTE + 1 * MiB;
constexpr size_t WS_PP = WS_PART;
constexpr size_t WS_MERGED = WS_PART + 64 * MiB;
constexpr size_t WS_Y = WS_MERGED + 32 * MiB;
constexpr size_t WS_YDN = WS_Y, WS_YSSM = WS_Y + 24 * MiB, WS_YATT = WS_Y + 48 * MiB, WS_OG = WS_Y + 56 * MiB, WS_LSE = WS_Y + 80 * MiB;
constexpr size_t WS_YPAIR = WS_Y;
constexpr size_t WS_PROJ = WS_Y + 81 * MiB;
constexpr size_t WS_PDN = WS_PROJ, WS_PSSM = WS_PDN + 96 * MiB, WS_SMALL = WS_PSSM + 64 * MiB, WS_QK = WS_SMALL + 2 * MiB, WS_VT = WS_QK + 48 * MiB, WS_GATES = WS_VT + 24 * MiB;
constexpr size_t WS_ACT = WS_PROJ, WS_ACTM = WS_PROJ;
constexpr int KSPL = 7, TAILMAX = 32;
constexpr size_t WS_PARTK = WS_PROJ + 256 * MiB;
static_assert((size_t)MOE_SLOTS * EXD * 2 <= 256 * MiB && WS_PARTK + (size_t)KSPL * (TAILMAX / 4) * 256 * 1024 * 4 <= WS_PROJ + 330 * MiB, "partk");
constexpr size_t WS_SCR = WS_PROJ + 330 * MiB;
constexpr size_t WS_XB2 = WS_SCR;
constexpr size_t WS_SSQ2 = WS_XB2 + 32 * MiB;
constexpr size_t WS_PART2 = WS_XB2 + 40 * MiB;
constexpr int DNS_ITEM = 73728;
constexpr size_t WS_DNS = WS_SCR + 40 * MiB;
constexpr size_t WS_DNEGL = WS_DNS + (size_t)NB * 32 * 6 * DNS_ITEM;
constexpr size_t WS_END = WS_SCR + 200 * MiB;
constexpr size_t WS_SSCD = WS_DNEGL + 8192;
static_assert(WS_SSCD + 16384 <= WS_END, "dn scratch");
constexpr size_t WS_SSPV = WS_SCR + 150 * MiB;
static_assert(WS_SSCD + 16384 <= WS_SSPV && WS_SSPV + 48 * MiB <= WS_END, "ssd prev");
constexpr size_t WS_SSST = WS_PART + 48 * MiB;
static_assert(WS_MERGED == WS_PART + 64 * MiB && (size_t)NB * 32 * 12 * 8192 * 2 <= 48 * MiB, "ssd states (bf16) sit in PART[48, 64) | MERGED, both idle during the mixers");
static_assert((size_t)MOE_SLOTS * EXD * 2 <= 330 * MiB, "moe act overlay");
static_assert((size_t)MOE_SLOTS * D * 2 <= 81 * MiB, "ypair overlay");
static_assert(WS_END <= 1024 * MiB, "workspace");
constexpr int RT_TOPE = 0, RT_TOPP = 2 * TC, RT_TOPW = 4 * TC, RT_TOPS = 6 * TC, RT_IDX = 8 * TC;
static_assert((size_t)(RT_IDX + MOE_SLOTS) * 4 <= MiB, "route");
constexpr int CW_BAR = 4096;
constexpr int CW_BAR2 = 8192;
constexpr int CW_SUB = 20480;
constexpr int CW_CNT = 16384;

constexpr int LDS_BYTES = 147456;
__device__ __forceinline__ int htid() { int t = threadIdx.x; asm volatile("" : "+v"(t)); return t; }
__device__ __forceinline__ float bf2f(bf16_t b) { return __uint_as_float(((unsigned)b) << 16); }
__device__ __forceinline__ unsigned f2bf(float f) { unsigned u = __float_as_uint(f); return (u + 0x7fffu + ((u >> 16) & 1u)) >> 16; }
typedef __bf16 bf16x2_t __attribute__((ext_vector_type(2)));
__device__ __forceinline__ unsigned pk2(float lo, float hi) { const f32x2 v = {lo, hi}; return __builtin_bit_cast(unsigned, __builtin_convertvector(v, bf16x2_t)); }
#define ST2_BF(PA, PB, A, B) do { const unsigned pw_ = pk2((A), (B)); *(PA) = (bf16_t)(pw_ & 0xffffu); *(PB) = (bf16_t)(pw_ >> 16); } while (0)
__device__ __forceinline__ float lo_bf(unsigned w) { return __uint_as_float(w << 16); }
__device__ __forceinline__ float hi_bf(unsigned w) { return __uint_as_float(w & 0xffff0000u); }
__device__ __forceinline__ float fexp(float x) { return __builtin_amdgcn_exp2f(x * 1.4426950408889634f); }
__device__ __forceinline__ float sigmoidf_(float x) { return __builtin_amdgcn_rcpf(1.f + fexp(-x)); }
__device__ __forceinline__ float siluf_(float x) { return x * sigmoidf_(x); }
__device__ __forceinline__ float softplusf_(float x) { const float e = fexp(x); return x > 20.f ? x : (x < -9.f ? e : __builtin_amdgcn_logf(1.f + e) * 0.6931471805599453f); }
__device__ __forceinline__ float q8(float v) {
    if (!EMU_FP8) return v;
    const float a = fabsf(v); float r;
    if (a < 0.015625f) r = rintf(a * 512.f) * (1.f / 512.f);
    else { unsigned u = __float_as_uint(a); u += 0x7FFFFu + ((u >> 20) & 1u); u &= ~0xFFFFFu; r = fminf(__uint_as_float(u), 448.f); }
    return copysignf(r, v);
}
__device__ __forceinline__ f32x4 q8v(f32x4 v) { return (f32x4){q8(v[0]), q8(v[1]), q8(v[2]), q8(v[3])}; }
__device__ __forceinline__ float wave_sum(float v) {
#pragma unroll
    for (int o = 1; o < 64; o <<= 1) v += __shfl_xor(v, o);
    return v;
}
__device__ __forceinline__ float wave_max(float v) {
#pragma unroll
    for (int o = 1; o < 64; o <<= 1) v = fmaxf(v, __shfl_xor(v, o));
    return v;
}
__device__ __forceinline__ float rstd_of(const float* ssq, int row) {
    const f32x4* p = (const f32x4*)(ssq + (size_t)row * 16);
    const f32x4 a = p[0], b = p[1], c = p[2], d = p[3];
    const float s = (((a.x + a.y) + (a.z + a.w)) + ((b.x + b.y) + (b.z + b.w))) + (((c.x + c.y) + (c.z + c.w)) + ((d.x + d.y) + (d.z + d.w)));
    return rsqrtf(s * (1.f / 1024.f) + EPS);
}
__device__ __forceinline__ int token_of_pos(int d, int p) {
    const int b = p >> 11, q = p & 2047;
    const int t = (d == 1) ? q : (d == 4) ? (4 * (q & 511) + (q >> 9)) : (16 * (q & 127) + (q >> 7));
    return b * 2048 + t;
}

#define XB_TMO      128
#define XB_XCNT(j)  (256  + 64 * (j))
#define XB_XSUB(j)  (1280 + 64 * (j))
#define XB_XGEN(j)  (2304 + 64 * (j))
#define XB_TOP      3328
#define XB_TOPGEN   3392
#define XCD_BAR_WORDS 3456
#define XB_SPIN_CAP (1u << 22)
__device__ __forceinline__ unsigned xb_ld(unsigned* p)              { return __hip_atomic_load(p, __ATOMIC_RELAXED, __HIP_MEMORY_SCOPE_AGENT); }
__device__ __forceinline__ unsigned xb_add(unsigned* p, unsigned v) { return __hip_atomic_fetch_add(p, v, __ATOMIC_RELAXED, __HIP_MEMORY_SCOPE_AGENT); }
__device__ __forceinline__ unsigned xb_xcc_id() { return (unsigned)__builtin_amdgcn_s_getreg((3 << 11) | 20) & 0xFu; }
#define XB_SPIN(cond, bar) do { unsigned _sp = 0; while (cond) { __builtin_amdgcn_s_sleep(1); \
    if ((++_sp & 255u) == 0u) { if (xb_ld(&(bar)[XB_TMO])) break; if (_sp > XB_SPIN_CAP) { atomicAdd(&(bar)[XB_TMO], 1u); break; } } } } while (0)
struct XcdBarrier { unsigned* bar; unsigned x; volatile LAS unsigned* st; };
__device__ __forceinline__ XcdBarrier xcd_barrier_post(unsigned* bar, volatile LAS unsigned* st) {
    XcdBarrier b; b.bar = bar; b.x = xb_xcc_id(); b.st = st;
    if (threadIdx.x == 0) (void)xb_add(&bar[XB_XCNT(b.x)], 1u);
    return b;
}
__device__ __forceinline__ void xcd_barrier_complete(unsigned* bar, unsigned x, unsigned& nloc, unsigned& nx, unsigned G) {
    unsigned sum, cnt, mine, sp = 0u;
    for (;;) {
        sum = 0u; cnt = 0u; mine = 0u;
#pragma unroll 1
        for (unsigned j = 0; j < 16; ++j) { const unsigned c = xb_ld(&bar[XB_XCNT(j)]); sum += c; cnt += (c > 0u) ? 1u : 0u; }
        mine = xb_ld(&bar[XB_XCNT(x)]);
        if (sum == G) break;
        __builtin_amdgcn_s_sleep(1);
        if ((++sp & 255u) == 0u) { if (xb_ld(&bar[XB_TMO])) break; if (sp > XB_SPIN_CAP) { atomicAdd(&bar[XB_TMO], 1u); break; } }
    }
    nloc = mine > 0u ? mine : 1u; nx = cnt > 0u ? cnt : 1u;
}
__device__ __forceinline__ void xcd_barrier(const XcdBarrier& b, unsigned nparts = 0u) {
    asm volatile("s_waitcnt vmcnt(0)" ::: "memory");
    __syncthreads();
    if (threadIdx.x == 0) {
        unsigned* bar = b.bar;
        __builtin_amdgcn_s_waitcnt(0);
        unsigned nloc = b.st[0], nx = b.st[1];
        if (nloc == 0u) { xcd_barrier_complete(bar, b.x, nloc, nx, nparts ? nparts : gridDim.x * gridDim.y * gridDim.z); b.st[0] = nloc; b.st[1] = nx; }
        const unsigned old = xb_add(&bar[XB_XSUB(b.x)], 1u);
        const unsigned gen = old / nloc;
        if (old + 1u == (gen + 1u) * nloc) {
            __builtin_amdgcn_fence(__ATOMIC_RELEASE, "agent");
            asm volatile("s_waitcnt vmcnt(0)" ::: "memory");
            const unsigned og = xb_add(&bar[XB_TOP], 1u);
            const unsigned tg = og / nx;
            if (og + 1u == (tg + 1u) * nx) xb_add(&bar[XB_TOPGEN], 1u);
            else XB_SPIN(xb_ld(&bar[XB_TOPGEN]) == tg, bar);
            __builtin_amdgcn_fence(__ATOMIC_ACQUIRE, "agent");
            xb_add(&bar[XB_XGEN(b.x)], 1u);
            asm volatile("s_waitcnt vmcnt(0)" ::: "memory");
        } else {
            XB_SPIN(xb_ld(&bar[XB_XGEN(b.x)]) == gen, bar);
            __builtin_amdgcn_fence(__ATOMIC_ACQUIRE, "agent");
            asm volatile("s_waitcnt vmcnt(0)" ::: "memory");
        }
    }
    __syncthreads();
}

constexpr int BM = 256, BK = 64, HALF = 128, HTB = HALF * BK * 2, STAGE_BYTES = 8 * HTB, NXCD = 8, WGM = 4;
__device__ __forceinline__ int lds_byte(int r, int c) { const int st = (r >> 4) * 2 + (c >> 5), rr = r & 15, cc = c & 31, ob = rr * 64 + cc * 2; return st * 1024 + (ob ^ (((ob >> 9) & 1) << 5)); }
__device__ __forceinline__ void stage_rc(int b, int& R, int& C) { const int st = b / 1024, sb = b % 1024, swz = sb ^ (((sb >> 9) & 1) << 5); R = (st >> 1) * 16 + swz / 64; C = (st & 1) * 32 + (swz % 64) / 2; }
__device__ __forceinline__ int perm32(int rho) { const int n = rho >> 4, i = rho & 15; return 8 * (i >> 2) + 4 * n + (i & 3); }

struct Unit { int pm, pn; };
struct StaticOrder {
    int nM, nN, nwg, G, c;
    __device__ __forceinline__ void init(int nM_, int nN_, int G_, int c_) { nM = nM_; nN = nN_; nwg = nM * nN; G = G_; c = c_; }
    __device__ __forceinline__ bool next(int i, Unit& u) const {
        const long L = (long)i * G + c; if (L >= nwg) return false;
        int wgid = (int)L; { const int q = nwg / NXCD, r = nwg % NXCD, xcd = wgid % NXCD, off = wgid / NXCD; wgid = (xcd < r ? xcd * (q + 1) : r * (q + 1) + (xcd - r) * q) + off; }
        const int nig = WGM * nN, gid = wgid / nig, fm = gid * WGM, gsz = (nM - fm) < WGM ? (nM - fm) : WGM;
        u.pm = fm + ((wgid % nig) % gsz); u.pn = (wgid % nig) / gsz; return true;
    }
};
struct GU { const char* A; const char* B; int lda, ldb, nt, mapA, mapB; const int* idx; int pm, pn, sub, aux; };
__device__ __forceinline__ unsigned row_off(int map, int RR, int ld, const int* idx) {
    int row;
    if (map == 0) row = RR;
    else if (map == 4) row = 4 * RR;
    else if (map == 16) row = 16 * (RR & 127) + (RR >> 7);
    else row = idx[RR];
    return (unsigned)row * (unsigned)ld;
}
template <class Prog>
__device__ __forceinline__ void gemm_phase(LAS unsigned char* lds, const Prog& P) {
    const int tid = htid(), wid = __builtin_amdgcn_readfirstlane(tid >> 6), lane = tid & 63, wr = wid >> 2, wc = wid & 3, fr = lane & 15, fq = lane >> 4;
    GU cur, nxt; int ui = 0;
    if (!P.unit(0, cur)) return;
    unsigned vA[4], vB[4];
#define G_SETV(u) do { int tz_ = threadIdx.x; asm volatile("" : "+v"(tz_)); int R0, C0, R1, C1; stage_rc(tz_ * 16, R0, C0); stage_rc(tz_ * 16 + 8192, R1, C1); \
        const int Rb0 = (R0 & ~31) + perm32(R0 & 31), Rb1 = (R1 & ~31) + perm32(R1 & 31); \
        vA[0] = row_off((u).mapA, R0, (u).lda, (u).idx) + C0 * 2; vA[1] = row_off((u).mapA, R1, (u).lda, (u).idx) + C1 * 2; \
        vA[2] = row_off((u).mapA, R0 + 128, (u).lda, (u).idx) + C0 * 2; vA[3] = row_off((u).mapA, R1 + 128, (u).lda, (u).idx) + C1 * 2; \
        vB[0] = row_off((u).mapB, Rb0, (u).ldb, nullptr) + C0 * 2; vB[1] = row_off((u).mapB, Rb1, (u).ldb, nullptr) + C1 * 2; \
        vB[2] = row_off((u).mapB, Rb0 + 128, (u).ldb, nullptr) + C0 * 2; vB[3] = row_off((u).mapB, Rb1 + 128, (u).ldb, nullptr) + C1 * 2; } while (0)
    G_SETV(cur);
    const unsigned ldsw = (unsigned)wid * 1024u;
    const int aoff = lds_byte(wr * 64 + fr, fq * 8), boff = lds_byte(wc * 32 + fr, fq * 8);
#define G_SA(b, h) (((b) * 2 + (h)) * HTB)
#define G_SB(b, h) ((4 + (b) * 2 + (h)) * HTB)
#define G_STAGE(bufoff, gbase, v, h) do { \
        __builtin_amdgcn_global_load_lds((const unsigned*)((gbase) + (v)[2 * (h)]), (LAS unsigned*)(lds + (bufoff) + ldsw), 16, 0, 0); \
        __builtin_amdgcn_global_load_lds((const unsigned*)((gbase) + (v)[2 * (h) + 1]), (LAS unsigned*)(lds + (bufoff) + ldsw + 8192), 16, 0, 0); } while (0)
#define G_LDA(dst, b, h) do { _Pragma("unroll") for (int m = 0; m < 4; ++m) _Pragma("unroll") for (int k = 0; k < 2; ++k) dst[m][k] = *(const LAS bf16x8*)(lds + G_SA(b, h) + aoff + m * 2048 + k * 1024); } while (0)
#define G_LDB(dst, b, h) do { _Pragma("unroll") for (int n = 0; n < 2; ++n) _Pragma("unroll") for (int k = 0; k < 2; ++k) dst[n][k] = *(const LAS bf16x8*)(lds + G_SB(b, h) + boff + n * 2048 + k * 1024); } while (0)
#define G_MMA(ai, bj, At, Bt) do { __builtin_amdgcn_s_setprio(1); _Pragma("unroll") for (int m = 0; m < 4; ++m) _Pragma("unroll") for (int n = 0; n < 2; ++n) _Pragma("unroll") for (int k = 0; k < 2; ++k) \
        acc[ai][bj][m][n] = __builtin_amdgcn_mfma_f32_16x16x32_bf16(Bt[n][k], At[m][k], acc[ai][bj][m][n], 0, 0, 0); __builtin_amdgcn_s_setprio(0); } while (0)
#define G_WAIT_V(n) asm volatile("s_waitcnt vmcnt(" #n ")" ::: "memory")
#define G_WAIT_L(n) asm volatile("s_waitcnt lgkmcnt(" #n ")" ::: "memory")
#define G_BAR __builtin_amdgcn_s_barrier()
#define G_SCHED __builtin_amdgcn_sched_barrier(0)
    f32x4 acc[2][2][4][2];
#pragma unroll
    for (int a = 0; a < 2; ++a)
#pragma unroll
        for (int b = 0; b < 2; ++b)
#pragma unroll
            for (int m = 0; m < 4; ++m)
#pragma unroll
                for (int n = 0; n < 2; ++n) acc[a][b][m][n] = (f32x4){0.f, 0.f, 0.f, 0.f};
    bf16x8 At[4][2], B0[2][2], B1[2][2];
    const char* cA = cur.A; const char* cB = cur.B;
    const size_t kstep = (size_t)(BK * 2);
    G_STAGE(G_SB(0, 0), cB, vB, 0); G_STAGE(G_SA(0, 0), cA, vA, 0); G_STAGE(G_SB(0, 1), cB, vB, 1); G_STAGE(G_SA(0, 1), cA, vA, 1);
    if (wr == 1) G_BAR;
    G_WAIT_V(4); G_BAR;
    G_STAGE(G_SB(1, 0), cB + kstep, vB, 0); G_STAGE(G_SA(1, 0), cA + kstep, vA, 0); G_STAGE(G_SB(1, 1), cB + kstep, vB, 1);
    G_WAIT_V(6); G_BAR;
    for (;;) {
        const bool has_next = P.unit(ui + 1, nxt);
        const char* nA = has_next ? nxt.A : cA; const char* nB = has_next ? nxt.B : cB;
        const int nt = cur.nt;
        for (int t = 0; t < nt; t += 2) {
            const bool last = (t == nt - 2);
            const char* a1 = cA + (size_t)(t + 1) * kstep;
            const char* a2 = last ? nA : cA + (size_t)(t + 2) * kstep; const char* b2 = last ? nB : cB + (size_t)(t + 2) * kstep;
            const char* a3 = a2 + kstep; const char* b3 = b2 + kstep;
            G_STAGE(G_SA(1, 1), a1, vA, 1);
            if (last && has_next) { G_SETV(nxt); }
            G_LDB(B0, 0, 0); G_SCHED; G_LDA(At, 0, 0);
            G_WAIT_L(8); G_BAR; G_WAIT_L(0); G_MMA(0, 0, At, B0); G_BAR; G_SCHED;
            G_LDB(B1, 0, 1); G_STAGE(G_SB(0, 0), b2, vB, 0);
            G_BAR; G_WAIT_L(0); G_MMA(0, 1, At, B1); G_BAR;
            G_LDA(At, 0, 1); G_STAGE(G_SA(0, 0), a2, vA, 0);
            G_BAR; G_WAIT_L(0); G_MMA(1, 0, At, B0); G_BAR; G_SCHED;
            G_STAGE(G_SB(0, 1), b2, vB, 1);
            G_WAIT_V(6); G_BAR; G_MMA(1, 1, At, B1); G_BAR;
            G_LDB(B0, 1, 0); G_SCHED; G_LDA(At, 1, 0); G_STAGE(G_SA(0, 1), a2, vA, 1);
            G_WAIT_L(8); G_BAR; G_WAIT_L(0); G_MMA(0, 0, At, B0); G_BAR; G_SCHED;
            G_LDB(B1, 1, 1); G_STAGE(G_SB(1, 0), b3, vB, 0);
            G_BAR; G_WAIT_L(0); G_MMA(0, 1, At, B1); G_BAR;
            G_LDA(At, 1, 1); G_STAGE(G_SA(1, 0), a3, vA, 0);
            G_BAR; G_WAIT_L(0); G_MMA(1, 0, At, B0); G_BAR; G_SCHED;
            G_STAGE(G_SB(1, 1), b3, vB, 1);
            G_WAIT_V(6); G_BAR; G_MMA(1, 1, At, B1); G_BAR;
        }
        { int tz_ = threadIdx.x; asm volatile("" : "+v"(tz_)); const int ln_ = tz_ & 63; P.epi(acc, cur, wr, wc, ln_ & 15, ln_ >> 4); }
        if (!has_next) break;
        if (!P.keep(cur))
#pragma unroll
        for (int a = 0; a < 2; ++a)
#pragma unroll
            for (int b = 0; b < 2; ++b)
#pragma unroll
                for (int m = 0; m < 4; ++m)
#pragma unroll
                    for (int n = 0; n < 2; ++n) acc[a][b][m][n] = (f32x4){0.f, 0.f, 0.f, 0.f};
        cur = nxt; cA = nA; cB = nB; ++ui;
    }
    G_WAIT_V(0);
    if (wr == 0) G_BAR;
    G_BAR;
#undef G_SETV
#undef G_SA
#undef G_SB
#undef G_STAGE
#undef G_LDA
#undef G_LDB
#undef G_MMA
#undef G_WAIT_V
#undef G_WAIT_L
#undef G_BAR
#undef G_SCHED
}

__device__ __forceinline__ void st_bf8(bf16_t* p, const f32x4 a, const f32x4 b) {
    u32x4 w; w.x = pk2(a[0], a[1]); w.y = pk2(a[2], a[3]); w.z = pk2(b[0], b[1]); w.w = pk2(b[2], b[3]);
    *(u32x4*)p = w;
}
__device__ __forceinline__ void ld_bf8(const bf16_t* p, f32x4& a, f32x4& b) {
    const u32x4 w = *(const u32x4*)p;
    a = (f32x4){lo_bf(w.x), hi_bf(w.x), lo_bf(w.y), hi_bf(w.y)}; b = (f32x4){lo_bf(w.z), hi_bf(w.z), lo_bf(w.w), hi_bf(w.w)};
}
__device__ __forceinline__ float sq8(const f32x4 a, const f32x4 b) { return ((a[0] * a[0] + a[1] * a[1]) + (a[2] * a[2] + a[3] * a[3])) + ((b[0] * b[0] + b[1] * b[1]) + (b[2] * b[2] + b[3] * b[3])); }

#define EPI_ROWS(ai, m) _Pragma("unroll") for (int ai = 0; ai < 2; ++ai) _Pragma("unroll") for (int m = 0; m < 4; ++m)
#define EPI_FENCE asm volatile("" ::: "memory")
#define EPI_SC(ai, m) __shfl((ai) ? r1_ : r0_, (m) * 16 + fr)

struct ProgIn {
    __device__ __forceinline__ bool keep(const GU&) const { return false; }
    StaticOrder S; const bf16_t* xb; const bf16_t* Wt; const float* ssq; unsigned char* wsb;
    const bf16_t* pb; const bf16_t* wple;
    __device__ __forceinline__ bool unit(int i, GU& u) const {
        Unit t;
        if (!S.next(i, t)) {
            const int rem = S.nwg % S.G, nfull = S.nwg / S.G, idle = rem == 0 ? S.G : S.G - rem, per = (256 + idle - 1) / idle;
            const int rk = rem == 0 ? S.c : S.c - rem, k = i - nfull;
            if (rk < 0 || k < 0 || k >= per) return false;
            const int pu = rk * per + k; if (pu >= 256) return false;
            u.pm = pu >> 2; u.pn = 64 + (pu & 3); u.sub = 0; u.aux = 0; u.nt = 4; u.idx = nullptr; u.lda = 512; u.ldb = 512; u.mapA = 0; u.mapB = 0;
            u.A = (const char*)pb + (size_t)(pu >> 2) * 256 * 512; u.B = (const char*)wple + (size_t)(pu & 3) * 256 * 512; return true;
        }
        u.pm = t.pm; u.pn = t.pn; u.sub = 0; u.aux = 0; u.nt = 16; u.idx = nullptr; u.lda = 2048; u.ldb = 2048;
        const char* w = (const char*)Wt + (size_t)t.pn * 256 * 2048;
        int g = 0; bool isvt = false;
        if (t.pn >= 20 && t.pn < 29) { g = (t.pn - 20) % 3; isvt = t.pn >= 26; }
        const int d = g == 0 ? 1 : (g == 1 ? 4 : 16);
        const int b = t.pm >> 3, tb = t.pm & 7;
        const int base = b * 2048 + (d == 1 ? 256 * tb : d == 4 ? 1024 * (tb & 1) + (tb >> 1) : 2 * tb);
        const char* x = (const char*)xb + (size_t)base * 2048;
        const int mapx = d == 1 ? 0 : d;
        if (!isvt) { u.A = x; u.mapA = mapx; u.B = w; u.mapB = 0; }
        else { u.A = w; u.mapA = 0; u.B = x; u.mapB = mapx; }
        return true;
    }
    __device__ __forceinline__ void epi(f32x4 (&acc)[2][2][4][2], const GU& u, int wr, int wc, int fr, int fq) const {
        const int pn = u.pn, pm = u.pm, rl0 = wr * 64 + fr, cl0 = wc * 32 + 8 * fq;
        if (pn >= 64) {
            EPI_ROWS(ai, m) { bf16_t* o = (bf16_t*)(wsb + WS_PP) + (size_t)(pm * 256 + ai * 128 + m * 16 + rl0) * 1024 + (pn - 64) * 256 + cl0;
#pragma unroll
                for (int bj = 0; bj < 2; ++bj) st_bf8(o + bj * 128, acc[ai][bj][m][0], acc[ai][bj][m][1]); }
            return;
        }
        if (pn >= 26 && pn < 29) {
            const int g = pn - 26, d = g == 0 ? 1 : (g == 1 ? 4 : 16), ln = fq * 16 + fr;
            const float rc = rstd_of(ssq, token_of_pos(d, pm * 256 + (ln >> 5) * 128 + wc * 32 + (ln & 31)));
            f32x4 s[2][2];
#pragma unroll
            for (int bj = 0; bj < 2; ++bj)
#pragma unroll
                for (int j = 0; j < 8; ++j) s[bj][j >> 2][j & 3] = __shfl(rc, bj * 32 + 8 * fq + j);
            EPI_ROWS(ai, m) { const int ch = ai * 128 + m * 16 + rl0; bf16_t* o = (bf16_t*)(wsb + WS_VT) + (size_t)(g * 256 + ch) * TC + pm * 256 + cl0;
#pragma unroll
                for (int bj = 0; bj < 2; ++bj) st_bf8(o + bj * 128, acc[ai][bj][m][0] * s[bj][0], acc[ai][bj][m][1] * s[bj][1]); }
            return;
        }
        int d = 1; if (pn >= 20 && pn < 26) { const int g = (pn - 20) % 3; d = g == 0 ? 1 : (g == 1 ? 4 : 16); }
        const float r0_ = rstd_of(ssq, token_of_pos(d, pm * 256 + fq * 16 + rl0)), r1_ = rstd_of(ssq, token_of_pos(d, pm * 256 + 128 + fq * 16 + rl0));
        if (pn < 20) {
            bf16_t* base = pn < 12 ? (bf16_t*)(wsb + WS_PDN) + pn * 256 : (bf16_t*)(wsb + WS_PSSM) + (pn - 12) * 256; const int ld = pn < 12 ? 3072 : 2048;
            EPI_ROWS(ai, m) { const int row = pm * 256 + ai * 128 + m * 16 + rl0; const float s = EPI_SC(ai, m); bf16_t* o = base + (size_t)row * ld + cl0;
#pragma unroll
                for (int bj = 0; bj < 2; ++bj) st_bf8(o + bj * 128, acc[ai][bj][m][0] * s, acc[ai][bj][m][1] * s); }
        } else if (pn < 26) {
            const int which = (pn - 20) / 3, g = (pn - 20) % 3; const float qs = which == 0 ? 0.125f : 1.f;
            bf16_t* base = (bf16_t*)(wsb + WS_QK) + (size_t)(which * 3 + g) * TC * 256;
            EPI_ROWS(ai, m) { const int p = pm * 256 + ai * 128 + m * 16 + rl0; const float s = EPI_SC(ai, m) * qs; bf16_t* o = base + (size_t)p * 256 + cl0;
#pragma unroll
                for (int bj = 0; bj < 2; ++bj) st_bf8(o + bj * 128, acc[ai][bj][m][0] * s, acc[ai][bj][m][1] * s); }
        } else if (pn < 41) {
            bf16_t* base = (bf16_t*)(wsb + WS_GATES) + (pn - 29) * 256;
            EPI_ROWS(ai, m) { const int row = pm * 256 + ai * 128 + m * 16 + rl0; const float s = EPI_SC(ai, m); bf16_t* o = base + (size_t)row * 3072 + cl0;
#pragma unroll
                for (int bj = 0; bj < 2; ++bj) { f32x4 a = acc[ai][bj][m][0] * s, b = acc[ai][bj][m][1] * s;
#pragma unroll
                    for (int j = 0; j < 4; ++j) { a[j] = sigmoidf_(a[j]); b[j] = sigmoidf_(b[j]); }
                    st_bf8(o + bj * 128, a, b); } }
        } else {
            EPI_ROWS(ai, m) { const int row = pm * 256 + ai * 128 + m * 16 + rl0; const float s = EPI_SC(ai, m);
                if (wc == 0) { float* o = (float*)(wsb + WS_SMALL) + (size_t)row * 32 + 8 * fq; *(f32x4*)o = acc[ai][0][m][0] * s; *(f32x4*)(o + 4) = acc[ai][0][m][1] * s; } }
        }
    }
};

struct ProgMerge {
    StaticOrder S; const bf16_t *wdn, *wssm, *watt; unsigned char* wsb;
    __device__ __forceinline__ bool keep(const GU& u) const { return u.sub < 2; }
    __device__ __forceinline__ bool unit(int i, GU& u) const {
        Unit t; if (!S.next(i / 3, t)) return false;
        const int sub = i % 3;
        u.pm = t.pm; u.pn = t.pn; u.sub = sub; u.aux = 0; u.idx = nullptr; u.mapA = 0; u.mapB = 0;
        if (sub < 2) { u.lda = 1536; u.ldb = 1536; u.nt = 12; u.A = (const char*)(wsb + (sub == 0 ? WS_YDN : WS_YSSM)) + (size_t)t.pm * 256 * 1536; u.B = (const char*)(sub == 0 ? wdn : wssm) + (size_t)t.pn * 256 * 1536; }
        else { u.lda = 512; u.ldb = 512; u.nt = 4; u.A = (const char*)(wsb + WS_YATT) + (size_t)t.pm * 256 * 512; u.B = (const char*)watt + (size_t)t.pn * 256 * 512; }
        return true;
    }
    __device__ __forceinline__ void epi(f32x4 (&acc)[2][2][4][2], const GU& u, int wr, int wc, int fr, int fq) const {
        const int rl0 = wr * 64 + fr, cl0 = wc * 32 + 8 * fq, sub = u.sub;
        const bf16_t* gp0 = (const bf16_t*)(wsb + WS_GATES) + (size_t)(u.pm * 256 + rl0) * 3072 + u.pn * 256 + cl0 + sub * 1024;
#pragma unroll
        for (int ai = 0; ai < 2; ++ai) {
            u32x4 gw[4][2], hw[4][2];
            if (sub < 2) {
#pragma unroll
                for (int m = 0; m < 4; ++m)
#pragma unroll
                    for (int bj = 0; bj < 2; ++bj) { const bf16_t* gp = gp0 + (size_t)(ai * 128 + m * 16) * 3072 + bj * 128; gw[m][bj] = *(const u32x4*)gp; hw[m][bj] = *(const u32x4*)(gp + 1024); }
            } else {
#pragma unroll
                for (int m = 0; m < 4; ++m)
#pragma unroll
                    for (int bj = 0; bj < 2; ++bj) { const bf16_t* gp = gp0 + (size_t)(ai * 128 + m * 16) * 3072 + bj * 128; gw[m][bj] = *(const u32x4*)gp; hw[m][bj] = gw[m][bj]; }
            }
#pragma unroll
            for (int m = 0; m < 4; ++m)
#pragma unroll
                for (int bj = 0; bj < 2; ++bj) { const int row = u.pm * 256 + ai * 128 + m * 16 + rl0, col = u.pn * 256 + bj * 128 + cl0;
                    f32x4 g0 = (f32x4){lo_bf(gw[m][bj].x), hi_bf(gw[m][bj].x), lo_bf(gw[m][bj].y), hi_bf(gw[m][bj].y)}, g1 = (f32x4){lo_bf(gw[m][bj].z), hi_bf(gw[m][bj].z), lo_bf(gw[m][bj].w), hi_bf(gw[m][bj].w)};
                    if ((DBG_ABL >> sub) & 1) { acc[ai][bj][m][0] = (f32x4){0.f, 0.f, 0.f, 0.f}; acc[ai][bj][m][1] = acc[ai][bj][m][0]; }
#pragma unroll
                    for (int j = 0; j < 4; ++j) { g0[j] = fmaxf(g0[j], 1e-8f); g1[j] = fmaxf(g1[j], 1e-8f); }
                    if (sub < 2) { const f32x4 h0 = (f32x4){lo_bf(hw[m][bj].x), hi_bf(hw[m][bj].x), lo_bf(hw[m][bj].y), hi_bf(hw[m][bj].y)}, h1 = (f32x4){lo_bf(hw[m][bj].z), hi_bf(hw[m][bj].z), lo_bf(hw[m][bj].w), hi_bf(hw[m][bj].w)};
#pragma unroll
                        for (int j = 0; j < 4; ++j) { acc[ai][bj][m][0][j] *= g0[j] * __builtin_amdgcn_rcpf(fmaxf(h0[j], 1e-8f)); acc[ai][bj][m][1][j] *= g1[j] * __builtin_amdgcn_rcpf(fmaxf(h1[j], 1e-8f)); } }
                    else st_bf8((bf16_t*)(wsb + WS_MERGED) + (size_t)row * 1024 + col, acc[ai][bj][m][0] * g0, acc[ai][bj][m][1] * g1); }
            EPI_FENCE;
        }
    }
};

struct ProgResid {
    __device__ __forceinline__ bool keep(const GU&) const { return false; }
    StaticOrder S; const bf16_t* A; int lda, nt; const bf16_t* Wt; int ldb; const float* xin_f; const bf16_t* xin_b; bf16_t* xb; float* ssq; float sc;
    __device__ __forceinline__ bool unit(int i, GU& u) const {
        Unit t; if (!S.next(i, t)) return false;
        u.pm = t.pm; u.pn = t.pn; u.sub = 0; u.aux = 0; u.idx = nullptr; u.mapA = 0; u.mapB = 0; u.lda = lda; u.ldb = ldb; u.nt = nt;
        u.A = (const char*)A + (size_t)t.pm * 256 * lda; u.B = (const char*)Wt + (size_t)t.pn * 256 * ldb; return true;
    }
    __device__ __forceinline__ void epi(f32x4 (&acc)[2][2][4][2], const GU& u, int wr, int wc, int fr, int fq) const {
        const int rl0 = wr * 64 + fr, cl0 = wc * 32 + 8 * fq;
#pragma unroll
        for (int ai = 0; ai < 2; ++ai) {
            f32x4 xv[4][2][2];
            if (xin_f) {
#pragma unroll
                for (int m = 0; m < 4; ++m)
#pragma unroll
                    for (int bj = 0; bj < 2; ++bj) { const size_t o = (size_t)(u.pm * 256 + ai * 128 + m * 16 + rl0) * 1024 + u.pn * 256 + bj * 128 + cl0; xv[m][bj][0] = *(const f32x4*)(xin_f + o); xv[m][bj][1] = *(const f32x4*)(xin_f + o + 4); }
            } else {
                u32x4 xw[4][2];
#pragma unroll
                for (int m = 0; m < 4; ++m)
#pragma unroll
                    for (int bj = 0; bj < 2; ++bj) xw[m][bj] = *(const u32x4*)(xin_b + (size_t)(u.pm * 256 + ai * 128 + m * 16 + rl0) * 1024 + u.pn * 256 + bj * 128 + cl0);
#pragma unroll
                for (int m = 0; m < 4; ++m)
#pragma unroll
                    for (int bj = 0; bj < 2; ++bj) { const u32x4 w = xw[m][bj]; xv[m][bj][0] = (f32x4){lo_bf(w.x), hi_bf(w.x), lo_bf(w.y), hi_bf(w.y)}; xv[m][bj][1] = (f32x4){lo_bf(w.z), hi_bf(w.z), lo_bf(w.w), hi_bf(w.w)}; }
            }
#pragma unroll
            for (int m = 0; m < 4; ++m) { const int row = u.pm * 256 + ai * 128 + m * 16 + rl0; float ss = 0.f;
#pragma unroll
                for (int bj = 0; bj < 2; ++bj) { const size_t o = (size_t)row * 1024 + u.pn * 256 + bj * 128 + cl0;
                    const f32x4 v0 = acc[ai][bj][m][0] * sc + xv[m][bj][0], v1 = acc[ai][bj][m][1] * sc + xv[m][bj][1];
                    st_bf8(xb + o, v0, v1); ss += sq8(v0, v1); }
                ss += __shfl_xor(ss, 16); ss += __shfl_xor(ss, 32);
                if (fq == 0) ssq[(size_t)row * 16 + u.pn * 4 + wc] = ss; }
            EPI_FENCE;
        }
    }
};

struct ProgFfnGu {
    __device__ __forceinline__ bool keep(const GU&) const { return false; }
    StaticOrder S; const bf16_t* xb; const bf16_t* Wt; const float* ssq; bf16_t* act;
    __device__ __forceinline__ bool unit(int i, GU& u) const {
        Unit t; if (!S.next(i, t)) return false;
        u.pm = t.pm; u.pn = t.pn; u.sub = 0; u.aux = 0; u.idx = nullptr; u.mapA = 0; u.mapB = 0; u.lda = 2048; u.ldb = 2048; u.nt = 16;
        u.A = (const char*)xb + (size_t)t.pm * 256 * 2048; u.B = (const char*)Wt + (size_t)t.pn * 256 * 2048; return true;
    }
    __device__ __forceinline__ void epi(f32x4 (&acc)[2][2][4][2], const GU& u, int wr, int wc, int fr, int fq) const {
        const int rl0 = wr * 64 + fr, cl0 = wc * 32 + 8 * fq;
        const float r0_ = rstd_of(ssq, u.pm * 256 + fq * 16 + rl0), r1_ = rstd_of(ssq, u.pm * 256 + 128 + fq * 16 + rl0);
        EPI_ROWS(ai, m) { const int row = u.pm * 256 + ai * 128 + m * 16 + rl0; const float s = EPI_SC(ai, m);
            f32x4 o[2];
#pragma unroll
            for (int n = 0; n < 2; ++n)
#pragma unroll
                for (int j = 0; j < 4; ++j) { const float g = acc[ai][0][m][n][j] * s, up = acc[ai][1][m][n][j] * s; o[n][j] = q8(siluf_(g) * up); }
            st_bf8(act + (size_t)row * FFN + u.pn * 128 + cl0, o[0], o[1]); }
    }
};

struct ProgPle {
    __device__ __forceinline__ bool keep(const GU&) const { return false; }
    StaticOrder S; const bf16_t *xb, *wpg, *pp; const float* ssq; bf16_t* xbout; float* ssqout;
    __device__ __forceinline__ bool unit(int i, GU& u) const {
        Unit t; if (!S.next(i, t)) return false;
        u.pm = t.pm; u.pn = t.pn; u.sub = 0; u.aux = 0; u.idx = nullptr; u.mapA = 0; u.mapB = 0; u.lda = 2048; u.ldb = 2048; u.nt = 16;
        u.A = (const char*)xb + (size_t)t.pm * 256 * 2048; u.B = (const char*)wpg + (size_t)t.pn * 256 * 2048; return true;
    }
    __device__ __forceinline__ void epi(f32x4 (&acc)[2][2][4][2], const GU& u, int wr, int wc, int fr, int fq) const {
        const int rl0 = wr * 64 + fr, cl0 = wc * 32 + 8 * fq; const float ps = (DBG_ABL & 32) ? 0.f : 1.f;
        const float r0_ = rstd_of(ssq, u.pm * 256 + fq * 16 + rl0), r1_ = rstd_of(ssq, u.pm * 256 + 128 + fq * 16 + rl0);
#pragma unroll
        for (int ai = 0; ai < 2; ++ai)
#pragma unroll
            for (int mh = 0; mh < 2; ++mh) {
                u32x4 xw[2][2], gw[2][2];
#pragma unroll
                for (int m2 = 0; m2 < 2; ++m2)
#pragma unroll
                    for (int bj = 0; bj < 2; ++bj) { const size_t o = (size_t)(u.pm * 256 + ai * 128 + (2 * mh + m2) * 16 + rl0) * 1024 + u.pn * 256 + bj * 128 + cl0;
                        xw[m2][bj] = *(const u32x4*)(xb + o); gw[m2][bj] = *(const u32x4*)(pp + o); }
#pragma unroll
                for (int m2 = 0; m2 < 2; ++m2) { const int m = 2 * mh + m2, row = u.pm * 256 + ai * 128 + m * 16 + rl0; const float sc = EPI_SC(ai, m); float ss = 0.f;
#pragma unroll
                    for (int bj = 0; bj < 2; ++bj) { const size_t o = (size_t)row * 1024 + u.pn * 256 + bj * 128 + cl0; const u32x4 w = gw[m2][bj], xq = xw[m2][bj];
                        const f32x4 p0 = (f32x4){lo_bf(w.x), hi_bf(w.x), lo_bf(w.y), hi_bf(w.y)}, p1 = (f32x4){lo_bf(w.z), hi_bf(w.z), lo_bf(w.w), hi_bf(w.w)};
                        const f32x4 x0 = (f32x4){lo_bf(xq.x), hi_bf(xq.x), lo_bf(xq.y), hi_bf(xq.y)}, x1 = (f32x4){lo_bf(xq.z), hi_bf(xq.z), lo_bf(xq.w), hi_bf(xq.w)};
                        f32x4 g0 = acc[ai][bj][m][0] * sc, g1 = acc[ai][bj][m][1] * sc;
#pragma unroll
                        for (int j = 0; j < 4; ++j) { g0[j] = sigmoidf_(g0[j]); g1[j] = sigmoidf_(g1[j]); }
                        const f32x4 v0 = x0 + p0 * ps * g0, v1 = x1 + p1 * ps * g1;
                        st_bf8(xbout + o, v0, v1); ss += sq8(v0, v1); }
                    ss += __shfl_xor(ss, 16); ss += __shfl_xor(ss, 32);
                    if (fq == 0) ssqout[(size_t)row * 16 + u.pn * 4 + wc] = ss; }
                EPI_FENCE;
            }
    }
};

struct MoeOrder {
    int tl[NE]; int nN, total, G, c;
    __device__ __forceinline__ void init(const unsigned* cnt, int nN_, int G_, int c_) {
        nN = nN_; G = G_; c = c_; int tt = 0;
#pragma unroll
        for (int e = 0; e < NE; ++e) { tl[e] = (int)((__builtin_amdgcn_readfirstlane(cnt[e]) + 255u) >> 8); tt += tl[e]; }
        total = tt * nN;
    }
    __device__ __forceinline__ bool next(int i, int& e, int& pml, int& pn, int& slot0) const {
        const long L = (long)i * G + c; if (L >= total) return false;
        int wgid = (int)L; { const int q = total / NXCD, r = total % NXCD, xcd = wgid % NXCD, off = wgid / NXCD; wgid = (xcd < r ? xcd * (q + 1) : r * (q + 1) + (xcd - r) * q) + off; }
        int ee = 0, ubase = 0, tbase = 0, nMe = tl[0], uacc = 0, tacc = 0;
#pragma unroll
        for (int k = 0; k < NE; ++k) { if (wgid >= uacc) { ee = k; ubase = uacc; tbase = tacc; nMe = tl[k]; } uacc += tl[k] * nN; tacc += tl[k]; }
        const int li = wgid - ubase, nig = WGM * nN, gid = li / nig, fm = gid * WGM, gsz = (nMe - fm) < WGM ? (nMe - fm) : WGM;
        pml = fm + ((li % nig) % gsz); pn = (li % nig) / gsz; e = ee; slot0 = (tbase + pml) * 256; return true;
    }
};
struct ProgMoeGu {
    __device__ __forceinline__ bool keep(const GU&) const { return false; }
    MoeOrder S; const bf16_t* xb; const bf16_t* Wt; const float* ssq; const int* idx; bf16_t* act;
    __device__ __forceinline__ bool unit(int i, GU& u) const {
        int e, pml, pn, slot0; if (!S.next(i, e, pml, pn, slot0)) return false;
        u.pm = slot0; u.pn = pn; u.sub = 0; u.aux = e; u.idx = idx + slot0; u.mapA = 99; u.mapB = 0; u.lda = 2048; u.ldb = 2048; u.nt = 16;
        u.A = (const char*)xb; u.B = (const char*)Wt + ((size_t)e * 7168 + (size_t)pn * 256) * 2048; return true;
    }
    __device__ __forceinline__ void epi(f32x4 (&acc)[2][2][4][2], const GU& u, int wr, int wc, int fr, int fq) const {
        const int rl0 = wr * 64 + fr, cl0 = wc * 32 + 8 * fq;
        const float r0_ = rstd_of(ssq, idx[u.pm + fq * 16 + rl0]), r1_ = rstd_of(ssq, idx[u.pm + 128 + fq * 16 + rl0]);
        EPI_ROWS(ai, m) { const int slot = u.pm + ai * 128 + m * 16 + rl0; const float s = EPI_SC(ai, m);
            f32x4 o[2];
#pragma unroll
            for (int n = 0; n < 2; ++n)
#pragma unroll
                for (int j = 0; j < 4; ++j) { const float g = acc[ai][0][m][n][j] * s, up = acc[ai][1][m][n][j] * s; o[n][j] = q8(siluf_(g) * up); }
            st_bf8(act + (size_t)slot * EXD + u.pn * 128 + cl0, o[0], o[1]); }
    }
};
struct MoeDownPlan { int ntiles, main, tail; };
__device__ __forceinline__ MoeDownPlan moe_down_plan(const unsigned* cnt, int G) {
    MoeDownPlan pl; int nt = 0;
#pragma unroll
    for (int e = 0; e < NE; ++e) nt += (int)((__builtin_amdgcn_readfirstlane(cnt[e]) + 255u) >> 8);
    const int U = 4 * nt; int tail = U % G; if (U < G || tail > TAILMAX) tail = 0;
    pl.ntiles = nt; pl.tail = tail; pl.main = U - tail; return pl;
}
struct ProgMoeDown {
    __device__ __forceinline__ bool keep(const GU&) const { return false; }
    int tl[NE]; MoeDownPlan pl; int G, c; const bf16_t* act; const bf16_t* Wt; bf16_t* ypair; float* partk;
    __device__ __forceinline__ void init(const unsigned* cnt, int G_, int c_) { G = G_; c = c_; pl = moe_down_plan(cnt, G_);
#pragma unroll
        for (int e = 0; e < NE; ++e) tl[e] = (int)((__builtin_amdgcn_readfirstlane(cnt[e]) + 255u) >> 8); }
    __device__ __forceinline__ bool unit(int i, GU& u) const {
        const long L = (long)i * G + c; int w, kp = -1;
        if (L < pl.main) { w = (int)L; const int q = pl.main / NXCD, r = pl.main % NXCD, xcd = w % NXCD, off = w / NXCD; w = (xcd < r ? xcd * (q + 1) : r * (q + 1) + (xcd - r) * q) + off; }
        else { const long s2 = L - pl.main; if (s2 >= (long)pl.tail * KSPL) return false; w = pl.main + (int)(s2 / KSPL); kp = (int)(s2 % KSPL); }
        const int tile = w >> 2, pn = w & 3; int e = 0, tacc = 0;
#pragma unroll
        for (int k = 0; k < NE; ++k) { if (tile >= tacc) e = k; tacc += tl[k]; }
        const int slot0 = tile * 256;
        u.pm = slot0; u.pn = pn; u.aux = e; u.idx = nullptr; u.mapA = 0; u.mapB = 0; u.lda = 7168; u.ldb = 7168;
        u.A = (const char*)act + (size_t)slot0 * 7168; u.B = (const char*)Wt + ((size_t)e * 1024 + (size_t)pn * 256) * 7168;
        if (kp < 0) { u.sub = 0; u.nt = 56; } else { u.sub = 1 + kp; u.nt = 8; u.A += kp * 1024; u.B += kp * 1024; }
        return true;
    }
    __device__ __forceinline__ void epi(f32x4 (&acc)[2][2][4][2], const GU& u, int wr, int wc, int fr, int fq) const {
        const int rl0 = wr * 64 + fr, cl0 = wc * 32 + 8 * fq;
        if (u.sub == 0) {
            EPI_ROWS(ai, m) { const int slot = u.pm + ai * 128 + m * 16 + rl0;
#pragma unroll
                for (int bj = 0; bj < 2; ++bj) st_bf8(ypair + (size_t)slot * 1024 + u.pn * 256 + bj * 128 + cl0, acc[ai][bj][m][0], acc[ai][bj][m][1]); }
        } else {
            float* pk = partk + ((size_t)(u.sub - 1) * (TAILMAX / 4) * 256 + (u.pm - (pl.main >> 2) * 256)) * 1024 + u.pn * 256 + cl0;
            EPI_ROWS(ai, m) { float* o = pk + (size_t)(ai * 128 + m * 16 + rl0) * 1024;
#pragma unroll
                for (int bj = 0; bj < 2; ++bj) { *(f32x4*)(o + bj * 128) = acc[ai][bj][m][0]; *(f32x4*)(o + bj * 128 + 4) = acc[ai][bj][m][1]; } }
        }
    }
};

struct Params { const float* in[30]; float* out; unsigned char* ws; int s_lo, s_hi; unsigned tmask; int pad; };
enum { I_X = 0, I_P, I_MIXN, I_WIN, I_DNCONV, I_DNALOG, I_DNDTB, I_DNNORM, I_SSCONV, I_SSCONVB, I_SSALOG, I_SSDTB, I_SSD, I_SSNORM, I_WBRDN, I_WBRSSM, I_WBRATT, I_WOUT, I_FFNN,
       I_WFG, I_WFU, I_WFD, I_WROUTER, I_WMG, I_WMU, I_WMD, I_PLEN, I_WPLE, I_WPLEG, I_FINALN };

template <class Map>
__device__ __forceinline__ void tr_job(const Map& map, int K, int N, bf16_t* WT, const float* gain, LAS float* scr, int lane, int gw, int NGW, float qs = 0.f) {
    const int nblk = N / 32, nitems = (K / 64) * nblk;
    for (int item = gw; item < nitems; item += NGW) {
        const int kb = item / nblk, nb = item % nblk, k0 = 64 * kb, n0 = 32 * nb;
        int ld = 0; const float* src = map(n0 + (lane & 31), ld);
#pragma unroll
        for (int i = 0; i < 32; ++i) { const int kk = 2 * i + (lane >> 5); float v = 0.f; if (src) { v = src[(size_t)(k0 + kk) * ld]; if (gain) v *= gain[k0 + kk]; if (EMU_FP8 && qs > 0.f) v = q8(v * qs) / qs; } scr[kk * 33 + (lane & 31)] = v; }
        asm volatile("s_waitcnt lgkmcnt(0)" ::: "memory");
        const int c = lane & 7;
#pragma unroll
        for (int j = 0; j < 4; ++j) { const int n = (lane >> 3) + 8 * j; const LAS float* s = scr + (8 * c) * 33 + n;
            u32x4 o; o.x = pk2(s[0 * 33], s[1 * 33]); o.y = pk2(s[2 * 33], s[3 * 33]); o.z = pk2(s[4 * 33], s[5 * 33]); o.w = pk2(s[6 * 33], s[7 * 33]);
            *(u32x4*)(WT + (size_t)(n0 + n) * K + k0 + 8 * c) = o; }
        asm volatile("s_waitcnt lgkmcnt(0)" ::: "memory");
    }
}
struct MapPlain { const float* W; int ld; __device__ __forceinline__ const float* operator()(int n, int& l) const { l = ld; return W + n; } };
struct MapIn { const float* W; __device__ __forceinline__ const float* operator()(int n, int& l) const { l = INW; const int tile = n >> 8, r = n & 255; int col;
        if (tile < 9) col = n; else if (tile < 12) col = C_DNZ + (n - 2304); else if (tile < 17) col = C_XBC + (n - 3072); else if (tile < 20) col = C_SSZ + (n - 4352);
        else if (tile < 29) col = C_ATT + (n - 5120); else if (tile < 41) col = C_GATE + (n - 7424);
        else { if (r < 6) col = C_DNA + r; else if (r < 12) col = C_DNB + (r - 6); else if (r < 24) col = C_SSDT + (r - 12); else return nullptr; }
        return W + col; } };
struct MapGu { const float* Wg; const float* Wu; int ld; __device__ __forceinline__ const float* operator()(int n, int& l) const { l = ld; const int tile = n >> 8, r = n & 255; return r < 128 ? Wg + tile * 128 + r : Wu + tile * 128 + (r - 128); } };

__device__ __forceinline__ void phase_convert(const Params& p, LAS unsigned char* lds) {
    const int tid_ = htid(), lane = tid_ & 63, wave = tid_ >> 6, G = gridDim.x;
    const int gw = blockIdx.x * 8 + wave, NGW = G * 8;
    LAS float* scr = (LAS float*)(lds + wave * 16384);
    unsigned char* ws = p.ws;
    for (int l = 0; l < DEPTH; ++l) {
        tr_job(MapIn{p.in[I_WIN] + (size_t)l * D * INW}, D, INP, (bf16_t*)(ws + WS_WIN) + (size_t)l * INP * D, p.in[I_MIXN] + l * D, scr, lane, gw, NGW);
        tr_job(MapPlain{p.in[I_WBRDN] + (size_t)l * 768 * D, D}, 768, D, (bf16_t*)(ws + WS_WDN) + (size_t)l * D * 768, nullptr, scr, lane, gw, NGW);
        tr_job(MapPlain{p.in[I_WBRSSM] + (size_t)l * 768 * D, D}, 768, D, (bf16_t*)(ws + WS_WSSM) + (size_t)l * D * 768, nullptr, scr, lane, gw, NGW);
        tr_job(MapPlain{p.in[I_WBRATT] + (size_t)l * 256 * D, D}, 256, D, (bf16_t*)(ws + WS_WATT) + (size_t)l * D * 256, nullptr, scr, lane, gw, NGW);
        tr_job(MapPlain{p.in[I_WOUT] + (size_t)l * D * D, D}, D, D, (bf16_t*)(ws + WS_WOUT) + (size_t)l * D * D, nullptr, scr, lane, gw, NGW);
        tr_job(MapPlain{p.in[I_WPLEG] + (size_t)l * D * D, D}, D, D, (bf16_t*)(ws + WS_WPG) + (size_t)l * D * D, p.in[I_PLEN] + l * D, scr, lane, gw, NGW);
        tr_job(MapPlain{p.in[I_WPLE] + (size_t)l * PLE * D, D}, PLE, D, (bf16_t*)(ws + WS_WPLE) + (size_t)l * D * PLE, nullptr, scr, lane, gw, NGW);
    }
    tr_job(MapGu{p.in[I_WFG], p.in[I_WFU], FFN}, D, 2 * FFN, (bf16_t*)(ws + WS_WFGU), p.in[I_FFNN], scr, lane, gw, NGW, 16.f);
    tr_job(MapPlain{p.in[I_WFD], D}, FFN, D, (bf16_t*)(ws + WS_WFD), nullptr, scr, lane, gw, NGW, 16.f);
    for (int e = 0; e < NE; ++e) {
        tr_job(MapGu{p.in[I_WMG] + (size_t)e * D * EXD, p.in[I_WMU] + (size_t)e * D * EXD, EXD}, D, 2 * EXD, (bf16_t*)(ws + WS_WMGU) + (size_t)e * 2 * EXD * D, p.in[I_FFNN] + D, scr, lane, gw, NGW, 16.f);
        tr_job(MapPlain{p.in[I_WMD] + (size_t)e * EXD * D, D}, EXD, D, (bf16_t*)(ws + WS_WMD) + (size_t)e * D * EXD, nullptr, scr, lane, gw, NGW, 16.f);
    }
    float* wr = (float*)(ws + WS_WR);
    for (int i = blockIdx.x * 512 + tid_; i < D * NE; i += G * 512) wr[i] = p.in[I_WROUTER][i] * p.in[I_FFNN][D + (i >> 3)];
}

__device__ __forceinline__ void phase_chunk_in(const Params& p, int chunk) {
    const int tid_ = htid(), lane = tid_ & 63, gw = blockIdx.x * 8 + (tid_ >> 6), NGW = gridDim.x * 8;
    const float* x = p.in[I_X] + (size_t)chunk * TC * D;
    bf16_t* xb = (bf16_t*)(p.ws + WS_XB); float* ssq = (float*)(p.ws + WS_SSQ);
    for (int r0 = gw; r0 < TC; r0 += 2 * NGW) {
        f32x4 v[2][4];
#pragma unroll
        for (int u = 0; u < 2; ++u) { const int r = r0 + u * NGW < TC ? r0 + u * NGW : r0; const f32x4* xr = (const f32x4*)(x + (size_t)r * D) + lane;
#pragma unroll
            for (int j = 0; j < 4; ++j) v[u][j] = xr[64 * j]; }
#pragma unroll
        for (int u = 0; u < 2; ++u) { const int r = r0 + u * NGW; if (r >= TC) break; float s = 0.f; u32x2* o = (u32x2*)(xb + (size_t)r * D) + lane;
#pragma unroll
            for (int j = 0; j < 4; ++j) { const f32x4 t = v[u][j]; s += (t.x * t.x + t.y * t.y) + (t.z * t.z + t.w * t.w); u32x2 w; w.x = pk2(t.x, t.y); w.y = pk2(t.z, t.w); o[64 * j] = w; }
            s = wave_sum(s);
            if (lane < 16) ssq[(size_t)r * 16 + lane] = lane == 0 ? s : 0.f; }
    }
    bf16_t* pb = (bf16_t*)(p.ws + WS_PB);
    for (int r0 = gw; r0 < 2 * TC; r0 += 4 * NGW) {
        f32x4 v[4];
#pragma unroll
        for (int u = 0; u < 4; ++u) { const int r = r0 + u * NGW < 2 * TC ? r0 + u * NGW : r0; const int l = r / TC, rr = r % TC;
            v[u] = *((const f32x4*)(p.in[I_P] + ((size_t)l * BATCH * SEQ + (size_t)chunk * TC + rr) * PLE) + lane); }
#pragma unroll
        for (int u = 0; u < 4; ++u) { const int r = r0 + u * NGW; if (r >= 2 * TC) break; const int l = r / TC, rr = r % TC;
            u32x2 w; w.x = pk2(v[u].x, v[u].y); w.y = pk2(v[u].z, v[u].w); *((u32x2*)(pb + ((size_t)l * TC + rr) * PLE) + lane) = w; }
    }
}
__device__ __forceinline__ void phase_final(const Params& p, int chunk) {
    const int tid_ = htid(), lane = tid_ & 63, gw = blockIdx.x * 8 + (tid_ >> 6), NGW = gridDim.x * 8;
    float* out = p.out + (size_t)chunk * TC * D; const bf16_t* xs = (const bf16_t*)(p.ws + WS_XB2); const float* g = p.in[I_FINALN];
    for (int r0 = gw; r0 < TC; r0 += 2 * NGW) {
        u32x4 q[2][2];
#pragma unroll
        for (int u = 0; u < 2; ++u) { const int r = r0 + u * NGW < TC ? r0 + u * NGW : r0; const u32x4* xr = (const u32x4*)(xs + (size_t)r * D) + lane; q[u][0] = xr[0]; q[u][1] = xr[64]; }
#pragma unroll
        for (int u = 0; u < 2; ++u) { const int r = r0 + u * NGW; if (r >= TC) break; float s = 0.f; f32x4 v[4];
#pragma unroll
            for (int j = 0; j < 2; ++j) { const u32x4 w = q[u][j]; v[2 * j] = (f32x4){lo_bf(w.x), hi_bf(w.x), lo_bf(w.y), hi_bf(w.y)}; v[2 * j + 1] = (f32x4){lo_bf(w.z), hi_bf(w.z), lo_bf(w.w), hi_bf(w.w)};
                s += sq8(v[2 * j], v[2 * j + 1]); }
            const float rs = rsqrtf(wave_sum(s) * (1.f / D) + EPS);
#pragma unroll
            for (int j = 0; j < 2; ++j) { const int c = 8 * (lane + 64 * j); float* o = out + (size_t)r * D + c;
                *(f32x4*)o = v[2 * j] * rs * *(const f32x4*)(g + c); *(f32x4*)(o + 4) = v[2 * j + 1] * rs * *(const f32x4*)(g + c + 4); } }
    }
}
__device__ __forceinline__ void phase_router(const Params& p, LAS unsigned char* lds, int chunk) {
    const int tid_ = htid(), lane = tid_ & 63, gw = blockIdx.x * 8 + (tid_ >> 6), NGW = gridDim.x * 8;
    const bf16_t* x = (const bf16_t*)(p.ws + WS_XB); const float* wr = (const float*)(p.ws + WS_WR);
    int* rt = (int*)(p.ws + WS_ROUTE); unsigned* cnt = (unsigned*)(p.ws + WS_CTL) + CW_CNT + chunk * 64;
    LAS unsigned* lcnt = (LAS unsigned*)lds;
    f32x4 w[16][2];
#pragma unroll
    for (int j = 0; j < 2; ++j)
#pragma unroll
        for (int q = 0; q < 8; ++q) { const int k = 8 * (lane + 64 * j) + q; w[8 * j + q][0] = *(const f32x4*)(wr + k * 8); w[8 * j + q][1] = *(const f32x4*)(wr + k * 8 + 4); }
    const int nouter = (TC + 8 * NGW - 1) / (8 * NGW);
    for (int ob = 0; ob < nouter; ++ob) {
        if (tid_ < 16) lcnt[tid_] = 0u;
        __syncthreads();
        int pe[8]; unsigned pr[8];
#pragma unroll
        for (int jr = 0; jr < 8; ++jr) { const int r = gw + (ob * 8 + jr) * NGW; pe[jr] = 0; pr[jr] = 0u;
            if (r < TC) {
                const u32x4* xr = (const u32x4*)(x + (size_t)r * D) + lane; float s = 0.f; float lg[NE];
#pragma unroll
                for (int e = 0; e < NE; ++e) lg[e] = 0.f;
#pragma unroll
                for (int j = 0; j < 2; ++j) { const u32x4 xw = xr[64 * j]; const float v[8] = {lo_bf(xw.x), hi_bf(xw.x), lo_bf(xw.y), hi_bf(xw.y), lo_bf(xw.z), hi_bf(xw.z), lo_bf(xw.w), hi_bf(xw.w)};
#pragma unroll
                    for (int q = 0; q < 8; ++q) { s += v[q] * v[q]; const f32x4 w0 = w[8 * j + q][0], w1 = w[8 * j + q][1];
                        lg[0] += v[q] * w0.x; lg[1] += v[q] * w0.y; lg[2] += v[q] * w0.z; lg[3] += v[q] * w0.w; lg[4] += v[q] * w1.x; lg[5] += v[q] * w1.y; lg[6] += v[q] * w1.z; lg[7] += v[q] * w1.w; } }
                const float rs = rsqrtf(wave_sum(s) * (1.f / D) + EPS);
#pragma unroll
                for (int e = 0; e < NE; ++e) lg[e] = wave_sum(lg[e]) * rs;
                int i0 = 0; float l0 = lg[0];
#pragma unroll
                for (int e = 1; e < NE; ++e) if (lg[e] > l0) { l0 = lg[e]; i0 = e; }
                int i1 = -1; float l1 = -3.0e38f;
#pragma unroll
                for (int e = 0; e < NE; ++e) if (e != i0 && lg[e] > l1) { l1 = lg[e]; i1 = e; }
                if (lane < 2) { const int e = lane == 0 ? i0 : i1; const float w0 = 1.f / (1.f + expf(l1 - l0));
                    pe[jr] = e; pr[jr] = __hip_atomic_fetch_add(lcnt + e, 1u, __ATOMIC_RELAXED, __HIP_MEMORY_SCOPE_WORKGROUP);
                    rt[RT_TOPE + 2 * r + lane] = e; ((float*)rt)[RT_TOPW + 2 * r + lane] = lane == 0 ? w0 : 1.f - w0; }
            } }
        __syncthreads();
        if (tid_ < 8) lcnt[8 + tid_] = atomicAdd(cnt + tid_, lcnt[tid_]);
        __syncthreads();
#pragma unroll
        for (int jr = 0; jr < 8; ++jr) { const int r = gw + (ob * 8 + jr) * NGW; if (r < TC && lane < 2) rt[RT_TOPP + 2 * r + lane] = (int)(lcnt[8 + pe[jr]] + pr[jr]); }
        __syncthreads();
    }
}
__device__ __forceinline__ void phase_slots(const Params& p, int chunk) {
    int* rt = (int*)(p.ws + WS_ROUTE); const unsigned* cnt = (const unsigned*)(p.ws + WS_CTL) + CW_CNT + chunk * 64;
    int c[NE], off[NE + 1]; off[0] = 0;
#pragma unroll
    for (int e = 0; e < NE; ++e) { c[e] = (int)cnt[e]; off[e + 1] = off[e] + ((c[e] + 255) & ~255); }
    const int gt = blockIdx.x * 512 + htid(), NT = gridDim.x * 512;
    for (int i = gt; i < 2 * TC; i += NT) {
        const int e = rt[RT_TOPE + i], pos = rt[RT_TOPP + i]; int o = 0;
#pragma unroll
        for (int k = 0; k < NE; ++k) o = (e == k) ? off[k] : o;
        const int slot = o + pos; rt[RT_TOPS + i] = slot; rt[RT_IDX + slot] = i >> 1;
    }
    for (int s = gt; s < off[NE]; s += NT) {
        bool pad = false;
#pragma unroll
        for (int k = 0; k < NE; ++k) pad = pad || (s >= off[k] + c[k] && s < off[k + 1]);
        if (pad) rt[RT_IDX + s] = 0;
    }
}
__device__ __forceinline__ f32x4 moe_y4(const bf16_t* yp, const float* partk, int slot, int tail0, int col) {
    if (slot < tail0) { const u32x2 a = *(const u32x2*)(yp + (size_t)slot * D + col); return (f32x4){lo_bf(a.x), hi_bf(a.x), lo_bf(a.y), hi_bf(a.y)}; }
    f32x4 v = (f32x4){0.f, 0.f, 0.f, 0.f};
#pragma unroll
    for (int k = 0; k < KSPL; ++k) v += *(const f32x4*)(partk + ((size_t)k * (TAILMAX / 4) * 256 + (slot - tail0)) * 1024 + col);
    return v;
}
__device__ __forceinline__ void phase_combine(const Params& p, int chunk) {
    const int tid_ = htid(), lane = tid_ & 63, gw = blockIdx.x * 8 + (tid_ >> 6), NGW = gridDim.x * 8;
    const int* rt = (const int*)(p.ws + WS_ROUTE);
    const bf16_t* yp = (const bf16_t*)(p.ws + WS_YPAIR); const float* partk = (const float*)(p.ws + WS_PARTK); bf16_t* xb = (bf16_t*)(p.ws + WS_XB); float* ssq = (float*)(p.ws + WS_SSQ);
    const MoeDownPlan pl = moe_down_plan((const unsigned*)(p.ws + WS_CTL) + CW_CNT + chunk * 64, gridDim.x);
    const int tail0 = pl.tail > 0 ? (pl.main >> 2) * 256 : 0x7fffffff;
    for (int r0 = gw; r0 < TC; r0 += 4 * NGW) {
        int sl[4][2]; float wt[4][2];
#pragma unroll
        for (int u = 0; u < 4; ++u) { const int r = r0 + u * NGW < TC ? r0 + u * NGW : r0; sl[u][0] = rt[RT_TOPS + 2 * r]; sl[u][1] = rt[RT_TOPS + 2 * r + 1];
            wt[u][0] = (DBG_ABL & 16) ? 0.f : ((const float*)rt)[RT_TOPW + 2 * r]; wt[u][1] = (DBG_ABL & 16) ? 0.f : ((const float*)rt)[RT_TOPW + 2 * r + 1]; }
#pragma unroll
        for (int u = 0; u < 4; ++u) { const int r = r0 + u * NGW; if (r >= TC) break;
            u32x2* xr = (u32x2*)(xb + (size_t)r * D) + lane; float s = 0.f;
            f32x4 v[4], y0[4], y1[4]; u32x2 xq[4];
            if (sl[u][0] < tail0 && sl[u][1] < tail0) {
                const u32x2* a0 = (const u32x2*)(yp + (size_t)sl[u][0] * D) + lane; const u32x2* a1 = (const u32x2*)(yp + (size_t)sl[u][1] * D) + lane; u32x2 q0[4], q1[4];
#pragma unroll
                for (int j = 0; j < 4; ++j) { xq[j] = xr[64 * j]; q0[j] = a0[64 * j]; q1[j] = a1[64 * j]; }
#pragma unroll
                for (int j = 0; j < 4; ++j) { y0[j] = (f32x4){lo_bf(q0[j].x), hi_bf(q0[j].x), lo_bf(q0[j].y), hi_bf(q0[j].y)}; y1[j] = (f32x4){lo_bf(q1[j].x), hi_bf(q1[j].x), lo_bf(q1[j].y), hi_bf(q1[j].y)}; }
            } else {
#pragma unroll
                for (int j = 0; j < 4; ++j) { const int col = 4 * (lane + 64 * j); xq[j] = xr[64 * j]; y0[j] = moe_y4(yp, partk, sl[u][0], tail0, col); y1[j] = moe_y4(yp, partk, sl[u][1], tail0, col); }
            }
#pragma unroll
            for (int j = 0; j < 4; ++j) { v[j] = (f32x4){lo_bf(xq[j].x), hi_bf(xq[j].x), lo_bf(xq[j].y), hi_bf(xq[j].y)}; const f32x4 t = v[j] + wt[u][0] * y0[j] + wt[u][1] * y1[j];
                s += (t.x * t.x + t.y * t.y) + (t.z * t.z + t.w * t.w); u32x2 w; w.x = pk2(t.x, t.y); w.y = pk2(t.z, t.w); xr[64 * j] = w; }
            s = wave_sum(s);
            if (lane < 16) ssq[(size_t)r * 16 + lane] = lane == 0 ? s : 0.f; }
    }
}

#define LDS_BARRIER() do { asm volatile("s_waitcnt lgkmcnt(0)" ::: "memory"); __builtin_amdgcn_s_barrier(); asm volatile("" ::: "memory"); } while (0)
__device__ __forceinline__ f32x4 mfma16(const bf16x8 a, const bf16x8 b, const f32x4 c) { return __builtin_amdgcn_mfma_f32_16x16x32_bf16(a, b, c, 0, 0, 0); }
__device__ __forceinline__ void dn_prep(const Params& p, LAS unsigned char* lds, int layer, int b, int n, int h) {
    const int tid = htid(), lane = tid & 63, wave = tid >> 6;
    LAS float* AM = (LAS float*)lds;
    LAS float* SC = (LAS float*)(lds + 17408);
    LAS unsigned char* TW = lds + 19968; LAS unsigned char* TU = lds + 29184;
    LAS unsigned char* QS = lds + 38400; LAS unsigned char* KS = lds + 55808;
    LAS unsigned char* VT = lds + 73216; LAS unsigned char* KT = lds + 91648;
    const int t0 = n * 64;
    const bf16_t* proj = (const bf16_t*)(p.ws + WS_PDN) + (size_t)b * SEQ * 3072;
    unsigned char* item = p.ws + WS_DNS + (size_t)((b * 32 + n) * 6 + h) * DNS_ITEM;
    if (tid < 480) {
        const int cg = tid % 48, seg = tid / 48, part = cg >> 4, c8 = (cg & 15) * 8, col = part * 768 + h * 128 + c8;
        const float* cw = p.in[I_DNCONV] + (size_t)layer * 4 * 2304 + col;
        f32x4 w[4][2];
#pragma unroll
        for (int j = 0; j < 4; ++j) { w[j][0] = *(const f32x4*)(cw + j * 2304); w[j][1] = *(const f32x4*)(cw + j * 2304 + 4); }
        const int ts = seg * 7;
        f32x4 x[10][2];
#pragma unroll
        for (int i = 0; i < 10; ++i) { const int t = t0 + ts - 3 + i; x[i][0] = (f32x4){0.f, 0.f, 0.f, 0.f}; x[i][1] = x[i][0];
            if (t >= 0 && ts - 3 + i < 64) ld_bf8(proj + (size_t)t * 3072 + col, x[i][0], x[i][1]); }
        LAS unsigned char* dst = part == 0 ? QS : KS; LAS unsigned char* dstT = (part == 1 ? KT : VT) + c8 * 144; const int sw = (c8 >> 3) & 7;
#pragma unroll
        for (int i = 0; i < 7; ++i) { const int tk = ts + i;
            if (tk < 64) { f32x4 a0 = w[3][0] * x[i + 3][0] + w[2][0] * x[i + 2][0] + w[1][0] * x[i + 1][0] + w[0][0] * x[i][0];
                f32x4 a1 = w[3][1] * x[i + 3][1] + w[2][1] * x[i + 2][1] + w[1][1] * x[i + 1][1] + w[0][1] * x[i][1];
#pragma unroll
                for (int c = 0; c < 4; ++c) { a0[c] = siluf_(a0[c]); a1[c] = siluf_(a1[c]); }
                u32x4 pw; pw.x = pk2(a0[0], a0[1]); pw.y = pk2(a0[2], a0[3]); pw.z = pk2(a1[0], a1[1]); pw.w = pk2(a1[2], a1[3]);
                if (part < 2) *(LAS u32x4*)(dst + tk * 272 + c8 * 2) = pw;
                if (part > 0) { LAS unsigned char* T = dstT + ((((tk >> 3) ^ sw) << 4) | ((tk & 7) << 1));
                    *(LAS bf16_t*)(T + 0 * 144) = (bf16_t)(pw.x & 0xffffu); *(LAS bf16_t*)(T + 1 * 144) = (bf16_t)(pw.x >> 16); *(LAS bf16_t*)(T + 2 * 144) = (bf16_t)(pw.y & 0xffffu); *(LAS bf16_t*)(T + 3 * 144) = (bf16_t)(pw.y >> 16);
                    *(LAS bf16_t*)(T + 4 * 144) = (bf16_t)(pw.z & 0xffffu); *(LAS bf16_t*)(T + 5 * 144) = (bf16_t)(pw.z >> 16); *(LAS bf16_t*)(T + 6 * 144) = (bf16_t)(pw.w & 0xffffu); *(LAS bf16_t*)(T + 7 * 144) = (bf16_t)(pw.w >> 16); }
 } }
    } else {
        const float Aexp = expf(p.in[I_DNALOG][layer * 6 + h]), dtb = p.in[I_DNDTB][layer * 6 + h];
        const float* small = (const float*)(p.ws + WS_SMALL) + (size_t)b * SEQ * 32;
#pragma unroll
        for (int q = 0; q < 2; ++q) { const int tk = (tid - 480) * 2 + q; const float a = small[(size_t)(t0 + tk) * 32 + h], bb = small[(size_t)(t0 + tk) * 32 + 6 + h];
            SC[128 + tk] = sigmoidf_(bb); SC[192 + tk] = -Aexp * softplusf_(a + dtb); }
    }
    LDS_BARRIER();
    TSUB(8);
    {
        const int row = tid >> 3, sg = tid & 7; const u32x4 q0 = *(const LAS u32x4*)(QS + row * 272 + sg * 32), q1 = *(const LAS u32x4*)(QS + row * 272 + sg * 32 + 16), k0 = *(const LAS u32x4*)(KS + row * 272 + sg * 32), k1 = *(const LAS u32x4*)(KS + row * 272 + sg * 32 + 16);
        float sq = sq8((f32x4){lo_bf(q0.x), hi_bf(q0.x), lo_bf(q0.y), hi_bf(q0.y)}, (f32x4){lo_bf(q0.z), hi_bf(q0.z), lo_bf(q0.w), hi_bf(q0.w)}) + sq8((f32x4){lo_bf(q1.x), hi_bf(q1.x), lo_bf(q1.y), hi_bf(q1.y)}, (f32x4){lo_bf(q1.z), hi_bf(q1.z), lo_bf(q1.w), hi_bf(q1.w)});
        float sk = sq8((f32x4){lo_bf(k0.x), hi_bf(k0.x), lo_bf(k0.y), hi_bf(k0.y)}, (f32x4){lo_bf(k0.z), hi_bf(k0.z), lo_bf(k0.w), hi_bf(k0.w)}) + sq8((f32x4){lo_bf(k1.x), hi_bf(k1.x), lo_bf(k1.y), hi_bf(k1.y)}, (f32x4){lo_bf(k1.z), hi_bf(k1.z), lo_bf(k1.w), hi_bf(k1.w)});
        sq += __shfl_xor(sq, 1); sq += __shfl_xor(sq, 2); sq += __shfl_xor(sq, 4); sk += __shfl_xor(sk, 1); sk += __shfl_xor(sk, 2); sk += __shfl_xor(sk, 4);
        if (sg == 0) { SC[row] = sq; SC[64 + row] = sk; } }
    LDS_BARRIER();
    TSUB(9);
    if (wave == 0) {
        float g = SC[192 + lane];
#pragma unroll
        for (int o = 1; o < 64; o <<= 1) { const float t = __shfl_up(g, o); if (lane >= o) g += t; }
        const float eg = expf(g), rk = rsqrtf(SC[64 + lane] + EPS), glast = __shfl(g, 63);
        SC[192 + lane] = g; SC[256 + lane] = eg; SC[320 + lane] = rsqrtf(SC[lane] + EPS); SC[384 + lane] = rk;
        SC[448 + lane] = rk * SC[128 + lane] * eg; SC[576 + lane] = rk * fexp(glast - g);
    }
    LDS_BARRIER();
    TSUB(10);
    {
        const int r = lane & 15, kg = lane >> 4;
        bf16x8 fa[4][4], fb[4][4];
#pragma unroll
        for (int q = 0; q < 4; ++q) { const int t = wave * 4 + q, which = t >> 4, mt = (t >> 2) & 3, nt = t & 3;
            const LAS unsigned char* A = (which == 0 ? KS : QS) + (16 * mt + r) * 272 + kg * 16; const LAS unsigned char* Bt = KS + (16 * nt + r) * 272 + kg * 16;
#pragma unroll
            for (int ks = 0; ks < 4; ++ks) { fa[q][ks] = *(const LAS bf16x8*)(A + ks * 64); fb[q][ks] = *(const LAS bf16x8*)(Bt + ks * 64); } }
#pragma unroll
        for (int q = 0; q < 4; ++q) { const int t = wave * 4 + q, which = t >> 4, mt = (t >> 2) & 3, nt = t & 3;
            f32x4 acc = (f32x4){0.f, 0.f, 0.f, 0.f};
#pragma unroll
            for (int ks = 0; ks < 4; ++ks) acc = mfma16(fa[q][ks], fb[q][ks], acc);
            const int j = 16 * nt + r; const float gj = SC[192 + j], rkj = SC[384 + j];
            float ov[4], av[4];
#pragma unroll
            for (int rr = 0; rr < 4; ++rr) { const int i = 16 * mt + 4 * kg + rr; const float e = fexp(fminf(SC[192 + i] - gj, 0.f));
                av[rr] = (i > j) ? SC[128 + i] * SC[384 + i] * rkj * acc[rr] * e : 0.f;
                ov[rr] = (i >= j) ? SC[320 + i] * rkj * 0.08838834764831845f * acc[rr] * e : 0.f; }
            if (which == 0) *(LAS f32x4*)(AM + (63 - j) * 68 + 60 - 16 * mt - 4 * kg) = (f32x4){av[3], av[2], av[1], av[0]};
            else { bf16_t* ao = (bf16_t*)(item + 32768) + (16 * mt + 4 * kg) * 64 + j; ST2_BF(ao, ao + 64, ov[0], ov[1]); ST2_BF(ao + 128, ao + 192, ov[2], ov[3]); }
        }
    }
    LDS_BARRIER();
    TSUB(11);
    if (wave == 0) {
        f32x2 x2[32];
        float lf = (float)lane; asm volatile("" : "+v"(lf));
#pragma unroll
        for (int m = 0; m < 32; ++m) x2[m] = (f32x2){fmaxf(1.f - fabsf(lf - (float)(2 * m)), 0.f), fmaxf(1.f - fabsf(lf - (float)(2 * m + 1)), 0.f)};
        const LAS float* AMv = AM; asm volatile("" : "+v"(AMv));
        f32x4 rw[2][8]; f32x2 accA, accB; float sres;
#define ROW_BEGIN(i) do { accA = (f32x2){0.f, 0.f}; accB = accA; sres = x2[(i) >> 1][(i) & 1]; } while (0)
#define ROW_CHUNK(i, k4, am) do { \
            if (4 * (k4) + 1 < (i)) accA -= __builtin_shufflevector(am, am, 0, 1) * x2[2 * (k4)]; else if (4 * (k4) < (i)) sres -= am[0] * x2[2 * (k4)][0]; \
            if (4 * (k4) + 3 < (i)) accB -= __builtin_shufflevector(am, am, 2, 3) * x2[2 * (k4) + 1]; else if (4 * (k4) + 2 < (i)) sres -= am[2] * x2[2 * (k4) + 1][0]; } while (0)
#define ROW_END(i) x2[(i) >> 1][(i) & 1] = sres + ((accA[0] + accA[1]) + (accB[0] + accB[1]))
        rw[1][0] = *(const LAS f32x4*)(AMv + 1 * 68);
#pragma unroll
        for (int i = 1; i <= 32; ++i) {
#pragma unroll
            for (int k4 = 0; k4 < (i + 4) / 4 && k4 < 8; ++k4) rw[(i + 1) & 1][k4] = *(const LAS f32x4*)(AMv + (i + 1) * 68 + 4 * k4);
            ROW_BEGIN(i);
#pragma unroll
            for (int k4 = 0; k4 < (i + 3) / 4; ++k4) { const f32x4 am = rw[i & 1][k4]; ROW_CHUNK(i, k4, am); }
            ROW_END(i);
            { const float xi_ = x2[i >> 1][i & 1]; asm("" : "+v"(AMv) : "v"(xi_)); }
        }
#pragma unroll
        for (int i = 33; i < 64; ++i) {
#pragma unroll
            for (int k4 = 8; k4 < (i + 3) / 4; ++k4) rw[0][k4 - 8] = *(const LAS f32x4*)(AMv + i * 68 + 4 * k4);
            ROW_BEGIN(i);
#pragma unroll
            for (int k4 = 0; k4 < 8; ++k4) { const f32x4 am = rw[1][k4]; ROW_CHUNK(i, k4, am); }
            if (i + 1 < 64) {
#pragma unroll
                for (int k4 = 0; k4 < 8; ++k4) rw[1][k4] = *(const LAS f32x4*)(AMv + (i + 1) * 68 + 4 * k4);
            }
#pragma unroll
            for (int k4 = 8; k4 < (i + 3) / 4; ++k4) { const f32x4 am = rw[0][k4 - 8]; ROW_CHUNK(i, k4, am); }
            ROW_END(i);
            { const float xi_ = x2[i >> 1][i & 1]; asm("" : "+v"(AMv) : "v"(xi_)); }
        }
#undef ROW_BEGIN
#undef ROW_CHUNK
#undef ROW_END
#define XE(a) x2[(a) >> 1][(a) & 1]
        const int irow = 63 - lane;
#pragma unroll
        for (int g = 0; g < 8; ++g) {
            const f32x4 sw0 = *(const LAS f32x4*)(SC + 448 + 8 * g), sw1 = *(const LAS f32x4*)(SC + 448 + 8 * g + 4), su0 = *(const LAS f32x4*)(SC + 128 + 8 * g), su1 = *(const LAS f32x4*)(SC + 128 + 8 * g + 4);
            u32x4 w, u;
            w.x = pk2(XE(63 - 8 * g) * sw0[0], XE(62 - 8 * g) * sw0[1]); w.y = pk2(XE(61 - 8 * g) * sw0[2], XE(60 - 8 * g) * sw0[3]); w.z = pk2(XE(59 - 8 * g) * sw1[0], XE(58 - 8 * g) * sw1[1]); w.w = pk2(XE(57 - 8 * g) * sw1[2], XE(56 - 8 * g) * sw1[3]);
            u.x = pk2(XE(63 - 8 * g) * su0[0], XE(62 - 8 * g) * su0[1]); u.y = pk2(XE(61 - 8 * g) * su0[2], XE(60 - 8 * g) * su0[3]); u.z = pk2(XE(59 - 8 * g) * su1[0], XE(58 - 8 * g) * su1[1]); u.w = pk2(XE(57 - 8 * g) * su1[2], XE(56 - 8 * g) * su1[3]);
            *(LAS u32x4*)(TW + irow * 144 + g * 16) = w; *(LAS u32x4*)(TU + irow * 144 + g * 16) = u; }
#undef XE
    } else {
        const int u = tid - 64;
#pragma unroll
        for (int i = 0; i < 3; ++i) { const int q = u + 448 * i; if (q < 1024) { const int c = q >> 4, d8 = (q & 15) * 8; f32x4 a0, a1;
            const u32x4 w = *(const LAS u32x4*)(QS + c * 272 + d8 * 2); const float sc = SC[320 + c] * 0.08838834764831845f * SC[256 + c];
            a0 = (f32x4){lo_bf(w.x), hi_bf(w.x), lo_bf(w.y), hi_bf(w.y)} * sc; a1 = (f32x4){lo_bf(w.z), hi_bf(w.z), lo_bf(w.w), hi_bf(w.w)} * sc;
            st_bf8((bf16_t*)(item + 16384) + c * 128 + d8, a0, a1); } }
#pragma unroll
        for (int i = 0; i < 3; ++i) { const int q = u + 448 * i; if (q < 1024) { const int d = q >> 3, g8 = q & 7;
            const u32x4 w = *(const LAS u32x4*)(KT + d * 144 + ((g8 ^ ((d >> 3) & 7)) << 4)); const f32x4 f0 = *(const LAS f32x4*)(SC + 576 + 8 * g8), f1 = *(const LAS f32x4*)(SC + 576 + 8 * g8 + 4);
            st_bf8((bf16_t*)(item + 40960) + d * 64 + 8 * g8, (f32x4){lo_bf(w.x), hi_bf(w.x), lo_bf(w.y), hi_bf(w.y)} * f0, (f32x4){lo_bf(w.z), hi_bf(w.z), lo_bf(w.w), hi_bf(w.w)} * f1); } }
        if (u == 0) ((float*)(p.ws + WS_DNEGL))[(b * 32 + n) * 6 + h] = SC[256 + 63];
        const float* ng = p.in[I_DNNORM] + layer * 128; bf16_t* ydn = (bf16_t*)(p.ws + WS_YDN) + ((size_t)b * SEQ + t0) * 768 + h * 128;
#pragma unroll
        for (int i = 0; i < 3; ++i) { const int q = u + 448 * i; if (q < 1024) { const int c = q >> 4, e8 = (q & 15) * 8; f32x4 z0, z1; ld_bf8(proj + (size_t)(t0 + c) * 3072 + 2304 + h * 128 + e8, z0, z1);
            const f32x4 g0 = *(const f32x4*)(ng + e8), g1 = *(const f32x4*)(ng + e8 + 4);
#pragma unroll
            for (int j = 0; j < 4; ++j) { z0[j] = g0[j] * siluf_(z0[j]); z1[j] = g1[j] * siluf_(z1[j]); }
            st_bf8(ydn + (size_t)c * 768 + e8, z0, z1); } }
    }
    LDS_BARRIER();
    TSUB(12);
    {
        const int r = lane & 15, kg = lane >> 4, ch = 16 * wave + r, sw = (ch >> 3) & 7;
        bf16x8 kf[2], vf[2], tw[4][2], tu[4][2];
#pragma unroll
        for (int ks = 0; ks < 2; ++ks) { kf[ks] = *(const LAS bf16x8*)(KT + ch * 144 + (((4 * ks + kg) ^ sw) << 4)); vf[ks] = *(const LAS bf16x8*)(VT + ch * 144 + (((4 * ks + kg) ^ sw) << 4)); }
#pragma unroll
        for (int it = 0; it < 4; ++it)
#pragma unroll
            for (int ks = 0; ks < 2; ++ks) { tw[it][ks] = *(const LAS bf16x8*)(TW + (16 * it + r) * 144 + (4 * ks + kg) * 16); tu[it][ks] = *(const LAS bf16x8*)(TU + (16 * it + r) * 144 + (4 * ks + kg) * 16); }
#pragma unroll
        for (int it = 0; it < 4; ++it) { f32x4 aw = (f32x4){0.f, 0.f, 0.f, 0.f}, au = aw;
#pragma unroll
            for (int ks = 0; ks < 2; ++ks) { aw = mfma16(kf[ks], tw[it][ks], aw); au = mfma16(tu[it][ks], vf[ks], au); }
            u32x2 o; o.x = pk2(aw[0], aw[1]); o.y = pk2(aw[2], aw[3]); *(u32x2*)((bf16_t*)item + (16 * it + r) * 128 + 16 * wave + 4 * kg) = o;
            o.x = pk2(au[0], au[1]); o.y = pk2(au[2], au[3]); *(u32x2*)(item + 57344 + (size_t)(16 * wave + r) * 128 + (16 * it + 4 * kg) * 2) = o; }
    }
    LDS_BARRIER();
    TSUB(13);
}
__device__ __forceinline__ float row16_sum(float v) {
    v += __builtin_bit_cast(float, __builtin_amdgcn_update_dpp(0, __builtin_bit_cast(int, v), 0xB1, 0xf, 0xf, false));
    v += __builtin_bit_cast(float, __builtin_amdgcn_update_dpp(0, __builtin_bit_cast(int, v), 0x4E, 0xf, 0xf, false));
    v += __builtin_bit_cast(float, __builtin_amdgcn_update_dpp(0, __builtin_bit_cast(int, v), 0x141, 0xf, 0xf, false));
    v += __builtin_bit_cast(float, __builtin_amdgcn_update_dpp(0, __builtin_bit_cast(int, v), 0x140, 0xf, 0xf, false));
    return v;
}
__device__ __forceinline__ void dn_scan(const Params& p, LAS unsigned char* lds, int layer, int b, int h) {
    const int tid = htid(), lane = tid & 63, wave = __builtin_amdgcn_readfirstlane(tid >> 6), r = lane & 15, kg = lane >> 4;
    LAS unsigned char* W = lds; LAS unsigned char* QD = lds + 17408; LAS unsigned char* ATT = lds + 34816; LAS unsigned char* KDT = lds + 44032; LAS unsigned char* UT = lds + 62464;
    LAS unsigned char* ST = lds + 80896; LAS unsigned char* VNT = lds + 115712; LAS float* PS = (LAS float*)(lds + 134144); LAS float* RS = (LAS float*)(lds + 136192) + wave * 64;
    const unsigned char* items = p.ws + WS_DNS + (size_t)(b * 32 * 6 + h) * DNS_ITEM;
    bf16_t* ydn = (bf16_t*)(p.ws + WS_YDN) + (size_t)b * SEQ * 768 + h * 128 + 16 * wave + r;
    float egl_all = lane < 32 ? ((const float*)(p.ws + WS_DNEGL))[b * 32 * 6 + h + 6 * lane] : 0.f;
    asm volatile("" : "+v"(egl_all));
    f32x4 S[8], o[4];
#pragma unroll
    for (int dt = 0; dt < 8; ++dt) S[dt] = (f32x4){0.f, 0.f, 0.f, 0.f};
#pragma unroll
    for (int mt = 0; mt < 4; ++mt) o[mt] = (f32x4){0.f, 0.f, 0.f, 0.f};
    for (int i = lane; i < 16 * 272 / 16; i += 64) *(LAS u32x4*)(ST + wave * 16 * 272 + i * 16) = (u32x4){0u, 0u, 0u, 0u};
    u32x4 R[9];
#pragma unroll
    for (int i = 0; i < 9; ++i) R[i] = *(const u32x4*)(items + (size_t)(tid + 512 * i) * 16);
    unsigned short zc[16];
#pragma unroll
    for (int i = 0; i < 16; ++i) zc[i] = 0u;
    LDS_BARRIER();
    for (int n = 0; n <= 32; ++n) {
        if (n < 32) {
#pragma unroll
            for (int i = 0; i < 9; ++i) { const int q = tid + 512 * i; LAS unsigned char* dst;
                if (i < 2) dst = W + (q >> 4) * 272 + (q & 15) * 16; else if (i < 4) dst = QD + ((q - 1024) >> 4) * 272 + (q & 15) * 16;
                else if (i < 5) dst = ATT + ((q - 2048) >> 3) * 144 + (q & 7) * 16; else if (i < 7) dst = KDT + ((q - 2560) >> 3) * 144 + (q & 7) * 16;
                else dst = UT + ((q - 3584) >> 3) * 144 + (q & 7) * 16;
                *(LAS u32x4*)dst = R[i]; }
        }
        if (n > 0) {
            float tot = 0.f;
#pragma unroll
            for (int w = 0; w < 8; ++w) tot += PS[w * 64 + lane];
            RS[lane] = rsqrtf(tot * (1.f / 128.f) + EPS);
#pragma unroll
            for (int mt = 0; mt < 4; ++mt) { const f32x4 rs = *(const LAS f32x4*)(RS + 16 * mt + 4 * kg);
#pragma unroll
                for (int rr = 0; rr < 4; rr += 2) { bf16_t* yo_ = ydn + (size_t)((n - 1) * 64 + 16 * mt + 4 * kg + rr) * 768;
                    ST2_BF(yo_, yo_ + 768, o[mt][rr] * rs[rr] * __uint_as_float(((unsigned)zc[4 * mt + rr]) << 16), o[mt][rr + 1] * rs[rr + 1] * __uint_as_float(((unsigned)zc[4 * mt + rr + 1]) << 16)); } }
        }
        if (n == 32) break;
        if (n + 1 < 32) {
#pragma unroll
            for (int i = 0; i < 9; ++i) R[i] = *(const u32x4*)(items + (size_t)(n + 1) * 6 * DNS_ITEM + (size_t)(tid + 512 * i) * 16);
        }
#pragma unroll
        for (int mt = 0; mt < 4; ++mt)
#pragma unroll
            for (int rr = 0; rr < 4; ++rr) zc[4 * mt + rr] = ydn[(size_t)(n * 64 + 16 * mt + 4 * kg + rr) * 768];
        const float egl = __builtin_bit_cast(float, __builtin_amdgcn_readlane(__builtin_bit_cast(int, egl_all), n));
        LDS_BARRIER();
        bf16x8 sf[4];
#pragma unroll
        for (int ks = 0; ks < 4; ++ks) sf[ks] = *(const LAS bf16x8*)(ST + (16 * wave + r) * 272 + ks * 64 + kg * 16);
        {   bf16x8 af[4][4]; u32x2 uw[4];
#pragma unroll
            for (int mt = 0; mt < 4; ++mt) {
#pragma unroll
                for (int ks = 0; ks < 4; ++ks) af[mt][ks] = *(const LAS bf16x8*)(W + (16 * mt + r) * 272 + ks * 64 + kg * 16);
                uw[mt] = *(const LAS u32x2*)(UT + (16 * wave + r) * 144 + (16 * mt + 4 * kg) * 2); }
#pragma unroll
            for (int mt = 0; mt < 4; ++mt) { f32x4 ws = (f32x4){0.f, 0.f, 0.f, 0.f};
#pragma unroll
                for (int ks = 0; ks < 4; ++ks) ws = mfma16(af[mt][ks], sf[ks], ws);
                const f32x4 vn = (f32x4){lo_bf(uw[mt].x), hi_bf(uw[mt].x), lo_bf(uw[mt].y), hi_bf(uw[mt].y)} - ws;
                u32x2 vw; vw.x = pk2(vn[0], vn[1]); vw.y = pk2(vn[2], vn[3]);
                *(LAS u32x2*)(VNT + (16 * wave + r) * 144 + (16 * mt + 4 * kg) * 2) = vw; } }
        bf16x8 vf[2];
        {
            bf16x8 qf[4][4], tf[4][2];
#pragma unroll
            for (int mt = 0; mt < 4; ++mt) {
#pragma unroll
                for (int ks = 0; ks < 4; ++ks) qf[mt][ks] = *(const LAS bf16x8*)(QD + (16 * mt + r) * 272 + ks * 64 + kg * 16);
#pragma unroll
                for (int kc = 0; kc < 2; ++kc) tf[mt][kc] = *(const LAS bf16x8*)(ATT + (16 * mt + r) * 144 + kc * 64 + kg * 16); }
#pragma unroll
            for (int kc = 0; kc < 2; ++kc) vf[kc] = *(const LAS bf16x8*)(VNT + (16 * wave + r) * 144 + kc * 64 + kg * 16);
#pragma unroll
            for (int mt = 0; mt < 4; ++mt) { f32x4 a = (f32x4){0.f, 0.f, 0.f, 0.f};
#pragma unroll
                for (int ks = 0; ks < 4; ++ks) a = mfma16(qf[mt][ks], sf[ks], a);
#pragma unroll
                for (int kc = 0; kc < 2; ++kc) a = mfma16(tf[mt][kc], vf[kc], a);
                o[mt] = a; } }
        {
            bf16x8 kf[8][2];
#pragma unroll
            for (int dt = 0; dt < 8; ++dt)
#pragma unroll
                for (int kc = 0; kc < 2; ++kc) kf[dt][kc] = *(const LAS bf16x8*)(KDT + (16 * dt + r) * 144 + kc * 64 + kg * 16);
#pragma unroll
            for (int dt = 0; dt < 8; ++dt) { f32x4 a = S[dt] * egl;
#pragma unroll
                for (int kc = 0; kc < 2; ++kc) a = mfma16(kf[dt][kc], vf[kc], a);
                S[dt] = a; u32x2 sw; sw.x = pk2(a[0], a[1]); sw.y = pk2(a[2], a[3]);
                *(LAS u32x2*)(ST + (16 * wave + r) * 272 + (16 * dt + 4 * kg) * 2) = sw; } }
#pragma unroll
        for (int mt = 0; mt < 4; ++mt) { f32x4 q;
#pragma unroll
            for (int rr = 0; rr < 4; ++rr) q[rr] = row16_sum(o[mt][rr] * o[mt][rr]);
            if (r == 0) *(LAS f32x4*)(PS + wave * 64 + 16 * mt + 4 * kg) = q; }
        LDS_BARRIER();
    }
    LDS_BARRIER();
}
template <int MODE>
__device__ __forceinline__ void ssd_load(const Params& p, LAS unsigned char* lds, int layer, int b, int c, int grp) {
    const int tid = htid(), lane = tid & 63, wave = tid >> 6, t0 = c * 64;
    LAS float* DT = (LAS float*)(lds + 117760); LAS float* ACS = DT + 384;
    LAS unsigned char* XT = lds + 34816;
    if (wave < 6) { const int hh = grp * 6 + wave; const float* small = (const float*)(p.ws + WS_SMALL) + ((size_t)b * SEQ + t0 + lane) * 32;
        const float dt = softplusf_(small[12 + hh] + p.in[I_SSDTB][layer * 12 + hh]); float a = -expf(p.in[I_SSALOG][layer * 12 + hh]) * dt;
#pragma unroll
        for (int o = 1; o < 64; o <<= 1) { const float t = __shfl_up(a, o); if (lane >= o) a += t; }
        DT[wave * 64 + lane] = dt; ACS[wave * 64 + lane] = a; }
    LDS_BARRIER();
    const int cg = tid % 80, seg = tid / 80, ch8 = cg * 8;
    if (tid < 480 && (MODE == 1 || ch8 < 512)) {
        const int col = ch8 < 384 ? grp * 384 + ch8 : (ch8 < 512 ? 768 + grp * 128 + (ch8 - 384) : 1024 + grp * 128 + (ch8 - 512));
        const float* cw = p.in[I_SSCONV] + (size_t)layer * 4 * 1280 + col; const float* cb = p.in[I_SSCONVB] + layer * 1280 + col;
        f32x4 w[4][2], bias[2];
#pragma unroll
        for (int j = 0; j < 4; ++j) { w[j][0] = *(const f32x4*)(cw + j * 1280); w[j][1] = *(const f32x4*)(cw + j * 1280 + 4); }
        bias[0] = *(const f32x4*)cb; bias[1] = *(const f32x4*)(cb + 4);
        const bf16_t* proj = (const bf16_t*)(p.ws + WS_PSSM) + (size_t)b * SEQ * 2048 + col;
        const int ts = seg * 11, hi = ch8 >> 6;
        f32x4 xm[3][2];
#pragma unroll
        for (int i = 0; i < 3; ++i) { const int t = t0 + ts - 3 + i; xm[i][0] = (f32x4){0.f, 0.f, 0.f, 0.f}; xm[i][1] = xm[i][0]; if (t >= 0) ld_bf8(proj + (size_t)t * 2048, xm[i][0], xm[i][1]); }
#pragma unroll
        for (int i = 0; i < 11; ++i) { const int tk = ts + i;
            if (tk < 64) { f32x4 c0, c1; ld_bf8(proj + (size_t)(t0 + tk) * 2048, c0, c1);
                f32x4 a0 = bias[0] + w[3][0] * c0 + w[2][0] * xm[2][0] + w[1][0] * xm[1][0] + w[0][0] * xm[0][0];
                f32x4 a1 = bias[1] + w[3][1] * c1 + w[2][1] * xm[2][1] + w[1][1] * xm[1][1] + w[0][1] * xm[0][1];
                xm[0][0] = xm[1][0]; xm[0][1] = xm[1][1]; xm[1][0] = xm[2][0]; xm[1][1] = xm[2][1]; xm[2][0] = c0; xm[2][1] = c1;
#pragma unroll
                for (int q = 0; q < 4; ++q) { a0[q] = siluf_(a0[q]); a1[q] = siluf_(a1[q]); }
                if (ch8 < 384) { const float sc = MODE == 0 ? DT[hi * 64 + tk] * fexp(ACS[hi * 64 + 63] - ACS[hi * 64 + tk]) : DT[hi * 64 + tk];
#pragma unroll
                    for (int q = 0; q < 4; ++q) { const unsigned pw = pk2(a0[q] * sc, a1[q] * sc);
                        *(LAS bf16_t*)(XT + (ch8 + q) * 144 + tk * 2) = (bf16_t)(pw & 0xffffu); *(LAS bf16_t*)(XT + (ch8 + 4 + q) * 144 + tk * 2) = (bf16_t)(pw >> 16); } }
                else if (MODE == 0) {
#pragma unroll
                    for (int q = 0; q < 4; ++q) { const unsigned pw = pk2(a0[q], a1[q]);
                        *(LAS bf16_t*)(lds + (ch8 - 384 + q) * 144 + tk * 2) = (bf16_t)(pw & 0xffffu); *(LAS bf16_t*)(lds + (ch8 - 384 + 4 + q) * 144 + tk * 2) = (bf16_t)(pw >> 16); } }
                else { u32x4 pw; pw.x = pk2(a0[0], a0[1]); pw.y = pk2(a0[2], a0[3]); pw.z = pk2(a1[0], a1[1]); pw.w = pk2(a1[2], a1[3]);
                    *(LAS u32x4*)(lds + (ch8 < 512 ? 17408 + tk * 272 + (ch8 - 384) * 2 : tk * 272 + (ch8 - 512) * 2)) = pw; } } }
    }
    LDS_BARRIER();
}
__device__ __forceinline__ void ssd_states(const Params& p, LAS unsigned char* lds, int layer, int b, int c, int grp) {
    ssd_load<0>(p, lds, layer, b, c, grp);
    const int tid = htid(), lane = tid & 63, wave = tid >> 6, r = lane & 15, kg = lane >> 4;
    const LAS unsigned char* XT = lds + 34816; const LAS unsigned char* BT = lds; const LAS float* ACS = (const LAS float*)(lds + 117760) + 384;
    bf16_t* st = (bf16_t*)(p.ws + WS_SSST) + ((size_t)(b * 32 + c) * 12 + grp * 6) * 8192;
    for (int t4 = 0; t4 < 24; t4 += 4) {
        bf16x8 af[4][2], bfr[4][2];
#pragma unroll
        for (int q = 0; q < 4; ++q) { const int t = wave + 8 * (t4 + q), hi = t >> 5, mt = (t >> 3) & 3, nt = t & 7;
#pragma unroll
            for (int ks = 0; ks < 2; ++ks) { af[q][ks] = *(const LAS bf16x8*)(XT + (hi * 64 + 16 * mt + r) * 144 + ks * 64 + kg * 16); bfr[q][ks] = *(const LAS bf16x8*)(BT + (16 * nt + r) * 144 + ks * 64 + kg * 16); } }
#pragma unroll
        for (int q = 0; q < 4; ++q) { const int t = wave + 8 * (t4 + q), hi = t >> 5, mt = (t >> 3) & 3, nt = t & 7;
            f32x4 acc = (f32x4){0.f, 0.f, 0.f, 0.f};
#pragma unroll
            for (int ks = 0; ks < 2; ++ks) acc = mfma16(af[q][ks], bfr[q][ks], acc);
#pragma unroll
            for (int rr = 0; rr < 4; rr += 2) { bf16_t* so_ = st + (size_t)hi * 8192 + (16 * mt + 4 * kg + rr) * 128 + 16 * nt + r; ST2_BF(so_, so_ + 128, acc[rr], acc[rr + 1]); } }
    }
    if (tid < 6) ((float*)(p.ws + WS_SSCD))[(b * 32 + c) * 12 + grp * 6 + tid] = expf(ACS[tid * 64 + 63]);
    LDS_BARRIER();
}
__device__ __forceinline__ void ssd_scan(const Params& p, int first_blk, int nblk) {
    const int gt = ((int)blockIdx.x - first_blk) * 512 + htid(), NT = nblk * 512;
    const u32x2* st = (const u32x2*)(p.ws + WS_SSST); const float* cd = (const float*)(p.ws + WS_SSCD); u32x2* pv = (u32x2*)(p.ws + WS_SSPV);
    for (int v = gt; v < NB * 12 * 2048; v += NT) { const int b = v / (12 * 2048), h = (v / 2048) % 12, e = v % 2048;
        f32x4 run = (f32x4){0.f, 0.f, 0.f, 0.f};
        for (int c0 = 0; c0 < 32; c0 += 8) { u32x2 t[8];
#pragma unroll
            for (int i = 0; i < 8; ++i) t[i] = st[((size_t)(b * 32 + c0 + i) * 12 + h) * 2048 + e];
#pragma unroll
            for (int i = 0; i < 8; ++i) { u32x2 w; w.x = pk2(run[0], run[1]); w.y = pk2(run[2], run[3]); pv[((size_t)(b * 32 + c0 + i) * 12 + h) * 2048 + e] = w;
                run = run * cd[(b * 32 + c0 + i) * 12 + h] + (f32x4){lo_bf(t[i].x), hi_bf(t[i].x), lo_bf(t[i].y), hi_bf(t[i].y)}; } }
    }
}
__device__ __forceinline__ void ssd_out(const Params& p, LAS unsigned char* lds, int layer, int b, int c, int grp) {
    ssd_load<1>(p, lds, layer, b, c, grp);
    const int tid = htid(), lane = tid & 63, wave = tid >> 6, r = lane & 15, kg = lane >> 4, t0 = c * 64;
    const LAS unsigned char* CM = lds; const LAS unsigned char* BM = lds + 17408; const LAS unsigned char* XT = lds + 34816; LAS unsigned char* MH = lds + 90112;
    const LAS float* DT = (const LAS float*)(lds + 117760); const LAS float* ACS = DT + 384; LAS float* YG = (LAS float*)lds;
    const bf16_t* prev = (const bf16_t*)(p.ws + WS_SSPV) + ((size_t)(b * 32 + c) * 12 + grp * 6) * 8192;
    f32x4 cb[2];
    {   bf16x8 ca[2][4], cbf[2][4];
#pragma unroll
        for (int q = 0; q < 2; ++q) { const int t = wave * 2 + q, mt = t >> 2, nt = t & 3;
#pragma unroll
            for (int ks = 0; ks < 4; ++ks) { ca[q][ks] = *(const LAS bf16x8*)(CM + (16 * mt + r) * 272 + ks * 64 + kg * 16); cbf[q][ks] = *(const LAS bf16x8*)(BM + (16 * nt + r) * 272 + ks * 64 + kg * 16); } }
#pragma unroll
        for (int q = 0; q < 2; ++q) { f32x4 acc = (f32x4){0.f, 0.f, 0.f, 0.f};
#pragma unroll
            for (int ks = 0; ks < 4; ++ks) acc = mfma16(ca[q][ks], cbf[q][ks], acc);
            cb[q] = acc; } }
    f32x4 y[2][6];
#pragma unroll
    for (int half = 0; half < 2; ++half) {
#pragma unroll
        for (int q = 0; q < 2; ++q) { const int t = wave * 2 + q, mt = t >> 2, nt = t & 3, j = 16 * nt + r;
#pragma unroll
            for (int hl = 0; hl < 3; ++hl) { const int hi = 3 * half + hl; const float aj = ACS[hi * 64 + j];
#pragma unroll
                for (int rr = 0; rr < 4; ++rr) { const int i = 16 * mt + 4 * kg + rr; *(LAS bf16_t*)(MH + hl * 9216 + i * 144 + j * 2) = (bf16_t)f2bf((i >= j) ? cb[q][rr] * fexp(fminf(ACS[hi * 64 + i] - aj, 0.f)) : 0.f); } } }
        bf16x8 pf[6][4];
#pragma unroll
        for (int k = 0; k < 6; ++k) { const int t = wave + 8 * k, hl = t >> 4, nt = t & 3, hi = 3 * half + hl; const bf16_t* pr = prev + (size_t)hi * 8192 + (16 * nt + r) * 128 + kg * 8;
#pragma unroll
            for (int ks = 0; ks < 4; ++ks) pf[k][ks] = *(const bf16x8*)(pr + ks * 32); }
        LDS_BARRIER();
#pragma unroll
        for (int k = 0; k < 6; ++k) { const int t = wave + 8 * k, hl = t >> 4, mt = (t >> 2) & 3, nt = t & 3, hi = 3 * half + hl, hh = grp * 6 + hi;
            f32x4 acc = (f32x4){0.f, 0.f, 0.f, 0.f}, off = acc;
            bf16x8 mf[2], xf[2], cf[4];
#pragma unroll
            for (int ks = 0; ks < 2; ++ks) { mf[ks] = *(const LAS bf16x8*)(MH + hl * 9216 + (16 * mt + r) * 144 + ks * 64 + kg * 16); xf[ks] = *(const LAS bf16x8*)(XT + (hi * 64 + 16 * nt + r) * 144 + ks * 64 + kg * 16); }
#pragma unroll
            for (int ks = 0; ks < 4; ++ks) cf[ks] = *(const LAS bf16x8*)(CM + (16 * mt + r) * 272 + ks * 64 + kg * 16);
#pragma unroll
            for (int ks = 0; ks < 2; ++ks) acc = mfma16(mf[ks], xf[ks], acc);
#pragma unroll
            for (int ks = 0; ks < 4; ++ks) off = mfma16(cf[ks], pf[k][ks], off);
            const u32x2 xw = *(const LAS u32x2*)(XT + (hi * 64 + 16 * nt + r) * 144 + (16 * mt + 4 * kg) * 2); const float xs[4] = {lo_bf(xw.x), hi_bf(xw.x), lo_bf(xw.y), hi_bf(xw.y)};
            const float dsk = p.in[I_SSD][layer * 12 + hh];
#pragma unroll
            for (int rr = 0; rr < 4; ++rr) { const int i = 16 * mt + 4 * kg + rr; acc[rr] += fexp(ACS[hi * 64 + i]) * off[rr] + dsk * xs[rr] * __builtin_amdgcn_rcpf(fmaxf(DT[hi * 64 + i], 1e-30f)); }
            y[half][k] = acc; }
        LDS_BARRIER();
    }
    const bf16_t* zp = (const bf16_t*)(p.ws + WS_PSSM) + ((size_t)b * SEQ + t0) * 2048 + 1280 + grp * 384;
#pragma unroll
    for (int half = 0; half < 2; ++half)
#pragma unroll
        for (int k = 0; k < 6; ++k) { const int t = wave + 8 * k, hl = t >> 4, mt = (t >> 2) & 3, nt = t & 3, hi = 3 * half + hl, ch = hi * 64 + 16 * nt + r;
#pragma unroll
            for (int rr = 0; rr < 4; ++rr) { const int i = 16 * mt + 4 * kg + rr; const float z = bf2f(zp[(size_t)i * 2048 + ch]); YG[i * 388 + ch] = y[half][k][rr] * siluf_(z); } }
    LDS_BARRIER();
    const float* sn = p.in[I_SSNORM] + layer * 768 + grp * 384; bf16_t* yo = (bf16_t*)(p.ws + WS_YSSM) + ((size_t)b * SEQ + t0) * 768 + grp * 384;
#pragma unroll
    for (int i8 = 0; i8 < 8; ++i8) { const int i = 8 * wave + i8; float v[6], ss = 0.f;
#pragma unroll
        for (int k = 0; k < 6; ++k) { v[k] = YG[i * 388 + lane + 64 * k]; ss += v[k] * v[k]; }
        const float rs = rsqrtf(wave_sum(ss) * (1.f / 384.f) + EPS);
#pragma unroll
        for (int k = 0; k < 6; k += 2) ST2_BF(yo + (size_t)i * 768 + lane + 64 * k, yo + (size_t)i * 768 + lane + 64 * (k + 1), v[k] * rs * sn[lane + 64 * k], v[k + 1] * rs * sn[lane + 64 * (k + 1)]); }
    LDS_BARRIER();
}

typedef float f32x16 __attribute__((ext_vector_type(16)));
__device__ __forceinline__ void attn_tile(const Params& p, int b, int g, int j, int r, int qt, int lane) {
    const int d = g == 0 ? 1 : (g == 1 ? 4 : 16), L = SEQ / d, n = lane & 31, hw = lane >> 5;
    const int P0 = b * SEQ + r * L;
    const bf16_t* Q = (const bf16_t*)(p.ws + WS_QK) + (size_t)(0 * 3 + g) * TC * 256 + j * 64;
    const bf16_t* K = (const bf16_t*)(p.ws + WS_QK) + (size_t)(1 * 3 + g) * TC * 256 + j * 64;
    const bf16_t* V = (const bf16_t*)(p.ws + WS_VT) + (size_t)(g * 256 + j * 64) * TC;
    const float sl2 = exp2f(-8.f * (float)(4 * g + j + 1) / 12.f) * (float)d * 1.4426950408889634f;
    bf16x8 qf[4];
    { const bf16_t* qrow = Q + (size_t)(P0 + 32 * qt + n) * 256 + 8 * hw;
#pragma unroll
      for (int s = 0; s < 4; ++s) qf[s] = *(const bf16x8*)(qrow + 16 * s); }
    f32x16 o0, o1;
#pragma unroll
    for (int i = 0; i < 16; ++i) { o0[i] = 0.f; o1[i] = 0.f; }
    float mrun = -1e30f, lrun = 0.f;
    const int pim = (n & 0x13) | (((n >> 2) & 1) << 3) | (((n >> 3) & 1) << 2);
    const int qi = 32 * qt + n;
    const int kb0 = qt > 4 ? qt - 4 : 0;
    bf16x8 kf[4], vf[2][2];
    { const bf16_t* krow = K + (size_t)(P0 + 32 * kb0 + pim) * 256 + 8 * hw;
#pragma unroll
      for (int s = 0; s < 4; ++s) kf[s] = *(const bf16x8*)(krow + 16 * s);
#pragma unroll
      for (int sp = 0; sp < 2; ++sp)
#pragma unroll
          for (int dh = 0; dh < 2; ++dh) vf[sp][dh] = *(const bf16x8*)(V + (size_t)(32 * dh + n) * TC + P0 + 32 * kb0 + 16 * sp + 8 * hw); }
    for (int kb = kb0; kb <= qt; ++kb) {
        f32x16 st;
#pragma unroll
        for (int i = 0; i < 16; ++i) st[i] = 0.f;
#pragma unroll
        for (int s = 0; s < 4; ++s) st = __builtin_amdgcn_mfma_f32_32x32x16_bf16(kf[s], qf[s], st, 0, 0, 0);
        bf16x8 vc[2][2];
#pragma unroll
        for (int sp = 0; sp < 2; ++sp)
#pragma unroll
            for (int dh = 0; dh < 2; ++dh) vc[sp][dh] = vf[sp][dh];
        if (kb < qt) {
            const bf16_t* krow = K + (size_t)(P0 + 32 * (kb + 1) + pim) * 256 + 8 * hw;
#pragma unroll
            for (int s = 0; s < 4; ++s) kf[s] = *(const bf16x8*)(krow + 16 * s);
#pragma unroll
            for (int sp = 0; sp < 2; ++sp)
#pragma unroll
                for (int dh = 0; dh < 2; ++dh) vf[sp][dh] = *(const bf16x8*)(V + (size_t)(32 * dh + n) * TC + P0 + 32 * (kb + 1) + 16 * sp + 8 * hw);
        }
        float mx = -1e30f;
#pragma unroll
        for (int jj = 0; jj < 16; ++jj) { const int kidx = 32 * kb + 16 * (jj >> 3) + 8 * hw + 4 * ((jj >> 2) & 1) + (jj & 3); const int dl = qi - kidx;
            const float sc = (dl >= 0 && dl <= 128) ? st[jj] * 1.4426950408889634f - sl2 * (float)dl : -1e30f; st[jj] = sc; mx = fmaxf(mx, sc); }
        mx = fmaxf(mx, __shfl_xor(mx, 32));
        const float mnew = fmaxf(mrun, mx), alpha = __builtin_amdgcn_exp2f(mrun - mnew);
        float rs = 0.f;
#pragma unroll
        for (int jj = 0; jj < 16; ++jj) { const float pj = __builtin_amdgcn_exp2f(st[jj] - mnew); st[jj] = pj; rs += pj; }
        rs += __shfl_xor(rs, 32);
        lrun = lrun * alpha + rs; mrun = mnew;
#pragma unroll
        for (int i = 0; i < 16; ++i) { o0[i] *= alpha; o1[i] *= alpha; }
#pragma unroll
        for (int sp = 0; sp < 2; ++sp) {
            u32x4 pw; pw.x = pk2(st[8 * sp + 0], st[8 * sp + 1]); pw.y = pk2(st[8 * sp + 2], st[8 * sp + 3]); pw.z = pk2(st[8 * sp + 4], st[8 * sp + 5]); pw.w = pk2(st[8 * sp + 6], st[8 * sp + 7]);
            const bf16x8 pf = __builtin_bit_cast(bf16x8, pw);
            o0 = __builtin_amdgcn_mfma_f32_32x32x16_bf16(vc[sp][0], pf, o0, 0, 0, 0);
            o1 = __builtin_amdgcn_mfma_f32_32x32x16_bf16(vc[sp][1], pf, o1, 0, 0, 0);
        }
    }
    const float inv = 1.f / lrun;
    const int tok = b * SEQ + qi * d + r;
    bf16_t* og = (bf16_t*)(p.ws + WS_OG) + ((size_t)g * TC + tok) * 256 + j * 64 + 4 * hw;
#pragma unroll
    for (int q4 = 0; q4 < 4; ++q4) {
        u32x2 w0, w1; w0.x = pk2(o0[4 * q4] * inv, o0[4 * q4 + 1] * inv); w0.y = pk2(o0[4 * q4 + 2] * inv, o0[4 * q4 + 3] * inv);
        w1.x = pk2(o1[4 * q4] * inv, o1[4 * q4 + 1] * inv); w1.y = pk2(o1[4 * q4 + 2] * inv, o1[4 * q4 + 3] * inv);
        *(u32x2*)(og + 8 * q4) = w0; *(u32x2*)(og + 32 + 8 * q4) = w1;
    }
    if (hw == 0) ((float*)(p.ws + WS_LSE))[((size_t)g * TC + tok) * 4 + j] = (mrun + log2f(lrun)) * 0.6931471805599453f;
}
__device__ __forceinline__ void phase_attn_combine(const Params& p, int skip) {
    const int tid_ = htid(), lane = tid_ & 63, gw = ((int)blockIdx.x - skip) * 8 + (tid_ >> 6), NGW = ((int)gridDim.x - skip) * 8;
    const bf16_t* og = (const bf16_t*)(p.ws + WS_OG); const float* lse = (const float*)(p.ws + WS_LSE); bf16_t* ya = (bf16_t*)(p.ws + WS_YATT);
    for (int t = gw; t < TC; t += NGW) {
        const int j = lane >> 4;
        const float l0 = lse[((size_t)0 * TC + t) * 4 + j], l1 = lse[((size_t)1 * TC + t) * 4 + j], l2 = lse[((size_t)2 * TC + t) * 4 + j];
        const float M = fmaxf(l0, fmaxf(l1, l2)); float w0 = expf(l0 - M), w1 = expf(l1 - M), w2 = expf(l2 - M); const float iw = 1.f / (w0 + w1 + w2); w0 *= iw; w1 *= iw; w2 *= iw;
        const u32x2 a = *((const u32x2*)(og + ((size_t)0 * TC + t) * 256) + lane), bb = *((const u32x2*)(og + ((size_t)1 * TC + t) * 256) + lane), c = *((const u32x2*)(og + ((size_t)2 * TC + t) * 256) + lane);
        u32x2 o; o.x = pk2(w0 * lo_bf(a.x) + w1 * lo_bf(bb.x) + w2 * lo_bf(c.x), w0 * hi_bf(a.x) + w1 * hi_bf(bb.x) + w2 * hi_bf(c.x));
        o.y = pk2(w0 * lo_bf(a.y) + w1 * lo_bf(bb.y) + w2 * lo_bf(c.y), w0 * hi_bf(a.y) + w1 * hi_bf(bb.y) + w2 * hi_bf(c.y));
        *((u32x2*)(ya + (size_t)t * 256) + lane) = o;
    }
}
__device__ __forceinline__ void sub_barrier(unsigned* cnt, unsigned target) {
    asm volatile("s_waitcnt vmcnt(0)" ::: "memory");
    __syncthreads();
    if (threadIdx.x == 0) {
        __builtin_amdgcn_fence(__ATOMIC_RELEASE, "agent"); asm volatile("s_waitcnt vmcnt(0)" ::: "memory");
        (void)xb_add(cnt, 1u);
        unsigned sp = 0; while (xb_ld(cnt) < target) { __builtin_amdgcn_s_sleep(2); if (++sp > (1u << 24)) break; }
        __builtin_amdgcn_fence(__ATOMIC_ACQUIRE, "agent"); asm volatile("s_waitcnt vmcnt(0)" ::: "memory");
    }
    __syncthreads();
}
__device__ __forceinline__ void phase_mixers(const Params& p, LAS unsigned char* lds, int layer) {
    const int G = gridDim.x, NDP = NB * 32 * 6, NSS = NB * 32 * 2;
    TSUB(15);
    for (int item = blockIdx.x; item < NDP + NSS; item += G) {
        if (item < NDP) { dn_prep(p, lds, layer, item / 192, (item / 6) % 32, item % 6); TSUB(6); }
        else { const int it = item - NDP; ssd_states(p, lds, layer, it / 64, (it >> 1) & 31, it & 1); TSUB(7); }
    }
}
__device__ __forceinline__ void phase_mixers2(const Params& p, LAS unsigned char* lds, int layer, int rep, unsigned* subcnt, bool use_bar2) {
    const int tid_ = htid(), lane = tid_ & 63, wave = tid_ >> 6, G = gridDim.x, nscan = NB * 6;
    const int ded = G > 2 * nscan ? nscan : 0;
    TSUB(15);
    if ((int)blockIdx.x < ded) { if (!(MIX2_PROBE == 2 && rep > 0)) dn_scan(p, lds, layer, blockIdx.x / 6, blockIdx.x % 6); TSUB(0); return; }
    if (MIX2_PROBE == 1 && rep > 0) return;
    if (ded == 0) for (int it = blockIdx.x; it < nscan; it += G) dn_scan(p, lds, layer, it / 6, it % 6);
    const int nb = G - ded, rb = (int)blockIdx.x - ded;
    for (int item = rb; item < NB * 3 * 4 * 64 / 8; item += nb) { const int w = item * 8 + wave;
        const int st = w & 63, jj = (w >> 6) & 3, gg = (w >> 8) % 3, bb = w / 768;
        const int dd = gg == 0 ? 1 : (gg == 1 ? 4 : 16), tiles = SEQ / dd / 32;
        attn_tile(p, bb, gg, jj, st / tiles, st % tiles, lane); }
    TSUB(1);
    ssd_scan(p, ded, nb);
    TSUB(2);
    if (use_bar2) { XcdBarrier bar2; bar2.bar = (unsigned*)(p.ws + WS_CTL) + CW_BAR2; bar2.x = xb_xcc_id(); bar2.st = (volatile LAS unsigned*)(lds + LDS_BYTES - 256) + 12; xcd_barrier(bar2, (unsigned)nb); } else sub_barrier(subcnt, (unsigned)(nb * (rep + 1)));
    TSUB(3);
    for (int it = rb; it < NB * 32 * 2; it += nb) ssd_out(p, lds, layer, it / 64, (it >> 1) & 31, it & 1);
    TSUB(4);
    phase_attn_combine(p, ded);
    TSUB(5);
}

constexpr int NSTEPS = 1 + NCH * (8 + 11 + 1);
__global__ void __launch_bounds__(512, 2) hybrid_fwd(Params p) {
    extern __shared__ __attribute__((aligned(16))) unsigned char lds_raw[];
    LAS unsigned char* lds = (LAS unsigned char*)lds_raw;
    volatile LAS unsigned* MISC = (volatile LAS unsigned*)(lds + LDS_BYTES - 256);
    if (threadIdx.x < 64) MISC[threadIdx.x] = 0u;
    __syncthreads();
    const int G = gridDim.x, cid = blockIdx.x;
    unsigned char* ws = p.ws;
    XcdBarrier bar; bar.bar = (unsigned*)(ws + WS_CTL) + CW_BAR; bar.x = 0; bar.st = MISC + 8;
    if (p.s_hi - p.s_lo > 1) bar = xcd_barrier_post((unsigned*)(ws + WS_CTL) + CW_BAR, MISC + 8);
    const bool use_bar2 = (p.s_hi - p.s_lo == NSTEPS) && ((int)gridDim.x > 2 * NB * 6);
    if (use_bar2 && (int)blockIdx.x >= NB * 6 && threadIdx.x == 0) (void)xb_add((unsigned*)(ws + WS_CTL) + CW_BAR2 + XB_XCNT(xb_xcc_id()), 1u);
    const int lo = p.s_lo, hi = p.s_hi;
    int step = 0;
    if (TPROBE_MASK != 0u && threadIdx.x == 0) { volatile LAS unsigned long long* tp_ = (volatile LAS unsigned long long*)(lds + LDS_BYTES - 256 + 128); tp_[0] = 0ull; tp_[1] = __builtin_amdgcn_s_memrealtime(); tp_[2] = 21ull; }
#define IN_STEP (step >= lo && step < hi)
#define END_STEP do { if (step >= lo && step + 1 < hi) xcd_barrier(bar); \
        if (TPROBE_ON && threadIdx.x == 0) { volatile LAS unsigned long long* tp_ = (volatile LAS unsigned long long*)(lds + LDS_BYTES - 256 + 128); const unsigned long long tn_ = __builtin_amdgcn_s_memrealtime(); \
            const unsigned pos_ = (unsigned)tp_[2]; if (pos_ < 22u && ((p.tmask >> pos_) & 1u)) tp_[0] += tn_ - tp_[1]; tp_[1] = tn_; tp_[2] = pos_ >= 20u ? 1ull : (unsigned long long)(pos_ + 1u); } \
        ++step; } while (0)
    bf16_t* xb = (bf16_t*)(ws + WS_XB); float* ssq = (float*)(ws + WS_SSQ);
    if (IN_STEP) for (int rep_ = 0; rep_ < (REP_PH == 0 ? 3 : 1); ++rep_, (rep_ < (REP_PH == 0 ? 3 : 1) ? xcd_barrier(bar) : (void)0)) { phase_convert(p, lds); phase_chunk_in(p, 0); }
    END_STEP;
    for (int chunk = 0; chunk < NCH; ++chunk) {
        float* xo = p.out + (size_t)chunk * TC * D;
        for (int layer = 0; layer < DEPTH; ++layer) {
            if (IN_STEP) for (int rep_ = 0; rep_ < (REP_PH == 2 ? 3 : 1); ++rep_, (rep_ < (REP_PH == 2 ? 3 : 1) ? xcd_barrier(bar) : (void)0)) {
                ProgIn P; P.S.init(TC / 256, INP / 256, G, cid); P.xb = layer == 0 ? xb : (const bf16_t*)(ws + WS_XB2); P.Wt = (const bf16_t*)(ws + WS_WIN) + (size_t)layer * INP * D; P.ssq = layer == 0 ? ssq : (const float*)(ws + WS_SSQ2);
                P.wsb = ws; P.pb = (const bf16_t*)(ws + WS_PB) + (size_t)layer * TC * PLE; P.wple = (const bf16_t*)(ws + WS_WPLE) + (size_t)layer * D * PLE;
                gemm_phase(lds, P);
            }
            END_STEP;
            if (IN_STEP) for (int rep_ = 0; rep_ < (REP_PH == 3 ? 3 : 1); ++rep_, (rep_ < (REP_PH == 3 ? 3 : 1) ? xcd_barrier(bar) : (void)0)) phase_mixers(p, lds, layer);
            END_STEP;
            if (IN_STEP) for (int rep_ = 0; rep_ < (REP_PH == 4 ? 3 : 1); ++rep_, (rep_ < (REP_PH == 4 ? 3 : 1) ? xcd_barrier(bar) : (void)0)) phase_mixers2(p, lds, layer, rep_, (unsigned*)(ws + WS_CTL) + CW_SUB + (chunk * 2 + layer) * 64, use_bar2);
            END_STEP;
            if (IN_STEP) for (int rep_ = 0; rep_ < (REP_PH == 6 ? 3 : 1); ++rep_, (rep_ < (REP_PH == 6 ? 3 : 1) ? xcd_barrier(bar) : (void)0)) {
                ProgMerge P; P.S.init(TC / 256, 4, G, cid); P.wsb = ws;
                P.wdn = (const bf16_t*)(ws + WS_WDN) + (size_t)layer * D * 768; P.wssm = (const bf16_t*)(ws + WS_WSSM) + (size_t)layer * D * 768; P.watt = (const bf16_t*)(ws + WS_WATT) + (size_t)layer * D * 256;
                gemm_phase(lds, P);
            }
            END_STEP;
            if (IN_STEP) {
                ProgResid P; P.S.init(TC / 256, 4, G, cid); P.A = (const bf16_t*)(ws + WS_MERGED); P.lda = 2048; P.nt = 16; P.Wt = (const bf16_t*)(ws + WS_WOUT) + (size_t)layer * D * D; P.ldb = 2048;
                P.xin_f = layer == 0 ? p.in[I_X] + (size_t)chunk * TC * D : nullptr; P.xin_b = (const bf16_t*)(ws + WS_XB2); P.xb = xb; P.ssq = ssq; P.sc = 1.f;
                gemm_phase(lds, P);
            }
            END_STEP;
            if (layer == 0) {
                if (IN_STEP) for (int rep_ = 0; rep_ < (REP_PH == 8 ? 3 : 1); ++rep_, (rep_ < (REP_PH == 8 ? 3 : 1) ? xcd_barrier(bar) : (void)0)) {
                    ProgFfnGu P; P.S.init(TC / 256, 2 * FFN / 256, G, cid); P.xb = xb; P.Wt = (const bf16_t*)(ws + WS_WFGU); P.ssq = ssq; P.act = (bf16_t*)(ws + WS_ACT);
                    gemm_phase(lds, P);
                }
                END_STEP;
                if (IN_STEP) {
                    ProgResid P; P.S.init(TC / 256, 4, G, cid); P.A = (const bf16_t*)(ws + WS_ACT); P.lda = 2 * FFN; P.nt = FFN / 64; P.Wt = (const bf16_t*)(ws + WS_WFD); P.ldb = 2 * FFN;
                    P.xin_f = nullptr; P.xin_b = xb; P.xb = xb; P.ssq = ssq; P.sc = (DBG_ABL & 8) ? 0.f : 1.f;
                    gemm_phase(lds, P);
                }
                END_STEP;
            } else {
                if (IN_STEP) phase_router(p, lds, chunk);
                END_STEP;
                if (IN_STEP) phase_slots(p, chunk);
                END_STEP;
                if (IN_STEP) for (int rep_ = 0; rep_ < (REP_PH == 12 ? 3 : 1); ++rep_, (rep_ < (REP_PH == 12 ? 3 : 1) ? xcd_barrier(bar) : (void)0)) {
                    ProgMoeGu P; P.S.init((const unsigned*)(ws + WS_CTL) + CW_CNT + chunk * 64, 2 * EXD / 256, G, cid); P.xb = xb; P.Wt = (const bf16_t*)(ws + WS_WMGU); P.ssq = ssq;
                    P.idx = (const int*)(ws + WS_ROUTE) + RT_IDX; P.act = (bf16_t*)(ws + WS_ACTM);
                    gemm_phase(lds, P);
                }
                END_STEP;
                if (IN_STEP) for (int rep_ = 0; rep_ < (REP_PH == 13 ? 3 : 1); ++rep_, (rep_ < (REP_PH == 13 ? 3 : 1) ? xcd_barrier(bar) : (void)0)) {
                    ProgMoeDown P; P.init((const unsigned*)(ws + WS_CTL) + CW_CNT + chunk * 64, G, cid); P.act = (const bf16_t*)(ws + WS_ACTM); P.Wt = (const bf16_t*)(ws + WS_WMD); P.ypair = (bf16_t*)(ws + WS_YPAIR); P.partk = (float*)(ws + WS_PARTK);
                    gemm_phase(lds, P);
                }
                END_STEP;
                if (IN_STEP) phase_combine(p, chunk);
                END_STEP;
            }
            if (IN_STEP) {
                ProgPle P; P.S.init(TC / 256, 4, G, cid); P.xb = xb; P.wpg = (const bf16_t*)(ws + WS_WPG) + (size_t)layer * D * D; P.pp = (const bf16_t*)(ws + WS_PP); P.ssq = ssq;
                P.xbout = (bf16_t*)(ws + WS_XB2); P.ssqout = (float*)(ws + WS_SSQ2);
                gemm_phase(lds, P);
            }
            END_STEP;
        }
        if (IN_STEP) { phase_final(p, chunk); if (chunk + 1 < NCH) phase_chunk_in(p, chunk + 1); }
        END_STEP;
    }
    if (TPROBE_MASK != 0u && (int)blockIdx.x == (p.pad & 0xffff) && threadIdx.x == 0) { const unsigned long long tsum_ = *(volatile LAS unsigned long long*)(lds + LDS_BYTES - 256 + 128); const unsigned long long t0_ = __builtin_amdgcn_s_memrealtime(); while (__builtin_amdgcn_s_memrealtime() - t0_ < 4ull * tsum_) __builtin_amdgcn_s_sleep(16); }
#undef IN_STEP
#undef END_STEP
}

#if defined(DBG_REP_STEP)
__global__ void dbg_csum(const unsigned* buf, size_t n, unsigned long long* out) {
    unsigned long long a = 0;
    for (size_t i = (size_t)blockIdx.x * 256 + threadIdx.x; i < n; i += (size_t)gridDim.x * 256) a += (unsigned long long)buf[i] * (unsigned long long)((i % 1021) + 1);
    atomicAdd(out, a);
}
__global__ void dbg_verdict(float* out, const unsigned long long* cs, int R) {
    bool bad = false; for (int r = 1; r < R; ++r) bad = bad || (cs[r] != cs[0]);
    const float v = bad ? __builtin_nanf("") : 0.f; const size_t n = (size_t)BATCH * SEQ * D;
    for (size_t i = (size_t)blockIdx.x * 256 + threadIdx.x; i < n; i += (size_t)gridDim.x * 256) out[i] = v;
}
#endif
#if defined(DBG_STOP)
#ifndef DBG_DUMP
#define DBG_DUMP 0
#define DBG_DUMP_OFF 0
#endif
__global__ void dbg_fill(float* out, const unsigned short* buf, int dump) {
    const size_t n = (size_t)BATCH * SEQ * D, c0 = (size_t)TC * D;
    for (size_t i = (size_t)blockIdx.x * 256 + threadIdx.x; i < n; i += (size_t)gridDim.x * 256) {
        if (i >= c0) out[i] = 0.f; else if (dump) out[i] = __uint_as_float(((unsigned)buf[i]) << 16);
    }
}
#endif
extern "C" void kernel_launch(void* const* d_in, const int* in_sizes, int n_in, void* d_out, int out_size, void* d_ws, size_t ws_size, hipStream_t stream) {
    static int grid = 0;
    if (grid == 0) {
        if (n_in != 30 || out_size != BATCH * SEQ * D || ws_size < WS_END) { fprintf(stderr, "kernel_launch: unexpected shapes (n_in %d, out %d, ws %zu < %zu)\n", n_in, out_size, ws_size, (size_t)WS_END); grid = -1; return; }
        int dev = 0, cus = 0;
        if (hipGetDevice(&dev) != hipSuccess || hipDeviceGetAttribute(&cus, hipDeviceAttributeMultiprocessorCount, dev) != hipSuccess) { grid = -1; return; }
        if (hipFuncSetAttribute((const void*)hybrid_fwd, hipFuncAttributeMaxDynamicSharedMemorySize, LDS_BYTES) != hipSuccess) { fprintf(stderr, "kernel_launch: hipFuncSetAttribute failed\n"); grid = -1; return; }
        int per_cu = 0;
        if (hipOccupancyMaxActiveBlocksPerMultiprocessor(&per_cu, (const void*)hybrid_fwd, 512, LDS_BYTES) != hipSuccess || per_cu < 1) { fprintf(stderr, "kernel_launch: occupancy query says %d\n", per_cu); }
        (void)hipGetLastError();
        grid = cus;
    }
    if (grid < 0) return;
    (void)hipMemsetAsync((char*)d_ws + WS_CTL, 0, MiB, stream);
    Params p{};
    for (int i = 0; i < 30; ++i) p.in[i] = (const float*)d_in[i];
    p.out = (float*)d_out; p.ws = (unsigned char*)d_ws; p.tmask = TPROBE_MASK; p.pad = TPROBE_PAD;
#if defined(DBG_REP_STEP)
    for (int s = 0; s < DBG_REP_STEP; ++s) { p.s_lo = s; p.s_hi = s + 1; hipLaunchKernelGGL(hybrid_fwd, dim3(grid), dim3(512), LDS_BYTES, stream, p); }
    unsigned long long* cs = (unsigned long long*)((char*)d_ws + WS_CTL + 512 * 1024);
    for (int r = 0; r < DBG_REP_N; ++r) { p.s_lo = DBG_REP_STEP; p.s_hi = DBG_REP_STEP + 1; hipLaunchKernelGGL(hybrid_fwd, dim3(grid), dim3(512), LDS_BYTES, stream, p);
        hipLaunchKernelGGL(dbg_csum, dim3(1024), dim3(256), 0, stream, (const unsigned*)((const char*)d_ws + DBG_REP_OFF), (size_t)(DBG_REP_BYTES) / 4, cs + r); }
    hipLaunchKernelGGL(dbg_verdict, dim3(2048), dim3(256), 0, stream, (float*)d_out, cs, (int)DBG_REP_N);
#elif defined(DBG_STOP)
    for (int s = 0; s < DBG_STOP; ++s) { p.s_lo = s; p.s_hi = s + 1; hipLaunchKernelGGL(hybrid_fwd, dim3(grid), dim3(512), LDS_BYTES, stream, p); }
    hipLaunchKernelGGL(dbg_fill, dim3(2048), dim3(256), 0, stream, (float*)d_out, (const unsigned short*)((const char*)d_ws + DBG_DUMP_OFF), (int)DBG_DUMP);
#elif ONE_LAUNCH
    p.s_lo = 0; p.s_hi = NSTEPS;
    hipLaunchKernelGGL(hybrid_fwd, dim3(grid), dim3(512), LDS_BYTES, stream, p);
#else
    for (int s = 0; s < NSTEPS; ++s) { p.s_lo = s; p.s_hi = s + 1; hipLaunchKernelGGL(hybrid_fwd, dim3(grid), dim3(512), LDS_BYTES, stream, p); }
#endif
}
```

```cpp
#include <hip/hip_runtime.h>
#include <cstdio>
#include <cstdint>

#define GAS __attribute__((address_space(1)))
#define LAS __attribute__((address_space(3)))
typedef unsigned short bf16_t;
typedef short bf16x8 __attribute__((ext_vector_type(8)));
typedef float f32x4 __attribute__((ext_vector_type(4)));
typedef float f32x2 __attribute__((ext_vector_type(2)));
typedef unsigned u32x4 __attribute__((ext_vector_type(4)));
typedef unsigned u32x2 __attribute__((ext_vector_type(2)));

#ifndef REP_PH
#define REP_PH -1
#endif
#ifndef EMU_FP8
#define EMU_FP8 0
#endif
#ifndef TPROBE_MASK
#define TPROBE_MASK 0u
#endif
#define TPROBE_ON (TPROBE_MASK != 0u)
#ifndef TPROBE_PAD
#define TPROBE_PAD 0
#endif
#define TSUB(b) do { if (TPROBE_ON && threadIdx.x == 0 && (int)blockIdx.x == (p.pad & 0xffff)) { volatile LAS unsigned long long* ts_ = (volatile LAS unsigned long long*)(lds + LDS_BYTES - 256 + 128); \
        const unsigned long long tn_ = __builtin_amdgcn_s_memrealtime(); if ((p.pad >> (16 + (b))) & 1) ts_[0] += tn_ - ts_[3]; ts_[3] = tn_; } } while (0)
#ifndef MIX2_PROBE
#define MIX2_PROBE 0
#endif
#ifndef DBG_ABL
#define DBG_ABL 0
#endif
#ifndef ONE_LAUNCH
#define ONE_LAUNCH 1
#endif

constexpr int D = 1024, BATCH = 32, SEQ = 2048, DEPTH = 2;
constexpr int PLE = 256;
constexpr float EPS = 1e-6f;
constexpr int FFN = 2816, NE = 8, EXD = 3584;
constexpr int C_DNZ = 2304, C_DNA = 3072, C_DNB = 3078, C_XBC = 3084, C_SSZ = 4364, C_SSDT = 5132, C_ATT = 5144, C_GATE = 7448, INW = 10520;
constexpr int NB = 8, TC = NB * SEQ, NCH = BATCH / NB;
constexpr int INP = 10752;
constexpr int MOE_SLOTS = 2 * TC + NE * 256;

constexpr size_t MiB = 1u << 20;
constexpr size_t WS_CTL = 0;
constexpr size_t WS_WIN = 1 * MiB;
constexpr size_t WS_WDN = WS_WIN + 42 * MiB;
constexpr size_t WS_WSSM = WS_WDN + 3 * MiB;
constexpr size_t WS_WATT = WS_WSSM + 3 * MiB;
constexpr size_t WS_WOUT = WS_WATT + 1 * MiB;
constexpr size_t WS_WFGU = WS_WOUT + 4 * MiB;
constexpr size_t WS_WFD = WS_WFGU + 11 * MiB;
constexpr size_t WS_WMGU = WS_WFD + 6 * MiB;
constexpr size_t WS_WMD = WS_WMGU + 112 * MiB;
constexpr size_t WS_WPG = WS_WMD + 56 * MiB;
constexpr size_t WS_WPLE = WS_WPG + 4 * MiB;
constexpr size_t WS_WR = WS_WPLE + 1 * MiB;
constexpr size_t WS_ACT0 = WS_WR + 1 * MiB;
constexpr size_t WS_XB = WS_ACT0;
constexpr size_t WS_SSQ = WS_XB + 32 * MiB;
constexpr size_t WS_PB = WS_SSQ + 1 * MiB;
constexpr size_t WS_ROUTE = WS_PB + 16 * MiB;
constexpr size_t WS_PART = WS_ROUTE + 1 * MiB;
constexpr size_t WS_PP = WS_PART;
constexpr size_t WS_MERGED = WS_PART + 64 * MiB;
constexpr size_t WS_Y = WS_MERGED + 32 * MiB;
constexpr size_t WS_YDN = WS_Y, WS_YSSM = WS_Y + 24 * MiB, WS_YATT = WS_Y + 48 * MiB, WS_OG = WS_Y + 56 * MiB, WS_LSE = WS_Y + 80 * MiB;
constexpr size_t WS_YPAIR = WS_Y;
constexpr size_t WS_PROJ = WS_Y + 81 * MiB;
constexpr size_t WS_PDN = WS_PROJ, WS_PSSM = WS_PDN + 96 * MiB, WS_SMALL = WS_PSSM + 64 * MiB, WS_QK = WS_SMALL + 2 * MiB, WS_VT = WS_QK + 48 * MiB, WS_GATES = WS_VT + 24 * MiB;
constexpr size_t WS_ACT = WS_PROJ, WS_ACTM = WS_PROJ;
constexpr int KSPL = 7, TAILMAX = 32;
constexpr size_t WS_PARTK = WS_PROJ + 256 * MiB;
static_assert((size_t)MOE_SLOTS * EXD * 2 <= 256 * MiB && WS_PARTK + (size_t)KSPL * (TAILMAX / 4) * 256 * 1024 * 4 <= WS_PROJ + 330 * MiB, "partk");
constexpr size_t WS_SCR = WS_PROJ + 330 * MiB;
constexpr size_t WS_XB2 = WS_SCR;
constexpr size_t WS_SSQ2 = WS_XB2 + 32 * MiB;
constexpr size_t WS_PART2 = WS_XB2 + 40 * MiB;
constexpr int DNS_ITEM = 73728;
constexpr size_t WS_DNS = WS_SCR + 40 * MiB;
constexpr size_t WS_DNEGL = WS_DNS + (size_t)NB * 32 * 6 * DNS_ITEM;
constexpr size_t WS_END = WS_SCR + 200 * MiB;
constexpr size_t WS_SSCD = WS_DNEGL + 8192;
static_assert(WS_SSCD + 16384 <= WS_END, "dn scratch");
constexpr size_t WS_SSPV = WS_SCR + 150 * MiB;
static_assert(WS_SSCD + 16384 <= WS_SSPV && WS_SSPV + 48 * MiB <= WS_END, "ssd prev");
constexpr size_t WS_SSST = WS_PART + 48 * MiB;
static_assert(WS_MERGED == WS_PART + 64 * MiB && (size_t)NB * 32 * 12 * 8192 * 2 <= 48 * MiB, "ssd states (bf16) sit in PART[48, 64) | MERGED, both idle during the mixers");
static_assert((size_t)MOE_SLOTS * EXD * 2 <= 330 * MiB, "moe act overlay");
static_assert((size_t)MOE_SLOTS * D * 2 <= 81 * MiB, "ypair overlay");
static_assert(WS_END <= 1024 * MiB, "workspace");
constexpr int RT_TOPE = 0, RT_TOPP = 2 * TC, RT_TOPW = 4 * TC, RT_TOPS = 6 * TC, RT_IDX = 8 * TC;
static_assert((size_t)(RT_IDX + MOE_SLOTS) * 4 <= MiB, "route");
constexpr int CW_BAR = 4096;
constexpr int CW_BAR2 = 8192;
constexpr int CW_SUB = 20480;
constexpr int CW_CNT = 16384;

constexpr int LDS_BYTES = 147456;
__device__ __forceinline__ int htid() { int t = threadIdx.x; asm volatile("" : "+v"(t)); return t; }
__device__ __forceinline__ float bf2f(bf16_t b) { return __uint_as_float(((unsigned)b) << 16); }
__device__ __forceinline__ unsigned f2bf(float f) { unsigned u = __float_as_uint(f); return (u + 0x7fffu + ((u >> 16) & 1u)) >> 16; }
typedef __bf16 bf16x2_t __attribute__((ext_vector_type(2)));
__device__ __forceinline__ unsigned pk2(float lo, float hi) { const f32x2 v = {lo, hi}; return __builtin_bit_cast(unsigned, __builtin_convertvector(v, bf16x2_t)); }
#define ST2_BF(PA, PB, A, B) do { const unsigned pw_ = pk2((A), (B)); *(PA) = (bf16_t)(pw_ & 0xffffu); *(PB) = (bf16_t)(pw_ >> 16); } while (0)
__device__ __forceinline__ float lo_bf(unsigned w) { return __uint_as_float(w << 16); }
__device__ __forceinline__ float hi_bf(unsigned w) { return __uint_as_float(w & 0xffff0000u); }
__device__ __forceinline__ float fexp(float x) { return __builtin_amdgcn_exp2f(x * 1.4426950408889634f); }
__device__ __forceinline__ float sigmoidf_(float x) { return __builtin_amdgcn_rcpf(1.f + fexp(-x)); }
__device__ __forceinline__ float siluf_(float x) { return x * sigmoidf_(x); }
__device__ __forceinline__ float softplusf_(float x) { const float e = fexp(x); return x > 20.f ? x : (x < -9.f ? e : __builtin_amdgcn_logf(1.f + e) * 0.6931471805599453f); }
__device__ __forceinline__ float q8(float v) {
    if (!EMU_FP8) return v;
    const float a = fabsf(v); float r;
    if (a < 0.015625f) r = rintf(a * 512.f) * (1.f / 512.f);
    else { unsigned u = __float_as_uint(a); u += 0x7FFFFu + ((u >> 20) & 1u); u &= ~0xFFFFFu; r = fminf(__uint_as_float(u), 448.f); }
    return copysignf(r, v);
}
__device__ __forceinline__ f32x4 q8v(f32x4 v) { return (f32x4){q8(v[0]), q8(v[1]), q8(v[2]), q8(v[3])}; }
__device__ __forceinline__ float wave_sum(float v) {
#pragma unroll
    for (int o = 1; o < 64; o <<= 1) v += __shfl_xor(v, o);
    return v;
}
__device__ __forceinline__ float wave_max(float v) {
#pragma unroll
    for (int o = 1; o < 64; o <<= 1) v = fmaxf(v, __shfl_xor(v, o));
    return v;
}
__device__ __forceinline__ float rstd_of(const float* ssq, int row) {
    const f32x4* p = (const f32x4*)(ssq + (size_t)row * 16);
    const f32x4 a = p[0], b = p[1], c = p[2], d = p[3];
    const float s = (((a.x + a.y) + (a.z + a.w)) + ((b.x + b.y) + (b.z + b.w))) + (((c.x + c.y) + (c.z + c.w)) + ((d.x + d.y) + (d.z + d.w)));
    return rsqrtf(s * (1.f / 1024.f) + EPS);
}
__device__ __forceinline__ int token_of_pos(int d, int p) {
    const int b = p >> 11, q = p & 2047;
    const int t = (d == 1) ? q : (d == 4) ? (4 * (q & 511) + (q >> 9)) : (16 * (q & 127) + (q >> 7));
    return b * 2048 + t;
}

#define XB_TMO      128
#define XB_XCNT(j)  (256  + 64 * (j))
#define XB_XSUB(j)  (1280 + 64 * (j))
#define XB_XGEN(j)  (2304 + 64 * (j))
#define XB_TOP      3328
#define XB_TOPGEN   3392
#define XCD_BAR_WORDS 3456
#define XB_SPIN_CAP (1u << 22)
__device__ __forceinline__ unsigned xb_ld(unsigned* p)              { return __hip_atomic_load(p, __ATOMIC_RELAXED, __HIP_MEMORY_SCOPE_AGENT); }
__device__ __forceinline__ unsigned xb_add(unsigned* p, unsigned v) { return __hip_atomic_fetch_add(p, v, __ATOMIC_RELAXED, __HIP_MEMORY_SCOPE_AGENT); }
__device__ __forceinline__ unsigned xb_xcc_id() { return (unsigned)__builtin_amdgcn_s_getreg((3 << 11) | 20) & 0xFu; }
#define XB_SPIN(cond, bar) do { unsigned _sp = 0; while (cond) { __builtin_amdgcn_s_sleep(1); \
    if ((++_sp & 255u) == 0u) { if (xb_ld(&(bar)[XB_TMO])) break; if (_sp > XB_SPIN_CAP) { atomicAdd(&(bar)[XB_TMO], 1u); break; } } } } while (0)
struct XcdBarrier { unsigned* bar; unsigned x; volatile LAS unsigned* st; };
__device__ __forceinline__ XcdBarrier xcd_barrier_post(unsigned* bar, volatile LAS unsigned* st) {
    XcdBarrier b; b.bar = bar; b.x = xb_xcc_id(); b.st = st;
    if (threadIdx.x == 0) (void)xb_add(&bar[XB_XCNT(b.x)], 1u);
    return b;
}
__device__ __forceinline__ void xcd_barrier_complete(unsigned* bar, unsigned x, unsigned& nloc, unsigned& nx, unsigned G) {
    unsigned sum, cnt, mine, sp = 0u;
    for (;;) {
        sum = 0u; cnt = 0u; mine = 0u;
#pragma unroll 1
        for (unsigned j = 0; j < 16; ++j) { const unsigned c = xb_ld(&bar[XB_XCNT(j)]); sum += c; cnt += (c > 0u) ? 1u : 0u; }
        mine = xb_ld(&bar[XB_XCNT(x)]);
        if (sum == G) break;
        __builtin_amdgcn_s_sleep(1);
        if ((++sp & 255u) == 0u) { if (xb_ld(&bar[XB_TMO])) break; if (sp > XB_SPIN_CAP) { atomicAdd(&bar[XB_TMO], 1u); break; } }
    }
    nloc = mine > 0u ? mine : 1u; nx = cnt > 0u ? cnt : 1u;
}
__device__ __forceinline__ void xcd_barrier(const XcdBarrier& b, unsigned nparts = 0u) {
    asm volatile("s_waitcnt vmcnt(0)" ::: "memory");
    __syncthreads();
    if (threadIdx.x == 0) {
        unsigned* bar = b.bar;
        __builtin_amdgcn_s_waitcnt(0);
        unsigned nloc = b.st[0], nx = b.st[1];
        if (nloc == 0u) { xcd_barrier_complete(bar, b.x, nloc, nx, nparts ? nparts : gridDim.x * gridDim.y * gridDim.z); b.st[0] = nloc; b.st[1] = nx; }
        const unsigned old = xb_add(&bar[XB_XSUB(b.x)], 1u);
        const unsigned gen = old / nloc;
        if (old + 1u == (gen + 1u) * nloc) {
            __builtin_amdgcn_fence(__ATOMIC_RELEASE, "agent");
            asm volatile("s_waitcnt vmcnt(0)" ::: "memory");
            const unsigned og = xb_add(&bar[XB_TOP], 1u);
            const unsigned tg = og / nx;
            if (og + 1u == (tg + 1u) * nx) xb_add(&bar[XB_TOPGEN], 1u);
            else XB_SPIN(xb_ld(&bar[XB_TOPGEN]) == tg, bar);
            __builtin_amdgcn_fence(__ATOMIC_ACQUIRE, "agent");
            xb_add(&bar[XB_XGEN(b.x)], 1u);
            asm volatile("s_waitcnt vmcnt(0)" ::: "memory");
        } else {
            XB_SPIN(xb_ld(&bar[XB_XGEN(b.x)]) == gen, bar);
            __builtin_amdgcn_fence(__ATOMIC_ACQUIRE, "agent");
            asm volatile("s_waitcnt vmcnt(0)" ::: "memory");
        }
    }
    __syncthreads();
}

constexpr int BM = 256, BK = 64, HALF = 128, HTB = HALF * BK * 2, STAGE_BYTES = 8 * HTB, NXCD = 8, WGM = 4;
__device__ __forceinline__ int lds_byte(int r, int c) { const int st = (r >> 4) * 2 + (c >> 5), rr = r & 15, cc = c & 31, ob = rr * 64 + cc * 2; return st * 1024 + (ob ^ (((ob >> 9) & 1) << 5)); }
__device__ __forceinline__ void stage_rc(int b, int& R, int& C) { const int st = b / 1024, sb = b % 1024, swz = sb ^ (((sb >> 9) & 1) << 5); R = (st >> 1) * 16 + swz / 64; C = (st & 1) * 32 + (swz % 64) / 2; }
__device__ __forceinline__ int perm32(int rho) { const int n = rho >> 4, i = rho & 15; return 8 * (i >> 2) + 4 * n + (i & 3); }

struct Unit { int pm, pn; };
struct StaticOrder {
    int nM, nN, nwg, G, c;
    __device__ __forceinline__ void init(int nM_, int nN_, int G_, int c_) { nM = nM_; nN = nN_; nwg = nM * nN; G = G_; c = c_; }
    __device__ __forceinline__ bool next(int i, Unit& u) const {
        const long L = (long)i * G + c; if (L >= nwg) return false;
        int wgid = (int)L; { const int q = nwg / NXCD, r = nwg % NXCD, xcd = wgid % NXCD, off = wgid / NXCD; wgid = (xcd < r ? xcd * (q + 1) : r * (q + 1) + (xcd - r) * q) + off; }
        const int nig = WGM * nN, gid = wgid / nig, fm = gid * WGM, gsz = (nM - fm) < WGM ? (nM - fm) : WGM;
        u.pm = fm + ((wgid % nig) % gsz); u.pn = (wgid % nig) / gsz; return true;
    }
};
struct GU { const char* A; const char* B; int lda, ldb, nt, mapA, mapB; const int* idx; int pm, pn, sub, aux; };
__device__ __forceinline__ unsigned row_off(int map, int RR, int ld, const int* idx) {
    int row;
    if (map == 0) row = RR;
    else if (map == 4) row = 4 * RR;
    else if (map == 16) row = 16 * (RR & 127) + (RR >> 7);
    else row = idx[RR];
    return (unsigned)row * (unsigned)ld;
}
template <class Prog>
__device__ __forceinline__ void gemm_phase(LAS unsigned char* lds, const Prog& P) {
    const int tid = htid(), wid = __builtin_amdgcn_readfirstlane(tid >> 6), lane = tid & 63, wr = wid >> 2, wc = wid & 3, fr = lane & 15, fq = lane >> 4;
    GU cur, nxt; int ui = 0;
    if (!P.unit(0, cur)) return;
    unsigned vA[4], vB[4];
#define G_SETV(u) do { int tz_ = threadIdx.x; asm volatile("" : "+v"(tz_)); int R0, C0, R1, C1; stage_rc(tz_ * 16, R0, C0); stage_rc(tz_ * 16 + 8192, R1, C1); \
        const int Rb0 = (R0 & ~31) + perm32(R0 & 31), Rb1 = (R1 & ~31) + perm32(R1 & 31); \
        vA[0] = row_off((u).mapA, R0, (u).lda, (u).idx) + C0 * 2; vA[1] = row_off((u).mapA, R1, (u).lda, (u).idx) + C1 * 2; \
        vA[2] = row_off((u).mapA, R0 + 128, (u).lda, (u).idx) + C0 * 2; vA[3] = row_off((u).mapA, R1 + 128, (u).lda, (u).idx) + C1 * 2; \
        vB[0] = row_off((u).mapB, Rb0, (u).ldb, nullptr) + C0 * 2; vB[1] = row_off((u).mapB, Rb1, (u).ldb, nullptr) + C1 * 2; \
        vB[2] = row_off((u).mapB, Rb0 + 128, (u).ldb, nullptr) + C0 * 2; vB[3] = row_off((u).mapB, Rb1 + 128, (u).ldb, nullptr) + C1 * 2; } while (0)
    G_SETV(cur);
    const unsigned ldsw = (unsigned)wid * 1024u;
    const int aoff = lds_byte(wr * 64 + fr, fq * 8), boff = lds_byte(wc * 32 + fr, fq * 8);
#define G_SA(b, h) (((b) * 2 + (h)) * HTB)
#define G_SB(b, h) ((4 + (b) * 2 + (h)) * HTB)
#define G_STAGE(bufoff, gbase, v, h) do { \
        __builtin_amdgcn_global_load_lds((const unsigned*)((gbase) + (v)[2 * (h)]), (LAS unsigned*)(lds + (bufoff) + ldsw), 16, 0, 0); \
        __builtin_amdgcn_global_load_lds((const unsigned*)((gbase) + (v)[2 * (h) + 1]), (LAS unsigned*)(lds + (bufoff) + ldsw + 8192), 16, 0, 0); } while (0)
#define G_LDA(dst, b, h) do { _Pragma("unroll") for (int m = 0; m < 4; ++m) _Pragma("unroll") for (int k = 0; k < 2; ++k) dst[m][k] = *(const LAS bf16x8*)(lds + G_SA(b, h) + aoff + m * 2048 + k * 1024); } while (0)
#define G_LDB(dst, b, h) do { _Pragma("unroll") for (int n = 0; n < 2; ++n) _Pragma("unroll") for (int k = 0; k < 2; ++k) dst[n][k] = *(const LAS bf16x8*)(lds + G_SB(b, h) + boff + n * 2048 + k * 1024); } while (0)
#define G_MMA(ai, bj, At, Bt) do { __builtin_amdgcn_s_setprio(1); _Pragma("unroll") for (int m = 0; m < 4; ++m) _Pragma("unroll") for (int n = 0; n < 2; ++n) _Pragma("unroll") for (int k = 0; k < 2; ++k) \
        acc[ai][bj][m][n] = __builtin_amdgcn_mfma_f32_16x16x32_bf16(Bt[n][k], At[m][k], acc[ai][bj][m][n], 0, 0, 0); __builtin_amdgcn_s_setprio(0); } while (0)
#define G_WAIT_V(n) asm volatile("s_waitcnt vmcnt(" #n ")" ::: "memory")
#define G_WAIT_L(n) asm volatile("s_waitcnt lgkmcnt(" #n ")" ::: "memory")
#define G_BAR __builtin_amdgcn_s_barrier()
#define G_SCHED __builtin_amdgcn_sched_barrier(0)
    f32x4 acc[2][2][4][2];
#pragma unroll
    for (int a = 0; a < 2; ++a)
#pragma unroll
        for (int b = 0; b < 2; ++b)
#pragma unroll
            for (int m = 0; m < 4; ++m)
#pragma unroll
                for (int n = 0; n < 2; ++n) acc[a][b][m][n] = (f32x4){0.f, 0.f, 0.f, 0.f};
    bf16x8 At[4][2], B0[2][2], B1[2][2];
    const char* cA = cur.A; const char* cB = cur.B;
    const size_t kstep = (size_t)(BK * 2);
    G_STAGE(G_SB(0, 0), cB, vB, 0); G_STAGE(G_SA(0, 0), cA, vA, 0); G_STAGE(G_SB(0, 1), cB, vB, 1); G_STAGE(G_SA(0, 1), cA, vA, 1);
    if (wr == 1) G_BAR;
    G_WAIT_V(4); G_BAR;
    G_STAGE(G_SB(1, 0), cB + kstep, vB, 0); G_STAGE(G_SA(1, 0), cA + kstep, vA, 0); G_STAGE(G_SB(1, 1), cB + kstep, vB, 1);
    G_WAIT_V(6); G_BAR;
    for (;;) {
        const bool has_next = P.unit(ui + 1, nxt);
        const char* nA = has_next ? nxt.A : cA; const char* nB = has_next ? nxt.B : cB;
        const int nt = cur.nt;
        for (int t = 0; t < nt; t += 2) {
            const bool last = (t == nt - 2);
            const char* a1 = cA + (size_t)(t + 1) * kstep;
            const char* a2 = last ? nA : cA + (size_t)(t + 2) * kstep; const char* b2 = last ? nB : cB + (size_t)(t + 2) * kstep;
            const char* a3 = a2 + kstep; const char* b3 = b2 + kstep;
            G_STAGE(G_SA(1, 1), a1, vA, 1);
            if (last && has_next) { G_SETV(nxt); }
            G_LDB(B0, 0, 0); G_SCHED; G_LDA(At, 0, 0);
            G_WAIT_L(8); G_BAR; G_WAIT_L(0); G_MMA(0, 0, At, B0); G_BAR; G_SCHED;
            G_LDB(B1, 0, 1); G_STAGE(G_SB(0, 0), b2, vB, 0);
            G_BAR; G_WAIT_L(0); G_MMA(0, 1, At, B1); G_BAR;
            G_LDA(At, 0, 1); G_STAGE(G_SA(0, 0), a2, vA, 0);
            G_BAR; G_WAIT_L(0); G_MMA(1, 0, At, B0); G_BAR; G_SCHED;
            G_STAGE(G_SB(0, 1), b2, vB, 1);
            G_WAIT_V(6); G_BAR; G_MMA(1, 1, At, B1); G_BAR;
            G_LDB(B0, 1, 0); G_SCHED; G_LDA(At, 1, 0); G_STAGE(G_SA(0, 1), a2, vA, 1);
            G_WAIT_L(8); G_BAR; G_WAIT_L(0); G_MMA(0, 0, At, B0); G_BAR; G_SCHED;
            G_LDB(B1, 1, 1); G_STAGE(G_SB(1, 0), b3, vB, 0);
            G_BAR; G_WAIT_L(0); G_MMA(0, 1, At, B1); G_BAR;
            G_LDA(At, 1, 1); G_STAGE(G_SA(1, 0), a3, vA, 0);
            G_BAR; G_WAIT_L(0); G_MMA(1, 0, At, B0); G_BAR; G_SCHED;
            G_STAGE(G_SB(1, 1), b3, vB, 1);
            G_WAIT_V(6); G_BAR; G_MMA(1, 1, At, B1); G_BAR;
        }
        { int tz_ = threadIdx.x; asm volatile("" : "+v"(tz_)); const int ln_ = tz_ & 63; P.epi(acc, cur, wr, wc, ln_ & 15, ln_ >> 4); }
        if (!has_next) break;
        if (!P.keep(cur))
#pragma unroll
        for (int a = 0; a < 2; ++a)
#pragma unroll
            for (int b = 0; b < 2; ++b)
#pragma unroll
                for (int m = 0; m < 4; ++m)
#pragma unroll
                    for (int n = 0; n < 2; ++n) acc[a][b][m][n] = (f32x4){0.f, 0.f, 0.f, 0.f};
        cur = nxt; cA = nA; cB = nB; ++ui;
    }
    G_WAIT_V(0);
    if (wr == 0) G_BAR;
    G_BAR;
#undef G_SETV
#undef G_SA
#undef G_SB
#undef G_STAGE
#undef G_LDA
#undef G_LDB
#undef G_MMA
#undef G_WAIT_V
#undef G_WAIT_L
#undef G_BAR
#undef G_SCHED
}

__device__ __forceinline__ void st_bf8(bf16_t* p, const f32x4 a, const f32x4 b) {
    u32x4 w; w.x = pk2(a[0], a[1]); w.y = pk2(a[2], a[3]); w.z = pk2(b[0], b[1]); w.w = pk2(b[2], b[3]);
    *(u32x4*)p = w;
}
__device__ __forceinline__ void ld_bf8(const bf16_t* p, f32x4& a, f32x4& b) {
    const u32x4 w = *(const u32x4*)p;
    a = (f32x4){lo_bf(w.x), hi_bf(w.x), lo_bf(w.y), hi_bf(w.y)}; b = (f32x4){lo_bf(w.z), hi_bf(w.z), lo_bf(w.w), hi_bf(w.w)};
}
__device__ __forceinline__ float sq8(const f32x4 a, const f32x4 b) { return ((a[0] * a[0] + a[1] * a[1]) + (a[2] * a[2] + a[3] * a[3])) + ((b[0] * b[0] + b[1] * b[1]) + (b[2] * b[2] + b[3] * b[3])); }

#define EPI_ROWS(ai, m) _Pragma("unroll") for (int ai = 0; ai < 2; ++ai) _Pragma("unroll") for (int m = 0; m < 4; ++m)
#define EPI_FENCE asm volatile("" ::: "memory")
#define EPI_SC(ai, m) __shfl((ai) ? r1_ : r0_, (m) * 16 + fr)

struct ProgIn {
    __device__ __forceinline__ bool keep(const GU&) const { return false; }
    StaticOrder S; const bf16_t* xb; const bf16_t* Wt; const float* ssq; unsigned char* wsb;
    const bf16_t* pb; const bf16_t* wple;
    __device__ __forceinline__ bool unit(int i, GU& u) const {
        Unit t;
        if (!S.next(i, t)) {
            const int rem = S.nwg % S.G, nfull = S.nwg / S.G, idle = rem == 0 ? S.G : S.G - rem, per = (256 + idle - 1) / idle;
            const int rk = rem == 0 ? S.c : S.c - rem, k = i - nfull;
            if (rk < 0 || k < 0 || k >= per) return false;
            const int pu = rk * per + k; if (pu >= 256) return false;
            u.pm = pu >> 2; u.pn = 64 + (pu & 3); u.sub = 0; u.aux = 0; u.nt = 4; u.idx = nullptr; u.lda = 512; u.ldb = 512; u.mapA = 0; u.mapB = 0;
            u.A = (const char*)pb + (size_t)(pu >> 2) * 256 * 512; u.B = (const char*)wple + (size_t)(pu & 3) * 256 * 512; return true;
        }
        u.pm = t.pm; u.pn = t.pn; u.sub = 0; u.aux = 0; u.nt = 16; u.idx = nullptr; u.lda = 2048; u.ldb = 2048;
        const char* w = (const char*)Wt + (size_t)t.pn * 256 * 2048;
        int g = 0; bool isvt = false;
        if (t.pn >= 20 && t.pn < 29) { g = (t.pn - 20) % 3; isvt = t.pn >= 26; }
        const int d = g == 0 ? 1 : (g == 1 ? 4 : 16);
        const int b = t.pm >> 3, tb = t.pm & 7;
        const int base = b * 2048 + (d == 1 ? 256 * tb : d == 4 ? 1024 * (tb & 1) + (tb >> 1) : 2 * tb);
        const char* x = (const char*)xb + (size_t)base * 2048;
        const int mapx = d == 1 ? 0 : d;
        if (!isvt) { u.A = x; u.mapA = mapx; u.B = w; u.mapB = 0; }
        else { u.A = w; u.mapA = 0; u.B = x; u.mapB = mapx; }
        return true;
    }
    __device__ __forceinline__ void epi(f32x4 (&acc)[2][2][4][2], const GU& u, int wr, int wc, int fr, int fq) const {
        const int pn = u.pn, pm = u.pm, rl0 = wr * 64 + fr, cl0 = wc * 32 + 8 * fq;
        if (pn >= 64) {
            EPI_ROWS(ai, m) { bf16_t* o = (bf16_t*)(wsb + WS_PP) + (size_t)(pm * 256 + ai * 128 + m * 16 + rl0) * 1024 + (pn - 64) * 256 + cl0;
#pragma unroll
                for (int bj = 0; bj < 2; ++bj) st_bf8(o + bj * 128, acc[ai][bj][m][0], acc[ai][bj][m][1]); }
            return;
        }
        if (pn >= 26 && pn < 29) {
            const int g = pn - 26, d = g == 0 ? 1 : (g == 1 ? 4 : 16), ln = fq * 16 + fr;
            const float rc = rstd_of(ssq, token_of_pos(d, pm * 256 + (ln >> 5) * 128 + wc * 32 + (ln & 31)));
            f32x4 s[2][2];
#pragma unroll
            for (int bj = 0; bj < 2; ++bj)
#pragma unroll
                for (int j = 0; j < 8; ++j) s[bj][j >> 2][j & 3] = __shfl(rc, bj * 32 + 8 * fq + j);
            EPI_ROWS(ai, m) { const int ch = ai * 128 + m * 16 + rl0; bf16_t* o = (bf16_t*)(wsb + WS_VT) + (size_t)(g * 256 + ch) * TC + pm * 256 + cl0;
#pragma unroll
                for (int bj = 0; bj < 2; ++bj) st_bf8(o + bj * 128, acc[ai][bj][m][0] * s[bj][0], acc[ai][bj][m][1] * s[bj][1]); }
            return;
        }
        int d = 1; if (pn >= 20 && pn < 26) { const int g = (pn - 20) % 3; d = g == 0 ? 1 : (g == 1 ? 4 : 16); }
        const float r0_ = rstd_of(ssq, token_of_pos(d, pm * 256 + fq * 16 + rl0)), r1_ = rstd_of(ssq, token_of_pos(d, pm * 256 + 128 + fq * 16 + rl0));
        if (pn < 20) {
            bf16_t* base = pn < 12 ? (bf16_t*)(wsb + WS_PDN) + pn * 256 : (bf16_t*)(wsb + WS_PSSM) + (pn - 12) * 256; const int ld = pn < 12 ? 3072 : 2048;
            EPI_ROWS(ai, m) { const int row = pm * 256 + ai * 128 + m * 16 + rl0; const float s = EPI_SC(ai, m); bf16_t* o = base + (size_t)row * ld + cl0;
#pragma unroll
                for (int bj = 0; bj < 2; ++bj) st_bf8(o + bj * 128, acc[ai][bj][m][0] * s, acc[ai][bj][m][1] * s); }
        } else if (pn < 26) {
            const int which = (pn - 20) / 3, g = (pn - 20) % 3; const float qs = which == 0 ? 0.125f : 1.f;
            bf16_t* base = (bf16_t*)(wsb + WS_QK) + (size_t)(which * 3 + g) * TC * 256;
            EPI_ROWS(ai, m) { const int p = pm * 256 + ai * 128 + m * 16 + rl0; const float s = EPI_SC(ai, m) * qs; bf16_t* o = base + (size_t)p * 256 + cl0;
#pragma unroll
                for (int bj = 0; bj < 2; ++bj) st_bf8(o + bj * 128, acc[ai][bj][m][0] * s, acc[ai][bj][m][1] * s); }
        } else if (pn < 41) {
            bf16_t* base = (bf16_t*)(wsb + WS_GATES) + (pn - 29) * 256;
            EPI_ROWS(ai, m) { const int row = pm * 256 + ai * 128 + m * 16 + rl0; const float s = EPI_SC(ai, m); bf16_t* o = base + (size_t)row * 3072 + cl0;
#pragma unroll
                for (int bj = 0; bj < 2; ++bj) { f32x4 a = acc[ai][bj][m][0] * s, b = acc[ai][bj][m][1] * s;
#pragma unroll
                    for (int j = 0; j < 4; ++j) { a[j] = sigmoidf_(a[j]); b[j] = sigmoidf_(b[j]); }
                    st_bf8(o + bj * 128, a, b); } }
        } else {
            EPI_ROWS(ai, m) { const int row = pm * 256 + ai * 128 + m * 16 + rl0; const float s = EPI_SC(ai, m);
                if (wc == 0) { float* o = (float*)(wsb + WS_SMALL) + (size_t)row * 32 + 8 * fq; *(f32x4*)o = acc[ai][0][m][0] * s; *(f32x4*)(o + 4) = acc[ai][0][m][1] * s; } }
        }
    }
};

struct ProgMerge {
    StaticOrder S; const bf16_t *wdn, *wssm, *watt; unsigned char* wsb;
    __device__ __forceinline__ bool keep(const GU& u) const { return u.sub < 2; }
    __device__ __forceinline__ bool unit(int i, GU& u) const {
        Unit t; if (!S.next(i / 3, t)) return false;
        const int sub = i % 3;
        u.pm = t.pm; u.pn = t.pn; u.sub = sub; u.aux = 0; u.idx = nullptr; u.mapA = 0; u.mapB = 0;
        if (sub < 2) { u.lda = 1536; u.ldb = 1536; u.nt = 12; u.A = (const char*)(wsb + (sub == 0 ? WS_YDN : WS_YSSM)) + (size_t)t.pm * 256 * 1536; u.B = (const char*)(sub == 0 ? wdn : wssm) + (size_t)t.pn * 256 * 1536; }
        else { u.lda = 512; u.ldb = 512; u.nt = 4; u.A = (const char*)(wsb + WS_YATT) + (size_t)t.pm * 256 * 512; u.B = (const char*)watt + (size_t)t.pn * 256 * 512; }
        return true;
    }
    __device__ __forceinline__ void epi(f32x4 (&acc)[2][2][4][2], const GU& u, int wr, int wc, int fr, int fq) const {
        const int rl0 = wr * 64 + fr, cl0 = wc * 32 + 8 * fq, sub = u.sub;
        const bf16_t* gp0 = (const bf16_t*)(wsb + WS_GATES) + (size_t)(u.pm * 256 + rl0) * 3072 + u.pn * 256 + cl0 + sub * 1024;
#pragma unroll
        for (int ai = 0; ai < 2; ++ai) {
            u32x4 gw[4][2], hw[4][2];
            if (sub < 2) {
#pragma unroll
                for (int m = 0; m < 4; ++m)
#pragma unroll
                    for (int bj = 0; bj < 2; ++bj) { const bf16_t* gp = gp0 + (size_t)(ai * 128 + m * 16) * 3072 + bj * 128; gw[m][bj] = *(const u32x4*)gp; hw[m][bj] = *(const u32x4*)(gp + 1024); }
            } else {
#pragma unroll
                for (int m = 0; m < 4; ++m)
#pragma unroll
                    for (int bj = 0; bj < 2; ++bj) { const bf16_t* gp = gp0 + (size_t)(ai * 128 + m * 16) * 3072 + bj * 128; gw[m][bj] = *(const u32x4*)gp; hw[m][bj] = gw[m][bj]; }
            }
#pragma unroll
            for (int m = 0; m < 4; ++m)
#pragma unroll
                for (int bj = 0; bj < 2; ++bj) { const int row = u.pm * 256 + ai * 128 + m * 16 + rl0, col = u.pn * 256 + bj * 128 + cl0;
                    f32x4 g0 = (f32x4){lo_bf(gw[m][bj].x), hi_bf(gw[m][bj].x), lo_bf(gw[m][bj].y), hi_bf(gw[m][bj].y)}, g1 = (f32x4){lo_bf(gw[m][bj].z), hi_bf(gw[m][bj].z), lo_bf(gw[m][bj].w), hi_bf(gw[m][bj].w)};
                    if ((DBG_ABL >> sub) & 1) { acc[ai][bj][m][0] = (f32x4){0.f, 0.f, 0.f, 0.f}; acc[ai][bj][m][1] = acc[ai][bj][m][0]; }
#pragma unroll
                    for (int j = 0; j < 4; ++j) { g0[j] = fmaxf(g0[j], 1e-8f); g1[j] = fmaxf(g1[j], 1e-8f); }
                    if (sub < 2) { const f32x4 h0 = (f32x4){lo_bf(hw[m][bj].x), hi_bf(hw[m][bj].x), lo_bf(hw[m][bj].y), hi_bf(hw[m][bj].y)}, h1 = (f32x4){lo_bf(hw[m][bj].z), hi_bf(hw[m][bj].z), lo_bf(hw[m][bj].w), hi_bf(hw[m][bj].w)};
#pragma unroll
                        for (int j = 0; j < 4; ++j) { acc[ai][bj][m][0][j] *= g0[j] * __builtin_amdgcn_rcpf(fmaxf(h0[j], 1e-8f)); acc[ai][bj][m][1][j] *= g1[j] * __builtin_amdgcn_rcpf(fmaxf(h1[j], 1e-8f)); } }
                    else st_bf8((bf16_t*)(wsb + WS_MERGED) + (size_t)row * 1024 + col, acc[ai][bj][m][0] * g0, acc[ai][bj][m][1] * g1); }
            EPI_FENCE;
        }
    }
};

struct ProgResid {
    __device__ __forceinline__ bool keep(const GU&) const { return false; }
    StaticOrder S; const bf16_t* A; int lda, nt; const bf16_t* Wt; int ldb; const float* xin_f; const bf16_t* xin_b; bf16_t* xb; float* ssq; float sc;
    __device__ __forceinline__ bool unit(int i, GU& u) const {
        Unit t; if (!S.next(i, t)) return false;
        u.pm = t.pm; u.pn = t.pn; u.sub = 0; u.aux = 0; u.idx = nullptr; u.mapA = 0; u.mapB = 0; u.lda = lda; u.ldb = ldb; u.nt = nt;
        u.A = (const char*)A + (size_t)t.pm * 256 * lda; u.B = (const char*)Wt + (size_t)t.pn * 256 * ldb; return true;
    }
    __device__ __forceinline__ void epi(f32x4 (&acc)[2][2][4][2], const GU& u, int wr, int wc, int fr, int fq) const {
        const int rl0 = wr * 64 + fr, cl0 = wc * 32 + 8 * fq;
#pragma unroll
        for (int ai = 0; ai < 2; ++ai) {
            f32x4 xv[4][2][2];
            if (xin_f) {
#pragma unroll
                for (int m = 0; m < 4; ++m)
#pragma unroll
                    for (int bj = 0; bj < 2; ++bj) { const size_t o = (size_t)(u.pm * 256 + ai * 128 + m * 16 + rl0) * 1024 + u.pn * 256 + bj * 128 + cl0; xv[m][bj][0] = *(const f32x4*)(xin_f + o); xv[m][bj][1] = *(const f32x4*)(xin_f + o + 4); }
            } else {
                u32x4 xw[4][2];
#pragma unroll
                for (int m = 0; m < 4; ++m)
#pragma unroll
                    for (int bj = 0; bj < 2; ++bj) xw[m][bj] = *(const u32x4*)(xin_b + (size_t)(u.pm * 256 + ai * 128 + m * 16 + rl0) * 1024 + u.pn * 256 + bj * 128 + cl0);
#pragma unroll
                for (int m = 0; m < 4; ++m)
#pragma unroll
                    for (int bj = 0; bj < 2; ++bj) { const u32x4 w = xw[m][bj]; xv[m][bj][0] = (f32x4){lo_bf(w.x), hi_bf(w.x), lo_bf(w.y), hi_bf(w.y)}; xv[m][bj][1] = (f32x4){lo_bf(w.z), hi_bf(w.z), lo_bf(w.w), hi_bf(w.w)}; }
            }
#pragma unroll
            for (int m = 0; m < 4; ++m) { const int row = u.pm * 256 + ai * 128 + m * 16 + rl0; float ss = 0.f;
#pragma unroll
                for (int bj = 0; bj < 2; ++bj) { const size_t o = (size_t)row * 1024 + u.pn * 256 + bj * 128 + cl0;
                    const f32x4 v0 = acc[ai][bj][m][0] * sc + xv[m][bj][0], v1 = acc[ai][bj][m][1] * sc + xv[m][bj][1];
                    st_bf8(xb + o, v0, v1); ss += sq8(v0, v1); }
                ss += __shfl_xor(ss, 16); ss += __shfl_xor(ss, 32);
                if (fq == 0) ssq[(size_t)row * 16 + u.pn * 4 + wc] = ss; }
            EPI_FENCE;
        }
    }
};

struct ProgFfnGu {
    __device__ __forceinline__ bool keep(const GU&) const { return false; }
    StaticOrder S; const bf16_t* xb; const bf16_t* Wt; const float* ssq; bf16_t* act;
    __device__ __forceinline__ bool unit(int i, GU& u) const {
        Unit t; if (!S.next(i, t)) return false;
        u.pm = t.pm; u.pn = t.pn; u.sub = 0; u.aux = 0; u.idx = nullptr; u.mapA = 0; u.mapB = 0; u.lda = 2048; u.ldb = 2048; u.nt = 16;
        u.A = (const char*)xb + (size_t)t.pm * 256 * 2048; u.B = (const char*)Wt + (size_t)t.pn * 256 * 2048; return true;
    }
    __device__ __forceinline__ void epi(f32x4 (&acc)[2][2][4][2], const GU& u, int wr, int wc, int fr, int fq) const {
        const int rl0 = wr * 64 + fr, cl0 = wc * 32 + 8 * fq;
        const float r0_ = rstd_of(ssq, u.pm * 256 + fq * 16 + rl0), r1_ = rstd_of(ssq, u.pm * 256 + 128 + fq * 16 + rl0);
        EPI_ROWS(ai, m) { const int row = u.pm * 256 + ai * 128 + m * 16 + rl0; const float s = EPI_SC(ai, m);
            f32x4 o[2];
#pragma unroll
            for (int n = 0; n < 2; ++n)
#pragma unroll
                for (int j = 0; j < 4; ++j) { const float g = acc[ai][0][m][n][j] * s, up = acc[ai][1][m][n][j] * s; o[n][j] = q8(siluf_(g) * up); }
            st_bf8(act + (size_t)row * FFN + u.pn * 128 + cl0, o[0], o[1]); }
    }
};

struct ProgPle {
    __device__ __forceinline__ bool keep(const GU&) const { return false; }
    StaticOrder S; const bf16_t *xb, *wpg, *pp; const float* ssq; bf16_t* xbout; float* ssqout;
    __device__ __forceinline__ bool unit(int i, GU& u) const {
        Unit t; if (!S.next(i, t)) return false;
        u.pm = t.pm; u.pn = t.pn; u.sub = 0; u.aux = 0; u.idx = nullptr; u.mapA = 0; u.mapB = 0; u.lda = 2048; u.ldb = 2048; u.nt = 16;
        u.A = (const char*)xb + (size_t)t.pm * 256 * 2048; u.B = (const char*)wpg + (size_t)t.pn * 256 * 2048; return true;
    }
    __device__ __forceinline__ void epi(f32x4 (&acc)[2][2][4][2], const GU& u, int wr, int wc, int fr, int fq) const {
        const int rl0 = wr * 64 + fr, cl0 = wc * 32 + 8 * fq; const float ps = (DBG_ABL & 32) ? 0.f : 1.f;
        const float r0_ = rstd_of(ssq, u.pm * 256 + fq * 16 + rl0), r1_ = rstd_of(ssq, u.pm * 256 + 128 + fq * 16 + rl0);
#pragma unroll
        for (int ai = 0; ai < 2; ++ai)
#pragma unroll
            for (int mh = 0; mh < 2; ++mh) {
                u32x4 xw[2][2], gw[2][2];
#pragma unroll
                for (int m2 = 0; m2 < 2; ++m2)
#pragma unroll
                    for (int bj = 0; bj < 2; ++bj) { const size_t o = (size_t)(u.pm * 256 + ai * 128 + (2 * mh + m2) * 16 + rl0) * 1024 + u.pn * 256 + bj * 128 + cl0;
                        xw[m2][bj] = *(const u32x4*)(xb + o); gw[m2][bj] = *(const u32x4*)(pp + o); }
#pragma unroll
                for (int m2 = 0; m2 < 2; ++m2) { const int m = 2 * mh + m2, row = u.pm * 256 + ai * 128 + m * 16 + rl0; const float sc = EPI_SC(ai, m); float ss = 0.f;
#pragma unroll
                    for (int bj = 0; bj < 2; ++bj) { const size_t o = (size_t)row * 1024 + u.pn * 256 + bj * 128 + cl0; const u32x4 w = gw[m2][bj], xq = xw[m2][bj];
                        const f32x4 p0 = (f32x4){lo_bf(w.x), hi_bf(w.x), lo_bf(w.y), hi_bf(w.y)}, p1 = (f32x4){lo_bf(w.z), hi_bf(w.z), lo_bf(w.w), hi_bf(w.w)};
                        const f32x4 x0 = (f32x4){lo_bf(xq.x), hi_bf(xq.x), lo_bf(xq.y), hi_bf(xq.y)}, x1 = (f32x4){lo_bf(xq.z), hi_bf(xq.z), lo_bf(xq.w), hi_bf(xq.w)};
                        f32x4 g0 = acc[ai][bj][m][0] * sc, g1 = acc[ai][bj][m][1] * sc;
#pragma unroll
                        for (int j = 0; j < 4; ++j) { g0[j] = sigmoidf_(g0[j]); g1[j] = sigmoidf_(g1[j]); }
                        const f32x4 v0 = x0 + p0 * ps * g0, v1 = x1 + p1 * ps * g1;
                        st_bf8(xbout + o, v0, v1); ss += sq8(v0, v1); }
                    ss += __shfl_xor(ss, 16); ss += __shfl_xor(ss, 32);
                    if (fq == 0) ssqout[(size_t)row * 16 + u.pn * 4 + wc] = ss; }
                EPI_FENCE;
            }
    }
};

struct MoeOrder {
    int tl[NE]; int nN, total, G, c;
    __device__ __forceinline__ void init(const unsigned* cnt, int nN_, int G_, int c_) {
        nN = nN_; G = G_; c = c_; int tt = 0;
#pragma unroll
        for (int e = 0; e < NE; ++e) { tl[e] = (int)((__builtin_amdgcn_readfirstlane(cnt[e]) + 255u) >> 8); tt += tl[e]; }
        total = tt * nN;
    }
    __device__ __forceinline__ bool next(int i, int& e, int& pml, int& pn, int& slot0) const {
        const long L = (long)i * G + c; if (L >= total) return false;
        int wgid = (int)L; { const int q = total / NXCD, r = total % NXCD, xcd = wgid % NXCD, off = wgid / NXCD; wgid = (xcd < r ? xcd * (q + 1) : r * (q + 1) + (xcd - r) * q) + off; }
        int ee = 0, ubase = 0, tbase = 0, nMe = tl[0], uacc = 0, tacc = 0;
#pragma unroll
        for (int k = 0; k < NE; ++k) { if (wgid >= uacc) { ee = k; ubase = uacc; tbase = tacc; nMe = tl[k]; } uacc += tl[k] * nN; tacc += tl[k]; }
        const int li = wgid - ubase, nig = WGM * nN, gid = li / nig, fm = gid * WGM, gsz = (nMe - fm) < WGM ? (nMe - fm) : WGM;
        pml = fm + ((li % nig) % gsz); pn = (li % nig) / gsz; e = ee; slot0 = (tbase + pml) * 256; return true;
    }
};
struct ProgMoeGu {
    __device__ __forceinline__ bool keep(const GU&) const { return false; }
    MoeOrder S; const bf16_t* xb; const bf16_t* Wt; const float* ssq; const int* idx; bf16_t* act;
    __device__ __forceinline__ bool unit(int i, GU& u) const {
        int e, pml, pn, slot0; if (!S.next(i, e, pml, pn, slot0)) return false;
        u.pm = slot0; u.pn = pn; u.sub = 0; u.aux = e; u.idx = idx + slot0; u.mapA = 99; u.mapB = 0; u.lda = 2048; u.ldb = 2048; u.nt = 16;
        u.A = (const char*)xb; u.B = (const char*)Wt + ((size_t)e * 7168 + (size_t)pn * 256) * 2048; return true;
    }
    __device__ __forceinline__ void epi(f32x4 (&acc)[2][2][4][2], const GU& u, int wr, int wc, int fr, int fq) const {
        const int rl0 = wr * 64 + fr, cl0 = wc * 32 + 8 * fq;
        const float r0_ = rstd_of(ssq, idx[u.pm + fq * 16 + rl0]), r1_ = rstd_of(ssq, idx[u.pm + 128 + fq * 16 + rl0]);
        EPI_ROWS(ai, m) { const int slot = u.pm + ai * 128 + m * 16 + rl0; const float s = EPI_SC(ai, m);
            f32x4 o[2];
#pragma unroll
            for (int n = 0; n < 2; ++n)
#pragma unroll
                for (int j = 0; j < 4; ++j) { const float g = acc[ai][0][m][n][j] * s, up = acc[ai][1][m][n][j] * s; o[n][j] = q8(siluf_(g) * up); }
            st_bf8(act + (size_t)slot * EXD + u.pn * 128 + cl0, o[0], o[1]); }
    }
};
struct MoeDownPlan { int ntiles, main, tail; };
__device__ __forceinline__ MoeDownPlan moe_down_plan(const unsigned* cnt, int G) {
    MoeDownPlan pl; int nt = 0;
#pragma unroll
    for (int e = 0; e < NE; ++e) nt += (int)((__builtin_amdgcn_readfirstlane(cnt[e]) + 255u) >> 8);
    const int U = 4 * nt; int tail = U % G; if (U < G || tail > TAILMAX) tail = 0;
    pl.ntiles = nt; pl.tail = tail; pl.main = U - tail; return pl;
}
struct ProgMoeDown {
    __device__ __forceinline__ bool keep(const GU&) const { return false; }
    int tl[NE]; MoeDownPlan pl; int G, c; const bf16_t* act; const bf16_t* Wt; bf16_t* ypair; float* partk;
    __device__ __forceinline__ void init(const unsigned* cnt, int G_, int c_) { G = G_; c = c_; pl = moe_down_plan(cnt, G_);
#pragma unroll
        for (int e = 0; e < NE; ++e) tl[e] = (int)((__builtin_amdgcn_readfirstlane(cnt[e]) + 255u) >> 8); }
    __device__ __forceinline__ bool unit(int i, GU& u) const {
        const long L = (long)i * G + c; int w, kp = -1;
        if (L < pl.main) { w = (int)L; const int q = pl.main / NXCD, r = pl.main % NXCD, xcd = w % NXCD, off = w / NXCD; w = (xcd < r ? xcd * (q + 1) : r * (q + 1) + (xcd - r) * q) + off; }
        else { const long s2 = L - pl.main; if (s2 >= (long)pl.tail * KSPL) return false; w = pl.main + (int)(s2 / KSPL); kp = (int)(s2 % KSPL); }
        const int tile = w >> 2, pn = w & 3; int e = 0, tacc = 0;
#pragma unroll
        for (int k = 0; k < NE; ++k) { if (tile >= tacc) e = k; tacc += tl[k]; }
        const int slot0 = tile * 256;
        u.pm = slot0; u.pn = pn; u.aux = e; u.idx = nullptr; u.mapA = 0; u.mapB = 0; u.lda = 7168; u.ldb = 7168;
        u.A = (const char*)act + (size_t)slot0 * 7168; u.B = (const char*)Wt + ((size_t)e * 1024 + (size_t)pn * 256) * 7168;
        if (kp < 0) { u.sub = 0; u.nt = 56; } else { u.sub = 1 + kp; u.nt = 8; u.A += kp * 1024; u.B += kp * 1024; }
        return true;
    }
    __device__ __forceinline__ void epi(f32x4 (&acc)[2][2][4][2], const GU& u, int wr, int wc, int fr, int fq) const {
        const int rl0 = wr * 64 + fr, cl0 = wc * 32 + 8 * fq;
        if (u.sub == 0) {
            EPI_ROWS(ai, m) { const int slot = u.pm + ai * 128 + m * 16 + rl0;
#pragma unroll
                for (int bj = 0; bj < 2; ++bj) st_bf8(ypair + (size_t)slot * 1024 + u.pn * 256 + bj * 128 + cl0, acc[ai][bj][m][0], acc[ai][bj][m][1]); }
        } else {
            float* pk = partk + ((size_t)(u.sub - 1) * (TAILMAX / 4) * 256 + (u.pm - (pl.main >> 2) * 256)) * 1024 + u.pn * 256 + cl0;
            EPI_ROWS(ai, m) { float* o = pk + (size_t)(ai * 128 + m * 16 + rl0) * 1024;
#pragma unroll
                for (int bj = 0; bj < 2; ++bj) { *(f32x4*)(o + bj * 128) = acc[ai][bj][m][0]; *(f32x4*)(o + bj * 128 + 4) = acc[ai][bj][m][1]; } }
        }
    }
};

struct Params { const float* in[30]; float* out; unsigned char* ws; int s_lo, s_hi; unsigned tmask; int pad; };
enum { I_X = 0, I_P, I_MIXN, I_WIN, I_DNCONV, I_DNALOG, I_DNDTB, I_DNNORM, I_SSCONV, I_SSCONVB, I_SSALOG, I_SSDTB, I_SSD, I_SSNORM, I_WBRDN, I_WBRSSM, I_WBRATT, I_WOUT, I_FFNN,
       I_WFG, I_WFU, I_WFD, I_WROUTER, I_WMG, I_WMU, I_WMD, I_PLEN, I_WPLE, I_WPLEG, I_FINALN };

template <class Map>
__device__ __forceinline__ void tr_job(const Map& map, int K, int N, bf16_t* WT, const float* gain, LAS float* scr, int lane, int gw, int NGW, float qs = 0.f) {
    const int nblk = N / 32, nitems = (K / 64) * nblk;
    for (int item = gw; item < nitems; item += NGW) {
        const int kb = item / nblk, nb = item % nblk, k0 = 64 * kb, n0 = 32 * nb;
        int ld = 0; const float* src = map(n0 + (lane & 31), ld);
#pragma unroll
        for (int i = 0; i < 32; ++i) { const int kk = 2 * i + (lane >> 5); float v = 0.f; if (src) { v = src[(size_t)(k0 + kk) * ld]; if (gain) v *= gain[k0 + kk]; if (EMU_FP8 && qs > 0.f) v = q8(v * qs) / qs; } scr[kk * 33 + (lane & 31)] = v; }
        asm volatile("s_waitcnt lgkmcnt(0)" ::: "memory");
        const int c = lane & 7;
#pragma unroll
        for (int j = 0; j < 4; ++j) { const int n = (lane >> 3) + 8 * j; const LAS float* s = scr + (8 * c) * 33 + n;
            u32x4 o; o.x = pk2(s[0 * 33], s[1 * 33]); o.y = pk2(s[2 * 33], s[3 * 33]); o.z = pk2(s[4 * 33], s[5 * 33]); o.w = pk2(s[6 * 33], s[7 * 33]);
            *(u32x4*)(WT + (size_t)(n0 + n) * K + k0 + 8 * c) = o; }
        asm volatile("s_waitcnt lgkmcnt(0)" ::: "memory");
    }
}
struct MapPlain { const float* W; int ld; __device__ __forceinline__ const float* operator()(int n, int& l) const { l = ld; return W + n; } };
struct MapIn { const float* W; __device__ __forceinline__ const float* operator()(int n, int& l) const { l = INW; const int tile = n >> 8, r = n & 255; int col;
        if (tile < 9) col = n; else if (tile < 12) col = C_DNZ + (n - 2304); else if (tile < 17) col = C_XBC + (n - 3072); else if (tile < 20) col = C_SSZ + (n - 4352);
        else if (tile < 29) col = C_ATT + (n - 5120); else if (tile < 41) col = C_GATE + (n - 7424);
        else { if (r < 6) col = C_DNA + r; else if (r < 12) col = C_DNB + (r - 6); else if (r < 24) col = C_SSDT + (r - 12); else return nullptr; }
        return W + col; } };
struct MapGu { const float* Wg; const float* Wu; int ld; __device__ __forceinline__ const float* operator()(int n, int& l) const { l = ld; const int tile = n >> 8, r = n & 255; return r < 128 ? Wg + tile * 128 + r : Wu + tile * 128 + (r - 128); } };

__device__ __forceinline__ void phase_convert(const Params& p, LAS unsigned char* lds) {
    const int tid_ = htid(), lane = tid_ & 63, wave = tid_ >> 6, G = gridDim.x;
    const int gw = blockIdx.x * 8 + wave, NGW = G * 8;
    LAS float* scr = (LAS float*)(lds + wave * 16384);
    unsigned char* ws = p.ws;
    for (int l = 0; l < DEPTH; ++l) {
        tr_job(MapIn{p.in[I_WIN] + (size_t)l * D * INW}, D, INP, (bf16_t*)(ws + WS_WIN) + (size_t)l * INP * D, p.in[I_MIXN] + l * D, scr, lane, gw, NGW);
        tr_job(MapPlain{p.in[I_WBRDN] + (size_t)l * 768 * D, D}, 768, D, (bf16_t*)(ws + WS_WDN) + (size_t)l * D * 768, nullptr, scr, lane, gw, NGW);
        tr_job(MapPlain{p.in[I_WBRSSM] + (size_t)l * 768 * D, D}, 768, D, (bf16_t*)(ws + WS_WSSM) + (size_t)l * D * 768, nullptr, scr, lane, gw, NGW);
        tr_job(MapPlain{p.in[I_WBRATT] + (size_t)l * 256 * D, D}, 256, D, (bf16_t*)(ws + WS_WATT) + (size_t)l * D * 256, nullptr, scr, lane, gw, NGW);
        tr_job(MapPlain{p.in[I_WOUT] + (size_t)l * D * D, D}, D, D, (bf16_t*)(ws + WS_WOUT) + (size_t)l * D * D, nullptr, scr, lane, gw, NGW);
        tr_job(MapPlain{p.in[I_WPLEG] + (size_t)l * D * D, D}, D, D, (bf16_t*)(ws + WS_WPG) + (size_t)l * D * D, p.in[I_PLEN] + l * D, scr, lane, gw, NGW);
        tr_job(MapPlain{p.in[I_WPLE] + (size_t)l * PLE * D, D}, PLE, D, (bf16_t*)(ws + WS_WPLE) + (size_t)l * D * PLE, nullptr, scr, lane, gw, NGW);
    }
    tr_job(MapGu{p.in[I_WFG], p.in[I_WFU], FFN}, D, 2 * FFN, (bf16_t*)(ws + WS_WFGU), p.in[I_FFNN], scr, lane, gw, NGW, 16.f);
    tr_job(MapPlain{p.in[I_WFD], D}, FFN, D, (bf16_t*)(ws + WS_WFD), nullptr, scr, lane, gw, NGW, 16.f);
    for (int e = 0; e < NE; ++e) {
        tr_job(MapGu{p.in[I_WMG] + (size_t)e * D * EXD, p.in[I_WMU] + (size_t)e * D * EXD, EXD}, D, 2 * EXD, (bf16_t*)(ws + WS_WMGU) + (size_t)e * 2 * EXD * D, p.in[I_FFNN] + D, scr, lane, gw, NGW, 16.f);
        tr_job(MapPlain{p.in[I_WMD] + (size_t)e * EXD * D, D}, EXD, D, (bf16_t*)(ws + WS_WMD) + (size_t)e * D * EXD, nullptr, scr, lane, gw, NGW, 16.f);
    }
    float* wr = (float*)(ws + WS_WR);
    for (int i = blockIdx.x * 512 + tid_; i < D * NE; i += G * 512) wr[i] = p.in[I_WROUTER][i] * p.in[I_FFNN][D + (i >> 3)];
}

__device__ __forceinline__ void phase_chunk_in(const Params& p, int chunk) {
    const int tid_ = htid(), lane = tid_ & 63, gw = blockIdx.x * 8 + (tid_ >> 6), NGW = gridDim.x * 8;
    const float* x = p.in[I_X] + (size_t)chunk * TC * D;
    bf16_t* xb = (bf16_t*)(p.ws + WS_XB); float* ssq = (float*)(p.ws + WS_SSQ);
    for (int r0 = gw; r0 < TC; r0 += 2 * NGW) {
        f32x4 v[2][4];
#pragma unroll
        for (int u = 0; u < 2; ++u) { const int r = r0 + u * NGW < TC ? r0 + u * NGW : r0; const f32x4* xr = (const f32x4*)(x + (size_t)r * D) + lane;
#pragma unroll
            for (int j = 0; j < 4; ++j) v[u][j] = xr[64 * j]; }
#pragma unroll
        for (int u = 0; u < 2; ++u) { const int r = r0 + u * NGW; if (r >= TC) break; float s = 0.f; u32x2* o = (u32x2*)(xb + (size_t)r * D) + lane;
#pragma unroll
            for (int j = 0; j < 4; ++j) { const f32x4 t = v[u][j]; s += (t.x * t.x + t.y * t.y) + (t.z * t.z + t.w * t.w); u32x2 w; w.x = pk2(t.x, t.y); w.y = pk2(t.z, t.w); o[64 * j] = w; }
            s = wave_sum(s);
            if (lane < 16) ssq[(size_t)r * 16 + lane] = lane == 0 ? s : 0.f; }
    }
    bf16_t* pb = (bf16_t*)(p.ws + WS_PB);
    for (int r0 = gw; r0 < 2 * TC; r0 += 4 * NGW) {
        f32x4 v[4];
#pragma unroll
        for (int u = 0; u < 4; ++u) { const int r = r0 + u * NGW < 2 * TC ? r0 + u * NGW : r0; const int l = r / TC, rr = r % TC;
            v[u] = *((const f32x4*)(p.in[I_P] + ((size_t)l * BATCH * SEQ + (size_t)chunk * TC + rr) * PLE) + lane); }
#pragma unroll
        for (int u = 0; u < 4; ++u) { const int r = r0 + u * NGW; if (r >= 2 * TC) break; const int l = r / TC, rr = r % TC;
            u32x2 w; w.x = pk2(v[u].x, v[u].y); w.y = pk2(v[u].z, v[u].w); *((u32x2*)(pb + ((size_t)l * TC + rr) * PLE) + lane) = w; }
    }
}
__device__ __forceinline__ void phase_final(const Params& p, int chunk) {
    const int tid_ = htid(), lane = tid_ & 63, gw = blockIdx.x * 8 + (tid_ >> 6), NGW = gridDim.x * 8;
    float* out = p.out + (size_t)chunk * TC * D; const bf16_t* xs = (const bf16_t*)(p.ws + WS_XB2); const float* g = p.in[I_FINALN];
    for (int r0 = gw; r0 < TC; r0 += 2 * NGW) {
        u32x4 q[2][2];
#pragma unroll
        for (int u = 0; u < 2; ++u) { const int r = r0 + u * NGW < TC ? r0 + u * NGW : r0; const u32x4* xr = (const u32x4*)(xs + (size_t)r * D) + lane; q[u][0] = xr[0]; q[u][1] = xr[64]; }
#pragma unroll
        for (int u = 0; u < 2; ++u) { const int r = r0 + u * NGW; if (r >= TC) break; float s = 0.f; f32x4 v[4];
#pragma unroll
            for (int j = 0; j < 2; ++j) { const u32x4 w = q[u][j]; v[2 * j] = (f32x4){lo_bf(w.x), hi_bf(w.x), lo_bf(w.y), hi_bf(w.y)}; v[2 * j + 1] = (f32x4){lo_bf(w.z), hi_bf(w.z), lo_bf(w.w), hi_bf(w.w)};
                s += sq8(v[2 * j], v[2 * j + 1]); }
            const float rs = rsqrtf(wave_sum(s) * (1.f / D) + EPS);
#pragma unroll
            for (int j = 0; j < 2; ++j) { const int c = 8 * (lane + 64 * j); float* o = out + (size_t)r * D + c;
                *(f32x4*)o = v[2 * j] * rs * *(const f32x4*)(g + c); *(f32x4*)(o + 4) = v[2 * j + 1] * rs * *(const f32x4*)(g + c + 4); } }
    }
}
__device__ __forceinline__ void phase_router(const Params& p, LAS unsigned char* lds, int chunk) {
    const int tid_ = htid(), lane = tid_ & 63, gw = blockIdx.x * 8 + (tid_ >> 6), NGW = gridDim.x * 8;
    const bf16_t* x = (const bf16_t*)(p.ws + WS_XB); const float* wr = (const float*)(p.ws + WS_WR);
    int* rt = (int*)(p.ws + WS_ROUTE); unsigned* cnt = (unsigned*)(p.ws + WS_CTL) + CW_CNT + chunk * 64;
    LAS unsigned* lcnt = (LAS unsigned*)lds;
    f32x4 w[16][2];
#pragma unroll
    for (int j = 0; j < 2; ++j)
#pragma unroll
        for (int q = 0; q < 8; ++q) { const int k = 8 * (lane + 64 * j) + q; w[8 * j + q][0] = *(const f32x4*)(wr + k * 8); w[8 * j + q][1] = *(const f32x4*)(wr + k * 8 + 4); }
    const int nouter = (TC + 8 * NGW - 1) / (8 * NGW);
    for (int ob = 0; ob < nouter; ++ob) {
        if (tid_ < 16) lcnt[tid_] = 0u;
        __syncthreads();
        int pe[8]; unsigned pr[8];
#pragma unroll
        for (int jr = 0; jr < 8; ++jr) { const int r = gw + (ob * 8 + jr) * NGW; pe[jr] = 0; pr[jr] = 0u;
            if (r < TC) {
                const u32x4* xr = (const u32x4*)(x + (size_t)r * D) + lane; float s = 0.f; float lg[NE];
#pragma unroll
                for (int e = 0; e < NE; ++e) lg[e] = 0.f;
#pragma unroll
                for (int j = 0; j < 2; ++j) { const u32x4 xw = xr[64 * j]; const float v[8] = {lo_bf(xw.x), hi_bf(xw.x), lo_bf(xw.y), hi_bf(xw.y), lo_bf(xw.z), hi_bf(xw.z), lo_bf(xw.w), hi_bf(xw.w)};
#pragma unroll
                    for (int q = 0; q < 8; ++q) { s += v[q] * v[q]; const f32x4 w0 = w[8 * j + q][0], w1 = w[8 * j + q][1];
                        lg[0] += v[q] * w0.x; lg[1] += v[q] * w0.y; lg[2] += v[q] * w0.z; lg[3] += v[q] * w0.w; lg[4] += v[q] * w1.x; lg[5] += v[q] * w1.y; lg[6] += v[q] * w1.z; lg[7] += v[q] * w1.w; } }
                const float rs = rsqrtf(wave_sum(s) * (1.f / D) + EPS);
#pragma unroll
                for (int e = 0; e < NE; ++e) lg[e] = wave_sum(lg[e]) * rs;
                int i0 = 0; float l0 = lg[0];
#pragma unroll
                for (int e = 1; e < NE; ++e) if (lg[e] > l0) { l0 = lg[e]; i0 = e; }
                int i1 = -1; float l1 = -3.0e38f;
#pragma unroll
                for (int e = 0; e < NE; ++e) if (e != i0 && lg[e] > l1) { l1 = lg[e]; i1 = e; }
                if (lane < 2) { const int e = lane == 0 ? i0 : i1; const float w0 = 1.f / (1.f + expf(l1 - l0));
                    pe[jr] = e; pr[jr] = __hip_atomic_fetch_add(lcnt + e, 1u, __ATOMIC_RELAXED, __HIP_MEMORY_SCOPE_WORKGROUP);
                    rt[RT_TOPE + 2 * r + lane] = e; ((float*)rt)[RT_TOPW + 2 * r + lane] = lane == 0 ? w0 : 1.f - w0; }
            } }
        __syncthreads();
        if (tid_ < 8) lcnt[8 + tid_] = atomicAdd(cnt + tid_, lcnt[tid_]);
        __syncthreads();
#pragma unroll
        for (int jr = 0; jr < 8; ++jr) { const int r = gw + (ob * 8 + jr) * NGW; if (r < TC && lane < 2) rt[RT_TOPP + 2 * r + lane] = (int)(lcnt[8 + pe[jr]] + pr[jr]); }
        __syncthreads();
    }
}
__device__ __forceinline__ void phase_slots(const Params& p, int chunk) {
    int* rt = (int*)(p.ws + WS_ROUTE); const unsigned* cnt = (const unsigned*)(p.ws + WS_CTL) + CW_CNT + chunk * 64;
    int c[NE], off[NE + 1]; off[0] = 0;
#pragma unroll
    for (int e = 0; e < NE; ++e) { c[e] = (int)cnt[e]; off[e + 1] = off[e] + ((c[e] + 255) & ~255); }
    const int gt = blockIdx.x * 512 + htid(), NT = gridDim.x * 512;
    for (int i = gt; i < 2 * TC; i += NT) {
        const int e = rt[RT_TOPE + i], pos = rt[RT_TOPP + i]; int o = 0;
#pragma unroll
        for (int k = 0; k < NE; ++k) o = (e == k) ? off[k] : o;
        const int slot = o + pos; rt[RT_TOPS + i] = slot; rt[RT_IDX + slot] = i >> 1;
    }
    for (int s = gt; s < off[NE]; s += NT) {
        bool pad = false;
#pragma unroll
        for (int k = 0; k < NE; ++k) pad = pad || (s >= off[k] + c[k] && s < off[k + 1]);
        if (pad) rt[RT_IDX + s] = 0;
    }
}
__device__ __forceinline__ f32x4 moe_y4(const bf16_t* yp, const float* partk, int slot, int tail0, int col) {
    if (slot < tail0) { const u32x2 a = *(const u32x2*)(yp + (size_t)slot * D + col); return (f32x4){lo_bf(a.x), hi_bf(a.x), lo_bf(a.y), hi_bf(a.y)}; }
    f32x4 v = (f32x4){0.f, 0.f, 0.f, 0.f};
#pragma unroll
    for (int k = 0; k < KSPL; ++k) v += *(const f32x4*)(partk + ((size_t)k * (TAILMAX / 4) * 256 + (slot - tail0)) * 1024 + col);
    return v;
}
__device__ __forceinline__ void phase_combine(const Params& p, int chunk) {
    const int tid_ = htid(), lane = tid_ & 63, gw = blockIdx.x * 8 + (tid_ >> 6), NGW = gridDim.x * 8;
    const int* rt = (const int*)(p.ws + WS_ROUTE);
    const bf16_t* yp = (const bf16_t*)(p.ws + WS_YPAIR); const float* partk = (const float*)(p.ws + WS_PARTK); bf16_t* xb = (bf16_t*)(p.ws + WS_XB); float* ssq = (float*)(p.ws + WS_SSQ);
    const MoeDownPlan pl = moe_down_plan((const unsigned*)(p.ws + WS_CTL) + CW_CNT + chunk * 64, gridDim.x);
    const int tail0 = pl.tail > 0 ? (pl.main >> 2) * 256 : 0x7fffffff;
    for (int r0 = gw; r0 < TC; r0 += 4 * NGW) {
        int sl[4][2]; float wt[4][2];
#pragma unroll
        for (int u = 0; u < 4; ++u) { const int r = r0 + u * NGW < TC ? r0 + u * NGW : r0; sl[u][0] = rt[RT_TOPS + 2 * r]; sl[u][1] = rt[RT_TOPS + 2 * r + 1];
            wt[u][0] = (DBG_ABL & 16) ? 0.f : ((const float*)rt)[RT_TOPW + 2 * r]; wt[u][1] = (DBG_ABL & 16) ? 0.f : ((const float*)rt)[RT_TOPW + 2 * r + 1]; }
#pragma unroll
        for (int u = 0; u < 4; ++u) { const int r = r0 + u * NGW; if (r >= TC) break;
            u32x2* xr = (u32x2*)(xb + (size_t)r * D) + lane; float s = 0.f;
            f32x4 v[4], y0[4], y1[4]; u32x2 xq[4];
            if (sl[u][0] < tail0 && sl[u][1] < tail0) {
                const u32x2* a0 = (const u32x2*)(yp + (size_t)sl[u][0] * D) + lane; const u32x2* a1 = (const u32x2*)(yp + (size_t)sl[u][1] * D) + lane; u32x2 q0[4], q1[4];
#pragma unroll
                for (int j = 0; j < 4; ++j) { xq[j] = xr[64 * j]; q0[j] = a0[64 * j]; q1[j] = a1[64 * j]; }
#pragma unroll
                for (int j = 0; j < 4; ++j) { y0[j] = (f32x4){lo_bf(q0[j].x), hi_bf(q0[j].x), lo_bf(q0[j].y), hi_bf(q0[j].y)}; y1[j] = (f32x4){lo_bf(q1[j].x), hi_bf(q1[j].x), lo_bf(q1[j].y), hi_bf(q1[j].y)}; }
            } else {
#pragma unroll
                for (int j = 0; j < 4; ++j) { const int col = 4 * (lane + 64 * j); xq[j] = xr[64 * j]; y0[j] = moe_y4(yp, partk, sl[u][0], tail0, col); y1[j] = moe_y4(yp, partk, sl[u][1], tail0, col); }
            }
#pragma unroll
            for (int j = 0; j < 4; ++j) { v[j] = (f32x4){lo_bf(xq[j].x), hi_bf(xq[j].x), lo_bf(xq[j].y), hi_bf(xq[j].y)}; const f32x4 t = v[j] + wt[u][0] * y0[j] + wt[u][1] * y1[j];
                s += (t.x * t.x + t.y * t.y) + (t.z * t.z + t.w * t.w); u32x2 w; w.x = pk2(t.x, t.y); w.y = pk2(t.z, t.w); xr[64 * j] = w; }
            s = wave_sum(s);
            if (lane < 16) ssq[(size_t)r * 16 + lane] = lane == 0 ? s : 0.f; }
    }
}

#define LDS_BARRIER() do { asm volatile("s_waitcnt lgkmcnt(0)" ::: "memory"); __builtin_amdgcn_s_barrier(); asm volatile("" ::: "memory"); } while (0)
__device__ __forceinline__ f32x4 mfma16(const bf16x8 a, const bf16x8 b, const f32x4 c) { return __builtin_amdgcn_mfma_f32_16x16x32_bf16(a, b, c, 0, 0, 0); }
__device__ __forceinline__ void dn_fetch(const Params& p, int b, int n, int h, u32x4 (&xr)[10]) {
    const int tid = htid();
    if (tid < 480) {
        const int cg = tid % 48, seg = tid / 48, part = cg >> 4, c8 = (cg & 15) * 8, col = part * 768 + h * 128 + c8, ts = seg * 7, t0 = n * 64;
        const bf16_t* proj = (const bf16_t*)(p.ws + WS_PDN) + (size_t)b * SEQ * 3072;
#pragma unroll
        for (int i = 0; i < 10; ++i) { const int t = t0 + ts - 3 + i; xr[i] = (u32x4){0u, 0u, 0u, 0u};
            if (t >= 0 && ts - 3 + i < 64) xr[i] = *(const u32x4*)(proj + (size_t)t * 3072 + col); }
    }
}
__device__ __forceinline__ void dn_prep(const Params& p, LAS unsigned char* lds, int layer, int b, int n, int h, u32x4 (&xr)[10], bool has_next, int nb_, int nn_, int nh_) {
    const int tid = htid(), lane = tid & 63, wave = tid >> 6;
    LAS float* AM = (LAS float*)lds;
    LAS float* SC = (LAS float*)(lds + 17408);
    LAS unsigned char* TW = lds + 19968; LAS unsigned char* TU = lds + 29184;
    LAS unsigned char* QS = lds + 38400; LAS unsigned char* KS = lds + 55808;
    LAS unsigned char* VT = lds + 73216; LAS unsigned char* KT = lds + 91648;
    const int t0 = n * 64;
    const bf16_t* proj = (const bf16_t*)(p.ws + WS_PDN) + (size_t)b * SEQ * 3072;
    unsigned char* item = p.ws + WS_DNS + (size_t)((b * 32 + n) * 6 + h) * DNS_ITEM;
    if (tid < 480) {
        const int cg = tid % 48, seg = tid / 48, part = cg >> 4, c8 = (cg & 15) * 8, col = part * 768 + h * 128 + c8;
        const float* cw = p.in[I_DNCONV] + (size_t)layer * 4 * 2304 + col;
        f32x4 w[4][2];
#pragma unroll
        for (int j = 0; j < 4; ++j) { w[j][0] = *(const f32x4*)(cw + j * 2304); w[j][1] = *(const f32x4*)(cw + j * 2304 + 4); }
        const int ts = seg * 7;
        f32x4 x[10][2];
#pragma unroll
        for (int i = 0; i < 10; ++i) { const u32x4 w_ = xr[i]; x[i][0] = (f32x4){lo_bf(w_.x), hi_bf(w_.x), lo_bf(w_.y), hi_bf(w_.y)}; x[i][1] = (f32x4){lo_bf(w_.z), hi_bf(w_.z), lo_bf(w_.w), hi_bf(w_.w)}; }
        LAS unsigned char* dst = part == 0 ? QS : KS; LAS unsigned char* dstT = (part == 1 ? KT : VT) + c8 * 144; const int sw = (c8 >> 3) & 7;
#pragma unroll
        for (int i = 0; i < 7; ++i) { const int tk = ts + i;
            if (tk < 64) { f32x4 a0 = w[3][0] * x[i + 3][0] + w[2][0] * x[i + 2][0] + w[1][0] * x[i + 1][0] + w[0][0] * x[i][0];
                f32x4 a1 = w[3][1] * x[i + 3][1] + w[2][1] * x[i + 2][1] + w[1][1] * x[i + 1][1] + w[0][1] * x[i][1];
#pragma unroll
                for (int c = 0; c < 4; ++c) { a0[c] = siluf_(a0[c]); a1[c] = siluf_(a1[c]); }
                u32x4 pw; pw.x = pk2(a0[0], a0[1]); pw.y = pk2(a0[2], a0[3]); pw.z = pk2(a1[0], a1[1]); pw.w = pk2(a1[2], a1[3]);
                if (part < 2) *(LAS u32x4*)(dst + tk * 272 + c8 * 2) = pw;
                if (part > 0) { LAS unsigned char* T = dstT + ((((tk >> 3) ^ sw) << 4) | ((tk & 7) << 1));
                    *(LAS bf16_t*)(T + 0 * 144) = (bf16_t)(pw.x & 0xffffu); *(LAS bf16_t*)(T + 1 * 144) = (bf16_t)(pw.x >> 16); *(LAS bf16_t*)(T + 2 * 144) = (bf16_t)(pw.y & 0xffffu); *(LAS bf16_t*)(T + 3 * 144) = (bf16_t)(pw.y >> 16);
                    *(LAS bf16_t*)(T + 4 * 144) = (bf16_t)(pw.z & 0xffffu); *(LAS bf16_t*)(T + 5 * 144) = (bf16_t)(pw.z >> 16); *(LAS bf16_t*)(T + 6 * 144) = (bf16_t)(pw.w & 0xffffu); *(LAS bf16_t*)(T + 7 * 144) = (bf16_t)(pw.w >> 16); }
 } }
    } else {
        const float Aexp = expf(p.in[I_DNALOG][layer * 6 + h]), dtb = p.in[I_DNDTB][layer * 6 + h];
        const float* small = (const float*)(p.ws + WS_SMALL) + (size_t)b * SEQ * 32;
#pragma unroll
        for (int q = 0; q < 2; ++q) { const int tk = (tid - 480) * 2 + q; const float a = small[(size_t)(t0 + tk) * 32 + h], bb = small[(size_t)(t0 + tk) * 32 + 6 + h];
            SC[128 + tk] = sigmoidf_(bb); SC[192 + tk] = -Aexp * softplusf_(a + dtb); }
    }
    LDS_BARRIER();
    if (has_next) dn_fetch(p, nb_, nn_, nh_, xr);
    TSUB(8);
    {
        const int row = tid >> 3, sg = tid & 7; const u32x4 q0 = *(const LAS u32x4*)(QS + row * 272 + sg * 32), q1 = *(const LAS u32x4*)(QS + row * 272 + sg * 32 + 16), k0 = *(const LAS u32x4*)(KS + row * 272 + sg * 32), k1 = *(const LAS u32x4*)(KS + row * 272 + sg * 32 + 16);
        float sq = sq8((f32x4){lo_bf(q0.x), hi_bf(q0.x), lo_bf(q0.y), hi_bf(q0.y)}, (f32x4){lo_bf(q0.z), hi_bf(q0.z), lo_bf(q0.w), hi_bf(q0.w)}) + sq8((f32x4){lo_bf(q1.x), hi_bf(q1.x), lo_bf(q1.y), hi_bf(q1.y)}, (f32x4){lo_bf(q1.z), hi_bf(q1.z), lo_bf(q1.w), hi_bf(q1.w)});
        float sk = sq8((f32x4){lo_bf(k0.x), hi_bf(k0.x), lo_bf(k0.y), hi_bf(k0.y)}, (f32x4){lo_bf(k0.z), hi_bf(k0.z), lo_bf(k0.w), hi_bf(k0.w)}) + sq8((f32x4){lo_bf(k1.x), hi_bf(k1.x), lo_bf(k1.y), hi_bf(k1.y)}, (f32x4){lo_bf(k1.z), hi_bf(k1.z), lo_bf(k1.w), hi_bf(k1.w)});
        sq += __shfl_xor(sq, 1); sq += __shfl_xor(sq, 2); sq += __shfl_xor(sq, 4); sk += __shfl_xor(sk, 1); sk += __shfl_xor(sk, 2); sk += __shfl_xor(sk, 4);
        if (sg == 0) { SC[row] = sq; SC[64 + row] = sk; } }
    LDS_BARRIER();
    TSUB(9);
    if (wave == 0) {
        float g = SC[192 + lane];
#pragma unroll
        for (int o = 1; o < 64; o <<= 1) { const float t = __shfl_up(g, o); if (lane >= o) g += t; }
        const float eg = expf(g), rk = rsqrtf(SC[64 + lane] + EPS), glast = __shfl(g, 63);
        SC[192 + lane] = g; SC[256 + lane] = eg; SC[320 + lane] = rsqrtf(SC[lane] + EPS); SC[384 + lane] = rk;
        SC[448 + lane] = rk * SC[128 + lane] * eg; SC[576 + lane] = rk * fexp(glast - g);
    }
    LDS_BARRIER();
    TSUB(10);
    {
        const int r = lane & 15, kg = lane >> 4;
        bf16x8 fa[4][4], fb[4][4];
#pragma unroll
        for (int q = 0; q < 4; ++q) { const int t = wave * 4 + q, which = t >> 4, mt = (t >> 2) & 3, nt = t & 3;
            const LAS unsigned char* A = (which == 0 ? KS : QS) + (16 * mt + r) * 272 + kg * 16; const LAS unsigned char* Bt = KS + (16 * nt + r) * 272 + kg * 16;
#pragma unroll
            for (int ks = 0; ks < 4; ++ks) { fa[q][ks] = *(const LAS bf16x8*)(A + ks * 64); fb[q][ks] = *(const LAS bf16x8*)(Bt + ks * 64); } }
#pragma unroll
        for (int q = 0; q < 4; ++q) { const int t = wave * 4 + q, which = t >> 4, mt = (t >> 2) & 3, nt = t & 3;
            f32x4 acc = (f32x4){0.f, 0.f, 0.f, 0.f};
#pragma unroll
            for (int ks = 0; ks < 4; ++ks) acc = mfma16(fa[q][ks], fb[q][ks], acc);
            const int j = 16 * nt + r; const float gj = SC[192 + j], rkj = SC[384 + j];
            float ov[4], av[4];
#pragma unroll
            for (int rr = 0; rr < 4; ++rr) { const int i = 16 * mt + 4 * kg + rr; const float e = fexp(fminf(SC[192 + i] - gj, 0.f));
                av[rr] = (i > j) ? SC[128 + i] * SC[384 + i] * rkj * acc[rr] * e : 0.f;
                ov[rr] = (i >= j) ? SC[320 + i] * rkj * 0.08838834764831845f * acc[rr] * e : 0.f; }
            if (which == 0) *(LAS f32x4*)(AM + (63 - j) * 68 + 60 - 16 * mt - 4 * kg) = (f32x4){av[3], av[2], av[1], av[0]};
            else { bf16_t* ao = (bf16_t*)(item + 32768) + (16 * mt + 4 * kg) * 64 + j; ST2_BF(ao, ao + 64, ov[0], ov[1]); ST2_BF(ao + 128, ao + 192, ov[2], ov[3]); }
        }
    }
    LDS_BARRIER();
    TSUB(11);
    if (wave == 0) {
        f32x2 x2[32];
        float lf = (float)lane; asm volatile("" : "+v"(lf));
#pragma unroll
        for (int m = 0; m < 32; ++m) x2[m] = (f32x2){fmaxf(1.f - fabsf(lf - (float)(2 * m)), 0.f), fmaxf(1.f - fabsf(lf - (float)(2 * m + 1)), 0.f)};
        const LAS float* AMv = AM; asm volatile("" : "+v"(AMv));
        f32x4 rw[2][8]; f32x2 accA, accB; float sres;
#define ROW_BEGIN(i) do { accA = (f32x2){0.f, 0.f}; accB = accA; sres = x2[(i) >> 1][(i) & 1]; } while (0)
#define ROW_CHUNK(i, k4, am) do { \
            if (4 * (k4) + 1 < (i)) accA -= __builtin_shufflevector(am, am, 0, 1) * x2[2 * (k4)]; else if (4 * (k4) < (i)) sres -= am[0] * x2[2 * (k4)][0]; \
            if (4 * (k4) + 3 < (i)) accB -= __builtin_shufflevector(am, am, 2, 3) * x2[2 * (k4) + 1]; else if (4 * (k4) + 2 < (i)) sres -= am[2] * x2[2 * (k4) + 1][0]; } while (0)
#define ROW_END(i) x2[(i) >> 1][(i) & 1] = sres + ((accA[0] + accA[1]) + (accB[0] + accB[1]))
        rw[1][0] = *(const LAS f32x4*)(AMv + 1 * 68);
#pragma unroll
        for (int i = 1; i <= 32; ++i) {
#pragma unroll
            for (int k4 = 0; k4 < (i + 4) / 4 && k4 < 8; ++k4) rw[(i + 1) & 1][k4] = *(const LAS f32x4*)(AMv + (i + 1) * 68 + 4 * k4);
            ROW_BEGIN(i);
#pragma unroll
            for (int k4 = 0; k4 < (i + 3) / 4; ++k4) { const f32x4 am = rw[i & 1][k4]; ROW_CHUNK(i, k4, am); }
            ROW_END(i);
            { const float xi_ = x2[i >> 1][i & 1]; asm("" : "+v"(AMv) : "v"(xi_)); }
        }
#pragma unroll
        for (int i = 33; i < 64; ++i) {
#pragma unroll
            for (int k4 = 8; k4 < (i + 3) / 4; ++k4) rw[0][k4 - 8] = *(const LAS f32x4*)(AMv + i * 68 + 4 * k4);
            ROW_BEGIN(i);
#pragma unroll
            for (int k4 = 0; k4 < 8; ++k4) { const f32x4 am = rw[1][k4]; ROW_CHUNK(i, k4, am); }
            if (i + 1 < 64) {
#pragma unroll
                for (int k4 = 0; k4 < 8; ++k4) rw[1][k4] = *(const LAS f32x4*)(AMv + (i + 1) * 68 + 4 * k4);
            }
#pragma unroll
            for (int k4 = 8; k4 < (i + 3) / 4; ++k4) { const f32x4 am = rw[0][k4 - 8]; ROW_CHUNK(i, k4, am); }
            ROW_END(i);
            { const float xi_ = x2[i >> 1][i & 1]; asm("" : "+v"(AMv) : "v"(xi_)); }
        }
#undef ROW_BEGIN
#undef ROW_CHUNK
#undef ROW_END
#define XE(a) x2[(a) >> 1][(a) & 1]
        const int irow = 63 - lane;
#pragma unroll
        for (int g = 0; g < 8; ++g) {
            const f32x4 sw0 = *(const LAS f32x4*)(SC + 448 + 8 * g), sw1 = *(const LAS f32x4*)(SC + 448 + 8 * g + 4), su0 = *(const LAS f32x4*)(SC + 128 + 8 * g), su1 = *(const LAS f32x4*)(SC + 128 + 8 * g + 4);
            u32x4 w, u;
            w.x = pk2(XE(63 - 8 * g) * sw0[0], XE(62 - 8 * g) * sw0[1]); w.y = pk2(XE(61 - 8 * g) * sw0[2], XE(60 - 8 * g) * sw0[3]); w.z = pk2(XE(59 - 8 * g) * sw1[0], XE(58 - 8 * g) * sw1[1]); w.w = pk2(XE(57 - 8 * g) * sw1[2], XE(56 - 8 * g) * sw1[3]);
            u.x = pk2(XE(63 - 8 * g) * su0[0], XE(62 - 8 * g) * su0[1]); u.y = pk2(XE(61 - 8 * g) * su0[2], XE(60 - 8 * g) * su0[3]); u.z = pk2(XE(59 - 8 * g) * su1[0], XE(58 - 8 * g) * su1[1]); u.w = pk2(XE(57 - 8 * g) * su1[2], XE(56 - 8 * g) * su1[3]);
            *(LAS u32x4*)(TW + irow * 144 + g * 16) = w; *(LAS u32x4*)(TU + irow * 144 + g * 16) = u; }
#undef XE
    } else {
        const int u = tid - 64;
#pragma unroll
        for (int i = 0; i < 3; ++i) { const int q = u + 448 * i; if (q < 1024) { const int c = q >> 4, d8 = (q & 15) * 8; f32x4 a0, a1;
            const u32x4 w = *(const LAS u32x4*)(QS + c * 272 + d8 * 2); const float sc = SC[320 + c] * 0.08838834764831845f * SC[256 + c];
            a0 = (f32x4){lo_bf(w.x), hi_bf(w.x), lo_bf(w.y), hi_bf(w.y)} * sc; a1 = (f32x4){lo_bf(w.z), hi_bf(w.z), lo_bf(w.w), hi_bf(w.w)} * sc;
            st_bf8((bf16_t*)(item + 16384) + c * 128 + d8, a0, a1); } }
#pragma unroll
        for (int i = 0; i < 3; ++i) { const int q = u + 448 * i; if (q < 1024) { const int d = q >> 3, g8 = q & 7;
            const u32x4 w = *(const LAS u32x4*)(KT + d * 144 + ((g8 ^ ((d >> 3) & 7)) << 4)); const f32x4 f0 = *(const LAS f32x4*)(SC + 576 + 8 * g8), f1 = *(const LAS f32x4*)(SC + 576 + 8 * g8 + 4);
            st_bf8((bf16_t*)(item + 40960) + d * 64 + 8 * g8, (f32x4){lo_bf(w.x), hi_bf(w.x), lo_bf(w.y), hi_bf(w.y)} * f0, (f32x4){lo_bf(w.z), hi_bf(w.z), lo_bf(w.w), hi_bf(w.w)} * f1); } }
        if (u == 0) ((float*)(p.ws + WS_DNEGL))[(b * 32 + n) * 6 + h] = SC[256 + 63];
        const float* ng = p.in[I_DNNORM] + layer * 128; bf16_t* ydn = (bf16_t*)(p.ws + WS_YDN) + ((size_t)b * SEQ + t0) * 768 + h * 128;
#pragma unroll
        for (int i = 0; i < 3; ++i) { const int q = u + 448 * i; if (q < 1024) { const int c = q >> 4, e8 = (q & 15) * 8; f32x4 z0, z1; ld_bf8(proj + (size_t)(t0 + c) * 3072 + 2304 + h * 128 + e8, z0, z1);
            const f32x4 g0 = *(const f32x4*)(ng + e8), g1 = *(const f32x4*)(ng + e8 + 4);
#pragma unroll
            for (int j = 0; j < 4; ++j) { z0[j] = g0[j] * siluf_(z0[j]); z1[j] = g1[j] * siluf_(z1[j]); }
            st_bf8(ydn + (size_t)c * 768 + e8, z0, z1); } }
    }
    LDS_BARRIER();
    TSUB(12);
    {
        const int r = lane & 15, kg = lane >> 4, ch = 16 * wave + r, sw = (ch >> 3) & 7;
        bf16x8 kf[2], vf[2], tw[4][2], tu[4][2];
#pragma unroll
        for (int ks = 0; ks < 2; ++ks) { kf[ks] = *(const LAS bf16x8*)(KT + ch * 144 + (((4 * ks + kg) ^ sw) << 4)); vf[ks] = *(const LAS bf16x8*)(VT + ch * 144 + (((4 * ks + kg) ^ sw) << 4)); }
#pragma unroll
        for (int it = 0; it < 4; ++it)
#pragma unroll
            for (int ks = 0; ks < 2; ++ks) { tw[it][ks] = *(const LAS bf16x8*)(TW + (16 * it + r) * 144 + (4 * ks + kg) * 16); tu[it][ks] = *(const LAS bf16x8*)(TU + (16 * it + r) * 144 + (4 * ks + kg) * 16); }
#pragma unroll
        for (int it = 0; it < 4; ++it) { f32x4 aw = (f32x4){0.f, 0.f, 0.f, 0.f}, au = aw;
#pragma unroll
            for (int ks = 0; ks < 2; ++ks) { aw = mfma16(kf[ks], tw[it][ks], aw); au = mfma16(tu[it][ks], vf[ks], au); }
            u32x2 o; o.x = pk2(aw[0], aw[1]); o.y = pk2(aw[2], aw[3]); *(u32x2*)((bf16_t*)item + (16 * it + r) * 128 + 16 * wave + 4 * kg) = o;
            o.x = pk2(au[0], au[1]); o.y = pk2(au[2], au[3]); *(u32x2*)(item + 57344 + (size_t)(16 * wave + r) * 128 + (16 * it + 4 * kg) * 2) = o; }
    }
    LDS_BARRIER();
    TSUB(13);
}
__device__ __forceinline__ float row16_sum(float v) {
    v += __builtin_bit_cast(float, __builtin_amdgcn_update_dpp(0, __builtin_bit_cast(int, v), 0xB1, 0xf, 0xf, false));
    v += __builtin_bit_cast(float, __builtin_amdgcn_update_dpp(0, __builtin_bit_cast(int, v), 0x4E, 0xf, 0xf, false));
    v += __builtin_bit_cast(float, __builtin_amdgcn_update_dpp(0, __builtin_bit_cast(int, v), 0x141, 0xf, 0xf, false));
    v += __builtin_bit_cast(float, __builtin_amdgcn_update_dpp(0, __builtin_bit_cast(int, v), 0x140, 0xf, 0xf, false));
    return v;
}
__device__ __forceinline__ void dn_scan(const Params& p, LAS unsigned char* lds, int layer, int b, int h) {
    const int tid = htid(), lane = tid & 63, wave = __builtin_amdgcn_readfirstlane(tid >> 6), r = lane & 15, kg = lane >> 4;
    LAS unsigned char* W = lds; LAS unsigned char* QD = lds + 17408; LAS unsigned char* ATT = lds + 34816; LAS unsigned char* KDT = lds + 44032; LAS unsigned char* UT = lds + 62464;
    LAS unsigned char* ST = lds + 80896; LAS unsigned char* VNT = lds + 115712; LAS float* PS = (LAS float*)(lds + 134144); LAS float* RS = (LAS float*)(lds + 136192) + wave * 64;
    const unsigned char* items = p.ws + WS_DNS + (size_t)(b * 32 * 6 + h) * DNS_ITEM;
    bf16_t* ydn = (bf16_t*)(p.ws + WS_YDN) + (size_t)b * SEQ * 768 + h * 128 + 16 * wave + r;
    float egl_all = lane < 32 ? ((const float*)(p.ws + WS_DNEGL))[b * 32 * 6 + h + 6 * lane] : 0.f;
    asm volatile("" : "+v"(egl_all));
    f32x4 S[8], o[4];
#pragma unroll
    for (int dt = 0; dt < 8; ++dt) S[dt] = (f32x4){0.f, 0.f, 0.f, 0.f};
#pragma unroll
    for (int mt = 0; mt < 4; ++mt) o[mt] = (f32x4){0.f, 0.f, 0.f, 0.f};
    for (int i = lane; i < 16 * 272 / 16; i += 64) *(LAS u32x4*)(ST + wave * 16 * 272 + i * 16) = (u32x4){0u, 0u, 0u, 0u};
    u32x4 R[9];
#pragma unroll
    for (int i = 0; i < 9; ++i) R[i] = *(const u32x4*)(items + (size_t)(tid + 512 * i) * 16);
    unsigned short zc[16];
#pragma unroll
    for (int i = 0; i < 16; ++i) zc[i] = 0u;
    LDS_BARRIER();
    for (int n = 0; n <= 32; ++n) {
        if (n < 32) {
#pragma unroll
            for (int i = 0; i < 9; ++i) { const int q = tid + 512 * i; LAS unsigned char* dst;
                if (i < 2) dst = W + (q >> 4) * 272 + (q & 15) * 16; else if (i < 4) dst = QD + ((q - 1024) >> 4) * 272 + (q & 15) * 16;
                else if (i < 5) dst = ATT + ((q - 2048) >> 3) * 144 + (q & 7) * 16; else if (i < 7) dst = KDT + ((q - 2560) >> 3) * 144 + (q & 7) * 16;
                else dst = UT + ((q - 3584) >> 3) * 144 + (q & 7) * 16;
                *(LAS u32x4*)dst = R[i]; }
        }
        if (n > 0) {
            float tot = 0.f;
#pragma unroll
            for (int w = 0; w < 8; ++w) tot += PS[w * 64 + lane];
            RS[lane] = rsqrtf(tot * (1.f / 128.f) + EPS);
#pragma unroll
            for (int mt = 0; mt < 4; ++mt) { const f32x4 rs = *(const LAS f32x4*)(RS + 16 * mt + 4 * kg);
#pragma unroll
                for (int rr = 0; rr < 4; rr += 2) { bf16_t* yo_ = ydn + (size_t)((n - 1) * 64 + 16 * mt + 4 * kg + rr) * 768;
                    ST2_BF(yo_, yo_ + 768, o[mt][rr] * rs[rr] * __uint_as_float(((unsigned)zc[4 * mt + rr]) << 16), o[mt][rr + 1] * rs[rr + 1] * __uint_as_float(((unsigned)zc[4 * mt + rr + 1]) << 16)); } }
        }
        if (n == 32) break;
        if (n + 1 < 32) {
#pragma unroll
            for (int i = 0; i < 9; ++i) R[i] = *(const u32x4*)(items + (size_t)(n + 1) * 6 * DNS_ITEM + (size_t)(tid + 512 * i) * 16);
        }
#pragma unroll
        for (int mt = 0; mt < 4; ++mt)
#pragma unroll
            for (int rr = 0; rr < 4; ++rr) zc[4 * mt + rr] = ydn[(size_t)(n * 64 + 16 * mt + 4 * kg + rr) * 768];
        const float egl = __builtin_bit_cast(float, __builtin_amdgcn_readlane(__builtin_bit_cast(int, egl_all), n));
        LDS_BARRIER();
        bf16x8 sf[4];
#pragma unroll
        for (int ks = 0; ks < 4; ++ks) sf[ks] = *(const LAS bf16x8*)(ST + (16 * wave + r) * 272 + ks * 64 + kg * 16);
        {   bf16x8 af[4][4]; u32x2 uw[4];
#pragma unroll
            for (int mt = 0; mt < 4; ++mt) {
#pragma unroll
                for (int ks = 0; ks < 4; ++ks) af[mt][ks] = *(const LAS bf16x8*)(W + (16 * mt + r) * 272 + ks * 64 + kg * 16);
                uw[mt] = *(const LAS u32x2*)(UT + (16 * wave + r) * 144 + (16 * mt + 4 * kg) * 2); }
#pragma unroll
            for (int mt = 0; mt < 4; ++mt) { f32x4 ws = (f32x4){0.f, 0.f, 0.f, 0.f};
#pragma unroll
                for (int ks = 0; ks < 4; ++ks) ws = mfma16(af[mt][ks], sf[ks], ws);
                const f32x4 vn = (f32x4){lo_bf(uw[mt].x), hi_bf(uw[mt].x), lo_bf(uw[mt].y), hi_bf(uw[mt].y)} - ws;
                u32x2 vw; vw.x = pk2(vn[0], vn[1]); vw.y = pk2(vn[2], vn[3]);
                *(LAS u32x2*)(VNT + (16 * wave + r) * 144 + (16 * mt + 4 * kg) * 2) = vw; } }
        bf16x8 vf[2];
        {
            bf16x8 qf[4][4], tf[4][2];
#pragma unroll
            for (int mt = 0; mt < 4; ++mt) {
#pragma unroll
                for (int ks = 0; ks < 4; ++ks) qf[mt][ks] = *(const LAS bf16x8*)(QD + (16 * mt + r) * 272 + ks * 64 + kg * 16);
#pragma unroll
                for (int kc = 0; kc < 2; ++kc) tf[mt][kc] = *(const LAS bf16x8*)(ATT + (16 * mt + r) * 144 + kc * 64 + kg * 16); }
#pragma unroll
            for (int kc = 0; kc < 2; ++kc) vf[kc] = *(const LAS bf16x8*)(VNT + (16 * wave + r) * 144 + kc * 64 + kg * 16);
#pragma unroll
            for (int mt = 0; mt < 4; ++mt) { f32x4 a = (f32x4){0.f, 0.f, 0.f, 0.f};
#pragma unroll
                for (int ks = 0; ks < 4; ++ks) a = mfma16(qf[mt][ks], sf[ks], a);
#pragma unroll
                for (int kc = 0; kc < 2; ++kc) a = mfma16(tf[mt][kc], vf[kc], a);
                o[mt] = a; } }
        {
            bf16x8 kf[8][2];
#pragma unroll
            for (int dt = 0; dt < 8; ++dt)
#pragma unroll
                for (int kc = 0; kc < 2; ++kc) kf[dt][kc] = *(const LAS bf16x8*)(KDT + (16 * dt + r) * 144 + kc * 64 + kg * 16);
#pragma unroll
            for (int dt = 0; dt < 8; ++dt) { f32x4 a = S[dt] * egl;
#pragma unroll
                for (int kc = 0; kc < 2; ++kc) a = mfma16(kf[dt][kc], vf[kc], a);
                S[dt] = a; u32x2 sw; sw.x = pk2(a[0], a[1]); sw.y = pk2(a[2], a[3]);
                *(LAS u32x2*)(ST + (16 * wave + r) * 272 + (16 * dt + 4 * kg) * 2) = sw; } }
#pragma unroll
        for (int mt = 0; mt < 4; ++mt) { f32x4 q;
#pragma unroll
            for (int rr = 0; rr < 4; ++rr) q[rr] = row16_sum(o[mt][rr] * o[mt][rr]);
            if (r == 0) *(LAS f32x4*)(PS + wave * 64 + 16 * mt + 4 * kg) = q; }
        LDS_BARRIER();
    }
    LDS_BARRIER();
}
template <int MODE>
__device__ __forceinline__ void ssd_load(const Params& p, LAS unsigned char* lds, int layer, int b, int c, int grp) {
    const int tid = htid(), lane = tid & 63, wave = tid >> 6, t0 = c * 64;
    LAS float* DT = (LAS float*)(lds + 117760); LAS float* ACS = DT + 384;
    LAS unsigned char* XT = lds + 34816;
    if (wave < 6) { const int hh = grp * 6 + wave; const float* small = (const float*)(p.ws + WS_SMALL) + ((size_t)b * SEQ + t0 + lane) * 32;
        const float dt = softplusf_(small[12 + hh] + p.in[I_SSDTB][layer * 12 + hh]); float a = -expf(p.in[I_SSALOG][layer * 12 + hh]) * dt;
#pragma unroll
        for (int o = 1; o < 64; o <<= 1) { const float t = __shfl_up(a, o); if (lane >= o) a += t; }
        DT[wave * 64 + lane] = dt; ACS[wave * 64 + lane] = a; }
    LDS_BARRIER();
    const int cg = tid % 80, seg = tid / 80, ch8 = cg * 8;
    if (tid < 480 && (MODE == 1 || ch8 < 512)) {
        const int col = ch8 < 384 ? grp * 384 + ch8 : (ch8 < 512 ? 768 + grp * 128 + (ch8 - 384) : 1024 + grp * 128 + (ch8 - 512));
        const float* cw = p.in[I_SSCONV] + (size_t)layer * 4 * 1280 + col; const float* cb = p.in[I_SSCONVB] + layer * 1280 + col;
        f32x4 w[4][2], bias[2];
#pragma unroll
        for (int j = 0; j < 4; ++j) { w[j][0] = *(const f32x4*)(cw + j * 1280); w[j][1] = *(const f32x4*)(cw + j * 1280 + 4); }
        bias[0] = *(const f32x4*)cb; bias[1] = *(const f32x4*)(cb + 4);
        const bf16_t* proj = (const bf16_t*)(p.ws + WS_PSSM) + (size_t)b * SEQ * 2048 + col;
        const int ts = seg * 11, hi = ch8 >> 6;
        f32x4 xm[3][2];
#pragma unroll
        for (int i = 0; i < 3; ++i) { const int t = t0 + ts - 3 + i; xm[i][0] = (f32x4){0.f, 0.f, 0.f, 0.f}; xm[i][1] = xm[i][0]; if (t >= 0) ld_bf8(proj + (size_t)t * 2048, xm[i][0], xm[i][1]); }
#pragma unroll
        for (int i = 0; i < 11; ++i) { const int tk = ts + i;
            if (tk < 64) { f32x4 c0, c1; ld_bf8(proj + (size_t)(t0 + tk) * 2048, c0, c1);
                f32x4 a0 = bias[0] + w[3][0] * c0 + w[2][0] * xm[2][0] + w[1][0] * xm[1][0] + w[0][0] * xm[0][0];
                f32x4 a1 = bias[1] + w[3][1] * c1 + w[2][1] * xm[2][1] + w[1][1] * xm[1][1] + w[0][1] * xm[0][1];
                xm[0][0] = xm[1][0]; xm[0][1] = xm[1][1]; xm[1][0] = xm[2][0]; xm[1][1] = xm[2][1]; xm[2][0] = c0; xm[2][1] = c1;
#pragma unroll
                for (int q = 0; q < 4; ++q) { a0[q] = siluf_(a0[q]); a1[q] = siluf_(a1[q]); }
                if (ch8 < 384) { const float sc = MODE == 0 ? DT[hi * 64 + tk] * fexp(ACS[hi * 64 + 63] - ACS[hi * 64 + tk]) : DT[hi * 64 + tk];
#pragma unroll
                    for (int q = 0; q < 4; ++q) { const unsigned pw = pk2(a0[q] * sc, a1[q] * sc);
                        *(LAS bf16_t*)(XT + (ch8 + q) * 144 + tk * 2) = (bf16_t)(pw & 0xffffu); *(LAS bf16_t*)(XT + (ch8 + 4 + q) * 144 + tk * 2) = (bf16_t)(pw >> 16); } }
                else if (MODE == 0) {
#pragma unroll
                    for (int q = 0; q < 4; ++q) { const unsigned pw = pk2(a0[q], a1[q]);
                        *(LAS bf16_t*)(lds + (ch8 - 384 + q) * 144 + tk * 2) = (bf16_t)(pw & 0xffffu); *(LAS bf16_t*)(lds + (ch8 - 384 + 4 + q) * 144 + tk * 2) = (bf16_t)(pw >> 16); } }
                else { u32x4 pw; pw.x = pk2(a0[0], a0[1]); pw.y = pk2(a0[2], a0[3]); pw.z = pk2(a1[0], a1[1]); pw.w = pk2(a1[2], a1[3]);
                    *(LAS u32x4*)(lds + (ch8 < 512 ? 17408 + tk * 272 + (ch8 - 384) * 2 : tk * 272 + (ch8 - 512) * 2)) = pw; } } }
    }
    LDS_BARRIER();
}
__device__ __forceinline__ void ssd_states(const Params& p, LAS unsigned char* lds, int layer, int b, int c, int grp) {
    ssd_load<0>(p, lds, layer, b, c, grp);
    const int tid = htid(), lane = tid & 63, wave = tid >> 6, r = lane & 15, kg = lane >> 4;
    const LAS unsigned char* XT = lds + 34816; const LAS unsigned char* BT = lds; const LAS float* ACS = (const LAS float*)(lds + 117760) + 384;
    bf16_t* st = (bf16_t*)(p.ws + WS_SSST) + ((size_t)(b * 32 + c) * 12 + grp * 6) * 8192;
    for (int t4 = 0; t4 < 24; t4 += 4) {
        bf16x8 af[4][2], bfr[4][2];
#pragma unroll
        for (int q = 0; q < 4; ++q) { const int t = wave + 8 * (t4 + q), hi = t >> 5, mt = (t >> 3) & 3, nt = t & 7;
#pragma unroll
            for (int ks = 0; ks < 2; ++ks) { af[q][ks] = *(const LAS bf16x8*)(XT + (hi * 64 + 16 * mt + r) * 144 + ks * 64 + kg * 16); bfr[q][ks] = *(const LAS bf16x8*)(BT + (16 * nt + r) * 144 + ks * 64 + kg * 16); } }
#pragma unroll
        for (int q = 0; q < 4; ++q) { const int t = wave + 8 * (t4 + q), hi = t >> 5, mt = (t >> 3) & 3, nt = t & 7;
            f32x4 acc = (f32x4){0.f, 0.f, 0.f, 0.f};
#pragma unroll
            for (int ks = 0; ks < 2; ++ks) acc = mfma16(af[q][ks], bfr[q][ks], acc);
#pragma unroll
            for (int rr = 0; rr < 4; rr += 2) { bf16_t* so_ = st + (size_t)hi * 8192 + (16 * mt + 4 * kg + rr) * 128 + 16 * nt + r; ST2_BF(so_, so_ + 128, acc[rr], acc[rr + 1]); } }
    }
    if (tid < 6) ((float*)(p.ws + WS_SSCD))[(b * 32 + c) * 12 + grp * 6 + tid] = expf(ACS[tid * 64 + 63]);
    LDS_BARRIER();
}
__device__ __forceinline__ void ssd_scan(const Params& p, int first_blk, int nblk) {
    const int gt = ((int)blockIdx.x - first_blk) * 512 + htid(), NT = nblk * 512;
    const u32x4* st = (const u32x4*)(p.ws + WS_SSST); const float* cd = (const float*)(p.ws + WS_SSCD); u32x4* pv = (u32x4*)(p.ws + WS_SSPV);
    for (int v = gt; v < NB * 12 * 1024; v += NT) { const int b = v / (12 * 1024), h = (v / 1024) % 12, e = v % 1024;
        f32x4 r0 = (f32x4){0.f, 0.f, 0.f, 0.f}, r1 = r0;
        for (int c0 = 0; c0 < 32; c0 += 8) { u32x4 t[8]; float dc[8];
#pragma unroll
            for (int i = 0; i < 8; ++i) { t[i] = st[((size_t)(b * 32 + c0 + i) * 12 + h) * 1024 + e]; dc[i] = cd[(b * 32 + c0 + i) * 12 + h]; }
#pragma unroll
            for (int i = 0; i < 8; ++i) { u32x4 w; w.x = pk2(r0[0], r0[1]); w.y = pk2(r0[2], r0[3]); w.z = pk2(r1[0], r1[1]); w.w = pk2(r1[2], r1[3]); pv[((size_t)(b * 32 + c0 + i) * 12 + h) * 1024 + e] = w;
                r0 = r0 * dc[i] + (f32x4){lo_bf(t[i].x), hi_bf(t[i].x), lo_bf(t[i].y), hi_bf(t[i].y)}; r1 = r1 * dc[i] + (f32x4){lo_bf(t[i].z), hi_bf(t[i].z), lo_bf(t[i].w), hi_bf(t[i].w)}; } }
    }
}
__device__ __forceinline__ void ssd_out(const Params& p, LAS unsigned char* lds, int layer, int b, int c, int grp) {
    ssd_load<1>(p, lds, layer, b, c, grp);
    const int tid = htid(), lane = tid & 63, wave = tid >> 6, r = lane & 15, kg = lane >> 4, t0 = c * 64;
    const LAS unsigned char* CM = lds; const LAS unsigned char* BM = lds + 17408; const LAS unsigned char* XT = lds + 34816; LAS unsigned char* MH = lds + 90112;
    const LAS float* DT = (const LAS float*)(lds + 117760); const LAS float* ACS = DT + 384; LAS float* YG = (LAS float*)lds;
    const bf16_t* prev = (const bf16_t*)(p.ws + WS_SSPV) + ((size_t)(b * 32 + c) * 12 + grp * 6) * 8192;
    f32x4 cb[2];
    {   bf16x8 ca[2][4], cbf[2][4];
#pragma unroll
        for (int q = 0; q < 2; ++q) { const int t = wave * 2 + q, mt = t >> 2, nt = t & 3;
#pragma unroll
            for (int ks = 0; ks < 4; ++ks) { ca[q][ks] = *(const LAS bf16x8*)(CM + (16 * mt + r) * 272 + ks * 64 + kg * 16); cbf[q][ks] = *(const LAS bf16x8*)(BM + (16 * nt + r) * 272 + ks * 64 + kg * 16); } }
#pragma unroll
        for (int q = 0; q < 2; ++q) { f32x4 acc = (f32x4){0.f, 0.f, 0.f, 0.f};
#pragma unroll
            for (int ks = 0; ks < 4; ++ks) acc = mfma16(ca[q][ks], cbf[q][ks], acc);
            cb[q] = acc; } }
    f32x4 y[2][6];
#pragma unroll
    for (int half = 0; half < 2; ++half) {
#pragma unroll
        for (int q = 0; q < 2; ++q) { const int t = wave * 2 + q, mt = t >> 2, nt = t & 3, j = 16 * nt + r;
#pragma unroll
            for (int hl = 0; hl < 3; ++hl) { const int hi = 3 * half + hl; const float aj = ACS[hi * 64 + j];
#pragma unroll
                for (int rr = 0; rr < 4; ++rr) { const int i = 16 * mt + 4 * kg + rr; *(LAS bf16_t*)(MH + hl * 9216 + i * 144 + j * 2) = (bf16_t)f2bf((i >= j) ? cb[q][rr] * fexp(fminf(ACS[hi * 64 + i] - aj, 0.f)) : 0.f); } } }
        bf16x8 pf[6][4];
#pragma unroll
        for (int k = 0; k < 6; ++k) { const int t = wave + 8 * k, hl = t >> 4, nt = t & 3, hi = 3 * half + hl; const bf16_t* pr = prev + (size_t)hi * 8192 + (16 * nt + r) * 128 + kg * 8;
#pragma unroll
            for (int ks = 0; ks < 4; ++ks) pf[k][ks] = *(const bf16x8*)(pr + ks * 32); }
        LDS_BARRIER();
#pragma unroll
        for (int k = 0; k < 6; ++k) { const int t = wave + 8 * k, hl = t >> 4, mt = (t >> 2) & 3, nt = t & 3, hi = 3 * half + hl, hh = grp * 6 + hi;
            f32x4 acc = (f32x4){0.f, 0.f, 0.f, 0.f}, off = acc;
            bf16x8 mf[2], xf[2], cf[4];
#pragma unroll
            for (int ks = 0; ks < 2; ++ks) { mf[ks] = *(const LAS bf16x8*)(MH + hl * 9216 + (16 * mt + r) * 144 + ks * 64 + kg * 16); xf[ks] = *(const LAS bf16x8*)(XT + (hi * 64 + 16 * nt + r) * 144 + ks * 64 + kg * 16); }
#pragma unroll
            for (int ks = 0; ks < 4; ++ks) cf[ks] = *(const LAS bf16x8*)(CM + (16 * mt + r) * 272 + ks * 64 + kg * 16);
#pragma unroll
            for (int ks = 0; ks < 2; ++ks) acc = mfma16(mf[ks], xf[ks], acc);
#pragma unroll
            for (int ks = 0; ks < 4; ++ks) off = mfma16(cf[ks], pf[k][ks], off);
            const u32x2 xw = *(const LAS u32x2*)(XT + (hi * 64 + 16 * nt + r) * 144 + (16 * mt + 4 * kg) * 2); const float xs[4] = {lo_bf(xw.x), hi_bf(xw.x), lo_bf(xw.y), hi_bf(xw.y)};
            const float dsk = p.in[I_SSD][layer * 12 + hh];
#pragma unroll
            for (int rr = 0; rr < 4; ++rr) { const int i = 16 * mt + 4 * kg + rr; acc[rr] += fexp(ACS[hi * 64 + i]) * off[rr] + dsk * xs[rr] * __builtin_amdgcn_rcpf(fmaxf(DT[hi * 64 + i], 1e-30f)); }
            y[half][k] = acc; }
        LDS_BARRIER();
    }
    const bf16_t* zp = (const bf16_t*)(p.ws + WS_PSSM) + ((size_t)b * SEQ + t0) * 2048 + 1280 + grp * 384;
#pragma unroll
    for (int half = 0; half < 2; ++half)
#pragma unroll
        for (int k = 0; k < 6; ++k) { const int t = wave + 8 * k, hl = t >> 4, mt = (t >> 2) & 3, nt = t & 3, hi = 3 * half + hl, ch = hi * 64 + 16 * nt + r;
#pragma unroll
            for (int rr = 0; rr < 4; ++rr) { const int i = 16 * mt + 4 * kg + rr; const float z = bf2f(zp[(size_t)i * 2048 + ch]); YG[i * 388 + ch] = y[half][k][rr] * siluf_(z); } }
    LDS_BARRIER();
    const float* sn = p.in[I_SSNORM] + layer * 768 + grp * 384; bf16_t* yo = (bf16_t*)(p.ws + WS_YSSM) + ((size_t)b * SEQ + t0) * 768 + grp * 384;
#pragma unroll
    for (int i8 = 0; i8 < 8; ++i8) { const int i = 8 * wave + i8; float v[6], ss = 0.f;
#pragma unroll
        for (int k = 0; k < 6; ++k) { v[k] = YG[i * 388 + lane + 64 * k]; ss += v[k] * v[k]; }
        const float rs = rsqrtf(wave_sum(ss) * (1.f / 384.f) + EPS);
#pragma unroll
        for (int k = 0; k < 6; k += 2) ST2_BF(yo + (size_t)i * 768 + lane + 64 * k, yo + (size_t)i * 768 + lane + 64 * (k + 1), v[k] * rs * sn[lane + 64 * k], v[k + 1] * rs * sn[lane + 64 * (k + 1)]); }
    LDS_BARRIER();
}

typedef float f32x16 __attribute__((ext_vector_type(16)));
__device__ __forceinline__ void attn_tile(const Params& p, int b, int g, int j, int r, int qt, int lane) {
    const int d = g == 0 ? 1 : (g == 1 ? 4 : 16), L = SEQ / d, n = lane & 31, hw = lane >> 5;
    const int P0 = b * SEQ + r * L;
    const bf16_t* Q = (const bf16_t*)(p.ws + WS_QK) + (size_t)(0 * 3 + g) * TC * 256 + j * 64;
    const bf16_t* K = (const bf16_t*)(p.ws + WS_QK) + (size_t)(1 * 3 + g) * TC * 256 + j * 64;
    const bf16_t* V = (const bf16_t*)(p.ws + WS_VT) + (size_t)(g * 256 + j * 64) * TC;
    const float sl2 = exp2f(-8.f * (float)(4 * g + j + 1) / 12.f) * (float)d * 1.4426950408889634f;
    bf16x8 qf[4];
    { const bf16_t* qrow = Q + (size_t)(P0 + 32 * qt + n) * 256 + 8 * hw;
#pragma unroll
      for (int s = 0; s < 4; ++s) qf[s] = *(const bf16x8*)(qrow + 16 * s); }
    f32x16 o0, o1;
#pragma unroll
    for (int i = 0; i < 16; ++i) { o0[i] = 0.f; o1[i] = 0.f; }
    float mrun = -1e30f, lrun = 0.f;
    const int pim = (n & 0x13) | (((n >> 2) & 1) << 3) | (((n >> 3) & 1) << 2);
    const int qi = 32 * qt + n;
    const int kb0 = qt > 4 ? qt - 4 : 0;
    bf16x8 kf[4], vf[2][2];
    { const bf16_t* krow = K + (size_t)(P0 + 32 * kb0 + pim) * 256 + 8 * hw;
#pragma unroll
      for (int s = 0; s < 4; ++s) kf[s] = *(const bf16x8*)(krow + 16 * s);
#pragma unroll
      for (int sp = 0; sp < 2; ++sp)
#pragma unroll
          for (int dh = 0; dh < 2; ++dh) vf[sp][dh] = *(const bf16x8*)(V + (size_t)(32 * dh + n) * TC + P0 + 32 * kb0 + 16 * sp + 8 * hw); }
    for (int kb = kb0; kb <= qt; ++kb) {
        f32x16 st;
#pragma unroll
        for (int i = 0; i < 16; ++i) st[i] = 0.f;
#pragma unroll
        for (int s = 0; s < 4; ++s) st = __builtin_amdgcn_mfma_f32_32x32x16_bf16(kf[s], qf[s], st, 0, 0, 0);
        bf16x8 vc[2][2];
#pragma unroll
        for (int sp = 0; sp < 2; ++sp)
#pragma unroll
            for (int dh = 0; dh < 2; ++dh) vc[sp][dh] = vf[sp][dh];
        if (kb < qt) {
            const bf16_t* krow = K + (size_t)(P0 + 32 * (kb + 1) + pim) * 256 + 8 * hw;
#pragma unroll
            for (int s = 0; s < 4; ++s) kf[s] = *(const bf16x8*)(krow + 16 * s);
#pragma unroll
            for (int sp = 0; sp < 2; ++sp)
#pragma unroll
                for (int dh = 0; dh < 2; ++dh) vf[sp][dh] = *(const bf16x8*)(V + (size_t)(32 * dh + n) * TC + P0 + 32 * (kb + 1) + 16 * sp + 8 * hw);
        }
        float mx = -1e30f;
#pragma unroll
        for (int jj = 0; jj < 16; ++jj) { const int kidx = 32 * kb + 16 * (jj >> 3) + 8 * hw + 4 * ((jj >> 2) & 1) + (jj & 3); const int dl = qi - kidx;
            const float sc = (dl >= 0 && dl <= 128) ? st[jj] * 1.4426950408889634f - sl2 * (float)dl : -1e30f; st[jj] = sc; mx = fmaxf(mx, sc); }
        mx = fmaxf(mx, __shfl_xor(mx, 32));
        const float mnew = fmaxf(mrun, mx), alpha = __builtin_amdgcn_exp2f(mrun - mnew);
        float rs = 0.f;
#pragma unroll
        for (int jj = 0; jj < 16; ++jj) { const float pj = __builtin_amdgcn_exp2f(st[jj] - mnew); st[jj] = pj; rs += pj; }
        rs += __shfl_xor(rs, 32);
        lrun = lrun * alpha + rs; mrun = mnew;
#pragma unroll
        for (int i = 0; i < 16; ++i) { o0[i] *= alpha; o1[i] *= alpha; }
#pragma unroll
        for (int sp = 0; sp < 2; ++sp) {
            u32x4 pw; pw.x = pk2(st[8 * sp + 0], st[8 * sp + 1]); pw.y = pk2(st[8 * sp + 2], st[8 * sp + 3]); pw.z = pk2(st[8 * sp + 4], st[8 * sp + 5]); pw.w = pk2(st[8 * sp + 6], st[8 * sp + 7]);
            const bf16x8 pf = __builtin_bit_cast(bf16x8, pw);
            o0 = __builtin_amdgcn_mfma_f32_32x32x16_bf16(vc[sp][0], pf, o0, 0, 0, 0);
            o1 = __builtin_amdgcn_mfma_f32_32x32x16_bf16(vc[sp][1], pf, o1, 0, 0, 0);
        }
    }
    const float inv = 1.f / lrun;
    const int tok = b * SEQ + qi * d + r;
    bf16_t* og = (bf16_t*)(p.ws + WS_OG) + ((size_t)g * TC + tok) * 256 + j * 64 + 4 * hw;
#pragma unroll
    for (int q4 = 0; q4 < 4; ++q4) {
        u32x2 w0, w1; w0.x = pk2(o0[4 * q4] * inv, o0[4 * q4 + 1] * inv); w0.y = pk2(o0[4 * q4 + 2] * inv, o0[4 * q4 + 3] * inv);
        w1.x = pk2(o1[4 * q4] * inv, o1[4 * q4 + 1] * inv); w1.y = pk2(o1[4 * q4 + 2] * inv, o1[4 * q4 + 3] * inv);
        *(u32x2*)(og + 8 * q4) = w0; *(u32x2*)(og + 32 + 8 * q4) = w1;
    }
    if (hw == 0) ((float*)(p.ws + WS_LSE))[((size_t)g * TC + tok) * 4 + j] = (mrun + log2f(lrun)) * 0.6931471805599453f;
}
__device__ __forceinline__ void phase_attn_combine(const Params& p, int skip) {
    const int tid_ = htid(), lane = tid_ & 63, gw = ((int)blockIdx.x - skip) * 8 + (tid_ >> 6), NGW = ((int)gridDim.x - skip) * 8;
    const bf16_t* og = (const bf16_t*)(p.ws + WS_OG); const float* lse = (const float*)(p.ws + WS_LSE); bf16_t* ya = (bf16_t*)(p.ws + WS_YATT);
    for (int t = gw; t < TC; t += NGW) {
        const int j = lane >> 4;
        const float l0 = lse[((size_t)0 * TC + t) * 4 + j], l1 = lse[((size_t)1 * TC + t) * 4 + j], l2 = lse[((size_t)2 * TC + t) * 4 + j];
        const float M = fmaxf(l0, fmaxf(l1, l2)); float w0 = expf(l0 - M), w1 = expf(l1 - M), w2 = expf(l2 - M); const float iw = 1.f / (w0 + w1 + w2); w0 *= iw; w1 *= iw; w2 *= iw;
        const u32x2 a = *((const u32x2*)(og + ((size_t)0 * TC + t) * 256) + lane), bb = *((const u32x2*)(og + ((size_t)1 * TC + t) * 256) + lane), c = *((const u32x2*)(og + ((size_t)2 * TC + t) * 256) + lane);
        u32x2 o; o.x = pk2(w0 * lo_bf(a.x) + w1 * lo_bf(bb.x) + w2 * lo_bf(c.x), w0 * hi_bf(a.x) + w1 * hi_bf(bb.x) + w2 * hi_bf(c.x));
        o.y = pk2(w0 * lo_bf(a.y) + w1 * lo_bf(bb.y) + w2 * lo_bf(c.y), w0 * hi_bf(a.y) + w1 * hi_bf(bb.y) + w2 * hi_bf(c.y));
        *((u32x2*)(ya + (size_t)t * 256) + lane) = o;
    }
}
__device__ __forceinline__ void sub_barrier(unsigned* cnt, unsigned target) {
    asm volatile("s_waitcnt vmcnt(0)" ::: "memory");
    __syncthreads();
    if (threadIdx.x == 0) {
        __builtin_amdgcn_fence(__ATOMIC_RELEASE, "agent"); asm volatile("s_waitcnt vmcnt(0)" ::: "memory");
        (void)xb_add(cnt, 1u);
        unsigned sp = 0; while (xb_ld(cnt) < target) { __builtin_amdgcn_s_sleep(2); if (++sp > (1u << 24)) break; }
        __builtin_amdgcn_fence(__ATOMIC_ACQUIRE, "agent"); asm volatile("s_waitcnt vmcnt(0)" ::: "memory");
    }
    __syncthreads();
}
__device__ __forceinline__ void phase_mixers(const Params& p, LAS unsigned char* lds, int layer) {
    const int G = gridDim.x, NDP = NB * 32 * 6, NSS = NB * 32 * 2;
    TSUB(15);
    u32x4 xr[10];
#pragma unroll
    for (int i = 0; i < 10; ++i) xr[i] = (u32x4){0u, 0u, 0u, 0u};
    if ((int)blockIdx.x < NDP) dn_fetch(p, (int)blockIdx.x / 192, ((int)blockIdx.x / 6) % 32, (int)blockIdx.x % 6, xr);
    for (int item = blockIdx.x; item < NDP + NSS; item += G) {
        if (item < NDP) { const int nx = item + G; dn_prep(p, lds, layer, item / 192, (item / 6) % 32, item % 6, xr, nx < NDP, nx / 192, (nx / 6) % 32, nx % 6); TSUB(6); }
        else { const int it = item - NDP; ssd_states(p, lds, layer, it / 64, (it >> 1) & 31, it & 1); TSUB(7); }
    }
}
__device__ __forceinline__ void phase_mixers2(const Params& p, LAS unsigned char* lds, int layer, int rep, unsigned* subcnt, bool use_bar2) {
    const int tid_ = htid(), lane = tid_ & 63, wave = tid_ >> 6, G = gridDim.x, nscan = NB * 6;
    const int ded = G > 2 * nscan ? nscan : 0;
    TSUB(15);
    if ((int)blockIdx.x < ded) { if (!(MIX2_PROBE == 2 && rep > 0)) dn_scan(p, lds, layer, blockIdx.x / 6, blockIdx.x % 6); TSUB(0); return; }
    if (MIX2_PROBE == 1 && rep > 0) return;
    if (ded == 0) for (int it = blockIdx.x; it < nscan; it += G) dn_scan(p, lds, layer, it / 6, it % 6);
    const int nb = G - ded, rb = (int)blockIdx.x - ded;
    for (int item = rb; item < NB * 3 * 4 * 64 / 8; item += nb) { const int w = item * 8 + wave;
        const int st = w & 63, jj = (w >> 6) & 3, gg = (w >> 8) % 3, bb = w / 768;
        const int dd = gg == 0 ? 1 : (gg == 1 ? 4 : 16), tiles = SEQ / dd / 32;
        attn_tile(p, bb, gg, jj, st / tiles, st % tiles, lane); }
    TSUB(1);
    ssd_scan(p, ded, nb);
    TSUB(2);
    if (use_bar2) { XcdBarrier bar2; bar2.bar = (unsigned*)(p.ws + WS_CTL) + CW_BAR2; bar2.x = xb_xcc_id(); bar2.st = (volatile LAS unsigned*)(lds + LDS_BYTES - 256) + 12; xcd_barrier(bar2, (unsigned)nb); } else sub_barrier(subcnt, (unsigned)(nb * (rep + 1)));
    TSUB(3);
    for (int it = rb; it < NB * 32 * 2; it += nb) ssd_out(p, lds, layer, it / 64, (it >> 1) & 31, it & 1);
    TSUB(4);
    phase_attn_combine(p, ded);
    TSUB(5);
}

constexpr int NSTEPS = 1 + NCH * (8 + 11 + 1);
__global__ void __launch_bounds__(512, 2) hybrid_fwd(Params p) {
    extern __shared__ __attribute__((aligned(16))) unsigned char lds_raw[];
    LAS unsigned char* lds = (LAS unsigned char*)lds_raw;
    volatile LAS unsigned* MISC = (volatile LAS unsigned*)(lds + LDS_BYTES - 256);
    if (threadIdx.x < 64) MISC[threadIdx.x] = 0u;
    __syncthreads();
    const int G = gridDim.x, cid = blockIdx.x;
    unsigned char* ws = p.ws;
    XcdBarrier bar; bar.bar = (unsigned*)(ws + WS_CTL) + CW_BAR; bar.x = 0; bar.st = MISC + 8;
    if (p.s_hi - p.s_lo > 1) bar = xcd_barrier_post((unsigned*)(ws + WS_CTL) + CW_BAR, MISC + 8);
    const bool use_bar2 = (p.s_hi - p.s_lo == NSTEPS) && ((int)gridDim.x > 2 * NB * 6);
    if (use_bar2 && (int)blockIdx.x >= NB * 6 && threadIdx.x == 0) (void)xb_add((unsigned*)(ws + WS_CTL) + CW_BAR2 + XB_XCNT(xb_xcc_id()), 1u);
    const int lo = p.s_lo, hi = p.s_hi;
    int step = 0;
    if (TPROBE_MASK != 0u && threadIdx.x == 0) { volatile LAS unsigned long long* tp_ = (volatile LAS unsigned long long*)(lds + LDS_BYTES - 256 + 128); tp_[0] = 0ull; tp_[1] = __builtin_amdgcn_s_memrealtime(); tp_[2] = 21ull; }
#define IN_STEP (step >= lo && step < hi)
#define END_STEP do { if (step >= lo && step + 1 < hi) xcd_barrier(bar); \
        if (TPROBE_ON && threadIdx.x == 0) { volatile LAS unsigned long long* tp_ = (volatile LAS unsigned long long*)(lds + LDS_BYTES - 256 + 128); const unsigned long long tn_ = __builtin_amdgcn_s_memrealtime(); \
            const unsigned pos_ = (unsigned)tp_[2]; if (pos_ < 22u && ((p.tmask >> pos_) & 1u)) tp_[0] += tn_ - tp_[1]; tp_[1] = tn_; tp_[2] = pos_ >= 20u ? 1ull : (unsigned long long)(pos_ + 1u); } \
        ++step; } while (0)
    bf16_t* xb = (bf16_t*)(ws + WS_XB); float* ssq = (float*)(ws + WS_SSQ);
    if (IN_STEP) for (int rep_ = 0; rep_ < (REP_PH == 0 ? 3 : 1); ++rep_, (rep_ < (REP_PH == 0 ? 3 : 1) ? xcd_barrier(bar) : (void)0)) { phase_convert(p, lds); phase_chunk_in(p, 0); }
    END_STEP;
    for (int chunk = 0; chunk < NCH; ++chunk) {
        float* xo = p.out + (size_t)chunk * TC * D;
        for (int layer = 0; layer < DEPTH; ++layer) {
            if (IN_STEP) for (int rep_ = 0; rep_ < (REP_PH == 2 ? 3 : 1); ++rep_, (rep_ < (REP_PH == 2 ? 3 : 1) ? xcd_barrier(bar) : (void)0)) {
                ProgIn P; P.S.init(TC / 256, INP / 256, G, cid); P.xb = layer == 0 ? xb : (const bf16_t*)(ws + WS_XB2); P.Wt = (const bf16_t*)(ws + WS_WIN) + (size_t)layer * INP * D; P.ssq = layer == 0 ? ssq : (const float*)(ws + WS_SSQ2);
                P.wsb = ws; P.pb = (const bf16_t*)(ws + WS_PB) + (size_t)layer * TC * PLE; P.wple = (const bf16_t*)(ws + WS_WPLE) + (size_t)layer * D * PLE;
                gemm_phase(lds, P);
            }
            END_STEP;
            if (IN_STEP) for (int rep_ = 0; rep_ < (REP_PH == 3 ? 3 : 1); ++rep_, (rep_ < (REP_PH == 3 ? 3 : 1) ? xcd_barrier(bar) : (void)0)) phase_mixers(p, lds, layer);
            END_STEP;
            if (IN_STEP) for (int rep_ = 0; rep_ < (REP_PH == 4 ? 3 : 1); ++rep_, (rep_ < (REP_PH == 4 ? 3 : 1) ? xcd_barrier(bar) : (void)0)) phase_mixers2(p, lds, layer, rep_, (unsigned*)(ws + WS_CTL) + CW_SUB + (chunk * 2 + layer) * 64, use_bar2);
            END_STEP;
            if (IN_STEP) for (int rep_ = 0; rep_ < (REP_PH == 6 ? 3 : 1); ++rep_, (rep_ < (REP_PH == 6 ? 3 : 1) ? xcd_barrier(bar) : (void)0)) {
                ProgMerge P; P.S.init(TC / 256, 4, G, cid); P.wsb = ws;
                P.wdn = (const bf16_t*)(ws + WS_WDN) + (size_t)layer * D * 768; P.wssm = (const bf16_t*)(ws + WS_WSSM) + (size_t)layer * D * 768; P.watt = (const bf16_t*)(ws + WS_WATT) + (size_t)layer * D * 256;
                gemm_phase(lds, P);
            }
            END_STEP;
            if (IN_STEP) {
                ProgResid P; P.S.init(TC / 256, 4, G, cid); P.A = (const bf16_t*)(ws + WS_MERGED); P.lda = 2048; P.nt = 16; P.Wt = (const bf16_t*)(ws + WS_WOUT) + (size_t)layer * D * D; P.ldb = 2048;
                P.xin_f = layer == 0 ? p.in[I_X] + (size_t)chunk * TC * D : nullptr; P.xin_b = (const bf16_t*)(ws + WS_XB2); P.xb = xb; P.ssq = ssq; P.sc = 1.f;
                gemm_phase(lds, P);
            }
            END_STEP;
            if (layer == 0) {
                if (IN_STEP) for (int rep_ = 0; rep_ < (REP_PH == 8 ? 3 : 1); ++rep_, (rep_ < (REP_PH == 8 ? 3 : 1) ? xcd_barrier(bar) : (void)0)) {
                    ProgFfnGu P; P.S.init(TC / 256, 2 * FFN / 256, G, cid); P.xb = xb; P.Wt = (const bf16_t*)(ws + WS_WFGU); P.ssq = ssq; P.act = (bf16_t*)(ws + WS_ACT);
                    gemm_phase(lds, P);
                }
                END_STEP;
                if (IN_STEP) {
                    ProgResid P; P.S.init(TC / 256, 4, G, cid); P.A = (const bf16_t*)(ws + WS_ACT); P.lda = 2 * FFN; P.nt = FFN / 64; P.Wt = (const bf16_t*)(ws + WS_WFD); P.ldb = 2 * FFN;
                    P.xin_f = nullptr; P.xin_b = xb; P.xb = xb; P.ssq = ssq; P.sc = (DBG_ABL & 8) ? 0.f : 1.f;
                    gemm_phase(lds, P);
                }
                END_STEP;
            } else {
                if (IN_STEP) phase_router(p, lds, chunk);
                END_STEP;
                if (IN_STEP) phase_slots(p, chunk);
                END_STEP;
                if (IN_STEP) for (int rep_ = 0; rep_ < (REP_PH == 12 ? 3 : 1); ++rep_, (rep_ < (REP_PH == 12 ? 3 : 1) ? xcd_barrier(bar) : (void)0)) {
                    ProgMoeGu P; P.S.init((const unsigned*)(ws + WS_CTL) + CW_CNT + chunk * 64, 2 * EXD / 256, G, cid); P.xb = xb; P.Wt = (const bf16_t*)(ws + WS_WMGU); P.ssq = ssq;
                    P.idx = (const int*)(ws + WS_ROUTE) + RT_IDX; P.act = (bf16_t*)(ws + WS_ACTM);
                    gemm_phase(lds, P);
                }
                END_STEP;
                if (IN_STEP) for (int rep_ = 0; rep_ < (REP_PH == 13 ? 3 : 1); ++rep_, (rep_ < (REP_PH == 13 ? 3 : 1) ? xcd_barrier(bar) : (void)0)) {
                    ProgMoeDown P; P.init((const unsigned*)(ws + WS_CTL) + CW_CNT + chunk * 64, G, cid); P.act = (const bf16_t*)(ws + WS_ACTM); P.Wt = (const bf16_t*)(ws + WS_WMD); P.ypair = (bf16_t*)(ws + WS_YPAIR); P.partk = (float*)(ws + WS_PARTK);
                    gemm_phase(lds, P);
                }
                END_STEP;
                if (IN_STEP) phase_combine(p, chunk);
                END_STEP;
            }
            if (IN_STEP) {
                ProgPle P; P.S.init(TC / 256, 4, G, cid); P.xb = xb; P.wpg = (const bf16_t*)(ws + WS_WPG) + (size_t)layer * D * D; P.pp = (const bf16_t*)(ws + WS_PP); P.ssq = ssq;
                P.xbout = (bf16_t*)(ws + WS_XB2); P.ssqout = (float*)(ws + WS_SSQ2);
                gemm_phase(lds, P);
            }
            END_STEP;
        }
        if (IN_STEP) { phase_final(p, chunk); if (chunk + 1 < NCH) phase_chunk_in(p, chunk + 1); }
        END_STEP;
    }
    if (TPROBE_MASK != 0u && (int)blockIdx.x == (p.pad & 0xffff) && threadIdx.x == 0) { const unsigned long long tsum_ = *(volatile LAS unsigned long long*)(lds + LDS_BYTES - 256 + 128); const unsigned long long t0_ = __builtin_amdgcn_s_memrealtime(); while (__builtin_amdgcn_s_memrealtime() - t0_ < 4ull * tsum_) __builtin_amdgcn_s_sleep(16); }
#undef IN_STEP
#undef END_STEP
}

#if defined(DBG_REP_STEP)
__global__ void dbg_csum(const unsigned* buf, size_t n, unsigned long long* out) {
    unsigned long long a = 0;
    for (size_t i = (size_t)blockIdx.x * 256 + threadIdx.x; i < n; i += (size_t)gridDim.x * 256) a += (unsigned long long)buf[i] * (unsigned long long)((i % 1021) + 1);
    atomicAdd(out, a);
}
__global__ void dbg_verdict(float* out, const unsigned long long* cs, int R) {
    bool bad = false; for (int r = 1; r < R; ++r) bad = bad || (cs[r] != cs[0]);
    const float v = bad ? __builtin_nanf("") : 0.f; const size_t n = (size_t)BATCH * SEQ * D;
    for (size_t i = (size_t)blockIdx.x * 256 + threadIdx.x; i < n; i += (size_t)gridDim.x * 256) out[i] = v;
}
#endif
#if defined(DBG_STOP)
#ifndef DBG_DUMP
#define DBG_DUMP 0
#define DBG_DUMP_OFF 0
#endif
__global__ void dbg_fill(float* out, const unsigned short* buf, int dump) {
    const size_t n = (size_t)BATCH * SEQ * D, c0 = (size_t)TC * D;
    for (size_t i = (size_t)blockIdx.x * 256 + threadIdx.x; i < n; i += (size_t)gridDim.x * 256) {
        if (i >= c0) out[i] = 0.f; else if (dump) out[i] = __uint_as_float(((unsigned)buf[i]) << 16);
    }
}
#endif
extern "C" void kernel_launch(void* const* d_in, const int* in_sizes, int n_in, void* d_out, int out_size, void* d_ws, size_t ws_size, hipStream_t stream) {
    static int grid = 0;
    if (grid == 0) {
        if (n_in != 30 || out_size != BATCH * SEQ * D || ws_size < WS_END) { fprintf(stderr, "kernel_launch: unexpected shapes (n_in %d, out %d, ws %zu < %zu)\n", n_in, out_size, ws_size, (size_t)WS_END); grid = -1; return; }
        int dev = 0, cus = 0;
        if (hipGetDevice(&dev) != hipSuccess || hipDeviceGetAttribute(&cus, hipDeviceAttributeMultiprocessorCount, dev) != hipSuccess) { grid = -1; return; }
        if (hipFuncSetAttribute((const void*)hybrid_fwd, hipFuncAttributeMaxDynamicSharedMemorySize, LDS_BYTES) != hipSuccess) { fprintf(stderr, "kernel_launch: hipFuncSetAttribute failed\n"); grid = -1; return; }
        int per_cu = 0;
        if (hipOccupancyMaxActiveBlocksPerMultiprocessor(&per_cu, (const void*)hybrid_fwd, 512, LDS_BYTES) != hipSuccess || per_cu < 1) { fprintf(stderr, "kernel_launch: occupancy query says %d\n", per_cu); }
        (void)hipGetLastError();
        grid = cus;
    }
    if (grid < 0) return;
    (void)hipMemsetAsync((char*)d_ws + WS_CTL, 0, MiB, stream);
    Params p{};
    for (int i = 0; i < 30; ++i) p.in[i] = (const float*)d_in[i];
    p.out = (float*)d_out; p.ws = (unsigned char*)d_ws; p.tmask = TPROBE_MASK; p.pad = TPROBE_PAD;
#if defined(DBG_REP_STEP)
    for (int s = 0; s < DBG_REP_STEP; ++s) { p.s_lo = s; p.s_hi = s + 1; hipLaunchKernelGGL(hybrid_fwd, dim3(grid), dim3(512), LDS_BYTES, stream, p); }
    unsigned long long* cs = (unsigned long long*)((char*)d_ws + WS_CTL + 512 * 1024);
    for (int r = 0; r < DBG_REP_N; ++r) { p.s_lo = DBG_REP_STEP; p.s_hi = DBG_REP_STEP + 1; hipLaunchKernelGGL(hybrid_fwd, dim3(grid), dim3(512), LDS_BYTES, stream, p);
        hipLaunchKernelGGL(dbg_csum, dim3(1024), dim3(256), 0, stream, (const unsigned*)((const char*)d_ws + DBG_REP_OFF), (size_t)(DBG_REP_BYTES) / 4, cs + r); }
    hipLaunchKernelGGL(dbg_verdict, dim3(2048), dim3(256), 0, stream, (float*)d_out, cs, (int)DBG_REP_N);
#elif defined(DBG_STOP)
    for (int s = 0; s < DBG_STOP; ++s) { p.s_lo = s; p.s_hi = s + 1; hipLaunchKernelGGL(hybrid_fwd, dim3(grid), dim3(512), LDS_BYTES, stream, p); }
    hipLaunchKernelGGL(dbg_fill, dim3(2048), dim3(256), 0, stream, (float*)d_out, (const unsigned short*)((const char*)d_ws + DBG_DUMP_OFF), (int)DBG_DUMP);
#elif ONE_LAUNCH
    p.s_lo = 0; p.s_hi = NSTEPS;
    hipLaunchKernelGGL(hybrid_fwd, dim3(grid), dim3(512), LDS_BYTES, stream, p);
#else
    for (int s = 0; s < NSTEPS; ++s) { p.s_lo = s; p.s_hi = s + 1; hipLaunchKernelGGL(hybrid_fwd, dim3(grid), dim3(512), LDS_BYTES, stream, p); }
#endif
}
```

```cpp
#include <hip/hip_runtime.h>
#include <cstdio>
#include <cstdint>

#define GAS __attribute__((address_space(1)))
#define LAS __attribute__((address_space(3)))
typedef unsigned short bf16_t;
typedef short bf16x8 __attribute__((ext_vector_type(8)));
typedef float f32x4 __attribute__((ext_vector_type(4)));
typedef float f32x2 __attribute__((ext_vector_type(2)));
typedef unsigned u32x4 __attribute__((ext_vector_type(4)));
typedef unsigned u32x2 __attribute__((ext_vector_type(2)));

#ifndef REP_PH
#define REP_PH -1
#endif
#ifndef EMU_FP8
#define EMU_FP8 0
#endif
#ifndef TPROBE_MASK
#define TPROBE_MASK 0u
#endif
#define TPROBE_ON (TPROBE_MASK != 0u)
#ifndef TPROBE_PAD
#define TPROBE_PAD 0
#endif
#define TSUB(b) do { if (TPROBE_ON && threadIdx.x == 0 && (int)blockIdx.x == (p.pad & 0xffff)) { volatile LAS unsigned long long* ts_ = (volatile LAS unsigned long long*)(lds + LDS_BYTES - 256 + 128); \
        const unsigned long long tn_ = __builtin_amdgcn_s_memrealtime(); if ((p.pad >> (16 + (b))) & 1) ts_[0] += tn_ - ts_[3]; ts_[3] = tn_; } } while (0)
#ifndef MIX2_PROBE
#define MIX2_PROBE 0
#endif
#ifndef DBG_ABL
#define DBG_ABL 0
#endif
#ifndef ONE_LAUNCH
#define ONE_LAUNCH 1
#endif

constexpr int D = 1024, BATCH = 32, SEQ = 2048, DEPTH = 2;
constexpr int PLE = 256;
constexpr float EPS = 1e-6f;
constexpr int FFN = 2816, NE = 8, EXD = 3584;
constexpr int C_DNZ = 2304, C_DNA = 3072, C_DNB = 3078, C_XBC = 3084, C_SSZ = 4364, C_SSDT = 5132, C_ATT = 5144, C_GATE = 7448, INW = 10520;
constexpr int NB = 8, TC = NB * SEQ, NCH = BATCH / NB;
constexpr int INP = 10752;
constexpr int MOE_SLOTS = 2 * TC + NE * 256;

constexpr size_t MiB = 1u << 20;
constexpr size_t WS_CTL = 0;
constexpr size_t WS_WIN = 1 * MiB;
constexpr size_t WS_WDN = WS_WIN + 42 * MiB;
constexpr size_t WS_WSSM = WS_WDN + 3 * MiB;
constexpr size_t WS_WATT = WS_WSSM + 3 * MiB;
constexpr size_t WS_WOUT = WS_WATT + 1 * MiB;
constexpr size_t WS_WFGU = WS_WOUT + 4 * MiB;
constexpr size_t WS_WFD = WS_WFGU + 11 * MiB;
constexpr size_t WS_WMGU = WS_WFD + 6 * MiB;
constexpr size_t WS_WMD = WS_WMGU + 112 * MiB;
constexpr size_t WS_WPG = WS_WMD + 56 * MiB;
constexpr size_t WS_WPLE = WS_WPG + 4 * MiB;
constexpr size_t WS_WR = WS_WPLE + 1 * MiB;
constexpr size_t WS_ACT0 = WS_WR + 1 * MiB;
constexpr size_t WS_XB = WS_ACT0;
constexpr size_t WS_SSQ = WS_XB + 32 * MiB;
constexpr size_t WS_PB = WS_SSQ + 1 * MiB;
constexpr size_t WS_ROUTE = WS_PB + 16 * MiB;
constexpr size_t WS_PART = WS_ROUTE + 1 * MiB;
constexpr size_t WS_PP = WS_PART;
constexpr size_t WS_MERGED = WS_PART + 64 * MiB;
constexpr size_t WS_Y = WS_MERGED + 32 * MiB;
constexpr size_t WS_YDN = WS_Y, WS_YSSM = WS_Y + 24 * MiB, WS_YATT = WS_Y + 48 * MiB, WS_OG = WS_Y + 56 * MiB, WS_LSE = WS_Y + 80 * MiB;
constexpr size_t WS_YPAIR = WS_Y;
constexpr size_t WS_PROJ = WS_Y + 81 * MiB;
constexpr size_t WS_PDN = WS_PROJ, WS_PSSM = WS_PDN + 96 * MiB, WS_SMALL = WS_PSSM + 64 * MiB, WS_QK = WS_SMALL + 2 * MiB, WS_VT = WS_QK + 48 * MiB, WS_GATES = WS_VT + 24 * MiB;
constexpr size_t WS_ACT = WS_PROJ, WS_ACTM = WS_PROJ;
constexpr int KSPL = 7, TAILMAX = 32;
constexpr size_t WS_PARTK = WS_PROJ + 256 * MiB;
static_assert((size_t)MOE_SLOTS * EXD * 2 <= 256 * MiB && WS_PARTK + (size_t)KSPL * (TAILMAX / 4) * 256 * 1024 * 4 <= WS_PROJ + 330 * MiB, "partk");
constexpr size_t WS_SCR = WS_PROJ + 330 * MiB;
constexpr size_t WS_XB2 = WS_SCR;
constexpr size_t WS_SSQ2 = WS_XB2 + 32 * MiB;
constexpr size_t WS_PART2 = WS_XB2 + 40 * MiB;
constexpr int DNS_ITEM = 73728;
constexpr size_t WS_DNS = WS_SCR + 40 * MiB;
constexpr size_t WS_DNEGL = WS_DNS + (size_t)NB * 32 * 6 * DNS_ITEM;
constexpr size_t WS_END = WS_SCR + 200 * MiB;
constexpr size_t WS_SSCD = WS_DNEGL + 8192;
static_assert(WS_SSCD + 16384 <= WS_END, "dn scratch");
constexpr size_t WS_SSPV = WS_SCR + 150 * MiB;
static_assert(WS_SSCD + 16384 <= WS_SSPV && WS_SSPV + 48 * MiB <= WS_END, "ssd prev");
constexpr size_t WS_SSST = WS_PART + 48 * MiB;
static_assert(WS_MERGED == WS_PART + 64 * MiB && (size_t)NB * 32 * 12 * 8192 * 2 <= 48 * MiB, "ssd states (bf16) sit in PART[48, 64) | MERGED, both idle during the mixers");
static_assert((size_t)MOE_SLOTS * EXD * 2 <= 330 * MiB, "moe act overlay");
static_assert((size_t)MOE_SLOTS * D * 2 <= 81 * MiB, "ypair overlay");
static_assert(WS_END <= 1024 * MiB, "workspace");
constexpr int RT_TOPE = 0, RT_TOPP = 2 * TC, RT_TOPW = 4 * TC, RT_TOPS = 6 * TC, RT_IDX = 8 * TC;
static_assert((size_t)(RT_IDX + MOE_SLOTS) * 4 <= MiB, "route");
constexpr int CW_BAR = 4096;
constexpr int CW_BAR2 = 8192;
constexpr int CW_SUB = 20480;
constexpr int CW_CNT = 16384;

constexpr int LDS_BYTES = 147456;
__device__ __forceinline__ int htid() { int t = threadIdx.x; asm volatile("" : "+v"(t)); return t; }
__device__ __forceinline__ float bf2f(bf16_t b) { return __uint_as_float(((unsigned)b) << 16); }
__device__ __forceinline__ unsigned f2bf(float f) { unsigned u = __float_as_uint(f); return (u + 0x7fffu + ((u >> 16) & 1u)) >> 16; }
typedef __bf16 bf16x2_t __attribute__((ext_vector_type(2)));
__device__ __forceinline__ unsigned pk2(float lo, float hi) { const f32x2 v = {lo, hi}; return __builtin_bit_cast(unsigned, __builtin_convertvector(v, bf16x2_t)); }
#define ST2_BF(PA, PB, A, B) do { const unsigned pw_ = pk2((A), (B)); *(PA) = (bf16_t)(pw_ & 0xffffu); *(PB) = (bf16_t)(pw_ >> 16); } while (0)
__device__ __forceinline__ float lo_bf(unsigned w) { return __uint_as_float(w << 16); }
__device__ __forceinline__ float hi_bf(unsigned w) { return __uint_as_float(w & 0xffff0000u); }
__device__ __forceinline__ float fexp(float x) { return __builtin_amdgcn_exp2f(x * 1.4426950408889634f); }
__device__ __forceinline__ float sigmoidf_(float x) { return __builtin_amdgcn_rcpf(1.f + fexp(-x)); }
__device__ __forceinline__ float siluf_(float x) { return x * sigmoidf_(x); }
__device__ __forceinline__ float softplusf_(float x) { const float e = fexp(x); return x > 20.f ? x : (x < -9.f ? e : __builtin_amdgcn_logf(1.f + e) * 0.6931471805599453f); }
__device__ __forceinline__ float q8(float v) {
    if (!EMU_FP8) return v;
    const float a = fabsf(v); float r;
    if (a < 0.015625f) r = rintf(a * 512.f) * (1.f / 512.f);
    else { unsigned u = __float_as_uint(a); u += 0x7FFFFu + ((u >> 20) & 1u); u &= ~0xFFFFFu; r = fminf(__uint_as_float(u), 448.f); }
    return copysignf(r, v);
}
__device__ __forceinline__ f32x4 q8v(f32x4 v) { return (f32x4){q8(v[0]), q8(v[1]), q8(v[2]), q8(v[3])}; }
__device__ __forceinline__ float wave_sum(float v) {
#pragma unroll
    for (int o = 1; o < 64; o <<= 1) v += __shfl_xor(v, o);
    return v;
}
__device__ __forceinline__ float wave_max(float v) {
#pragma unroll
    for (int o = 1; o < 64; o <<= 1) v = fmaxf(v, __shfl_xor(v, o));
    return v;
}
__device__ __forceinline__ float rstd_of(const float* ssq, int row) {
    const f32x4* p = (const f32x4*)(ssq + (size_t)row * 16);
    const f32x4 a = p[0], b = p[1], c = p[2], d = p[3];
    const float s = (((a.x + a.y) + (a.z + a.w)) + ((b.x + b.y) + (b.z + b.w))) + (((c.x + c.y) + (c.z + c.w)) + ((d.x + d.y) + (d.z + d.w)));
    return rsqrtf(s * (1.f / 1024.f) + EPS);
}
__device__ __forceinline__ int token_of_pos(int d, int p) {
    const int b = p >> 11, q = p & 2047;
    const int t = (d == 1) ? q : (d == 4) ? (4 * (q & 511) + (q >> 9)) : (16 * (q & 127) + (q >> 7));
    return b * 2048 + t;
}

#define XB_TMO      128
#define XB_XCNT(j)  (256  + 64 * (j))
#define XB_XSUB(j)  (1280 + 64 * (j))
#define XB_XGEN(j)  (2304 + 64 * (j))
#define XB_TOP      3328
#define XB_TOPGEN   3392
#define XCD_BAR_WORDS 3456
#define XB_SPIN_CAP (1u << 22)
__device__ __forceinline__ unsigned xb_ld(unsigned* p)              { return __hip_atomic_load(p, __ATOMIC_RELAXED, __HIP_MEMORY_SCOPE_AGENT); }
__device__ __forceinline__ unsigned xb_add(unsigned* p, unsigned v) { return __hip_atomic_fetch_add(p, v, __ATOMIC_RELAXED, __HIP_MEMORY_SCOPE_AGENT); }
__device__ __forceinline__ unsigned xb_xcc_id() { return (unsigned)__builtin_amdgcn_s_getreg((3 << 11) | 20) & 0xFu; }
#define XB_SPIN(cond, bar) do { unsigned _sp = 0; while (cond) { __builtin_amdgcn_s_sleep(1); \
    if ((++_sp & 255u) == 0u) { if (xb_ld(&(bar)[XB_TMO])) break; if (_sp > XB_SPIN_CAP) { atomicAdd(&(bar)[XB_TMO], 1u); break; } } } } while (0)
struct XcdBarrier { unsigned* bar; unsigned x; volatile LAS unsigned* st; };
__device__ __forceinline__ XcdBarrier xcd_barrier_post(unsigned* bar, volatile LAS unsigned* st) {
    XcdBarrier b; b.bar = bar; b.x = xb_xcc_id(); b.st = st;
    if (threadIdx.x == 0) (void)xb_add(&bar[XB_XCNT(b.x)], 1u);
    return b;
}
__device__ __forceinline__ void xcd_barrier_complete(unsigned* bar, unsigned x, unsigned& nloc, unsigned& nx, unsigned G) {
    unsigned sum, cnt, mine, sp = 0u;
    for (;;) {
        sum = 0u; cnt = 0u; mine = 0u;
#pragma unroll 1
        for (unsigned j = 0; j < 16; ++j) { const unsigned c = xb_ld(&bar[XB_XCNT(j)]); sum += c; cnt += (c > 0u) ? 1u : 0u; }
        mine = xb_ld(&bar[XB_XCNT(x)]);
        if (sum == G) break;
        __builtin_amdgcn_s_sleep(1);
        if ((++sp & 255u) == 0u) { if (xb_ld(&bar[XB_TMO])) break; if (sp > XB_SPIN_CAP) { atomicAdd(&bar[XB_TMO], 1u); break; } }
    }
    nloc = mine > 0u ? mine : 1u; nx = cnt > 0u ? cnt : 1u;
}
__device__ __forceinline__ void xcd_barrier(const XcdBarrier& b, unsigned nparts = 0u) {
    asm volatile("s_waitcnt vmcnt(0)" ::: "memory");
    __syncthreads();
    if (threadIdx.x == 0) {
        unsigned* bar = b.bar;
        __builtin_amdgcn_s_waitcnt(0);
        unsigned nloc = b.st[0], nx = b.st[1];
        if (nloc == 0u) { xcd_barrier_complete(bar, b.x, nloc, nx, nparts ? nparts : gridDim.x * gridDim.y * gridDim.z); b.st[0] = nloc; b.st[1] = nx; }
        const unsigned old = xb_add(&bar[XB_XSUB(b.x)], 1u);
        const unsigned gen = old / nloc;
        if (old + 1u == (gen + 1u) * nloc) {
            __builtin_amdgcn_fence(__ATOMIC_RELEASE, "agent");
            asm volatile("s_waitcnt vmcnt(0)" ::: "memory");
            const unsigned og = xb_add(&bar[XB_TOP], 1u);
            const unsigned tg = og / nx;
            if (og + 1u == (tg + 1u) * nx) xb_add(&bar[XB_TOPGEN], 1u);
            else XB_SPIN(xb_ld(&bar[XB_TOPGEN]) == tg, bar);
            __builtin_amdgcn_fence(__ATOMIC_ACQUIRE, "agent");
            xb_add(&bar[XB_XGEN(b.x)], 1u);
            asm volatile("s_waitcnt vmcnt(0)" ::: "memory");
        } else {
            XB_SPIN(xb_ld(&bar[XB_XGEN(b.x)]) == gen, bar);
            __builtin_amdgcn_fence(__ATOMIC_ACQUIRE, "agent");
            asm volatile("s_waitcnt vmcnt(0)" ::: "memory");
        }
    }
    __syncthreads();
}

constexpr int BM = 256, BK = 64, HALF = 128, HTB = HALF * BK * 2, STAGE_BYTES = 8 * HTB, NXCD = 8, WGM = 4;
__device__ __forceinline__ int lds_byte(int r, int c) { const int st = (r >> 4) * 2 + (c >> 5), rr = r & 15, cc = c & 31, ob = rr * 64 + cc * 2; return st * 1024 + (ob ^ (((ob >> 9) & 1) << 5)); }
__device__ __forceinline__ void stage_rc(int b, int& R, int& C) { const int st = b / 1024, sb = b % 1024, swz = sb ^ (((sb >> 9) & 1) << 5); R = (st >> 1) * 16 + swz / 64; C = (st & 1) * 32 + (swz % 64) / 2; }
__device__ __forceinline__ int perm32(int rho) { const int n = rho >> 4, i = rho & 15; return 8 * (i >> 2) + 4 * n + (i & 3); }

struct Unit { int pm, pn; };
struct StaticOrder {
    int nM, nN, nwg, G, c;
    __device__ __forceinline__ void init(int nM_, int nN_, int G_, int c_) { nM = nM_; nN = nN_; nwg = nM * nN; G = G_; c = c_; }
    __device__ __forceinline__ bool next(int i, Unit& u) const {
        const long L = (long)i * G + c; if (L >= nwg) return false;
        int wgid = (int)L; { const int q = nwg / NXCD, r = nwg % NXCD, xcd = wgid % NXCD, off = wgid / NXCD; wgid = (xcd < r ? xcd * (q + 1) : r * (q + 1) + (xcd - r) * q) + off; }
        const int nig = WGM * nN, gid = wgid / nig, fm = gid * WGM, gsz = (nM - fm) < WGM ? (nM - fm) : WGM;
        u.pm = fm + ((wgid % nig) % gsz); u.pn = (wgid % nig) / gsz; return true;
    }
};
struct GU { const char* A; const char* B; int lda, ldb, nt, mapA, mapB; const int* idx; int pm, pn, sub, aux; };
__device__ __forceinline__ unsigned row_off(int map, int RR, int ld, const int* idx) {
    int row;
    if (map == 0) row = RR;
    else if (map == 4) row = 4 * RR;
    else if (map == 16) row = 16 * (RR & 127) + (RR >> 7);
    else row = idx[RR];
    return (unsigned)row * (unsigned)ld;
}
template <class Prog>
__device__ __forceinline__ void gemm_phase(LAS unsigned char* lds, const Prog& P) {
    const int tid = htid(), wid = __builtin_amdgcn_readfirstlane(tid >> 6), lane = tid & 63, wr = wid >> 2, wc = wid & 3, fr = lane & 15, fq = lane >> 4;
    GU cur, nxt; int ui = 0;
    if (!P.unit(0, cur)) return;
    unsigned vA[4], vB[4];
#define G_SETV(u) do { int tz_ = threadIdx.x; asm volatile("" : "+v"(tz_)); int R0, C0, R1, C1; stage_rc(tz_ * 16, R0, C0); stage_rc(tz_ * 16 + 8192, R1, C1); \
        const int Rb0 = (R0 & ~31) + perm32(R0 & 31), Rb1 = (R1 & ~31) + perm32(R1 & 31); \
        vA[0] = row_off((u).mapA, R0, (u).lda, (u).idx) + C0 * 2; vA[1] = row_off((u).mapA, R1, (u).lda, (u).idx) + C1 * 2; \
        vA[2] = row_off((u).mapA, R0 + 128, (u).lda, (u).idx) + C0 * 2; vA[3] = row_off((u).mapA, R1 + 128, (u).lda, (u).idx) + C1 * 2; \
        vB[0] = row_off((u).mapB, Rb0, (u).ldb, nullptr) + C0 * 2; vB[1] = row_off((u).mapB, Rb1, (u).ldb, nullptr) + C1 * 2; \
        vB[2] = row_off((u).mapB, Rb0 + 128, (u).ldb, nullptr) + C0 * 2; vB[3] = row_off((u).mapB, Rb1 + 128, (u).ldb, nullptr) + C1 * 2; } while (0)
    G_SETV(cur);
    const unsigned ldsw = (unsigned)wid * 1024u;
    const int aoff = lds_byte(wr * 64 + fr, fq * 8), boff = lds_byte(wc * 32 + fr, fq * 8);
#define G_SA(b, h) (((b) * 2 + (h)) * HTB)
#define G_SB(b, h) ((4 + (b) * 2 + (h)) * HTB)
#define G_STAGE(bufoff, gbase, v, h) do { \
        __builtin_amdgcn_global_load_lds((const unsigned*)((gbase) + (v)[2 * (h)]), (LAS unsigned*)(lds + (bufoff) + ldsw), 16, 0, 0); \
        __builtin_amdgcn_global_load_lds((const unsigned*)((gbase) + (v)[2 * (h) + 1]), (LAS unsigned*)(lds + (bufoff) + ldsw + 8192), 16, 0, 0); } while (0)
#define G_LDA(dst, b, h) do { _Pragma("unroll") for (int m = 0; m < 4; ++m) _Pragma("unroll") for (int k = 0; k < 2; ++k) dst[m][k] = *(const LAS bf16x8*)(lds + G_SA(b, h) + aoff + m * 2048 + k * 1024); } while (0)
#define G_LDB(dst, b, h) do { _Pragma("unroll") for (int n = 0; n < 2; ++n) _Pragma("unroll") for (int k = 0; k < 2; ++k) dst[n][k] = *(const LAS bf16x8*)(lds + G_SB(b, h) + boff + n * 2048 + k * 1024); } while (0)
#define G_MMA(ai, bj, At, Bt) do { __builtin_amdgcn_s_setprio(1); _Pragma("unroll") for (int m = 0; m < 4; ++m) _Pragma("unroll") for (int n = 0; n < 2; ++n) _Pragma("unroll") for (int k = 0; k < 2; ++k) \
        acc[ai][bj][m][n] = __builtin_amdgcn_mfma_f32_16x16x32_bf16(Bt[n][k], At[m][k], acc[ai][bj][m][n], 0, 0, 0); __builtin_amdgcn_s_setprio(0); } while (0)
#define G_WAIT_V(n) asm volatile("s_waitcnt vmcnt(" #n ")" ::: "memory")
#define G_WAIT_L(n) asm volatile("s_waitcnt lgkmcnt(" #n ")" ::: "memory")
#define G_BAR __builtin_amdgcn_s_barrier()
#define G_SCHED __builtin_amdgcn_sched_barrier(0)
    f32x4 acc[2][2][4][2];
#pragma unroll
    for (int a = 0; a < 2; ++a)
#pragma unroll
        for (int b = 0; b < 2; ++b)
#pragma unroll
            for (int m = 0; m < 4; ++m)
#pragma unroll
                for (int n = 0; n < 2; ++n) acc[a][b][m][n] = (f32x4){0.f, 0.f, 0.f, 0.f};
    bf16x8 At[4][2], B0[2][2], B1[2][2];
    const char* cA = cur.A; const char* cB = cur.B;
    const size_t kstep = (size_t)(BK * 2);
    G_STAGE(G_SB(0, 0), cB, vB, 0); G_STAGE(G_SA(0, 0), cA, vA, 0); G_STAGE(G_SB(0, 1), cB, vB, 1); G_STAGE(G_SA(0, 1), cA, vA, 1);
    if (wr == 1) G_BAR;
    G_WAIT_V(4); G_BAR;
    G_STAGE(G_SB(1, 0), cB + kstep, vB, 0); G_STAGE(G_SA(1, 0), cA + kstep, vA, 0); G_STAGE(G_SB(1, 1), cB + kstep, vB, 1);
    G_WAIT_V(6); G_BAR;
    for (;;) {
        const bool has_next = P.unit(ui + 1, nxt);
        const char* nA = has_next ? nxt.A : cA; const char* nB = has_next ? nxt.B : cB;
        const int nt = cur.nt;
        for (int t = 0; t < nt; t += 2) {
            const bool last = (t == nt - 2);
            const char* a1 = cA + (size_t)(t + 1) * kstep;
            const char* a2 = last ? nA : cA + (size_t)(t + 2) * kstep; const char* b2 = last ? nB : cB + (size_t)(t + 2) * kstep;
            const char* a3 = a2 + kstep; const char* b3 = b2 + kstep;
            G_STAGE(G_SA(1, 1), a1, vA, 1);
            if (last && has_next) { G_SETV(nxt); }
            G_LDB(B0, 0, 0); G_SCHED; G_LDA(At, 0, 0);
            G_WAIT_L(8); G_BAR; G_WAIT_L(0); G_MMA(0, 0, At, B0); G_BAR; G_SCHED;
            G_LDB(B1, 0, 1); G_STAGE(G_SB(0, 0), b2, vB, 0);
            G_BAR; G_WAIT_L(0); G_MMA(0, 1, At, B1); G_BAR;
            G_LDA(At, 0, 1); G_STAGE(G_SA(0, 0), a2, vA, 0);
            G_BAR; G_WAIT_L(0); G_MMA(1, 0, At, B0); G_BAR; G_SCHED;
            G_STAGE(G_SB(0, 1), b2, vB, 1);
            G_WAIT_V(6); G_BAR; G_MMA(1, 1, At, B1); G_BAR;
            G_LDB(B0, 1, 0); G_SCHED; G_LDA(At, 1, 0); G_STAGE(G_SA(0, 1), a2, vA, 1);
            G_WAIT_L(8); G_BAR; G_WAIT_L(0); G_MMA(0, 0, At, B0); G_BAR; G_SCHED;
            G_LDB(B1, 1, 1); G_STAGE(G_SB(1, 0), b3, vB, 0);
            G_BAR; G_WAIT_L(0); G_MMA(0, 1, At, B1); G_BAR;
            G_LDA(At, 1, 1); G_STAGE(G_SA(1, 0), a3, vA, 0);
            G_BAR; G_WAIT_L(0); G_MMA(1, 0, At, B0); G_BAR; G_SCHED;
            G_STAGE(G_SB(1, 1), b3, vB, 1);
            G_WAIT_V(6); G_BAR; G_MMA(1, 1, At, B1); G_BAR;
        }
        { int tz_ = threadIdx.x; asm volatile("" : "+v"(tz_)); const int ln_ = tz_ & 63; P.epi(acc, cur, wr, wc, ln_ & 15, ln_ >> 4); }
        if (!has_next) break;
        if (!P.keep(cur))
#pragma unroll
        for (int a = 0; a < 2; ++a)
#pragma unroll
            for (int b = 0; b < 2; ++b)
#pragma unroll
                for (int m = 0; m < 4; ++m)
#pragma unroll
                    for (int n = 0; n < 2; ++n) acc[a][b][m][n] = (f32x4){0.f, 0.f, 0.f, 0.f};
        cur = nxt; cA = nA; cB = nB; ++ui;
    }
    G_WAIT_V(0);
    if (wr == 0) G_BAR;
    G_BAR;
#undef G_SETV
#undef G_SA
#undef G_SB
#undef G_STAGE
#undef G_LDA
#undef G_LDB
#undef G_MMA
#undef G_WAIT_V
#undef G_WAIT_L
#undef G_BAR
#undef G_SCHED
}

__device__ __forceinline__ void st_bf8(bf16_t* p, const f32x4 a, const f32x4 b) {
    u32x4 w; w.x = pk2(a[0], a[1]); w.y = pk2(a[2], a[3]); w.z = pk2(b[0], b[1]); w.w = pk2(b[2], b[3]);
    *(u32x4*)p = w;
}
__device__ __forceinline__ void ld_bf8(const bf16_t* p, f32x4& a, f32x4& b) {
    const u32x4 w = *(const u32x4*)p;
    a = (f32x4){lo_bf(w.x), hi_bf(w.x), lo_bf(w.y), hi_bf(w.y)}; b = (f32x4){lo_bf(w.z), hi_bf(w.z), lo_bf(w.w), hi_bf(w.w)};
}
__device__ __forceinline__ float sq8(const f32x4 a, const f32x4 b) { return ((a[0] * a[0] + a[1] * a[1]) + (a[2] * a[2] + a[3] * a[3])) + ((b[0] * b[0] + b[1] * b[1]) + (b[2] * b[2] + b[3] * b[3])); }

#define EPI_ROWS(ai, m) _Pragma("unroll") for (int ai = 0; ai < 2; ++ai) _Pragma("unroll") for (int m = 0; m < 4; ++m)
#define EPI_FENCE asm volatile("" ::: "memory")
#define EPI_SC(ai, m) __shfl((ai) ? r1_ : r0_, (m) * 16 + fr)

struct ProgIn {
    __device__ __forceinline__ bool keep(const GU&) const { return false; }
    StaticOrder S; const bf16_t* xb; const bf16_t* Wt; const float* ssq; unsigned char* wsb;
    const bf16_t* pb; const bf16_t* wple;
    __device__ __forceinline__ bool unit(int i, GU& u) const {
        Unit t;
        if (!S.next(i, t)) {
            const int rem = S.nwg % S.G, nfull = S.nwg / S.G, idle = rem == 0 ? S.G : S.G - rem, per = (256 + idle - 1) / idle;
            const int rk = rem == 0 ? S.c : S.c - rem, k = i - nfull;
            if (rk < 0 || k < 0 || k >= per) return false;
            const int pu = rk * per + k; if (pu >= 256) return false;
            u.pm = pu >> 2; u.pn = 64 + (pu & 3); u.sub = 0; u.aux = 0; u.nt = 4; u.idx = nullptr; u.lda = 512; u.ldb = 512; u.mapA = 0; u.mapB = 0;
            u.A = (const char*)pb + (size_t)(pu >> 2) * 256 * 512; u.B = (const char*)wple + (size_t)(pu & 3) * 256 * 512; return true;
        }
        u.pm = t.pm; u.pn = t.pn; u.sub = 0; u.aux = 0; u.nt = 16; u.idx = nullptr; u.lda = 2048; u.ldb = 2048;
        const char* w = (const char*)Wt + (size_t)t.pn * 256 * 2048;
        int g = 0; bool isvt = false;
        if (t.pn >= 20 && t.pn < 29) { g = (t.pn - 20) % 3; isvt = t.pn >= 26; }
        const int d = g == 0 ? 1 : (g == 1 ? 4 : 16);
        const int b = t.pm >> 3, tb = t.pm & 7;
        const int base = b * 2048 + (d == 1 ? 256 * tb : d == 4 ? 1024 * (tb & 1) + (tb >> 1) : 2 * tb);
        const char* x = (const char*)xb + (size_t)base * 2048;
        const int mapx = d == 1 ? 0 : d;
        if (!isvt) { u.A = x; u.mapA = mapx; u.B = w; u.mapB = 0; }
        else { u.A = w; u.mapA = 0; u.B = x; u.mapB = mapx; }
        return true;
    }
    __device__ __forceinline__ void epi(f32x4 (&acc)[2][2][4][2], const GU& u, int wr, int wc, int fr, int fq) const {
        const int pn = u.pn, pm = u.pm, rl0 = wr * 64 + fr, cl0 = wc * 32 + 8 * fq;
        if (pn >= 64) {
            EPI_ROWS(ai, m) { bf16_t* o = (bf16_t*)(wsb + WS_PP) + (size_t)(pm * 256 + ai * 128 + m * 16 + rl0) * 1024 + (pn - 64) * 256 + cl0;
#pragma unroll
                for (int bj = 0; bj < 2; ++bj) st_bf8(o + bj * 128, acc[ai][bj][m][0], acc[ai][bj][m][1]); }
            return;
        }
        if (pn >= 26 && pn < 29) {
            const int g = pn - 26, d = g == 0 ? 1 : (g == 1 ? 4 : 16), ln = fq * 16 + fr;
            const float rc = rstd_of(ssq, token_of_pos(d, pm * 256 + (ln >> 5) * 128 + wc * 32 + (ln & 31)));
            f32x4 s[2][2];
#pragma unroll
            for (int bj = 0; bj < 2; ++bj)
#pragma unroll
                for (int j = 0; j < 8; ++j) s[bj][j >> 2][j & 3] = __shfl(rc, bj * 32 + 8 * fq + j);
            EPI_ROWS(ai, m) { const int ch = ai * 128 + m * 16 + rl0; bf16_t* o = (bf16_t*)(wsb + WS_VT) + (size_t)(g * 256 + ch) * TC + pm * 256 + cl0;
#pragma unroll
                for (int bj = 0; bj < 2; ++bj) st_bf8(o + bj * 128, acc[ai][bj][m][0] * s[bj][0], acc[ai][bj][m][1] * s[bj][1]); }
            return;
        }
        int d = 1; if (pn >= 20 && pn < 26) { const int g = (pn - 20) % 3; d = g == 0 ? 1 : (g == 1 ? 4 : 16); }
        const float r0_ = rstd_of(ssq, token_of_pos(d, pm * 256 + fq * 16 + rl0)), r1_ = rstd_of(ssq, token_of_pos(d, pm * 256 + 128 + fq * 16 + rl0));
        if (pn < 20) {
            bf16_t* base = pn < 12 ? (bf16_t*)(wsb + WS_PDN) + pn * 256 : (bf16_t*)(wsb + WS_PSSM) + (pn - 12) * 256; const int ld = pn < 12 ? 3072 : 2048;
            EPI_ROWS(ai, m) { const int row = pm * 256 + ai * 128 + m * 16 + rl0; const float s = EPI_SC(ai, m); bf16_t* o = base + (size_t)row * ld + cl0;
#pragma unroll
                for (int bj = 0; bj < 2; ++bj) st_bf8(o + bj * 128, acc[ai][bj][m][0] * s, acc[ai][bj][m][1] * s); }
        } else if (pn < 26) {
            const int which = (pn - 20) / 3, g = (pn - 20) % 3; const float qs = which == 0 ? 0.125f : 1.f;
            bf16_t* base = (bf16_t*)(wsb + WS_QK) + (size_t)(which * 3 + g) * TC * 256;
            EPI_ROWS(ai, m) { const int p = pm * 256 + ai * 128 + m * 16 + rl0; const float s = EPI_SC(ai, m) * qs; bf16_t* o = base + (size_t)p * 256 + cl0;
#pragma unroll
                for (int bj = 0; bj < 2; ++bj) st_bf8(o + bj * 128, acc[ai][bj][m][0] * s, acc[ai][bj][m][1] * s); }
        } else if (pn < 41) {
            bf16_t* base = (bf16_t*)(wsb + WS_GATES) + (pn - 29) * 256;
            EPI_ROWS(ai, m) { const int row = pm * 256 + ai * 128 + m * 16 + rl0; const float s = EPI_SC(ai, m); bf16_t* o = base + (size_t)row * 3072 + cl0;
#pragma unroll
                for (int bj = 0; bj < 2; ++bj) { f32x4 a = acc[ai][bj][m][0] * s, b = acc[ai][bj][m][1] * s;
#pragma unroll
                    for (int j = 0; j < 4; ++j) { a[j] = sigmoidf_(a[j]); b[j] = sigmoidf_(b[j]); }
                    st_bf8(o + bj * 128, a, b); } }
        } else {
            EPI_ROWS(ai, m) { const int row = pm * 256 + ai * 128 + m * 16 + rl0; const float s = EPI_SC(ai, m);
                if (wc == 0) { float* o = (float*)(wsb + WS_SMALL) + (size_t)row * 32 + 8 * fq; *(f32x4*)o = acc[ai][0][m][0] * s; *(f32x4*)(o + 4) = acc[ai][0][m][1] * s; } }
        }
    }
};

struct ProgMerge {
    StaticOrder S; const bf16_t *wdn, *wssm, *watt; unsigned char* wsb;
    __device__ __forceinline__ bool keep(const GU& u) const { return u.sub < 2; }
    __device__ __forceinline__ bool unit(int i, GU& u) const {
        Unit t; if (!S.next(i / 3, t)) return false;
        const int sub = i % 3;
        u.pm = t.pm; u.pn = t.pn; u.sub = sub; u.aux = 0; u.idx = nullptr; u.mapA = 0; u.mapB = 0;
        if (sub < 2) { u.lda = 1536; u.ldb = 1536; u.nt = 12; u.A = (const char*)(wsb + (sub == 0 ? WS_YDN : WS_YSSM)) + (size_t)t.pm * 256 * 1536; u.B = (const char*)(sub == 0 ? wdn : wssm) + (size_t)t.pn * 256 * 1536; }
        else { u.lda = 512; u.ldb = 512; u.nt = 4; u.A = (const char*)(wsb + WS_YATT) + (size_t)t.pm * 256 * 512; u.B = (const char*)watt + (size_t)t.pn * 256 * 512; }
        return true;
    }
    __device__ __forceinline__ void epi(f32x4 (&acc)[2][2][4][2], const GU& u, int wr, int wc, int fr, int fq) const {
        const int rl0 = wr * 64 + fr, cl0 = wc * 32 + 8 * fq, sub = u.sub;
        const bf16_t* gp0 = (const bf16_t*)(wsb + WS_GATES) + (size_t)(u.pm * 256 + rl0) * 3072 + u.pn * 256 + cl0 + sub * 1024;
#pragma unroll
        for (int ai = 0; ai < 2; ++ai) {
            u32x4 gw[4][2], hw[4][2];
            if (sub < 2) {
#pragma unroll
                for (int m = 0; m < 4; ++m)
#pragma unroll
                    for (int bj = 0; bj < 2; ++bj) { const bf16_t* gp = gp0 + (size_t)(ai * 128 + m * 16) * 3072 + bj * 128; gw[m][bj] = *(const u32x4*)gp; hw[m][bj] = *(const u32x4*)(gp + 1024); }
            } else {
#pragma unroll
                for (int m = 0; m < 4; ++m)
#pragma unroll
                    for (int bj = 0; bj < 2; ++bj) { const bf16_t* gp = gp0 + (size_t)(ai * 128 + m * 16) * 3072 + bj * 128; gw[m][bj] = *(const u32x4*)gp; hw[m][bj] = gw[m][bj]; }
            }
#pragma unroll
            for (int m = 0; m < 4; ++m)
#pragma unroll
                for (int bj = 0; bj < 2; ++bj) { const int row = u.pm * 256 + ai * 128 + m * 16 + rl0, col = u.pn * 256 + bj * 128 + cl0;
                    f32x4 g0 = (f32x4){lo_bf(gw[m][bj].x), hi_bf(gw[m][bj].x), lo_bf(gw[m][bj].y), hi_bf(gw[m][bj].y)}, g1 = (f32x4){lo_bf(gw[m][bj].z), hi_bf(gw[m][bj].z), lo_bf(gw[m][bj].w), hi_bf(gw[m][bj].w)};
                    if ((DBG_ABL >> sub) & 1) { acc[ai][bj][m][0] = (f32x4){0.f, 0.f, 0.f, 0.f}; acc[ai][bj][m][1] = acc[ai][bj][m][0]; }
#pragma unroll
                    for (int j = 0; j < 4; ++j) { g0[j] = fmaxf(g0[j], 1e-8f); g1[j] = fmaxf(g1[j], 1e-8f); }
                    if (sub < 2) { const f32x4 h0 = (f32x4){lo_bf(hw[m][bj].x), hi_bf(hw[m][bj].x), lo_bf(hw[m][bj].y), hi_bf(hw[m][bj].y)}, h1 = (f32x4){lo_bf(hw[m][bj].z), hi_bf(hw[m][bj].z), lo_bf(hw[m][bj].w), hi_bf(hw[m][bj].w)};
#pragma unroll
                        for (int j = 0; j < 4; ++j) { acc[ai][bj][m][0][j] *= g0[j] * __builtin_amdgcn_rcpf(fmaxf(h0[j], 1e-8f)); acc[ai][bj][m][1][j] *= g1[j] * __builtin_amdgcn_rcpf(fmaxf(h1[j], 1e-8f)); } }
                    else st_bf8((bf16_t*)(wsb + WS_MERGED) + (size_t)row * 1024 + col, acc[ai][bj][m][0] * g0, acc[ai][bj][m][1] * g1); }
            EPI_FENCE;
        }
    }
};

struct ProgResid {
    __device__ __forceinline__ bool keep(const GU&) const { return false; }
    StaticOrder S; const bf16_t* A; int lda, nt; const bf16_t* Wt; int ldb; const float* xin_f; const bf16_t* xin_b; bf16_t* xb; float* ssq; float sc;
    __device__ __forceinline__ bool unit(int i, GU& u) const {
        Unit t; if (!S.next(i, t)) return false;
        u.pm = t.pm; u.pn = t.pn; u.sub = 0; u.aux = 0; u.idx = nullptr; u.mapA = 0; u.mapB = 0; u.lda = lda; u.ldb = ldb; u.nt = nt;
        u.A = (const char*)A + (size_t)t.pm * 256 * lda; u.B = (const char*)Wt + (size_t)t.pn * 256 * ldb; return true;
    }
    __device__ __forceinline__ void epi(f32x4 (&acc)[2][2][4][2], const GU& u, int wr, int wc, int fr, int fq) const {
        const int rl0 = wr * 64 + fr, cl0 = wc * 32 + 8 * fq;
#pragma unroll
        for (int ai = 0; ai < 2; ++ai) {
            f32x4 xv[4][2][2];
            if (xin_f) {
#pragma unroll
                for (int m = 0; m < 4; ++m)
#pragma unroll
                    for (int bj = 0; bj < 2; ++bj) { const size_t o = (size_t)(u.pm * 256 + ai * 128 + m * 16 + rl0) * 1024 + u.pn * 256 + bj * 128 + cl0; xv[m][bj][0] = *(const f32x4*)(xin_f + o); xv[m][bj][1] = *(const f32x4*)(xin_f + o + 4); }
            } else {
                u32x4 xw[4][2];
#pragma unroll
                for (int m = 0; m < 4; ++m)
#pragma unroll
                    for (int bj = 0; bj < 2; ++bj) xw[m][bj] = *(const u32x4*)(xin_b + (size_t)(u.pm * 256 + ai * 128 + m * 16 + rl0) * 1024 + u.pn * 256 + bj * 128 + cl0);
#pragma unroll
                for (int m = 0; m < 4; ++m)
#pragma unroll
                    for (int bj = 0; bj < 2; ++bj) { const u32x4 w = xw[m][bj]; xv[m][bj][0] = (f32x4){lo_bf(w.x), hi_bf(w.x), lo_bf(w.y), hi_bf(w.y)}; xv[m][bj][1] = (f32x4){lo_bf(w.z), hi_bf(w.z), lo_bf(w.w), hi_bf(w.w)}; }
            }
#pragma unroll
            for (int m = 0; m < 4; ++m) { const int row = u.pm * 256 + ai * 128 + m * 16 + rl0; float ss = 0.f;
#pragma unroll
                for (int bj = 0; bj < 2; ++bj) { const size_t o = (size_t)row * 1024 + u.pn * 256 + bj * 128 + cl0;
                    const f32x4 v0 = acc[ai][bj][m][0] * sc + xv[m][bj][0], v1 = acc[ai][bj][m][1] * sc + xv[m][bj][1];
                    st_bf8(xb + o, v0, v1); ss += sq8(v0, v1); }
                ss += __shfl_xor(ss, 16); ss += __shfl_xor(ss, 32);
                if (fq == 0) ssq[(size_t)row * 16 + u.pn * 4 + wc] = ss; }
            EPI_FENCE;
        }
    }
};

struct ProgFfnGu {
    __device__ __forceinline__ bool keep(const GU&) const { return false; }
    StaticOrder S; const bf16_t* xb; const bf16_t* Wt; const float* ssq; bf16_t* act;
    __device__ __forceinline__ bool unit(int i, GU& u) const {
        Unit t; if (!S.next(i, t)) return false;
        u.pm = t.pm; u.pn = t.pn; u.sub = 0; u.aux = 0; u.idx = nullptr; u.mapA = 0; u.mapB = 0; u.lda = 2048; u.ldb = 2048; u.nt = 16;
        u.A = (const char*)xb + (size_t)t.pm * 256 * 2048; u.B = (const char*)Wt + (size_t)t.pn * 256 * 2048; return true;
    }
    __device__ __forceinline__ void epi(f32x4 (&acc)[2][2][4][2], const GU& u, int wr, int wc, int fr, int fq) const {
        const int rl0 = wr * 64 + fr, cl0 = wc * 32 + 8 * fq;
        const float r0_ = rstd_of(ssq, u.pm * 256 + fq * 16 + rl0), r1_ = rstd_of(ssq, u.pm * 256 + 128 + fq * 16 + rl0);
        EPI_ROWS(ai, m) { const int row = u.pm * 256 + ai * 128 + m * 16 + rl0; const float s = EPI_SC(ai, m);
            f32x4 o[2];
#pragma unroll
            for (int n = 0; n < 2; ++n)
#pragma unroll
                for (int j = 0; j < 4; ++j) { const float g = acc[ai][0][m][n][j] * s, up = acc[ai][1][m][n][j] * s; o[n][j] = q8(siluf_(g) * up); }
            st_bf8(act + (size_t)row * FFN + u.pn * 128 + cl0, o[0], o[1]); }
    }
};

struct ProgPle {
    __device__ __forceinline__ bool keep(const GU&) const { return false; }
    StaticOrder S; const bf16_t *xb, *wpg, *pp; const float* ssq; bf16_t* xbout; float* ssqout;
    __device__ __forceinline__ bool unit(int i, GU& u) const {
        Unit t; if (!S.next(i, t)) return false;
        u.pm = t.pm; u.pn = t.pn; u.sub = 0; u.aux = 0; u.idx = nullptr; u.mapA = 0; u.mapB = 0; u.lda = 2048; u.ldb = 2048; u.nt = 16;
        u.A = (const char*)xb + (size_t)t.pm * 256 * 2048; u.B = (const char*)wpg + (size_t)t.pn * 256 * 2048; return true;
    }
    __device__ __forceinline__ void epi(f32x4 (&acc)[2][2][4][2], const GU& u, int wr, int wc, int fr, int fq) const {
        const int rl0 = wr * 64 + fr, cl0 = wc * 32 + 8 * fq; const float ps = (DBG_ABL & 32) ? 0.f : 1.f;
        const float r0_ = rstd_of(ssq, u.pm * 256 + fq * 16 + rl0), r1_ = rstd_of(ssq, u.pm * 256 + 128 + fq * 16 + rl0);
#pragma unroll
        for (int ai = 0; ai < 2; ++ai)
#pragma unroll
            for (int mh = 0; mh < 2; ++mh) {
                u32x4 xw[2][2], gw[2][2];
#pragma unroll
                for (int m2 = 0; m2 < 2; ++m2)
#pragma unroll
                    for (int bj = 0; bj < 2; ++bj) { const size_t o = (size_t)(u.pm * 256 + ai * 128 + (2 * mh + m2) * 16 + rl0) * 1024 + u.pn * 256 + bj * 128 + cl0;
                        xw[m2][bj] = *(const u32x4*)(xb + o); gw[m2][bj] = *(const u32x4*)(pp + o); }
#pragma unroll
                for (int m2 = 0; m2 < 2; ++m2) { const int m = 2 * mh + m2, row = u.pm * 256 + ai * 128 + m * 16 + rl0; const float sc = EPI_SC(ai, m); float ss = 0.f;
#pragma unroll
                    for (int bj = 0; bj < 2; ++bj) { const size_t o = (size_t)row * 1024 + u.pn * 256 + bj * 128 + cl0; const u32x4 w = gw[m2][bj], xq = xw[m2][bj];
                        const f32x4 p0 = (f32x4){lo_bf(w.x), hi_bf(w.x), lo_bf(w.y), hi_bf(w.y)}, p1 = (f32x4){lo_bf(w.z), hi_bf(w.z), lo_bf(w.w), hi_bf(w.w)};
                        const f32x4 x0 = (f32x4){lo_bf(xq.x), hi_bf(xq.x), lo_bf(xq.y), hi_bf(xq.y)}, x1 = (f32x4){lo_bf(xq.z), hi_bf(xq.z), lo_bf(xq.w), hi_bf(xq.w)};
                        f32x4 g0 = acc[ai][bj][m][0] * sc, g1 = acc[ai][bj][m][1] * sc;
#pragma unroll
                        for (int j = 0; j < 4; ++j) { g0[j] = sigmoidf_(g0[j]); g1[j] = sigmoidf_(g1[j]); }
                        const f32x4 v0 = x0 + p0 * ps * g0, v1 = x1 + p1 * ps * g1;
                        st_bf8(xbout + o, v0, v1); ss += sq8(v0, v1); }
                    ss += __shfl_xor(ss, 16); ss += __shfl_xor(ss, 32);
                    if (fq == 0) ssqout[(size_t)row * 16 + u.pn * 4 + wc] = ss; }
                EPI_FENCE;
            }
    }
};

struct MoeOrder {
    int tl[NE]; int nN, total, G, c;
    __device__ __forceinline__ void init(const unsigned* cnt, int nN_, int G_, int c_) {
        nN = nN_; G = G_; c = c_; int tt = 0;
#pragma unroll
        for (int e = 0; e < NE; ++e) { tl[e] = (int)((__builtin_amdgcn_readfirstlane(cnt[e]) + 255u) >> 8); tt += tl[e]; }
        total = tt * nN;
    }
    __device__ __forceinline__ bool next(int i, int& e, int& pml, int& pn, int& slot0) const {
        const long L = (long)i * G + c; if (L >= total) return false;
        int wgid = (int)L; { const int q = total / NXCD, r = total % NXCD, xcd = wgid % NXCD, off = wgid / NXCD; wgid = (xcd < r ? xcd * (q + 1) : r * (q + 1) + (xcd - r) * q) + off; }
        int ee = 0, ubase = 0, tbase = 0, nMe = tl[0], uacc = 0, tacc = 0;
#pragma unroll
        for (int k = 0; k < NE; ++k) { if (wgid >= uacc) { ee = k; ubase = uacc; tbase = tacc; nMe = tl[k]; } uacc += tl[k] * nN; tacc += tl[k]; }
        const int li = wgid - ubase, nig = WGM * nN, gid = li / nig, fm = gid * WGM, gsz = (nMe - fm) < WGM ? (nMe - fm) : WGM;
        pml = fm + ((li % nig) % gsz); pn = (li % nig) / gsz; e = ee; slot0 = (tbase + pml) * 256; return true;
    }
};
struct ProgMoeGu {
    __device__ __forceinline__ bool keep(const GU&) const { return false; }
    MoeOrder S; const bf16_t* xb; const bf16_t* Wt; const float* ssq; const int* idx; bf16_t* act;
    __device__ __forceinline__ bool unit(int i, GU& u) const {
        int e, pml, pn, slot0; if (!S.next(i, e, pml, pn, slot0)) return false;
        u.pm = slot0; u.pn = pn; u.sub = 0; u.aux = e; u.idx = idx + slot0; u.mapA = 99; u.mapB = 0; u.lda = 2048; u.ldb = 2048; u.nt = 16;
        u.A = (const char*)xb; u.B = (const char*)Wt + ((size_t)e * 7168 + (size_t)pn * 256) * 2048; return true;
    }
    __device__ __forceinline__ void epi(f32x4 (&acc)[2][2][4][2], const GU& u, int wr, int wc, int fr, int fq) const {
        const int rl0 = wr * 64 + fr, cl0 = wc * 32 + 8 * fq;
        const float r0_ = rstd_of(ssq, idx[u.pm + fq * 16 + rl0]), r1_ = rstd_of(ssq, idx[u.pm + 128 + fq * 16 + rl0]);
        EPI_ROWS(ai, m) { const int slot = u.pm + ai * 128 + m * 16 + rl0; const float s = EPI_SC(ai, m);
            f32x4 o[2];
#pragma unroll
            for (int n = 0; n < 2; ++n)
#pragma unroll
                for (int j = 0; j < 4; ++j) { const float g = acc[ai][0][m][n][j] * s, up = acc[ai][1][m][n][j] * s; o[n][j] = q8(siluf_(g) * up); }
            st_bf8(act + (size_t)slot * EXD + u.pn * 128 + cl0, o[0], o[1]); }
    }
};
struct MoeDownPlan { int ntiles, main, tail; };
__device__ __forceinline__ MoeDownPlan moe_down_plan(const unsigned* cnt, int G) {
    MoeDownPlan pl; int nt = 0;
#pragma unroll
    for (int e = 0; e < NE; ++e) nt += (int)((__builtin_amdgcn_readfirstlane(cnt[e]) + 255u) >> 8);
    const int U = 4 * nt; int tail = U % G; if (U < G || tail > TAILMAX) tail = 0;
    pl.ntiles = nt; pl.tail = tail; pl.main = U - tail; return pl;
}
struct ProgMoeDown {
    __device__ __forceinline__ bool keep(const GU&) const { return false; }
    int tl[NE]; MoeDownPlan pl; int G, c; const bf16_t* act; const bf16_t* Wt; bf16_t* ypair; float* partk;
    __device__ __forceinline__ void init(const unsigned* cnt, int G_, int c_) { G = G_; c = c_; pl = moe_down_plan(cnt, G_);
#pragma unroll
        for (int e = 0; e < NE; ++e) tl[e] = (int)((__builtin_amdgcn_readfirstlane(cnt[e]) + 255u) >> 8); }
    __device__ __forceinline__ bool unit(int i, GU& u) const {
        const long L = (long)i * G + c; int w, kp = -1;
        if (L < pl.main) { w = (int)L; const int q = pl.main / NXCD, r = pl.main % NXCD, xcd = w % NXCD, off = w / NXCD; w = (xcd < r ? xcd * (q + 1) : r * (q + 1) + (xcd - r) * q) + off; }
        else { const long s2 = L - pl.main; if (s2 >= (long)pl.tail * KSPL) return false; w = pl.main + (int)(s2 / KSPL); kp = (int)(s2 % KSPL); }
        const int tile = w >> 2, pn = w & 3; int e = 0, tacc = 0;
#pragma unroll
        for (int k = 0; k < NE; ++k) { if (tile >= tacc) e = k; tacc += tl[k]; }
        const int slot0 = tile * 256;
        u.pm = slot0; u.pn = pn; u.aux = e; u.idx = nullptr; u.mapA = 0; u.mapB = 0; u.lda = 7168; u.ldb = 7168;
        u.A = (const char*)act + (size_t)slot0 * 7168; u.B = (const char*)Wt + ((size_t)e * 1024 + (size_t)pn * 256) * 7168;
        if (kp < 0) { u.sub = 0; u.nt = 56; } else { u.sub = 1 + kp; u.nt = 8; u.A += kp * 1024; u.B += kp * 1024; }
        return true;
    }
    __device__ __forceinline__ void epi(f32x4 (&acc)[2][2][4][2], const GU& u, int wr, int wc, int fr, int fq) const {
        const int rl0 = wr * 64 + fr, cl0 = wc * 32 + 8 * fq;
        if (u.sub == 0) {
            EPI_ROWS(ai, m) { const int slot = u.pm + ai * 128 + m * 16 + rl0;
#pragma unroll
                for (int bj = 0; bj < 2; ++bj) st_bf8(ypair + (size_t)slot * 1024 + u.pn * 256 + bj * 128 + cl0, acc[ai][bj][m][0], acc[ai][bj][m][1]); }
        } else {
            float* pk = partk + ((size_t)(u.sub - 1) * (TAILMAX / 4) * 256 + (u.pm - (pl.main >> 2) * 256)) * 1024 + u.pn * 256 + cl0;
            EPI_ROWS(ai, m) { float* o = pk + (size_t)(ai * 128 + m * 16 + rl0) * 1024;
#pragma unroll
                for (int bj = 0; bj < 2; ++bj) { *(f32x4*)(o + bj * 128) = acc[ai][bj][m][0]; *(f32x4*)(o + bj * 128 + 4) = acc[ai][bj][m][1]; } }
        }
    }
};

struct Params { const float* in[30]; float* out; unsigned char* ws; int s_lo, s_hi; unsigned tmask; int pad; };
enum { I_X = 0, I_P, I_MIXN, I_WIN, I_DNCONV, I_DNALOG, I_DNDTB, I_DNNORM, I_SSCONV, I_SSCONVB, I_SSALOG, I_SSDTB, I_SSD, I_SSNORM, I_WBRDN, I_WBRSSM, I_WBRATT, I_WOUT, I_FFNN,
       I_WFG, I_WFU, I_WFD, I_WROUTER, I_WMG, I_WMU, I_WMD, I_PLEN, I_WPLE, I_WPLEG, I_FINALN };

template <class Map>
__device__ __forceinline__ void tr_job(const Map& map, int K, int N, bf16_t* WT, const float* gain, LAS float* scr, int lane, int gw, int NGW, float qs = 0.f) {
    const int nblk = N / 32, nitems = (K / 64) * nblk;
    for (int item = gw; item < nitems; item += NGW) {
        const int kb = item / nblk, nb = item % nblk, k0 = 64 * kb, n0 = 32 * nb;
        int ld = 0; const float* src = map(n0 + (lane & 31), ld);
#pragma unroll
        for (int i = 0; i < 32; ++i) { const int kk = 2 * i + (lane >> 5); float v = 0.f; if (src) { v = src[(size_t)(k0 + kk) * ld]; if (gain) v *= gain[k0 + kk]; if (EMU_FP8 && qs > 0.f) v = q8(v * qs) / qs; } scr[kk * 33 + (lane & 31)] = v; }
        asm volatile("s_waitcnt lgkmcnt(0)" ::: "memory");
        const int c = lane & 7;
#pragma unroll
        for (int j = 0; j < 4; ++j) { const int n = (lane >> 3) + 8 * j; const LAS float* s = scr + (8 * c) * 33 + n;
            u32x4 o; o.x = pk2(s[0 * 33], s[1 * 33]); o.y = pk2(s[2 * 33], s[3 * 33]); o.z = pk2(s[4 * 33], s[5 * 33]); o.w = pk2(s[6 * 33], s[7 * 33]);
            *(u32x4*)(WT + (size_t)(n0 + n) * K + k0 + 8 * c) = o; }
        asm volatile("s_waitcnt lgkmcnt(0)" ::: "memory");
    }
}
struct MapPlain { const float* W; int ld; __device__ __forceinline__ const float* operator()(int n, int& l) const { l = ld; return W + n; } };
struct MapIn { const float* W; __device__ __forceinline__ const float* operator()(int n, int& l) const { l = INW; const int tile = n >> 8, r = n & 255; int col;
        if (tile < 9) col = n; else if (tile < 12) col = C_DNZ + (n - 2304); else if (tile < 17) col = C_XBC + (n - 3072); else if (tile < 20) col = C_SSZ + (n - 4352);
        else if (tile < 29) col = C_ATT + (n - 5120); else if (tile < 41) col = C_GATE + (n - 7424);
        else { if (r < 6) col = C_DNA + r; else if (r < 12) col = C_DNB + (r - 6); else if (r < 24) col = C_SSDT + (r - 12); else return nullptr; }
        return W + col; } };
struct MapGu { const float* Wg; const float* Wu; int ld; __device__ __forceinline__ const float* operator()(int n, int& l) const { l = ld; const int tile = n >> 8, r = n & 255; return r < 128 ? Wg + tile * 128 + r : Wu + tile * 128 + (r - 128); } };

__device__ __forceinline__ void phase_convert(const Params& p, LAS unsigned char* lds) {
    const int tid_ = htid(), lane = tid_ & 63, wave = tid_ >> 6, G = gridDim.x;
    const int gw = blockIdx.x * 8 + wave, NGW = G * 8;
    LAS float* scr = (LAS float*)(lds + wave * 16384);
    unsigned char* ws = p.ws;
    for (int l = 0; l < DEPTH; ++l) {
        tr_job(MapIn{p.in[I_WIN] + (size_t)l * D * INW}, D, INP, (bf16_t*)(ws + WS_WIN) + (size_t)l * INP * D, p.in[I_MIXN] + l * D, scr, lane, gw, NGW);
        tr_job(MapPlain{p.in[I_WBRDN] + (size_t)l * 768 * D, D}, 768, D, (bf16_t*)(ws + WS_WDN) + (size_t)l * D * 768, nullptr, scr, lane, gw, NGW);
        tr_job(MapPlain{p.in[I_WBRSSM] + (size_t)l * 768 * D, D}, 768, D, (bf16_t*)(ws + WS_WSSM) + (size_t)l * D * 768, nullptr, scr, lane, gw, NGW);
        tr_job(MapPlain{p.in[I_WBRATT] + (size_t)l * 256 * D, D}, 256, D, (bf16_t*)(ws + WS_WATT) + (size_t)l * D * 256, nullptr, scr, lane, gw, NGW);
        tr_job(MapPlain{p.in[I_WOUT] + (size_t)l * D * D, D}, D, D, (bf16_t*)(ws + WS_WOUT) + (size_t)l * D * D, nullptr, scr, lane, gw, NGW);
        tr_job(MapPlain{p.in[I_WPLEG] + (size_t)l * D * D, D}, D, D, (bf16_t*)(ws + WS_WPG) + (size_t)l * D * D, p.in[I_PLEN] + l * D, scr, lane, gw, NGW);
        tr_job(MapPlain{p.in[I_WPLE] + (size_t)l * PLE * D, D}, PLE, D, (bf16_t*)(ws + WS_WPLE) + (size_t)l * D * PLE, nullptr, scr, lane, gw, NGW);
    }
    tr_job(MapGu{p.in[I_WFG], p.in[I_WFU], FFN}, D, 2 * FFN, (bf16_t*)(ws + WS_WFGU), p.in[I_FFNN], scr, lane, gw, NGW, 16.f);
    tr_job(MapPlain{p.in[I_WFD], D}, FFN, D, (bf16_t*)(ws + WS_WFD), nullptr, scr, lane, gw, NGW, 16.f);
    for (int e = 0; e < NE; ++e) {
        tr_job(MapGu{p.in[I_WMG] + (size_t)e * D * EXD, p.in[I_WMU] + (size_t)e * D * EXD, EXD}, D, 2 * EXD, (bf16_t*)(ws + WS_WMGU) + (size_t)e * 2 * EXD * D, p.in[I_FFNN] + D, scr, lane, gw, NGW, 16.f);
        tr_job(MapPlain{p.in[I_WMD] + (size_t)e * EXD * D, D}, EXD, D, (bf16_t*)(ws + WS_WMD) + (size_t)e * D * EXD, nullptr, scr, lane, gw, NGW, 16.f);
    }
    float* wr = (float*)(ws + WS_WR);
    for (int i = blockIdx.x * 512 + tid_; i < D * NE; i += G * 512) wr[i] = p.in[I_WROUTER][i] * p.in[I_FFNN][D + (i >> 3)];
}

__device__ __forceinline__ void phase_chunk_in(const Params& p, int chunk) {
    const int tid_ = htid(), lane = tid_ & 63, gw = blockIdx.x * 8 + (tid_ >> 6), NGW = gridDim.x * 8;
    const float* x = p.in[I_X] + (size_t)chunk * TC * D;
    bf16_t* xb = (bf16_t*)(p.ws + WS_XB); float* ssq = (float*)(p.ws + WS_SSQ);
    for (int r0 = gw; r0 < TC; r0 += 2 * NGW) {
        f32x4 v[2][4];
#pragma unroll
        for (int u = 0; u < 2; ++u) { const int r = r0 + u * NGW < TC ? r0 + u * NGW : r0; const f32x4* xr = (const f32x4*)(x + (size_t)r * D) + lane;
#pragma unroll
            for (int j = 0; j < 4; ++j) v[u][j] = xr[64 * j]; }
#pragma unroll
        for (int u = 0; u < 2; ++u) { const int r = r0 + u * NGW; if (r >= TC) break; float s = 0.f; u32x2* o = (u32x2*)(xb + (size_t)r * D) + lane;
#pragma unroll
            for (int j = 0; j < 4; ++j) { const f32x4 t = v[u][j]; s += (t.x * t.x + t.y * t.y) + (t.z * t.z + t.w * t.w); u32x2 w; w.x = pk2(t.x, t.y); w.y = pk2(t.z, t.w); o[64 * j] = w; }
            s = wave_sum(s);
            if (lane < 16) ssq[(size_t)r * 16 + lane] = lane == 0 ? s : 0.f; }
    }
    bf16_t* pb = (bf16_t*)(p.ws + WS_PB);
    for (int r0 = gw; r0 < 2 * TC; r0 += 4 * NGW) {
        f32x4 v[4];
#pragma unroll
        for (int u = 0; u < 4; ++u) { const int r = r0 + u * NGW < 2 * TC ? r0 + u * NGW : r0; const int l = r / TC, rr = r % TC;
            v[u] = *((const f32x4*)(p.in[I_P] + ((size_t)l * BATCH * SEQ + (size_t)chunk * TC + rr) * PLE) + lane); }
#pragma unroll
        for (int u = 0; u < 4; ++u) { const int r = r0 + u * NGW; if (r >= 2 * TC) break; const int l = r / TC, rr = r % TC;
            u32x2 w; w.x = pk2(v[u].x, v[u].y); w.y = pk2(v[u].z, v[u].w); *((u32x2*)(pb + ((size_t)l * TC + rr) * PLE) + lane) = w; }
    }
}
__device__ __forceinline__ void phase_final(const Params& p, int chunk) {
    const int tid_ = htid(), lane = tid_ & 63, gw = blockIdx.x * 8 + (tid_ >> 6), NGW = gridDim.x * 8;
    float* out = p.out + (size_t)chunk * TC * D; const bf16_t* xs = (const bf16_t*)(p.ws + WS_XB2); const float* g = p.in[I_FINALN];
    for (int r0 = gw; r0 < TC; r0 += 2 * NGW) {
        u32x4 q[2][2];
#pragma unroll
        for (int u = 0; u < 2; ++u) { const int r = r0 + u * NGW < TC ? r0 + u * NGW : r0; const u32x4* xr = (const u32x4*)(xs + (size_t)r * D) + lane; q[u][0] = xr[0]; q[u][1] = xr[64]; }
#pragma unroll
        for (int u = 0; u < 2; ++u) { const int r = r0 + u * NGW; if (r >= TC) break; float s = 0.f; f32x4 v[4];
#pragma unroll
            for (int j = 0; j < 2; ++j) { const u32x4 w = q[u][j]; v[2 * j] = (f32x4){lo_bf(w.x), hi_bf(w.x), lo_bf(w.y), hi_bf(w.y)}; v[2 * j + 1] = (f32x4){lo_bf(w.z), hi_bf(w.z), lo_bf(w.w), hi_bf(w.w)};
                s += sq8(v[2 * j], v[2 * j + 1]); }
            const float rs = rsqrtf(wave_sum(s) * (1.f / D) + EPS);
#pragma unroll
            for (int j = 0; j < 2; ++j) { const int c = 8 * (lane + 64 * j); float* o = out + (size_t)r * D + c;
                *(f32x4*)o = v[2 * j] * rs * *(const f32x4*)(g + c); *(f32x4*)(o + 4) = v[2 * j + 1] * rs * *(const f32x4*)(g + c + 4); } }
    }
}
__device__ __forceinline__ void phase_router(const Params& p, LAS unsigned char* lds, int chunk) {
    const int tid_ = htid(), lane = tid_ & 63, gw = blockIdx.x * 8 + (tid_ >> 6), NGW = gridDim.x * 8;
    const bf16_t* x = (const bf16_t*)(p.ws + WS_XB); const float* wr = (const float*)(p.ws + WS_WR);
    int* rt = (int*)(p.ws + WS_ROUTE); unsigned* cnt = (unsigned*)(p.ws + WS_CTL) + CW_CNT + chunk * 64;
    LAS unsigned* lcnt = (LAS unsigned*)lds;
    f32x4 w[16][2];
#pragma unroll
    for (int j = 0; j < 2; ++j)
#pragma unroll
        for (int q = 0; q < 8; ++q) { const int k = 8 * (lane + 64 * j) + q; w[8 * j + q][0] = *(const f32x4*)(wr + k * 8); w[8 * j + q][1] = *(const f32x4*)(wr + k * 8 + 4); }
    const int nouter = (TC + 8 * NGW - 1) / (8 * NGW);
    for (int ob = 0; ob < nouter; ++ob) {
        if (tid_ < 16) lcnt[tid_] = 0u;
        __syncthreads();
        int pe[8]; unsigned pr[8];
#pragma unroll
        for (int jr = 0; jr < 8; ++jr) { const int r = gw + (ob * 8 + jr) * NGW; pe[jr] = 0; pr[jr] = 0u;
            if (r < TC) {
                const u32x4* xr = (const u32x4*)(x + (size_t)r * D) + lane; float s = 0.f; float lg[NE];
#pragma unroll
                for (int e = 0; e < NE; ++e) lg[e] = 0.f;
#pragma unroll
                for (int j = 0; j < 2; ++j) { const u32x4 xw = xr[64 * j]; const float v[8] = {lo_bf(xw.x), hi_bf(xw.x), lo_bf(xw.y), hi_bf(xw.y), lo_bf(xw.z), hi_bf(xw.z), lo_bf(xw.w), hi_bf(xw.w)};
#pragma unroll
                    for (int q = 0; q < 8; ++q) { s += v[q] * v[q]; const f32x4 w0 = w[8 * j + q][0], w1 = w[8 * j + q][1];
                        lg[0] += v[q] * w0.x; lg[1] += v[q] * w0.y; lg[2] += v[q] * w0.z; lg[3] += v[q] * w0.w; lg[4] += v[q] * w1.x; lg[5] += v[q] * w1.y; lg[6] += v[q] * w1.z; lg[7] += v[q] * w1.w; } }
                const float rs = rsqrtf(wave_sum(s) * (1.f / D) + EPS);
#pragma unroll
                for (int e = 0; e < NE; ++e) lg[e] = wave_sum(lg[e]) * rs;
                int i0 = 0; float l0 = lg[0];
#pragma unroll
                for (int e = 1; e < NE; ++e) if (lg[e] > l0) { l0 = lg[e]; i0 = e; }
                int i1 = -1; float l1 = -3.0e38f;
#pragma unroll
                for (int e = 0; e < NE; ++e) if (e != i0 && lg[e] > l1) { l1 = lg[e]; i1 = e; }
                if (lane < 2) { const int e = lane == 0 ? i0 : i1; const float w0 = 1.f / (1.f + expf(l1 - l0));
                    pe[jr] = e; pr[jr] = __hip_atomic_fetch_add(lcnt + e, 1u, __ATOMIC_RELAXED, __HIP_MEMORY_SCOPE_WORKGROUP);
                    rt[RT_TOPE + 2 * r + lane] = e; ((float*)rt)[RT_TOPW + 2 * r + lane] = lane == 0 ? w0 : 1.f - w0; }
            } }
        __syncthreads();
        if (tid_ < 8) lcnt[8 + tid_] = atomicAdd(cnt + tid_, lcnt[tid_]);
        __syncthreads();
#pragma unroll
        for (int jr = 0; jr < 8; ++jr) { const int r = gw + (ob * 8 + jr) * NGW; if (r < TC && lane < 2) rt[RT_TOPP + 2 * r + lane] = (int)(lcnt[8 + pe[jr]] + pr[jr]); }
        __syncthreads();
    }
}
__device__ __forceinline__ void phase_slots(const Params& p, int chunk) {
    int* rt = (int*)(p.ws + WS_ROUTE); const unsigned* cnt = (const unsigned*)(p.ws + WS_CTL) + CW_CNT + chunk * 64;
    int c[NE], off[NE + 1]; off[0] = 0;
#pragma unroll
    for (int e = 0; e < NE; ++e) { c[e] = (int)cnt[e]; off[e + 1] = off[e] + ((c[e] + 255) & ~255); }
    const int gt = blockIdx.x * 512 + htid(), NT = gridDim.x * 512;
    for (int i = gt; i < 2 * TC; i += NT) {
        const int e = rt[RT_TOPE + i], pos = rt[RT_TOPP + i]; int o = 0;
#pragma unroll
        for (int k = 0; k < NE; ++k) o = (e == k) ? off[k] : o;
        const int slot = o + pos; rt[RT_TOPS + i] = slot; rt[RT_IDX + slot] = i >> 1;
    }
    for (int s = gt; s < off[NE]; s += NT) {
        bool pad = false;
#pragma unroll
        for (int k = 0; k < NE; ++k) pad = pad || (s >= off[k] + c[k] && s < off[k + 1]);
        if (pad) rt[RT_IDX + s] = 0;
    }
}
__device__ __forceinline__ f32x4 moe_y4(const bf16_t* yp, const float* partk, int slot, int tail0, int col) {
    if (slot < tail0) { const u32x2 a = *(const u32x2*)(yp + (size_t)slot * D + col); return (f32x4){lo_bf(a.x), hi_bf(a.x), lo_bf(a.y), hi_bf(a.y)}; }
    f32x4 v = (f32x4){0.f, 0.f, 0.f, 0.f};
#pragma unroll
    for (int k = 0; k < KSPL; ++k) v += *(const f32x4*)(partk + ((size_t)k * (TAILMAX / 4) * 256 + (slot - tail0)) * 1024 + col);
    return v;
}
__device__ __forceinline__ void phase_combine(const Params& p, int chunk) {
    const int tid_ = htid(), lane = tid_ & 63, gw = blockIdx.x * 8 + (tid_ >> 6), NGW = gridDim.x * 8;
    const int* rt = (const int*)(p.ws + WS_ROUTE);
    const bf16_t* yp = (const bf16_t*)(p.ws + WS_YPAIR); const float* partk = (const float*)(p.ws + WS_PARTK); bf16_t* xb = (bf16_t*)(p.ws + WS_XB); float* ssq = (float*)(p.ws + WS_SSQ);
    const MoeDownPlan pl = moe_down_plan((const unsigned*)(p.ws + WS_CTL) + CW_CNT + chunk * 64, gridDim.x);
    const int tail0 = pl.tail > 0 ? (pl.main >> 2) * 256 : 0x7fffffff;
    for (int r0 = gw; r0 < TC; r0 += 4 * NGW) {
        int sl[4][2]; float wt[4][2];
#pragma unroll
        for (int u = 0; u < 4; ++u) { const int r = r0 + u * NGW < TC ? r0 + u * NGW : r0; sl[u][0] = rt[RT_TOPS + 2 * r]; sl[u][1] = rt[RT_TOPS + 2 * r + 1];
            wt[u][0] = (DBG_ABL & 16) ? 0.f : ((const float*)rt)[RT_TOPW + 2 * r]; wt[u][1] = (DBG_ABL & 16) ? 0.f : ((const float*)rt)[RT_TOPW + 2 * r + 1]; }
#pragma unroll
        for (int u = 0; u < 4; ++u) { const int r = r0 + u * NGW; if (r >= TC) break;
            u32x2* xr = (u32x2*)(xb + (size_t)r * D) + lane; float s = 0.f;
            f32x4 v[4], y0[4], y1[4]; u32x2 xq[4];
            if (sl[u][0] < tail0 && sl[u][1] < tail0) {
                const u32x2* a0 = (const u32x2*)(yp + (size_t)sl[u][0] * D) + lane; const u32x2* a1 = (const u32x2*)(yp + (size_t)sl[u][1] * D) + lane; u32x2 q0[4], q1[4];
#pragma unroll
                for (int j = 0; j < 4; ++j) { xq[j] = xr[64 * j]; q0[j] = a0[64 * j]; q1[j] = a1[64 * j]; }
#pragma unroll
                for (int j = 0; j < 4; ++j) { y0[j] = (f32x4){lo_bf(q0[j].x), hi_bf(q0[j].x), lo_bf(q0[j].y), hi_bf(q0[j].y)}; y1[j] = (f32x4){lo_bf(q1[j].x), hi_bf(q1[j].x), lo_bf(q1[j].y), hi_bf(q1[j].y)}; }
            } else {
#pragma unroll
                for (int j = 0; j < 4; ++j) { const int col = 4 * (lane + 64 * j); xq[j] = xr[64 * j]; y0[j] = moe_y4(yp, partk, sl[u][0], tail0, col); y1[j] = moe_y4(yp, partk, sl[u][1], tail0, col); }
            }
#pragma unroll
            for (int j = 0; j < 4; ++j) { v[j] = (f32x4){lo_bf(xq[j].x), hi_bf(xq[j].x), lo_bf(xq[j].y), hi_bf(xq[j].y)}; const f32x4 t = v[j] + wt[u][0] * y0[j] + wt[u][1] * y1[j];
                s += (t.x * t.x + t.y * t.y) + (t.z * t.z + t.w * t.w); u32x2 w; w.x = pk2(t.x, t.y); w.y = pk2(t.z, t.w); xr[64 * j] = w; }
            s = wave_sum(s);
            if (lane < 16) ssq[(size_t)r * 16 + lane] = lane == 0 ? s : 0.f; }
    }
}

#define LDS_BARRIER() do { asm volatile("s_waitcnt lgkmcnt(0)" ::: "memory"); __builtin_amdgcn_s_barrier(); asm volatile("" ::: "memory"); } while (0)
__device__ __forceinline__ f32x4 mfma16(const bf16x8 a, const bf16x8 b, const f32x4 c) { return __builtin_amdgcn_mfma_f32_16x16x32_bf16(a, b, c, 0, 0, 0); }
__device__ __forceinline__ void dn_fetch(const Params& p, int b, int n, int h, u32x4 (&xr)[10]) {
    const int tid = htid();
    if (tid < 480) {
        const int cg = tid % 48, seg = tid / 48, part = cg >> 4, c8 = (cg & 15) * 8, col = part * 768 + h * 128 + c8, ts = seg * 7, t0 = n * 64;
        const bf16_t* proj = (const bf16_t*)(p.ws + WS_PDN) + (size_t)b * SEQ * 3072;
#pragma unroll
        for (int i = 0; i < 10; ++i) { const int t = t0 + ts - 3 + i; xr[i] = (u32x4){0u, 0u, 0u, 0u};
            if (t >= 0 && ts - 3 + i < 64) xr[i] = *(const u32x4*)(proj + (size_t)t * 3072 + col); }
    }
}
__device__ __forceinline__ void dn_prep(const Params& p, LAS unsigned char* lds, int layer, int b, int n, int h, u32x4 (&xr)[10], bool has_next, int nb_, int nn_, int nh_) {
    const int tid = htid(), lane = tid & 63, wave = tid >> 6;
    LAS float* AM = (LAS float*)lds;
    LAS float* SC = (LAS float*)(lds + 17408);
    LAS unsigned char* TW = lds + 19968; LAS unsigned char* TU = lds + 29184;
    LAS unsigned char* QS = lds + 38400; LAS unsigned char* KS = lds + 55808;
    LAS unsigned char* VT = lds + 73216; LAS unsigned char* KT = lds + 91648;
    LAS float* AR = (LAS float*)(lds + 110080);
    LAS unsigned char* T22L = lds + 118784; LAS unsigned char* T11C = lds + 121344;
    const int t0 = n * 64;
    const bf16_t* proj = (const bf16_t*)(p.ws + WS_PDN) + (size_t)b * SEQ * 3072;
    unsigned char* item = p.ws + WS_DNS + (size_t)((b * 32 + n) * 6 + h) * DNS_ITEM;
    if (tid < 480) {
        const int cg = tid % 48, seg = tid / 48, part = cg >> 4, c8 = (cg & 15) * 8, col = part * 768 + h * 128 + c8;
        const float* cw = p.in[I_DNCONV] + (size_t)layer * 4 * 2304 + col;
        f32x4 w[4][2];
#pragma unroll
        for (int j = 0; j < 4; ++j) { w[j][0] = *(const f32x4*)(cw + j * 2304); w[j][1] = *(const f32x4*)(cw + j * 2304 + 4); }
        const int ts = seg * 7;
        f32x4 x[10][2];
#pragma unroll
        for (int i = 0; i < 10; ++i) { const u32x4 w_ = xr[i]; x[i][0] = (f32x4){lo_bf(w_.x), hi_bf(w_.x), lo_bf(w_.y), hi_bf(w_.y)}; x[i][1] = (f32x4){lo_bf(w_.z), hi_bf(w_.z), lo_bf(w_.w), hi_bf(w_.w)}; }
        LAS unsigned char* dst = part == 0 ? QS : KS; LAS unsigned char* dstT = (part == 1 ? KT : VT) + c8 * 144; const int sw = (c8 >> 3) & 7;
#pragma unroll
        for (int i = 0; i < 7; ++i) { const int tk = ts + i;
            if (tk < 64) { f32x4 a0 = w[3][0] * x[i + 3][0] + w[2][0] * x[i + 2][0] + w[1][0] * x[i + 1][0] + w[0][0] * x[i][0];
                f32x4 a1 = w[3][1] * x[i + 3][1] + w[2][1] * x[i + 2][1] + w[1][1] * x[i + 1][1] + w[0][1] * x[i][1];
#pragma unroll
                for (int c = 0; c < 4; ++c) { a0[c] = siluf_(a0[c]); a1[c] = siluf_(a1[c]); }
                u32x4 pw; pw.x = pk2(a0[0], a0[1]); pw.y = pk2(a0[2], a0[3]); pw.z = pk2(a1[0], a1[1]); pw.w = pk2(a1[2], a1[3]);
                if (part < 2) *(LAS u32x4*)(dst + tk * 272 + c8 * 2) = pw;
                if (part > 0) { LAS unsigned char* T = dstT + ((((tk >> 3) ^ sw) << 4) | ((tk & 7) << 1));
                    *(LAS bf16_t*)(T + 0 * 144) = (bf16_t)(pw.x & 0xffffu); *(LAS bf16_t*)(T + 1 * 144) = (bf16_t)(pw.x >> 16); *(LAS bf16_t*)(T + 2 * 144) = (bf16_t)(pw.y & 0xffffu); *(LAS bf16_t*)(T + 3 * 144) = (bf16_t)(pw.y >> 16);
                    *(LAS bf16_t*)(T + 4 * 144) = (bf16_t)(pw.z & 0xffffu); *(LAS bf16_t*)(T + 5 * 144) = (bf16_t)(pw.z >> 16); *(LAS bf16_t*)(T + 6 * 144) = (bf16_t)(pw.w & 0xffffu); *(LAS bf16_t*)(T + 7 * 144) = (bf16_t)(pw.w >> 16); }
 } }
    } else {
        const float Aexp = expf(p.in[I_DNALOG][layer * 6 + h]), dtb = p.in[I_DNDTB][layer * 6 + h];
        const float* small = (const float*)(p.ws + WS_SMALL) + (size_t)b * SEQ * 32;
#pragma unroll
        for (int q = 0; q < 2; ++q) { const int tk = (tid - 480) * 2 + q; const float a = small[(size_t)(t0 + tk) * 32 + h], bb = small[(size_t)(t0 + tk) * 32 + 6 + h];
            SC[128 + tk] = sigmoidf_(bb); SC[192 + tk] = -Aexp * softplusf_(a + dtb); }
    }
    LDS_BARRIER();
    if (has_next) dn_fetch(p, nb_, nn_, nh_, xr);
    TSUB(8);
    {
        const int row = tid >> 3, sg = tid & 7; const u32x4 q0 = *(const LAS u32x4*)(QS + row * 272 + sg * 32), q1 = *(const LAS u32x4*)(QS + row * 272 + sg * 32 + 16), k0 = *(const LAS u32x4*)(KS + row * 272 + sg * 32), k1 = *(const LAS u32x4*)(KS + row * 272 + sg * 32 + 16);
        float sq = sq8((f32x4){lo_bf(q0.x), hi_bf(q0.x), lo_bf(q0.y), hi_bf(q0.y)}, (f32x4){lo_bf(q0.z), hi_bf(q0.z), lo_bf(q0.w), hi_bf(q0.w)}) + sq8((f32x4){lo_bf(q1.x), hi_bf(q1.x), lo_bf(q1.y), hi_bf(q1.y)}, (f32x4){lo_bf(q1.z), hi_bf(q1.z), lo_bf(q1.w), hi_bf(q1.w)});
        float sk = sq8((f32x4){lo_bf(k0.x), hi_bf(k0.x), lo_bf(k0.y), hi_bf(k0.y)}, (f32x4){lo_bf(k0.z), hi_bf(k0.z), lo_bf(k0.w), hi_bf(k0.w)}) + sq8((f32x4){lo_bf(k1.x), hi_bf(k1.x), lo_bf(k1.y), hi_bf(k1.y)}, (f32x4){lo_bf(k1.z), hi_bf(k1.z), lo_bf(k1.w), hi_bf(k1.w)});
        sq += __shfl_xor(sq, 1); sq += __shfl_xor(sq, 2); sq += __shfl_xor(sq, 4); sk += __shfl_xor(sk, 1); sk += __shfl_xor(sk, 2); sk += __shfl_xor(sk, 4);
        if (sg == 0) { SC[row] = sq; SC[64 + row] = sk; } }
    LDS_BARRIER();
    TSUB(9);
    if (wave == 0) {
        float g = SC[192 + lane];
#pragma unroll
        for (int o = 1; o < 64; o <<= 1) { const float t = __shfl_up(g, o); if (lane >= o) g += t; }
        const float eg = expf(g), rk = rsqrtf(SC[64 + lane] + EPS), glast = __shfl(g, 63);
        SC[192 + lane] = g; SC[256 + lane] = eg; SC[320 + lane] = rsqrtf(SC[lane] + EPS); SC[384 + lane] = rk;
        SC[448 + lane] = rk * SC[128 + lane] * eg; SC[576 + lane] = rk * fexp(glast - g);
    }
    LDS_BARRIER();
    TSUB(10);
    {
        const int r = lane & 15, kg = lane >> 4;
        bf16x8 fa[4][4], fb[4][4];
#pragma unroll
        for (int q = 0; q < 4; ++q) { const int t = wave * 4 + q, which = t >> 4, mt = (t >> 2) & 3, nt = t & 3;
            const LAS unsigned char* A = (which == 0 ? KS : QS) + (16 * mt + r) * 272 + kg * 16; const LAS unsigned char* Bt = KS + (16 * nt + r) * 272 + kg * 16;
#pragma unroll
            for (int ks = 0; ks < 4; ++ks) { fa[q][ks] = *(const LAS bf16x8*)(A + ks * 64); fb[q][ks] = *(const LAS bf16x8*)(Bt + ks * 64); } }
#pragma unroll
        for (int q = 0; q < 4; ++q) { const int t = wave * 4 + q, which = t >> 4, mt = (t >> 2) & 3, nt = t & 3;
            f32x4 acc = (f32x4){0.f, 0.f, 0.f, 0.f};
#pragma unroll
            for (int ks = 0; ks < 4; ++ks) acc = mfma16(fa[q][ks], fb[q][ks], acc);
            const int j = 16 * nt + r; const float gj = SC[192 + j], rkj = SC[384 + j];
            float ov[4], av[4];
#pragma unroll
            for (int rr = 0; rr < 4; ++rr) { const int i = 16 * mt + 4 * kg + rr; const float e = fexp(fminf(SC[192 + i] - gj, 0.f));
                av[rr] = (i > j) ? SC[128 + i] * SC[384 + i] * rkj * acc[rr] * e : 0.f;
                ov[rr] = (i >= j) ? SC[320 + i] * rkj * 0.08838834764831845f * acc[rr] * e : 0.f; }
            if (which == 0) { *(LAS f32x4*)(AM + (63 - j) * 68 + 60 - 16 * mt - 4 * kg) = (f32x4){av[3], av[2], av[1], av[0]};
                if (mt < 2 && nt < 2) { LAS float* ar_ = AR + (16 * mt + 4 * kg) * 68 + j; ar_[0] = av[0]; ar_[68] = av[1]; ar_[136] = av[2]; ar_[204] = av[3]; } }
            else { bf16_t* ao = (bf16_t*)(item + 32768) + (16 * mt + 4 * kg) * 64 + j; ST2_BF(ao, ao + 64, ov[0], ov[1]); ST2_BF(ao + 128, ao + 192, ov[2], ov[3]); }
        }
    }
    LDS_BARRIER();
    TSUB(11);
    if (wave < 2) {
        f32x2 x2[16];
        float lf = (float)lane; asm volatile("" : "+v"(lf));
#pragma unroll
        for (int m = 0; m < 16; ++m) x2[m] = (f32x2){fmaxf(1.f - fabsf(lf - (float)(2 * m)), 0.f), fmaxf(1.f - fabsf(lf - (float)(2 * m + 1)), 0.f)};
        const LAS float* AMv = wave == 0 ? AM : AR; asm volatile("" : "+v"(AMv));
        f32x4 rw[2][8]; f32x2 accA, accB; float sres;
#define ROW_BEGIN(i) do { accA = (f32x2){0.f, 0.f}; accB = accA; sres = x2[(i) >> 1][(i) & 1]; } while (0)
#define ROW_CHUNK(i, k4, am) do { \
            if (4 * (k4) + 1 < (i)) accA -= __builtin_shufflevector(am, am, 0, 1) * x2[2 * (k4)]; else if (4 * (k4) < (i)) sres -= am[0] * x2[2 * (k4)][0]; \
            if (4 * (k4) + 3 < (i)) accB -= __builtin_shufflevector(am, am, 2, 3) * x2[2 * (k4) + 1]; else if (4 * (k4) + 2 < (i)) sres -= am[2] * x2[2 * (k4) + 1][0]; } while (0)
#define ROW_END(i) x2[(i) >> 1][(i) & 1] = sres + ((accA[0] + accA[1]) + (accB[0] + accB[1]))
        rw[1][0] = *(const LAS f32x4*)(AMv + 1 * 68);
#pragma unroll
        for (int i = 1; i < 32; ++i) {
            if (i + 1 < 32) {
#pragma unroll
                for (int k4 = 0; k4 < (i + 4) / 4; ++k4) rw[(i + 1) & 1][k4] = *(const LAS f32x4*)(AMv + (i + 1) * 68 + 4 * k4);
            }
            ROW_BEGIN(i);
#pragma unroll
            for (int k4 = 0; k4 < (i + 3) / 4; ++k4) { const f32x4 am = rw[i & 1][k4]; ROW_CHUNK(i, k4, am); }
            ROW_END(i);
            { const float xi_ = x2[i >> 1][i & 1]; asm("" : "+v"(AMv) : "v"(xi_)); }
        }
#undef ROW_BEGIN
#undef ROW_CHUNK
#undef ROW_END
#define XE(a) x2[(a) >> 1][(a) & 1]
        if (wave == 0) {
            if (lane < 32) { const int irow = 63 - lane;
#pragma unroll
                for (int g = 4; g < 8; ++g) {
                    const f32x4 sw0 = *(const LAS f32x4*)(SC + 448 + 8 * g), sw1 = *(const LAS f32x4*)(SC + 448 + 8 * g + 4), su0 = *(const LAS f32x4*)(SC + 128 + 8 * g), su1 = *(const LAS f32x4*)(SC + 128 + 8 * g + 4);
                    u32x4 w, u, t;
                    w.x = pk2(XE(63 - 8 * g) * sw0[0], XE(62 - 8 * g) * sw0[1]); w.y = pk2(XE(61 - 8 * g) * sw0[2], XE(60 - 8 * g) * sw0[3]); w.z = pk2(XE(59 - 8 * g) * sw1[0], XE(58 - 8 * g) * sw1[1]); w.w = pk2(XE(57 - 8 * g) * sw1[2], XE(56 - 8 * g) * sw1[3]);
                    u.x = pk2(XE(63 - 8 * g) * su0[0], XE(62 - 8 * g) * su0[1]); u.y = pk2(XE(61 - 8 * g) * su0[2], XE(60 - 8 * g) * su0[3]); u.z = pk2(XE(59 - 8 * g) * su1[0], XE(58 - 8 * g) * su1[1]); u.w = pk2(XE(57 - 8 * g) * su1[2], XE(56 - 8 * g) * su1[3]);
                    t.x = pk2(XE(63 - 8 * g), XE(62 - 8 * g)); t.y = pk2(XE(61 - 8 * g), XE(60 - 8 * g)); t.z = pk2(XE(59 - 8 * g), XE(58 - 8 * g)); t.w = pk2(XE(57 - 8 * g), XE(56 - 8 * g));
                    *(LAS u32x4*)(TW + irow * 144 + g * 16) = w; *(LAS u32x4*)(TU + irow * 144 + g * 16) = u; *(LAS u32x4*)(T22L + (irow - 32) * 80 + (g - 4) * 16) = t; }
            }
        } else {
            if (lane < 32) {
#pragma unroll
                for (int g = 0; g < 4; ++g) { u32x4 t; t.x = pk2(XE(8 * g), XE(8 * g + 1)); t.y = pk2(XE(8 * g + 2), XE(8 * g + 3)); t.z = pk2(XE(8 * g + 4), XE(8 * g + 5)); t.w = pk2(XE(8 * g + 6), XE(8 * g + 7));
                    *(LAS u32x4*)(T11C + lane * 80 + g * 16) = t; }
                const float swl = SC[448 + lane], sul = SC[128 + lane];
#pragma unroll
                for (int a = 0; a < 32; a += 2) { const unsigned pw = pk2(XE(a) * swl, XE(a + 1) * swl), pu = pk2(XE(a) * sul, XE(a + 1) * sul);
                    *(LAS bf16_t*)(TW + a * 144 + lane * 2) = (bf16_t)(pw & 0xffffu); *(LAS bf16_t*)(TW + (a + 1) * 144 + lane * 2) = (bf16_t)(pw >> 16);
                    *(LAS bf16_t*)(TU + a * 144 + lane * 2) = (bf16_t)(pu & 0xffffu); *(LAS bf16_t*)(TU + (a + 1) * 144 + lane * 2) = (bf16_t)(pu >> 16); }
            } else {
#pragma unroll
                for (int g = 4; g < 8; ++g) { *(LAS u32x4*)(TW + (lane - 32) * 144 + g * 16) = (u32x4){0u, 0u, 0u, 0u}; *(LAS u32x4*)(TU + (lane - 32) * 144 + g * 16) = (u32x4){0u, 0u, 0u, 0u}; }
            }
        }
#undef XE
    } else {
        const int u = tid - 128;
#pragma unroll
        for (int i = 0; i < 3; ++i) { const int q = u + 384 * i; if (q < 1024) { const int c = q >> 4, d8 = (q & 15) * 8; f32x4 a0, a1;
            const u32x4 w = *(const LAS u32x4*)(QS + c * 272 + d8 * 2); const float sc = SC[320 + c] * 0.08838834764831845f * SC[256 + c];
            a0 = (f32x4){lo_bf(w.x), hi_bf(w.x), lo_bf(w.y), hi_bf(w.y)} * sc; a1 = (f32x4){lo_bf(w.z), hi_bf(w.z), lo_bf(w.w), hi_bf(w.w)} * sc;
            st_bf8((bf16_t*)(item + 16384) + c * 128 + d8, a0, a1); } }
#pragma unroll
        for (int i = 0; i < 3; ++i) { const int q = u + 384 * i; if (q < 1024) { const int d = q >> 3, g8 = q & 7;
            const u32x4 w = *(const LAS u32x4*)(KT + d * 144 + ((g8 ^ ((d >> 3) & 7)) << 4)); const f32x4 f0 = *(const LAS f32x4*)(SC + 576 + 8 * g8), f1 = *(const LAS f32x4*)(SC + 576 + 8 * g8 + 4);
            st_bf8((bf16_t*)(item + 40960) + d * 64 + 8 * g8, (f32x4){lo_bf(w.x), hi_bf(w.x), lo_bf(w.y), hi_bf(w.y)} * f0, (f32x4){lo_bf(w.z), hi_bf(w.z), lo_bf(w.w), hi_bf(w.w)} * f1); } }
        if (u == 0) ((float*)(p.ws + WS_DNEGL))[(b * 32 + n) * 6 + h] = SC[256 + 63];
        const float* ng = p.in[I_DNNORM] + layer * 128; bf16_t* ydn = (bf16_t*)(p.ws + WS_YDN) + ((size_t)b * SEQ + t0) * 768 + h * 128;
#pragma unroll
        for (int i = 0; i < 3; ++i) { const int q = u + 384 * i; if (q < 1024) { const int c = q >> 4, e8 = (q & 15) * 8; f32x4 z0, z1; ld_bf8(proj + (size_t)(t0 + c) * 3072 + 2304 + h * 128 + e8, z0, z1);
            const f32x4 g0 = *(const f32x4*)(ng + e8), g1 = *(const f32x4*)(ng + e8 + 4);
#pragma unroll
            for (int j = 0; j < 4; ++j) { z0[j] = g0[j] * siluf_(z0[j]); z1[j] = g1[j] * siluf_(z1[j]); }
            st_bf8(ydn + (size_t)c * 768 + e8, z0, z1); } }
    }
    LDS_BARRIER();
    if (wave < 4) {
        const int r = lane & 15, kg = lane >> 4, mt = wave >> 1, nt = wave & 1;
        const bf16x8 tb = *(const LAS bf16x8*)(T22L + (16 * mt + r) * 80 + kg * 16);
        f32x4 qt[2];
#pragma unroll
        for (int jt = 0; jt < 2; ++jt) { const LAS float* ap = AM + (63 - 16 * jt - r) * 68 + 24 - 8 * kg; const f32x4 lo = *(const LAS f32x4*)ap, hi = *(const LAS f32x4*)(ap + 4);
            u32x4 aw; aw.x = pk2(hi[3], hi[2]); aw.y = pk2(hi[1], hi[0]); aw.z = pk2(lo[3], lo[2]); aw.w = pk2(lo[1], lo[0]);
            qt[jt] = mfma16(__builtin_bit_cast(bf16x8, aw), tb, (f32x4){0.f, 0.f, 0.f, 0.f}); }
        u32x4 bw; bw.x = pk2(qt[0][0], qt[0][1]); bw.y = pk2(qt[0][2], qt[0][3]); bw.z = pk2(qt[1][0], qt[1][1]); bw.w = pk2(qt[1][2], qt[1][3]);
        const u32x2 a0 = *(const LAS u32x2*)(T11C + (16 * nt + r) * 80 + kg * 8), a1 = *(const LAS u32x2*)(T11C + (16 * nt + r) * 80 + 32 + kg * 8);
        u32x4 aw2; aw2.x = a0.x; aw2.y = a0.y; aw2.z = a1.x; aw2.w = a1.y;
        const f32x4 res = mfma16(__builtin_bit_cast(bf16x8, aw2), __builtin_bit_cast(bf16x8, bw), (f32x4){0.f, 0.f, 0.f, 0.f});
        const int row = 32 + 16 * mt + r, col0 = 16 * nt + 4 * kg;
        const f32x4 sw = *(const LAS f32x4*)(SC + 448 + col0), su = *(const LAS f32x4*)(SC + 128 + col0);
        u32x2 ow, ou; ow.x = pk2(-res[0] * sw[0], -res[1] * sw[1]); ow.y = pk2(-res[2] * sw[2], -res[3] * sw[3]); ou.x = pk2(-res[0] * su[0], -res[1] * su[1]); ou.y = pk2(-res[2] * su[2], -res[3] * su[3]);
        *(LAS u32x2*)(TW + row * 144 + col0 * 2) = ow; *(LAS u32x2*)(TU + row * 144 + col0 * 2) = ou;
    }
    LDS_BARRIER();
    TSUB(12);
    {
        const int r = lane & 15, kg = lane >> 4, ch = 16 * wave + r, sw = (ch >> 3) & 7;
        bf16x8 kf[2], vf[2], tw[4][2], tu[4][2];
#pragma unroll
        for (int ks = 0; ks < 2; ++ks) { kf[ks] = *(const LAS bf16x8*)(KT + ch * 144 + (((4 * ks + kg) ^ sw) << 4)); vf[ks] = *(const LAS bf16x8*)(VT + ch * 144 + (((4 * ks + kg) ^ sw) << 4)); }
#pragma unroll
        for (int it = 0; it < 4; ++it)
#pragma unroll
            for (int ks = 0; ks < 2; ++ks) { tw[it][ks] = *(const LAS bf16x8*)(TW + (16 * it + r) * 144 + (4 * ks + kg) * 16); tu[it][ks] = *(const LAS bf16x8*)(TU + (16 * it + r) * 144 + (4 * ks + kg) * 16); }
#pragma unroll
        for (int it = 0; it < 4; ++it) { f32x4 aw = (f32x4){0.f, 0.f, 0.f, 0.f}, au = aw;
#pragma unroll
            for (int ks = 0; ks < 2; ++ks) { aw = mfma16(kf[ks], tw[it][ks], aw); au = mfma16(tu[it][ks], vf[ks], au); }
            u32x2 o; o.x = pk2(aw[0], aw[1]); o.y = pk2(aw[2], aw[3]); *(u32x2*)((bf16_t*)item + (16 * it + r) * 128 + 16 * wave + 4 * kg) = o;
            o.x = pk2(au[0], au[1]); o.y = pk2(au[2], au[3]); *(u32x2*)(item + 57344 + (size_t)(16 * wave + r) * 128 + (16 * it + 4 * kg) * 2) = o; }
    }
    LDS_BARRIER();
    TSUB(13);
}
__device__ __forceinline__ float row16_sum(float v) {
    v += __builtin_bit_cast(float, __builtin_amdgcn_update_dpp(0, __builtin_bit_cast(int, v), 0xB1, 0xf, 0xf, false));
    v += __builtin_bit_cast(float, __builtin_amdgcn_update_dpp(0, __builtin_bit_cast(int, v), 0x4E, 0xf, 0xf, false));
    v += __builtin_bit_cast(float, __builtin_amdgcn_update_dpp(0, __builtin_bit_cast(int, v), 0x141, 0xf, 0xf, false));
    v += __builtin_bit_cast(float, __builtin_amdgcn_update_dpp(0, __builtin_bit_cast(int, v), 0x140, 0xf, 0xf, false));
    return v;
}
__device__ __forceinline__ void dn_scan(const Params& p, LAS unsigned char* lds, int layer, int b, int h) {
    const int tid = htid(), lane = tid & 63, wave = __builtin_amdgcn_readfirstlane(tid >> 6), r = lane & 15, kg = lane >> 4;
    LAS unsigned char* W = lds; LAS unsigned char* QD = lds + 17408; LAS unsigned char* ATT = lds + 34816; LAS unsigned char* KDT = lds + 44032; LAS unsigned char* UT = lds + 62464;
    LAS unsigned char* ST = lds + 80896; LAS unsigned char* VNT = lds + 115712; LAS float* PS = (LAS float*)(lds + 134144); LAS float* RS = (LAS float*)(lds + 136192) + wave * 64;
    const unsigned char* items = p.ws + WS_DNS + (size_t)(b * 32 * 6 + h) * DNS_ITEM;
    bf16_t* ydn = (bf16_t*)(p.ws + WS_YDN) + (size_t)b * SEQ * 768 + h * 128 + 16 * wave + r;
    float egl_all = lane < 32 ? ((const float*)(p.ws + WS_DNEGL))[b * 32 * 6 + h + 6 * lane] : 0.f;
    asm volatile("" : "+v"(egl_all));
    f32x4 S[8], o[4];
#pragma unroll
    for (int dt = 0; dt < 8; ++dt) S[dt] = (f32x4){0.f, 0.f, 0.f, 0.f};
#pragma unroll
    for (int mt = 0; mt < 4; ++mt) o[mt] = (f32x4){0.f, 0.f, 0.f, 0.f};
    for (int i = lane; i < 16 * 272 / 16; i += 64) *(LAS u32x4*)(ST + wave * 16 * 272 + i * 16) = (u32x4){0u, 0u, 0u, 0u};
    u32x4 R[9];
#pragma unroll
    for (int i = 0; i < 9; ++i) R[i] = *(const u32x4*)(items + (size_t)(tid + 512 * i) * 16);
    unsigned short zc[16];
#pragma unroll
    for (int i = 0; i < 16; ++i) zc[i] = 0u;
    LDS_BARRIER();
    for (int n = 0; n <= 32; ++n) {
        if (n < 32) {
#pragma unroll
            for (int i = 0; i < 9; ++i) { const int q = tid + 512 * i; LAS unsigned char* dst;
                if (i < 2) dst = W + (q >> 4) * 272 + (q & 15) * 16; else if (i < 4) dst = QD + ((q - 1024) >> 4) * 272 + (q & 15) * 16;
                else if (i < 5) dst = ATT + ((q - 2048) >> 3) * 144 + (q & 7) * 16; else if (i < 7) dst = KDT + ((q - 2560) >> 3) * 144 + (q & 7) * 16;
                else dst = UT + ((q - 3584) >> 3) * 144 + (q & 7) * 16;
                *(LAS u32x4*)dst = R[i]; }
        }
        if (n > 0) {
            float tot = 0.f;
#pragma unroll
            for (int w = 0; w < 8; ++w) tot += PS[w * 64 + lane];
            RS[lane] = rsqrtf(tot * (1.f / 128.f) + EPS);
#pragma unroll
            for (int mt = 0; mt < 4; ++mt) { const f32x4 rs = *(const LAS f32x4*)(RS + 16 * mt + 4 * kg);
#pragma unroll
                for (int rr = 0; rr < 4; rr += 2) { bf16_t* yo_ = ydn + (size_t)((n - 1) * 64 + 16 * mt + 4 * kg + rr) * 768;
                    ST2_BF(yo_, yo_ + 768, o[mt][rr] * rs[rr] * __uint_as_float(((unsigned)zc[4 * mt + rr]) << 16), o[mt][rr + 1] * rs[rr + 1] * __uint_as_float(((unsigned)zc[4 * mt + rr + 1]) << 16)); } }
        }
        if (n == 32) break;
        if (n + 1 < 32) {
#pragma unroll
            for (int i = 0; i < 9; ++i) R[i] = *(const u32x4*)(items + (size_t)(n + 1) * 6 * DNS_ITEM + (size_t)(tid + 512 * i) * 16);
        }
#pragma unroll
        for (int mt = 0; mt < 4; ++mt)
#pragma unroll
            for (int rr = 0; rr < 4; ++rr) zc[4 * mt + rr] = ydn[(size_t)(n * 64 + 16 * mt + 4 * kg + rr) * 768];
        const float egl = __builtin_bit_cast(float, __builtin_amdgcn_readlane(__builtin_bit_cast(int, egl_all), n));
        LDS_BARRIER();
        bf16x8 sf[4];
#pragma unroll
        for (int ks = 0; ks < 4; ++ks) sf[ks] = *(const LAS bf16x8*)(ST + (16 * wave + r) * 272 + ks * 64 + kg * 16);
        {   bf16x8 af[4][4]; u32x2 uw[4];
#pragma unroll
            for (int mt = 0; mt < 4; ++mt) {
#pragma unroll
                for (int ks = 0; ks < 4; ++ks) af[mt][ks] = *(const LAS bf16x8*)(W + (16 * mt + r) * 272 + ks * 64 + kg * 16);
                uw[mt] = *(const LAS u32x2*)(UT + (16 * wave + r) * 144 + (16 * mt + 4 * kg) * 2); }
#pragma unroll
            for (int mt = 0; mt < 4; ++mt) { f32x4 ws = (f32x4){0.f, 0.f, 0.f, 0.f};
#pragma unroll
                for (int ks = 0; ks < 4; ++ks) ws = mfma16(af[mt][ks], sf[ks], ws);
                const f32x4 vn = (f32x4){lo_bf(uw[mt].x), hi_bf(uw[mt].x), lo_bf(uw[mt].y), hi_bf(uw[mt].y)} - ws;
                u32x2 vw; vw.x = pk2(vn[0], vn[1]); vw.y = pk2(vn[2], vn[3]);
                *(LAS u32x2*)(VNT + (16 * wave + r) * 144 + (16 * mt + 4 * kg) * 2) = vw; } }
        bf16x8 vf[2];
        {
            bf16x8 qf[4][4], tf[4][2];
#pragma unroll
            for (int mt = 0; mt < 4; ++mt) {
#pragma unroll
                for (int ks = 0; ks < 4; ++ks) qf[mt][ks] = *(const LAS bf16x8*)(QD + (16 * mt + r) * 272 + ks * 64 + kg * 16);
#pragma unroll
                for (int kc = 0; kc < 2; ++kc) tf[mt][kc] = *(const LAS bf16x8*)(ATT + (16 * mt + r) * 144 + kc * 64 + kg * 16); }
#pragma unroll
            for (int kc = 0; kc < 2; ++kc) vf[kc] = *(const LAS bf16x8*)(VNT + (16 * wave + r) * 144 + kc * 64 + kg * 16);
#pragma unroll
            for (int mt = 0; mt < 4; ++mt) { f32x4 a = (f32x4){0.f, 0.f, 0.f, 0.f};
#pragma unroll
                for (int ks = 0; ks < 4; ++ks) a = mfma16(qf[mt][ks], sf[ks], a);
#pragma unroll
                for (int kc = 0; kc < 2; ++kc) a = mfma16(tf[mt][kc], vf[kc], a);
                o[mt] = a; } }
        {
            bf16x8 kf[8][2];
#pragma unroll
            for (int dt = 0; dt < 8; ++dt)
#pragma unroll
                for (int kc = 0; kc < 2; ++kc) kf[dt][kc] = *(const LAS bf16x8*)(KDT + (16 * dt + r) * 144 + kc * 64 + kg * 16);
#pragma unroll
            for (int dt = 0; dt < 8; ++dt) { f32x4 a = S[dt] * egl;
#pragma unroll
                for (int kc = 0; kc < 2; ++kc) a = mfma16(kf[dt][kc], vf[kc], a);
                S[dt] = a; u32x2 sw; sw.x = pk2(a[0], a[1]); sw.y = pk2(a[2], a[3]);
                *(LAS u32x2*)(ST + (16 * wave + r) * 272 + (16 * dt + 4 * kg) * 2) = sw; } }
#pragma unroll
        for (int mt = 0; mt < 4; ++mt) { f32x4 q;
#pragma unroll
            for (int rr = 0; rr < 4; ++rr) q[rr] = row16_sum(o[mt][rr] * o[mt][rr]);
            if (r == 0) *(LAS f32x4*)(PS + wave * 64 + 16 * mt + 4 * kg) = q; }
        LDS_BARRIER();
    }
    LDS_BARRIER();
}
template <int MODE>
__device__ __forceinline__ void ssd_load(const Params& p, LAS unsigned char* lds, int layer, int b, int c, int grp) {
    const int tid = htid(), lane = tid & 63, wave = tid >> 6, t0 = c * 64;
    LAS float* DT = (LAS float*)(lds + 117760); LAS float* ACS = DT + 384;
    LAS unsigned char* XT = lds + 34816;
    if (wave < 6) { const int hh = grp * 6 + wave; const float* small = (const float*)(p.ws + WS_SMALL) + ((size_t)b * SEQ + t0 + lane) * 32;
        const float dt = softplusf_(small[12 + hh] + p.in[I_SSDTB][layer * 12 + hh]); float a = -expf(p.in[I_SSALOG][layer * 12 + hh]) * dt;
#pragma unroll
        for (int o = 1; o < 64; o <<= 1) { const float t = __shfl_up(a, o); if (lane >= o) a += t; }
        DT[wave * 64 + lane] = dt; ACS[wave * 64 + lane] = a; }
    LDS_BARRIER();
    const int cg = tid % 80, seg = tid / 80, ch8 = cg * 8;
    if (tid < 480 && (MODE == 1 || ch8 < 512)) {
        const int col = ch8 < 384 ? grp * 384 + ch8 : (ch8 < 512 ? 768 + grp * 128 + (ch8 - 384) : 1024 + grp * 128 + (ch8 - 512));
        const float* cw = p.in[I_SSCONV] + (size_t)layer * 4 * 1280 + col; const float* cb = p.in[I_SSCONVB] + layer * 1280 + col;
        f32x4 w[4][2], bias[2];
#pragma unroll
        for (int j = 0; j < 4; ++j) { w[j][0] = *(const f32x4*)(cw + j * 1280); w[j][1] = *(const f32x4*)(cw + j * 1280 + 4); }
        bias[0] = *(const f32x4*)cb; bias[1] = *(const f32x4*)(cb + 4);
        const bf16_t* proj = (const bf16_t*)(p.ws + WS_PSSM) + (size_t)b * SEQ * 2048 + col;
        const int ts = seg * 11, hi = ch8 >> 6;
        f32x4 xm[3][2];
#pragma unroll
        for (int i = 0; i < 3; ++i) { const int t = t0 + ts - 3 + i; xm[i][0] = (f32x4){0.f, 0.f, 0.f, 0.f}; xm[i][1] = xm[i][0]; if (t >= 0) ld_bf8(proj + (size_t)t * 2048, xm[i][0], xm[i][1]); }
#pragma unroll
        for (int i = 0; i < 11; ++i) { const int tk = ts + i;
            if (tk < 64) { f32x4 c0, c1; ld_bf8(proj + (size_t)(t0 + tk) * 2048, c0, c1);
                f32x4 a0 = bias[0] + w[3][0] * c0 + w[2][0] * xm[2][0] + w[1][0] * xm[1][0] + w[0][0] * xm[0][0];
                f32x4 a1 = bias[1] + w[3][1] * c1 + w[2][1] * xm[2][1] + w[1][1] * xm[1][1] + w[0][1] * xm[0][1];
                xm[0][0] = xm[1][0]; xm[0][1] = xm[1][1]; xm[1][0] = xm[2][0]; xm[1][1] = xm[2][1]; xm[2][0] = c0; xm[2][1] = c1;
#pragma unroll
                for (int q = 0; q < 4; ++q) { a0[q] = siluf_(a0[q]); a1[q] = siluf_(a1[q]); }
                if (ch8 < 384) { const float sc = MODE == 0 ? DT[hi * 64 + tk] * fexp(ACS[hi * 64 + 63] - ACS[hi * 64 + tk]) : DT[hi * 64 + tk];
#pragma unroll
                    for (int q = 0; q < 4; ++q) { const unsigned pw = pk2(a0[q] * sc, a1[q] * sc);
                        *(LAS bf16_t*)(XT + (ch8 + q) * 144 + tk * 2) = (bf16_t)(pw & 0xffffu); *(LAS bf16_t*)(XT + (ch8 + 4 + q) * 144 + tk * 2) = (bf16_t)(pw >> 16); } }
                else if (MODE == 0) {
#pragma unroll
                    for (int q = 0; q < 4; ++q) { const unsigned pw = pk2(a0[q], a1[q]);
                        *(LAS bf16_t*)(lds + (ch8 - 384 + q) * 144 + tk * 2) = (bf16_t)(pw & 0xffffu); *(LAS bf16_t*)(lds + (ch8 - 384 + 4 + q) * 144 + tk * 2) = (bf16_t)(pw >> 16); } }
                else { u32x4 pw; pw.x = pk2(a0[0], a0[1]); pw.y = pk2(a0[2], a0[3]); pw.z = pk2(a1[0], a1[1]); pw.w = pk2(a1[2], a1[3]);
                    *(LAS u32x4*)(lds + (ch8 < 512 ? 17408 + tk * 272 + (ch8 - 384) * 2 : tk * 272 + (ch8 - 512) * 2)) = pw; } } }
    }
    LDS_BARRIER();
}
__device__ __forceinline__ void ssd_states(const Params& p, LAS unsigned char* lds, int layer, int b, int c, int grp) {
    ssd_load<0>(p, lds, layer, b, c, grp);
    const int tid = htid(), lane = tid & 63, wave = tid >> 6, r = lane & 15, kg = lane >> 4;
    const LAS unsigned char* XT = lds + 34816; const LAS unsigned char* BT = lds; const LAS float* ACS = (const LAS float*)(lds + 117760) + 384;
    bf16_t* st = (bf16_t*)(p.ws + WS_SSST) + ((size_t)(b * 32 + c) * 12 + grp * 6) * 8192;
    for (int t4 = 0; t4 < 24; t4 += 4) {
        bf16x8 af[4][2], bfr[4][2];
#pragma unroll
        for (int q = 0; q < 4; ++q) { const int t = wave + 8 * (t4 + q), hi = t >> 5, mt = (t >> 3) & 3, nt = t & 7;
#pragma unroll
            for (int ks = 0; ks < 2; ++ks) { af[q][ks] = *(const LAS bf16x8*)(XT + (hi * 64 + 16 * mt + r) * 144 + ks * 64 + kg * 16); bfr[q][ks] = *(const LAS bf16x8*)(BT + (16 * nt + r) * 144 + ks * 64 + kg * 16); } }
#pragma unroll
        for (int q = 0; q < 4; ++q) { const int t = wave + 8 * (t4 + q), hi = t >> 5, mt = (t >> 3) & 3, nt = t & 7;
            f32x4 acc = (f32x4){0.f, 0.f, 0.f, 0.f};
#pragma unroll
            for (int ks = 0; ks < 2; ++ks) acc = mfma16(af[q][ks], bfr[q][ks], acc);
#pragma unroll
            for (int rr = 0; rr < 4; rr += 2) { bf16_t* so_ = st + (size_t)hi * 8192 + (16 * mt + 4 * kg + rr) * 128 + 16 * nt + r; ST2_BF(so_, so_ + 128, acc[rr], acc[rr + 1]); } }
    }
    if (tid < 6) ((float*)(p.ws + WS_SSCD))[(b * 32 + c) * 12 + grp * 6 + tid] = expf(ACS[tid * 64 + 63]);
    LDS_BARRIER();
}
__device__ __forceinline__ void ssd_scan(const Params& p, int first_blk, int nblk) {
    const int gt = ((int)blockIdx.x - first_blk) * 512 + htid(), NT = nblk * 512;
    const u32x4* st = (const u32x4*)(p.ws + WS_SSST); const float* cd = (const float*)(p.ws + WS_SSCD); u32x4* pv = (u32x4*)(p.ws + WS_SSPV);
    for (int v = gt; v < NB * 12 * 1024; v += NT) { const int b = v / (12 * 1024), h = (v / 1024) % 12, e = v % 1024;
        f32x4 r0 = (f32x4){0.f, 0.f, 0.f, 0.f}, r1 = r0;
        for (int c0 = 0; c0 < 32; c0 += 8) { u32x4 t[8]; float dc[8];
#pragma unroll
            for (int i = 0; i < 8; ++i) { t[i] = st[((size_t)(b * 32 + c0 + i) * 12 + h) * 1024 + e]; dc[i] = cd[(b * 32 + c0 + i) * 12 + h]; }
#pragma unroll
            for (int i = 0; i < 8; ++i) { u32x4 w; w.x = pk2(r0[0], r0[1]); w.y = pk2(r0[2], r0[3]); w.z = pk2(r1[0], r1[1]); w.w = pk2(r1[2], r1[3]); pv[((size_t)(b * 32 + c0 + i) * 12 + h) * 1024 + e] = w;
                r0 = r0 * dc[i] + (f32x4){lo_bf(t[i].x), hi_bf(t[i].x), lo_bf(t[i].y), hi_bf(t[i].y)}; r1 = r1 * dc[i] + (f32x4){lo_bf(t[i].z), hi_bf(t[i].z), lo_bf(t[i].w), hi_bf(t[i].w)}; } }
    }
}
__device__ __forceinline__ void ssd_out(const Params& p, LAS unsigned char* lds, int layer, int b, int c, int grp) {
    ssd_load<1>(p, lds, layer, b, c, grp);
    const int tid = htid(), lane = tid & 63, wave = tid >> 6, r = lane & 15, kg = lane >> 4, t0 = c * 64;
    const LAS unsigned char* CM = lds; const LAS unsigned char* BM = lds + 17408; const LAS unsigned char* XT = lds + 34816; LAS unsigned char* MH = lds + 90112;
    const LAS float* DT = (const LAS float*)(lds + 117760); const LAS float* ACS = DT + 384; LAS float* YG = (LAS float*)lds;
    const bf16_t* prev = (const bf16_t*)(p.ws + WS_SSPV) + ((size_t)(b * 32 + c) * 12 + grp * 6) * 8192;
    f32x4 cb[2];
    {   bf16x8 ca[2][4], cbf[2][4];
#pragma unroll
        for (int q = 0; q < 2; ++q) { const int t = wave * 2 + q, mt = t >> 2, nt = t & 3;
#pragma unroll
            for (int ks = 0; ks < 4; ++ks) { ca[q][ks] = *(const LAS bf16x8*)(CM + (16 * mt + r) * 272 + ks * 64 + kg * 16); cbf[q][ks] = *(const LAS bf16x8*)(BM + (16 * nt + r) * 272 + ks * 64 + kg * 16); } }
#pragma unroll
        for (int q = 0; q < 2; ++q) { f32x4 acc = (f32x4){0.f, 0.f, 0.f, 0.f};
#pragma unroll
            for (int ks = 0; ks < 4; ++ks) acc = mfma16(ca[q][ks], cbf[q][ks], acc);
            cb[q] = acc; } }
    f32x4 y[2][6];
#pragma unroll
    for (int half = 0; half < 2; ++half) {
#pragma unroll
        for (int q = 0; q < 2; ++q) { const int t = wave * 2 + q, mt = t >> 2, nt = t & 3, j = 16 * nt + r;
#pragma unroll
            for (int hl = 0; hl < 3; ++hl) { const int hi = 3 * half + hl; const float aj = ACS[hi * 64 + j];
#pragma unroll
                for (int rr = 0; rr < 4; ++rr) { const int i = 16 * mt + 4 * kg + rr; *(LAS bf16_t*)(MH + hl * 9216 + i * 144 + j * 2) = (bf16_t)f2bf((i >= j) ? cb[q][rr] * fexp(fminf(ACS[hi * 64 + i] - aj, 0.f)) : 0.f); } } }
        bf16x8 pf[6][4];
#pragma unroll
        for (int k = 0; k < 6; ++k) { const int t = wave + 8 * k, hl = t >> 4, nt = t & 3, hi = 3 * half + hl; const bf16_t* pr = prev + (size_t)hi * 8192 + (16 * nt + r) * 128 + kg * 8;
#pragma unroll
            for (int ks = 0; ks < 4; ++ks) pf[k][ks] = *(const bf16x8*)(pr + ks * 32); }
        LDS_BARRIER();
#pragma unroll
        for (int k = 0; k < 6; ++k) { const int t = wave + 8 * k, hl = t >> 4, mt = (t >> 2) & 3, nt = t & 3, hi = 3 * half + hl, hh = grp * 6 + hi;
            f32x4 acc = (f32x4){0.f, 0.f, 0.f, 0.f}, off = acc;
            bf16x8 mf[2], xf[2], cf[4];
#pragma unroll
            for (int ks = 0; ks < 2; ++ks) { mf[ks] = *(const LAS bf16x8*)(MH + hl * 9216 + (16 * mt + r) * 144 + ks * 64 + kg * 16); xf[ks] = *(const LAS bf16x8*)(XT + (hi * 64 + 16 * nt + r) * 144 + ks * 64 + kg * 16); }
#pragma unroll
            for (int ks = 0; ks < 4; ++ks) cf[ks] = *(const LAS bf16x8*)(CM + (16 * mt + r) * 272 + ks * 64 + kg * 16);
#pragma unroll
            for (int ks = 0; ks < 2; ++ks) acc = mfma16(mf[ks], xf[ks], acc);
#pragma unroll
            for (int ks = 0; ks < 4; ++ks) off = mfma16(cf[ks], pf[k][ks], off);
            const u32x2 xw = *(const LAS u32x2*)(XT + (hi * 64 + 16 * nt + r) * 144 + (16 * mt + 4 * kg) * 2); const float xs[4] = {lo_bf(xw.x), hi_bf(xw.x), lo_bf(xw.y), hi_bf(xw.y)};
            const float dsk = p.in[I_SSD][layer * 12 + hh];
#pragma unroll
            for (int rr = 0; rr < 4; ++rr) { const int i = 16 * mt + 4 * kg + rr; acc[rr] += fexp(ACS[hi * 64 + i]) * off[rr] + dsk * xs[rr] * __builtin_amdgcn_rcpf(fmaxf(DT[hi * 64 + i], 1e-30f)); }
            y[half][k] = acc; }
        LDS_BARRIER();
    }
    const bf16_t* zp = (const bf16_t*)(p.ws + WS_PSSM) + ((size_t)b * SEQ + t0) * 2048 + 1280 + grp * 384;
#pragma unroll
    for (int half = 0; half < 2; ++half)
#pragma unroll
        for (int k = 0; k < 6; ++k) { const int t = wave + 8 * k, hl = t >> 4, mt = (t >> 2) & 3, nt = t & 3, hi = 3 * half + hl, ch = hi * 64 + 16 * nt + r;
#pragma unroll
            for (int rr = 0; rr < 4; ++rr) { const int i = 16 * mt + 4 * kg + rr; const float z = bf2f(zp[(size_t)i * 2048 + ch]); YG[i * 388 + ch] = y[half][k][rr] * siluf_(z); } }
    LDS_BARRIER();
    const float* sn = p.in[I_SSNORM] + layer * 768 + grp * 384; bf16_t* yo = (bf16_t*)(p.ws + WS_YSSM) + ((size_t)b * SEQ + t0) * 768 + grp * 384;
#pragma unroll
    for (int i8 = 0; i8 < 8; ++i8) { const int i = 8 * wave + i8; float v[6], ss = 0.f;
#pragma unroll
        for (int k = 0; k < 6; ++k) { v[k] = YG[i * 388 + lane + 64 * k]; ss += v[k] * v[k]; }
        const float rs = rsqrtf(wave_sum(ss) * (1.f / 384.f) + EPS);
#pragma unroll
        for (int k = 0; k < 6; k += 2) ST2_BF(yo + (size_t)i * 768 + lane + 64 * k, yo + (size_t)i * 768 + lane + 64 * (k + 1), v[k] * rs * sn[lane + 64 * k], v[k + 1] * rs * sn[lane + 64 * (k + 1)]); }
    LDS_BARRIER();
}

typedef float f32x16 __attribute__((ext_vector_type(16)));
__device__ __forceinline__ void attn_tile(const Params& p, int b, int g, int j, int r, int qt, int lane) {
    const int d = g == 0 ? 1 : (g == 1 ? 4 : 16), L = SEQ / d, n = lane & 31, hw = lane >> 5;
    const int P0 = b * SEQ + r * L;
    const bf16_t* Q = (const bf16_t*)(p.ws + WS_QK) + (size_t)(0 * 3 + g) * TC * 256 + j * 64;
    const bf16_t* K = (const bf16_t*)(p.ws + WS_QK) + (size_t)(1 * 3 + g) * TC * 256 + j * 64;
    const bf16_t* V = (const bf16_t*)(p.ws + WS_VT) + (size_t)(g * 256 + j * 64) * TC;
    const float sl2 = exp2f(-8.f * (float)(4 * g + j + 1) / 12.f) * (float)d * 1.4426950408889634f;
    bf16x8 qf[4];
    { const bf16_t* qrow = Q + (size_t)(P0 + 32 * qt + n) * 256 + 8 * hw;
#pragma unroll
      for (int s = 0; s < 4; ++s) qf[s] = *(const bf16x8*)(qrow + 16 * s); }
    f32x16 o0, o1;
#pragma unroll
    for (int i = 0; i < 16; ++i) { o0[i] = 0.f; o1[i] = 0.f; }
    float mrun = -1e30f, lrun = 0.f;
    const int pim = (n & 0x13) | (((n >> 2) & 1) << 3) | (((n >> 3) & 1) << 2);
    const int qi = 32 * qt + n;
    const int kb0 = qt > 4 ? qt - 4 : 0;
    bf16x8 kf[4], vf[2][2];
    { const bf16_t* krow = K + (size_t)(P0 + 32 * kb0 + pim) * 256 + 8 * hw;
#pragma unroll
      for (int s = 0; s < 4; ++s) kf[s] = *(const bf16x8*)(krow + 16 * s);
#pragma unroll
      for (int sp = 0; sp < 2; ++sp)
#pragma unroll
          for (int dh = 0; dh < 2; ++dh) vf[sp][dh] = *(const bf16x8*)(V + (size_t)(32 * dh + n) * TC + P0 + 32 * kb0 + 16 * sp + 8 * hw); }
    for (int kb = kb0; kb <= qt; ++kb) {
        f32x16 st;
#pragma unroll
        for (int i = 0; i < 16; ++i) st[i] = 0.f;
#pragma unroll
        for (int s = 0; s < 4; ++s) st = __builtin_amdgcn_mfma_f32_32x32x16_bf16(kf[s], qf[s], st, 0, 0, 0);
        bf16x8 vc[2][2];
#pragma unroll
        for (int sp = 0; sp < 2; ++sp)
#pragma unroll
            for (int dh = 0; dh < 2; ++dh) vc[sp][dh] = vf[sp][dh];
        if (kb < qt) {
            const bf16_t* krow = K + (size_t)(P0 + 32 * (kb + 1) + pim) * 256 + 8 * hw;
#pragma unroll
            for (int s = 0; s < 4; ++s) kf[s] = *(const bf16x8*)(krow + 16 * s);
#pragma unroll
            for (int sp = 0; sp < 2; ++sp)
#pragma unroll
                for (int dh = 0; dh < 2; ++dh) vf[sp][dh] = *(const bf16x8*)(V + (size_t)(32 * dh + n) * TC + P0 + 32 * (kb + 1) + 16 * sp + 8 * hw);
        }
        float mx = -1e30f;
#pragma unroll
        for (int jj = 0; jj < 16; ++jj) { const int kidx = 32 * kb + 16 * (jj >> 3) + 8 * hw + 4 * ((jj >> 2) & 1) + (jj & 3); const int dl = qi - kidx;
            const float sc = (dl >= 0 && dl <= 128) ? st[jj] * 1.4426950408889634f - sl2 * (float)dl : -1e30f; st[jj] = sc; mx = fmaxf(mx, sc); }
        mx = fmaxf(mx, __shfl_xor(mx, 32));
        const float mnew = fmaxf(mrun, mx), alpha = __builtin_amdgcn_exp2f(mrun - mnew);
        float rs = 0.f;
#pragma unroll
        for (int jj = 0; jj < 16; ++jj) { const float pj = __builtin_amdgcn_exp2f(st[jj] - mnew); st[jj] = pj; rs += pj; }
        rs += __shfl_xor(rs, 32);
        lrun = lrun * alpha + rs; mrun = mnew;
#pragma unroll
        for (int i = 0; i < 16; ++i) { o0[i] *= alpha; o1[i] *= alpha; }
#pragma unroll
        for (int sp = 0; sp < 2; ++sp) {
            u32x4 pw; pw.x = pk2(st[8 * sp + 0], st[8 * sp + 1]); pw.y = pk2(st[8 * sp + 2], st[8 * sp + 3]); pw.z = pk2(st[8 * sp + 4], st[8 * sp + 5]); pw.w = pk2(st[8 * sp + 6], st[8 * sp + 7]);
            const bf16x8 pf = __builtin_bit_cast(bf16x8, pw);
            o0 = __builtin_amdgcn_mfma_f32_32x32x16_bf16(vc[sp][0], pf, o0, 0, 0, 0);
            o1 = __builtin_amdgcn_mfma_f32_32x32x16_bf16(vc[sp][1], pf, o1, 0, 0, 0);
        }
    }
    const float inv = 1.f / lrun;
    const int tok = b * SEQ + qi * d + r;
    bf16_t* og = (bf16_t*)(p.ws + WS_OG) + ((size_t)g * TC + tok) * 256 + j * 64 + 4 * hw;
#pragma unroll
    for (int q4 = 0; q4 < 4; ++q4) {
        u32x2 w0, w1; w0.x = pk2(o0[4 * q4] * inv, o0[4 * q4 + 1] * inv); w0.y = pk2(o0[4 * q4 + 2] * inv, o0[4 * q4 + 3] * inv);
        w1.x = pk2(o1[4 * q4] * inv, o1[4 * q4 + 1] * inv); w1.y = pk2(o1[4 * q4 + 2] * inv, o1[4 * q4 + 3] * inv);
        *(u32x2*)(og + 8 * q4) = w0; *(u32x2*)(og + 32 + 8 * q4) = w1;
    }
    if (hw == 0) ((float*)(p.ws + WS_LSE))[((size_t)g * TC + tok) * 4 + j] = (mrun + log2f(lrun)) * 0.6931471805599453f;
}
__device__ __forceinline__ void phase_attn_combine(const Params& p, int skip) {
    const int tid_ = htid(), lane = tid_ & 63, gw = ((int)blockIdx.x - skip) * 8 + (tid_ >> 6), NGW = ((int)gridDim.x - skip) * 8;
    const bf16_t* og = (const bf16_t*)(p.ws + WS_OG); const float* lse = (const float*)(p.ws + WS_LSE); bf16_t* ya = (bf16_t*)(p.ws + WS_YATT);
    for (int t = gw; t < TC; t += NGW) {
        const int j = lane >> 4;
        const float l0 = lse[((size_t)0 * TC + t) * 4 + j], l1 = lse[((size_t)1 * TC + t) * 4 + j], l2 = lse[((size_t)2 * TC + t) * 4 + j];
        const float M = fmaxf(l0, fmaxf(l1, l2)); float w0 = expf(l0 - M), w1 = expf(l1 - M), w2 = expf(l2 - M); const float iw = 1.f / (w0 + w1 + w2); w0 *= iw; w1 *= iw; w2 *= iw;
        const u32x2 a = *((const u32x2*)(og + ((size_t)0 * TC + t) * 256) + lane), bb = *((const u32x2*)(og + ((size_t)1 * TC + t) * 256) + lane), c = *((const u32x2*)(og + ((size_t)2 * TC + t) * 256) + lane);
        u32x2 o; o.x = pk2(w0 * lo_bf(a.x) + w1 * lo_bf(bb.x) + w2 * lo_bf(c.x), w0 * hi_bf(a.x) + w1 * hi_bf(bb.x) + w2 * hi_bf(c.x));
        o.y = pk2(w0 * lo_bf(a.y) + w1 * lo_bf(bb.y) + w2 * lo_bf(c.y), w0 * hi_bf(a.y) + w1 * hi_bf(bb.y) + w2 * hi_bf(c.y));
        *((u32x2*)(ya + (size_t)t * 256) + lane) = o;
    }
}
__device__ __forceinline__ void sub_barrier(unsigned* cnt, unsigned target) {
    asm volatile("s_waitcnt vmcnt(0)" ::: "memory");
    __syncthreads();
    if (threadIdx.x == 0) {
        __builtin_amdgcn_fence(__ATOMIC_RELEASE, "agent"); asm volatile("s_waitcnt vmcnt(0)" ::: "memory");
        (void)xb_add(cnt, 1u);
        unsigned sp = 0; while (xb_ld(cnt) < target) { __builtin_amdgcn_s_sleep(2); if (++sp > (1u << 24)) break; }
        __builtin_amdgcn_fence(__ATOMIC_ACQUIRE, "agent"); asm volatile("s_waitcnt vmcnt(0)" ::: "memory");
    }
    __syncthreads();
}
__device__ __forceinline__ void phase_mixers(const Params& p, LAS unsigned char* lds, int layer) {
    const int G = gridDim.x, NDP = NB * 32 * 6, NSS = NB * 32 * 2;
    TSUB(15);
    u32x4 xr[10];
#pragma unroll
    for (int i = 0; i < 10; ++i) xr[i] = (u32x4){0u, 0u, 0u, 0u};
    if ((int)blockIdx.x < NDP) dn_fetch(p, (int)blockIdx.x / 192, ((int)blockIdx.x / 6) % 32, (int)blockIdx.x % 6, xr);
    for (int item = blockIdx.x; item < NDP + NSS; item += G) {
        if (item < NDP) { const int nx = item + G; dn_prep(p, lds, layer, item / 192, (item / 6) % 32, item % 6, xr, nx < NDP, nx / 192, (nx / 6) % 32, nx % 6); TSUB(6); }
        else { const int it = item - NDP; ssd_states(p, lds, layer, it / 64, (it >> 1) & 31, it & 1); TSUB(7); }
    }
}
__device__ __forceinline__ void phase_mixers2(const Params& p, LAS unsigned char* lds, int layer, int rep, unsigned* subcnt, bool use_bar2) {
    const int tid_ = htid(), lane = tid_ & 63, wave = tid_ >> 6, G = gridDim.x, nscan = NB * 6;
    const int ded = G > 2 * nscan ? nscan : 0;
    TSUB(15);
    if ((int)blockIdx.x < ded) { if (!(MIX2_PROBE == 2 && rep > 0)) dn_scan(p, lds, layer, blockIdx.x / 6, blockIdx.x % 6); TSUB(0); return; }
    if (MIX2_PROBE == 1 && rep > 0) return;
    if (ded == 0) for (int it = blockIdx.x; it < nscan; it += G) dn_scan(p, lds, layer, it / 6, it % 6);
    const int nb = G - ded, rb = (int)blockIdx.x - ded;
    for (int item = rb; item < NB * 3 * 4 * 64 / 8; item += nb) { const int w = item * 8 + wave;
        const int st = w & 63, jj = (w >> 6) & 3, gg = (w >> 8) % 3, bb = w / 768;
        const int dd = gg == 0 ? 1 : (gg == 1 ? 4 : 16), tiles = SEQ / dd / 32;
        attn_tile(p, bb, gg, jj, st / tiles, st % tiles, lane); }
    TSUB(1);
    ssd_scan(p, ded, nb);
    TSUB(2);
    if (use_bar2) { XcdBarrier bar2; bar2.bar = (unsigned*)(p.ws + WS_CTL) + CW_BAR2; bar2.x = xb_xcc_id(); bar2.st = (volatile LAS unsigned*)(lds + LDS_BYTES - 256) + 12; xcd_barrier(bar2, (unsigned)nb); } else sub_barrier(subcnt, (unsigned)(nb * (rep + 1)));
    TSUB(3);
    for (int it = rb; it < NB * 32 * 2; it += nb) ssd_out(p, lds, layer, it / 64, (it >> 1) & 31, it & 1);
    TSUB(4);
    phase_attn_combine(p, ded);
    TSUB(5);
}

constexpr int NSTEPS = 1 + NCH * (8 + 11 + 1);
__global__ void __launch_bounds__(512, 2) hybrid_fwd(Params p) {
    extern __shared__ __attribute__((aligned(16))) unsigned char lds_raw[];
    LAS unsigned char* lds = (LAS unsigned char*)lds_raw;
    volatile LAS unsigned* MISC = (volatile LAS unsigned*)(lds + LDS_BYTES - 256);
    if (threadIdx.x < 64) MISC[threadIdx.x] = 0u;
    __syncthreads();
    const int G = gridDim.x, cid = blockIdx.x;
    unsigned char* ws = p.ws;
    XcdBarrier bar; bar.bar = (unsigned*)(ws + WS_CTL) + CW_BAR; bar.x = 0; bar.st = MISC + 8;
    if (p.s_hi - p.s_lo > 1) bar = xcd_barrier_post((unsigned*)(ws + WS_CTL) + CW_BAR, MISC + 8);
    const bool use_bar2 = (p.s_hi - p.s_lo == NSTEPS) && ((int)gridDim.x > 2 * NB * 6);
    if (use_bar2 && (int)blockIdx.x >= NB * 6 && threadIdx.x == 0) (void)xb_add((unsigned*)(ws + WS_CTL) + CW_BAR2 + XB_XCNT(xb_xcc_id()), 1u);
    const int lo = p.s_lo, hi = p.s_hi;
    int step = 0;
    if (TPROBE_MASK != 0u && threadIdx.x == 0) { volatile LAS unsigned long long* tp_ = (volatile LAS unsigned long long*)(lds + LDS_BYTES - 256 + 128); tp_[0] = 0ull; tp_[1] = __builtin_amdgcn_s_memrealtime(); tp_[2] = 21ull; }
#define IN_STEP (step >= lo && step < hi)
#define END_STEP do { if (step >= lo && step + 1 < hi) xcd_barrier(bar); \
        if (TPROBE_ON && threadIdx.x == 0) { volatile LAS unsigned long long* tp_ = (volatile LAS unsigned long long*)(lds + LDS_BYTES - 256 + 128); const unsigned long long tn_ = __builtin_amdgcn_s_memrealtime(); \
            const unsigned pos_ = (unsigned)tp_[2]; if (pos_ < 22u && ((p.tmask >> pos_) & 1u)) tp_[0] += tn_ - tp_[1]; tp_[1] = tn_; tp_[2] = pos_ >= 20u ? 1ull : (unsigned long long)(pos_ + 1u); } \
        ++step; } while (0)
    bf16_t* xb = (bf16_t*)(ws + WS_XB); float* ssq = (float*)(ws + WS_SSQ);
    if (IN_STEP) for (int rep_ = 0; rep_ < (REP_PH == 0 ? 3 : 1); ++rep_, (rep_ < (REP_PH == 0 ? 3 : 1) ? xcd_barrier(bar) : (void)0)) { phase_convert(p, lds); phase_chunk_in(p, 0); }
    END_STEP;
    for (int chunk = 0; chunk < NCH; ++chunk) {
        float* xo = p.out + (size_t)chunk * TC * D;
        for (int layer = 0; layer < DEPTH; ++layer) {
            if (IN_STEP) for (int rep_ = 0; rep_ < (REP_PH == 2 ? 3 : 1); ++rep_, (rep_ < (REP_PH == 2 ? 3 : 1) ? xcd_barrier(bar) : (void)0)) {
                ProgIn P; P.S.init(TC / 256, INP / 256, G, cid); P.xb = layer == 0 ? xb : (const bf16_t*)(ws + WS_XB2); P.Wt = (const bf16_t*)(ws + WS_WIN) + (size_t)layer * INP * D; P.ssq = layer == 0 ? ssq : (const float*)(ws + WS_SSQ2);
                P.wsb = ws; P.pb = (const bf16_t*)(ws + WS_PB) + (size_t)layer * TC * PLE; P.wple = (const bf16_t*)(ws + WS_WPLE) + (size_t)layer * D * PLE;
                gemm_phase(lds, P);
            }
            END_STEP;
            if (IN_STEP) for (int rep_ = 0; rep_ < (REP_PH == 3 ? 3 : 1); ++rep_, (rep_ < (REP_PH == 3 ? 3 : 1) ? xcd_barrier(bar) : (void)0)) phase_mixers(p, lds, layer);
            END_STEP;
            if (IN_STEP) for (int rep_ = 0; rep_ < (REP_PH == 4 ? 3 : 1); ++rep_, (rep_ < (REP_PH == 4 ? 3 : 1) ? xcd_barrier(bar) : (void)0)) phase_mixers2(p, lds, layer, rep_, (unsigned*)(ws + WS_CTL) + CW_SUB + (chunk * 2 + layer) * 64, use_bar2);
            END_STEP;
            if (IN_STEP) for (int rep_ = 0; rep_ < (REP_PH == 6 ? 3 : 1); ++rep_, (rep_ < (REP_PH == 6 ? 3 : 1) ? xcd_barrier(bar) : (void)0)) {
                ProgMerge P; P.S.init(TC / 256, 4, G, cid); P.wsb = ws;
                P.wdn = (const bf16_t*)(ws + WS_WDN) + (size_t)layer * D * 768; P.wssm = (const bf16_t*)(ws + WS_WSSM) + (size_t)layer * D * 768; P.watt = (const bf16_t*)(ws + WS_WATT) + (size_t)layer * D * 256;
                gemm_phase(lds, P);
            }
            END_STEP;
            if (IN_STEP) {
                ProgResid P; P.S.init(TC / 256, 4, G, cid); P.A = (const bf16_t*)(ws + WS_MERGED); P.lda = 2048; P.nt = 16; P.Wt = (const bf16_t*)(ws + WS_WOUT) + (size_t)layer * D * D; P.ldb = 2048;
                P.xin_f = layer == 0 ? p.in[I_X] + (size_t)chunk * TC * D : nullptr; P.xin_b = (const bf16_t*)(ws + WS_XB2); P.xb = xb; P.ssq = ssq; P.sc = 1.f;
                gemm_phase(lds, P);
            }
            END_STEP;
            if (layer == 0) {
                if (IN_STEP) for (int rep_ = 0; rep_ < (REP_PH == 8 ? 3 : 1); ++rep_, (rep_ < (REP_PH == 8 ? 3 : 1) ? xcd_barrier(bar) : (void)0)) {
                    ProgFfnGu P; P.S.init(TC / 256, 2 * FFN / 256, G, cid); P.xb = xb; P.Wt = (const bf16_t*)(ws + WS_WFGU); P.ssq = ssq; P.act = (bf16_t*)(ws + WS_ACT);
                    gemm_phase(lds, P);
                }
                END_STEP;
                if (IN_STEP) {
                    ProgResid P; P.S.init(TC / 256, 4, G, cid); P.A = (const bf16_t*)(ws + WS_ACT); P.lda = 2 * FFN; P.nt = FFN / 64; P.Wt = (const bf16_t*)(ws + WS_WFD); P.ldb = 2 * FFN;
                    P.xin_f = nullptr; P.xin_b = xb; P.xb = xb; P.ssq = ssq; P.sc = (DBG_ABL & 8) ? 0.f : 1.f;
                    gemm_phase(lds, P);
                }
                END_STEP;
            } else {
                if (IN_STEP) phase_router(p, lds, chunk);
                END_STEP;
                if (IN_STEP) phase_slots(p, chunk);
                END_STEP;
                if (IN_STEP) for (int rep_ = 0; rep_ < (REP_PH == 12 ? 3 : 1); ++rep_, (rep_ < (REP_PH == 12 ? 3 : 1) ? xcd_barrier(bar) : (void)0)) {
                    ProgMoeGu P; P.S.init((const unsigned*)(ws + WS_CTL) + CW_CNT + chunk * 64, 2 * EXD / 256, G, cid); P.xb = xb; P.Wt = (const bf16_t*)(ws + WS_WMGU); P.ssq = ssq;
                    P.idx = (const int*)(ws + WS_ROUTE) + RT_IDX; P.act = (bf16_t*)(ws + WS_ACTM);
                    gemm_phase(lds, P);
                }
                END_STEP;
                if (IN_STEP) for (int rep_ = 0; rep_ < (REP_PH == 13 ? 3 : 1); ++rep_, (rep_ < (REP_PH == 13 ? 3 : 1) ? xcd_barrier(bar) : (void)0)) {
                    ProgMoeDown P; P.init((const unsigned*)(ws + WS_CTL) + CW_CNT + chunk * 64, G, cid); P.act = (const bf16_t*)(ws + WS_ACTM); P.Wt = (const bf16_t*)(ws + WS_WMD); P.ypair = (bf16_t*)(ws + WS_YPAIR); P.partk = (float*)(ws + WS_PARTK);
                    gemm_phase(lds, P);
                }
                END_STEP;
                if (IN_STEP) phase_combine(p, chunk);
                END_STEP;
            }
            if (IN_STEP) {
                ProgPle P; P.S.init(TC / 256, 4, G, cid); P.xb = xb; P.wpg = (const bf16_t*)(ws + WS_WPG) + (size_t)layer * D * D; P.pp = (const bf16_t*)(ws + WS_PP); P.ssq = ssq;
                P.xbout = (bf16_t*)(ws + WS_XB2); P.ssqout = (float*)(ws + WS_SSQ2);
                gemm_phase(lds, P);
            }
            END_STEP;
        }
        if (IN_STEP) { phase_final(p, chunk); if (chunk + 1 < NCH) phase_chunk_in(p, chunk + 1); }
        END_STEP;
    }
    if (TPROBE_MASK != 0u && (int)blockIdx.x == (p.pad & 0xffff) && threadIdx.x == 0) { const unsigned long long tsum_ = *(volatile LAS unsigned long long*)(lds + LDS_BYTES - 256 + 128); const unsigned long long t0_ = __builtin_amdgcn_s_memrealtime(); while (__builtin_amdgcn_s_memrealtime() - t0_ < 4ull * tsum_) __builtin_amdgcn_s_sleep(16); }
#undef IN_STEP
#undef END_STEP
}

#if defined(DBG_REP_STEP)
__global__ void dbg_csum(const unsigned* buf, size_t n, unsigned long long* out) {
    unsigned long long a = 0;
    for (size_t i = (size_t)blockIdx.x * 256 + threadIdx.x; i < n; i += (size_t)gridDim.x * 256) a += (unsigned long long)buf[i] * (unsigned long long)((i % 1021) + 1);
    atomicAdd(out, a);
}
__global__ void dbg_verdict(float* out, const unsigned long long* cs, int R) {
    bool bad = false; for (int r = 1; r < R; ++r) bad = bad || (cs[r] != cs[0]);
    const float v = bad ? __builtin_nanf("") : 0.f; const size_t n = (size_t)BATCH * SEQ * D;
    for (size_t i = (size_t)blockIdx.x * 256 + threadIdx.x; i < n; i += (size_t)gridDim.x * 256) out[i] = v;
}
#endif
#if defined(DBG_STOP)
#ifndef DBG_DUMP
#define DBG_DUMP 0
#define DBG_DUMP_OFF 0
#endif
__global__ void dbg_fill(float* out, const unsigned short* buf, int dump) {
    const size_t n = (size_t)BATCH * SEQ * D, c0 = (size_t)TC * D;
    for (size_t i = (size_t)blockIdx.x * 256 + threadIdx.x; i < n; i += (size_t)gridDim.x * 256) {
        if (i >= c0) out[i] = 0.f; else if (dump) out[i] = __uint_as_float(((unsigned)buf[i]) << 16);
    }
}
#endif
extern "C" void kernel_launch(void* const* d_in, const int* in_sizes, int n_in, void* d_out, int out_size, void* d_ws, size_t ws_size, hipStream_t stream) {
    static int grid = 0;
    if (grid == 0) {
        if (n_in != 30 || out_size != BATCH * SEQ * D || ws_size < WS_END) { fprintf(stderr, "kernel_launch: unexpected shapes (n_in %d, out %d, ws %zu < %zu)\n", n_in, out_size, ws_size, (size_t)WS_END); grid = -1; return; }
        int dev = 0, cus = 0;
        if (hipGetDevice(&dev) != hipSuccess || hipDeviceGetAttribute(&cus, hipDeviceAttributeMultiprocessorCount, dev) != hipSuccess) { grid = -1; return; }
        if (hipFuncSetAttribute((const void*)hybrid_fwd, hipFuncAttributeMaxDynamicSharedMemorySize, LDS_BYTES) != hipSuccess) { fprintf(stderr, "kernel_launch: hipFuncSetAttribute failed\n"); grid = -1; return; }
        int per_cu = 0;
        if (hipOccupancyMaxActiveBlocksPerMultiprocessor(&per_cu, (const void*)hybrid_fwd, 512, LDS_BYTES) != hipSuccess || per_cu < 1) { fprintf(stderr, "kernel_launch: occupancy query says %d\n", per_cu); }
        (void)hipGetLastError();
        grid = cus;
    }
    if (grid < 0) return;
    (void)hipMemsetAsync((char*)d_ws + WS_CTL, 0, MiB, stream);
    Params p{};
    for (int i = 0; i < 30; ++i) p.in[i] = (const float*)d_in[i];
    p.out = (float*)d_out; p.ws = (unsigned char*)d_ws; p.tmask = TPROBE_MASK; p.pad = TPROBE_PAD;
#if defined(DBG_REP_STEP)
    for (int s = 0; s < DBG_REP_STEP; ++s) { p.s_lo = s; p.s_hi = s + 1; hipLaunchKernelGGL(hybrid_fwd, dim3(grid), dim3(512), LDS_BYTES, stream, p); }
    unsigned long long* cs = (unsigned long long*)((char*)d_ws + WS_CTL + 512 * 1024);
    for (int r = 0; r < DBG_REP_N; ++r) { p.s_lo = DBG_REP_STEP; p.s_hi = DBG_REP_STEP + 1; hipLaunchKernelGGL(hybrid_fwd, dim3(grid), dim3(512), LDS_BYTES, stream, p);
        hipLaunchKernelGGL(dbg_csum, dim3(1024), dim3(256), 0, stream, (const unsigned*)((const char*)d_ws + DBG_REP_OFF), (size_t)(DBG_REP_BYTES) / 4, cs + r); }
    hipLaunchKernelGGL(dbg_verdict, dim3(2048), dim3(256), 0, stream, (float*)d_out, cs, (int)DBG_REP_N);
#elif defined(DBG_STOP)
    for (int s = 0; s < DBG_STOP; ++s) { p.s_lo = s; p.s_hi = s + 1; hipLaunchKernelGGL(hybrid_fwd, dim3(grid), dim3(512), LDS_BYTES, stream, p); }
    hipLaunchKernelGGL(dbg_fill, dim3(2048), dim3(256), 0, stream, (float*)d_out, (const unsigned short*)((const char*)d_ws + DBG_DUMP_OFF), (int)DBG_DUMP);
#elif ONE_LAUNCH
    p.s_lo = 0; p.s_hi = NSTEPS;
    hipLaunchKernelGGL(hybrid_fwd, dim3(grid), dim3(512), LDS_BYTES, stream, p);
#else
    for (int s = 0; s < NSTEPS; ++s) { p.s_lo = s; p.s_hi = s + 1; hipLaunchKernelGGL(hybrid_fwd, dim3(grid), dim3(512), LDS_BYTES, stream, p); }
#endif
}
```

```cpp
#include <hip/hip_runtime.h>
#include <cstdio>
#include <cstdint>

#define GAS __attribute__((address_space(1)))
#define LAS __attribute__((address_space(3)))
typedef unsigned short bf16_t;
typedef short bf16x8 __attribute__((ext_vector_type(8)));
typedef float f32x4 __attribute__((ext_vector_type(4)));
typedef float f32x2 __attribute__((ext_vector_type(2)));
typedef unsigned u32x4 __attribute__((ext_vector_type(4)));
typedef unsigned u32x2 __attribute__((ext_vector_type(2)));

#ifndef REP_PH
#define REP_PH -1
#endif
#ifndef EMU_FP8
#define EMU_FP8 0
#endif
#ifndef TPROBE_MASK
#define TPROBE_MASK 0u
#endif
#define TPROBE_ON (TPROBE_MASK != 0u)
#ifndef TPROBE_PAD
#define TPROBE_PAD 0
#endif
#define TSUB(b) do { if (TPROBE_ON && threadIdx.x == 0 && (int)blockIdx.x == (p.pad & 0xffff)) { volatile LAS unsigned long long* ts_ = (volatile LAS unsigned long long*)(lds + LDS_BYTES - 256 + 128); \
        const unsigned long long tn_ = __builtin_amdgcn_s_memrealtime(); if ((p.pad >> (16 + (b))) & 1) ts_[0] += tn_ - ts_[3]; ts_[3] = tn_; } } while (0)
#ifndef MIX2_PROBE
#define MIX2_PROBE 0
#endif
#ifndef DBG_ABL
#define DBG_ABL 0
#endif
#ifndef ONE_LAUNCH
#define ONE_LAUNCH 1
#endif

constexpr int D = 1024, BATCH = 32, SEQ = 2048, DEPTH = 2;
constexpr int PLE = 256;
constexpr float EPS = 1e-6f;
constexpr int FFN = 2816, NE = 8, EXD = 3584;
constexpr int C_DNZ = 2304, C_DNA = 3072, C_DNB = 3078, C_XBC = 3084, C_SSZ = 4364, C_SSDT = 5132, C_ATT = 5144, C_GATE = 7448, INW = 10520;
constexpr int NB = 8, TC = NB * SEQ, NCH = BATCH / NB;
constexpr int INP = 10752;
constexpr int MOE_SLOTS = 2 * TC + NE * 256;

constexpr size_t MiB = 1u << 20;
constexpr size_t WS_CTL = 0;
constexpr size_t WS_WIN = 1 * MiB;
constexpr size_t WS_WDN = WS_WIN + 42 * MiB;
constexpr size_t WS_WSSM = WS_WDN + 3 * MiB;
constexpr size_t WS_WATT = WS_WSSM + 3 * MiB;
constexpr size_t WS_WOUT = WS_WATT + 1 * MiB;
constexpr size_t WS_WFGU = WS_WOUT + 4 * MiB;
constexpr size_t WS_WFD = WS_WFGU + 11 * MiB;
constexpr size_t WS_WMGU = WS_WFD + 6 * MiB;
constexpr size_t WS_WMD = WS_WMGU + 112 * MiB;
constexpr size_t WS_WPG = WS_WMD + 56 * MiB;
constexpr size_t WS_WPLE = WS_WPG + 4 * MiB;
constexpr size_t WS_WR = WS_WPLE + 1 * MiB;
constexpr size_t WS_ACT0 = WS_WR + 1 * MiB;
constexpr size_t WS_XB = WS_ACT0;
constexpr size_t WS_SSQ = WS_XB + 32 * MiB;
constexpr size_t WS_PB = WS_SSQ + 1 * MiB;
constexpr size_t WS_ROUTE = WS_PB + 16 * MiB;
constexpr size_t WS_PART = WS_ROUTE + 1 * MiB;
constexpr size_t WS_PP = WS_PART;
constexpr size_t WS_MERGED = WS_PART + 64 * MiB;
constexpr size_t WS_Y = WS_MERGED + 32 * MiB;
constexpr size_t WS_YDN = WS_Y, WS_YSSM = WS_Y + 24 * MiB, WS_YATT = WS_Y + 48 * MiB, WS_OG = WS_Y + 56 * MiB, WS_LSE = WS_Y + 80 * MiB;
constexpr size_t WS_YPAIR = WS_Y;
constexpr size_t WS_PROJ = WS_Y + 81 * MiB;
constexpr size_t WS_PDN = WS_PROJ, WS_PSSM = WS_PDN + 96 * MiB, WS_SMALL = WS_PSSM + 64 * MiB, WS_QK = WS_SMALL + 2 * MiB, WS_VT = WS_QK + 48 * MiB, WS_GATES = WS_VT + 24 * MiB;
constexpr size_t WS_ACT = WS_PROJ, WS_ACTM = WS_PROJ;
constexpr int KSPL = 7, TAILMAX = 32;
constexpr size_t WS_PARTK = WS_PROJ + 256 * MiB;
static_assert((size_t)MOE_SLOTS * EXD * 2 <= 256 * MiB && WS_PARTK + (size_t)KSPL * (TAILMAX / 4) * 256 * 1024 * 4 <= WS_PROJ + 330 * MiB, "partk");
constexpr size_t WS_SCR = WS_PROJ + 330 * MiB;
constexpr size_t WS_XB2 = WS_SCR;
constexpr size_t WS_SSQ2 = WS_XB2 + 32 * MiB;
constexpr size_t WS_PART2 = WS_XB2 + 40 * MiB;
constexpr int DNS_ITEM = 73728;
constexpr size_t WS_DNS = WS_SCR + 40 * MiB;
constexpr size_t WS_DNEGL = WS_DNS + (size_t)NB * 32 * 6 * DNS_ITEM;
constexpr size_t WS_END = WS_SCR + 200 * MiB;
constexpr size_t WS_SSCD = WS_DNEGL + 8192;
static_assert(WS_SSCD + 16384 <= WS_END, "dn scratch");
constexpr size_t WS_SSPV = WS_SCR + 150 * MiB;
static_assert(WS_SSCD + 16384 <= WS_SSPV && WS_SSPV + 48 * MiB <= WS_END, "ssd prev");
constexpr size_t WS_SSST = WS_PART + 48 * MiB;
static_assert(WS_MERGED == WS_PART + 64 * MiB && (size_t)NB * 32 * 12 * 8192 * 2 <= 48 * MiB, "ssd states (bf16) sit in PART[48, 64) | MERGED, both idle during the mixers");
static_assert((size_t)MOE_SLOTS * EXD * 2 <= 330 * MiB, "moe act overlay");
static_assert((size_t)MOE_SLOTS * D * 2 <= 81 * MiB, "ypair overlay");
static_assert(WS_END <= 1024 * MiB, "workspace");
constexpr int RT_TOPE = 0, RT_TOPP = 2 * TC, RT_TOPW = 4 * TC, RT_TOPS = 6 * TC, RT_IDX = 8 * TC;
static_assert((size_t)(RT_IDX + MOE_SLOTS) * 4 <= MiB, "route");
constexpr int CW_BAR = 4096;
constexpr int CW_BAR2 = 8192;
constexpr int CW_SUB = 20480;
constexpr int CW_CNT = 16384;

constexpr int LDS_BYTES = 147456;
__device__ __forceinline__ int htid() { int t = threadIdx.x; asm volatile("" : "+v"(t)); return t; }
__device__ __forceinline__ float bf2f(bf16_t b) { return __uint_as_float(((unsigned)b) << 16); }
__device__ __forceinline__ unsigned f2bf(float f) { unsigned u = __float_as_uint(f); return (u + 0x7fffu + ((u >> 16) & 1u)) >> 16; }
typedef __bf16 bf16x2_t __attribute__((ext_vector_type(2)));
__device__ __forceinline__ unsigned pk2(float lo, float hi) { const f32x2 v = {lo, hi}; return __builtin_bit_cast(unsigned, __builtin_convertvector(v, bf16x2_t)); }
#define ST2_BF(PA, PB, A, B) do { const unsigned pw_ = pk2((A), (B)); *(PA) = (bf16_t)(pw_ & 0xffffu); *(PB) = (bf16_t)(pw_ >> 16); } while (0)
__device__ __forceinline__ float lo_bf(unsigned w) { return __uint_as_float(w << 16); }
__device__ __forceinline__ float hi_bf(unsigned w) { return __uint_as_float(w & 0xffff0000u); }
__device__ __forceinline__ float fexp(float x) { return __builtin_amdgcn_exp2f(x * 1.4426950408889634f); }
__device__ __forceinline__ float sigmoidf_(float x) { return __builtin_amdgcn_rcpf(1.f + fexp(-x)); }
__device__ __forceinline__ float siluf_(float x) { return x * sigmoidf_(x); }
__device__ __forceinline__ float softplusf_(float x) { const float e = fexp(x); return x > 20.f ? x : (x < -9.f ? e : __builtin_amdgcn_logf(1.f + e) * 0.6931471805599453f); }
__device__ __forceinline__ float q8(float v) {
    if (!EMU_FP8) return v;
    const float a = fabsf(v); float r;
    if (a < 0.015625f) r = rintf(a * 512.f) * (1.f / 512.f);
    else { unsigned u = __float_as_uint(a); u += 0x7FFFFu + ((u >> 20) & 1u); u &= ~0xFFFFFu; r = fminf(__uint_as_float(u), 448.f); }
    return copysignf(r, v);
}
__device__ __forceinline__ f32x4 q8v(f32x4 v) { return (f32x4){q8(v[0]), q8(v[1]), q8(v[2]), q8(v[3])}; }
__device__ __forceinline__ float wave_sum(float v) {
#pragma unroll
    for (int o = 1; o < 64; o <<= 1) v += __shfl_xor(v, o);
    return v;
}
__device__ __forceinline__ float wave_max(float v) {
#pragma unroll
    for (int o = 1; o < 64; o <<= 1) v = fmaxf(v, __shfl_xor(v, o));
    return v;
}
__device__ __forceinline__ float rstd_of(const float* ssq, int row) {
    const f32x4* p = (const f32x4*)(ssq + (size_t)row * 16);
    const f32x4 a = p[0], b = p[1], c = p[2], d = p[3];
    const float s = (((a.x + a.y) + (a.z + a.w)) + ((b.x + b.y) + (b.z + b.w))) + (((c.x + c.y) + (c.z + c.w)) + ((d.x + d.y) + (d.z + d.w)));
    return rsqrtf(s * (1.f / 1024.f) + EPS);
}
__device__ __forceinline__ int token_of_pos(int d, int p) {
    const int b = p >> 11, q = p & 2047;
    const int t = (d == 1) ? q : (d == 4) ? (4 * (q & 511) + (q >> 9)) : (16 * (q & 127) + (q >> 7));
    return b * 2048 + t;
}

#define XB_TMO      128
#define XB_XCNT(j)  (256  + 64 * (j))
#define XB_XSUB(j)  (1280 + 64 * (j))
#define XB_XGEN(j)  (2304 + 64 * (j))
#define XB_TOP      3328
#define XB_TOPGEN   3392
#define XCD_BAR_WORDS 3456
#define XB_SPIN_CAP (1u << 22)
__device__ __forceinline__ unsigned xb_ld(unsigned* p)              { return __hip_atomic_load(p, __ATOMIC_RELAXED, __HIP_MEMORY_SCOPE_AGENT); }
__device__ __forceinline__ unsigned xb_add(unsigned* p, unsigned v) { return __hip_atomic_fetch_add(p, v, __ATOMIC_RELAXED, __HIP_MEMORY_SCOPE_AGENT); }
__device__ __forceinline__ unsigned xb_xcc_id() { return (unsigned)__builtin_amdgcn_s_getreg((3 << 11) | 20) & 0xFu; }
#define XB_SPIN(cond, bar) do { unsigned _sp = 0; while (cond) { __builtin_amdgcn_s_sleep(1); \
    if ((++_sp & 255u) == 0u) { if (xb_ld(&(bar)[XB_TMO])) break; if (_sp > XB_SPIN_CAP) { atomicAdd(&(bar)[XB_TMO], 1u); break; } } } } while (0)
struct XcdBarrier { unsigned* bar; unsigned x; volatile LAS unsigned* st; };
__device__ __forceinline__ XcdBarrier xcd_barrier_post(unsigned* bar, volatile LAS unsigned* st) {
    XcdBarrier b; b.bar = bar; b.x = xb_xcc_id(); b.st = st;
    if (threadIdx.x == 0) (void)xb_add(&bar[XB_XCNT(b.x)], 1u);
    return b;
}
__device__ __forceinline__ void xcd_barrier_complete(unsigned* bar, unsigned x, unsigned& nloc, unsigned& nx, unsigned G) {
    unsigned sum, cnt, mine, sp = 0u;
    for (;;) {
        sum = 0u; cnt = 0u; mine = 0u;
#pragma unroll 1
        for (unsigned j = 0; j < 16; ++j) { const unsigned c = xb_ld(&bar[XB_XCNT(j)]); sum += c; cnt += (c > 0u) ? 1u : 0u; }
        mine = xb_ld(&bar[XB_XCNT(x)]);
        if (sum == G) break;
        __builtin_amdgcn_s_sleep(1);
        if ((++sp & 255u) == 0u) { if (xb_ld(&bar[XB_TMO])) break; if (sp > XB_SPIN_CAP) { atomicAdd(&bar[XB_TMO], 1u); break; } }
    }
    nloc = mine > 0u ? mine : 1u; nx = cnt > 0u ? cnt : 1u;
}
__device__ __forceinline__ void xcd_barrier(const XcdBarrier& b, unsigned nparts = 0u) {
    asm volatile("s_waitcnt vmcnt(0)" ::: "memory");
    __syncthreads();
    if (threadIdx.x == 0) {
        unsigned* bar = b.bar;
        __builtin_amdgcn_s_waitcnt(0);
        unsigned nloc = b.st[0], nx = b.st[1];
        if (nloc == 0u) { xcd_barrier_complete(bar, b.x, nloc, nx, nparts ? nparts : gridDim.x * gridDim.y * gridDim.z); b.st[0] = nloc; b.st[1] = nx; }
        const unsigned old = xb_add(&bar[XB_XSUB(b.x)], 1u);
        const unsigned gen = old / nloc;
        if (old + 1u == (gen + 1u) * nloc) {
            __builtin_amdgcn_fence(__ATOMIC_RELEASE, "agent");
            asm volatile("s_waitcnt vmcnt(0)" ::: "memory");
            const unsigned og = xb_add(&bar[XB_TOP], 1u);
            const unsigned tg = og / nx;
            if (og + 1u == (tg + 1u) * nx) xb_add(&bar[XB_TOPGEN], 1u);
            else XB_SPIN(xb_ld(&bar[XB_TOPGEN]) == tg, bar);
            __builtin_amdgcn_fence(__ATOMIC_ACQUIRE, "agent");
            xb_add(&bar[XB_XGEN(b.x)], 1u);
            asm volatile("s_waitcnt vmcnt(0)" ::: "memory");
        } else {
            XB_SPIN(xb_ld(&bar[XB_XGEN(b.x)]) == gen, bar);
            __builtin_amdgcn_fence(__ATOMIC_ACQUIRE, "agent");
            asm volatile("s_waitcnt vmcnt(0)" ::: "memory");
        }
    }
    __syncthreads();
}

constexpr int BM = 256, BK = 64, HALF = 128, HTB = HALF * BK * 2, STAGE_BYTES = 8 * HTB, NXCD = 8, WGM = 4;
__device__ __forceinline__ int lds_byte(int r, int c) { const int st = (r >> 4) * 2 + (c >> 5), rr = r & 15, cc = c & 31, ob = rr * 64 + cc * 2; return st * 1024 + (ob ^ (((ob >> 9) & 1) << 5)); }
__device__ __forceinline__ void stage_rc(int b, int& R, int& C) { const int st = b / 1024, sb = b % 1024, swz = sb ^ (((sb >> 9) & 1) << 5); R = (st >> 1) * 16 + swz / 64; C = (st & 1) * 32 + (swz % 64) / 2; }
__device__ __forceinline__ int perm32(int rho) { const int n = rho >> 4, i = rho & 15; return 8 * (i >> 2) + 4 * n + (i & 3); }

struct Unit { int pm, pn; };
struct StaticOrder {
    int nM, nN, nwg, G, c;
    __device__ __forceinline__ void init(int nM_, int nN_, int G_, int c_) { nM = nM_; nN = nN_; nwg = nM * nN; G = G_; c = c_; }
    __device__ __forceinline__ bool next(int i, Unit& u) const {
        const long L = (long)i * G + c; if (L >= nwg) return false;
        int wgid = (int)L; { const int q = nwg / NXCD, r = nwg % NXCD, xcd = wgid % NXCD, off = wgid / NXCD; wgid = (xcd < r ? xcd * (q + 1) : r * (q + 1) + (xcd - r) * q) + off; }
        const int nig = WGM * nN, gid = wgid / nig, fm = gid * WGM, gsz = (nM - fm) < WGM ? (nM - fm) : WGM;
        u.pm = fm + ((wgid % nig) % gsz); u.pn = (wgid % nig) / gsz; return true;
    }
};
struct GU { const char* A; const char* B; int lda, ldb, nt, mapA, mapB; const int* idx; int pm, pn, sub, aux; };
__device__ __forceinline__ unsigned row_off(int map, int RR, int ld, const int* idx) {
    int row;
    if (map == 0) row = RR;
    else if (map == 4) row = 4 * RR;
    else if (map == 16) row = 16 * (RR & 127) + (RR >> 7);
    else row = idx[RR];
    return (unsigned)row * (unsigned)ld;
}
template <class Prog>
__device__ __forceinline__ void gemm_phase(LAS unsigned char* lds, const Prog& P) {
    const int tid = htid(), wid = __builtin_amdgcn_readfirstlane(tid >> 6), lane = tid & 63, wr = wid >> 2, wc = wid & 3, fr = lane & 15, fq = lane >> 4;
    GU cur, nxt; int ui = 0;
    if (!P.unit(0, cur)) return;
    unsigned vA[4], vB[4];
#define G_SETV(u) do { int tz_ = threadIdx.x; asm volatile("" : "+v"(tz_)); int R0, C0, R1, C1; stage_rc(tz_ * 16, R0, C0); stage_rc(tz_ * 16 + 8192, R1, C1); \
        const int Rb0 = (R0 & ~31) + perm32(R0 & 31), Rb1 = (R1 & ~31) + perm32(R1 & 31); \
        vA[0] = row_off((u).mapA, R0, (u).lda, (u).idx) + C0 * 2; vA[1] = row_off((u).mapA, R1, (u).lda, (u).idx) + C1 * 2; \
        vA[2] = row_off((u).mapA, R0 + 128, (u).lda, (u).idx) + C0 * 2; vA[3] = row_off((u).mapA, R1 + 128, (u).lda, (u).idx) + C1 * 2; \
        vB[0] = row_off((u).mapB, Rb0, (u).ldb, nullptr) + C0 * 2; vB[1] = row_off((u).mapB, Rb1, (u).ldb, nullptr) + C1 * 2; \
        vB[2] = row_off((u).mapB, Rb0 + 128, (u).ldb, nullptr) + C0 * 2; vB[3] = row_off((u).mapB, Rb1 + 128, (u).ldb, nullptr) + C1 * 2; } while (0)
    G_SETV(cur);
    const unsigned ldsw = (unsigned)wid * 1024u;
    const int aoff = lds_byte(wr * 64 + fr, fq * 8), boff = lds_byte(wc * 32 + fr, fq * 8);
#define G_SA(b, h) (((b) * 2 + (h)) * HTB)
#define G_SB(b, h) ((4 + (b) * 2 + (h)) * HTB)
#define G_STAGE(bufoff, gbase, v, h) do { \
        __builtin_amdgcn_global_load_lds((const unsigned*)((gbase) + (v)[2 * (h)]), (LAS unsigned*)(lds + (bufoff) + ldsw), 16, 0, 0); \
        __builtin_amdgcn_global_load_lds((const unsigned*)((gbase) + (v)[2 * (h) + 1]), (LAS unsigned*)(lds + (bufoff) + ldsw + 8192), 16, 0, 0); } while (0)
#define G_LDA(dst, b, h) do { _Pragma("unroll") for (int m = 0; m < 4; ++m) _Pragma("unroll") for (int k = 0; k < 2; ++k) dst[m][k] = *(const LAS bf16x8*)(lds + G_SA(b, h) + aoff + m * 2048 + k * 1024); } while (0)
#define G_LDB(dst, b, h) do { _Pragma("unroll") for (int n = 0; n < 2; ++n) _Pragma("unroll") for (int k = 0; k < 2; ++k) dst[n][k] = *(const LAS bf16x8*)(lds + G_SB(b, h) + boff + n * 2048 + k * 1024); } while (0)
#define G_MMA(ai, bj, At, Bt) do { __builtin_amdgcn_s_setprio(1); _Pragma("unroll") for (int m = 0; m < 4; ++m) _Pragma("unroll") for (int n = 0; n < 2; ++n) _Pragma("unroll") for (int k = 0; k < 2; ++k) \
        acc[ai][bj][m][n] = __builtin_amdgcn_mfma_f32_16x16x32_bf16(Bt[n][k], At[m][k], acc[ai][bj][m][n], 0, 0, 0); __builtin_amdgcn_s_setprio(0); } while (0)
#define G_WAIT_V(n) asm volatile("s_waitcnt vmcnt(" #n ")" ::: "memory")
#define G_WAIT_L(n) asm volatile("s_waitcnt lgkmcnt(" #n ")" ::: "memory")
#define G_BAR __builtin_amdgcn_s_barrier()
#define G_SCHED __builtin_amdgcn_sched_barrier(0)
    f32x4 acc[2][2][4][2];
#pragma unroll
    for (int a = 0; a < 2; ++a)
#pragma unroll
        for (int b = 0; b < 2; ++b)
#pragma unroll
            for (int m = 0; m < 4; ++m)
#pragma unroll
                for (int n = 0; n < 2; ++n) acc[a][b][m][n] = (f32x4){0.f, 0.f, 0.f, 0.f};
    bf16x8 At[4][2], B0[2][2], B1[2][2];
    const char* cA = cur.A; const char* cB = cur.B;
    const size_t kstep = (size_t)(BK * 2);
    G_STAGE(G_SB(0, 0), cB, vB, 0); G_STAGE(G_SA(0, 0), cA, vA, 0); G_STAGE(G_SB(0, 1), cB, vB, 1); G_STAGE(G_SA(0, 1), cA, vA, 1);
    if (wr == 1) G_BAR;
    G_WAIT_V(4); G_BAR;
    G_STAGE(G_SB(1, 0), cB + kstep, vB, 0); G_STAGE(G_SA(1, 0), cA + kstep, vA, 0); G_STAGE(G_SB(1, 1), cB + kstep, vB, 1);
    G_WAIT_V(6); G_BAR;
    for (;;) {
        const bool has_next = P.unit(ui + 1, nxt);
        const char* nA = has_next ? nxt.A : cA; const char* nB = has_next ? nxt.B : cB;
        const int nt = cur.nt;
        for (int t = 0; t < nt; t += 2) {
            const bool last = (t == nt - 2);
            const char* a1 = cA + (size_t)(t + 1) * kstep;
            const char* a2 = last ? nA : cA + (size_t)(t + 2) * kstep; const char* b2 = last ? nB : cB + (size_t)(t + 2) * kstep;
            const char* a3 = a2 + kstep; const char* b3 = b2 + kstep;
            G_STAGE(G_SA(1, 1), a1, vA, 1);
            if (last && has_next) { G_SETV(nxt); }
            G_LDB(B0, 0, 0); G_SCHED; G_LDA(At, 0, 0);
            G_WAIT_L(8); G_BAR; G_WAIT_L(0); G_MMA(0, 0, At, B0); G_BAR; G_SCHED;
            G_LDB(B1, 0, 1); G_STAGE(G_SB(0, 0), b2, vB, 0);
            G_BAR; G_WAIT_L(0); G_MMA(0, 1, At, B1); G_BAR;
            G_LDA(At, 0, 1); G_STAGE(G_SA(0, 0), a2, vA, 0);
            G_BAR; G_WAIT_L(0); G_MMA(1, 0, At, B0); G_BAR; G_SCHED;
            G_STAGE(G_SB(0, 1), b2, vB, 1);
            G_WAIT_V(6); G_BAR; G_MMA(1, 1, At, B1); G_BAR;
            G_LDB(B0, 1, 0); G_SCHED; G_LDA(At, 1, 0); G_STAGE(G_SA(0, 1), a2, vA, 1);
            G_WAIT_L(8); G_BAR; G_WAIT_L(0); G_MMA(0, 0, At, B0); G_BAR; G_SCHED;
            G_LDB(B1, 1, 1); G_STAGE(G_SB(1, 0), b3, vB, 0);
            G_BAR; G_WAIT_L(0); G_MMA(0, 1, At, B1); G_BAR;
            G_LDA(At, 1, 1); G_STAGE(G_SA(1, 0), a3, vA, 0);
            G_BAR; G_WAIT_L(0); G_MMA(1, 0, At, B0); G_BAR; G_SCHED;
            G_STAGE(G_SB(1, 1), b3, vB, 1);
            G_WAIT_V(6); G_BAR; G_MMA(1, 1, At, B1); G_BAR;
        }
        { int tz_ = threadIdx.x; asm volatile("" : "+v"(tz_)); const int ln_ = tz_ & 63; P.epi(acc, cur, wr, wc, ln_ & 15, ln_ >> 4); }
        if (!has_next) break;
        if (!P.keep(cur))
#pragma unroll
        for (int a = 0; a < 2; ++a)
#pragma unroll
            for (int b = 0; b < 2; ++b)
#pragma unroll
                for (int m = 0; m < 4; ++m)
#pragma unroll
                    for (int n = 0; n < 2; ++n) acc[a][b][m][n] = (f32x4){0.f, 0.f, 0.f, 0.f};
        cur = nxt; cA = nA; cB = nB; ++ui;
    }
    G_WAIT_V(0);
    if (wr == 0) G_BAR;
    G_BAR;
#undef G_SETV
#undef G_SA
#undef G_SB
#undef G_STAGE
#undef G_LDA
#undef G_LDB
#undef G_MMA
#undef G_WAIT_V
#undef G_WAIT_L
#undef G_BAR
#undef G_SCHED
}

__device__ __forceinline__ void st_bf8(bf16_t* p, const f32x4 a, const f32x4 b) {
    u32x4 w; w.x = pk2(a[0], a[1]); w.y = pk2(a[2], a[3]); w.z = pk2(b[0], b[1]); w.w = pk2(b[2], b[3]);
    *(u32x4*)p = w;
}
__device__ __forceinline__ void ld_bf8(const bf16_t* p, f32x4& a, f32x4& b) {
    const u32x4 w = *(const u32x4*)p;
    a = (f32x4){lo_bf(w.x), hi_bf(w.x), lo_bf(w.y), hi_bf(w.y)}; b = (f32x4){lo_bf(w.z), hi_bf(w.z), lo_bf(w.w), hi_bf(w.w)};
}
__device__ __forceinline__ float sq8(const f32x4 a, const f32x4 b) { return ((a[0] * a[0] + a[1] * a[1]) + (a[2] * a[2] + a[3] * a[3])) + ((b[0] * b[0] + b[1] * b[1]) + (b[2] * b[2] + b[3] * b[3])); }

#define EPI_ROWS(ai, m) _Pragma("unroll") for (int ai = 0; ai < 2; ++ai) _Pragma("unroll") for (int m = 0; m < 4; ++m)
#define EPI_FENCE asm volatile("" ::: "memory")
#define EPI_SC(ai, m) __shfl((ai) ? r1_ : r0_, (m) * 16 + fr)

struct ProgIn {
    __device__ __forceinline__ bool keep(const GU&) const { return false; }
    StaticOrder S; const bf16_t* xb; const bf16_t* Wt; const float* ssq; unsigned char* wsb;
    const bf16_t* pb; const bf16_t* wple;
    __device__ __forceinline__ bool unit(int i, GU& u) const {
        Unit t;
        if (!S.next(i, t)) {
            const int rem = S.nwg % S.G, nfull = S.nwg / S.G, idle = rem == 0 ? S.G : S.G - rem, per = (256 + idle - 1) / idle;
            const int rk = rem == 0 ? S.c : S.c - rem, k = i - nfull;
            if (rk < 0 || k < 0 || k >= per) return false;
            const int pu = rk * per + k; if (pu >= 256) return false;
            u.pm = pu >> 2; u.pn = 64 + (pu & 3); u.sub = 0; u.aux = 0; u.nt = 4; u.idx = nullptr; u.lda = 512; u.ldb = 512; u.mapA = 0; u.mapB = 0;
            u.A = (const char*)pb + (size_t)(pu >> 2) * 256 * 512; u.B = (const char*)wple + (size_t)(pu & 3) * 256 * 512; return true;
        }
        u.pm = t.pm; u.pn = t.pn; u.sub = 0; u.aux = 0; u.nt = 16; u.idx = nullptr; u.lda = 2048; u.ldb = 2048;
        const char* w = (const char*)Wt + (size_t)t.pn * 256 * 2048;
        int g = 0; bool isvt = false;
        if (t.pn >= 20 && t.pn < 29) { g = (t.pn - 20) % 3; isvt = t.pn >= 26; }
        const int d = g == 0 ? 1 : (g == 1 ? 4 : 16);
        const int b = t.pm >> 3, tb = t.pm & 7;
        const int base = b * 2048 + (d == 1 ? 256 * tb : d == 4 ? 1024 * (tb & 1) + (tb >> 1) : 2 * tb);
        const char* x = (const char*)xb + (size_t)base * 2048;
        const int mapx = d == 1 ? 0 : d;
        if (!isvt) { u.A = x; u.mapA = mapx; u.B = w; u.mapB = 0; }
        else { u.A = w; u.mapA = 0; u.B = x; u.mapB = mapx; }
        return true;
    }
    __device__ __forceinline__ void epi(f32x4 (&acc)[2][2][4][2], const GU& u, int wr, int wc, int fr, int fq) const {
        const int pn = u.pn, pm = u.pm, rl0 = wr * 64 + fr, cl0 = wc * 32 + 8 * fq;
        if (pn >= 64) {
            EPI_ROWS(ai, m) { bf16_t* o = (bf16_t*)(wsb + WS_PP) + (size_t)(pm * 256 + ai * 128 + m * 16 + rl0) * 1024 + (pn - 64) * 256 + cl0;
#pragma unroll
                for (int bj = 0; bj < 2; ++bj) st_bf8(o + bj * 128, acc[ai][bj][m][0], acc[ai][bj][m][1]); }
            return;
        }
        if (pn >= 26 && pn < 29) {
            const int g = pn - 26, d = g == 0 ? 1 : (g == 1 ? 4 : 16), ln = fq * 16 + fr;
            const float rc = rstd_of(ssq, token_of_pos(d, pm * 256 + (ln >> 5) * 128 + wc * 32 + (ln & 31)));
            f32x4 s[2][2];
#pragma unroll
            for (int bj = 0; bj < 2; ++bj)
#pragma unroll
                for (int j = 0; j < 8; ++j) s[bj][j >> 2][j & 3] = __shfl(rc, bj * 32 + 8 * fq + j);
            EPI_ROWS(ai, m) { const int ch = ai * 128 + m * 16 + rl0; bf16_t* o = (bf16_t*)(wsb + WS_VT) + (size_t)(g * 256 + ch) * TC + pm * 256 + cl0;
#pragma unroll
                for (int bj = 0; bj < 2; ++bj) st_bf8(o + bj * 128, acc[ai][bj][m][0] * s[bj][0], acc[ai][bj][m][1] * s[bj][1]); }
            return;
        }
        int d = 1; if (pn >= 20 && pn < 26) { const int g = (pn - 20) % 3; d = g == 0 ? 1 : (g == 1 ? 4 : 16); }
        const float r0_ = rstd_of(ssq, token_of_pos(d, pm * 256 + fq * 16 + rl0)), r1_ = rstd_of(ssq, token_of_pos(d, pm * 256 + 128 + fq * 16 + rl0));
        if (pn < 20) {
            bf16_t* base = pn < 12 ? (bf16_t*)(wsb + WS_PDN) + pn * 256 : (bf16_t*)(wsb + WS_PSSM) + (pn - 12) * 256; const int ld = pn < 12 ? 3072 : 2048;
            EPI_ROWS(ai, m) { const int row = pm * 256 + ai * 128 + m * 16 + rl0; const float s = EPI_SC(ai, m); bf16_t* o = base + (size_t)row * ld + cl0;
#pragma unroll
                for (int bj = 0; bj < 2; ++bj) st_bf8(o + bj * 128, acc[ai][bj][m][0] * s, acc[ai][bj][m][1] * s); }
        } else if (pn < 26) {
            const int which = (pn - 20) / 3, g = (pn - 20) % 3; const float qs = which == 0 ? 0.125f : 1.f;
            bf16_t* base = (bf16_t*)(wsb + WS_QK) + (size_t)(which * 3 + g) * TC * 256;
            EPI_ROWS(ai, m) { const int p = pm * 256 + ai * 128 + m * 16 + rl0; const float s = EPI_SC(ai, m) * qs; bf16_t* o = base + (size_t)p * 256 + cl0;
#pragma unroll
                for (int bj = 0; bj < 2; ++bj) st_bf8(o + bj * 128, acc[ai][bj][m][0] * s, acc[ai][bj][m][1] * s); }
        } else if (pn < 41) {
            bf16_t* base = (bf16_t*)(wsb + WS_GATES) + (pn - 29) * 256;
            EPI_ROWS(ai, m) { const int row = pm * 256 + ai * 128 + m * 16 + rl0; const float s = EPI_SC(ai, m); bf16_t* o = base + (size_t)row * 3072 + cl0;
#pragma unroll
                for (int bj = 0; bj < 2; ++bj) { f32x4 a = acc[ai][bj][m][0] * s, b = acc[ai][bj][m][1] * s;
#pragma unroll
                    for (int j = 0; j < 4; ++j) { a[j] = sigmoidf_(a[j]); b[j] = sigmoidf_(b[j]); }
                    st_bf8(o + bj * 128, a, b); } }
        } else {
            EPI_ROWS(ai, m) { const int row = pm * 256 + ai * 128 + m * 16 + rl0; const float s = EPI_SC(ai, m);
                if (wc == 0) { float* o = (float*)(wsb + WS_SMALL) + (size_t)row * 32 + 8 * fq; *(f32x4*)o = acc[ai][0][m][0] * s; *(f32x4*)(o + 4) = acc[ai][0][m][1] * s; } }
        }
    }
};

struct ProgMerge {
    StaticOrder S; const bf16_t *wdn, *wssm, *watt; unsigned char* wsb;
    __device__ __forceinline__ bool keep(const GU& u) const { return u.sub < 2; }
    __device__ __forceinline__ bool unit(int i, GU& u) const {
        Unit t; if (!S.next(i / 3, t)) return false;
        const int sub = i % 3;
        u.pm = t.pm; u.pn = t.pn; u.sub = sub; u.aux = 0; u.idx = nullptr; u.mapA = 0; u.mapB = 0;
        if (sub < 2) { u.lda = 1536; u.ldb = 1536; u.nt = 12; u.A = (const char*)(wsb + (sub == 0 ? WS_YDN : WS_YSSM)) + (size_t)t.pm * 256 * 1536; u.B = (const char*)(sub == 0 ? wdn : wssm) + (size_t)t.pn * 256 * 1536; }
        else { u.lda = 512; u.ldb = 512; u.nt = 4; u.A = (const char*)(wsb + WS_YATT) + (size_t)t.pm * 256 * 512; u.B = (const char*)watt + (size_t)t.pn * 256 * 512; }
        return true;
    }
    __device__ __forceinline__ void epi(f32x4 (&acc)[2][2][4][2], const GU& u, int wr, int wc, int fr, int fq) const {
        const int rl0 = wr * 64 + fr, cl0 = wc * 32 + 8 * fq, sub = u.sub;
        const bf16_t* gp0 = (const bf16_t*)(wsb + WS_GATES) + (size_t)(u.pm * 256 + rl0) * 3072 + u.pn * 256 + cl0 + sub * 1024;
#pragma unroll
        for (int ai = 0; ai < 2; ++ai) {
            u32x4 gw[4][2], hw[4][2];
            if (sub < 2) {
#pragma unroll
                for (int m = 0; m < 4; ++m)
#pragma unroll
                    for (int bj = 0; bj < 2; ++bj) { const bf16_t* gp = gp0 + (size_t)(ai * 128 + m * 16) * 3072 + bj * 128; gw[m][bj] = *(const u32x4*)gp; hw[m][bj] = *(const u32x4*)(gp + 1024); }
            } else {
#pragma unroll
                for (int m = 0; m < 4; ++m)
#pragma unroll
                    for (int bj = 0; bj < 2; ++bj) { const bf16_t* gp = gp0 + (size_t)(ai * 128 + m * 16) * 3072 + bj * 128; gw[m][bj] = *(const u32x4*)gp; hw[m][bj] = gw[m][bj]; }
            }
#pragma unroll
            for (int m = 0; m < 4; ++m)
#pragma unroll
                for (int bj = 0; bj < 2; ++bj) { const int row = u.pm * 256 + ai * 128 + m * 16 + rl0, col = u.pn * 256 + bj * 128 + cl0;
                    f32x4 g0 = (f32x4){lo_bf(gw[m][bj].x), hi_bf(gw[m][bj].x), lo_bf(gw[m][bj].y), hi_bf(gw[m][bj].y)}, g1 = (f32x4){lo_bf(gw[m][bj].z), hi_bf(gw[m][bj].z), lo_bf(gw[m][bj].w), hi_bf(gw[m][bj].w)};
                    if ((DBG_ABL >> sub) & 1) { acc[ai][bj][m][0] = (f32x4){0.f, 0.f, 0.f, 0.f}; acc[ai][bj][m][1] = acc[ai][bj][m][0]; }
#pragma unroll
                    for (int j = 0; j < 4; ++j) { g0[j] = fmaxf(g0[j], 1e-8f); g1[j] = fmaxf(g1[j], 1e-8f); }
                    if (sub < 2) { const f32x4 h0 = (f32x4){lo_bf(hw[m][bj].x), hi_bf(hw[m][bj].x), lo_bf(hw[m][bj].y), hi_bf(hw[m][bj].y)}, h1 = (f32x4){lo_bf(hw[m][bj].z), hi_bf(hw[m][bj].z), lo_bf(hw[m][bj].w), hi_bf(hw[m][bj].w)};
#pragma unroll
                        for (int j = 0; j < 4; ++j) { acc[ai][bj][m][0][j] *= g0[j] * __builtin_amdgcn_rcpf(fmaxf(h0[j], 1e-8f)); acc[ai][bj][m][1][j] *= g1[j] * __builtin_amdgcn_rcpf(fmaxf(h1[j], 1e-8f)); } }
                    else st_bf8((bf16_t*)(wsb + WS_MERGED) + (size_t)row * 1024 + col, acc[ai][bj][m][0] * g0, acc[ai][bj][m][1] * g1); }
            EPI_FENCE;
        }
    }
};

struct ProgResid {
    __device__ __forceinline__ bool keep(const GU&) const { return false; }
    StaticOrder S; const bf16_t* A; int lda, nt; const bf16_t* Wt; int ldb; const float* xin_f; const bf16_t* xin_b; bf16_t* xb; float* ssq; float sc;
    __device__ __forceinline__ bool unit(int i, GU& u) const {
        Unit t; if (!S.next(i, t)) return false;
        u.pm = t.pm; u.pn = t.pn; u.sub = 0; u.aux = 0; u.idx = nullptr; u.mapA = 0; u.mapB = 0; u.lda = lda; u.ldb = ldb; u.nt = nt;
        u.A = (const char*)A + (size_t)t.pm * 256 * lda; u.B = (const char*)Wt + (size_t)t.pn * 256 * ldb; return true;
    }
    __device__ __forceinline__ void epi(f32x4 (&acc)[2][2][4][2], const GU& u, int wr, int wc, int fr, int fq) const {
        const int rl0 = wr * 64 + fr, cl0 = wc * 32 + 8 * fq;
#pragma unroll
        for (int ai = 0; ai < 2; ++ai) {
            f32x4 xv[4][2][2];
            if (xin_f) {
#pragma unroll
                for (int m = 0; m < 4; ++m)
#pragma unroll
                    for (int bj = 0; bj < 2; ++bj) { const size_t o = (size_t)(u.pm * 256 + ai * 128 + m * 16 + rl0) * 1024 + u.pn * 256 + bj * 128 + cl0; xv[m][bj][0] = *(const f32x4*)(xin_f + o); xv[m][bj][1] = *(const f32x4*)(xin_f + o + 4); }
            } else {
                u32x4 xw[4][2];
#pragma unroll
                for (int m = 0; m < 4; ++m)
#pragma unroll
                    for (int bj = 0; bj < 2; ++bj) xw[m][bj] = *(const u32x4*)(xin_b + (size_t)(u.pm * 256 + ai * 128 + m * 16 + rl0) * 1024 + u.pn * 256 + bj * 128 + cl0);
#pragma unroll
                for (int m = 0; m < 4; ++m)
#pragma unroll
                    for (int bj = 0; bj < 2; ++bj) { const u32x4 w = xw[m][bj]; xv[m][bj][0] = (f32x4){lo_bf(w.x), hi_bf(w.x), lo_bf(w.y), hi_bf(w.y)}; xv[m][bj][1] = (f32x4){lo_bf(w.z), hi_bf(w.z), lo_bf(w.w), hi_bf(w.w)}; }
            }
#pragma unroll
            for (int m = 0; m < 4; ++m) { const int row = u.pm * 256 + ai * 128 + m * 16 + rl0; float ss = 0.f;
#pragma unroll
                for (int bj = 0; bj < 2; ++bj) { const size_t o = (size_t)row * 1024 + u.pn * 256 + bj * 128 + cl0;
                    const f32x4 v0 = acc[ai][bj][m][0] * sc + xv[m][bj][0], v1 = acc[ai][bj][m][1] * sc + xv[m][bj][1];
                    st_bf8(xb + o, v0, v1); ss += sq8(v0, v1); }
                ss += __shfl_xor(ss, 16); ss += __shfl_xor(ss, 32);
                if (fq == 0) ssq[(size_t)row * 16 + u.pn * 4 + wc] = ss; }
            EPI_FENCE;
        }
    }
};

struct ProgFfnGu {
    __device__ __forceinline__ bool keep(const GU&) const { return false; }
    StaticOrder S; const bf16_t* xb; const bf16_t* Wt; const float* ssq; bf16_t* act;
    __device__ __forceinline__ bool unit(int i, GU& u) const {
        Unit t; if (!S.next(i, t)) return false;
        u.pm = t.pm; u.pn = t.pn; u.sub = 0; u.aux = 0; u.idx = nullptr; u.mapA = 0; u.mapB = 0; u.lda = 2048; u.ldb = 2048; u.nt = 16;
        u.A = (const char*)xb + (size_t)t.pm * 256 * 2048; u.B = (const char*)Wt + (size_t)t.pn * 256 * 2048; return true;
    }
    __device__ __forceinline__ void epi(f32x4 (&acc)[2][2][4][2], const GU& u, int wr, int wc, int fr, int fq) const {
        const int rl0 = wr * 64 + fr, cl0 = wc * 32 + 8 * fq;
        const float r0_ = rstd_of(ssq, u.pm * 256 + fq * 16 + rl0), r1_ = rstd_of(ssq, u.pm * 256 + 128 + fq * 16 + rl0);
        EPI_ROWS(ai, m) { const int row = u.pm * 256 + ai * 128 + m * 16 + rl0; const float s = EPI_SC(ai, m);
            f32x4 o[2];
#pragma unroll
            for (int n = 0; n < 2; ++n)
#pragma unroll
                for (int j = 0; j < 4; ++j) { const float g = acc[ai][0][m][n][j] * s, up = acc[ai][1][m][n][j] * s; o[n][j] = q8(siluf_(g) * up); }
            st_bf8(act + (size_t)row * FFN + u.pn * 128 + cl0, o[0], o[1]); }
    }
};

struct ProgPle {
    __device__ __forceinline__ bool keep(const GU&) const { return false; }
    StaticOrder S; const bf16_t *xb, *wpg, *pp; const float* ssq; bf16_t* xbout; float* ssqout;
    __device__ __forceinline__ bool unit(int i, GU& u) const {
        Unit t; if (!S.next(i, t)) return false;
        u.pm = t.pm; u.pn = t.pn; u.sub = 0; u.aux = 0; u.idx = nullptr; u.mapA = 0; u.mapB = 0; u.lda = 2048; u.ldb = 2048; u.nt = 16;
        u.A = (const char*)xb + (size_t)t.pm * 256 * 2048; u.B = (const char*)wpg + (size_t)t.pn * 256 * 2048; return true;
    }
    __device__ __forceinline__ void epi(f32x4 (&acc)[2][2][4][2], const GU& u, int wr, int wc, int fr, int fq) const {
        const int rl0 = wr * 64 + fr, cl0 = wc * 32 + 8 * fq; const float ps = (DBG_ABL & 32) ? 0.f : 1.f;
        const float r0_ = rstd_of(ssq, u.pm * 256 + fq * 16 + rl0), r1_ = rstd_of(ssq, u.pm * 256 + 128 + fq * 16 + rl0);
#pragma unroll
        for (int ai = 0; ai < 2; ++ai)
#pragma unroll
            for (int mh = 0; mh < 2; ++mh) {
                u32x4 xw[2][2], gw[2][2];
#pragma unroll
                for (int m2 = 0; m2 < 2; ++m2)
#pragma unroll
                    for (int bj = 0; bj < 2; ++bj) { const size_t o = (size_t)(u.pm * 256 + ai * 128 + (2 * mh + m2) * 16 + rl0) * 1024 + u.pn * 256 + bj * 128 + cl0;
                        xw[m2][bj] = *(const u32x4*)(xb + o); gw[m2][bj] = *(const u32x4*)(pp + o); }
#pragma unroll
                for (int m2 = 0; m2 < 2; ++m2) { const int m = 2 * mh + m2, row = u.pm * 256 + ai * 128 + m * 16 + rl0; const float sc = EPI_SC(ai, m); float ss = 0.f;
#pragma unroll
                    for (int bj = 0; bj < 2; ++bj) { const size_t o = (size_t)row * 1024 + u.pn * 256 + bj * 128 + cl0; const u32x4 w = gw[m2][bj], xq = xw[m2][bj];
                        const f32x4 p0 = (f32x4){lo_bf(w.x), hi_bf(w.x), lo_bf(w.y), hi_bf(w.y)}, p1 = (f32x4){lo_bf(w.z), hi_bf(w.z), lo_bf(w.w), hi_bf(w.w)};
                        const f32x4 x0 = (f32x4){lo_bf(xq.x), hi_bf(xq.x), lo_bf(xq.y), hi_bf(xq.y)}, x1 = (f32x4){lo_bf(xq.z), hi_bf(xq.z), lo_bf(xq.w), hi_bf(xq.w)};
                        f32x4 g0 = acc[ai][bj][m][0] * sc, g1 = acc[ai][bj][m][1] * sc;
#pragma unroll
                        for (int j = 0; j < 4; ++j) { g0[j] = sigmoidf_(g0[j]); g1[j] = sigmoidf_(g1[j]); }
                        const f32x4 v0 = x0 + p0 * ps * g0, v1 = x1 + p1 * ps * g1;
                        st_bf8(xbout + o, v0, v1); ss += sq8(v0, v1); }
                    ss += __shfl_xor(ss, 16); ss += __shfl_xor(ss, 32);
                    if (fq == 0) ssqout[(size_t)row * 16 + u.pn * 4 + wc] = ss; }
                EPI_FENCE;
            }
    }
};

struct MoeOrder {
    int tl[NE]; int nN, total, G, c;
    __device__ __forceinline__ void init(const unsigned* cnt, int nN_, int G_, int c_) {
        nN = nN_; G = G_; c = c_; int tt = 0;
#pragma unroll
        for (int e = 0; e < NE; ++e) { tl[e] = (int)((__builtin_amdgcn_readfirstlane(cnt[e]) + 255u) >> 8); tt += tl[e]; }
        total = tt * nN;
    }
    __device__ __forceinline__ bool next(int i, int& e, int& pml, int& pn, int& slot0) const {
        const long L = (long)i * G + c; if (L >= total) return false;
        int wgid = (int)L; { const int q = total / NXCD, r = total % NXCD, xcd = wgid % NXCD, off = wgid / NXCD; wgid = (xcd < r ? xcd * (q + 1) : r * (q + 1) + (xcd - r) * q) + off; }
        int ee = 0, ubase = 0, tbase = 0, nMe = tl[0], uacc = 0, tacc = 0;
#pragma unroll
        for (int k = 0; k < NE; ++k) { if (wgid >= uacc) { ee = k; ubase = uacc; tbase = tacc; nMe = tl[k]; } uacc += tl[k] * nN; tacc += tl[k]; }
        const int li = wgid - ubase, nig = WGM * nN, gid = li / nig, fm = gid * WGM, gsz = (nMe - fm) < WGM ? (nMe - fm) : WGM;
        pml = fm + ((li % nig) % gsz); pn = (li % nig) / gsz; e = ee; slot0 = (tbase + pml) * 256; return true;
    }
};
struct ProgMoeGu {
    __device__ __forceinline__ bool keep(const GU&) const { return false; }
    MoeOrder S; const bf16_t* xb; const bf16_t* Wt; const float* ssq; const int* idx; bf16_t* act;
    __device__ __forceinline__ bool unit(int i, GU& u) const {
        int e, pml, pn, slot0; if (!S.next(i, e, pml, pn, slot0)) return false;
        u.pm = slot0; u.pn = pn; u.sub = 0; u.aux = e; u.idx = idx + slot0; u.mapA = 99; u.mapB = 0; u.lda = 2048; u.ldb = 2048; u.nt = 16;
        u.A = (const char*)xb; u.B = (const char*)Wt + ((size_t)e * 7168 + (size_t)pn * 256) * 2048; return true;
    }
    __device__ __forceinline__ void epi(f32x4 (&acc)[2][2][4][2], const GU& u, int wr, int wc, int fr, int fq) const {
        const int rl0 = wr * 64 + fr, cl0 = wc * 32 + 8 * fq;
        const float r0_ = rstd_of(ssq, idx[u.pm + fq * 16 + rl0]), r1_ = rstd_of(ssq, idx[u.pm + 128 + fq * 16 + rl0]);
        EPI_ROWS(ai, m) { const int slot = u.pm + ai * 128 + m * 16 + rl0; const float s = EPI_SC(ai, m);
            f32x4 o[2];
#pragma unroll
            for (int n = 0; n < 2; ++n)
#pragma unroll
                for (int j = 0; j < 4; ++j) { const float g = acc[ai][0][m][n][j] * s, up = acc[ai][1][m][n][j] * s; o[n][j] = q8(siluf_(g) * up); }
            st_bf8(act + (size_t)slot * EXD + u.pn * 128 + cl0, o[0], o[1]); }
    }
};
struct MoeDownPlan { int ntiles, main, tail; };
__device__ __forceinline__ MoeDownPlan moe_down_plan(const unsigned* cnt, int G) {
    MoeDownPlan pl; int nt = 0;
#pragma unroll
    for (int e = 0; e < NE; ++e) nt += (int)((__builtin_amdgcn_readfirstlane(cnt[e]) + 255u) >> 8);
    const int U = 4 * nt; int tail = U % G; if (U < G || tail > TAILMAX) tail = 0;
    pl.ntiles = nt; pl.tail = tail; pl.main = U - tail; return pl;
}
struct ProgMoeDown {
    __device__ __forceinline__ bool keep(const GU&) const { return false; }
    int tl[NE]; MoeDownPlan pl; int G, c; const bf16_t* act; const bf16_t* Wt; bf16_t* ypair; float* partk;
    __device__ __forceinline__ void init(const unsigned* cnt, int G_, int c_) { G = G_; c = c_; pl = moe_down_plan(cnt, G_);
#pragma unroll
        for (int e = 0; e < NE; ++e) tl[e] = (int)((__builtin_amdgcn_readfirstlane(cnt[e]) + 255u) >> 8); }
    __device__ __forceinline__ bool unit(int i, GU& u) const {
        const long L = (long)i * G + c; int w, kp = -1;
        if (L < pl.main) { w = (int)L; const int q = pl.main / NXCD, r = pl.main % NXCD, xcd = w % NXCD, off = w / NXCD; w = (xcd < r ? xcd * (q + 1) : r * (q + 1) + (xcd - r) * q) + off; }
        else { const long s2 = L - pl.main; if (s2 >= (long)pl.tail * KSPL) return false; w = pl.main + (int)(s2 / KSPL); kp = (int)(s2 % KSPL); }
        const int tile = w >> 2, pn = w & 3; int e = 0, tacc = 0;
#pragma unroll
        for (int k = 0; k < NE; ++k) { if (tile >= tacc) e = k; tacc += tl[k]; }
        const int slot0 = tile * 256;
        u.pm = slot0; u.pn = pn; u.aux = e; u.idx = nullptr; u.mapA = 0; u.mapB = 0; u.lda = 7168; u.ldb = 7168;
        u.A = (const char*)act + (size_t)slot0 * 7168; u.B = (const char*)Wt + ((size_t)e * 1024 + (size_t)pn * 256) * 7168;
        if (kp < 0) { u.sub = 0; u.nt = 56; } else { u.sub = 1 + kp; u.nt = 8; u.A += kp * 1024; u.B += kp * 1024; }
        return true;
    }
    __device__ __forceinline__ void epi(f32x4 (&acc)[2][2][4][2], const GU& u, int wr, int wc, int fr, int fq) const {
        const int rl0 = wr * 64 + fr, cl0 = wc * 32 + 8 * fq;
        if (u.sub == 0) {
            EPI_ROWS(ai, m) { const int slot = u.pm + ai * 128 + m * 16 + rl0;
#pragma unroll
                for (int bj = 0; bj < 2; ++bj) st_bf8(ypair + (size_t)slot * 1024 + u.pn * 256 + bj * 128 + cl0, acc[ai][bj][m][0], acc[ai][bj][m][1]); }
        } else {
            float* pk = partk + ((size_t)(u.sub - 1) * (TAILMAX / 4) * 256 + (u.pm - (pl.main >> 2) * 256)) * 1024 + u.pn * 256 + cl0;
            EPI_ROWS(ai, m) { float* o = pk + (size_t)(ai * 128 + m * 16 + rl0) * 1024;
#pragma unroll
                for (int bj = 0; bj < 2; ++bj) { *(f32x4*)(o + bj * 128) = acc[ai][bj][m][0]; *(f32x4*)(o + bj * 128 + 4) = acc[ai][bj][m][1]; } }
        }
    }
};

struct Params { const float* in[30]; float* out; unsigned char* ws; int s_lo, s_hi; unsigned tmask; int pad; };
enum { I_X = 0, I_P, I_MIXN, I_WIN, I_DNCONV, I_DNALOG, I_DNDTB, I_DNNORM, I_SSCONV, I_SSCONVB, I_SSALOG, I_SSDTB, I_SSD, I_SSNORM, I_WBRDN, I_WBRSSM, I_WBRATT, I_WOUT, I_FFNN,
       I_WFG, I_WFU, I_WFD, I_WROUTER, I_WMG, I_WMU, I_WMD, I_PLEN, I_WPLE, I_WPLEG, I_FINALN };

template <class Map>
__device__ __forceinline__ void tr_job(const Map& map, int K, int N, bf16_t* WT, const float* gain, LAS float* scr, int lane, int gw, int NGW, float qs = 0.f) {
    const int nblk = N / 32, nitems = (K / 64) * nblk;
    for (int item = gw; item < nitems; item += NGW) {
        const int kb = item / nblk, nb = item % nblk, k0 = 64 * kb, n0 = 32 * nb;
        int ld = 0; const float* src = map(n0 + (lane & 31), ld);
#pragma unroll
        for (int i = 0; i < 32; ++i) { const int kk = 2 * i + (lane >> 5); float v = 0.f; if (src) { v = src[(size_t)(k0 + kk) * ld]; if (gain) v *= gain[k0 + kk]; if (EMU_FP8 && qs > 0.f) v = q8(v * qs) / qs; } scr[kk * 33 + (lane & 31)] = v; }
        asm volatile("s_waitcnt lgkmcnt(0)" ::: "memory");
        const int c = lane & 7;
#pragma unroll
        for (int j = 0; j < 4; ++j) { const int n = (lane >> 3) + 8 * j; const LAS float* s = scr + (8 * c) * 33 + n;
            u32x4 o; o.x = pk2(s[0 * 33], s[1 * 33]); o.y = pk2(s[2 * 33], s[3 * 33]); o.z = pk2(s[4 * 33], s[5 * 33]); o.w = pk2(s[6 * 33], s[7 * 33]);
            *(u32x4*)(WT + (size_t)(n0 + n) * K + k0 + 8 * c) = o; }
        asm volatile("s_waitcnt lgkmcnt(0)" ::: "memory");
    }
}
struct MapPlain { const float* W; int ld; __device__ __forceinline__ const float* operator()(int n, int& l) const { l = ld; return W + n; } };
struct MapIn { const float* W; __device__ __forceinline__ const float* operator()(int n, int& l) const { l = INW; const int tile = n >> 8, r = n & 255; int col;
        if (tile < 9) col = n; else if (tile < 12) col = C_DNZ + (n - 2304); else if (tile < 17) col = C_XBC + (n - 3072); else if (tile < 20) col = C_SSZ + (n - 4352);
        else if (tile < 29) col = C_ATT + (n - 5120); else if (tile < 41) col = C_GATE + (n - 7424);
        else { if (r < 6) col = C_DNA + r; else if (r < 12) col = C_DNB + (r - 6); else if (r < 24) col = C_SSDT + (r - 12); else return nullptr; }
        return W + col; } };
struct MapGu { const float* Wg; const float* Wu; int ld; __device__ __forceinline__ const float* operator()(int n, int& l) const { l = ld; const int tile = n >> 8, r = n & 255; return r < 128 ? Wg + tile * 128 + r : Wu + tile * 128 + (r - 128); } };

__device__ __forceinline__ void phase_convert(const Params& p, LAS unsigned char* lds) {
    const int tid_ = htid(), lane = tid_ & 63, wave = tid_ >> 6, G = gridDim.x;
    const int gw = blockIdx.x * 8 + wave, NGW = G * 8;
    LAS float* scr = (LAS float*)(lds + wave * 16384);
    unsigned char* ws = p.ws;
    for (int l = 0; l < DEPTH; ++l) {
        tr_job(MapIn{p.in[I_WIN] + (size_t)l * D * INW}, D, INP, (bf16_t*)(ws + WS_WIN) + (size_t)l * INP * D, p.in[I_MIXN] + l * D, scr, lane, gw, NGW);
        tr_job(MapPlain{p.in[I_WBRDN] + (size_t)l * 768 * D, D}, 768, D, (bf16_t*)(ws + WS_WDN) + (size_t)l * D * 768, nullptr, scr, lane, gw, NGW);
        tr_job(MapPlain{p.in[I_WBRSSM] + (size_t)l * 768 * D, D}, 768, D, (bf16_t*)(ws + WS_WSSM) + (size_t)l * D * 768, nullptr, scr, lane, gw, NGW);
        tr_job(MapPlain{p.in[I_WBRATT] + (size_t)l * 256 * D, D}, 256, D, (bf16_t*)(ws + WS_WATT) + (size_t)l * D * 256, nullptr, scr, lane, gw, NGW);
        tr_job(MapPlain{p.in[I_WOUT] + (size_t)l * D * D, D}, D, D, (bf16_t*)(ws + WS_WOUT) + (size_t)l * D * D, nullptr, scr, lane, gw, NGW);
        tr_job(MapPlain{p.in[I_WPLEG] + (size_t)l * D * D, D}, D, D, (bf16_t*)(ws + WS_WPG) + (size_t)l * D * D, p.in[I_PLEN] + l * D, scr, lane, gw, NGW);
        tr_job(MapPlain{p.in[I_WPLE] + (size_t)l * PLE * D, D}, PLE, D, (bf16_t*)(ws + WS_WPLE) + (size_t)l * D * PLE, nullptr, scr, lane, gw, NGW);
    }
    tr_job(MapGu{p.in[I_WFG], p.in[I_WFU], FFN}, D, 2 * FFN, (bf16_t*)(ws + WS_WFGU), p.in[I_FFNN], scr, lane, gw, NGW, 16.f);
    tr_job(MapPlain{p.in[I_WFD], D}, FFN, D, (bf16_t*)(ws + WS_WFD), nullptr, scr, lane, gw, NGW, 16.f);
    for (int e = 0; e < NE; ++e) {
        tr_job(MapGu{p.in[I_WMG] + (size_t)e * D * EXD, p.in[I_WMU] + (size_t)e * D * EXD, EXD}, D, 2 * EXD, (bf16_t*)(ws + WS_WMGU) + (size_t)e * 2 * EXD * D, p.in[I_FFNN] + D, scr, lane, gw, NGW, 16.f);
        tr_job(MapPlain{p.in[I_WMD] + (size_t)e * EXD * D, D}, EXD, D, (bf16_t*)(ws + WS_WMD) + (size_t)e * D * EXD, nullptr, scr, lane, gw, NGW, 16.f);
    }
    float* wr = (float*)(ws + WS_WR);
    for (int i = blockIdx.x * 512 + tid_; i < D * NE; i += G * 512) wr[i] = p.in[I_WROUTER][i] * p.in[I_FFNN][D + (i >> 3)];
}

__device__ __forceinline__ void phase_chunk_in(const Params& p, int chunk) {
    const int tid_ = htid(), lane = tid_ & 63, gw = blockIdx.x * 8 + (tid_ >> 6), NGW = gridDim.x * 8;
    const float* x = p.in[I_X] + (size_t)chunk * TC * D;
    bf16_t* xb = (bf16_t*)(p.ws + WS_XB); float* ssq = (float*)(p.ws + WS_SSQ);
    for (int r0 = gw; r0 < TC; r0 += 2 * NGW) {
        f32x4 v[2][4];
#pragma unroll
        for (int u = 0; u < 2; ++u) { const int r = r0 + u * NGW < TC ? r0 + u * NGW : r0; const f32x4* xr = (const f32x4*)(x + (size_t)r * D) + lane;
#pragma unroll
            for (int j = 0; j < 4; ++j) v[u][j] = xr[64 * j]; }
#pragma unroll
        for (int u = 0; u < 2; ++u) { const int r = r0 + u * NGW; if (r >= TC) break; float s = 0.f; u32x2* o = (u32x2*)(xb + (size_t)r * D) + lane;
#pragma unroll
            for (int j = 0; j < 4; ++j) { const f32x4 t = v[u][j]; s += (t.x * t.x + t.y * t.y) + (t.z * t.z + t.w * t.w); u32x2 w; w.x = pk2(t.x, t.y); w.y = pk2(t.z, t.w); o[64 * j] = w; }
            s = wave_sum(s);
            if (lane < 16) ssq[(size_t)r * 16 + lane] = lane == 0 ? s : 0.f; }
    }
    bf16_t* pb = (bf16_t*)(p.ws + WS_PB);
    for (int r0 = gw; r0 < 2 * TC; r0 += 4 * NGW) {
        f32x4 v[4];
#pragma unroll
        for (int u = 0; u < 4; ++u) { const int r = r0 + u * NGW < 2 * TC ? r0 + u * NGW : r0; const int l = r / TC, rr = r % TC;
            v[u] = *((const f32x4*)(p.in[I_P] + ((size_t)l * BATCH * SEQ + (size_t)chunk * TC + rr) * PLE) + lane); }
#pragma unroll
        for (int u = 0; u < 4; ++u) { const int r = r0 + u * NGW; if (r >= 2 * TC) break; const int l = r / TC, rr = r % TC;
            u32x2 w; w.x = pk2(v[u].x, v[u].y); w.y = pk2(v[u].z, v[u].w); *((u32x2*)(pb + ((size_t)l * TC + rr) * PLE) + lane) = w; }
    }
}
__device__ __forceinline__ void phase_final(const Params& p, int chunk) {
    const int tid_ = htid(), lane = tid_ & 63, gw = blockIdx.x * 8 + (tid_ >> 6), NGW = gridDim.x * 8;
    float* out = p.out + (size_t)chunk * TC * D; const bf16_t* xs = (const bf16_t*)(p.ws + WS_XB2); const float* g = p.in[I_FINALN];
    for (int r0 = gw; r0 < TC; r0 += 2 * NGW) {
        u32x4 q[2][2];
#pragma unroll
        for (int u = 0; u < 2; ++u) { const int r = r0 + u * NGW < TC ? r0 + u * NGW : r0; const u32x4* xr = (const u32x4*)(xs + (size_t)r * D) + lane; q[u][0] = xr[0]; q[u][1] = xr[64]; }
#pragma unroll
        for (int u = 0; u < 2; ++u) { const int r = r0 + u * NGW; if (r >= TC) break; float s = 0.f; f32x4 v[4];
#pragma unroll
            for (int j = 0; j < 2; ++j) { const u32x4 w = q[u][j]; v[2 * j] = (f32x4){lo_bf(w.x), hi_bf(w.x), lo_bf(w.y), hi_bf(w.y)}; v[2 * j + 1] = (f32x4){lo_bf(w.z), hi_bf(w.z), lo_bf(w.w), hi_bf(w.w)};
                s += sq8(v[2 * j], v[2 * j + 1]); }
            const float rs = rsqrtf(wave_sum(s) * (1.f / D) + EPS);
#pragma unroll
            for (int j = 0; j < 2; ++j) { const int c = 8 * (lane + 64 * j); float* o = out + (size_t)r * D + c;
                *(f32x4*)o = v[2 * j] * rs * *(const f32x4*)(g + c); *(f32x4*)(o + 4) = v[2 * j + 1] * rs * *(const f32x4*)(g + c + 4); } }
    }
}
__device__ __forceinline__ void phase_router(const Params& p, LAS unsigned char* lds, int chunk) {
    const int tid_ = htid(), lane = tid_ & 63, gw = blockIdx.x * 8 + (tid_ >> 6), NGW = gridDim.x * 8;
    const bf16_t* x = (const bf16_t*)(p.ws + WS_XB); const float* wr = (const float*)(p.ws + WS_WR);
    int* rt = (int*)(p.ws + WS_ROUTE); unsigned* cnt = (unsigned*)(p.ws + WS_CTL) + CW_CNT + chunk * 64;
    LAS unsigned* lcnt = (LAS unsigned*)lds;
    f32x4 w[16][2];
#pragma unroll
    for (int j = 0; j < 2; ++j)
#pragma unroll
        for (int q = 0; q < 8; ++q) { const int k = 8 * (lane + 64 * j) + q; w[8 * j + q][0] = *(const f32x4*)(wr + k * 8); w[8 * j + q][1] = *(const f32x4*)(wr + k * 8 + 4); }
    const int nouter = (TC + 8 * NGW - 1) / (8 * NGW);
    for (int ob = 0; ob < nouter; ++ob) {
        if (tid_ < 16) lcnt[tid_] = 0u;
        __syncthreads();
        int pe[8]; unsigned pr[8];
#pragma unroll
        for (int jr = 0; jr < 8; ++jr) { const int r = gw + (ob * 8 + jr) * NGW; pe[jr] = 0; pr[jr] = 0u;
            if (r < TC) {
                const u32x4* xr = (const u32x4*)(x + (size_t)r * D) + lane; float s = 0.f; float lg[NE];
#pragma unroll
                for (int e = 0; e < NE; ++e) lg[e] = 0.f;
#pragma unroll
                for (int j = 0; j < 2; ++j) { const u32x4 xw = xr[64 * j]; const float v[8] = {lo_bf(xw.x), hi_bf(xw.x), lo_bf(xw.y), hi_bf(xw.y), lo_bf(xw.z), hi_bf(xw.z), lo_bf(xw.w), hi_bf(xw.w)};
#pragma unroll
                    for (int q = 0; q < 8; ++q) { s += v[q] * v[q]; const f32x4 w0 = w[8 * j + q][0], w1 = w[8 * j + q][1];
                        lg[0] += v[q] * w0.x; lg[1] += v[q] * w0.y; lg[2] += v[q] * w0.z; lg[3] += v[q] * w0.w; lg[4] += v[q] * w1.x; lg[5] += v[q] * w1.y; lg[6] += v[q] * w1.z; lg[7] += v[q] * w1.w; } }
                const float rs = rsqrtf(wave_sum(s) * (1.f / D) + EPS);
#pragma unroll
                for (int e = 0; e < NE; ++e) lg[e] = wave_sum(lg[e]) * rs;
                int i0 = 0; float l0 = lg[0];
#pragma unroll
                for (int e = 1; e < NE; ++e) if (lg[e] > l0) { l0 = lg[e]; i0 = e; }
                int i1 = -1; float l1 = -3.0e38f;
#pragma unroll
                for (int e = 0; e < NE; ++e) if (e != i0 && lg[e] > l1) { l1 = lg[e]; i1 = e; }
                if (lane < 2) { const int e = lane == 0 ? i0 : i1; const float w0 = 1.f / (1.f + expf(l1 - l0));
                    pe[jr] = e; pr[jr] = __hip_atomic_fetch_add(lcnt + e, 1u, __ATOMIC_RELAXED, __HIP_MEMORY_SCOPE_WORKGROUP);
                    rt[RT_TOPE + 2 * r + lane] = e; ((float*)rt)[RT_TOPW + 2 * r + lane] = lane == 0 ? w0 : 1.f - w0; }
            } }
        __syncthreads();
        if (tid_ < 8) lcnt[8 + tid_] = atomicAdd(cnt + tid_, lcnt[tid_]);
        __syncthreads();
#pragma unroll
        for (int jr = 0; jr < 8; ++jr) { const int r = gw + (ob * 8 + jr) * NGW; if (r < TC && lane < 2) rt[RT_TOPP + 2 * r + lane] = (int)(lcnt[8 + pe[jr]] + pr[jr]); }
        __syncthreads();
    }
}
__device__ __forceinline__ void phase_slots(const Params& p, int chunk) {
    int* rt = (int*)(p.ws + WS_ROUTE); const unsigned* cnt = (const unsigned*)(p.ws + WS_CTL) + CW_CNT + chunk * 64;
    int c[NE], off[NE + 1]; off[0] = 0;
#pragma unroll
    for (int e = 0; e < NE; ++e) { c[e] = (int)cnt[e]; off[e + 1] = off[e] + ((c[e] + 255) & ~255); }
    const int gt = blockIdx.x * 512 + htid(), NT = gridDim.x * 512;
    for (int i = gt; i < 2 * TC; i += NT) {
        const int e = rt[RT_TOPE + i], pos = rt[RT_TOPP + i]; int o = 0;
#pragma unroll
        for (int k = 0; k < NE; ++k) o = (e == k) ? off[k] : o;
        const int slot = o + pos; rt[RT_TOPS + i] = slot; rt[RT_IDX + slot] = i >> 1;
    }
    for (int s = gt; s < off[NE]; s += NT) {
        bool pad = false;
#pragma unroll
        for (int k = 0; k < NE; ++k) pad = pad || (s >= off[k] + c[k] && s < off[k + 1]);
        if (pad) rt[RT_IDX + s] = 0;
    }
}
__device__ __forceinline__ f32x4 moe_y4(const bf16_t* yp, const float* partk, int slot, int tail0, int col) {
    if (slot < tail0) { const u32x2 a = *(const u32x2*)(yp + (size_t)slot * D + col); return (f32x4){lo_bf(a.x), hi_bf(a.x), lo_bf(a.y), hi_bf(a.y)}; }
    f32x4 v = (f32x4){0.f, 0.f, 0.f, 0.f};
#pragma unroll
    for (int k = 0; k < KSPL; ++k) v += *(const f32x4*)(partk + ((size_t)k * (TAILMAX / 4) * 256 + (slot - tail0)) * 1024 + col);
    return v;
}
__device__ __forceinline__ void phase_combine(const Params& p, int chunk) {
    const int tid_ = htid(), lane = tid_ & 63, gw = blockIdx.x * 8 + (tid_ >> 6), NGW = gridDim.x * 8;
    const int* rt = (const int*)(p.ws + WS_ROUTE);
    const bf16_t* yp = (const bf16_t*)(p.ws + WS_YPAIR); const float* partk = (const float*)(p.ws + WS_PARTK); bf16_t* xb = (bf16_t*)(p.ws + WS_XB); float* ssq = (float*)(p.ws + WS_SSQ);
    const MoeDownPlan pl = moe_down_plan((const unsigned*)(p.ws + WS_CTL) + CW_CNT + chunk * 64, gridDim.x);
    const int tail0 = pl.tail > 0 ? (pl.main >> 2) * 256 : 0x7fffffff;
    for (int r0 = gw; r0 < TC; r0 += 4 * NGW) {
        int sl[4][2]; float wt[4][2];
#pragma unroll
        for (int u = 0; u < 4; ++u) { const int r = r0 + u * NGW < TC ? r0 + u * NGW : r0; sl[u][0] = rt[RT_TOPS + 2 * r]; sl[u][1] = rt[RT_TOPS + 2 * r + 1];
            wt[u][0] = (DBG_ABL & 16) ? 0.f : ((const float*)rt)[RT_TOPW + 2 * r]; wt[u][1] = (DBG_ABL & 16) ? 0.f : ((const float*)rt)[RT_TOPW + 2 * r + 1]; }
#pragma unroll
        for (int u = 0; u < 4; ++u) { const int r = r0 + u * NGW; if (r >= TC) break;
            u32x2* xr = (u32x2*)(xb + (size_t)r * D) + lane; float s = 0.f;
            f32x4 v[4], y0[4], y1[4]; u32x2 xq[4];
            if (sl[u][0] < tail0 && sl[u][1] < tail0) {
                const u32x2* a0 = (const u32x2*)(yp + (size_t)sl[u][0] * D) + lane; const u32x2* a1 = (const u32x2*)(yp + (size_t)sl[u][1] * D) + lane; u32x2 q0[4], q1[4];
#pragma unroll
                for (int j = 0; j < 4; ++j) { xq[j] = xr[64 * j]; q0[j] = a0[64 * j]; q1[j] = a1[64 * j]; }
#pragma unroll
                for (int j = 0; j < 4; ++j) { y0[j] = (f32x4){lo_bf(q0[j].x), hi_bf(q0[j].x), lo_bf(q0[j].y), hi_bf(q0[j].y)}; y1[j] = (f32x4){lo_bf(q1[j].x), hi_bf(q1[j].x), lo_bf(q1[j].y), hi_bf(q1[j].y)}; }
            } else {
#pragma unroll
                for (int j = 0; j < 4; ++j) { const int col = 4 * (lane + 64 * j); xq[j] = xr[64 * j]; y0[j] = moe_y4(yp, partk, sl[u][0], tail0, col); y1[j] = moe_y4(yp, partk, sl[u][1], tail0, col); }
            }
#pragma unroll
            for (int j = 0; j < 4; ++j) { v[j] = (f32x4){lo_bf(xq[j].x), hi_bf(xq[j].x), lo_bf(xq[j].y), hi_bf(xq[j].y)}; const f32x4 t = v[j] + wt[u][0] * y0[j] + wt[u][1] * y1[j];
                s += (t.x * t.x + t.y * t.y) + (t.z * t.z + t.w * t.w); u32x2 w; w.x = pk2(t.x, t.y); w.y = pk2(t.z, t.w); xr[64 * j] = w; }
            s = wave_sum(s);
            if (lane < 16) ssq[(size_t)r * 16 + lane] = lane == 0 ? s : 0.f; }
    }
}

#define LDS_BARRIER() do { asm volatile("s_waitcnt lgkmcnt(0)" ::: "memory"); __builtin_amdgcn_s_barrier(); asm volatile("" ::: "memory"); } while (0)
__device__ __forceinline__ f32x4 mfma16(const bf16x8 a, const bf16x8 b, const f32x4 c) { return __builtin_amdgcn_mfma_f32_16x16x32_bf16(a, b, c, 0, 0, 0); }
__device__ __forceinline__ void dn_fetch(const Params& p, int b, int n, int h, u32x4 (&xr)[10]) {
    const int tid = htid();
    if (tid < 480) {
        const int cg = tid % 48, seg = tid / 48, part = cg >> 4, c8 = (cg & 15) * 8, col = part * 768 + h * 128 + c8, ts = seg * 7, t0 = n * 64;
        const bf16_t* proj = (const bf16_t*)(p.ws + WS_PDN) + (size_t)b * SEQ * 3072;
#pragma unroll
        for (int i = 0; i < 10; ++i) { const int t = t0 + ts - 3 + i; xr[i] = (u32x4){0u, 0u, 0u, 0u};
            if (t >= 0 && ts - 3 + i < 64) xr[i] = *(const u32x4*)(proj + (size_t)t * 3072 + col); }
    }
}
__device__ __forceinline__ void dn_prep(const Params& p, LAS unsigned char* lds, int layer, int b, int n, int h, u32x4 (&xr)[10], bool has_next, int nb_, int nn_, int nh_) {
    const int tid = htid(), lane = tid & 63, wave = tid >> 6;
    LAS float* AM = (LAS float*)lds;
    LAS float* SC = (LAS float*)(lds + 17408);
    LAS unsigned char* TW = lds + 19968; LAS unsigned char* TU = lds + 29184;
    LAS unsigned char* QS = lds + 38400; LAS unsigned char* KS = lds + 55808;
    LAS unsigned char* VT = lds + 73216; LAS unsigned char* KT = lds + 91648;
    LAS float* AR = (LAS float*)(lds + 110080);
    LAS unsigned char* T22L = lds + 118784; LAS unsigned char* T11C = lds + 121344;
    const int t0 = n * 64;
    const bf16_t* proj = (const bf16_t*)(p.ws + WS_PDN) + (size_t)b * SEQ * 3072;
    unsigned char* item = p.ws + WS_DNS + (size_t)((b * 32 + n) * 6 + h) * DNS_ITEM;
    if (tid < 480) {
        const int cg = tid % 48, seg = tid / 48, part = cg >> 4, c8 = (cg & 15) * 8, col = part * 768 + h * 128 + c8;
        const float* cw = p.in[I_DNCONV] + (size_t)layer * 4 * 2304 + col;
        f32x4 w[4][2];
#pragma unroll
        for (int j = 0; j < 4; ++j) { w[j][0] = *(const f32x4*)(cw + j * 2304); w[j][1] = *(const f32x4*)(cw + j * 2304 + 4); }
        const int ts = seg * 7;
        f32x4 x[10][2];
#pragma unroll
        for (int i = 0; i < 10; ++i) { const u32x4 w_ = xr[i]; x[i][0] = (f32x4){lo_bf(w_.x), hi_bf(w_.x), lo_bf(w_.y), hi_bf(w_.y)}; x[i][1] = (f32x4){lo_bf(w_.z), hi_bf(w_.z), lo_bf(w_.w), hi_bf(w_.w)}; }
        LAS unsigned char* dst = part == 0 ? QS : KS; LAS unsigned char* dstT = (part == 1 ? KT : VT) + c8 * 144; const int sw = (c8 >> 3) & 7;
#pragma unroll
        for (int i = 0; i < 7; ++i) { const int tk = ts + i;
            if (tk < 64) { f32x4 a0 = w[3][0] * x[i + 3][0] + w[2][0] * x[i + 2][0] + w[1][0] * x[i + 1][0] + w[0][0] * x[i][0];
                f32x4 a1 = w[3][1] * x[i + 3][1] + w[2][1] * x[i + 2][1] + w[1][1] * x[i + 1][1] + w[0][1] * x[i][1];
#pragma unroll
                for (int c = 0; c < 4; ++c) { a0[c] = siluf_(a0[c]); a1[c] = siluf_(a1[c]); }
                u32x4 pw; pw.x = pk2(a0[0], a0[1]); pw.y = pk2(a0[2], a0[3]); pw.z = pk2(a1[0], a1[1]); pw.w = pk2(a1[2], a1[3]);
                if (part < 2) *(LAS u32x4*)(dst + tk * 272 + c8 * 2) = pw;
                if (part > 0) { LAS unsigned char* T = dstT + ((((tk >> 3) ^ sw) << 4) | ((tk & 7) << 1));
                    *(LAS bf16_t*)(T + 0 * 144) = (bf16_t)(pw.x & 0xffffu); *(LAS bf16_t*)(T + 1 * 144) = (bf16_t)(pw.x >> 16); *(LAS bf16_t*)(T + 2 * 144) = (bf16_t)(pw.y & 0xffffu); *(LAS bf16_t*)(T + 3 * 144) = (bf16_t)(pw.y >> 16);
                    *(LAS bf16_t*)(T + 4 * 144) = (bf16_t)(pw.z & 0xffffu); *(LAS bf16_t*)(T + 5 * 144) = (bf16_t)(pw.z >> 16); *(LAS bf16_t*)(T + 6 * 144) = (bf16_t)(pw.w & 0xffffu); *(LAS bf16_t*)(T + 7 * 144) = (bf16_t)(pw.w >> 16); }
 } }
    } else {
        const float Aexp = expf(p.in[I_DNALOG][layer * 6 + h]), dtb = p.in[I_DNDTB][layer * 6 + h];
        const float* small = (const float*)(p.ws + WS_SMALL) + (size_t)b * SEQ * 32;
#pragma unroll
        for (int q = 0; q < 2; ++q) { const int tk = (tid - 480) * 2 + q; const float a = small[(size_t)(t0 + tk) * 32 + h], bb = small[(size_t)(t0 + tk) * 32 + 6 + h];
            SC[128 + tk] = sigmoidf_(bb); SC[192 + tk] = -Aexp * softplusf_(a + dtb); }
    }
    LDS_BARRIER();
    if (has_next) dn_fetch(p, nb_, nn_, nh_, xr);
    TSUB(8);
    {
        const int row = tid >> 3, sg = tid & 7; const u32x4 q0 = *(const LAS u32x4*)(QS + row * 272 + sg * 32), q1 = *(const LAS u32x4*)(QS + row * 272 + sg * 32 + 16), k0 = *(const LAS u32x4*)(KS + row * 272 + sg * 32), k1 = *(const LAS u32x4*)(KS + row * 272 + sg * 32 + 16);
        float sq = sq8((f32x4){lo_bf(q0.x), hi_bf(q0.x), lo_bf(q0.y), hi_bf(q0.y)}, (f32x4){lo_bf(q0.z), hi_bf(q0.z), lo_bf(q0.w), hi_bf(q0.w)}) + sq8((f32x4){lo_bf(q1.x), hi_bf(q1.x), lo_bf(q1.y), hi_bf(q1.y)}, (f32x4){lo_bf(q1.z), hi_bf(q1.z), lo_bf(q1.w), hi_bf(q1.w)});
        float sk = sq8((f32x4){lo_bf(k0.x), hi_bf(k0.x), lo_bf(k0.y), hi_bf(k0.y)}, (f32x4){lo_bf(k0.z), hi_bf(k0.z), lo_bf(k0.w), hi_bf(k0.w)}) + sq8((f32x4){lo_bf(k1.x), hi_bf(k1.x), lo_bf(k1.y), hi_bf(k1.y)}, (f32x4){lo_bf(k1.z), hi_bf(k1.z), lo_bf(k1.w), hi_bf(k1.w)});
        sq += __shfl_xor(sq, 1); sq += __shfl_xor(sq, 2); sq += __shfl_xor(sq, 4); sk += __shfl_xor(sk, 1); sk += __shfl_xor(sk, 2); sk += __shfl_xor(sk, 4);
        if (sg == 0) { SC[row] = sq; SC[64 + row] = sk; } }
    LDS_BARRIER();
    TSUB(9);
    if (wave == 0) {
        float g = SC[192 + lane];
#pragma unroll
        for (int o = 1; o < 64; o <<= 1) { const float t = __shfl_up(g, o); if (lane >= o) g += t; }
        const float eg = expf(g), rk = rsqrtf(SC[64 + lane] + EPS), glast = __shfl(g, 63);
        SC[192 + lane] = g; SC[256 + lane] = eg; SC[320 + lane] = rsqrtf(SC[lane] + EPS); SC[384 + lane] = rk;
        SC[448 + lane] = rk * SC[128 + lane] * eg; SC[576 + lane] = rk * fexp(glast - g);
    }
    LDS_BARRIER();
    TSUB(10);
    {
        const int r = lane & 15, kg = lane >> 4;
        bf16x8 fa[4][4], fb[4][4];
#pragma unroll
        for (int q = 0; q < 4; ++q) { const int t = wave * 4 + q, which = t >> 4, mt = (t >> 2) & 3, nt = t & 3;
            const LAS unsigned char* A = (which == 0 ? KS : QS) + (16 * mt + r) * 272 + kg * 16; const LAS unsigned char* Bt = KS + (16 * nt + r) * 272 + kg * 16;
#pragma unroll
            for (int ks = 0; ks < 4; ++ks) { fa[q][ks] = *(const LAS bf16x8*)(A + ks * 64); fb[q][ks] = *(const LAS bf16x8*)(Bt + ks * 64); } }
#pragma unroll
        for (int q = 0; q < 4; ++q) { const int t = wave * 4 + q, which = t >> 4, mt = (t >> 2) & 3, nt = t & 3;
            f32x4 acc = (f32x4){0.f, 0.f, 0.f, 0.f};
#pragma unroll
            for (int ks = 0; ks < 4; ++ks) acc = mfma16(fa[q][ks], fb[q][ks], acc);
            const int j = 16 * nt + r; const float gj = SC[192 + j], rkj = SC[384 + j];
            float ov[4], av[4];
#pragma unroll
            for (int rr = 0; rr < 4; ++rr) { const int i = 16 * mt + 4 * kg + rr; const float e = fexp(fminf(SC[192 + i] - gj, 0.f));
                av[rr] = (i > j) ? SC[128 + i] * SC[384 + i] * rkj * acc[rr] * e : 0.f;
                ov[rr] = (i >= j) ? SC[320 + i] * rkj * 0.08838834764831845f * acc[rr] * e : 0.f; }
            if (which == 0) { *(LAS f32x4*)(AM + (63 - j) * 68 + 60 - 16 * mt - 4 * kg) = (f32x4){av[3], av[2], av[1], av[0]};
                if (mt < 2 && nt < 2) { LAS float* ar_ = AR + (16 * mt + 4 * kg) * 68 + j; ar_[0] = av[0]; ar_[68] = av[1]; ar_[136] = av[2]; ar_[204] = av[3]; } }
            else { bf16_t* ao = (bf16_t*)(item + 32768) + (16 * mt + 4 * kg) * 64 + j; ST2_BF(ao, ao + 64, ov[0], ov[1]); ST2_BF(ao + 128, ao + 192, ov[2], ov[3]); }
        }
    }
    LDS_BARRIER();
    TSUB(11);
    if (wave < 2) {
        f32x2 x2[16];
        float lf = (float)lane; asm volatile("" : "+v"(lf));
#pragma unroll
        for (int m = 0; m < 16; ++m) x2[m] = (f32x2){fmaxf(1.f - fabsf(lf - (float)(2 * m)), 0.f), fmaxf(1.f - fabsf(lf - (float)(2 * m + 1)), 0.f)};
        const LAS float* AMv = wave == 0 ? AM : AR; asm volatile("" : "+v"(AMv));
        f32x4 rw[2][8]; f32x2 accA, accB; float sres;
#define ROW_BEGIN(i) do { accA = (f32x2){0.f, 0.f}; accB = accA; sres = x2[(i) >> 1][(i) & 1]; } while (0)
#define ROW_CHUNK(i, k4, am) do { \
            if (4 * (k4) + 1 < (i)) accA -= __builtin_shufflevector(am, am, 0, 1) * x2[2 * (k4)]; else if (4 * (k4) < (i)) sres -= am[0] * x2[2 * (k4)][0]; \
            if (4 * (k4) + 3 < (i)) accB -= __builtin_shufflevector(am, am, 2, 3) * x2[2 * (k4) + 1]; else if (4 * (k4) + 2 < (i)) sres -= am[2] * x2[2 * (k4) + 1][0]; } while (0)
#define ROW_END(i) x2[(i) >> 1][(i) & 1] = sres + ((accA[0] + accA[1]) + (accB[0] + accB[1]))
        rw[1][0] = *(const LAS f32x4*)(AMv + 1 * 68);
#pragma unroll
        for (int i = 1; i < 32; ++i) {
            if (i + 1 < 32) {
#pragma unroll
                for (int k4 = 0; k4 < (i + 4) / 4; ++k4) rw[(i + 1) & 1][k4] = *(const LAS f32x4*)(AMv + (i + 1) * 68 + 4 * k4);
            }
            ROW_BEGIN(i);
#pragma unroll
            for (int k4 = 0; k4 < (i + 3) / 4; ++k4) { const f32x4 am = rw[i & 1][k4]; ROW_CHUNK(i, k4, am); }
            ROW_END(i);
            { const float xi_ = x2[i >> 1][i & 1]; asm("" : "+v"(AMv) : "v"(xi_)); }
        }
#undef ROW_BEGIN
#undef ROW_CHUNK
#undef ROW_END
#define XE(a) x2[(a) >> 1][(a) & 1]
        if (wave == 0) {
            if (lane < 32) { const int irow = 63 - lane;
#pragma unroll
                for (int g = 4; g < 8; ++g) {
                    const f32x4 sw0 = *(const LAS f32x4*)(SC + 448 + 8 * g), sw1 = *(const LAS f32x4*)(SC + 448 + 8 * g + 4), su0 = *(const LAS f32x4*)(SC + 128 + 8 * g), su1 = *(const LAS f32x4*)(SC + 128 + 8 * g + 4);
                    u32x4 w, u, t;
                    w.x = pk2(XE(63 - 8 * g) * sw0[0], XE(62 - 8 * g) * sw0[1]); w.y = pk2(XE(61 - 8 * g) * sw0[2], XE(60 - 8 * g) * sw0[3]); w.z = pk2(XE(59 - 8 * g) * sw1[0], XE(58 - 8 * g) * sw1[1]); w.w = pk2(XE(57 - 8 * g) * sw1[2], XE(56 - 8 * g) * sw1[3]);
                    u.x = pk2(XE(63 - 8 * g) * su0[0], XE(62 - 8 * g) * su0[1]); u.y = pk2(XE(61 - 8 * g) * su0[2], XE(60 - 8 * g) * su0[3]); u.z = pk2(XE(59 - 8 * g) * su1[0], XE(58 - 8 * g) * su1[1]); u.w = pk2(XE(57 - 8 * g) * su1[2], XE(56 - 8 * g) * su1[3]);
                    t.x = pk2(XE(63 - 8 * g), XE(62 - 8 * g)); t.y = pk2(XE(61 - 8 * g), XE(60 - 8 * g)); t.z = pk2(XE(59 - 8 * g), XE(58 - 8 * g)); t.w = pk2(XE(57 - 8 * g), XE(56 - 8 * g));
                    *(LAS u32x4*)(TW + irow * 144 + g * 16) = w; *(LAS u32x4*)(TU + irow * 144 + g * 16) = u; *(LAS u32x4*)(T22L + (irow - 32) * 80 + (g - 4) * 16) = t; }
            }
        } else {
            if (lane < 32) {
#pragma unroll
                for (int g = 0; g < 4; ++g) { u32x4 t; t.x = pk2(XE(8 * g), XE(8 * g + 1)); t.y = pk2(XE(8 * g + 2), XE(8 * g + 3)); t.z = pk2(XE(8 * g + 4), XE(8 * g + 5)); t.w = pk2(XE(8 * g + 6), XE(8 * g + 7));
                    *(LAS u32x4*)(T11C + lane * 80 + g * 16) = t; }
                const float swl = SC[448 + lane], sul = SC[128 + lane];
#pragma unroll
                for (int a = 0; a < 32; a += 2) { const unsigned pw = pk2(XE(a) * swl, XE(a + 1) * swl), pu = pk2(XE(a) * sul, XE(a + 1) * sul);
                    *(LAS bf16_t*)(TW + a * 144 + lane * 2) = (bf16_t)(pw & 0xffffu); *(LAS bf16_t*)(TW + (a + 1) * 144 + lane * 2) = (bf16_t)(pw >> 16);
                    *(LAS bf16_t*)(TU + a * 144 + lane * 2) = (bf16_t)(pu & 0xffffu); *(LAS bf16_t*)(TU + (a + 1) * 144 + lane * 2) = (bf16_t)(pu >> 16); }
            } else {
#pragma unroll
                for (int g = 4; g < 8; ++g) { *(LAS u32x4*)(TW + (lane - 32) * 144 + g * 16) = (u32x4){0u, 0u, 0u, 0u}; *(LAS u32x4*)(TU + (lane - 32) * 144 + g * 16) = (u32x4){0u, 0u, 0u, 0u}; }
            }
        }
#undef XE
    } else {
        const int u = tid - 128;
#pragma unroll
        for (int i = 0; i < 3; ++i) { const int q = u + 384 * i; if (q < 1024) { const int c = q >> 4, d8 = (q & 15) * 8; f32x4 a0, a1;
            const u32x4 w = *(const LAS u32x4*)(QS + c * 272 + d8 * 2); const float sc = SC[320 + c] * 0.08838834764831845f * SC[256 + c];
            a0 = (f32x4){lo_bf(w.x), hi_bf(w.x), lo_bf(w.y), hi_bf(w.y)} * sc; a1 = (f32x4){lo_bf(w.z), hi_bf(w.z), lo_bf(w.w), hi_bf(w.w)} * sc;
            st_bf8((bf16_t*)(item + 16384) + c * 128 + d8, a0, a1); } }
#pragma unroll
        for (int i = 0; i < 3; ++i) { const int q = u + 384 * i; if (q < 1024) { const int d = q >> 3, g8 = q & 7;
            const u32x4 w = *(const LAS u32x4*)(KT + d * 144 + ((g8 ^ ((d >> 3) & 7)) << 4)); const f32x4 f0 = *(const LAS f32x4*)(SC + 576 + 8 * g8), f1 = *(const LAS f32x4*)(SC + 576 + 8 * g8 + 4);
            st_bf8((bf16_t*)(item + 40960) + d * 64 + 8 * g8, (f32x4){lo_bf(w.x), hi_bf(w.x), lo_bf(w.y), hi_bf(w.y)} * f0, (f32x4){lo_bf(w.z), hi_bf(w.z), lo_bf(w.w), hi_bf(w.w)} * f1); } }
        if (u == 0) ((float*)(p.ws + WS_DNEGL))[(b * 32 + n) * 6 + h] = SC[256 + 63];
        const float* ng = p.in[I_DNNORM] + layer * 128; bf16_t* ydn = (bf16_t*)(p.ws + WS_YDN) + ((size_t)b * SEQ + t0) * 768 + h * 128;
#pragma unroll
        for (int i = 0; i < 3; ++i) { const int q = u + 384 * i; if (q < 1024) { const int c = q >> 4, e8 = (q & 15) * 8; f32x4 z0, z1; ld_bf8(proj + (size_t)(t0 + c) * 3072 + 2304 + h * 128 + e8, z0, z1);
            const f32x4 g0 = *(const f32x4*)(ng + e8), g1 = *(const f32x4*)(ng + e8 + 4);
#pragma unroll
            for (int j = 0; j < 4; ++j) { z0[j] = g0[j] * siluf_(z0[j]); z1[j] = g1[j] * siluf_(z1[j]); }
            st_bf8(ydn + (size_t)c * 768 + e8, z0, z1); } }
    }
    LDS_BARRIER();
    if (wave < 4) {
        const int r = lane & 15, kg = lane >> 4, mt = wave >> 1, nt = wave & 1;
        const bf16x8 tb = *(const LAS bf16x8*)(T22L + (16 * mt + r) * 80 + kg * 16);
        f32x4 qt[2];
#pragma unroll
        for (int jt = 0; jt < 2; ++jt) { const LAS float* ap = AM + (63 - 16 * jt - r) * 68 + 24 - 8 * kg; const f32x4 lo = *(const LAS f32x4*)ap, hi = *(const LAS f32x4*)(ap + 4);
            u32x4 aw; aw.x = pk2(hi[3], hi[2]); aw.y = pk2(hi[1], hi[0]); aw.z = pk2(lo[3], lo[2]); aw.w = pk2(lo[1], lo[0]);
            qt[jt] = mfma16(__builtin_bit_cast(bf16x8, aw), tb, (f32x4){0.f, 0.f, 0.f, 0.f}); }
        u32x4 bw; bw.x = pk2(qt[0][0], qt[0][1]); bw.y = pk2(qt[0][2], qt[0][3]); bw.z = pk2(qt[1][0], qt[1][1]); bw.w = pk2(qt[1][2], qt[1][3]);
        const u32x2 a0 = *(const LAS u32x2*)(T11C + (16 * nt + r) * 80 + kg * 8), a1 = *(const LAS u32x2*)(T11C + (16 * nt + r) * 80 + 32 + kg * 8);
        u32x4 aw2; aw2.x = a0.x; aw2.y = a0.y; aw2.z = a1.x; aw2.w = a1.y;
        const f32x4 res = mfma16(__builtin_bit_cast(bf16x8, aw2), __builtin_bit_cast(bf16x8, bw), (f32x4){0.f, 0.f, 0.f, 0.f});
        const int row = 32 + 16 * mt + r, col0 = 16 * nt + 4 * kg;
        const f32x4 sw = *(const LAS f32x4*)(SC + 448 + col0), su = *(const LAS f32x4*)(SC + 128 + col0);
        u32x2 ow, ou; ow.x = pk2(-res[0] * sw[0], -res[1] * sw[1]); ow.y = pk2(-res[2] * sw[2], -res[3] * sw[3]); ou.x = pk2(-res[0] * su[0], -res[1] * su[1]); ou.y = pk2(-res[2] * su[2], -res[3] * su[3]);
        *(LAS u32x2*)(TW + row * 144 + col0 * 2) = ow; *(LAS u32x2*)(TU + row * 144 + col0 * 2) = ou;
    }
    LDS_BARRIER();
    TSUB(12);
    {
        const int r = lane & 15, kg = lane >> 4, ch = 16 * wave + r, sw = (ch >> 3) & 7;
        bf16x8 kf[2], vf[2], tw[4][2], tu[4][2];
#pragma unroll
        for (int ks = 0; ks < 2; ++ks) { kf[ks] = *(const LAS bf16x8*)(KT + ch * 144 + (((4 * ks + kg) ^ sw) << 4)); vf[ks] = *(const LAS bf16x8*)(VT + ch * 144 + (((4 * ks + kg) ^ sw) << 4)); }
#pragma unroll
        for (int it = 0; it < 4; ++it)
#pragma unroll
            for (int ks = 0; ks < 2; ++ks) { tw[it][ks] = *(const LAS bf16x8*)(TW + (16 * it + r) * 144 + (4 * ks + kg) * 16); tu[it][ks] = *(const LAS bf16x8*)(TU + (16 * it + r) * 144 + (4 * ks + kg) * 16); }
#pragma unroll
        for (int it = 0; it < 4; ++it) { f32x4 aw = (f32x4){0.f, 0.f, 0.f, 0.f}, au = aw;
#pragma unroll
            for (int ks = 0; ks < 2; ++ks) { aw = mfma16(kf[ks], tw[it][ks], aw); au = mfma16(tu[it][ks], vf[ks], au); }
            u32x2 o; o.x = pk2(aw[0], aw[1]); o.y = pk2(aw[2], aw[3]); *(u32x2*)((bf16_t*)item + (16 * it + r) * 128 + 16 * wave + 4 * kg) = o;
            o.x = pk2(au[0], au[1]); o.y = pk2(au[2], au[3]); *(u32x2*)(item + 57344 + (size_t)(16 * wave + r) * 128 + (16 * it + 4 * kg) * 2) = o; }
    }
    LDS_BARRIER();
    TSUB(13);
}
__device__ __forceinline__ float row16_sum(float v) {
    v += __builtin_bit_cast(float, __builtin_amdgcn_update_dpp(0, __builtin_bit_cast(int, v), 0xB1, 0xf, 0xf, false));
    v += __builtin_bit_cast(float, __builtin_amdgcn_update_dpp(0, __builtin_bit_cast(int, v), 0x4E, 0xf, 0xf, false));
    v += __builtin_bit_cast(float, __builtin_amdgcn_update_dpp(0, __builtin_bit_cast(int, v), 0x141, 0xf, 0xf, false));
    v += __builtin_bit_cast(float, __builtin_amdgcn_update_dpp(0, __builtin_bit_cast(int, v), 0x140, 0xf, 0xf, false));
    return v;
}
__device__ __forceinline__ void dn_scan(const Params& p, LAS unsigned char* lds, int layer, int b, int h) {
    const int tid = htid(), lane = tid & 63, wave = __builtin_amdgcn_readfirstlane(tid >> 6), r = lane & 15, kg = lane >> 4;
    LAS unsigned char* W = lds; LAS unsigned char* QD = lds + 17408; LAS unsigned char* ATT = lds + 34816; LAS unsigned char* KDT = lds + 44032; LAS unsigned char* UT = lds + 62464;
    LAS unsigned char* ST = lds + 80896; LAS unsigned char* VNT = lds + 115712; LAS float* PS = (LAS float*)(lds + 134144); LAS float* RS = (LAS float*)(lds + 136192) + wave * 64;
    const unsigned char* items = p.ws + WS_DNS + (size_t)(b * 32 * 6 + h) * DNS_ITEM;
    bf16_t* ydn = (bf16_t*)(p.ws + WS_YDN) + (size_t)b * SEQ * 768 + h * 128 + 16 * wave + r;
    float egl_all = lane < 32 ? ((const float*)(p.ws + WS_DNEGL))[b * 32 * 6 + h + 6 * lane] : 0.f;
    asm volatile("" : "+v"(egl_all));
    f32x4 S[8], o[4];
#pragma unroll
    for (int dt = 0; dt < 8; ++dt) S[dt] = (f32x4){0.f, 0.f, 0.f, 0.f};
#pragma unroll
    for (int mt = 0; mt < 4; ++mt) o[mt] = (f32x4){0.f, 0.f, 0.f, 0.f};
    for (int i = lane; i < 16 * 272 / 16; i += 64) *(LAS u32x4*)(ST + wave * 16 * 272 + i * 16) = (u32x4){0u, 0u, 0u, 0u};
    u32x4 R[9];
#pragma unroll
    for (int i = 0; i < 9; ++i) R[i] = *(const u32x4*)(items + (size_t)(tid + 512 * i) * 16);
    unsigned short zc[16];
#pragma unroll
    for (int i = 0; i < 16; ++i) zc[i] = 0u;
    LDS_BARRIER();
    for (int n = 0; n <= 32; ++n) {
        if (n < 32) {
#pragma unroll
            for (int i = 0; i < 9; ++i) { const int q = tid + 512 * i; LAS unsigned char* dst;
                if (i < 2) dst = W + (q >> 4) * 272 + (q & 15) * 16; else if (i < 4) dst = QD + ((q - 1024) >> 4) * 272 + (q & 15) * 16;
                else if (i < 5) dst = ATT + ((q - 2048) >> 3) * 144 + (q & 7) * 16; else if (i < 7) dst = KDT + ((q - 2560) >> 3) * 144 + (q & 7) * 16;
                else dst = UT + ((q - 3584) >> 3) * 144 + (q & 7) * 16;
                *(LAS u32x4*)dst = R[i]; }
        }
        if (n > 0) {
            float tot = 0.f;
#pragma unroll
            for (int w = 0; w < 8; ++w) tot += PS[w * 64 + lane];
            RS[lane] = rsqrtf(tot * (1.f / 128.f) + EPS);
#pragma unroll
            for (int mt = 0; mt < 4; ++mt) { const f32x4 rs = *(const LAS f32x4*)(RS + 16 * mt + 4 * kg);
#pragma unroll
                for (int rr = 0; rr < 4; rr += 2) { bf16_t* yo_ = ydn + (size_t)((n - 1) * 64 + 16 * mt + 4 * kg + rr) * 768;
                    ST2_BF(yo_, yo_ + 768, o[mt][rr] * rs[rr] * __uint_as_float(((unsigned)zc[4 * mt + rr]) << 16), o[mt][rr + 1] * rs[rr + 1] * __uint_as_float(((unsigned)zc[4 * mt + rr + 1]) << 16)); } }
        }
        if (n == 32) break;
        if (n + 1 < 32) {
#pragma unroll
            for (int i = 0; i < 9; ++i) R[i] = *(const u32x4*)(items + (size_t)(n + 1) * 6 * DNS_ITEM + (size_t)(tid + 512 * i) * 16);
        }
#pragma unroll
        for (int mt = 0; mt < 4; ++mt)
#pragma unroll
            for (int rr = 0; rr < 4; ++rr) zc[4 * mt + rr] = ydn[(size_t)(n * 64 + 16 * mt + 4 * kg + rr) * 768];
        const float egl = __builtin_bit_cast(float, __builtin_amdgcn_readlane(__builtin_bit_cast(int, egl_all), n));
        LDS_BARRIER();
        bf16x8 sf[4];
#pragma unroll
        for (int ks = 0; ks < 4; ++ks) sf[ks] = *(const LAS bf16x8*)(ST + (16 * wave + r) * 272 + ks * 64 + kg * 16);
        {   bf16x8 af[4][4]; u32x2 uw[4];
#pragma unroll
            for (int mt = 0; mt < 4; ++mt) {
#pragma unroll
                for (int ks = 0; ks < 4; ++ks) af[mt][ks] = *(const LAS bf16x8*)(W + (16 * mt + r) * 272 + ks * 64 + kg * 16);
                uw[mt] = *(const LAS u32x2*)(UT + (16 * wave + r) * 144 + (16 * mt + 4 * kg) * 2); }
#pragma unroll
            for (int mt = 0; mt < 4; ++mt) { f32x4 ws = (f32x4){0.f, 0.f, 0.f, 0.f};
#pragma unroll
                for (int ks = 0; ks < 4; ++ks) ws = mfma16(af[mt][ks], sf[ks], ws);
                const f32x4 vn = (f32x4){lo_bf(uw[mt].x), hi_bf(uw[mt].x), lo_bf(uw[mt].y), hi_bf(uw[mt].y)} - ws;
                u32x2 vw; vw.x = pk2(vn[0], vn[1]); vw.y = pk2(vn[2], vn[3]);
                *(LAS u32x2*)(VNT + (16 * wave + r) * 144 + (16 * mt + 4 * kg) * 2) = vw; } }
        bf16x8 vf[2];
        {
            bf16x8 qf[4][4], tf[4][2];
#pragma unroll
            for (int mt = 0; mt < 4; ++mt) {
#pragma unroll
                for (int ks = 0; ks < 4; ++ks) qf[mt][ks] = *(const LAS bf16x8*)(QD + (16 * mt + r) * 272 + ks * 64 + kg * 16);
#pragma unroll
                for (int kc = 0; kc < 2; ++kc) tf[mt][kc] = *(const LAS bf16x8*)(ATT + (16 * mt + r) * 144 + kc * 64 + kg * 16); }
#pragma unroll
            for (int kc = 0; kc < 2; ++kc) vf[kc] = *(const LAS bf16x8*)(VNT + (16 * wave + r) * 144 + kc * 64 + kg * 16);
#pragma unroll
            for (int mt = 0; mt < 4; ++mt) { f32x4 a = (f32x4){0.f, 0.f, 0.f, 0.f};
#pragma unroll
                for (int ks = 0; ks < 4; ++ks) a = mfma16(qf[mt][ks], sf[ks], a);
#pragma unroll
                for (int kc = 0; kc < 2; ++kc) a = mfma16(tf[mt][kc], vf[kc], a);
                o[mt] = a; } }
        {
            bf16x8 kf[8][2];
#pragma unroll
            for (int dt = 0; dt < 8; ++dt)
#pragma unroll
                for (int kc = 0; kc < 2; ++kc) kf[dt][kc] = *(const LAS bf16x8*)(KDT + (16 * dt + r) * 144 + kc * 64 + kg * 16);
#pragma unroll
            for (int dt = 0; dt < 8; ++dt) { f32x4 a = S[dt] * egl;
#pragma unroll
                for (int kc = 0; kc < 2; ++kc) a = mfma16(kf[dt][kc], vf[kc], a);
                S[dt] = a; u32x2 sw; sw.x = pk2(a[0], a[1]); sw.y = pk2(a[2], a[3]);
                *(LAS u32x2*)(ST + (16 * wave + r) * 272 + (16 * dt + 4 * kg) * 2) = sw; } }
#pragma unroll
        for (int mt = 0; mt < 4; ++mt) { f32x4 q;
#pragma unroll
            for (int rr = 0; rr < 4; ++rr) q[rr] = row16_sum(o[mt][rr] * o[mt][rr]);
            if (r == 0) *(LAS f32x4*)(PS + wave * 64 + 16 * mt + 4 * kg) = q; }
        LDS_BARRIER();
    }
    LDS_BARRIER();
}
template <int MODE>
__device__ __forceinline__ void ssd_load(const Params& p, LAS unsigned char* lds, int layer, int b, int c, int grp) {
    const int tid = htid(), lane = tid & 63, wave = tid >> 6, t0 = c * 64;
    LAS float* DT = (LAS float*)(lds + 117760); LAS float* ACS = DT + 384;
    LAS unsigned char* XT = lds + 34816;
    if (wave < 6) { const int hh = grp * 6 + wave; const float* small = (const float*)(p.ws + WS_SMALL) + ((size_t)b * SEQ + t0 + lane) * 32;
        const float dt = softplusf_(small[12 + hh] + p.in[I_SSDTB][layer * 12 + hh]); float a = -expf(p.in[I_SSALOG][layer * 12 + hh]) * dt;
#pragma unroll
        for (int o = 1; o < 64; o <<= 1) { const float t = __shfl_up(a, o); if (lane >= o) a += t; }
        DT[wave * 64 + lane] = dt; ACS[wave * 64 + lane] = a; }
    LDS_BARRIER();
    const int cg = tid % 80, seg = tid / 80, ch8 = cg * 8;
    if (tid < 480 && (MODE == 1 || ch8 < 512)) {
        const int col = ch8 < 384 ? grp * 384 + ch8 : (ch8 < 512 ? 768 + grp * 128 + (ch8 - 384) : 1024 + grp * 128 + (ch8 - 512));
        const float* cw = p.in[I_SSCONV] + (size_t)layer * 4 * 1280 + col; const float* cb = p.in[I_SSCONVB] + layer * 1280 + col;
        f32x4 w[4][2], bias[2];
#pragma unroll
        for (int j = 0; j < 4; ++j) { w[j][0] = *(const f32x4*)(cw + j * 1280); w[j][1] = *(const f32x4*)(cw + j * 1280 + 4); }
        bias[0] = *(const f32x4*)cb; bias[1] = *(const f32x4*)(cb + 4);
        const bf16_t* proj = (const bf16_t*)(p.ws + WS_PSSM) + (size_t)b * SEQ * 2048 + col;
        const int ts = seg * 11, hi = ch8 >> 6;
        f32x4 xm[3][2];
#pragma unroll
        for (int i = 0; i < 3; ++i) { const int t = t0 + ts - 3 + i; xm[i][0] = (f32x4){0.f, 0.f, 0.f, 0.f}; xm[i][1] = xm[i][0]; if (t >= 0) ld_bf8(proj + (size_t)t * 2048, xm[i][0], xm[i][1]); }
#pragma unroll
        for (int i = 0; i < 11; ++i) { const int tk = ts + i;
            if (tk < 64) { f32x4 c0, c1; ld_bf8(proj + (size_t)(t0 + tk) * 2048, c0, c1);
                f32x4 a0 = bias[0] + w[3][0] * c0 + w[2][0] * xm[2][0] + w[1][0] * xm[1][0] + w[0][0] * xm[0][0];
                f32x4 a1 = bias[1] + w[3][1] * c1 + w[2][1] * xm[2][1] + w[1][1] * xm[1][1] + w[0][1] * xm[0][1];
                xm[0][0] = xm[1][0]; xm[0][1] = xm[1][1]; xm[1][0] = xm[2][0]; xm[1][1] = xm[2][1]; xm[2][0] = c0; xm[2][1] = c1;
#pragma unroll
                for (int q = 0; q < 4; ++q) { a0[q] = siluf_(a0[q]); a1[q] = siluf_(a1[q]); }
                if (ch8 < 384) { const float sc = MODE == 0 ? DT[hi * 64 + tk] * fexp(ACS[hi * 64 + 63] - ACS[hi * 64 + tk]) : DT[hi * 64 + tk];
#pragma unroll
                    for (int q = 0; q < 4; ++q) { const unsigned pw = pk2(a0[q] * sc, a1[q] * sc);
                        *(LAS bf16_t*)(XT + (ch8 + q) * 144 + tk * 2) = (bf16_t)(pw & 0xffffu); *(LAS bf16_t*)(XT + (ch8 + 4 + q) * 144 + tk * 2) = (bf16_t)(pw >> 16); } }
                else if (MODE == 0) {
#pragma unroll
                    for (int q = 0; q < 4; ++q) { const unsigned pw = pk2(a0[q], a1[q]);
                        *(LAS bf16_t*)(lds + (ch8 - 384 + q) * 144 + tk * 2) = (bf16_t)(pw & 0xffffu); *(LAS bf16_t*)(lds + (ch8 - 384 + 4 + q) * 144 + tk * 2) = (bf16_t)(pw >> 16); } }
                else { u32x4 pw; pw.x = pk2(a0[0], a0[1]); pw.y = pk2(a0[2], a0[3]); pw.z = pk2(a1[0], a1[1]); pw.w = pk2(a1[2], a1[3]);
                    *(LAS u32x4*)(lds + (ch8 < 512 ? 17408 + tk * 272 + (ch8 - 384) * 2 : tk * 272 + (ch8 - 512) * 2)) = pw; } } }
    }
    LDS_BARRIER();
}
__device__ __forceinline__ void ssd_states(const Params& p, LAS unsigned char* lds, int layer, int b, int c, int grp) {
    ssd_load<0>(p, lds, layer, b, c, grp);
    const int tid = htid(), lane = tid & 63, wave = tid >> 6, r = lane & 15, kg = lane >> 4;
    const LAS unsigned char* XT = lds + 34816; const LAS unsigned char* BT = lds; const LAS float* ACS = (const LAS float*)(lds + 117760) + 384;
    bf16_t* st = (bf16_t*)(p.ws + WS_SSST) + ((size_t)(b * 32 + c) * 12 + grp * 6) * 8192;
    for (int t4 = 0; t4 < 24; t4 += 4) {
        bf16x8 af[4][2], bfr[4][2];
#pragma unroll
        for (int q = 0; q < 4; ++q) { const int t = wave + 8 * (t4 + q), hi = t >> 5, mt = (t >> 3) & 3, nt = t & 7;
#pragma unroll
            for (int ks = 0; ks < 2; ++ks) { af[q][ks] = *(const LAS bf16x8*)(XT + (hi * 64 + 16 * mt + r) * 144 + ks * 64 + kg * 16); bfr[q][ks] = *(const LAS bf16x8*)(BT + (16 * nt + r) * 144 + ks * 64 + kg * 16); } }
#pragma unroll
        for (int q = 0; q < 4; ++q) { const int t = wave + 8 * (t4 + q), hi = t >> 5, mt = (t >> 3) & 3, nt = t & 7;
            f32x4 acc = (f32x4){0.f, 0.f, 0.f, 0.f};
#pragma unroll
            for (int ks = 0; ks < 2; ++ks) acc = mfma16(af[q][ks], bfr[q][ks], acc);
#pragma unroll
            for (int rr = 0; rr < 4; rr += 2) { bf16_t* so_ = st + (size_t)hi * 8192 + (16 * mt + 4 * kg + rr) * 128 + 16 * nt + r; ST2_BF(so_, so_ + 128, acc[rr], acc[rr + 1]); } }
    }
    if (tid < 6) ((float*)(p.ws + WS_SSCD))[(b * 32 + c) * 12 + grp * 6 + tid] = expf(ACS[tid * 64 + 63]);
    LDS_BARRIER();
}
__device__ __forceinline__ void ssd_scan(const Params& p, int first_blk, int nblk) {
    const int gt = ((int)blockIdx.x - first_blk) * 512 + htid(), NT = nblk * 512;
    const u32x4* st = (const u32x4*)(p.ws + WS_SSST); const float* cd = (const float*)(p.ws + WS_SSCD); u32x4* pv = (u32x4*)(p.ws + WS_SSPV);
    for (int v = gt; v < NB * 12 * 1024; v += NT) { const int b = v / (12 * 1024), h = (v / 1024) % 12, e = v % 1024;
        f32x4 r0 = (f32x4){0.f, 0.f, 0.f, 0.f}, r1 = r0;
        for (int c0 = 0; c0 < 32; c0 += 8) { u32x4 t[8]; float dc[8];
#pragma unroll
            for (int i = 0; i < 8; ++i) { t[i] = st[((size_t)(b * 32 + c0 + i) * 12 + h) * 1024 + e]; dc[i] = cd[(b * 32 + c0 + i) * 12 + h]; }
#pragma unroll
            for (int i = 0; i < 8; ++i) { u32x4 w; w.x = pk2(r0[0], r0[1]); w.y = pk2(r0[2], r0[3]); w.z = pk2(r1[0], r1[1]); w.w = pk2(r1[2], r1[3]); pv[((size_t)(b * 32 + c0 + i) * 12 + h) * 1024 + e] = w;
                r0 = r0 * dc[i] + (f32x4){lo_bf(t[i].x), hi_bf(t[i].x), lo_bf(t[i].y), hi_bf(t[i].y)}; r1 = r1 * dc[i] + (f32x4){lo_bf(t[i].z), hi_bf(t[i].z), lo_bf(t[i].w), hi_bf(t[i].w)}; } }
    }
}
__device__ __forceinline__ void ssd_out(const Params& p, LAS unsigned char* lds, int layer, int b, int c, int grp) {
    ssd_load<1>(p, lds, layer, b, c, grp);
    const int tid = htid(), lane = tid & 63, wave = tid >> 6, r = lane & 15, kg = lane >> 4, t0 = c * 64;
    const LAS unsigned char* CM = lds; const LAS unsigned char* BM = lds + 17408; const LAS unsigned char* XT = lds + 34816; LAS unsigned char* MH = lds + 90112;
    const LAS float* DT = (const LAS float*)(lds + 117760); const LAS float* ACS = DT + 384; LAS float* YG = (LAS float*)lds;
    const bf16_t* prev = (const bf16_t*)(p.ws + WS_SSPV) + ((size_t)(b * 32 + c) * 12 + grp * 6) * 8192;
    f32x4 cb[2];
    {   bf16x8 ca[2][4], cbf[2][4];
#pragma unroll
        for (int q = 0; q < 2; ++q) { const int t = wave * 2 + q, mt = t >> 2, nt = t & 3;
#pragma unroll
            for (int ks = 0; ks < 4; ++ks) { ca[q][ks] = *(const LAS bf16x8*)(CM + (16 * mt + r) * 272 + ks * 64 + kg * 16); cbf[q][ks] = *(const LAS bf16x8*)(BM + (16 * nt + r) * 272 + ks * 64 + kg * 16); } }
#pragma unroll
        for (int q = 0; q < 2; ++q) { f32x4 acc = (f32x4){0.f, 0.f, 0.f, 0.f};
#pragma unroll
            for (int ks = 0; ks < 4; ++ks) acc = mfma16(ca[q][ks], cbf[q][ks], acc);
            cb[q] = acc; } }
    f32x4 y[2][6];
#pragma unroll
    for (int half = 0; half < 2; ++half) {
#pragma unroll
        for (int q = 0; q < 2; ++q) { const int t = wave * 2 + q, mt = t >> 2, nt = t & 3, j = 16 * nt + r;
#pragma unroll
            for (int hl = 0; hl < 3; ++hl) { const int hi = 3 * half + hl; const float aj = ACS[hi * 64 + j];
#pragma unroll
                for (int rr = 0; rr < 4; ++rr) { const int i = 16 * mt + 4 * kg + rr; *(LAS bf16_t*)(MH + hl * 9216 + i * 144 + j * 2) = (bf16_t)f2bf((i >= j) ? cb[q][rr] * fexp(fminf(ACS[hi * 64 + i] - aj, 0.f)) : 0.f); } } }
        bf16x8 pf[6][4];
#pragma unroll
        for (int k = 0; k < 6; ++k) { const int t = wave + 8 * k, hl = t >> 4, nt = t & 3, hi = 3 * half + hl; const bf16_t* pr = prev + (size_t)hi * 8192 + (16 * nt + r) * 128 + kg * 8;
#pragma unroll
            for (int ks = 0; ks < 4; ++ks) pf[k][ks] = *(const bf16x8*)(pr + ks * 32); }
        LDS_BARRIER();
#pragma unroll
        for (int k = 0; k < 6; ++k) { const int t = wave + 8 * k, hl = t >> 4, mt = (t >> 2) & 3, nt = t & 3, hi = 3 * half + hl, hh = grp * 6 + hi;
            f32x4 acc = (f32x4){0.f, 0.f, 0.f, 0.f}, off = acc;
            bf16x8 mf[2], xf[2], cf[4];
#pragma unroll
            for (int ks = 0; ks < 2; ++ks) { mf[ks] = *(const LAS bf16x8*)(MH + hl * 9216 + (16 * mt + r) * 144 + ks * 64 + kg * 16); xf[ks] = *(const LAS bf16x8*)(XT + (hi * 64 + 16 * nt + r) * 144 + ks * 64 + kg * 16); }
#pragma unroll
            for (int ks = 0; ks < 4; ++ks) cf[ks] = *(const LAS bf16x8*)(CM + (16 * mt + r) * 272 + ks * 64 + kg * 16);
#pragma unroll
            for (int ks = 0; ks < 2; ++ks) acc = mfma16(mf[ks], xf[ks], acc);
#pragma unroll
            for (int ks = 0; ks < 4; ++ks) off = mfma16(cf[ks], pf[k][ks], off);
            const u32x2 xw = *(const LAS u32x2*)(XT + (hi * 64 + 16 * nt + r) * 144 + (16 * mt + 4 * kg) * 2); const float xs[4] = {lo_bf(xw.x), hi_bf(xw.x), lo_bf(xw.y), hi_bf(xw.y)};
            const float dsk = p.in[I_SSD][layer * 12 + hh];
#pragma unroll
            for (int rr = 0; rr < 4; ++rr) { const int i = 16 * mt + 4 * kg + rr; acc[rr] += fexp(ACS[hi * 64 + i]) * off[rr] + dsk * xs[rr] * __builtin_amdgcn_rcpf(fmaxf(DT[hi * 64 + i], 1e-30f)); }
            y[half][k] = acc; }
        LDS_BARRIER();
    }
    const bf16_t* zp = (const bf16_t*)(p.ws + WS_PSSM) + ((size_t)b * SEQ + t0) * 2048 + 1280 + grp * 384;
#pragma unroll
    for (int half = 0; half < 2; ++half)
#pragma unroll
        for (int k = 0; k < 6; ++k) { const int t = wave + 8 * k, hl = t >> 4, mt = (t >> 2) & 3, nt = t & 3, hi = 3 * half + hl, ch = hi * 64 + 16 * nt + r;
#pragma unroll
            for (int rr = 0; rr < 4; ++rr) { const int i = 16 * mt + 4 * kg + rr; const float z = bf2f(zp[(size_t)i * 2048 + ch]); YG[i * 388 + ch] = y[half][k][rr] * siluf_(z); } }
    LDS_BARRIER();
    const float* sn = p.in[I_SSNORM] + layer * 768 + grp * 384; bf16_t* yo = (bf16_t*)(p.ws + WS_YSSM) + ((size_t)b * SEQ + t0) * 768 + grp * 384;
#pragma unroll
    for (int i8 = 0; i8 < 8; ++i8) { const int i = 8 * wave + i8; float v[6], ss = 0.f;
#pragma unroll
        for (int k = 0; k < 6; ++k) { v[k] = YG[i * 388 + lane + 64 * k]; ss += v[k] * v[k]; }
        const float rs = rsqrtf(wave_sum(ss) * (1.f / 384.f) + EPS);
#pragma unroll
        for (int k = 0; k < 6; k += 2) ST2_BF(yo + (size_t)i * 768 + lane + 64 * k, yo + (size_t)i * 768 + lane + 64 * (k + 1), v[k] * rs * sn[lane + 64 * k], v[k + 1] * rs * sn[lane + 64 * (k + 1)]); }
    LDS_BARRIER();
}

typedef float f32x16 __attribute__((ext_vector_type(16)));
__device__ __forceinline__ void attn_tile(const Params& p, int b, int g, int j, int r, int qt, int lane) {
    const int d = g == 0 ? 1 : (g == 1 ? 4 : 16), L = SEQ / d, n = lane & 31, hw = lane >> 5;
    const int P0 = b * SEQ + r * L;
    const bf16_t* Q = (const bf16_t*)(p.ws + WS_QK) + (size_t)(0 * 3 + g) * TC * 256 + j * 64;
    const bf16_t* K = (const bf16_t*)(p.ws + WS_QK) + (size_t)(1 * 3 + g) * TC * 256 + j * 64;
    const bf16_t* V = (const bf16_t*)(p.ws + WS_VT) + (size_t)(g * 256 + j * 64) * TC;
    const float sl2 = exp2f(-8.f * (float)(4 * g + j + 1) / 12.f) * (float)d * 1.4426950408889634f;
    bf16x8 qf[4];
    { const bf16_t* qrow = Q + (size_t)(P0 + 32 * qt + n) * 256 + 8 * hw;
#pragma unroll
      for (int s = 0; s < 4; ++s) qf[s] = *(const bf16x8*)(qrow + 16 * s); }
    f32x16 o0, o1;
#pragma unroll
    for (int i = 0; i < 16; ++i) { o0[i] = 0.f; o1[i] = 0.f; }
    float mrun = -1e30f, lrun = 0.f;
    const int pim = (n & 0x13) | (((n >> 2) & 1) << 3) | (((n >> 3) & 1) << 2);
    const int qi = 32 * qt + n;
    const int kb0 = qt > 4 ? qt - 4 : 0;
    bf16x8 kf[4], vf[2][2];
    { const bf16_t* krow = K + (size_t)(P0 + 32 * kb0 + pim) * 256 + 8 * hw;
#pragma unroll
      for (int s = 0; s < 4; ++s) kf[s] = *(const bf16x8*)(krow + 16 * s);
#pragma unroll
      for (int sp = 0; sp < 2; ++sp)
#pragma unroll
          for (int dh = 0; dh < 2; ++dh) vf[sp][dh] = *(const bf16x8*)(V + (size_t)(32 * dh + n) * TC + P0 + 32 * kb0 + 16 * sp + 8 * hw); }
    for (int kb = kb0; kb <= qt; ++kb) {
        f32x16 st;
#pragma unroll
        for (int i = 0; i < 16; ++i) st[i] = 0.f;
#pragma unroll
        for (int s = 0; s < 4; ++s) st = __builtin_amdgcn_mfma_f32_32x32x16_bf16(kf[s], qf[s], st, 0, 0, 0);
        bf16x8 vc[2][2];
#pragma unroll
        for (int sp = 0; sp < 2; ++sp)
#pragma unroll
            for (int dh = 0; dh < 2; ++dh) vc[sp][dh] = vf[sp][dh];
        if (kb < qt) {
            const bf16_t* krow = K + (size_t)(P0 + 32 * (kb + 1) + pim) * 256 + 8 * hw;
#pragma unroll
            for (int s = 0; s < 4; ++s) kf[s] = *(const bf16x8*)(krow + 16 * s);
#pragma unroll
            for (int sp = 0; sp < 2; ++sp)
#pragma unroll
                for (int dh = 0; dh < 2; ++dh) vf[sp][dh] = *(const bf16x8*)(V + (size_t)(32 * dh + n) * TC + P0 + 32 * (kb + 1) + 16 * sp + 8 * hw);
        }
        float mx = -1e30f;
#pragma unroll
        for (int jj = 0; jj < 16; ++jj) { const int kidx = 32 * kb + 16 * (jj >> 3) + 8 * hw + 4 * ((jj >> 2) & 1) + (jj & 3); const int dl = qi - kidx;
            const float sc = (dl >= 0 && dl <= 128) ? st[jj] * 1.4426950408889634f - sl2 * (float)dl : -1e30f; st[jj] = sc; mx = fmaxf(mx, sc); }
        mx = fmaxf(mx, __shfl_xor(mx, 32));
        const float mnew = fmaxf(mrun, mx), alpha = __builtin_amdgcn_exp2f(mrun - mnew);
        float rs = 0.f;
#pragma unroll
        for (int jj = 0; jj < 16; ++jj) { const float pj = __builtin_amdgcn_exp2f(st[jj] - mnew); st[jj] = pj; rs += pj; }
        rs += __shfl_xor(rs, 32);
        lrun = lrun * alpha + rs; mrun = mnew;
#pragma unroll
        for (int i = 0; i < 16; ++i) { o0[i] *= alpha; o1[i] *= alpha; }
#pragma unroll
        for (int sp = 0; sp < 2; ++sp) {
            u32x4 pw; pw.x = pk2(st[8 * sp + 0], st[8 * sp + 1]); pw.y = pk2(st[8 * sp + 2], st[8 * sp + 3]); pw.z = pk2(st[8 * sp + 4], st[8 * sp + 5]); pw.w = pk2(st[8 * sp + 6], st[8 * sp + 7]);
            const bf16x8 pf = __builtin_bit_cast(bf16x8, pw);
            o0 = __builtin_amdgcn_mfma_f32_32x32x16_bf16(vc[sp][0], pf, o0, 0, 0, 0);
            o1 = __builtin_amdgcn_mfma_f32_32x32x16_bf16(vc[sp][1], pf, o1, 0, 0, 0);
        }
    }
    const float inv = 1.f / lrun;
    const int tok = b * SEQ + qi * d + r;
    bf16_t* og = (bf16_t*)(p.ws + WS_OG) + ((size_t)g * TC + tok) * 256 + j * 64 + 4 * hw;
#pragma unroll
    for (int q4 = 0; q4 < 4; ++q4) {
        u32x2 w0, w1; w0.x = pk2(o0[4 * q4] * inv, o0[4 * q4 + 1] * inv); w0.y = pk2(o0[4 * q4 + 2] * inv, o0[4 * q4 + 3] * inv);
        w1.x = pk2(o1[4 * q4] * inv, o1[4 * q4 + 1] * inv); w1.y = pk2(o1[4 * q4 + 2] * inv, o1[4 * q4 + 3] * inv);
        *(u32x2*)(og + 8 * q4) = w0; *(u32x2*)(og + 32 + 8 * q4) = w1;
    }
    if (hw == 0) ((float*)(p.ws + WS_LSE))[((size_t)g * TC + tok) * 4 + j] = (mrun + log2f(lrun)) * 0.6931471805599453f;
}
__device__ __forceinline__ void phase_attn_combine(const Params& p, int skip) {
    const int tid_ = htid(), lane = tid_ & 63, gw = ((int)blockIdx.x - skip) * 8 + (tid_ >> 6), NGW = ((int)gridDim.x - skip) * 8;
    const bf16_t* og = (const bf16_t*)(p.ws + WS_OG); const float* lse = (const float*)(p.ws + WS_LSE); bf16_t* ya = (bf16_t*)(p.ws + WS_YATT);
    for (int t = gw; t < TC; t += NGW) {
        const int j = lane >> 4;
        const float l0 = lse[((size_t)0 * TC + t) * 4 + j], l1 = lse[((size_t)1 * TC + t) * 4 + j], l2 = lse[((size_t)2 * TC + t) * 4 + j];
        const float M = fmaxf(l0, fmaxf(l1, l2)); float w0 = expf(l0 - M), w1 = expf(l1 - M), w2 = expf(l2 - M); const float iw = 1.f / (w0 + w1 + w2); w0 *= iw; w1 *= iw; w2 *= iw;
        const u32x2 a = *((const u32x2*)(og + ((size_t)0 * TC + t) * 256) + lane), bb = *((const u32x2*)(og + ((size_t)1 * TC + t) * 256) + lane), c = *((const u32x2*)(og + ((size_t)2 * TC + t) * 256) + lane);
        u32x2 o; o.x = pk2(w0 * lo_bf(a.x) + w1 * lo_bf(bb.x) + w2 * lo_bf(c.x), w0 * hi_bf(a.x) + w1 * hi_bf(bb.x) + w2 * hi_bf(c.x));
        o.y = pk2(w0 * lo_bf(a.y) + w1 * lo_bf(bb.y) + w2 * lo_bf(c.y), w0 * hi_bf(a.y) + w1 * hi_bf(bb.y) + w2 * hi_bf(c.y));
        *((u32x2*)(ya + (size_t)t * 256) + lane) = o;
    }
}
__device__ __forceinline__ void sub_barrier(unsigned* cnt, unsigned target) {
    asm volatile("s_waitcnt vmcnt(0)" ::: "memory");
    __syncthreads();
    if (threadIdx.x == 0) {
        __builtin_amdgcn_fence(__ATOMIC_RELEASE, "agent"); asm volatile("s_waitcnt vmcnt(0)" ::: "memory");
        (void)xb_add(cnt, 1u);
        unsigned sp = 0; while (xb_ld(cnt) < target) { __builtin_amdgcn_s_sleep(2); if (++sp > (1u << 24)) break; }
        __builtin_amdgcn_fence(__ATOMIC_ACQUIRE, "agent"); asm volatile("s_waitcnt vmcnt(0)" ::: "memory");
    }
    __syncthreads();
}
__device__ __forceinline__ void phase_mixers(const Params& p, LAS unsigned char* lds, int layer) {
    const int G = gridDim.x, NDP = NB * 32 * 6, NSS = NB * 32 * 2;
    TSUB(15);
    u32x4 xr[10];
#pragma unroll
    for (int i = 0; i < 10; ++i) xr[i] = (u32x4){0u, 0u, 0u, 0u};
    if ((int)blockIdx.x < NDP) dn_fetch(p, (int)blockIdx.x / 192, ((int)blockIdx.x / 6) % 32, (int)blockIdx.x % 6, xr);
    for (int item = blockIdx.x; item < NDP + NSS; item += G) {
        if (item < NDP) { const int nx = item + G; dn_prep(p, lds, layer, item / 192, (item / 6) % 32, item % 6, xr, nx < NDP, nx / 192, (nx / 6) % 32, nx % 6); TSUB(6); }
        else { const int it = item - NDP; ssd_states(p, lds, layer, it / 64, (it >> 1) & 31, it & 1); TSUB(7); }
    }
}
__device__ __forceinline__ void phase_mixers2(const Params& p, LAS unsigned char* lds, int layer, int rep, unsigned* subcnt, bool use_bar2) {
    const int tid_ = htid(), lane = tid_ & 63, wave = tid_ >> 6, G = gridDim.x, nscan = NB * 6;
    const int ded = G > 2 * nscan ? nscan : 0;
    TSUB(15);
    if ((int)blockIdx.x < ded) { if (!(MIX2_PROBE == 2 && rep > 0)) dn_scan(p, lds, layer, blockIdx.x / 6, blockIdx.x % 6); TSUB(0); return; }
    if (MIX2_PROBE == 1 && rep > 0) return;
    if (ded == 0) for (int it = blockIdx.x; it < nscan; it += G) dn_scan(p, lds, layer, it / 6, it % 6);
    const int nb = G - ded, rb = (int)blockIdx.x - ded;
    constexpr int NAT = NB * 3 * 4 * 64 / 8, NSO = NB * 32 * 2, PA = 5;
    const int rounds = (NSO + nb - 1) / nb, nfull = NSO - (rounds - 1) * nb, nslack = nb - nfull;
    const int npost = (nslack > 0 && nslack * PA < NAT) ? nslack * PA : 0, npre = NAT - npost;
    auto attn_item = [&](int item) { const int w = item * 8 + wave;
        const int st = w & 63, jj = (w >> 6) & 3, gg = (w >> 8) % 3, bb = w / 768;
        const int dd = gg == 0 ? 1 : (gg == 1 ? 4 : 16), tiles = SEQ / dd / 32;
        attn_tile(p, bb, gg, jj, st / tiles, st % tiles, lane); };
    for (int item = rb; item < npre; item += nb) attn_item(item);
    TSUB(1);
    ssd_scan(p, ded, nb);
    TSUB(2);
    XcdBarrier bar2; bar2.bar = (unsigned*)(p.ws + WS_CTL) + CW_BAR2; bar2.x = xb_xcc_id(); bar2.st = (volatile LAS unsigned*)(lds + LDS_BYTES - 256) + 12;
    if (use_bar2) xcd_barrier(bar2, (unsigned)nb); else sub_barrier(subcnt, (unsigned)(nb * (2 * rep + 1)));
    TSUB(3);
    for (int it = rb; it < NSO; it += nb) ssd_out(p, lds, layer, it / 64, (it >> 1) & 31, it & 1);
    if (npost > 0 && rb >= nfull) for (int k = 0; k < PA; ++k) attn_item(npre + (rb - nfull) + k * nslack);
    TSUB(4);
    if (use_bar2) xcd_barrier(bar2, (unsigned)nb); else sub_barrier(subcnt, (unsigned)(nb * (2 * rep + 2)));
    phase_attn_combine(p, ded);
    TSUB(5);
}

constexpr int NSTEPS = 1 + NCH * (8 + 11 + 1);
__global__ void __launch_bounds__(512, 2) hybrid_fwd(Params p) {
    extern __shared__ __attribute__((aligned(16))) unsigned char lds_raw[];
    LAS unsigned char* lds = (LAS unsigned char*)lds_raw;
    volatile LAS unsigned* MISC = (volatile LAS unsigned*)(lds + LDS_BYTES - 256);
    if (threadIdx.x < 64) MISC[threadIdx.x] = 0u;
    __syncthreads();
    const int G = gridDim.x, cid = blockIdx.x;
    unsigned char* ws = p.ws;
    XcdBarrier bar; bar.bar = (unsigned*)(ws + WS_CTL) + CW_BAR; bar.x = 0; bar.st = MISC + 8;
    if (p.s_hi - p.s_lo > 1) bar = xcd_barrier_post((unsigned*)(ws + WS_CTL) + CW_BAR, MISC + 8);
    const bool use_bar2 = (p.s_hi - p.s_lo == NSTEPS) && ((int)gridDim.x > 2 * NB * 6);
    if (use_bar2 && (int)blockIdx.x >= NB * 6 && threadIdx.x == 0) (void)xb_add((unsigned*)(ws + WS_CTL) + CW_BAR2 + XB_XCNT(xb_xcc_id()), 1u);
    const int lo = p.s_lo, hi = p.s_hi;
    int step = 0;
    if (TPROBE_MASK != 0u && threadIdx.x == 0) { volatile LAS unsigned long long* tp_ = (volatile LAS unsigned long long*)(lds + LDS_BYTES - 256 + 128); tp_[0] = 0ull; tp_[1] = __builtin_amdgcn_s_memrealtime(); tp_[2] = 21ull; }
#define IN_STEP (step >= lo && step < hi)
#define END_STEP do { if (step >= lo && step + 1 < hi) xcd_barrier(bar); \
        if (TPROBE_ON && threadIdx.x == 0) { volatile LAS unsigned long long* tp_ = (volatile LAS unsigned long long*)(lds + LDS_BYTES - 256 + 128); const unsigned long long tn_ = __builtin_amdgcn_s_memrealtime(); \
            const unsigned pos_ = (unsigned)tp_[2]; if (pos_ < 22u && ((p.tmask >> pos_) & 1u)) tp_[0] += tn_ - tp_[1]; tp_[1] = tn_; tp_[2] = pos_ >= 20u ? 1ull : (unsigned long long)(pos_ + 1u); } \
        ++step; } while (0)
    bf16_t* xb = (bf16_t*)(ws + WS_XB); float* ssq = (float*)(ws + WS_SSQ);
    if (IN_STEP) for (int rep_ = 0; rep_ < (REP_PH == 0 ? 3 : 1); ++rep_, (rep_ < (REP_PH == 0 ? 3 : 1) ? xcd_barrier(bar) : (void)0)) { phase_convert(p, lds); phase_chunk_in(p, 0); }
    END_STEP;
    for (int chunk = 0; chunk < NCH; ++chunk) {
        float* xo = p.out + (size_t)chunk * TC * D;
        for (int layer = 0; layer < DEPTH; ++layer) {
            if (IN_STEP) for (int rep_ = 0; rep_ < (REP_PH == 2 ? 3 : 1); ++rep_, (rep_ < (REP_PH == 2 ? 3 : 1) ? xcd_barrier(bar) : (void)0)) {
                ProgIn P; P.S.init(TC / 256, INP / 256, G, cid); P.xb = layer == 0 ? xb : (const bf16_t*)(ws + WS_XB2); P.Wt = (const bf16_t*)(ws + WS_WIN) + (size_t)layer * INP * D; P.ssq = layer == 0 ? ssq : (const float*)(ws + WS_SSQ2);
                P.wsb = ws; P.pb = (const bf16_t*)(ws + WS_PB) + (size_t)layer * TC * PLE; P.wple = (const bf16_t*)(ws + WS_WPLE) + (size_t)layer * D * PLE;
                gemm_phase(lds, P);
            }
            END_STEP;
            if (IN_STEP) for (int rep_ = 0; rep_ < (REP_PH == 3 ? 3 : 1); ++rep_, (rep_ < (REP_PH == 3 ? 3 : 1) ? xcd_barrier(bar) : (void)0)) phase_mixers(p, lds, layer);
            END_STEP;
            if (IN_STEP) for (int rep_ = 0; rep_ < (REP_PH == 4 ? 3 : 1); ++rep_, (rep_ < (REP_PH == 4 ? 3 : 1) ? xcd_barrier(bar) : (void)0)) phase_mixers2(p, lds, layer, rep_, (unsigned*)(ws + WS_CTL) + CW_SUB + (chunk * 2 + layer) * 64, use_bar2);
            END_STEP;
            if (IN_STEP) for (int rep_ = 0; rep_ < (REP_PH == 6 ? 3 : 1); ++rep_, (rep_ < (REP_PH == 6 ? 3 : 1) ? xcd_barrier(bar) : (void)0)) {
                ProgMerge P; P.S.init(TC / 256, 4, G, cid); P.wsb = ws;
                P.wdn = (const bf16_t*)(ws + WS_WDN) + (size_t)layer * D * 768; P.wssm = (const bf16_t*)(ws + WS_WSSM) + (size_t)layer * D * 768; P.watt = (const bf16_t*)(ws + WS_WATT) + (size_t)layer * D * 256;
                gemm_phase(lds, P);
            }
            END_STEP;
            if (IN_STEP) {
                ProgResid P; P.S.init(TC / 256, 4, G, cid); P.A = (const bf16_t*)(ws + WS_MERGED); P.lda = 2048; P.nt = 16; P.Wt = (const bf16_t*)(ws + WS_WOUT) + (size_t)layer * D * D; P.ldb = 2048;
                P.xin_f = layer == 0 ? p.in[I_X] + (size_t)chunk * TC * D : nullptr; P.xin_b = (const bf16_t*)(ws + WS_XB2); P.xb = xb; P.ssq = ssq; P.sc = 1.f;
                gemm_phase(lds, P);
            }
            END_STEP;
            if (layer == 0) {
                if (IN_STEP) for (int rep_ = 0; rep_ < (REP_PH == 8 ? 3 : 1); ++rep_, (rep_ < (REP_PH == 8 ? 3 : 1) ? xcd_barrier(bar) : (void)0)) {
                    ProgFfnGu P; P.S.init(TC / 256, 2 * FFN / 256, G, cid); P.xb = xb; P.Wt = (const bf16_t*)(ws + WS_WFGU); P.ssq = ssq; P.act = (bf16_t*)(ws + WS_ACT);
                    gemm_phase(lds, P);
                }
                END_STEP;
                if (IN_STEP) {
                    ProgResid P; P.S.init(TC / 256, 4, G, cid); P.A = (const bf16_t*)(ws + WS_ACT); P.lda = 2 * FFN; P.nt = FFN / 64; P.Wt = (const bf16_t*)(ws + WS_WFD); P.ldb = 2 * FFN;
                    P.xin_f = nullptr; P.xin_b = xb; P.xb = xb; P.ssq = ssq; P.sc = (DBG_ABL & 8) ? 0.f : 1.f;
                    gemm_phase(lds, P);
                }
                END_STEP;
            } else {
                if (IN_STEP) phase_router(p, lds, chunk);
                END_STEP;
                if (IN_STEP) phase_slots(p, chunk);
                END_STEP;
                if (IN_STEP) for (int rep_ = 0; rep_ < (REP_PH == 12 ? 3 : 1); ++rep_, (rep_ < (REP_PH == 12 ? 3 : 1) ? xcd_barrier(bar) : (void)0)) {
                    ProgMoeGu P; P.S.init((const unsigned*)(ws + WS_CTL) + CW_CNT + chunk * 64, 2 * EXD / 256, G, cid); P.xb = xb; P.Wt = (const bf16_t*)(ws + WS_WMGU); P.ssq = ssq;
                    P.idx = (const int*)(ws + WS_ROUTE) + RT_IDX; P.act = (bf16_t*)(ws + WS_ACTM);
                    gemm_phase(lds, P);
                }
                END_STEP;
                if (IN_STEP) for (int rep_ = 0; rep_ < (REP_PH == 13 ? 3 : 1); ++rep_, (rep_ < (REP_PH == 13 ? 3 : 1) ? xcd_barrier(bar) : (void)0)) {
                    ProgMoeDown P; P.init((const unsigned*)(ws + WS_CTL) + CW_CNT + chunk * 64, G, cid); P.act = (const bf16_t*)(ws + WS_ACTM); P.Wt = (const bf16_t*)(ws + WS_WMD); P.ypair = (bf16_t*)(ws + WS_YPAIR); P.partk = (float*)(ws + WS_PARTK);
                    gemm_phase(lds, P);
                }
                END_STEP;
                if (IN_STEP) phase_combine(p, chunk);
                END_STEP;
            }
            if (IN_STEP) {
                ProgPle P; P.S.init(TC / 256, 4, G, cid); P.xb = xb; P.wpg = (const bf16_t*)(ws + WS_WPG) + (size_t)layer * D * D; P.pp = (const bf16_t*)(ws + WS_PP); P.ssq = ssq;
                P.xbout = (bf16_t*)(ws + WS_XB2); P.ssqout = (float*)(ws + WS_SSQ2);
                gemm_phase(lds, P);
            }
            END_STEP;
        }
        if (IN_STEP) { phase_final(p, chunk); if (chunk + 1 < NCH) phase_chunk_in(p, chunk + 1); }
        END_STEP;
    }
    if (TPROBE_MASK != 0u && (int)blockIdx.x == (p.pad & 0xffff) && threadIdx.x == 0) { const unsigned long long tsum_ = *(volatile LAS unsigned long long*)(lds + LDS_BYTES - 256 + 128); const unsigned long long t0_ = __builtin_amdgcn_s_memrealtime(); while (__builtin_amdgcn_s_memrealtime() - t0_ < 4ull * tsum_) __builtin_amdgcn_s_sleep(16); }
#undef IN_STEP
#undef END_STEP
}

#if defined(DBG_REP_STEP)
__global__ void dbg_csum(const unsigned* buf, size_t n, unsigned long long* out) {
    unsigned long long a = 0;
    for (size_t i = (size_t)blockIdx.x * 256 + threadIdx.x; i < n; i += (size_t)gridDim.x * 256) a += (unsigned long long)buf[i] * (unsigned long long)((i % 1021) + 1);
    atomicAdd(out, a);
}
__global__ void dbg_verdict(float* out, const unsigned long long* cs, int R) {
    bool bad = false; for (int r = 1; r < R; ++r) bad = bad || (cs[r] != cs[0]);
    const float v = bad ? __builtin_nanf("") : 0.f; const size_t n = (size_t)BATCH * SEQ * D;
    for (size_t i = (size_t)blockIdx.x * 256 + threadIdx.x; i < n; i += (size_t)gridDim.x * 256) out[i] = v;
}
#endif
#if defined(DBG_STOP)
#ifndef DBG_DUMP
#define DBG_DUMP 0
#define DBG_DUMP_OFF 0
#endif
__global__ void dbg_fill(float* out, const unsigned short* buf, int dump) {
    const size_t n = (size_t)BATCH * SEQ * D, c0 = (size_t)TC * D;
    for (size_t i = (size_t)blockIdx.x * 256 + threadIdx.x; i < n; i += (size_t)gridDim.x * 256) {
        if (i >= c0) out[i] = 0.f; else if (dump) out[i] = __uint_as_float(((unsigned)buf[i]) << 16);
    }
}
#endif
extern "C" void kernel_launch(void* const* d_in, const int* in_sizes, int n_in, void* d_out, int out_size, void* d_ws, size_t ws_size, hipStream_t stream) {
    static int grid = 0;
    if (grid == 0) {
        if (n_in != 30 || out_size != BATCH * SEQ * D || ws_size < WS_END) { fprintf(stderr, "kernel_launch: unexpected shapes (n_in %d, out %d, ws %zu < %zu)\n", n_in, out_size, ws_size, (size_t)WS_END); grid = -1; return; }
        int dev = 0, cus = 0;
        if (hipGetDevice(&dev) != hipSuccess || hipDeviceGetAttribute(&cus, hipDeviceAttributeMultiprocessorCount, dev) != hipSuccess) { grid = -1; return; }
        if (hipFuncSetAttribute((const void*)hybrid_fwd, hipFuncAttributeMaxDynamicSharedMemorySize, LDS_BYTES) != hipSuccess) { fprintf(stderr, "kernel_launch: hipFuncSetAttribute failed\n"); grid = -1; return; }
        int per_cu = 0;
        if (hipOccupancyMaxActiveBlocksPerMultiprocessor(&per_cu, (const void*)hybrid_fwd, 512, LDS_BYTES) != hipSuccess || per_cu < 1) { fprintf(stderr, "kernel_launch: occupancy query says %d\n", per_cu); }
        (void)hipGetLastError();
        grid = cus;
    }
    if (grid < 0) return;
    (void)hipMemsetAsync((char*)d_ws + WS_CTL, 0, MiB, stream);
    Params p{};
    for (int i = 0; i < 30; ++i) p.in[i] = (const float*)d_in[i];
    p.out = (float*)d_out; p.ws = (unsigned char*)d_ws; p.tmask = TPROBE_MASK; p.pad = TPROBE_PAD;
#if defined(DBG_REP_STEP)
    for (int s = 0; s < DBG_REP_STEP; ++s) { p.s_lo = s; p.s_hi = s + 1; hipLaunchKernelGGL(hybrid_fwd, dim3(grid), dim3(512), LDS_BYTES, stream, p); }
    unsigned long long* cs = (unsigned long long*)((char*)d_ws + WS_CTL + 512 * 1024);
    for (int r = 0; r < DBG_REP_N; ++r) { p.s_lo = DBG_REP_STEP; p.s_hi = DBG_REP_STEP + 1; hipLaunchKernelGGL(hybrid_fwd, dim3(grid), dim3(512), LDS_BYTES, stream, p);
        hipLaunchKernelGGL(dbg_csum, dim3(1024), dim3(256), 0, stream, (const unsigned*)((const char*)d_ws + DBG_REP_OFF), (size_t)(DBG_REP_BYTES) / 4, cs + r); }
    hipLaunchKernelGGL(dbg_verdict, dim3(2048), dim3(256), 0, stream, (float*)d_out, cs, (int)DBG_REP_N);
#elif defined(DBG_STOP)
    for (int s = 0; s < DBG_STOP; ++s) { p.s_lo = s; p.s_hi = s + 1; hipLaunchKernelGGL(hybrid_fwd, dim3(grid), dim3(512), LDS_BYTES, stream, p); }
    hipLaunchKernelGGL(dbg_fill, dim3(2048), dim3(256), 0, stream, (float*)d_out, (const unsigned short*)((const char*)d_ws + DBG_DUMP_OFF), (int)DBG_DUMP);
#elif ONE_LAUNCH
    p.s_lo = 0; p.s_hi = NSTEPS;
    hipLaunchKernelGGL(hybrid_fwd, dim3(grid), dim3(512), LDS_BYTES, stream, p);
#else
    for (int s = 0; s < NSTEPS; ++s) { p.s_lo = s; p.s_hi = s + 1; hipLaunchKernelGGL(hybrid_fwd, dim3(grid), dim3(512), LDS_BYTES, stream, p); }
#endif
}
```
